# Optimizing an MI355X kernel written in HIP

```python
import math
import jax, jax.numpy as jnp
from jax import lax
import numpy as np


D_MODEL = 1024
BATCH = 8
SEQ = 4096
DEPTH = 2

MIX_W = 512
ATTN_HEADS = 8
ATTN_HEAD_DIM = 64
IDX_HEADS = 8
IDX_DIM = 64
TOPK_MAX = 256
Q_BLOCK = 128
N_BUCKETS = 32
MAX_DISTANCE = 128
RWKV_HEADS = 8
RWKV_HEAD_DIM = 64
LORA_DECAY = 64
LORA_ICLR = 64
LORA_GATE = 128
CONV_CH = 512
CONV_W = 3
D_FF = 2816
N_BRANCH = 3
NORM_EPS = 1e-6
GN_EPS = 64e-5
NEG_INF = -1e30

ATTN_COLS = 3 * MIX_W + IDX_HEADS * IDX_DIM + IDX_DIM + IDX_HEADS
RWKV_COLS = 3 * MIX_W + LORA_DECAY + LORA_ICLR + LORA_GATE
CONV_COLS = 3 * CONV_CH
GATE_COLS = N_BRANCH * D_MODEL
IN_COLS = ATTN_COLS + RWKV_COLS + CONV_COLS + GATE_COLS

kernel_name = 'hybrid_dsa_rwkv7_shortconv_block'


def split_cols(z, sizes):
    out, start = [], 0
    for n in sizes:
        out.append(z[..., start:start + n])
        start += n
    return out


def rmsnorm(x, g):
    xf = x.astype(jnp.float32)
    y = xf * lax.rsqrt(jnp.mean(xf * xf, axis=-1, keepdims=True) + NORM_EPS)
    return (y * g.astype(jnp.float32)).astype(x.dtype)


def token_shift(z):
    return jnp.pad(z, ((0, 0), (1, 0), (0, 0)))[:, :-1]


def causal_dwconv(z, w):
    s = z.shape[1]
    zp = jnp.pad(z, ((0, 0), (CONV_W - 1, 0), (0, 0)))
    return sum(zp[:, j:j + s] * w[:, j] for j in range(CONV_W))


def t5_bucket(dist):
    n = jnp.maximum(dist, 0)
    max_exact = N_BUCKETS // 2
    nf = jnp.maximum(n, 1).astype(jnp.float32)
    large = max_exact + (jnp.log(nf / max_exact) / math.log(MAX_DISTANCE / max_exact)
                         * (N_BUCKETS - max_exact)).astype(jnp.int32)
    large = jnp.minimum(large, N_BUCKETS - 1)
    return jnp.where(n < max_exact, n, large)


def dsa_attention(z_attn, positions, rel_bias):
    b, s, _ = z_attn.shape
    q, k, v, qi, ki, wi = split_cols(z_attn, (MIX_W, MIX_W, MIX_W, IDX_HEADS * IDX_DIM, IDX_DIM, IDX_HEADS))
    q = q.reshape(b, s, ATTN_HEADS, ATTN_HEAD_DIM)
    k = k.reshape(b, s, ATTN_HEADS, ATTN_HEAD_DIM)
    v = v.reshape(b, s, ATTN_HEADS, ATTN_HEAD_DIM)
    qi = qi.reshape(b, s, IDX_HEADS, IDX_DIM)
    wi = wi * IDX_HEADS ** -0.5
    n_keep = min(TOPK_MAX, s // 4)
    nb = s // Q_BLOCK
    s_idx = jnp.arange(s, dtype=jnp.int32)
    t_blocks = s_idx.reshape(nb, Q_BLOCK)
    gather = jax.vmap(lambda a, i: a[i])

    def to_blocks(a):
        return jnp.moveaxis(a.reshape((b, nb, Q_BLOCK) + a.shape[2:]), 1, 0)

    def one_block(args):
        q_b, qi_b, wi_b, pos_b, t_b = args
        sc = jnp.einsum('bqhd,bsd->bqsh', qi_b, ki) * IDX_DIM ** -0.5
        score = jnp.einsum('bqsh,bqh->bqs', jax.nn.relu(sc), wi_b).astype(jnp.float32)
        score = jnp.where(s_idx[None, None, :] <= t_b[None, :, None], score, NEG_INF)
        _, sel = lax.top_k(score, n_keep)
        k_sel = gather(k, sel)
        v_sel = gather(v, sel)
        logits = jnp.einsum('bqhd,bqkhd->bqhk', q_b, k_sel).astype(jnp.float32) * ATTN_HEAD_DIM ** -0.5
        dist = pos_b[:, :, None] - gather(positions, sel)
        bias = rel_bias[t5_bucket(dist)].astype(jnp.float32)
        logits = logits + jnp.moveaxis(bias, -1, 2)
        valid = (sel <= t_b[None, :, None])[:, :, None, :]
        p = jax.nn.softmax(jnp.where(valid, logits, NEG_INF), axis=-1)
        o = jnp.einsum('bqhk,bqkhd->bqhd', p.astype(v.dtype), v_sel)
        return o.reshape(b, Q_BLOCK, MIX_W)

    out = lax.map(one_block, (to_blocks(q), to_blocks(qi), to_blocks(wi), to_blocks(positions), t_blocks))
    return jnp.moveaxis(out, 0, 1).reshape(b, s, MIX_W)


def rwkv7_mix(z, mu, w0, w_up, a0, a_up, g_up, k_k, k_a, r_k, ln_w, ln_b):
    b, s, _ = z.shape
    f32 = jnp.float32
    z = z + (token_shift(z) - z) * mu
    r, k, v, wd, ad, gd = split_cols(z, (MIX_W, MIX_W, MIX_W, LORA_DECAY, LORA_ICLR, LORA_GATE))
    log_w = -jax.nn.softplus(-(w0 + jnp.tanh(wd) @ w_up).astype(f32)) - 0.5
    decay = jnp.exp(-jnp.exp(log_w))
    a_f = jax.nn.sigmoid((a0 + ad @ a_up).astype(f32))
    g = jax.nn.sigmoid(gd) @ g_up
    heads = lambda t: t.astype(f32).reshape(b, s, RWKV_HEADS, RWKV_HEAD_DIM)
    kk = heads(k * k_k)
    kk = kk / jnp.maximum(jnp.sqrt(jnp.sum(kk * kk, axis=-1, keepdims=True)), 1e-12)
    k_mod = k.astype(f32) * (1 + (a_f - 1) * k_a)
    r_h, w_h, k_h, v_h, a_h = heads(r), heads(decay), heads(k_mod), heads(v), heads(a_f)

    def step(state, inp):
        r_t, w_t, k_t, v_t, ka_t, kb_t = inp
        sa = jnp.einsum('bhij,bhj->bhi', state, ka_t)
        state = state * w_t[:, :, None, :] + sa[..., None] * kb_t[:, :, None, :] + v_t[..., None] * k_t[:, :, None, :]
        return state, jnp.einsum('bhij,bhj->bhi', state, r_t)

    tm = lambda t: jnp.moveaxis(t, 1, 0)
    s0 = jnp.zeros((b, RWKV_HEADS, RWKV_HEAD_DIM, RWKV_HEAD_DIM), f32)
    _, y = lax.scan(step, s0, (tm(r_h), tm(w_h), tm(k_h), tm(v_h), tm(-kk), tm(kk * a_h)))
    y = jnp.moveaxis(y, 0, 1)
    mean = jnp.mean(y, axis=-1, keepdims=True)
    var = jnp.mean(jnp.square(y - mean), axis=-1, keepdims=True)
    hn = (RWKV_HEADS, RWKV_HEAD_DIM)
    y = (y - mean) * lax.rsqrt(var + GN_EPS) * ln_w.astype(f32).reshape(hn) + ln_b.astype(f32).reshape(hn)
    y = y + jnp.sum(r_h * k_h * r_k.astype(f32).reshape(hn), axis=-1, keepdims=True) * v_h
    return (y.reshape(b, s, MIX_W) * g.astype(f32)).astype(z.dtype)


def conv_glu_ffn(h, w_up, conv_w, w_down):
    a, g = jnp.split(h @ w_up, 2, axis=-1)
    return (jax.nn.silu(causal_dwconv(a, conv_w)) * g) @ w_down


def setup_inputs(seed: int = 0) -> dict:
    key = jax.random.key(seed)
    ks = jax.random.split(key, 32)
    nrm = lambda k, shape, scale: jax.random.normal(k, shape, jnp.float32) * scale
    L = DEPTH
    return {
        'x': nrm(ks[0], (BATCH, SEQ, D_MODEL), 1.0),
        'c': nrm(ks[1], (BATCH, D_MODEL), 1.0),
        'positions': jnp.broadcast_to(jnp.arange(SEQ, dtype=jnp.int32), (BATCH, SEQ)),
        'rel_bias': nrm(ks[2], (N_BUCKETS, ATTN_HEADS), 0.5),
        'final_norm': 1.0 + nrm(ks[3], (D_MODEL,), 0.02),
        'ada_w': nrm(ks[4], (L, D_MODEL, 6 * D_MODEL), 0.5 * D_MODEL ** -0.5),
        'ada_b': nrm(ks[5], (L, 6 * D_MODEL), 0.02),
        'norm_mix': 1.0 + nrm(ks[6], (L, D_MODEL), 0.02),
        'w_in': nrm(ks[7], (L, D_MODEL, IN_COLS), D_MODEL ** -0.5),
        'rwkv_mu': jax.random.uniform(ks[8], (L, RWKV_COLS), jnp.float32),
        'rwkv_w0': jax.random.uniform(ks[9], (L, MIX_W), jnp.float32, -4.0, 0.0),
        'rwkv_w_up': nrm(ks[10], (L, LORA_DECAY, MIX_W), 0.1),
        'rwkv_a0': nrm(ks[11], (L, MIX_W), 0.1),
        'rwkv_a_up': nrm(ks[12], (L, LORA_ICLR, MIX_W), LORA_ICLR ** -0.5),
        'rwkv_g_up': nrm(ks[13], (L, LORA_GATE, MIX_W), LORA_GATE ** -0.5),
        'rwkv_k_k': 0.85 + nrm(ks[14], (L, MIX_W), 0.1),
        'rwkv_k_a': 1.0 + nrm(ks[15], (L, MIX_W), 0.1),
        'rwkv_r_k': nrm(ks[16], (L, MIX_W), 0.1),
        'rwkv_ln_w': 1.0 + nrm(ks[17], (L, MIX_W), 0.02),
        'rwkv_ln_b': nrm(ks[18], (L, MIX_W), 0.02),
        'sc_conv_w': nrm(ks[19], (L, CONV_CH, CONV_W), CONV_W ** -0.5),
        'w_branch': nrm(ks[20], (L, N_BRANCH, MIX_W, D_MODEL), MIX_W ** -0.5),
        'w_o': nrm(ks[21], (L, D_MODEL, D_MODEL), D_MODEL ** -0.5),
        'norm_ffn': 1.0 + nrm(ks[22], (L, D_MODEL), 0.02),
        'ffn_w_up': nrm(ks[23], (L, D_MODEL, 2 * D_FF), D_MODEL ** -0.5),
        'ffn_conv_w': nrm(ks[24], (L, D_FF, CONV_W), CONV_W ** -0.5),
        'ffn_w_down': nrm(ks[25], (L, D_FF, D_MODEL), D_FF ** -0.5),
    }


def reference(x, c, positions, rel_bias, final_norm, ada_w, ada_b, norm_mix, w_in,
              rwkv_mu, rwkv_w0, rwkv_w_up, rwkv_a0, rwkv_a_up, rwkv_g_up, rwkv_k_k, rwkv_k_a,
              rwkv_r_k, rwkv_ln_w, rwkv_ln_b, sc_conv_w, w_branch, w_o, norm_ffn,
              ffn_w_up, ffn_conv_w, ffn_w_down):
    b, s, _ = x.shape
    for l in range(DEPTH):
        mod = (c @ ada_w[l] + ada_b[l])[:, None, :]
        sh1, sc1, g1, sh2, sc2, g2 = jnp.split(mod, 6, axis=-1)

        h = rmsnorm(x, norm_mix[l]) * (1 + sc1) + sh1
        z = h @ w_in[l]
        z_attn, z_rwkv, z_conv, z_gate = split_cols(z, (ATTN_COLS, RWKV_COLS, CONV_COLS, GATE_COLS))
        o_attn = dsa_attention(z_attn, positions, rel_bias)
        o_rwkv = rwkv7_mix(z_rwkv, rwkv_mu[l], rwkv_w0[l], rwkv_w_up[l], rwkv_a0[l], rwkv_a_up[l],
                           rwkv_g_up[l], rwkv_k_k[l], rwkv_k_a[l], rwkv_r_k[l], rwkv_ln_w[l], rwkv_ln_b[l])
        c_b, c_c, c_x = split_cols(z_conv, (CONV_CH, CONV_CH, CONV_CH))
        o_conv = c_b * causal_dwconv(c_c * c_x, sc_conv_w[l])
        gates = jax.nn.sigmoid(z_gate).reshape(b, s, N_BRANCH, D_MODEL)
        merged = sum(gates[:, :, i] * (o @ w_branch[l, i]) for i, o in enumerate((o_attn, o_rwkv, o_conv)))
        x = x + g1 * (merged @ w_o[l])

        h = rmsnorm(x, norm_ffn[l]) * (1 + sc2) + sh2
        x = x + g2 * conv_glu_ffn(h, ffn_w_up[l], ffn_conv_w[l], ffn_w_down[l])
    return rmsnorm(x, final_norm)
```

```cpp
#include <hip/hip_runtime.h>
#include <stdint.h>

#ifndef MK_SINGLE
#define MK_SINGLE 1
#endif

#define LAS __attribute__((address_space(3)))
#define CAS __attribute__((address_space(4)))
typedef unsigned short bf16_t;
typedef short bf16x8 __attribute__((ext_vector_type(8)));
typedef short bf16x4 __attribute__((ext_vector_type(4)));
typedef float f32x4 __attribute__((ext_vector_type(4)));
typedef float f32x16 __attribute__((ext_vector_type(16)));
typedef float f32x2 __attribute__((ext_vector_type(2)));
typedef unsigned u32x4 __attribute__((ext_vector_type(4)));
typedef unsigned u32x2 __attribute__((ext_vector_type(2)));
typedef int i32x4 __attribute__((ext_vector_type(4)));
typedef unsigned long long u64;

constexpr int T_ = 32768, D_ = 1024, NB_ = 8, S_ = 4096;
constexpr int NSEG = 32, SEGL = 128, TB = 8;
constexpr int NBLK = 256, NTHR = 512;
constexpr int IN_COLS = 8520, DFF = 2816;
constexpr int LDS_BYTES = 150 * 1024;

constexpr size_t MiB = 1ull << 20;
constexpr size_t OFF_BAR = 0;
constexpr size_t OFF_MOD = 64 * 1024;
constexpr size_t OFF_TAB = 512 * 1024;
constexpr size_t OFF_WB = 2 * MiB;
constexpr size_t WB_WIN = 0;
constexpr size_t WB_WBR = WB_WIN + (size_t)8704 * 1024 * 2;
constexpr size_t WB_WO = WB_WBR + (size_t)3 * 1024 * 512 * 2;
constexpr size_t WB_WUP = WB_WO + (size_t)1024 * 1024 * 2;
constexpr size_t WB_WDN = WB_WUP + (size_t)5632 * 1024 * 2;
constexpr size_t WB_LW = WB_WDN + (size_t)1024 * 2816 * 2;
constexpr size_t WB_LA = WB_LW + (size_t)512 * 64 * 2;
constexpr size_t WB_LG = WB_LA + (size_t)512 * 64 * 2;
constexpr size_t OFF_H = 42 * MiB;
constexpr size_t OFF_ZQ = 106 * MiB;
constexpr size_t OFF_MASK = 250 * MiB;
constexpr size_t OFF_VT = 266 * MiB;
constexpr size_t OFF_ZR = 106 * MiB;
constexpr size_t OFF_Y = 218 * MiB;
constexpr size_t OFF_P = 250 * MiB;
constexpr size_t OFF_G = 314 * MiB;
constexpr size_t OFF_SEG = 346 * MiB;
constexpr size_t OFF_ZCV = 106 * MiB;
constexpr size_t OFF_ZG = 202 * MiB;
constexpr size_t OFF_MRG = 106 * MiB;
constexpr size_t OFF_UP = 106 * MiB;
constexpr size_t OFF_OCONV = 416 * MiB;
constexpr size_t OFF_ORWKV = 448 * MiB;
constexpr size_t OFF_OATT = 480 * MiB;
constexpr size_t OFF_VB = OFF_OCONV;
constexpr size_t OFF_SCR = OFF_ORWKV;

struct Params {
    const float* x_in; const float* c; const int* pos; const float* rel_bias; const float* final_norm;
    const float* ada_w; const float* ada_b; const float* norm_mix; const float* w_in;
    const float* mu; const float* w0; const float* w_up; const float* a0; const float* a_up; const float* g_up;
    const float* k_k; const float* k_a; const float* r_k; const float* ln_w; const float* ln_b;
    const float* sc_conv_w; const float* w_branch; const float* w_o; const float* norm_ffn;
    const float* ffn_w_up; const float* ffn_conv_w; const float* ffn_w_down;
    float* out; unsigned char* ws;
};

__device__ __forceinline__ float bf2f(bf16_t b) { return __uint_as_float(((unsigned)b) << 16); }
__device__ __forceinline__ bf16_t f2bf(float f) { unsigned u = __float_as_uint(f); u += 0x7FFFu + ((u >> 16) & 1u); return (bf16_t)(u >> 16); }
__device__ __forceinline__ unsigned cvt_pk_bf16(float lo, float hi) { unsigned r; asm volatile("v_cvt_pk_bf16_f32 %0, %1, %2" : "=v"(r) : "v"(lo), "v"(hi)); return r; }
__device__ __forceinline__ float bflo(unsigned w) { return __uint_as_float(w << 16); }
__device__ __forceinline__ float bfhi(unsigned w) { return __uint_as_float(w & 0xffff0000u); }
__device__ __forceinline__ float wave_sum(float v) {
#pragma unroll
    for (int o = 32; o >= 1; o >>= 1) v += __shfl_xor(v, o);
    return v;
}
__device__ __forceinline__ float sigmoidf_(float x) { return 1.0f / (1.0f + __expf(-x)); }
__device__ __forceinline__ unsigned f2ord(float x) { unsigned u = __float_as_uint(x); return (u & 0x80000000u) ? ~u : (u | 0x80000000u); }

__device__ __forceinline__ int opaque_tid() { int t = threadIdx.x; asm volatile("" : "+v"(t)); return t; }
__device__ __forceinline__ unsigned char* opaque_ptr(unsigned char* p) { asm volatile("" : "+s"(p)); return p; }
template <int O0, int O1, int O2, int O3>
__device__ __forceinline__ void sload4(const float* p, f32x16& a, f32x16& b, f32x16& c, f32x16& d) {
    asm volatile("s_load_dwordx16 %0, %4, %5 glc\n\ts_load_dwordx16 %1, %4, %6 glc\n\ts_load_dwordx16 %2, %4, %7 glc\n\ts_load_dwordx16 %3, %4, %8 glc\n\ts_waitcnt lgkmcnt(0)"
                 : "=&s"(a), "=&s"(b), "=&s"(c), "=&s"(d) : "s"(p), "i"(O0), "i"(O1), "i"(O2), "i"(O3) : "memory");
}
#define PAIR(v, i) ((f32x2){(v)[2 * (i)], (v)[2 * (i) + 1]})

#define XB_TMO      128
#define XB_XCNT(j)  (256  + 64 * (j))
#define XB_XSUB(j)  (1280 + 64 * (j))
#define XB_XGEN(j)  (2304 + 64 * (j))
#define XB_TOP      3328
#define XB_TOPGEN   3392
#define XCD_BAR_WORDS 3456
#define XB_SPIN_CAP (1u << 22)

__device__ __forceinline__ unsigned xb_ld(unsigned* p)              { return __hip_atomic_load(p, __ATOMIC_RELAXED, __HIP_MEMORY_SCOPE_AGENT); }
__device__ __forceinline__ unsigned xb_add(unsigned* p, unsigned v) { return __hip_atomic_fetch_add(p, v, __ATOMIC_RELAXED, __HIP_MEMORY_SCOPE_AGENT); }
__device__ __forceinline__ unsigned xb_xcc_id() { return (unsigned)__builtin_amdgcn_s_getreg((3 << 11) | 20) & 0xFu; }
#define XB_SPIN(cond, bar) do { unsigned _sp = 0; while (cond) { __builtin_amdgcn_s_sleep(1); \
    if ((++_sp & 255u) == 0u) { if (xb_ld(&(bar)[XB_TMO])) break; if (_sp > XB_SPIN_CAP) { atomicAdd(&(bar)[XB_TMO], 1u); break; } } } } while (0)

struct XcdBarrier { unsigned* bar; unsigned x; volatile LAS unsigned* st; };

__device__ __forceinline__ XcdBarrier xcd_barrier_post(unsigned* bar, volatile LAS unsigned* st) {
    XcdBarrier b; b.bar = bar; b.x = xb_xcc_id(); b.st = st;
    if (threadIdx.x == 0) (void)xb_add(&bar[XB_XCNT(b.x)], 1u);
    return b;
}
__device__ __forceinline__ void xcd_barrier_complete(unsigned* bar, unsigned x, unsigned& nloc, unsigned& nx) {
    const unsigned G = gridDim.x * gridDim.y * gridDim.z;
    unsigned sum, cnt, mine, sp = 0u;
    for (;;) {
        sum = 0u; cnt = 0u; mine = 0u;
#pragma unroll
        for (unsigned j = 0; j < 16; ++j) { const unsigned c = xb_ld(&bar[XB_XCNT(j)]); sum += c; cnt += (c > 0u) ? 1u : 0u; mine = (j == x) ? c : mine; }
        if (sum == G) break;
        __builtin_amdgcn_s_sleep(1);
        if ((++sp & 255u) == 0u) { if (xb_ld(&bar[XB_TMO])) break; if (sp > XB_SPIN_CAP) { atomicAdd(&bar[XB_TMO], 1u); break; } }
    }
    nloc = mine > 0u ? mine : 1u; nx = cnt > 0u ? cnt : 1u;
}
__device__ __forceinline__ void xcd_barrier(const XcdBarrier& b) {
    asm volatile("s_waitcnt vmcnt(0)" ::: "memory");
    __syncthreads();
    if (threadIdx.x == 0) {
        unsigned* bar = b.bar;
        __builtin_amdgcn_s_waitcnt(0);
        unsigned nloc = b.st[0], nx = b.st[1];
        if (nloc == 0u) { xcd_barrier_complete(bar, b.x, nloc, nx); b.st[0] = nloc; b.st[1] = nx; }
        const unsigned old = xb_add(&bar[XB_XSUB(b.x)], 1u);
        const unsigned gen = old / nloc;
        if (old + 1u == (gen + 1u) * nloc) {
            __builtin_amdgcn_fence(__ATOMIC_RELEASE, "agent");
            asm volatile("s_waitcnt vmcnt(0)" ::: "memory");
            const unsigned og = xb_add(&bar[XB_TOP], 1u);
            const unsigned tg = og / nx;
            if (og + 1u == (tg + 1u) * nx) xb_add(&bar[XB_TOPGEN], 1u);
            else XB_SPIN(xb_ld(&bar[XB_TOPGEN]) == tg, bar);
            __builtin_amdgcn_fence(__ATOMIC_ACQUIRE, "agent");
            xb_add(&bar[XB_XGEN(b.x)], 1u);
            asm volatile("s_waitcnt vmcnt(0)" ::: "memory");
        } else {
            XB_SPIN(xb_ld(&bar[XB_XGEN(b.x)]) == gen, bar);
            __builtin_amdgcn_fence(__ATOMIC_ACQUIRE, "agent");
            asm volatile("s_waitcnt vmcnt(0)" ::: "memory");
        }
    }
    __syncthreads();
}

namespace g8 {
constexpr int BM = 256, BK = 64, HALF = 128, HTB = HALF * BK * 2, STAGE_BYTES = 8 * HTB, NXCD = 8, WGM = 8;
__device__ __forceinline__ int lds_byte(int r, int c) { const int st = (r >> 4) * 2 + (c >> 5), rr = r & 15, cc = c & 31, ob = rr * 64 + cc * 2; return st * 1024 + (ob ^ (((ob >> 9) & 1) << 5)); }
__device__ __forceinline__ void stage_rc(int b, int& R, int& C) { const int st = b / 1024, sb = b % 1024, swz = sb ^ (((sb >> 9) & 1) << 5); R = (st >> 1) * 16 + swz / 64; C = (st & 1) * 32 + (swz % 64) / 2; }
__device__ __forceinline__ int perm32(int rho) { const int n = rho >> 4, i = rho & 15; return 8 * (i >> 2) + 4 * n + (i & 3); }

struct Unit { const char* A; const char* B; int pm, pn, tag; };

struct SOrder {
    int nM, nN, nwg, G, c; const char* A; const char* Bt; size_t a_t, b_t;
    __device__ void init(int M, int N, int lda, int ldb, const void* A_, const void* Bt_) {
        nM = M / BM; nN = N / BM; nwg = nM * nN; G = (int)gridDim.x; c = (int)blockIdx.x; A = (const char*)A_; Bt = (const char*)Bt_;
        a_t = (size_t)BM * lda * 2; b_t = (size_t)BM * ldb * 2; }
    __device__ bool next(int i, Unit& u) const {
        const long L = (long)i * G + c; if (L >= nwg) return false;
        int wgid = (int)L; { const int q = nwg / NXCD, r = nwg % NXCD, xcd = wgid % NXCD, off = wgid / NXCD; wgid = (xcd < r ? xcd * (q + 1) : r * (q + 1) + (xcd - r) * q) + off; }
        const int nig = WGM * nN, gid = wgid / nig, fm = gid * WGM, gsz = (nM - fm) < WGM ? (nM - fm) : WGM;
        u.pm = fm + ((wgid % nig) % gsz); u.pn = (wgid % nig) / gsz; u.tag = 0;
        u.A = A + (size_t)u.pm * a_t; u.B = Bt + (size_t)u.pn * b_t; return true;
    }
};

template <class Epi, class Sched>
__device__ __forceinline__ void gemm_phase(LAS unsigned char* lds, const int K, const int lda, const int ldb, const Sched& S, const Epi& E) {
    const int tid = opaque_tid(), wid = __builtin_amdgcn_readfirstlane(tid >> 6), lane = tid & 63, wr = wid >> 2, wc = wid & 3, fr = lane & 15, fq = lane >> 4;
    const int nt = K / BK;
    unsigned voffA[2], voffB[2];
#pragma unroll
    for (int i = 0; i < 2; ++i) { int R, C; stage_rc(tid * 16 + i * 8192, R, C); const int Rb = Epi::PERM ? ((R & ~31) + perm32(R & 31)) : R;
        voffA[i] = (unsigned)(R * lda + C) * 2u; voffB[i] = (unsigned)(Rb * ldb + C) * 2u; }
    const size_t kstep = (size_t)(BK * 2);
    const size_t hstepA = (size_t)HALF * lda * 2, hstepB = (size_t)HALF * ldb * 2;
    const unsigned ldsw = (unsigned)wid * 1024u;
    const int aoff = lds_byte(wr * 64 + fr, fq * 8), boff = lds_byte(wc * 32 + fr, fq * 8);
#define PG8_SA(b, h) (((b) * 2 + (h)) * HTB)
#define PG8_SB(b, h) ((4 + (b) * 2 + (h)) * HTB)
#define PG8_STAGE(bufoff, gbase, voff) do { _Pragma("unroll") for (int _i = 0; _i < 2; ++_i) \
        __builtin_amdgcn_global_load_lds((const unsigned*)((const char*)(gbase) + (voff)[_i]), (LAS unsigned*)(lds + (bufoff) + ldsw + _i * 8192), 16, 0, 0); } while (0)
#define PG8_LDA(dst, b, h) do { _Pragma("unroll") for (int m = 0; m < 4; ++m) _Pragma("unroll") for (int k = 0; k < 2; ++k) dst[m][k] = *(const LAS bf16x8*)(lds + PG8_SA(b, h) + aoff + m * 2048 + k * 1024); } while (0)
#define PG8_LDB(dst, b, h) do { _Pragma("unroll") for (int n = 0; n < 2; ++n) _Pragma("unroll") for (int k = 0; k < 2; ++k) dst[n][k] = *(const LAS bf16x8*)(lds + PG8_SB(b, h) + boff + n * 2048 + k * 1024); } while (0)
#define PG8_MMA(ai, bj, At, Bt) do { __builtin_amdgcn_s_setprio(1); _Pragma("unroll") for (int m = 0; m < 4; ++m) _Pragma("unroll") for (int n = 0; n < 2; ++n) _Pragma("unroll") for (int k = 0; k < 2; ++k) \
        acc[ai][bj][m][n] = __builtin_amdgcn_mfma_f32_16x16x32_bf16(Bt[n][k], At[m][k], acc[ai][bj][m][n], 0, 0, 0); __builtin_amdgcn_s_setprio(0); } while (0)
#define PG8_WAIT_V(n) asm volatile("s_waitcnt vmcnt(" #n ")" ::: "memory")
#define PG8_WAIT_L(n) asm volatile("s_waitcnt lgkmcnt(" #n ")" ::: "memory")
#define PG8_BAR __builtin_amdgcn_s_barrier()
#define PG8_SCHED __builtin_amdgcn_sched_barrier(0)
    Unit cur, nxt; int ui = 0;
    if (!S.next(0, cur)) return;
    f32x4 acc[2][2][4][2];
#pragma unroll
    for (int a = 0; a < 2; ++a)
#pragma unroll
        for (int b = 0; b < 2; ++b)
#pragma unroll
            for (int m = 0; m < 4; ++m)
#pragma unroll
                for (int n = 0; n < 2; ++n) acc[a][b][m][n] = (f32x4){0.f, 0.f, 0.f, 0.f};
    bf16x8 At[4][2], B0[2][2], B1[2][2];
    const char* cA = cur.A; const char* cB = cur.B;
    PG8_STAGE(PG8_SB(0, 0), cB, voffB); PG8_STAGE(PG8_SA(0, 0), cA, voffA); PG8_STAGE(PG8_SB(0, 1), cB + hstepB, voffB); PG8_STAGE(PG8_SA(0, 1), cA + hstepA, voffA);
    if (wr == 1) PG8_BAR;
    PG8_WAIT_V(4); PG8_BAR;
    PG8_STAGE(PG8_SB(1, 0), cB + kstep, voffB); PG8_STAGE(PG8_SA(1, 0), cA + kstep, voffA); PG8_STAGE(PG8_SB(1, 1), cB + hstepB + kstep, voffB);
    PG8_WAIT_V(6); PG8_BAR;
    for (;;) {
        const bool has_next = S.next(ui + 1, nxt);
        const char* nA = has_next ? nxt.A : cA; const char* nB = has_next ? nxt.B : cB;
        for (int t = 0; t < nt; t += 2) {
            const bool last = (t == nt - 2);
            const char* a1 = cA + (size_t)(t + 1) * kstep;
            const char* a2 = last ? nA : cA + (size_t)(t + 2) * kstep; const char* b2 = last ? nB : cB + (size_t)(t + 2) * kstep;
            const char* a3 = a2 + kstep; const char* b3 = b2 + kstep;
            PG8_LDB(B0, 0, 0); PG8_SCHED; PG8_LDA(At, 0, 0); PG8_STAGE(PG8_SA(1, 1), a1 + hstepA, voffA);
            PG8_WAIT_L(8); PG8_BAR; PG8_WAIT_L(0); PG8_MMA(0, 0, At, B0); PG8_BAR; PG8_SCHED;
            PG8_LDB(B1, 0, 1); PG8_STAGE(PG8_SB(0, 0), b2, voffB);
            PG8_BAR; PG8_WAIT_L(0); PG8_MMA(0, 1, At, B1); PG8_BAR;
            PG8_LDA(At, 0, 1); PG8_STAGE(PG8_SA(0, 0), a2, voffA);
            PG8_BAR; PG8_WAIT_L(0); PG8_MMA(1, 0, At, B0); PG8_BAR; PG8_SCHED;
            PG8_STAGE(PG8_SB(0, 1), b2 + hstepB, voffB);
            PG8_WAIT_V(6); PG8_BAR; PG8_MMA(1, 1, At, B1); PG8_BAR;
            PG8_LDB(B0, 1, 0); PG8_SCHED; PG8_LDA(At, 1, 0); PG8_STAGE(PG8_SA(0, 1), a2 + hstepA, voffA);
            PG8_WAIT_L(8); PG8_BAR; PG8_WAIT_L(0); PG8_MMA(0, 0, At, B0); PG8_BAR; PG8_SCHED;
            PG8_LDB(B1, 1, 1); PG8_STAGE(PG8_SB(1, 0), b3, voffB);
            PG8_BAR; PG8_WAIT_L(0); PG8_MMA(0, 1, At, B1); PG8_BAR;
            PG8_LDA(At, 1, 1); PG8_STAGE(PG8_SA(1, 0), a3, voffA);
            PG8_BAR; PG8_WAIT_L(0); PG8_MMA(1, 0, At, B0); PG8_BAR; PG8_SCHED;
            PG8_STAGE(PG8_SB(1, 1), b3 + hstepB, voffB);
            PG8_WAIT_V(6); PG8_BAR; PG8_MMA(1, 1, At, B1); PG8_BAR;
        }
        E(acc, cur, wr, wc, fr, fq);
        if (!has_next) break;
#pragma unroll
        for (int a = 0; a < 2; ++a)
#pragma unroll
            for (int b = 0; b < 2; ++b)
#pragma unroll
                for (int m = 0; m < 4; ++m)
#pragma unroll
                    for (int n = 0; n < 2; ++n) acc[a][b][m][n] = (f32x4){0.f, 0.f, 0.f, 0.f};
        cur = nxt; cA = nA; cB = nB; ++ui;
    }
    PG8_WAIT_V(0);
    if (wr == 0) PG8_BAR;
    PG8_BAR;
#undef PG8_SA
#undef PG8_SB
#undef PG8_STAGE
#undef PG8_LDA
#undef PG8_LDB
#undef PG8_MMA
#undef PG8_WAIT_V
#undef PG8_WAIT_L
#undef PG8_BAR
#undef PG8_SCHED
}

struct EpiBf {
    static constexpr bool PERM = true;
    bf16_t* O0; int ld0; int split; bf16_t* O1; int ld1; int act1;
    __device__ __forceinline__ void operator()(const f32x4 (&acc)[2][2][4][2], const Unit& u, int wr, int wc, int fr, int fq) const {
        const bool second = u.pn >= split;
        bf16_t* base = second ? O1 : O0; const int ld = second ? ld1 : ld0; const int colt = (second ? (u.pn - split) : u.pn) * BM;
        const bool act = second && act1;
        const int row0 = u.pm * BM + wr * 64 + fr, col0 = colt + wc * 32 + 8 * fq;
#pragma unroll
        for (int ai = 0; ai < 2; ++ai)
#pragma unroll
            for (int m = 0; m < 4; ++m) { bf16_t* rowp = base + (size_t)(row0 + ai * HALF + m * 16) * ld + col0;
#pragma unroll
                for (int bj = 0; bj < 2; ++bj) { f32x4 v0 = acc[ai][bj][m][0], v1 = acc[ai][bj][m][1];
                    if (act) {
#pragma unroll
                        for (int j = 0; j < 4; ++j) { v0[j] = sigmoidf_(v0[j]); v1[j] = sigmoidf_(v1[j]); } }
                    u32x4 w; w.x = cvt_pk_bf16(v0[0], v0[1]); w.y = cvt_pk_bf16(v0[2], v0[3]); w.z = cvt_pk_bf16(v1[0], v1[1]); w.w = cvt_pk_bf16(v1[2], v1[3]);
                    *(u32x4*)(rowp + bj * HALF) = w; } }
    }
};
struct EpiMerge {
    static constexpr bool PERM = true;
    bf16_t* M; const bf16_t* ZG;
    __device__ __forceinline__ void operator()(const f32x4 (&acc)[2][2][4][2], const Unit& u, int wr, int wc, int fr, int fq) const {
        const int row0 = u.pm * BM + wr * 64 + fr, col0 = u.pn * BM + wc * 32 + 8 * fq;
#pragma unroll
        for (int ai = 0; ai < 2; ++ai)
#pragma unroll
            for (int m = 0; m < 4; ++m) { const size_t r = (size_t)(row0 + ai * HALF + m * 16);
#pragma unroll
                for (int bj = 0; bj < 2; ++bj) {
                    const u32x4 g = *(const u32x4*)(ZG + r * 3072 + u.tag * 1024 + col0 + bj * HALF);
                    bf16_t* mp = M + r * 1024 + col0 + bj * HALF;
                    const f32x4 v0 = acc[ai][bj][m][0], v1 = acc[ai][bj][m][1];
                    float o[8];
                    o[0] = v0[0] * bflo(g.x); o[1] = v0[1] * bfhi(g.x); o[2] = v0[2] * bflo(g.y); o[3] = v0[3] * bfhi(g.y);
                    o[4] = v1[0] * bflo(g.z); o[5] = v1[1] * bfhi(g.z); o[6] = v1[2] * bflo(g.w); o[7] = v1[3] * bfhi(g.w);
                    if (u.tag != 0) { const u32x4 p = *(const u32x4*)mp;
                        o[0] += bflo(p.x); o[1] += bfhi(p.x); o[2] += bflo(p.y); o[3] += bfhi(p.y); o[4] += bflo(p.z); o[5] += bfhi(p.z); o[6] += bflo(p.w); o[7] += bfhi(p.w); }
                    u32x4 w; w.x = cvt_pk_bf16(o[0], o[1]); w.y = cvt_pk_bf16(o[2], o[3]); w.z = cvt_pk_bf16(o[4], o[5]); w.w = cvt_pk_bf16(o[6], o[7]);
                    *(u32x4*)mp = w; } }
    }
};
struct EpiRes {
    static constexpr bool PERM = false;
    const float* xin; float* xout; const float* gate;
    __device__ __forceinline__ void operator()(const f32x4 (&acc)[2][2][4][2], const Unit& u, int wr, int wc, int fr, int fq) const {
        const int row0 = u.pm * BM + wr * 64 + fr, col0 = u.pn * BM + wc * 32 + 4 * fq;
        const float* gp = gate + (size_t)(u.pm >> 4) * 6144 + col0;
        f32x4 gv[2][2];
#pragma unroll
        for (int bj = 0; bj < 2; ++bj)
#pragma unroll
            for (int n = 0; n < 2; ++n) gv[bj][n] = *(const f32x4*)(gp + bj * HALF + n * 16);
#pragma unroll
        for (int ai = 0; ai < 2; ++ai)
#pragma unroll
            for (int m = 0; m < 4; ++m) { const size_t off = (size_t)(row0 + ai * HALF + m * 16) * 1024 + col0;
#pragma unroll
                for (int bj = 0; bj < 2; ++bj)
#pragma unroll
                    for (int n = 0; n < 2; ++n) { const f32x4 xi = *(const f32x4*)(xin + off + bj * HALF + n * 16);
                        *(f32x4*)(xout + off + bj * HALF + n * 16) = xi + gv[bj][n] * acc[ai][bj][m][n]; } }
    }
};
struct MergeOrder {
    int G, c; const char* o_att; const char* wbr;
    __device__ bool next(int i, Unit& u) const {
        const int tile = (i / 3) * G + c; if (tile >= (T_ / BM) * 4) return false;
        const int br = i % 3; u.pm = tile >> 2; u.pn = tile & 3; u.tag = br;
        u.A = o_att - (size_t)br * (32 * MiB) + (size_t)u.pm * BM * 512 * 2;
        u.B = wbr + (size_t)br * 1024 * 512 * 2 + (size_t)u.pn * BM * 512 * 2; return true;
    }
};
}

#define GSTRIDE_BLOCKS(var, n) for (int var = blockIdx.x; var < (n); var += gridDim.x)

__device__ __forceinline__ void ph_mod(const Params& P, LAS unsigned char* lds) {
    LAS float* red = (LAS float*)lds;
    float* mod = (float*)(P.ws + OFF_MOD); float* tab = (float*)(P.ws + OFF_TAB);
    const int tid = opaque_tid(), wid = tid >> 6, lane = tid & 63;
    GSTRIDE_BLOCKS(blk, 192) {
        const int l = blk / 96, jb = blk % 96, j = jb * 64 + lane;
        float acc[8];
#pragma unroll
        for (int b = 0; b < 8; ++b) acc[b] = 0.f;
        const float* aw = P.ada_w + (size_t)l * 1024 * 6144 + j;
        for (int k = wid * 128; k < wid * 128 + 128; ++k) {
            const float w = aw[(size_t)k * 6144];
#pragma unroll
            for (int b = 0; b < 8; ++b) acc[b] += P.c[b * 1024 + k] * w;
        }
#pragma unroll
        for (int b = 0; b < 8; ++b) red[(wid * 8 + b) * 64 + lane] = acc[b];
        __syncthreads();
        { const int b = wid; float s = P.ada_b[l * 6144 + j];
#pragma unroll
          for (int w = 0; w < 8; ++w) s += red[(w * 8 + b) * 64 + lane];
          mod[((size_t)l * 8 + b) * 6144 + j] = s; }
        __syncthreads();
    }
    if (blockIdx.x == gridDim.x - 1) {
        for (int i = tid; i < 1024; i += NTHR) { const int n = i >> 3, h = i & 7; int bk;
            if (n < 16) bk = n; else { const float nf = (float)n; bk = 16 + (int)(logf(nf / 16.0f) / 2.0794415416798357f * 16.0f); bk = bk < 31 ? bk : 31; }
            tab[i] = P.rel_bias[bk * 8 + h]; }
    }
}

struct WJob { const float* src; int ldsrc; int K; int N; bf16_t* dst; int win; };
__device__ __forceinline__ void conv_tiles(const WJob& J, LAS float* tile  ) {
    const int tid = opaque_tid(); const int nkt = J.K / 64, nnt = J.N / 64, ntiles = nkt * nnt;
    GSTRIDE_BLOCKS(ti, ntiles) {
        const int kt = ti % nkt, ntb = ti / nkt, k0 = kt * 64, n0 = ntb * 64;
        { const int n = tid & 63, kk0 = tid >> 6; const int nn = n0 + n; int col = nn;
          if (J.win) col = nn < 2120 ? nn : (nn < 2304 ? -1 : nn - 184);
#pragma unroll
          for (int p = 0; p < 8; ++p) { const int k = kk0 + 8 * p; tile[k * 65 + n] = col >= 0 ? J.src[(size_t)(k0 + k) * J.ldsrc + col] : 0.f; } }
        __syncthreads();
        { const int n = tid >> 3, kg = tid & 7; float v[8];
#pragma unroll
          for (int e = 0; e < 8; ++e) v[e] = tile[(kg * 8 + e) * 65 + n];
          u32x4 w; w.x = cvt_pk_bf16(v[0], v[1]); w.y = cvt_pk_bf16(v[2], v[3]); w.z = cvt_pk_bf16(v[4], v[5]); w.w = cvt_pk_bf16(v[6], v[7]);
          *(u32x4*)(J.dst + (size_t)(n0 + n) * J.K + k0 + kg * 8) = w; }
        __syncthreads();
    }
}
__device__ __forceinline__ void ph_wconv(const Params& P, int l, LAS unsigned char* lds) {
    LAS float* tile = (LAS float*)lds; unsigned char* wb = P.ws + OFF_WB;
    { WJob J{P.w_in + (size_t)l * 1024 * IN_COLS, IN_COLS, 1024, 8704, (bf16_t*)(wb + WB_WIN), 1}; conv_tiles(J, tile); }
    for (int i = 0; i < 3; ++i) { WJob J{P.w_branch + ((size_t)l * 3 + i) * 512 * 1024, 1024, 512, 1024, (bf16_t*)(wb + WB_WBR) + (size_t)i * 1024 * 512, 0}; conv_tiles(J, tile); }
    { WJob J{P.w_o + (size_t)l * 1024 * 1024, 1024, 1024, 1024, (bf16_t*)(wb + WB_WO), 0}; conv_tiles(J, tile); }
    { WJob J{P.ffn_w_up + (size_t)l * 1024 * 5632, 5632, 1024, 5632, (bf16_t*)(wb + WB_WUP), 0}; conv_tiles(J, tile); }
    { WJob J{P.ffn_w_down + (size_t)l * 2816 * 1024, 1024, 2816, 1024, (bf16_t*)(wb + WB_WDN), 0}; conv_tiles(J, tile); }
    { WJob J{P.w_up + (size_t)l * 64 * 512, 512, 64, 512, (bf16_t*)(wb + WB_LW), 0}; conv_tiles(J, tile); }
    { WJob J{P.a_up + (size_t)l * 64 * 512, 512, 64, 512, (bf16_t*)(wb + WB_LA), 0}; conv_tiles(J, tile); }
    { WJob J{P.g_up + (size_t)l * 128 * 512, 512, 128, 512, (bf16_t*)(wb + WB_LG), 0}; conv_tiles(J, tile); }
}

__device__ __forceinline__ void ph_norm(const Params& P, int l, int which) {
    const float* x = (l == 0 && which == 0) ? P.x_in : P.out;
    const float* nw = (which == 0 ? P.norm_mix : P.norm_ffn) + l * 1024;
    const float* mod = (const float*)(P.ws + OFF_MOD) + (size_t)l * 8 * 6144 + which * 3072;
    bf16_t* H = (bf16_t*)(P.ws + OFF_H);
    const int tid = opaque_tid(), wid = tid >> 6, lane = tid & 63;
    for (int row = blockIdx.x * 8 + wid; row < T_; row += gridDim.x * 8) {
        const int b = row >> 12; const float* xr = x + (size_t)row * 1024; const float* mb = mod + (size_t)b * 6144;
        f32x4 v[4]; float ss = 0.f;
#pragma unroll
        for (int i = 0; i < 4; ++i) { v[i] = *(const f32x4*)(xr + i * 256 + lane * 4); ss += v[i][0] * v[i][0] + v[i][1] * v[i][1] + v[i][2] * v[i][2] + v[i][3] * v[i][3]; }
        ss = wave_sum(ss);
        const float rstd = rsqrtf(ss * (1.0f / 1024.0f) + 1e-6f);
#pragma unroll
        for (int i = 0; i < 4; ++i) { const int c = i * 256 + lane * 4;
            const f32x4 g = *(const f32x4*)(nw + c), sh = *(const f32x4*)(mb + c), sc = *(const f32x4*)(mb + 1024 + c);
            const f32x4 y = v[i] * rstd * g * (sc + 1.0f) + sh;
            u32x2 w; w.x = cvt_pk_bf16(y[0], y[1]); w.y = cvt_pk_bf16(y[2], y[3]);
            *(u32x2*)(H + (size_t)row * 1024 + c) = w; }
    }
}

__device__ __forceinline__ void ph_final(const Params& P) {
    const int tid = opaque_tid(), wid = tid >> 6, lane = tid & 63;
    for (int row = blockIdx.x * 8 + wid; row < T_; row += gridDim.x * 8) {
        float* xr = P.out + (size_t)row * 1024;
        f32x4 v[4]; float ss = 0.f;
#pragma unroll
        for (int i = 0; i < 4; ++i) { v[i] = *(const f32x4*)(xr + i * 256 + lane * 4); ss += v[i][0] * v[i][0] + v[i][1] * v[i][1] + v[i][2] * v[i][2] + v[i][3] * v[i][3]; }
        ss = wave_sum(ss);
        const float rstd = rsqrtf(ss * (1.0f / 1024.0f) + 1e-6f);
#pragma unroll
        for (int i = 0; i < 4; ++i) { const int c = i * 256 + lane * 4; const f32x4 g = *(const f32x4*)(P.final_norm + c);
            *(f32x4*)(xr + c) = v[i] * rstd * g; }
    }
}

__device__ __forceinline__ void ph_gemm_zq(const Params& P, LAS unsigned char* lds) {
    g8::SOrder S; S.init(T_, 2304, 1024, 1024, P.ws + OFF_H, P.ws + OFF_WB + WB_WIN);
    g8::EpiBf E{(bf16_t*)(P.ws + OFF_ZQ), 2304, 9, nullptr, 0, 0};
    g8::gemm_phase(lds, 1024, 1024, 1024, S, E);
}
__device__ __forceinline__ void ph_gemm_zr(const Params& P, LAS unsigned char* lds) {
    g8::SOrder S; S.init(T_, 1792, 1024, 1024, P.ws + OFF_H, P.ws + OFF_WB + WB_WIN + (size_t)2304 * 1024 * 2);
    g8::EpiBf E{(bf16_t*)(P.ws + OFF_ZR), 1792, 7, nullptr, 0, 0};
    g8::gemm_phase(lds, 1024, 1024, 1024, S, E);
}
__device__ __forceinline__ void ph_gemm_zc(const Params& P, LAS unsigned char* lds) {
    g8::SOrder S; S.init(T_, 4608, 1024, 1024, P.ws + OFF_H, P.ws + OFF_WB + WB_WIN + (size_t)4096 * 1024 * 2);
    g8::EpiBf E{(bf16_t*)(P.ws + OFF_ZCV), 1536, 6, (bf16_t*)(P.ws + OFF_ZG), 3072, 1};
    g8::gemm_phase(lds, 1024, 1024, 1024, S, E);
}
__device__ __forceinline__ void ph_gemm_merge(const Params& P, LAS unsigned char* lds) {
    g8::MergeOrder S{(int)gridDim.x, (int)blockIdx.x, (const char*)(P.ws + OFF_OATT), (const char*)(P.ws + OFF_WB + WB_WBR)};
    g8::EpiMerge E{(bf16_t*)(P.ws + OFF_MRG), (const bf16_t*)(P.ws + OFF_ZG)};
    g8::gemm_phase(lds, 512, 512, 512, S, E);
}
__device__ __forceinline__ void ph_gemm_wo(const Params& P, int l, LAS unsigned char* lds) {
    g8::SOrder S; S.init(T_, 1024, 1024, 1024, P.ws + OFF_MRG, P.ws + OFF_WB + WB_WO);
    g8::EpiRes E{l == 0 ? P.x_in : P.out, P.out, (const float*)(P.ws + OFF_MOD) + (size_t)l * 8 * 6144 + 2048};
    g8::gemm_phase(lds, 1024, 1024, 1024, S, E);
}
__device__ __forceinline__ void ph_gemm_up(const Params& P, LAS unsigned char* lds) {
    g8::SOrder S; S.init(T_, 5632, 1024, 1024, P.ws + OFF_H, P.ws + OFF_WB + WB_WUP);
    g8::EpiBf E{(bf16_t*)(P.ws + OFF_UP), 5632, 22, nullptr, 0, 0};
    g8::gemm_phase(lds, 1024, 1024, 1024, S, E);
}
__device__ __forceinline__ void ph_gemm_down(const Params& P, int l, LAS unsigned char* lds) {
    g8::SOrder S; S.init(T_, 1024, 5632, 2816, P.ws + OFF_UP + (size_t)2816 * 2, P.ws + OFF_WB + WB_WDN);
    g8::EpiRes E{P.out, P.out, (const float*)(P.ws + OFF_MOD) + (size_t)l * 8 * 6144 + 5120};
    g8::gemm_phase(lds, 2816, 5632, 2816, S, E);
}

__device__ __forceinline__ void ph_conv(const Params& P, int l) {
    const bf16_t* Z = (const bf16_t*)(P.ws + OFF_ZCV); bf16_t* O = (bf16_t*)(P.ws + OFF_OCONV);
    const float* cw = P.sc_conv_w + (size_t)l * 512 * 3;
    const int nitem = T_ * 64;
    for (int it = blockIdx.x * NTHR + opaque_tid(); it < nitem; it += gridDim.x * NTHR) {
        const int row = it >> 6, c0 = (it & 63) * 8, t = row & 4095;
        float accv[8];
#pragma unroll
        for (int e = 0; e < 8; ++e) accv[e] = 0.f;
#pragma unroll
        for (int j = 0; j < 3; ++j) { const int tt = t - 2 + j; if (tt < 0) continue;
            const bf16_t* zr = Z + (size_t)(row - 2 + j) * 1536;
            const u32x4 cc = *(const u32x4*)(zr + 512 + c0), cx = *(const u32x4*)(zr + 1024 + c0);
            const unsigned ccw[4] = {cc.x, cc.y, cc.z, cc.w}, cxw[4] = {cx.x, cx.y, cx.z, cx.w};
#pragma unroll
            for (int q = 0; q < 4; ++q) { accv[2 * q] += cw[(c0 + 2 * q) * 3 + j] * (bflo(ccw[q]) * bflo(cxw[q])); accv[2 * q + 1] += cw[(c0 + 2 * q + 1) * 3 + j] * (bfhi(ccw[q]) * bfhi(cxw[q])); } }
        const u32x4 cb = *(const u32x4*)(Z + (size_t)row * 1536 + c0); const unsigned cbw[4] = {cb.x, cb.y, cb.z, cb.w};
        u32x4 w; unsigned ww[4];
#pragma unroll
        for (int q = 0; q < 4; ++q) ww[q] = cvt_pk_bf16(accv[2 * q] * bflo(cbw[q]), accv[2 * q + 1] * bfhi(cbw[q]));
        w.x = ww[0]; w.y = ww[1]; w.z = ww[2]; w.w = ww[3];
        *(u32x4*)(O + (size_t)row * 512 + c0) = w;
    }
}

__device__ __forceinline__ void ph_u(const Params& P, int l) {
    bf16_t* U = (bf16_t*)(P.ws + OFF_UP); const float* cw = P.ffn_conv_w + (size_t)l * DFF * 3;
    const int nitem = T_ * 352;
    for (int it = blockIdx.x * NTHR + opaque_tid(); it < nitem; it += gridDim.x * NTHR) {
        const int row = it / 352, c0 = (it % 352) * 8, t = row & 4095;
        float accv[8];
#pragma unroll
        for (int e = 0; e < 8; ++e) accv[e] = 0.f;
#pragma unroll
        for (int j = 0; j < 3; ++j) { const int tt = t - 2 + j; if (tt < 0) continue;
            const u32x4 a = *(const u32x4*)(U + (size_t)(row - 2 + j) * 5632 + c0); const unsigned aw[4] = {a.x, a.y, a.z, a.w};
#pragma unroll
            for (int q = 0; q < 4; ++q) { accv[2 * q] += cw[(c0 + 2 * q) * 3 + j] * bflo(aw[q]); accv[2 * q + 1] += cw[(c0 + 2 * q + 1) * 3 + j] * bfhi(aw[q]); } }
        const u32x4 g = *(const u32x4*)(U + (size_t)row * 5632 + 2816 + c0); const unsigned gw[4] = {g.x, g.y, g.z, g.w};
        unsigned ww[4];
#pragma unroll
        for (int q = 0; q < 4; ++q) { const float s0 = accv[2 * q] * sigmoidf_(accv[2 * q]), s1 = accv[2 * q + 1] * sigmoidf_(accv[2 * q + 1]);
            ww[q] = cvt_pk_bf16(s0 * bflo(gw[q]), s1 * bfhi(gw[q])); }
        u32x4 w; w.x = ww[0]; w.y = ww[1]; w.z = ww[2]; w.w = ww[3];
        *(u32x4*)(U + (size_t)row * 5632 + 2816 + c0) = w;
    }
}

__device__ __forceinline__ void ph_idx(const Params& P, LAS unsigned char* lds) {
    LAS float* SC = (LAS float*)lds;
    const bf16_t* ZQ = (const bf16_t*)(P.ws + OFF_ZQ); u64* MASK = (u64*)(P.ws + OFF_MASK);
    const int tid = opaque_tid(), wid = __builtin_amdgcn_readfirstlane(tid >> 6), lane = tid & 63, m = lane & 31, hh = lane >> 5;
    int itc = 0;
    for (int idx = blockIdx.x; idx < NB_ * 512; idx += gridDim.x, ++itc) {
        const int b = idx & 7, j = idx >> 3; const int qb = (itc & 1) ? (j ^ 31) : j; const int t0 = qb * 8;
        const bf16_t* zb = ZQ + (size_t)b * S_ * 2304;
        bf16x8 Af[2][4]; float wv[2][16];
#pragma unroll
        for (int blk = 0; blk < 2; ++blk) {
            const bf16_t* qp = zb + (size_t)(t0 + 4 * blk + (m >> 3)) * 2304 + 1536 + (m & 7) * 64 + 8 * hh;
#pragma unroll
            for (int ks = 0; ks < 4; ++ks) Af[blk][ks] = *(const bf16x8*)(qp + 16 * ks);
#pragma unroll
            for (int r = 0; r < 16; ++r) wv[blk][r] = bf2f(zb[(size_t)(t0 + 4 * blk + (r >> 2)) * 2304 + 2112 + (r & 3) + 4 * hh]);
        }
        const int ntile = (t0 + 7) / 32 + 1;
        for (int kt = wid; kt < ntile; kt += 8) {
            const bf16_t* kp = zb + (size_t)(32 * kt + m) * 2304 + 2048 + 8 * hh;
            bf16x8 Bf[4];
#pragma unroll
            for (int ks = 0; ks < 4; ++ks) Bf[ks] = *(const bf16x8*)(kp + 16 * ks);
#pragma unroll
            for (int blk = 0; blk < 2; ++blk) {
                f32x16 Dv;
#pragma unroll
                for (int r = 0; r < 16; ++r) Dv[r] = 0.f;
#pragma unroll
                for (int ks = 0; ks < 4; ++ks) Dv = __builtin_amdgcn_mfma_f32_32x32x16_bf16(Af[blk][ks], Bf[ks], Dv, 0, 0, 0);
#pragma unroll
                for (int q = 0; q < 4; ++q) {
                    float part = 0.f;
#pragma unroll
                    for (int e = 0; e < 4; ++e) part += wv[blk][4 * q + e] * fmaxf(Dv[4 * q + e], 0.f);
                    part += __shfl_xor(part, 32);
                    if (hh == 0) SC[(4 * blk + q) * 4096 + 32 * kt + m] = part;
                }
            }
        }
        __syncthreads();
        {
            const int t = t0 + wid; u64* mrow = MASK + (size_t)(b * S_ + t) * 64;
            if (t < 256) {
                const int lo = 64 * lane; u64 w;
                if (t >= lo + 63) w = ~0ull; else if (t < lo) w = 0ull; else w = (2ull << (t - lo)) - 1ull;
                mrow[lane] = w;
            } else {
                unsigned u[64];
#pragma unroll
                for (int i = 0; i < 64; ++i) { const int key = 64 * i + lane; const float x = SC[wid * 4096 + key]; u[i] = (key <= t) ? f2ord(x) : 0u; }
                unsigned Tt = 0u;
#pragma unroll 1
                for (int bit = 31; bit >= 0; --bit) {
                    const unsigned cand = Tt | (1u << bit); int cnt = 0;
#pragma unroll
                    for (int i = 0; i < 64; ++i) cnt += __popcll(__ballot(u[i] >= cand));
                    if (cnt >= 256) Tt = cand;
                }
                int cgt = 0;
#pragma unroll
                for (int i = 0; i < 64; ++i) cgt += __popcll(__ballot(u[i] > Tt));
                int need = 256 - cgt; u64 myw = 0ull;
#pragma unroll
                for (int i = 0; i < 64; ++i) {
                    const u64 g = __ballot(u[i] > Tt); u64 e = __ballot(u[i] == Tt);
                    int ne = __popcll(e);
                    while (ne > need) { e &= ~(1ull << (63 - __clzll(e))); --ne; }
                    need -= ne;
                    if (lane == i) myw = g | e;
                }
                mrow[lane] = myw;
            }
        }
        __syncthreads();
    }
    {
        LAS bf16_t* tl = (LAS bf16_t*)lds;
        bf16_t* VT = (bf16_t*)(P.ws + OFF_VT);
        for (int it = blockIdx.x; it < NB_ * 8 * 64; it += gridDim.x) {
            const int b = it >> 9, h = (it >> 6) & 7, k0 = (it & 63) * 64;
            { const int row = tid >> 3, ch = tid & 7;
              const u32x4 v = *(const u32x4*)(ZQ + (size_t)(b * S_ + k0 + row) * 2304 + 1024 + h * 64 + ch * 8);
              *(LAS u32x4*)(tl + row * 72 + ch * 8) = v; }
            __syncthreads();
            { const int d = tid >> 3, kc = tid & 7; unsigned short e[8];
#pragma unroll
              for (int q = 0; q < 8; ++q) e[q] = tl[(kc * 8 + q) * 72 + d];
              u32x4 w; w.x = e[0] | ((unsigned)e[1] << 16); w.y = e[2] | ((unsigned)e[3] << 16); w.z = e[4] | ((unsigned)e[5] << 16); w.w = e[6] | ((unsigned)e[7] << 16);
              *(u32x4*)(VT + ((size_t)((b * 8 + h) * 64 + d)) * S_ + k0 + kc * 8) = w; }
            __syncthreads();
        }
    }
}

__device__ __forceinline__ void ph_att(const Params& P, LAS unsigned char* lds) {
    LAS float* TAB = (LAS float*)lds;
    const float* tabg = (const float*)(P.ws + OFF_TAB);
    const int tid = opaque_tid(), wid = __builtin_amdgcn_readfirstlane(tid >> 6), lane = tid & 63, m = lane & 31, hh = lane >> 5;
    for (int i = tid; i < 1024; i += NTHR) TAB[i] = tabg[i];
    __syncthreads();
    const bf16_t* ZQ = (const bf16_t*)(P.ws + OFF_ZQ); const u64* MASK = (const u64*)(P.ws + OFF_MASK);
    const bf16_t* VT = (const bf16_t*)(P.ws + OFF_VT); bf16_t* OA = (bf16_t*)(P.ws + OFF_OATT);
    int itc = 0;
    for (int idx = blockIdx.x; idx < NB_ * 8 * 16; idx += gridDim.x, ++itc) {
        const int b = idx & 7, head = (idx >> 3) & 7, j = idx >> 6; const int qb = (itc & 1) ? (j ^ 3) : j;
        const int tq0 = qb * 256 + 32 * wid, t = tq0 + m;
        const bf16_t* zb = ZQ + (size_t)b * S_ * 2304;
        bf16x8 Qf[4];
        { const bf16_t* qp = zb + (size_t)t * 2304 + head * 64 + 8 * hh;
#pragma unroll
          for (int ks = 0; ks < 4; ++ks) Qf[ks] = *(const bf16x8*)(qp + 16 * ks); }
        const int posq = P.pos[b * S_ + t];
        const u64* mrow = MASK + (size_t)(b * S_ + t) * 64;
        const bf16_t* vtb = VT + (size_t)(b * 8 + head) * 64 * S_;
        f32x16 O0, O1;
#pragma unroll
        for (int r = 0; r < 16; ++r) { O0[r] = 0.f; O1[r] = 0.f; }
        float m_run = -1e30f, l_run = 0.f;
        const int ktmax = (tq0 + 31) >> 5;
        for (int kt = 0; kt <= ktmax; ++kt) {
            const int s0 = 32 * kt;
            const bf16_t* kp = zb + (size_t)(s0 + m) * 2304 + 512 + head * 64 + 8 * hh;
            f32x16 Dv;
#pragma unroll
            for (int r = 0; r < 16; ++r) Dv[r] = 0.f;
#pragma unroll
            for (int ks = 0; ks < 4; ++ks) { const bf16x8 Kf = *(const bf16x8*)(kp + 16 * ks); Dv = __builtin_amdgcn_mfma_f32_32x32x16_bf16(Kf, Qf[ks], Dv, 0, 0, 0); }
            const u64 mw = mrow[kt >> 1]; unsigned w32 = (kt & 1) ? (unsigned)(mw >> 32) : (unsigned)mw; w32 >>= (4 * hh);
            float lg[16]; float mx = -1e30f;
#pragma unroll
            for (int g = 0; g < 4; ++g) {
                const i32x4 pk = *(const i32x4*)(P.pos + b * S_ + s0 + 8 * g + 4 * hh);
#pragma unroll
                for (int e = 0; e < 4; ++e) { const int r = 4 * g + e;
                    int n = posq - pk[e]; n = n < 0 ? 0 : (n > 127 ? 127 : n);
                    const float x = Dv[r] * 0.125f + TAB[n * 8 + head];
                    const bool on = (w32 >> (e + 8 * g)) & 1u;
                    lg[r] = on ? x : -1e30f; mx = fmaxf(mx, lg[r]); }
            }
            mx = fmaxf(mx, __shfl_xor(mx, 32));
            const float m_new = fmaxf(m_run, mx); const float alpha = __expf(m_run - m_new); m_run = m_new;
            float ps = 0.f; float pv[16];
#pragma unroll
            for (int r = 0; r < 16; ++r) { const bool on = (w32 >> ((r & 3) + 8 * (r >> 2))) & 1u; pv[r] = on ? __expf(lg[r] - m_new) : 0.f; ps += pv[r]; }
            l_run = l_run * alpha + ps;
#pragma unroll
            for (int r = 0; r < 16; ++r) { O0[r] *= alpha; O1[r] *= alpha; }
#pragma unroll
            for (int s = 0; s < 2; ++s) {
                u32x4 pw; pw.x = cvt_pk_bf16(pv[8 * s + 0], pv[8 * s + 1]); pw.y = cvt_pk_bf16(pv[8 * s + 2], pv[8 * s + 3]); pw.z = cvt_pk_bf16(pv[8 * s + 4], pv[8 * s + 5]); pw.w = cvt_pk_bf16(pv[8 * s + 6], pv[8 * s + 7]);
                const bf16x8 Pf = __builtin_bit_cast(bf16x8, pw);
#pragma unroll
                for (int blk = 0; blk < 2; ++blk) {
                    const bf16_t* vp = vtb + (size_t)(32 * blk + m) * S_ + s0 + 16 * s + 4 * hh;
                    const u32x2 va = *(const u32x2*)vp, vb = *(const u32x2*)(vp + 8);
                    u32x4 vw; vw.x = va.x; vw.y = va.y; vw.z = vb.x; vw.w = vb.y;
                    const bf16x8 Vf = __builtin_bit_cast(bf16x8, vw);
                    if (blk == 0) O0 = __builtin_amdgcn_mfma_f32_32x32x16_bf16(Vf, Pf, O0, 0, 0, 0);
                    else O1 = __builtin_amdgcn_mfma_f32_32x32x16_bf16(Vf, Pf, O1, 0, 0, 0);
                }
            }
        }
        const float l = l_run + __shfl_xor(l_run, 32); const float inv = 1.0f / l;
        bf16_t* op = OA + (size_t)(b * S_ + t) * 512 + head * 64 + 4 * hh;
#pragma unroll
        for (int g = 0; g < 4; ++g) {
            u32x2 w0; w0.x = cvt_pk_bf16(O0[4 * g] * inv, O0[4 * g + 1] * inv); w0.y = cvt_pk_bf16(O0[4 * g + 2] * inv, O0[4 * g + 3] * inv);
            *(u32x2*)(op + 8 * g) = w0;
            u32x2 w1; w1.x = cvt_pk_bf16(O1[4 * g] * inv, O1[4 * g + 1] * inv); w1.y = cvt_pk_bf16(O1[4 * g + 2] * inv, O1[4 * g + 3] * inv);
            *(u32x2*)(op + 32 + 8 * g) = w1;
        }
    }
}

__device__ __forceinline__ void ph_scan(const Params& P, int l, LAS unsigned char* lds) {
    LAS bf16_t* LI = (LAS bf16_t*)lds;
    LAS float* RKV = (LAS float*)(lds + 4096);
    LAS float* PRM = (LAS float*)(lds + 4096 + 49152);
    LAS float* LO = (LAS float*)(lds + 4096 + 49152 + 10240);
    const bf16_t* ZR = (const bf16_t*)(P.ws + OFF_ZR);
    const float* mu = P.mu + (size_t)l * 1792;
    const bf16_t* LW = (const bf16_t*)(P.ws + OFF_WB + WB_LW); const bf16_t* LA = (const bf16_t*)(P.ws + OFF_WB + WB_LA); const bf16_t* LG = (const bf16_t*)(P.ws + OFF_WB + WB_LG);
    bf16_t* Yo = (bf16_t*)(P.ws + OFF_Y); float* Po = (float*)(P.ws + OFF_P); bf16_t* Go = (bf16_t*)(P.ws + OFF_G); bf16_t* VBo = (bf16_t*)(P.ws + OFF_VB);
    float* SEGp = (float*)(P.ws + OFF_SEG);
    const int tid = opaque_tid(), wid = __builtin_amdgcn_readfirstlane(tid >> 6), lane = tid & 63;
    for (int blk = blockIdx.x; blk < NB_ * NSEG; blk += gridDim.x) {
        const int b = blk / NSEG, seg = blk % NSEG, tbeg = seg * SEGL;
        f32x2 S2[32], Pm2[32];
#pragma unroll
        for (int j = 0; j < 32; ++j) { S2[j] = (f32x2){0.f, 0.f}; Pm2[j] = (f32x2){(2 * j == lane) ? 1.f : 0.f, (2 * j + 1 == lane) ? 1.f : 0.f}; }
        __syncthreads();
        for (int i = tid; i < 512; i += NTHR) { PRM[i] = P.w0[l * 512 + i]; PRM[512 + i] = P.a0[l * 512 + i]; PRM[1024 + i] = P.k_k[l * 512 + i]; PRM[1536 + i] = P.k_a[l * 512 + i]; PRM[2048 + i] = P.r_k[l * 512 + i]; }
        float* scr = (float*)(P.ws + OFF_SCR) + (size_t)(blk * 8 + wid) * (TB * 6 * 64);
        float* scrv = scr + TB * 5 * 64;
        for (int sb = 0; sb < SEGL / TB; ++sb) {
            const int ts = tbeg + sb * TB;
            int tz = threadIdx.x; asm volatile("" : "+v"(tz));
            const int lz = tz & 63;
            __syncthreads();
            {
                const int tok = tz >> 6, c4 = (tz & 63) * 4, t = ts + tok; const size_t row = (size_t)b * S_ + t;
                const u32x2 zc = *(const u32x2*)(ZR + row * 1792 + 1536 + c4);
                u32x2 zp; zp.x = 0u; zp.y = 0u; if (t > 0) zp = *(const u32x2*)(ZR + (row - 1) * 1792 + 1536 + c4);
                const f32x4 m4 = *(const f32x4*)(mu + 1536 + c4);
                float x[4]; const float cur[4] = {bflo(zc.x), bfhi(zc.x), bflo(zc.y), bfhi(zc.y)}, prv[4] = {bflo(zp.x), bfhi(zp.x), bflo(zp.y), bfhi(zp.y)};
#pragma unroll
                for (int e = 0; e < 4; ++e) { x[e] = cur[e] + (prv[e] - cur[e]) * m4[e];
                    if (c4 < 64) x[e] = 1.0f - 2.0f / (1.0f + __expf(2.0f * x[e])); else if (c4 >= 128) x[e] = sigmoidf_(x[e]); }
                u32x2 w; w.x = cvt_pk_bf16(x[0], x[1]); w.y = cvt_pk_bf16(x[2], x[3]);
                *(LAS u32x2*)(LI + tok * 256 + c4) = w;
            }
#pragma unroll 1
            for (int k3 = 0; k3 < 3; ++k3) {
                const int q = tz + NTHR * k3, tok = q / 192, c8 = (q % 192) * 8, t = ts + tok; const size_t row = (size_t)b * S_ + t;
                const u32x4 zc = *(const u32x4*)(ZR + row * 1792 + c8);
                u32x4 zp; zp.x = 0u; zp.y = 0u; zp.z = 0u; zp.w = 0u; if (t > 0) zp = *(const u32x4*)(ZR + (row - 1) * 1792 + c8);
                const f32x4 ma = *(const f32x4*)(mu + c8), mb = *(const f32x4*)(mu + c8 + 4);
                const unsigned cw[4] = {zc.x, zc.y, zc.z, zc.w}, pw[4] = {zp.x, zp.y, zp.z, zp.w};
                f32x4 oa, ob;
#pragma unroll
                for (int q2 = 0; q2 < 2; ++q2) { const float c0 = bflo(cw[q2]), c1 = bfhi(cw[q2]), p0 = bflo(pw[q2]), p1 = bfhi(pw[q2]);
                    oa[2 * q2] = c0 + (p0 - c0) * ma[2 * q2]; oa[2 * q2 + 1] = c1 + (p1 - c1) * ma[2 * q2 + 1]; }
#pragma unroll
                for (int q2 = 0; q2 < 2; ++q2) { const float c0 = bflo(cw[2 + q2]), c1 = bfhi(cw[2 + q2]), p0 = bflo(pw[2 + q2]), p1 = bfhi(pw[2 + q2]);
                    ob[2 * q2] = c0 + (p0 - c0) * mb[2 * q2]; ob[2 * q2 + 1] = c1 + (p1 - c1) * mb[2 * q2 + 1]; }
                *(LAS f32x4*)(RKV + tok * 1536 + c8) = oa; *(LAS f32x4*)(RKV + tok * 1536 + c8 + 4) = ob;
            }
            __syncthreads();
            const bf16x8 zero8 = {0, 0, 0, 0, 0, 0, 0, 0};
#pragma unroll 1
            for (int kn = 0; kn < 12; ++kn) {
                const int fr = lz & 15, kq = lz >> 4; const int kind = kn >> 2, nb = kn & 3, ch = 64 * wid + 16 * nb + fr;
                const bf16_t* Wt = kind == 0 ? LW : (kind == 1 ? LA : LG); const int Kk = kind == 2 ? 128 : 64, aoff = kind * 64;
                f32x4 acc = (f32x4){0.f, 0.f, 0.f, 0.f};
#pragma unroll 1
                for (int ks = 0; ks < Kk / 32; ++ks) {
                    const bf16x8 Afr = (fr < 8) ? *(const LAS bf16x8*)(LI + fr * 256 + aoff + 32 * ks + 8 * kq) : zero8;
                    const bf16x8 Bfr = *(const bf16x8*)(Wt + (size_t)ch * Kk + 32 * ks + 8 * kq);
                    acc = __builtin_amdgcn_mfma_f32_16x16x32_bf16(Afr, Bfr, acc, 0, 0, 0); }
                if (kq < 2) {
#pragma unroll
                    for (int r = 0; r < 4; ++r) LO[((wid * 3 + kind) * 8 + 4 * kq + r) * 64 + 16 * nb + fr] = acc[r]; }
            }
#pragma unroll 1
            for (int tk = 0; tk < TB; ++tk) {
                const int c = 64 * wid + lz; const size_t row = (size_t)b * S_ + ts + tk;
                const float rr = RKV[tk * 1536 + c], kv = RKV[tk * 1536 + 512 + c], vv = RKV[tk * 1536 + 1024 + c];
                const float wl = LO[((wid * 3 + 0) * 8 + tk) * 64 + lz], al = LO[((wid * 3 + 1) * 8 + tk) * 64 + lz], gl = LO[((wid * 3 + 2) * 8 + tk) * 64 + lz];
                const float x = -(PRM[c] + wl);
                const float sp = fmaxf(x, 0.f) + __logf(1.0f + __expf(-fabsf(x)));
                const float dc = __expf(-__expf(-sp - 0.5f));
                const float av = sigmoidf_(PRM[512 + c] + al);
                const float kkv = kv * PRM[1024 + c];
                const float km = kv * (1.0f + (av - 1.0f) * PRM[1536 + c]);
                const float ss = wave_sum(kkv * kkv), bon = wave_sum(rr * km * PRM[2048 + c]);
                const float kkn = kkv / fmaxf(sqrtf(ss), 1e-12f);
                scr[(tk * 5 + 0) * 64 + lz] = rr; scr[(tk * 5 + 1) * 64 + lz] = dc; scr[(tk * 5 + 2) * 64 + lz] = km;
                scr[(tk * 5 + 3) * 64 + lz] = -kkn; scr[(tk * 5 + 4) * 64 + lz] = kkn * av; scrv[tk * 64 + lz] = vv;
                Go[row * 512 + c] = f2bf(gl); VBo[row * 512 + c] = f2bf(bon * vv);
            }
            asm volatile("s_waitcnt vmcnt(0)" ::: "memory");
#pragma unroll 1
            for (int tk = 0; tk < TB; ++tk) {
                const float* sq = scr + tk * 320;
                const float vi = scrv[tk * 64 + lz];
                f32x2 sa0 = {0.f, 0.f}, sa1 = {0.f, 0.f}, sp0 = {0.f, 0.f}, sp1 = {0.f, 0.f};
                {   f32x16 k0, k1, k2, k3; sload4<768, 832, 896, 960>(sq, k0, k1, k2, k3);
#pragma unroll
                    for (int i = 0; i < 8; i += 2) {
                        sa0 += S2[i] * PAIR(k0, i); sa1 += S2[i + 1] * PAIR(k0, i + 1); sp0 += Pm2[i] * PAIR(k0, i); sp1 += Pm2[i + 1] * PAIR(k0, i + 1);
                        sa0 += S2[8 + i] * PAIR(k1, i); sa1 += S2[8 + i + 1] * PAIR(k1, i + 1); sp0 += Pm2[8 + i] * PAIR(k1, i); sp1 += Pm2[8 + i + 1] * PAIR(k1, i + 1);
                        sa0 += S2[16 + i] * PAIR(k2, i); sa1 += S2[16 + i + 1] * PAIR(k2, i + 1); sp0 += Pm2[16 + i] * PAIR(k2, i); sp1 += Pm2[16 + i + 1] * PAIR(k2, i + 1);
                        sa0 += S2[24 + i] * PAIR(k3, i); sa1 += S2[24 + i + 1] * PAIR(k3, i + 1); sp0 += Pm2[24 + i] * PAIR(k3, i); sp1 += Pm2[24 + i + 1] * PAIR(k3, i + 1); }
                }
                const float sa = (sa0.x + sa0.y) + (sa1.x + sa1.y), sp = (sp0.x + sp0.y) + (sp1.x + sp1.y);
                const f32x2 sav = {sa, sa}, spv = {sp, sp}, vv2 = {vi, vi};
                f32x2 y0 = {0.f, 0.f}, y1 = {0.f, 0.f}, p0 = {0.f, 0.f}, p1 = {0.f, 0.f};
#define SCAN_CHUNK(C) { f32x16 w_, kb_, kk_, rr_; sload4<256 + 64 * C, 1024 + 64 * C, 512 + 64 * C, 64 * C>(sq, w_, kb_, kk_, rr_); \
                    _Pragma("unroll") for (int i = 0; i < 8; i += 2) { const int j = 8 * C + i; \
                        S2[j] = S2[j] * PAIR(w_, i) + sav * PAIR(kb_, i) + vv2 * PAIR(kk_, i); Pm2[j] = Pm2[j] * PAIR(w_, i) + spv * PAIR(kb_, i); y0 += S2[j] * PAIR(rr_, i); p0 += Pm2[j] * PAIR(rr_, i); \
                        S2[j + 1] = S2[j + 1] * PAIR(w_, i + 1) + sav * PAIR(kb_, i + 1) + vv2 * PAIR(kk_, i + 1); Pm2[j + 1] = Pm2[j + 1] * PAIR(w_, i + 1) + spv * PAIR(kb_, i + 1); y1 += S2[j + 1] * PAIR(rr_, i + 1); p1 += Pm2[j + 1] * PAIR(rr_, i + 1); } }
                SCAN_CHUNK(0) SCAN_CHUNK(1) SCAN_CHUNK(2) SCAN_CHUNK(3)
#undef SCAN_CHUNK
                const size_t row = (size_t)b * S_ + ts + tk;
                Yo[row * 512 + 64 * wid + lz] = f2bf((y0.x + y0.y) + (y1.x + y1.y));
                Po[row * 512 + 64 * wid + lz] = (p0.x + p0.y) + (p1.x + p1.y);
            }
        }
        {
            float* sg = SEGp + ((size_t)((b * 8 + wid) * NSEG + seg)) * 8192 + lane * 64;
#pragma unroll
            for (int j = 0; j < 32; j += 2) { *(f32x4*)(sg + 2 * j) = (f32x4){Pm2[j].x, Pm2[j].y, Pm2[j + 1].x, Pm2[j + 1].y};
                *(f32x4*)(sg + 4096 + 2 * j) = (f32x4){S2[j].x, S2[j].y, S2[j + 1].x, S2[j + 1].y}; }
        }
    }
}

__device__ __forceinline__ void ph_comb(const Params& P, LAS unsigned char* lds) {
    LAS float* SI = (LAS float*)lds;
    float* SEGp = (float*)(P.ws + OFF_SEG);
    const int tid = opaque_tid(), wid = __builtin_amdgcn_readfirstlane(tid >> 6), lane = tid & 63, m = lane & 31, hh = lane >> 5;
    for (int chain = blockIdx.x; chain < 64; chain += gridDim.x) {
        float* base = SEGp + (size_t)chain * NSEG * 8192;
        __syncthreads();
        for (int i = tid; i < 4096; i += NTHR) SI[(i >> 6) * 65 + (i & 63)] = base[4096 + i];
        __syncthreads();
        for (int k = 1; k <= NSEG - 2; ++k) {
            const float* Pm = base + (size_t)k * 8192; float* Q = base + (size_t)k * 8192 + 4096;
            f32x16 Dv; const int ti = wid >> 1, tj = wid & 1;
            if (wid < 4) {
#pragma unroll
                for (int r = 0; r < 16; ++r) Dv[r] = 0.f;
#pragma unroll 8
                for (int kk = 0; kk < 32; ++kk) { const float a = SI[(32 * ti + m) * 65 + 2 * kk + hh], bq = Pm[(2 * kk + hh) * 64 + 32 * tj + m];
                    Dv = __builtin_amdgcn_mfma_f32_32x32x2f32(a, bq, Dv, 0, 0, 0); }
#pragma unroll
                for (int r = 0; r < 16; ++r) { const int row = 32 * ti + (r & 3) + 8 * (r >> 2) + 4 * hh; Dv[r] += Q[row * 64 + 32 * tj + m]; }
            }
            __syncthreads();
            if (wid < 4) {
#pragma unroll
                for (int r = 0; r < 16; ++r) { const int row = 32 * ti + (r & 3) + 8 * (r >> 2) + 4 * hh; SI[row * 65 + 32 * tj + m] = Dv[r]; Q[row * 64 + 32 * tj + m] = Dv[r]; }
            }
            __syncthreads();
        }
    }
}

__device__ __forceinline__ void ph_post(const Params& P, int l) {
    const bf16_t* Yo = (const bf16_t*)(P.ws + OFF_Y); const float* Po = (const float*)(P.ws + OFF_P); const bf16_t* Go = (const bf16_t*)(P.ws + OFF_G);
    const bf16_t* VBo = (const bf16_t*)(P.ws + OFF_VB); const float* SEGp = (const float*)(P.ws + OFF_SEG); bf16_t* OR = (bf16_t*)(P.ws + OFF_ORWKV);
    const int tid = opaque_tid(), wid = __builtin_amdgcn_readfirstlane(tid >> 6), lane = tid & 63;
    for (int blk = blockIdx.x; blk < NB_ * NSEG; blk += gridDim.x) {
        const int b = blk / NSEG, seg = blk % NSEG, tbeg = seg * SEGL, c = 64 * wid + lane;
        f32x2 SI2[32];
        if (seg > 0) { const float* sg = SEGp + ((size_t)((b * 8 + wid) * NSEG + seg - 1)) * 8192 + 4096 + lane * 64;
#pragma unroll
            for (int j = 0; j < 32; j += 2) { const f32x4 v = *(const f32x4*)(sg + 2 * j); SI2[j] = (f32x2){v[0], v[1]}; SI2[j + 1] = (f32x2){v[2], v[3]}; } }
        else {
#pragma unroll
            for (int j = 0; j < 32; ++j) SI2[j] = (f32x2){0.f, 0.f}; }
        const float lnw = P.ln_w[l * 512 + c], lnb = P.ln_b[l * 512 + c];
        const float* pc = Po + ((size_t)b * S_ + tbeg) * 512 + 64 * wid;
#pragma unroll 1
        for (int t = 0; t < SEGL; ++t) {
            const size_t row = (size_t)b * S_ + tbeg + t;
            f32x16 q0, q1, q2, q3; sload4<0, 64, 128, 192>(pc + (size_t)t * 512, q0, q1, q2, q3);
            f32x2 ca = {0.f, 0.f}, cb = {0.f, 0.f};
#pragma unroll
            for (int i = 0; i < 8; i += 2) {
                ca += SI2[i] * PAIR(q0, i); cb += SI2[i + 1] * PAIR(q0, i + 1); ca += SI2[8 + i] * PAIR(q1, i); cb += SI2[8 + i + 1] * PAIR(q1, i + 1);
                ca += SI2[16 + i] * PAIR(q2, i); cb += SI2[16 + i + 1] * PAIR(q2, i + 1); ca += SI2[24 + i] * PAIR(q3, i); cb += SI2[24 + i + 1] * PAIR(q3, i + 1); }
            const float y = bf2f(Yo[row * 512 + c]) + (ca.x + ca.y) + (cb.x + cb.y);
            const float mean = wave_sum(y) * (1.0f / 64.0f); const float d = y - mean;
            const float var = wave_sum(d * d) * (1.0f / 64.0f);
            const float yn = d * rsqrtf(var + 64e-5f) * lnw + lnb;
            OR[row * 512 + c] = f2bf((yn + bf2f(VBo[row * 512 + c])) * bf2f(Go[row * 512 + c]));
        }
    }
}

enum { PH_PRO = 0, PH_NORM1, PH_ZQ, PH_IDX, PH_ATT, PH_ZR, PH_SCAN, PH_COMB, PH_POST, PH_ZC, PH_CONV, PH_MERGE, PH_WO, PH_NORM2, PH_UP, PH_U, PH_DOWN, PH_FINAL, PH_COUNT };

template <int PH>
__device__ __forceinline__ void run_phase(const Params& P0, int l, LAS unsigned char* lds) {
    Params P = P0; P.ws = opaque_ptr(P0.ws);
    if constexpr (PH == PH_PRO) { if (l == 0) ph_mod(P, lds); ph_wconv(P, l, lds); }
    if constexpr (PH == PH_NORM1) ph_norm(P, l, 0);
    if constexpr (PH == PH_ZQ) ph_gemm_zq(P, lds);
    if constexpr (PH == PH_IDX) ph_idx(P, lds);
    if constexpr (PH == PH_ATT) ph_att(P, lds);
    if constexpr (PH == PH_ZR) ph_gemm_zr(P, lds);
    if constexpr (PH == PH_SCAN) ph_scan(P, l, lds);
    if constexpr (PH == PH_COMB) ph_comb(P, lds);
    if constexpr (PH == PH_POST) ph_post(P, l);
    if constexpr (PH == PH_ZC) ph_gemm_zc(P, lds);
    if constexpr (PH == PH_CONV) ph_conv(P, l);
    if constexpr (PH == PH_MERGE) ph_gemm_merge(P, lds);
    if constexpr (PH == PH_WO) ph_gemm_wo(P, l, lds);
    if constexpr (PH == PH_NORM2) ph_norm(P, l, 1);
    if constexpr (PH == PH_UP) ph_gemm_up(P, lds);
    if constexpr (PH == PH_U) ph_u(P, l);
    if constexpr (PH == PH_DOWN) ph_gemm_down(P, l, lds);
    if constexpr (PH == PH_FINAL) ph_final(P);
}

#if MK_SINGLE
__global__ void __launch_bounds__(NTHR, 2) k_mega(Params P) {
    extern __shared__ __attribute__((aligned(16))) unsigned char shm[];
    LAS unsigned char* lds = (LAS unsigned char*)shm;
    LAS unsigned* xbw = (LAS unsigned*)(lds + LDS_BYTES - 16);
    if (threadIdx.x == 0) { xbw[0] = 0u; xbw[1] = 0u; xbw[2] = 0u; xbw[3] = 0u; }
    __syncthreads();
    XcdBarrier bar = xcd_barrier_post((unsigned*)(P.ws + OFF_BAR), (volatile LAS unsigned*)xbw);
#define PHASE(PH, l) do { run_phase<PH>(P, l, lds); xcd_barrier(bar); } while (0)
#pragma unroll 1
    for (int l = 0; l < 2; ++l) {
        PHASE(PH_PRO, l); PHASE(PH_NORM1, l); PHASE(PH_ZQ, l); PHASE(PH_IDX, l); PHASE(PH_ATT, l); PHASE(PH_ZR, l); PHASE(PH_SCAN, l); PHASE(PH_COMB, l); PHASE(PH_POST, l);
        PHASE(PH_ZC, l); PHASE(PH_CONV, l); PHASE(PH_MERGE, l); PHASE(PH_WO, l); PHASE(PH_NORM2, l); PHASE(PH_UP, l); PHASE(PH_U, l); PHASE(PH_DOWN, l);
    }
    run_phase<PH_FINAL>(P, 0, lds);
#undef PHASE
}
#else
template <int PH>
__global__ void __launch_bounds__(NTHR, 2) k_phase(Params P, int l) {
    extern __shared__ __attribute__((aligned(16))) unsigned char shm[];
    run_phase<PH>(P, l, (LAS unsigned char*)shm);
}
template <int PH> static void launch_phase(const Params& P, int l, hipStream_t stream) {
    static bool attr = false;
    if (!attr) { hipFuncSetAttribute((const void*)k_phase<PH>, hipFuncAttributeMaxDynamicSharedMemorySize, LDS_BYTES); attr = true; }
    hipLaunchKernelGGL(k_phase<PH>, dim3(NBLK), dim3(NTHR), LDS_BYTES, stream, P, l);
}
#endif

extern "C" void kernel_launch(void* const* d_in, const int* in_sizes, int n_in, void* d_out, int out_size, void* d_ws, size_t ws_size, hipStream_t stream) {
    (void)in_sizes; (void)n_in; (void)out_size; (void)ws_size;
    Params P{};
    P.x_in = (const float*)d_in[0]; P.c = (const float*)d_in[1]; P.pos = (const int*)d_in[2]; P.rel_bias = (const float*)d_in[3]; P.final_norm = (const float*)d_in[4];
    P.ada_w = (const float*)d_in[5]; P.ada_b = (const float*)d_in[6]; P.norm_mix = (const float*)d_in[7]; P.w_in = (const float*)d_in[8];
    P.mu = (const float*)d_in[9]; P.w0 = (const float*)d_in[10]; P.w_up = (const float*)d_in[11]; P.a0 = (const float*)d_in[12]; P.a_up = (const float*)d_in[13]; P.g_up = (const float*)d_in[14];
    P.k_k = (const float*)d_in[15]; P.k_a = (const float*)d_in[16]; P.r_k = (const float*)d_in[17]; P.ln_w = (const float*)d_in[18]; P.ln_b = (const float*)d_in[19];
    P.sc_conv_w = (const float*)d_in[20]; P.w_branch = (const float*)d_in[21]; P.w_o = (const float*)d_in[22]; P.norm_ffn = (const float*)d_in[23];
    P.ffn_w_up = (const float*)d_in[24]; P.ffn_conv_w = (const float*)d_in[25]; P.ffn_w_down = (const float*)d_in[26];
    P.out = (float*)d_out; P.ws = (unsigned char*)d_ws;
#if MK_SINGLE
    static bool attr = false;
    if (!attr) { hipFuncSetAttribute((const void*)k_mega, hipFuncAttributeMaxDynamicSharedMemorySize, LDS_BYTES); attr = true; }
    hipMemsetAsync((unsigned char*)d_ws + OFF_BAR, 0, XCD_BAR_WORDS * sizeof(unsigned), stream);
    hipLaunchKernelGGL(k_mega, dim3(NBLK), dim3(NTHR), LDS_BYTES, stream, P);
#else
    for (int l = 0; l < 2; ++l) {
        launch_phase<PH_PRO>(P, l, stream); launch_phase<PH_NORM1>(P, l, stream); launch_phase<PH_ZQ>(P, l, stream); launch_phase<PH_IDX>(P, l, stream);
        launch_phase<PH_ATT>(P, l, stream); launch_phase<PH_ZR>(P, l, stream); launch_phase<PH_SCAN>(P, l, stream); launch_phase<PH_COMB>(P, l, stream);
        launch_phase<PH_POST>(P, l, stream); launch_phase<PH_ZC>(P, l, stream); launch_phase<PH_CONV>(P, l, stream); launch_phase<PH_MERGE>(P, l, stream);
        launch_phase<PH_WO>(P, l, stream); launch_phase<PH_NORM2>(P, l, stream); launch_phase<PH_UP>(P, l, stream); launch_phase<PH_U>(P, l, stream);
        launch_phase<PH_DOWN>(P, l, stream);
    }
    launch_phase<PH_FINAL>(P, 0, stream);
#endif
}
```

```cpp
#include <hip/hip_runtime.h>
#include <stdint.h>

#ifndef MK_SINGLE
#define MK_SINGLE 1
#endif

#define LAS __attribute__((address_space(3)))
typedef unsigned short bf16_t;
typedef short bf16x8 __attribute__((ext_vector_type(8)));
typedef short bf16x4 __attribute__((ext_vector_type(4)));
typedef float f32x4 __attribute__((ext_vector_type(4)));
typedef float f32x16 __attribute__((ext_vector_type(16)));
typedef float f32x2 __attribute__((ext_vector_type(2)));
typedef unsigned u32x4 __attribute__((ext_vector_type(4)));
typedef unsigned u32x2 __attribute__((ext_vector_type(2)));
typedef int i32x4 __attribute__((ext_vector_type(4)));
typedef unsigned long long u64;

constexpr int T_ = 32768, D_ = 1024, NB_ = 8, S_ = 4096;
constexpr int NSEG = 32, SEGL = 128, TB = 8;
constexpr int NBLK = 256, NTHR = 512;
constexpr int IN_COLS = 8520, DFF = 2816;
constexpr int LDS_BYTES = 150 * 1024;

constexpr size_t MiB = 1ull << 20;
constexpr size_t OFF_BAR = 0;
constexpr size_t OFF_MOD = 64 * 1024;
constexpr size_t OFF_TAB = 512 * 1024;
constexpr size_t OFF_KPM = 520 * 1024;
constexpr size_t OFF_WB = 2 * MiB;
constexpr size_t WB_WIN = 0;
constexpr size_t WB_WBR = WB_WIN + (size_t)8704 * 1024 * 2;
constexpr size_t WB_WO = WB_WBR + (size_t)3 * 1024 * 512 * 2;
constexpr size_t WB_WUP = WB_WO + (size_t)1024 * 1024 * 2;
constexpr size_t WB_WDN = WB_WUP + (size_t)5632 * 1024 * 2;
constexpr size_t WB_LW = WB_WDN + (size_t)1024 * 2816 * 2;
constexpr size_t WB_LA = WB_LW + (size_t)512 * 64 * 2;
constexpr size_t WB_LG = WB_LA + (size_t)512 * 64 * 2;
constexpr size_t OFF_H = 42 * MiB;
constexpr size_t OFF_ZQ = 106 * MiB;
constexpr size_t OFF_MASK = 250 * MiB;
constexpr size_t OFF_VT = 266 * MiB;
constexpr size_t OFF_ZR = 106 * MiB;
constexpr size_t OFF_Y = 218 * MiB;
constexpr size_t OFF_P = 250 * MiB;
constexpr size_t OFF_G = 282 * MiB;
constexpr size_t OFF_SEG = 314 * MiB;
constexpr size_t OFF_ZCV = 106 * MiB;
constexpr size_t OFF_ZG = 202 * MiB;
constexpr size_t OFF_MRG = 106 * MiB;
constexpr size_t OFF_UP = 106 * MiB;
constexpr size_t OFF_HA = 300 * MiB;
constexpr size_t OFF_HB = 320 * MiB;
constexpr size_t OFF_OCONV = 416 * MiB;
constexpr size_t OFF_ORWKV = 448 * MiB;
constexpr size_t OFF_OATT = 480 * MiB;
constexpr size_t OFF_VB = OFF_ORWKV;
constexpr size_t OFF_SCR = 378 * MiB;

struct Params {
    const float* x_in; const float* c; const int* pos; const float* rel_bias; const float* final_norm;
    const float* ada_w; const float* ada_b; const float* norm_mix; const float* w_in;
    const float* mu; const float* w0; const float* w_up; const float* a0; const float* a_up; const float* g_up;
    const float* k_k; const float* k_a; const float* r_k; const float* ln_w; const float* ln_b;
    const float* sc_conv_w; const float* w_branch; const float* w_o; const float* norm_ffn;
    const float* ffn_w_up; const float* ffn_conv_w; const float* ffn_w_down;
    float* out; unsigned char* ws;
};

__device__ __forceinline__ float bf2f(bf16_t b) { return __uint_as_float(((unsigned)b) << 16); }
__device__ __forceinline__ bf16_t f2bf(float f) { unsigned u = __float_as_uint(f); u += 0x7FFFu + ((u >> 16) & 1u); return (bf16_t)(u >> 16); }
typedef __bf16 bf16x2_t __attribute__((ext_vector_type(2)));
__device__ __forceinline__ unsigned cvt_pk_bf16(float lo, float hi) { const f32x2 v = {lo, hi}; return __builtin_bit_cast(unsigned, __builtin_convertvector(v, bf16x2_t)); }
__device__ __forceinline__ float bflo(unsigned w) { return __uint_as_float(w << 16); }
__device__ __forceinline__ float bfhi(unsigned w) { return __uint_as_float(w & 0xffff0000u); }
__device__ __forceinline__ float shx(float v, int mask, int lane) { return __int_as_float(__builtin_amdgcn_ds_bpermute((lane ^ mask) << 2, __float_as_int(v))); }
__device__ __forceinline__ int shxi(int v, int mask, int lane) { return __builtin_amdgcn_ds_bpermute((lane ^ mask) << 2, v); }
__device__ __forceinline__ float wave_sum(float v, int lane) {
#pragma unroll
    for (int o = 32; o >= 1; o >>= 1) v += shx(v, o, lane);
    return v;
}
__device__ __forceinline__ void writelane_c2(int& vlo, int& vhi, int lo, int hi, int ln  ) {
    asm("s_nop 3\n\tv_writelane_b32 %0, %2, %4\n\tv_writelane_b32 %1, %3, %4" : "+v"(vlo), "+v"(vhi) : "s"(lo), "s"(hi), "n"(ln)); }
__device__ __forceinline__ int writelane_v(int vec, int val, int ln  ) { asm("s_mov_b32 m0, %2\n\ts_nop 3\n\tv_writelane_b32 %0, %1, m0" : "+v"(vec) : "s"(val), "s"(ln) : "m0"); return vec; }
__device__ __forceinline__ float sigmoidf_(float x) { return __builtin_amdgcn_rcpf(1.0f + __expf(-x)); }
__device__ __forceinline__ unsigned f2ord(float x) { unsigned u = __float_as_uint(x); return (u & 0x80000000u) ? ~u : (u | 0x80000000u); }
__device__ __forceinline__ float ord2f(unsigned k) { return __uint_as_float((k & 0x80000000u) ? (k & 0x7fffffffu) : ~k); }

__device__ __forceinline__ int opaque_tid() { int t = threadIdx.x; asm volatile("" : "+v"(t)); return t; }
__device__ __forceinline__ unsigned char* opaque_ptr(unsigned char* p) {
    typedef __attribute__((address_space(1))) unsigned char* gptr_t;
    gptr_t g = (gptr_t)p; asm volatile("" : "+s"(g)); return (unsigned char*)g; }

#define XB_TMO      128
#define XB_XCNT(j)  (256  + 64 * (j))
#define XB_XSUB(j)  (1280 + 64 * (j))
#define XB_XGEN(j)  (2304 + 64 * (j))
#define XB_TOP      3328
#define XB_TOPGEN   3392
#define XCD_BAR_WORDS 3456
#define XB_SPIN_CAP (1u << 22)

__device__ __forceinline__ unsigned xb_ld(unsigned* p)              { return __hip_atomic_load(p, __ATOMIC_RELAXED, __HIP_MEMORY_SCOPE_AGENT); }
__device__ __forceinline__ unsigned xb_add(unsigned* p, unsigned v) { return __hip_atomic_fetch_add(p, v, __ATOMIC_RELAXED, __HIP_MEMORY_SCOPE_AGENT); }
__device__ __forceinline__ unsigned xb_xcc_id() { return (unsigned)__builtin_amdgcn_s_getreg((3 << 11) | 20) & 0xFu; }
#define XB_SPIN(cond, bar) do { unsigned _sp = 0; while (cond) { __builtin_amdgcn_s_sleep(1); \
    if ((++_sp & 255u) == 0u) { if (xb_ld(&(bar)[XB_TMO])) break; if (_sp > XB_SPIN_CAP) { atomicAdd(&(bar)[XB_TMO], 1u); break; } } } } while (0)

struct XcdBarrier { unsigned* bar; unsigned x; volatile LAS unsigned* st; };

__device__ __forceinline__ XcdBarrier xcd_barrier_post(unsigned* bar, volatile LAS unsigned* st) {
    XcdBarrier b; b.bar = bar; b.x = xb_xcc_id(); b.st = st;
    if (threadIdx.x == 0) (void)xb_add(&bar[XB_XCNT(b.x)], 1u);
    return b;
}
__device__ __forceinline__ void xcd_barrier_complete(unsigned* bar, unsigned x, unsigned& nloc, unsigned& nx) {
    const unsigned G = gridDim.x * gridDim.y * gridDim.z;
    unsigned sum, cnt, mine, sp = 0u;
    for (;;) {
        sum = 0u; cnt = 0u; mine = 0u;
#pragma unroll
        for (unsigned j = 0; j < 16; ++j) { const unsigned c = xb_ld(&bar[XB_XCNT(j)]); sum += c; cnt += (c > 0u) ? 1u : 0u; mine = (j == x) ? c : mine; }
        if (sum == G) break;
        __builtin_amdgcn_s_sleep(1);
        if ((++sp & 255u) == 0u) { if (xb_ld(&bar[XB_TMO])) break; if (sp > XB_SPIN_CAP) { atomicAdd(&bar[XB_TMO], 1u); break; } }
    }
    nloc = mine > 0u ? mine : 1u; nx = cnt > 0u ? cnt : 1u;
}
__device__ __forceinline__ void xcd_barrier(const XcdBarrier& b) {
    asm volatile("s_waitcnt vmcnt(0)" ::: "memory");
    __syncthreads();
    if (threadIdx.x == 0) {
        unsigned* bar = b.bar;
        __builtin_amdgcn_s_waitcnt(0);
        unsigned nloc = b.st[0], nx = b.st[1];
        if (nloc == 0u) { xcd_barrier_complete(bar, b.x, nloc, nx); b.st[0] = nloc; b.st[1] = nx; }
        const unsigned old = xb_add(&bar[XB_XSUB(b.x)], 1u);
        const unsigned gen = old / nloc;
        if (old + 1u == (gen + 1u) * nloc) {
            __builtin_amdgcn_fence(__ATOMIC_RELEASE, "agent");
            asm volatile("s_waitcnt vmcnt(0)" ::: "memory");
            const unsigned og = xb_add(&bar[XB_TOP], 1u);
            const unsigned tg = og / nx;
            if (og + 1u == (tg + 1u) * nx) xb_add(&bar[XB_TOPGEN], 1u);
            else XB_SPIN(xb_ld(&bar[XB_TOPGEN]) == tg, bar);
            __builtin_amdgcn_fence(__ATOMIC_ACQUIRE, "agent");
            xb_add(&bar[XB_XGEN(b.x)], 1u);
            asm volatile("s_waitcnt vmcnt(0)" ::: "memory");
        } else {
            XB_SPIN(xb_ld(&bar[XB_XGEN(b.x)]) == gen, bar);
            __builtin_amdgcn_fence(__ATOMIC_ACQUIRE, "agent");
            asm volatile("s_waitcnt vmcnt(0)" ::: "memory");
        }
    }
    __syncthreads();
}

namespace g8 {
constexpr int BM = 256, BK = 64, HALF = 128, HTB = HALF * BK * 2, STAGE_BYTES = 8 * HTB, NXCD = 8, WGM = 8;
__device__ __forceinline__ int lds_byte(int r, int c) { const int st = (r >> 4) * 2 + (c >> 5), rr = r & 15, cc = c & 31, ob = rr * 64 + cc * 2; return st * 1024 + (ob ^ (((ob >> 9) & 1) << 5)); }
__device__ __forceinline__ void stage_rc(int b, int& R, int& C) { const int st = b / 1024, sb = b % 1024, swz = sb ^ (((sb >> 9) & 1) << 5); R = (st >> 1) * 16 + swz / 64; C = (st & 1) * 32 + (swz % 64) / 2; }
__device__ __forceinline__ int perm32(int rho) { const int n = rho >> 4, i = rho & 15; return 8 * (i >> 2) + 4 * n + (i & 3); }

struct Unit { const char* A; const char* B; int pm, pn, tag; };

struct SOrder {
    int nM, nN, nwg, G, c; const char* A; const char* Bt; size_t a_t, b_t;
    __device__ void init(int M, int N, int lda, int ldb, const void* A_, const void* Bt_) {
        nM = M / BM; nN = N / BM; nwg = nM * nN; G = (int)gridDim.x; c = (int)blockIdx.x; A = (const char*)A_; Bt = (const char*)Bt_;
        a_t = (size_t)BM * lda * 2; b_t = (size_t)BM * ldb * 2; }
    __device__ bool next(int i, Unit& u) const {
        const long L = (long)i * G + c; if (L >= nwg) return false;
        int wgid = (int)L; { const int q = nwg / NXCD, r = nwg % NXCD, xcd = wgid % NXCD, off = wgid / NXCD; wgid = (xcd < r ? xcd * (q + 1) : r * (q + 1) + (xcd - r) * q) + off; }
        const int nig = WGM * nN, gid = wgid / nig, fm = gid * WGM, gsz = (nM - fm) < WGM ? (nM - fm) : WGM;
        u.pm = fm + ((wgid % nig) % gsz); u.pn = (wgid % nig) / gsz; u.tag = 0;
        u.A = A + (size_t)u.pm * a_t; u.B = Bt + (size_t)u.pn * b_t; return true;
    }
};

template <class Epi, class Sched>
__device__ __forceinline__ void gemm_phase(LAS unsigned char* lds, const int K, const int lda, const int ldb, const Sched& S, const Epi& E) {
    const int tid = opaque_tid(), wid = __builtin_amdgcn_readfirstlane(tid >> 6), lane = tid & 63, wr = wid >> 2, wc = wid & 3, fr = lane & 15, fq = lane >> 4;
    const int nt = K / BK;
    unsigned voffA[2], voffB[2];
#pragma unroll
    for (int i = 0; i < 2; ++i) { int R, C; stage_rc(tid * 16 + i * 8192, R, C); const int Rb = Epi::PERM ? ((R & ~31) + perm32(R & 31)) : R;
        voffA[i] = (unsigned)(R * lda + C) * 2u; voffB[i] = (unsigned)(Rb * ldb + C) * 2u; }
    const size_t kstep = (size_t)(BK * 2);
    const size_t hstepA = (size_t)HALF * lda * 2, hstepB = (size_t)HALF * ldb * 2;
    const unsigned ldsw = (unsigned)wid * 1024u;
    const int aoff = lds_byte(wr * 64 + fr, fq * 8), boff = lds_byte(wc * 32 + fr, fq * 8);
#define PG8_SA(b, h) (((b) * 2 + (h)) * HTB)
#define PG8_SB(b, h) ((4 + (b) * 2 + (h)) * HTB)
#define PG8_STAGE(bufoff, gbase, voff) do { _Pragma("unroll") for (int _i = 0; _i < 2; ++_i) \
        __builtin_amdgcn_global_load_lds((const unsigned*)((const char*)(gbase) + (voff)[_i]), (LAS unsigned*)(lds + (bufoff) + ldsw + _i * 8192), 16, 0, 0); } while (0)
#define PG8_LDA(dst, b, h) do { _Pragma("unroll") for (int m = 0; m < 4; ++m) _Pragma("unroll") for (int k = 0; k < 2; ++k) dst[m][k] = *(const LAS bf16x8*)(lds + PG8_SA(b, h) + aoff + m * 2048 + k * 1024); } while (0)
#define PG8_LDB(dst, b, h) do { _Pragma("unroll") for (int n = 0; n < 2; ++n) _Pragma("unroll") for (int k = 0; k < 2; ++k) dst[n][k] = *(const LAS bf16x8*)(lds + PG8_SB(b, h) + boff + n * 2048 + k * 1024); } while (0)
#define PG8_MMA(ai, bj, At, Bt) do { __builtin_amdgcn_s_setprio(1); _Pragma("unroll") for (int m = 0; m < 4; ++m) _Pragma("unroll") for (int n = 0; n < 2; ++n) _Pragma("unroll") for (int k = 0; k < 2; ++k) \
        acc[ai][bj][m][n] = __builtin_amdgcn_mfma_f32_16x16x32_bf16(Bt[n][k], At[m][k], acc[ai][bj][m][n], 0, 0, 0); __builtin_amdgcn_s_setprio(0); } while (0)
#define PG8_WAIT_V(n) asm volatile("s_waitcnt vmcnt(" #n ")" ::: "memory")
#define PG8_WAIT_L(n) asm volatile("s_waitcnt lgkmcnt(" #n ")" ::: "memory")
#define PG8_BAR __builtin_amdgcn_s_barrier()
#define PG8_SCHED __builtin_amdgcn_sched_barrier(0)
    Unit cur, nxt; int ui = 0;
    if (!S.next(0, cur)) return;
    f32x4 acc[2][2][4][2];
#pragma unroll
    for (int a = 0; a < 2; ++a)
#pragma unroll
        for (int b = 0; b < 2; ++b)
#pragma unroll
            for (int m = 0; m < 4; ++m)
#pragma unroll
                for (int n = 0; n < 2; ++n) acc[a][b][m][n] = (f32x4){0.f, 0.f, 0.f, 0.f};
    bf16x8 At[4][2], B0[2][2], B1[2][2];
    const char* cA = cur.A; const char* cB = cur.B;
    PG8_STAGE(PG8_SB(0, 0), cB, voffB); PG8_STAGE(PG8_SA(0, 0), cA, voffA); PG8_STAGE(PG8_SB(0, 1), cB + hstepB, voffB); PG8_STAGE(PG8_SA(0, 1), cA + hstepA, voffA);
    if (wr == 1) PG8_BAR;
    PG8_WAIT_V(4); PG8_BAR;
    PG8_STAGE(PG8_SB(1, 0), cB + kstep, voffB); PG8_STAGE(PG8_SA(1, 0), cA + kstep, voffA); PG8_STAGE(PG8_SB(1, 1), cB + hstepB + kstep, voffB);
    PG8_WAIT_V(6); PG8_BAR;
    for (;;) {
        const bool has_next = S.next(ui + 1, nxt);
        const char* nA = has_next ? nxt.A : cA; const char* nB = has_next ? nxt.B : cB;
        for (int t = 0; t < nt; t += 2) {
            const bool last = (t == nt - 2);
            const char* a1 = cA + (size_t)(t + 1) * kstep;
            const char* a2 = last ? nA : cA + (size_t)(t + 2) * kstep; const char* b2 = last ? nB : cB + (size_t)(t + 2) * kstep;
            const char* a3 = a2 + kstep; const char* b3 = b2 + kstep;
            PG8_LDB(B0, 0, 0); PG8_SCHED; PG8_LDA(At, 0, 0); PG8_STAGE(PG8_SA(1, 1), a1 + hstepA, voffA);
            PG8_WAIT_L(8); PG8_BAR; PG8_WAIT_L(0); PG8_MMA(0, 0, At, B0); PG8_BAR; PG8_SCHED;
            PG8_LDB(B1, 0, 1); PG8_STAGE(PG8_SB(0, 0), b2, voffB);
            PG8_BAR; PG8_WAIT_L(0); PG8_MMA(0, 1, At, B1); PG8_BAR;
            PG8_LDA(At, 0, 1); PG8_STAGE(PG8_SA(0, 0), a2, voffA);
            PG8_BAR; PG8_WAIT_L(0); PG8_MMA(1, 0, At, B0); PG8_BAR; PG8_SCHED;
            PG8_STAGE(PG8_SB(0, 1), b2 + hstepB, voffB);
            PG8_WAIT_V(6); PG8_BAR; PG8_MMA(1, 1, At, B1); PG8_BAR;
            PG8_LDB(B0, 1, 0); PG8_SCHED; PG8_LDA(At, 1, 0); PG8_STAGE(PG8_SA(0, 1), a2 + hstepA, voffA);
            PG8_WAIT_L(8); PG8_BAR; PG8_WAIT_L(0); PG8_MMA(0, 0, At, B0); PG8_BAR; PG8_SCHED;
            PG8_LDB(B1, 1, 1); PG8_STAGE(PG8_SB(1, 0), b3, voffB);
            PG8_BAR; PG8_WAIT_L(0); PG8_MMA(0, 1, At, B1); PG8_BAR;
            PG8_LDA(At, 1, 1); PG8_STAGE(PG8_SA(1, 0), a3, voffA);
            PG8_BAR; PG8_WAIT_L(0); PG8_MMA(1, 0, At, B0); PG8_BAR; PG8_SCHED;
            PG8_STAGE(PG8_SB(1, 1), b3 + hstepB, voffB);
            PG8_WAIT_V(6); PG8_BAR; PG8_MMA(1, 1, At, B1); PG8_BAR;
        }
        bool keep = false;
        if constexpr (Epi::CHAIN) keep = E.chain(acc, cur, wr, wc, fr, fq); else E(acc, cur, wr, wc, fr, fq);
        if (!has_next) break;
        if (!keep) {
#pragma unroll
            for (int a = 0; a < 2; ++a)
#pragma unroll
                for (int b = 0; b < 2; ++b)
#pragma unroll
                    for (int m = 0; m < 4; ++m)
#pragma unroll
                        for (int n = 0; n < 2; ++n) acc[a][b][m][n] = (f32x4){0.f, 0.f, 0.f, 0.f};
        }
        cur = nxt; cA = nA; cB = nB; ++ui;
    }
    PG8_WAIT_V(0);
    if (wr == 0) PG8_BAR;
    PG8_BAR;
#undef PG8_SA
#undef PG8_SB
#undef PG8_STAGE
#undef PG8_LDA
#undef PG8_LDB
#undef PG8_MMA
#undef PG8_WAIT_V
#undef PG8_WAIT_L
#undef PG8_BAR
#undef PG8_SCHED
}

struct EpiBf {
    static constexpr bool PERM = true, CHAIN = false;
    bf16_t* O0; int ld0; int split; bf16_t* O1; int ld1; int act1;
    __device__ __forceinline__ void operator()(const f32x4 (&acc)[2][2][4][2], const Unit& u, int wr, int wc, int fr, int fq) const {
        const bool second = u.pn >= split;
        bf16_t* base = second ? O1 : O0; const int ld = second ? ld1 : ld0; const int colt = (second ? (u.pn - split) : u.pn) * BM;
        const bool act = second && act1;
        const int row0 = u.pm * BM + wr * 64 + fr, col0 = colt + wc * 32 + 8 * fq;
#pragma unroll
        for (int ai = 0; ai < 2; ++ai)
#pragma unroll
            for (int m = 0; m < 4; ++m) { bf16_t* rowp = base + (size_t)(row0 + ai * HALF + m * 16) * ld + col0;
#pragma unroll
                for (int bj = 0; bj < 2; ++bj) { f32x4 v0 = acc[ai][bj][m][0], v1 = acc[ai][bj][m][1];
                    if (act) {
#pragma unroll
                        for (int j = 0; j < 4; ++j) { v0[j] = sigmoidf_(v0[j]); v1[j] = sigmoidf_(v1[j]); } }
                    u32x4 w; w.x = cvt_pk_bf16(v0[0], v0[1]); w.y = cvt_pk_bf16(v0[2], v0[3]); w.z = cvt_pk_bf16(v1[0], v1[1]); w.w = cvt_pk_bf16(v1[2], v1[3]);
                    *(u32x4*)(rowp + bj * HALF) = w; } }
    }
};
struct EpiMerge {
    static constexpr bool PERM = true, CHAIN = true;
    bf16_t* M; const bf16_t* ZG;
    __device__ __forceinline__ bool chain(f32x4 (&acc)[2][2][4][2], const Unit& u, int wr, int wc, int fr, int fq) const {
        const int row0 = u.pm * BM + wr * 64 + fr, col0 = u.pn * BM + wc * 32 + 8 * fq;
#pragma unroll
        for (int ai = 0; ai < 2; ++ai)
#pragma unroll
            for (int m = 0; m < 4; ++m) { const size_t r = (size_t)(row0 + ai * HALF + m * 16);
#pragma unroll
                for (int bj = 0; bj < 2; ++bj) {
                    const bf16_t* gp = ZG + r * 3072 + col0 + bj * HALF;
                    float f[8];
                    if (u.tag == 2) { const u32x4 g = *(const u32x4*)(gp + 2048);
                        f[0] = bflo(g.x); f[1] = bfhi(g.x); f[2] = bflo(g.y); f[3] = bfhi(g.y); f[4] = bflo(g.z); f[5] = bfhi(g.z); f[6] = bflo(g.w); f[7] = bfhi(g.w);
#pragma unroll
                        for (int e = 0; e < 8; ++e) f[e] = fmaxf(f[e], 1e-12f);
                    } else { const u32x4 gn = *(const u32x4*)(gp + u.tag * 1024), gd = *(const u32x4*)(gp + (u.tag + 1) * 1024);
                        const float nn[8] = {bflo(gn.x), bfhi(gn.x), bflo(gn.y), bfhi(gn.y), bflo(gn.z), bfhi(gn.z), bflo(gn.w), bfhi(gn.w)};
                        const float dd[8] = {bflo(gd.x), bfhi(gd.x), bflo(gd.y), bfhi(gd.y), bflo(gd.z), bfhi(gd.z), bflo(gd.w), bfhi(gd.w)};
#pragma unroll
                        for (int e = 0; e < 8; ++e) f[e] = (u.tag == 0 ? nn[e] : fmaxf(nn[e], 1e-12f)) * __builtin_amdgcn_rcpf(fmaxf(dd[e], 1e-12f)); }
                    f32x4& v0 = acc[ai][bj][m][0]; f32x4& v1 = acc[ai][bj][m][1];
                    v0[0] *= f[0]; v0[1] *= f[1]; v0[2] *= f[2]; v0[3] *= f[3]; v1[0] *= f[4]; v1[1] *= f[5]; v1[2] *= f[6]; v1[3] *= f[7];
                    if (u.tag == 2) { u32x4 w; w.x = cvt_pk_bf16(v0[0], v0[1]); w.y = cvt_pk_bf16(v0[2], v0[3]); w.z = cvt_pk_bf16(v1[0], v1[1]); w.w = cvt_pk_bf16(v1[2], v1[3]);
                        *(u32x4*)(M + r * 1024 + col0 + bj * HALF) = w; }
                } }
        return u.tag != 2;
    }
};
struct EpiRes {
    static constexpr bool PERM = true, CHAIN = false;
    const float* xin32; const bf16_t* xin16; bf16_t* xout; const float* gate;
    __device__ __forceinline__ void operator()(const f32x4 (&acc)[2][2][4][2], const Unit& u, int wr, int wc, int fr, int fq) const {
        const int row0 = u.pm * BM + wr * 64 + fr, col0 = u.pn * BM + wc * 32 + 8 * fq;
        const float* gp = gate + (size_t)(u.pm >> 4) * 6144 + col0;
        f32x4 gv[2][2];
#pragma unroll
        for (int bj = 0; bj < 2; ++bj) { gv[bj][0] = *(const f32x4*)(gp + bj * HALF); gv[bj][1] = *(const f32x4*)(gp + bj * HALF + 4); }
#pragma unroll
        for (int ai = 0; ai < 2; ++ai)
#pragma unroll
            for (int m = 0; m < 4; ++m) { const size_t off = (size_t)(row0 + ai * HALF + m * 16) * 1024 + col0;
#pragma unroll
                for (int bj = 0; bj < 2; ++bj) {
                    f32x4 x0, x1;
                    if (xin32) { x0 = *(const f32x4*)(xin32 + off + bj * HALF); x1 = *(const f32x4*)(xin32 + off + bj * HALF + 4); }
                    else { const u32x4 xw = *(const u32x4*)(xin16 + off + bj * HALF);
                        x0 = (f32x4){bflo(xw.x), bfhi(xw.x), bflo(xw.y), bfhi(xw.y)}; x1 = (f32x4){bflo(xw.z), bfhi(xw.z), bflo(xw.w), bfhi(xw.w)}; }
                    const f32x4 o0 = x0 + gv[bj][0] * acc[ai][bj][m][0], o1 = x1 + gv[bj][1] * acc[ai][bj][m][1];
                    u32x4 w; w.x = cvt_pk_bf16(o0[0], o0[1]); w.y = cvt_pk_bf16(o0[2], o0[3]); w.z = cvt_pk_bf16(o1[0], o1[1]); w.w = cvt_pk_bf16(o1[2], o1[3]);
                    *(u32x4*)(xout + off + bj * HALF) = w; } }
    }
};
__device__ __forceinline__ float dpp_prev(float x, float y, int n) {
    if (n == 1) { const int yr = __builtin_amdgcn_update_dpp(0, __float_as_int(y), 0x121, 0xf, 0xf, false);
                  return __int_as_float(__builtin_amdgcn_update_dpp(yr, __float_as_int(x), 0x111, 0xf, 0xf, false)); }
    const int yr = __builtin_amdgcn_update_dpp(0, __float_as_int(y), 0x122, 0xf, 0xf, false);
    return __int_as_float(__builtin_amdgcn_update_dpp(yr, __float_as_int(x), 0x112, 0xf, 0xf, false));
}
struct EpiUp {
    static constexpr bool PERM = true, CHAIN = false;
    bf16_t* U; float* HA; float* HB; const float* cw;
    __device__ __forceinline__ void operator()(const f32x4 (&acc)[2][2][4][2], const Unit& u, int wr, int wc, int fr, int fq) const {
        const int c0 = 128 * u.pn + 32 * wc + 8 * fq;
        float w0[8], w1[8], w2[8];
        { float f[24];
#pragma unroll
          for (int q = 0; q < 6; ++q) { const f32x4 v = *(const f32x4*)(cw + (size_t)c0 * 3 + 4 * q); f[4 * q] = v[0]; f[4 * q + 1] = v[1]; f[4 * q + 2] = v[2]; f[4 * q + 3] = v[3]; }
#pragma unroll
          for (int e = 0; e < 8; ++e) { w0[e] = f[3 * e]; w1[e] = f[3 * e + 1]; w2[e] = f[3 * e + 2]; } }
#pragma unroll
        for (int ai = 0; ai < 2; ++ai) {
            const int grp = 4 * u.pm + 2 * ai + wr;
            float Y[8];
#pragma unroll
            for (int e = 0; e < 8; ++e) Y[e] = 0.f;
#pragma unroll
            for (int m = 0; m < 4; ++m) {
                const size_t row = (size_t)u.pm * BM + ai * HALF + wr * 64 + m * 16 + fr;
                float X[8], G[8], o[8];
#pragma unroll
                for (int e = 0; e < 8; ++e) { X[e] = acc[ai][0][m][e >> 2][e & 3]; G[e] = acc[ai][1][m][e >> 2][e & 3]; }
#pragma unroll
                for (int e = 0; e < 8; ++e) { const float a1 = dpp_prev(X[e], Y[e], 1), a2 = dpp_prev(X[e], Y[e], 2);
                    const float s = w0[e] * a2 + w1[e] * a1 + w2[e] * X[e]; o[e] = s * sigmoidf_(s) * G[e]; }
                if (m > 0 || fr >= 2) { u32x4 w; w.x = cvt_pk_bf16(o[0], o[1]); w.y = cvt_pk_bf16(o[2], o[3]); w.z = cvt_pk_bf16(o[4], o[5]); w.w = cvt_pk_bf16(o[6], o[7]);
                    *(u32x4*)(U + row * DFF + c0) = w; }
                if (m == 0 && fr < 2) { float* hb = HB + ((size_t)(grp * 2 + fr) * 2) * DFF + c0;
                    *(f32x4*)hb = (f32x4){X[0], X[1], X[2], X[3]}; *(f32x4*)(hb + 4) = (f32x4){X[4], X[5], X[6], X[7]};
                    *(f32x4*)(hb + DFF) = (f32x4){G[0], G[1], G[2], G[3]}; *(f32x4*)(hb + DFF + 4) = (f32x4){G[4], G[5], G[6], G[7]}; }
                if (m == 3 && fr >= 14) { float* ha = HA + (size_t)(grp * 2 + fr - 14) * DFF + c0;
                    *(f32x4*)ha = (f32x4){X[0], X[1], X[2], X[3]}; *(f32x4*)(ha + 4) = (f32x4){X[4], X[5], X[6], X[7]}; }
#pragma unroll
                for (int e = 0; e < 8; ++e) Y[e] = X[e];
            }
        }
    }
};
struct MergeOrder {
    int G, c; const char* o_att; const char* wbr;
    __device__ bool next(int i, Unit& u) const {
        const int tile = (i / 3) * G + c; if (tile >= (T_ / BM) * 4) return false;
        const int br = i % 3; u.pm = tile >> 2; u.pn = tile & 3; u.tag = br;
        u.A = o_att - (size_t)br * (32 * MiB) + (size_t)u.pm * BM * 512 * 2;
        u.B = wbr + (size_t)br * 1024 * 512 * 2 + (size_t)u.pn * BM * 512 * 2; return true;
    }
};
}

#define GSTRIDE_BLOCKS(var, n) for (int var = blockIdx.x; var < (n); var += gridDim.x)

__device__ __forceinline__ void ph_mod(const Params& P, LAS unsigned char* lds) {
    LAS float* red = (LAS float*)lds;
    float* mod = (float*)(P.ws + OFF_MOD); float* tab = (float*)(P.ws + OFF_TAB);
    const int tid = opaque_tid(), wid = tid >> 6, lane = tid & 63;
    GSTRIDE_BLOCKS(blk, 192) {
        const int l = blk / 96, jb = blk % 96, j = jb * 64 + lane;
        float acc[8];
#pragma unroll
        for (int b = 0; b < 8; ++b) acc[b] = 0.f;
        const float* aw = P.ada_w + (size_t)l * 1024 * 6144 + j;
        for (int k = wid * 128; k < wid * 128 + 128; ++k) {
            const float w = aw[(size_t)k * 6144];
#pragma unroll
            for (int b = 0; b < 8; ++b) acc[b] += P.c[b * 1024 + k] * w;
        }
#pragma unroll
        for (int b = 0; b < 8; ++b) red[(wid * 8 + b) * 64 + lane] = acc[b];
        __syncthreads();
        { const int b = wid; float s = P.ada_b[l * 6144 + j];
#pragma unroll
          for (int w = 0; w < 8; ++w) s += red[(w * 8 + b) * 64 + lane];
          mod[((size_t)l * 8 + b) * 6144 + j] = s; }
        __syncthreads();
    }
    if (blockIdx.x == gridDim.x - 1) {
        for (int i = tid; i < 1024; i += NTHR) { const int n = i >> 3, h = i & 7; int bk;
            if (n < 16) bk = n; else { const float nf = (float)n; bk = 16 + (int)(logf(nf / 16.0f) / 2.0794415416798357f * 16.0f); bk = bk < 31 ? bk : 31; }
            tab[i] = P.rel_bias[bk * 8 + h]; }
    }
}

struct WJob { const float* src; int ldsrc; int K; int N; bf16_t* dst; int win; };
template <int KT  >
__device__ __forceinline__ void conv_tiles(const WJob& J, LAS float* tile  ) {
    const int tid = opaque_tid(); const int nkt = J.K / KT, nnt = J.N / 64, ntiles = nkt * nnt;
    GSTRIDE_BLOCKS(ti, ntiles) {
        const int kt = ti % nkt, ntb = ti / nkt, k0 = kt * KT, n0 = ntb * 64;
        { const int n = tid & 63, kk0 = tid >> 6; const int nn = n0 + n; int col = nn;
          if (J.win == 1) col = nn < 2120 ? nn : (nn < 2304 ? -1 : nn - 184);
          if (J.win == 2) col = ((nn & 255) < 128) ? 128 * (nn >> 8) + (nn & 127) : DFF + 128 * (nn >> 8) + (nn & 127);
          float v[KT / 8];
#pragma unroll
          for (int p = 0; p < KT / 8; ++p) { const int k = kk0 + 8 * p; v[p] = col >= 0 ? J.src[(size_t)(k0 + k) * J.ldsrc + col] : 0.f; }
#pragma unroll
          for (int p = 0; p < KT / 8; ++p) tile[(kk0 + 8 * p) * 65 + n] = v[p]; }
        __syncthreads();
#pragma unroll
        for (int q = 0; q < KT / 64; ++q) { const int n = tid >> 3, kg = (tid & 7) + 8 * q; float v[8];
#pragma unroll
          for (int e = 0; e < 8; ++e) v[e] = tile[(kg * 8 + e) * 65 + n];
          u32x4 w; w.x = cvt_pk_bf16(v[0], v[1]); w.y = cvt_pk_bf16(v[2], v[3]); w.z = cvt_pk_bf16(v[4], v[5]); w.w = cvt_pk_bf16(v[6], v[7]);
          *(u32x4*)(J.dst + (size_t)(n0 + n) * J.K + k0 + kg * 8) = w; }
        __syncthreads();
    }
}
__device__ __forceinline__ void ph_wconv(const Params& P, int l, LAS unsigned char* lds) {
    LAS float* tile = (LAS float*)lds; unsigned char* wb = P.ws + OFF_WB;
    { WJob J{P.w_in + (size_t)l * 1024 * IN_COLS, IN_COLS, 1024, 8704, (bf16_t*)(wb + WB_WIN), 1}; conv_tiles<256>(J, tile); }
    for (int i = 0; i < 3; ++i) { WJob J{P.w_branch + ((size_t)l * 3 + i) * 512 * 1024, 1024, 512, 1024, (bf16_t*)(wb + WB_WBR) + (size_t)i * 1024 * 512, 0}; conv_tiles<256>(J, tile); }
    { WJob J{P.w_o + (size_t)l * 1024 * 1024, 1024, 1024, 1024, (bf16_t*)(wb + WB_WO), 0}; conv_tiles<256>(J, tile); }
    { WJob J{P.ffn_w_up + (size_t)l * 1024 * 5632, 5632, 1024, 5632, (bf16_t*)(wb + WB_WUP), 2}; conv_tiles<256>(J, tile); }
    { WJob J{P.ffn_w_down + (size_t)l * 2816 * 1024, 1024, 2816, 1024, (bf16_t*)(wb + WB_WDN), 0}; conv_tiles<256>(J, tile); }
    { WJob J{P.w_up + (size_t)l * 64 * 512, 512, 64, 512, (bf16_t*)(wb + WB_LW), 0}; conv_tiles<64>(J, tile); }
    { WJob J{P.a_up + (size_t)l * 64 * 512, 512, 64, 512, (bf16_t*)(wb + WB_LA), 0}; conv_tiles<64>(J, tile); }
    { WJob J{P.g_up + (size_t)l * 128 * 512, 512, 128, 512, (bf16_t*)(wb + WB_LG), 0}; conv_tiles<64>(J, tile); }
}

__device__ __forceinline__ void ph_norm(const Params& P, int l, int which) {
    const bool first = (l == 0 && which == 0);
    const float* nw = (which == 0 ? P.norm_mix : P.norm_ffn) + l * 1024;
    const float* mod = (const float*)(P.ws + OFF_MOD) + (size_t)l * 8 * 6144 + which * 3072;
    const bf16_t* XB = (const bf16_t*)P.out;
    bf16_t* H = (bf16_t*)(P.ws + OFF_H);
    const int tid = opaque_tid(), wid = tid >> 6, lane = tid & 63;
    for (int row = blockIdx.x * 8 + wid; row < T_; row += gridDim.x * 8) {
        const int b = row >> 12; const float* mb = mod + (size_t)b * 6144;
        f32x4 v[4]; float ss = 0.f;
#pragma unroll
        for (int i = 0; i < 4; ++i) {
            if (first) v[i] = *(const f32x4*)(P.x_in + (size_t)row * 1024 + i * 256 + lane * 4);
            else { const u32x2 w = *(const u32x2*)(XB + (size_t)row * 1024 + i * 256 + lane * 4); v[i] = (f32x4){bflo(w.x), bfhi(w.x), bflo(w.y), bfhi(w.y)}; }
            ss += v[i][0] * v[i][0] + v[i][1] * v[i][1] + v[i][2] * v[i][2] + v[i][3] * v[i][3]; }
        ss = wave_sum(ss, lane);
        const float rstd = rsqrtf(ss * (1.0f / 1024.0f) + 1e-6f);
#pragma unroll
        for (int i = 0; i < 4; ++i) { const int c = i * 256 + lane * 4;
            const f32x4 g = *(const f32x4*)(nw + c), sh = *(const f32x4*)(mb + c), sc = *(const f32x4*)(mb + 1024 + c);
            const f32x4 y = v[i] * rstd * g * (sc + 1.0f) + sh;
            u32x2 w; w.x = cvt_pk_bf16(y[0], y[1]); w.y = cvt_pk_bf16(y[2], y[3]);
            *(u32x2*)(H + (size_t)row * 1024 + c) = w; }
    }
}

__device__ __forceinline__ void ph_final(const Params& P) {
    const bf16_t* XF = (const bf16_t*)(P.ws + OFF_H);
    const int tid = opaque_tid(), wid = tid >> 6, lane = tid & 63;
    for (int row = blockIdx.x * 8 + wid; row < T_; row += gridDim.x * 8) {
        float* xr = P.out + (size_t)row * 1024;
        f32x4 v[4]; float ss = 0.f;
#pragma unroll
        for (int i = 0; i < 4; ++i) { const u32x2 w = *(const u32x2*)(XF + (size_t)row * 1024 + i * 256 + lane * 4); v[i] = (f32x4){bflo(w.x), bfhi(w.x), bflo(w.y), bfhi(w.y)};
            ss += v[i][0] * v[i][0] + v[i][1] * v[i][1] + v[i][2] * v[i][2] + v[i][3] * v[i][3]; }
        ss = wave_sum(ss, lane);
        const float rstd = rsqrtf(ss * (1.0f / 1024.0f) + 1e-6f);
#pragma unroll
        for (int i = 0; i < 4; ++i) { const int c = i * 256 + lane * 4; const f32x4 g = *(const f32x4*)(P.final_norm + c);
            *(f32x4*)(xr + c) = v[i] * rstd * g; }
    }
}

__device__ __forceinline__ void ph_gemm_zq(const Params& P, LAS unsigned char* lds) {
    g8::SOrder S; S.init(T_, 2304, 1024, 1024, P.ws + OFF_H, P.ws + OFF_WB + WB_WIN);
    g8::EpiBf E{(bf16_t*)(P.ws + OFF_ZQ), 2304, 9, nullptr, 0, 0};
    g8::gemm_phase(lds, 1024, 1024, 1024, S, E);
}
__device__ __forceinline__ void ph_gemm_zr(const Params& P, LAS unsigned char* lds) {
    g8::SOrder S; S.init(T_, 1792, 1024, 1024, P.ws + OFF_H, P.ws + OFF_WB + WB_WIN + (size_t)2304 * 1024 * 2);
    g8::EpiBf E{(bf16_t*)(P.ws + OFF_ZR), 1792, 7, nullptr, 0, 0};
    g8::gemm_phase(lds, 1024, 1024, 1024, S, E);
}
__device__ __forceinline__ void ph_gemm_zc(const Params& P, LAS unsigned char* lds) {
    g8::SOrder S; S.init(T_, 4608, 1024, 1024, P.ws + OFF_H, P.ws + OFF_WB + WB_WIN + (size_t)4096 * 1024 * 2);
    g8::EpiBf E{(bf16_t*)(P.ws + OFF_ZCV), 1536, 6, (bf16_t*)(P.ws + OFF_ZG), 3072, 1};
    g8::gemm_phase(lds, 1024, 1024, 1024, S, E);
}
__device__ __forceinline__ void ph_gemm_merge(const Params& P, LAS unsigned char* lds) {
    g8::MergeOrder S{(int)gridDim.x, (int)blockIdx.x, (const char*)(P.ws + OFF_OATT), (const char*)(P.ws + OFF_WB + WB_WBR)};
    g8::EpiMerge E{(bf16_t*)(P.ws + OFF_MRG), (const bf16_t*)(P.ws + OFF_ZG)};
    g8::gemm_phase(lds, 512, 512, 512, S, E);
}
__device__ __forceinline__ void ph_gemm_wo(const Params& P, int l, LAS unsigned char* lds) {
    g8::SOrder S; S.init(T_, 1024, 1024, 1024, P.ws + OFF_MRG, P.ws + OFF_WB + WB_WO);
    g8::EpiRes E{l == 0 ? P.x_in : nullptr, (const bf16_t*)P.out, (bf16_t*)P.out, (const float*)(P.ws + OFF_MOD) + (size_t)l * 8 * 6144 + 2048};
    g8::gemm_phase(lds, 1024, 1024, 1024, S, E);
}
__device__ __forceinline__ void ph_gemm_up(const Params& P, int l, LAS unsigned char* lds) {
    g8::SOrder S; S.init(T_, 5632, 1024, 1024, P.ws + OFF_H, P.ws + OFF_WB + WB_WUP);
    g8::EpiUp E{(bf16_t*)(P.ws + OFF_UP), (float*)(P.ws + OFF_HA), (float*)(P.ws + OFF_HB), P.ffn_conv_w + (size_t)l * DFF * 3};
    g8::gemm_phase(lds, 1024, 1024, 1024, S, E);
}
__device__ __forceinline__ void ph_gemm_down(const Params& P, int l, LAS unsigned char* lds) {
    g8::SOrder S; S.init(T_, 1024, 2816, 2816, P.ws + OFF_UP, P.ws + OFF_WB + WB_WDN);
    g8::EpiRes E{nullptr, (const bf16_t*)P.out, l == 1 ? (bf16_t*)(P.ws + OFF_H) : (bf16_t*)P.out, (const float*)(P.ws + OFF_MOD) + (size_t)l * 8 * 6144 + 5120};
    g8::gemm_phase(lds, 2816, 2816, 2816, S, E);
}

__device__ __forceinline__ void ph_conv(const Params& P, int l, LAS unsigned char* lds) {
    const bf16_t* Z = (const bf16_t*)(P.ws + OFF_ZCV); bf16_t* O = (bf16_t*)(P.ws + OFF_OCONV);
    LAS float* cwT = (LAS float*)lds;
    const int tid = opaque_tid();
    for (int i = tid; i < 1536; i += NTHR) cwT[(i % 3) * 512 + i / 3] = P.sc_conv_w[(size_t)l * 1536 + i];
    __syncthreads();
    constexpr int RB = 16; const int nitem = (T_ / RB) * 64;
    for (int it = blockIdx.x * NTHR + tid; it < nitem; it += gridDim.x * NTHR) {
        const int rb = it >> 6, c0 = (it & 63) * 8, row0 = rb * RB, t0 = row0 & 4095;
        float w0[8], w1[8], w2[8];
#pragma unroll
        for (int e = 0; e < 8; ++e) { w0[e] = cwT[c0 + e]; w1[e] = cwT[512 + c0 + e]; w2[e] = cwT[1024 + c0 + e]; }
        float pm2[8], pm1[8];
#pragma unroll
        for (int e = 0; e < 8; ++e) { pm2[e] = 0.f; pm1[e] = 0.f; }
        if (t0 >= 2) {
#pragma unroll
            for (int j = 0; j < 2; ++j) { const bf16_t* zr = Z + (size_t)(row0 - 2 + j) * 1536;
                const u32x4 cc = *(const u32x4*)(zr + 512 + c0), cx = *(const u32x4*)(zr + 1024 + c0);
                const unsigned ccw[4] = {cc.x, cc.y, cc.z, cc.w}, cxw[4] = {cx.x, cx.y, cx.z, cx.w};
#pragma unroll
                for (int q = 0; q < 4; ++q) { const float a = bflo(ccw[q]) * bflo(cxw[q]), b2 = bfhi(ccw[q]) * bfhi(cxw[q]);
                    if (j == 0) { pm2[2 * q] = a; pm2[2 * q + 1] = b2; } else { pm1[2 * q] = a; pm1[2 * q + 1] = b2; } } }
        }
#pragma unroll 4
        for (int r = 0; r < RB; ++r) {
            const bf16_t* zr = Z + (size_t)(row0 + r) * 1536;
            const u32x4 cb = *(const u32x4*)(zr + c0), cc = *(const u32x4*)(zr + 512 + c0), cx = *(const u32x4*)(zr + 1024 + c0);
            const unsigned cbw[4] = {cb.x, cb.y, cb.z, cb.w}, ccw[4] = {cc.x, cc.y, cc.z, cc.w}, cxw[4] = {cx.x, cx.y, cx.z, cx.w};
            float cur[8], o[8];
#pragma unroll
            for (int q = 0; q < 4; ++q) { cur[2 * q] = bflo(ccw[q]) * bflo(cxw[q]); cur[2 * q + 1] = bfhi(ccw[q]) * bfhi(cxw[q]); }
#pragma unroll
            for (int e = 0; e < 8; ++e) { o[e] = w0[e] * pm2[e] + w1[e] * pm1[e] + w2[e] * cur[e]; pm2[e] = pm1[e]; pm1[e] = cur[e]; }
            u32x4 w; w.x = cvt_pk_bf16(o[0] * bflo(cbw[0]), o[1] * bfhi(cbw[0])); w.y = cvt_pk_bf16(o[2] * bflo(cbw[1]), o[3] * bfhi(cbw[1]));
            w.z = cvt_pk_bf16(o[4] * bflo(cbw[2]), o[5] * bfhi(cbw[2])); w.w = cvt_pk_bf16(o[6] * bflo(cbw[3]), o[7] * bfhi(cbw[3]));
            *(u32x4*)(O + (size_t)(row0 + r) * 512 + c0) = w;
        }
    }
}

__device__ __forceinline__ void ph_ufix(const Params& P, int l, LAS unsigned char* lds) {
    bf16_t* U = (bf16_t*)(P.ws + OFF_UP); const float* HA = (const float*)(P.ws + OFF_HA); const float* HB = (const float*)(P.ws + OFF_HB);
    LAS float* cwT = (LAS float*)lds;
    const int tid = opaque_tid();
    for (int i = tid; i < DFF * 3; i += NTHR) cwT[(i % 3) * DFF + i / 3] = P.ffn_conv_w[(size_t)l * DFF * 3 + i];
    __syncthreads();
    const int nitem = (T_ / 64) * 2 * 352;
    for (int it = blockIdx.x * NTHR + tid; it < nitem; it += gridDim.x * NTHR) {
        const int c0 = (it % 352) * 8, gr = it / 352, grp = gr >> 1, rr = gr & 1; const bool first = (grp & 63) == 0;
        const float* hb = HB + ((size_t)(grp * 2 + rr) * 2) * DFF + c0;
        float a0[8], a1[8], a2[8], g[8];
#pragma unroll
        for (int q = 0; q < 2; ++q) { const f32x4 va = *(const f32x4*)(hb + 4 * q), vg = *(const f32x4*)(hb + DFF + 4 * q);
#pragma unroll
            for (int e = 0; e < 4; ++e) { a0[4 * q + e] = va[e]; g[4 * q + e] = vg[e]; a1[4 * q + e] = 0.f; a2[4 * q + e] = 0.f; } }
        if (rr == 1) { const float* p1 = HB + ((size_t)(grp * 2) * 2) * DFF + c0;
#pragma unroll
            for (int q = 0; q < 2; ++q) { const f32x4 v = *(const f32x4*)(p1 + 4 * q);
#pragma unroll
                for (int e = 0; e < 4; ++e) a1[4 * q + e] = v[e]; } }
        if (!first) {
            const float* pl = HA + (size_t)((grp - 1) * 2 + 1) * DFF + c0;
            const float* pk = HA + (size_t)((grp - 1) * 2) * DFF + c0;
#pragma unroll
            for (int q = 0; q < 2; ++q) { const f32x4 v63 = *(const f32x4*)(pl + 4 * q), v62 = *(const f32x4*)(pk + 4 * q);
#pragma unroll
                for (int e = 0; e < 4; ++e) { if (rr == 1) a2[4 * q + e] = v63[e]; else { a1[4 * q + e] = v63[e]; a2[4 * q + e] = v62[e]; } } }
        }
        float o[8];
#pragma unroll
        for (int e = 0; e < 8; ++e) { const float s = cwT[c0 + e] * a2[e] + cwT[DFF + c0 + e] * a1[e] + cwT[2 * DFF + c0 + e] * a0[e]; o[e] = s * sigmoidf_(s) * g[e]; }
        u32x4 w; w.x = cvt_pk_bf16(o[0], o[1]); w.y = cvt_pk_bf16(o[2], o[3]); w.z = cvt_pk_bf16(o[4], o[5]); w.w = cvt_pk_bf16(o[6], o[7]);
        *(u32x4*)(U + (size_t)(grp * 64 + rr) * DFF + c0) = w;
    }
}

template <int NR>
__device__ __forceinline__ u64 select_row(LAS float* row, const int t, const int lz) {
    const int imax = t >> 6;
    float x[NR]; float Tx = 0.f; bool have = false, exact = false;
    {
        int bin[NR]; float lo = __builtin_inff(), hi = -__builtin_inff();
        LAS unsigned* hist = (LAS unsigned*)row;
#pragma unroll
        for (int i = 0; i < NR; ++i) { const float v = row[64 * i + lz]; x[i] = (i <= imax) ? v : -__builtin_inff(); hi = fmaxf(hi, x[i]); lo = fminf(lo, (i < imax || x[i] > -__builtin_inff()) ? x[i] : __builtin_inff()); }
#pragma unroll
        for (int o = 32; o >= 1; o >>= 1) { lo = fminf(lo, shx(lo, o, lz)); hi = fmaxf(hi, shx(hi, o, lz)); }
        if (hi > lo) {
            const float scale = 4095.0f / (hi - lo);
#pragma unroll
            for (int q = 0; q < 16; ++q) *(LAS u32x4*)(hist + 256 * q + 4 * lz) = (u32x4){0u, 0u, 0u, 0u};
#pragma unroll
            for (int i = 0; i < NR; ++i) {
                const int bq = (int)fminf(fmaxf((x[i] - lo) * scale, -1.0f), 4095.0f); bin[i] = bq;
                if (bq >= 0) __hip_atomic_fetch_add(hist + bq, 1u, __ATOMIC_RELAXED, __HIP_MEMORY_SCOPE_WORKGROUP); }
            unsigned c1 = 0u;
#pragma unroll
            for (int q = 0; q < 16; ++q) { const u32x4 h4 = *(const LAS u32x4*)(hist + 64 * lz + 4 * ((q + lz) & 15)); c1 += (h4.x + h4.y) + (h4.z + h4.w); }
            unsigned inc = c1;
#pragma unroll
            for (int o = 1; o <= 32; o <<= 1) { const unsigned v = (unsigned)__builtin_amdgcn_ds_bpermute(((lz + o) & 63) << 2, (int)inc); inc += (lz + o < 64) ? v : 0u; }
            const unsigned ab1 = inc - c1;
            const u64 cr1 = __ballot(ab1 < 256u && ab1 + c1 >= 256u);
            const int L1 = __builtin_ctzll(cr1);
            const unsigned abL = (unsigned)__builtin_amdgcn_readlane((int)ab1, L1);
            const unsigned c2 = hist[64 * L1 + lz];
            unsigned inc2 = c2;
#pragma unroll
            for (int o = 1; o <= 32; o <<= 1) { const unsigned v = (unsigned)__builtin_amdgcn_ds_bpermute(((lz + o) & 63) << 2, (int)inc2); inc2 += (lz + o < 64) ? v : 0u; }
            const unsigned ab2 = inc2 - c2 + abL;
            const u64 cr2 = __ballot(ab2 < 256u && ab2 + c2 >= 256u);
            const int L2 = __builtin_ctzll(cr2);
            const int bstar = 64 * L1 + L2;
            const int cb = __builtin_amdgcn_readlane((int)c2, L2), need2 = 256 - __builtin_amdgcn_readlane((int)ab2, L2);
            if (cb <= 64) {
                int cand = 0; int pos = 0;
#pragma unroll
                for (int i = 0; i < NR; ++i) { u64 mm = __ballot(bin[i] == bstar);
                    while (mm) { const int s = __builtin_ctzll(mm); mm &= mm - 1ull; cand = writelane_v(cand, __builtin_amdgcn_readlane(__float_as_int(x[i]), s), pos); ++pos; } }
                const unsigned cu = (lz < cb) ? f2ord(__int_as_float(cand)) : 0u;
                unsigned Tc = 0u;
#pragma unroll 1
                for (int bit = 31; bit >= 0; --bit) { const unsigned cd = Tc | (1u << bit); if ((int)__popcll(__ballot(cu >= cd)) >= need2) Tc = cd; }
                Tx = ord2f(Tc); have = true; exact = (256 - need2) + (int)__popcll(__ballot(cu >= Tc)) == 256;
            }
        }
    }
    if (!have) {
        unsigned Tt = 0u;
#pragma unroll 1
        for (int bit = 31; bit >= 0; --bit) {
            const unsigned cand = Tt | (1u << bit); int cnt = 0;
#pragma unroll
            for (int i = 0; i < NR; ++i) cnt += __popcll(__ballot(f2ord(x[i]) >= cand));
            if (cnt >= 256) Tt = cand;
        }
        Tx = ord2f(Tt);
    }
    int wlo = 0, whi = 0;
#pragma unroll
    for (int i = 0; i < NR; ++i) { const u64 g = __ballot(x[i] >= Tx); writelane_c2(wlo, whi, (int)(unsigned)g, (int)(unsigned)(g >> 32), i); }
    u64 myw = ((u64)(unsigned)whi << 32) | (unsigned)wlo;
    if (!exact) {
        int cgt = 0;
#pragma unroll
        for (int i = 0; i < NR; ++i) cgt += __popcll(__ballot(x[i] > Tx));
        int need = 256 - cgt; myw = 0ull;
#pragma unroll
        for (int i = 0; i < NR; ++i) {
            const u64 g = __ballot(x[i] > Tx); u64 e = __ballot(x[i] == Tx);
            int ne = __popcll(e);
            while (ne > need) { e &= ~(1ull << (63 - __clzll(e))); --ne; }
            need -= ne;
            if (lz == i) myw = g | e;
        }
    }
    return myw;
}

__device__ __forceinline__ void ph_idx(const Params& P, LAS unsigned char* lds) {
    LAS float* SC = (LAS float*)lds;
    const bf16_t* ZQ = (const bf16_t*)(P.ws + OFF_ZQ); u64* MASK = (u64*)(P.ws + OFF_MASK);
    const int tid = opaque_tid(), wid = __builtin_amdgcn_readfirstlane(tid >> 6), lane = tid & 63, m = lane & 31, hh = lane >> 5;
    { int* KPM = (int*)(P.ws + OFF_KPM);
      for (int i = blockIdx.x * NTHR + tid; i < NB_ * 64; i += gridDim.x * NTHR) { const int* pp = P.pos + (i >> 6) * S_ + (i & 63) * 64; int mxp = pp[0];
          for (int k = 1; k < 64; ++k) mxp = pp[k] > mxp ? pp[k] : mxp;
          KPM[i] = mxp; } }
    int itc = 0;
    for (int idx = blockIdx.x; idx < NB_ * 512; idx += gridDim.x, ++itc) {
        const int b = idx & 7, j = idx >> 3; const int qb = (itc & 1) ? (j ^ 31) : j; const int t0 = qb * 8;
        const bf16_t* zb = ZQ + (size_t)b * S_ * 2304;
        bf16x8 Af[2][4]; float wv[2][16];
#pragma unroll
        for (int blk = 0; blk < 2; ++blk) {
            const bf16_t* qp = zb + (size_t)(t0 + 4 * blk + 2 * ((m >> 2) & 1) + (m >> 4)) * 2304 + 1536 + (4 * ((m >> 3) & 1) + (m & 3)) * 64 + 8 * hh;
#pragma unroll
            for (int ks = 0; ks < 4; ++ks) Af[blk][ks] = *(const bf16x8*)(qp + 16 * ks);
#pragma unroll
            for (int q = 0; q < 2; ++q) { const u32x4 ww = *(const u32x4*)(zb + (size_t)(t0 + 4 * blk + 2 * hh + q) * 2304 + 2112);
                wv[blk][8 * q + 0] = bflo(ww.x); wv[blk][8 * q + 1] = bfhi(ww.x); wv[blk][8 * q + 2] = bflo(ww.y); wv[blk][8 * q + 3] = bfhi(ww.y);
                wv[blk][8 * q + 4] = bflo(ww.z); wv[blk][8 * q + 5] = bfhi(ww.z); wv[blk][8 * q + 6] = bflo(ww.w); wv[blk][8 * q + 7] = bfhi(ww.w); }
        }
        const int ntile = 2 * ((t0 + 7) / 64 + 1);
        for (int kt = wid; kt < ntile; kt += 8) {
            const bf16_t* kp = zb + (size_t)(32 * kt + m) * 2304 + 2048 + 8 * hh;
            bf16x8 Bf[4];
#pragma unroll
            for (int ks = 0; ks < 4; ++ks) Bf[ks] = *(const bf16x8*)(kp + 16 * ks);
#pragma unroll
            for (int blk = 0; blk < 2; ++blk) {
                f32x16 Dv;
#pragma unroll
                for (int r = 0; r < 16; ++r) Dv[r] = 0.f;
#pragma unroll
                for (int ks = 0; ks < 4; ++ks) Dv = __builtin_amdgcn_mfma_f32_32x32x16_bf16(Af[blk][ks], Bf[ks], Dv, 0, 0, 0);
#pragma unroll
                for (int q = 0; q < 2; ++q) {
                    float part = 0.f;
#pragma unroll
                    for (int e = 0; e < 8; ++e) { const float d = Dv[8 * q + e], w = wv[blk][8 * q + e]; part = __builtin_fmaf(w, d, part); part = __builtin_fmaf(w, __builtin_fabsf(d), part); }
                    SC[(4 * blk + 2 * hh + q) * 4096 + 32 * kt + m] = (32 * kt + m <= t0 + 4 * blk + 2 * hh + q) ? part : -__builtin_inff();
                }
            }
        }
        __syncthreads();
        {
            const int t = t0 + wid; u64* mrow = MASK + (size_t)(b * S_ + t) * 64;
            if (t < 256) {
                const int lo = 64 * lane; u64 w;
                if (t >= lo + 63) w = ~0ull; else if (t < lo) w = 0ull; else w = (2ull << (t - lo)) - 1ull;
                mrow[lane] = w;
            } else {
                int lz = threadIdx.x; asm volatile("" : "+v"(lz)); lz &= 63;
                LAS float* rowp = SC + wid * 4096; u64 myw;
                if (t < 512) myw = select_row<8>(rowp, t, lz); else if (t < 1024) myw = select_row<16>(rowp, t, lz); else if (t < 2048) myw = select_row<32>(rowp, t, lz); else myw = select_row<64>(rowp, t, lz);
                mrow[lz] = myw;
            }
        }
        __syncthreads();
    }
    {
        LAS bf16_t* tl = (LAS bf16_t*)lds;
        bf16_t* VT = (bf16_t*)(P.ws + OFF_VT);
        for (int it = blockIdx.x; it < NB_ * 8 * 64; it += gridDim.x) {
            const int b = it >> 9, h = (it >> 6) & 7, k0 = (it & 63) * 64;
            { const int row = tid >> 3, ch = tid & 7;
              const u32x4 v = *(const u32x4*)(ZQ + (size_t)(b * S_ + k0 + row) * 2304 + 1024 + h * 64 + ch * 8);
              *(LAS u32x4*)(tl + row * 72 + ch * 8) = v; }
            __syncthreads();
            { const int d = tid >> 3, kc = tid & 7; unsigned short e[8];
#pragma unroll
              for (int q = 0; q < 8; ++q) e[q] = tl[(kc * 8 + q) * 72 + d];
              u32x4 w; w.x = e[0] | ((unsigned)e[1] << 16); w.y = e[2] | ((unsigned)e[3] << 16); w.z = e[4] | ((unsigned)e[5] << 16); w.w = e[6] | ((unsigned)e[7] << 16);
              *(u32x4*)(VT + ((size_t)((b * 8 + h) * 64 + d)) * S_ + k0 + kc * 8) = w; }
            __syncthreads();
        }
    }
}

__device__ __forceinline__ void ph_att(const Params& P, LAS unsigned char* lds) {
    LAS float* TABL = (LAS float*)lds;
    LAS unsigned char* KB = lds + 4096;
    constexpr int KT_B = 64 * 144, VT_B = 64 * 136, BUF_B = KT_B + VT_B;
    constexpr float LOG2E = 1.4426950408889634f;
    const float* tabg = (const float*)(P.ws + OFF_TAB);
    const int tid = opaque_tid(), wid = __builtin_amdgcn_readfirstlane(tid >> 6), lane = tid & 63, m = lane & 31, hh = lane >> 5;
    for (int i = tid; i < 1024; i += NTHR) TABL[i] = tabg[i] * LOG2E;
    __syncthreads();
    const bf16_t* ZQ = (const bf16_t*)(P.ws + OFF_ZQ); const u64* MASK = (const u64*)(P.ws + OFF_MASK);
    const bf16_t* VT = (const bf16_t*)(P.ws + OFF_VT); bf16_t* OA = (bf16_t*)(P.ws + OFF_OATT); const int* KPM = (const int*)(P.ws + OFF_KPM);
    int itc = 0;
    for (int idx = blockIdx.x; idx < NB_ * 8 * 16; idx += gridDim.x, ++itc) {
        const int b = idx & 7, head = (idx >> 3) & 7, j = idx >> 6; const int qb = (itc & 1) ? (j ^ 3) : j;
        const int q0 = qb * 256, tq0 = q0 + 32 * wid, t = tq0 + m;
        const bf16_t* zb = ZQ + (size_t)b * S_ * 2304;
        bf16x8 Qf[4];
        { const bf16_t* qp = zb + (size_t)t * 2304 + head * 64 + 8 * hh;
#pragma unroll
          for (int ks = 0; ks < 4; ++ks) Qf[ks] = *(const bf16x8*)(qp + 16 * ks); }
        const int posq = P.pos[b * S_ + t];
        int minq = posq;
#pragma unroll
        for (int o = 32; o >= 1; o >>= 1) { const int v = shxi(minq, o, lane); minq = v < minq ? v : minq; }
        minq = __builtin_amdgcn_readfirstlane(minq);
        const u64* mrow = MASK + (size_t)(b * S_ + t) * 64;
        const bf16_t* vtb = VT + (size_t)(b * 8 + head) * 64 * S_;
        const float c1 = 0.125f * LOG2E, c2 = TABL[127 * 8 + head];
        f32x16 O0, O1, OL;
#pragma unroll
        for (int r = 0; r < 16; ++r) { O0[r] = 0.f; O1[r] = 0.f; OL[r] = 0.f; }
        const bf16x8 ones8 = {0x3F80, 0x3F80, 0x3F80, 0x3F80, 0x3F80, 0x3F80, 0x3F80, 0x3F80};
        float m_run = -1e30f;
        const int nt = 4 * qb + 4, my_nt = ((tq0 + 31) >> 6) + 1;
        const int skey = tid >> 3, sch = tid & 7;
        const bf16_t* kg = zb + (size_t)skey * 2304 + 512 + head * 64 + 8 * sch;
        const bf16_t* vg = vtb + (size_t)skey * S_ + 8 * sch;
        LAS unsigned char* kdst = KB + skey * 144 + sch * 16; LAS unsigned char* vdst = KB + KT_B + skey * 136 + sch * 16;
        u64 mw_nxt = mrow[0]; const int kpm_l = KPM[b * 64 + lane];
        auto tile = [&](const int kt, const int boff) {
                const LAS unsigned char* Kt = KB + boff; const LAS unsigned char* Vt = Kt + KT_B;
                f32x16 D0, D1;
#pragma unroll
                for (int r = 0; r < 16; ++r) { D0[r] = 0.f; D1[r] = 0.f; }
#pragma unroll
                for (int ks = 0; ks < 4; ++ks) {
                    const bf16x8 K0 = *(const LAS bf16x8*)(Kt + m * 144 + 32 * ks + 16 * hh), K1 = *(const LAS bf16x8*)(Kt + (32 + m) * 144 + 32 * ks + 16 * hh);
                    D0 = __builtin_amdgcn_mfma_f32_32x32x16_bf16(K0, Qf[ks], D0, 0, 0, 0); D1 = __builtin_amdgcn_mfma_f32_32x32x16_bf16(K1, Qf[ks], D1, 0, 0, 0); }
                const u64 mw = mw_nxt; mw_nxt = mrow[kt + 1 < 64 ? kt + 1 : kt];
                const int w0 = (int)((unsigned)mw >> (4 * hh)), w1 = (int)((unsigned)(mw >> 32) >> (4 * hh));
                float xe[32]; float esc, eoff0;
                if (minq - __builtin_amdgcn_readlane(kpm_l, kt) >= 127) {
#pragma unroll
                    for (int r = 0; r < 16; ++r) { xe[r] = D0[r]; xe[16 + r] = D1[r]; }
                    esc = c1; eoff0 = c2;
                } else {
#pragma unroll
                    for (int mb = 0; mb < 2; ++mb)
#pragma unroll
                        for (int g = 0; g < 4; ++g) {
                            const i32x4 pk = *(const i32x4*)(P.pos + b * S_ + 64 * kt + 32 * mb + 8 * g + 4 * hh);
#pragma unroll
                            for (int e = 0; e < 4; ++e) { const int r = 4 * g + e; int n = posq - pk[e]; n = n < 0 ? 0 : (n > 127 ? 127 : n);
                                xe[16 * mb + r] = (mb ? D1[r] : D0[r]) * c1 + TABL[n * 8 + head]; }
                        }
                    esc = 1.0f; eoff0 = 0.f;
                }
                float mx = __builtin_fmaxf(__builtin_fmaxf(xe[0], xe[1]), xe[2]);
#pragma unroll
                for (int r = 3; r < 31; r += 2) mx = __builtin_fmaxf(__builtin_fmaxf(mx, xe[r]), xe[r + 1]);
                mx = fmaxf(mx, xe[31]);
                mx = fmaxf(mx, shx(mx, 32, lane));
                const float m_new = fmaxf(m_run, mx * esc + eoff0); const float alpha = __builtin_amdgcn_exp2f(m_run - m_new); m_run = m_new;
                const float eoff = eoff0 - m_new;
#pragma unroll
                for (int r = 0; r < 16; ++r) {
                    const int bp = (r & 3) + 8 * (r >> 2);
                    xe[r] = __int_as_float(__float_as_int(__builtin_amdgcn_exp2f(xe[r] * esc + eoff)) & __builtin_amdgcn_sbfe(w0, bp, 1));
                    xe[16 + r] = __int_as_float(__float_as_int(__builtin_amdgcn_exp2f(xe[16 + r] * esc + eoff)) & __builtin_amdgcn_sbfe(w1, bp, 1)); }
                if (!__all(alpha == 1.0f)) {
#pragma unroll
                    for (int r = 0; r < 16; ++r) { O0[r] *= alpha; O1[r] *= alpha; OL[r] *= alpha; } }
#pragma unroll
                for (int s = 0; s < 4; ++s) {
                    u32x4 pw; pw.x = cvt_pk_bf16(xe[8 * s + 0], xe[8 * s + 1]); pw.y = cvt_pk_bf16(xe[8 * s + 2], xe[8 * s + 3]); pw.z = cvt_pk_bf16(xe[8 * s + 4], xe[8 * s + 5]); pw.w = cvt_pk_bf16(xe[8 * s + 6], xe[8 * s + 7]);
                    const bf16x8 Pf = __builtin_bit_cast(bf16x8, pw);
                    const LAS unsigned char* vp = Vt + m * 136 + (16 * s + 4 * hh) * 2;
                    { const u32x2 va = *(const LAS u32x2*)vp, vb = *(const LAS u32x2*)(vp + 16); u32x4 vw; vw.x = va.x; vw.y = va.y; vw.z = vb.x; vw.w = vb.y;
                      O0 = __builtin_amdgcn_mfma_f32_32x32x16_bf16(__builtin_bit_cast(bf16x8, vw), Pf, O0, 0, 0, 0); }
                    { const u32x2 va = *(const LAS u32x2*)(vp + 32 * 136), vb = *(const LAS u32x2*)(vp + 32 * 136 + 16); u32x4 vw; vw.x = va.x; vw.y = va.y; vw.z = vb.x; vw.w = vb.y;
                      O1 = __builtin_amdgcn_mfma_f32_32x32x16_bf16(__builtin_bit_cast(bf16x8, vw), Pf, O1, 0, 0, 0); }
                    OL = __builtin_amdgcn_mfma_f32_32x32x16_bf16(ones8, Pf, OL, 0, 0, 0);
                }
        };
        __syncthreads();
        constexpr int SUB_B = KT_B + VT_B, SUP_B = 2 * SUB_B;
        const int nst = nt >> 1;
        u32x4 ka0, kb0, va0, vb0, ka1, kb1, va1, vb1;
#define ATT_LOAD(KA, KB_, VA, VB, ST) do { KA = *(const u32x4*)(kg + (size_t)(2 * (ST)) * 64 * 2304); KB_ = *(const u32x4*)(kg + (size_t)(2 * (ST) + 1) * 64 * 2304); \
            VA = *(const u32x4*)(vg + (2 * (ST)) * 64); VB = *(const u32x4*)(vg + (2 * (ST) + 1) * 64); } while (0)
#define ATT_STORE(KA, KB_, VA, VB, BUF) do { LAS unsigned char* kd_ = kdst + (BUF) * SUP_B; LAS unsigned char* vd_ = vdst + (BUF) * SUP_B; \
            *(LAS u32x4*)kd_ = KA; *(LAS u32x2*)vd_ = (u32x2){VA.x, VA.y}; *(LAS u32x2*)(vd_ + 8) = (u32x2){VA.z, VA.w}; \
            *(LAS u32x4*)(kd_ + SUB_B) = KB_; *(LAS u32x2*)(vd_ + SUB_B) = (u32x2){VB.x, VB.y}; *(LAS u32x2*)(vd_ + SUB_B + 8) = (u32x2){VB.z, VB.w}; } while (0)
        ATT_LOAD(ka0, kb0, va0, vb0, 0); ATT_STORE(ka0, kb0, va0, vb0, 0);
        if (nst > 1) ATT_LOAD(ka1, kb1, va1, vb1, 1);
        __syncthreads();
        for (int st = 0; st < nst; st += 2) {
            if (st + 2 < nst) ATT_LOAD(ka0, kb0, va0, vb0, st + 2);
            if (2 * st < my_nt) tile(2 * st, 0);
            if (2 * st + 1 < my_nt) tile(2 * st + 1, SUB_B);
            if (st + 1 < nst) ATT_STORE(ka1, kb1, va1, vb1, 1);
            __syncthreads();
            if (st + 1 >= nst) break;
            if (st + 3 < nst) ATT_LOAD(ka1, kb1, va1, vb1, st + 3);
            if (2 * st + 2 < my_nt) tile(2 * st + 2, SUP_B);
            if (2 * st + 3 < my_nt) tile(2 * st + 3, SUP_B + SUB_B);
            if (st + 2 < nst) ATT_STORE(ka0, kb0, va0, vb0, 0);
            __syncthreads();
        }
#undef ATT_LOAD
#undef ATT_STORE
        const float inv = __builtin_amdgcn_rcpf(OL[0]);
        bf16_t* op = OA + (size_t)(b * S_ + t) * 512 + head * 64 + 4 * hh;
#pragma unroll
        for (int g = 0; g < 4; ++g) {
            u32x2 wa; wa.x = cvt_pk_bf16(O0[4 * g] * inv, O0[4 * g + 1] * inv); wa.y = cvt_pk_bf16(O0[4 * g + 2] * inv, O0[4 * g + 3] * inv);
            *(u32x2*)(op + 8 * g) = wa;
            u32x2 wb; wb.x = cvt_pk_bf16(O1[4 * g] * inv, O1[4 * g + 1] * inv); wb.y = cvt_pk_bf16(O1[4 * g + 2] * inv, O1[4 * g + 3] * inv);
            *(u32x2*)(op + 32 + 8 * g) = wb;
        }
    }
}

#define DSR4(A, addr, o0, o1, o2, o3) asm volatile("ds_read_b128 %0, %4 offset:%5\n\tds_read_b128 %1, %4 offset:%6\n\tds_read_b128 %2, %4 offset:%7\n\tds_read_b128 %3, %4 offset:%8" \
    : "=&v"(A[0]), "=&v"(A[1]), "=&v"(A[2]), "=&v"(A[3]) : "v"(addr), "i"(o0), "i"(o1), "i"(o2), "i"(o3))
#define DSW(A, N) asm volatile("s_waitcnt lgkmcnt(" #N ")" : "+v"(A[0]), "+v"(A[1]), "+v"(A[2]), "+v"(A[3]))
#define SCAN_A(X, G) _Pragma("unroll") for (int i_ = 0; i_ < 4; ++i_) { const f32x2 k01 = {X[i_][0], X[i_][1]}, k23 = {X[i_][2], X[i_][3]}; \
    sa0 += S2[8 * G + 2 * i_] * k01; sa1 += S2[8 * G + 2 * i_ + 1] * k23; sp0 += Pm2[8 * G + 2 * i_] * k01; sp1 += Pm2[8 * G + 2 * i_ + 1] * k23; }
#define SCAN_B(X, C) { const int j = 2 * C; \
    { const f32x2 w = {X[0][0], X[0][1]}, kb = {X[1][0], X[1][1]}, kk = {X[2][0], X[2][1]}, rr = {X[3][0], X[3][1]}; \
      S2[j] = S2[j] * w + sav * kb + vv2 * kk; Pm2[j] = Pm2[j] * w + spv * kb; y0 += S2[j] * rr; p0 += Pm2[j] * rr; } \
    { const f32x2 w = {X[0][2], X[0][3]}, kb = {X[1][2], X[1][3]}, kk = {X[2][2], X[2][3]}, rr = {X[3][2], X[3][3]}; \
      S2[j + 1] = S2[j + 1] * w + sav * kb + vv2 * kk; Pm2[j + 1] = Pm2[j + 1] * w + spv * kb; y1 += S2[j + 1] * rr; p1 += Pm2[j + 1] * rr; } }
__device__ __forceinline__ float wave_sum_dpp(float v) {
    v += __int_as_float(__builtin_amdgcn_update_dpp(0, __float_as_int(v), 0x111, 0xf, 0xf, true));
    v += __int_as_float(__builtin_amdgcn_update_dpp(0, __float_as_int(v), 0x112, 0xf, 0xf, true));
    v += __int_as_float(__builtin_amdgcn_update_dpp(0, __float_as_int(v), 0x114, 0xf, 0xf, true));
    v += __int_as_float(__builtin_amdgcn_update_dpp(0, __float_as_int(v), 0x118, 0xf, 0xf, true));
    v += __int_as_float(__builtin_amdgcn_update_dpp(0, __float_as_int(v), 0x142, 0xa, 0xf, false));
    v += __int_as_float(__builtin_amdgcn_update_dpp(0, __float_as_int(v), 0x143, 0xc, 0xf, false));
    return __int_as_float(__builtin_amdgcn_readlane(__float_as_int(v), 63));
}
__device__ __forceinline__ void ph_scan(const Params& P, int l, LAS unsigned char* lds) {
    LAS bf16_t* LI = (LAS bf16_t*)lds;
    LAS float* SIN = (LAS float*)(lds + 32768);
    const bf16_t* ZR = (const bf16_t*)(P.ws + OFF_ZR);
    const float* mu = P.mu + (size_t)l * 1792;
    const bf16_t* LW = (const bf16_t*)(P.ws + OFF_WB + WB_LW); const bf16_t* LA = (const bf16_t*)(P.ws + OFF_WB + WB_LA); const bf16_t* LG = (const bf16_t*)(P.ws + OFF_WB + WB_LG);
    bf16_t* Yo = (bf16_t*)(P.ws + OFF_Y); bf16_t* Po = (bf16_t*)(P.ws + OFF_P); bf16_t* Go = (bf16_t*)(P.ws + OFF_G); bf16_t* VBo = (bf16_t*)(P.ws + OFF_VB);
    float* SEGp = (float*)(P.ws + OFF_SEG);
    const int tid = opaque_tid(), wid = __builtin_amdgcn_readfirstlane(tid >> 6), lane = tid & 63;
    for (int blk = blockIdx.x; blk < NB_ * NSEG; blk += gridDim.x) {
        const int b = blk / NSEG, seg = blk % NSEG, tbeg = seg * SEGL;
        f32x2 S2[32], Pm2[32];
        { int lq = threadIdx.x; asm volatile("" : "+v"(lq)); lq &= 63;
#pragma unroll
          for (int j = 0; j < 32; ++j) { S2[j] = (f32x2){0.f, 0.f}; Pm2[j] = (f32x2){(2 * j == lq) ? 1.f : 0.f, (2 * j + 1 == lq) ? 1.f : 0.f}; } }
        for (int half = 0; half < 2; ++half) {
            __syncthreads();
            {
                int tq = threadIdx.x; asm volatile("" : "+v"(tq));
#pragma unroll 1
                for (int rnd = 0; rnd < 4; ++rnd) {
                    const int q = tq + NTHR * rnd, tok = q >> 5, c8 = (q & 31) * 8, t = tbeg + 64 * half + tok; const size_t row = (size_t)b * S_ + t;
                    const u32x4 zc = *(const u32x4*)(ZR + row * 1792 + 1536 + c8);
                    u32x4 zp; zp.x = 0u; zp.y = 0u; zp.z = 0u; zp.w = 0u; if (t > 0) zp = *(const u32x4*)(ZR + (row - 1) * 1792 + 1536 + c8);
                    const f32x4 ma = *(const f32x4*)(mu + 1536 + c8), mb = *(const f32x4*)(mu + 1536 + c8 + 4);
                    const unsigned cw[4] = {zc.x, zc.y, zc.z, zc.w}, pw[4] = {zp.x, zp.y, zp.z, zp.w};
                    float x[8];
#pragma unroll
                    for (int q2 = 0; q2 < 4; ++q2) { const float c0 = bflo(cw[q2]), c1 = bfhi(cw[q2]), p0 = bflo(pw[q2]), p1 = bfhi(pw[q2]);
                        const float m0 = q2 < 2 ? ma[2 * q2] : mb[2 * q2 - 4], m1 = q2 < 2 ? ma[2 * q2 + 1] : mb[2 * q2 - 3];
                        x[2 * q2] = c0 + (p0 - c0) * m0; x[2 * q2 + 1] = c1 + (p1 - c1) * m1; }
#pragma unroll
                    for (int e = 0; e < 8; ++e) { if (c8 < 64) x[e] = 1.0f - 2.0f * __builtin_amdgcn_rcpf(1.0f + __expf(2.0f * x[e])); else if (c8 >= 128) x[e] = sigmoidf_(x[e]); }
                    u32x4 w; w.x = cvt_pk_bf16(x[0], x[1]); w.y = cvt_pk_bf16(x[2], x[3]); w.z = cvt_pk_bf16(x[4], x[5]); w.w = cvt_pk_bf16(x[6], x[7]);
                    *(LAS u32x4*)(LI + tok * 256 + c8) = w;
                }
            }
            __syncthreads();
            float* los = (float*)(P.ws + OFF_SCR) + (size_t)(blk * 8 + wid) * (64 * 2 * 64);
            {
                int tq = threadIdx.x; asm volatile("" : "+v"(tq));
                const int lq = tq & 63, fr = lq & 15, kq = lq >> 4;
#pragma unroll 1
                for (int pass = 0; pass < 8; ++pass) {
                    const int kind = pass < 2 ? 0 : (pass < 4 ? 1 : 2), Kk = kind == 2 ? 128 : 64, aoff = kind * 64, nb0 = kind == 2 ? pass - 4 : 2 * (pass & 1);
                    const bf16_t* Wt = kind == 0 ? LW : (kind == 1 ? LA : LG);
                    bf16x8 Bf[4];
#pragma unroll
                    for (int q = 0; q < 4; ++q) { const int nb = kind == 2 ? nb0 : nb0 + (q >> 1), ks = kind == 2 ? q : (q & 1);
                        Bf[q] = *(const bf16x8*)(Wt + (size_t)(64 * wid + 16 * nb + fr) * Kk + 32 * ks + 8 * kq); }
#pragma unroll 1
                    for (int tt = 0; tt < 4; ++tt) {
                        f32x4 acc[2];
                        acc[0] = (f32x4){0.f, 0.f, 0.f, 0.f}; acc[1] = acc[0];
#pragma unroll
                        for (int q = 0; q < 4; ++q) { const int ai = kind == 2 ? 0 : (q >> 1), ks = kind == 2 ? q : (q & 1);
                            const bf16x8 Afr = *(const LAS bf16x8*)(LI + (16 * tt + fr) * 256 + aoff + 32 * ks + 8 * kq);
                            acc[ai] = __builtin_amdgcn_mfma_f32_16x16x32_bf16(Afr, Bf[q], acc[ai], 0, 0, 0); }
                        if (kind == 2) {
#pragma unroll
                            for (int r = 0; r < 4; ++r) Go[((size_t)b * S_ + tbeg + 64 * half + 16 * tt + 4 * kq + r) * 512 + 64 * wid + 16 * nb0 + fr] = f2bf(acc[0][r]);
                        } else {
#pragma unroll
                            for (int ai = 0; ai < 2; ++ai)
#pragma unroll
                                for (int r = 0; r < 4; ++r) los[((16 * tt + 4 * kq + r) * 2 + kind) * 64 + 16 * (nb0 + ai) + fr] = acc[ai][r];
                        }
                    }
                }
            }
            asm volatile("s_waitcnt vmcnt(0)" ::: "memory");
            for (int sb = 0; sb < 64 / TB; ++sb) {
                const int ts = tbeg + 64 * half + sb * TB;
                int tz = threadIdx.x; asm volatile("" : "+v"(tz));
                const int lz = tz & 63;
                LAS float* sw = SIN + (size_t)wid * (TB * 6 * 64);
                {
                    const int c = 64 * wid + lz; const size_t row0 = (size_t)b * S_ + ts;
                    const float mur = mu[c], muk = mu[512 + c], muv = mu[1024 + c];
                    const float pw0 = P.w0[l * 512 + c], pa0 = P.a0[l * 512 + c], pkk = P.k_k[l * 512 + c], pka = P.k_a[l * 512 + c], prk = P.r_k[l * 512 + c];
                    const float* lo = los + (size_t)(sb * TB) * 128 + lz;
                    float pr = 0.f, pk = 0.f, pv = 0.f;
                    if (ts > 0) { pr = bf2f(ZR[(row0 - 1) * 1792 + c]); pk = bf2f(ZR[(row0 - 1) * 1792 + 512 + c]); pv = bf2f(ZR[(row0 - 1) * 1792 + 1024 + c]); }
                    float nr = bf2f(ZR[row0 * 1792 + c]), nk = bf2f(ZR[row0 * 1792 + 512 + c]), nv = bf2f(ZR[row0 * 1792 + 1024 + c]);
                    float nwl = lo[0], nal = lo[64];
#pragma unroll 1
                    for (int tk = 0; tk < TB; ++tk) {
                        const size_t row = row0 + tk; LAS float* st = sw + tk * 6 * 64;
                        const float cr = nr, ck = nk, cv = nv, wl = nwl, al = nal;
                        if (tk + 1 < TB) { nr = bf2f(ZR[(row + 1) * 1792 + c]); nk = bf2f(ZR[(row + 1) * 1792 + 512 + c]); nv = bf2f(ZR[(row + 1) * 1792 + 1024 + c]);
                            nwl = lo[(tk + 1) * 128]; nal = lo[(tk + 1) * 128 + 64]; }
                        const float rr = cr + (pr - cr) * mur, kv = ck + (pk - ck) * muk, vv = cv + (pv - cv) * muv;
                        pr = cr; pk = ck; pv = cv;
                        const float x = -(pw0 + wl);
                        const float sp = fmaxf(x, 0.f) + __logf(1.0f + __expf(-fabsf(x)));
                        const float dc = __expf(-__expf(-sp - 0.5f));
                        const float av = sigmoidf_(pa0 + al);
                        const float kkv = kv * pkk;
                        const float km = kv * (1.0f + (av - 1.0f) * pka);
                        const float ss = wave_sum_dpp(kkv * kkv), bon = wave_sum_dpp(rr * km * prk);
                        const float kkn = kkv * __builtin_amdgcn_rsqf(fmaxf(ss, 1e-24f));
                        st[lz] = rr; st[64 + lz] = dc; st[2 * 64 + lz] = km; st[3 * 64 + lz] = -kkn; st[4 * 64 + lz] = kkn * av; st[5 * 64 + lz] = vv;
                        VBo[row * 512 + c] = f2bf(bon * vv);
                    }
                }
#pragma unroll 1
                for (int tk = 0; tk < TB; ++tk) {
                    const LAS float* sq = sw + tk * 6 * 64;
                    const float vi = sq[5 * 64 + lz];
                    f32x2 sa0 = {0.f, 0.f}, sa1 = {0.f, 0.f}, sp0 = {0.f, 0.f}, sp1 = {0.f, 0.f};
                    f32x2 y0 = {0.f, 0.f}, y1 = {0.f, 0.f}, p0 = {0.f, 0.f}, p1 = {0.f, 0.f};
                    f32x2 sav, spv; const f32x2 vv2 = {vi, vi};
                    const unsigned sqa = (unsigned)(uintptr_t)sq;
                    f32x4 X0[4], X1[4], X2[4];
                    DSR4(X0, sqa, 768, 784, 800, 816);
                    DSR4(X1, sqa, 832, 848, 864, 880);
                    DSR4(X2, sqa, 896, 912, 928, 944);
                    DSW(X0, 8);
                    SCAN_A(X0, 0);
                    DSR4(X0, sqa, 960, 976, 992, 1008);
                    DSW(X1, 8);
                    SCAN_A(X1, 1);
                    DSR4(X1, sqa, 256, 1024, 512, 0);
                    DSW(X2, 8);
                    SCAN_A(X2, 2);
                    DSR4(X2, sqa, 272, 1040, 528, 16);
                    DSW(X0, 8);
                    SCAN_A(X0, 3);
                    { const float sa = (sa0.x + sa0.y) + (sa1.x + sa1.y), sp = (sp0.x + sp0.y) + (sp1.x + sp1.y); sav = (f32x2){sa, sa}; spv = (f32x2){sp, sp}; }
                    DSR4(X0, sqa, 288, 1056, 544, 32);
                    DSW(X1, 8);
                    SCAN_B(X1, 0);
                    DSR4(X1, sqa, 304, 1072, 560, 48);
                    DSW(X2, 8);
                    SCAN_B(X2, 1);
                    DSR4(X2, sqa, 320, 1088, 576, 64);
                    DSW(X0, 8);
                    SCAN_B(X0, 2);
                    DSR4(X0, sqa, 336, 1104, 592, 80);
                    DSW(X1, 8);
                    SCAN_B(X1, 3);
                    DSR4(X1, sqa, 352, 1120, 608, 96);
                    DSW(X2, 8);
                    SCAN_B(X2, 4);
                    DSR4(X2, sqa, 368, 1136, 624, 112);
                    DSW(X0, 8);
                    SCAN_B(X0, 5);
                    DSR4(X0, sqa, 384, 1152, 640, 128);
                    DSW(X1, 8);
                    SCAN_B(X1, 6);
                    DSR4(X1, sqa, 400, 1168, 656, 144);
                    DSW(X2, 8);
                    SCAN_B(X2, 7);
                    DSR4(X2, sqa, 416, 1184, 672, 160);
                    DSW(X0, 8);
                    SCAN_B(X0, 8);
                    DSR4(X0, sqa, 432, 1200, 688, 176);
                    DSW(X1, 8);
                    SCAN_B(X1, 9);
                    DSR4(X1, sqa, 448, 1216, 704, 192);
                    DSW(X2, 8);
                    SCAN_B(X2, 10);
                    DSR4(X2, sqa, 464, 1232, 720, 208);
                    DSW(X0, 8);
                    SCAN_B(X0, 11);
                    DSR4(X0, sqa, 480, 1248, 736, 224);
                    DSW(X1, 8);
                    SCAN_B(X1, 12);
                    DSR4(X1, sqa, 496, 1264, 752, 240);
                    DSW(X2, 8);
                    SCAN_B(X2, 13);
                    DSW(X0, 4);
                    SCAN_B(X0, 14);
                    DSW(X1, 0);
                    SCAN_B(X1, 15);
                    const size_t row = (size_t)b * S_ + ts + tk;
                    Yo[row * 512 + 64 * wid + lz] = f2bf((y0.x + y0.y) + (y1.x + y1.y));
                    Po[row * 512 + 64 * wid + lz] = f2bf((p0.x + p0.y) + (p1.x + p1.y));
                }
            }
        }
        {
            int lq = threadIdx.x; asm volatile("" : "+v"(lq)); lq &= 63;
            float* sg = SEGp + ((size_t)((b * 8 + wid) * NSEG + seg)) * 8192 + lq * 64;
#pragma unroll
            for (int j = 0; j < 32; j += 2) { *(f32x4*)(sg + 2 * j) = (f32x4){Pm2[j].x, Pm2[j].y, Pm2[j + 1].x, Pm2[j + 1].y};
                *(f32x4*)(sg + 4096 + 2 * j) = (f32x4){S2[j].x, S2[j].y, S2[j + 1].x, S2[j + 1].y}; }
        }
    }
}

__device__ __forceinline__ void ph_comb(const Params& P, LAS unsigned char* lds) {
    LAS float* SI = (LAS float*)lds;
    LAS float* PB = (LAS float*)(lds + 20480);
    float* SEGp = (float*)(P.ws + OFF_SEG);
    const int tid = opaque_tid(), wid = __builtin_amdgcn_readfirstlane(tid >> 6), lane = tid & 63, m = lane & 31, hh = lane >> 5;
    for (int chain = blockIdx.x; chain < 64; chain += gridDim.x) {
        float* base = SEGp + (size_t)chain * NSEG * 8192;
        __syncthreads();
        for (int i = tid; i < 4096; i += NTHR) SI[(i >> 6) * 65 + (i & 63)] = base[4096 + i];
        { const f32x4 a = *(const f32x4*)(base + 8192 + tid * 8), c = *(const f32x4*)(base + 8192 + tid * 8 + 4);
          *(LAS f32x4*)(PB + 4096 + tid * 8) = a; *(LAS f32x4*)(PB + 4096 + tid * 8 + 4) = c; }
        __syncthreads();
        const int ti = (wid >> 1) & 1, tj = wid & 1;
        for (int k = 1; k <= NSEG - 2; ++k) {
            float* Q = base + (size_t)k * 8192 + 4096;
            const LAS float* Pb = PB + (k & 1) * 4096;
            f32x4 na = {0.f, 0.f, 0.f, 0.f}, nc = na;
            if (k + 1 <= NSEG - 2) { const float* pn = base + (size_t)(k + 1) * 8192 + tid * 8; na = *(const f32x4*)pn; nc = *(const f32x4*)(pn + 4); }
            f32x16 Dv;
            if (wid < 4) {
                float qv[16];
#pragma unroll
                for (int r = 0; r < 16; ++r) { const int row = 32 * ti + (r & 3) + 8 * (r >> 2) + 4 * hh; qv[r] = Q[row * 64 + 32 * tj + m]; Dv[r] = 0.f; }
#pragma unroll
                for (int kk = 0; kk < 32; ++kk) { const float a = SI[(32 * ti + m) * 65 + 2 * kk + hh], bq = Pb[(2 * kk + hh) * 64 + 32 * tj + m];
                    Dv = __builtin_amdgcn_mfma_f32_32x32x2f32(a, bq, Dv, 0, 0, 0); }
#pragma unroll
                for (int r = 0; r < 16; ++r) Dv[r] += qv[r];
            }
            __syncthreads();
            if (wid < 4) {
#pragma unroll
                for (int r = 0; r < 16; ++r) { const int row = 32 * ti + (r & 3) + 8 * (r >> 2) + 4 * hh; SI[row * 65 + 32 * tj + m] = Dv[r]; Q[row * 64 + 32 * tj + m] = Dv[r]; }
            }
            if (k + 1 <= NSEG - 2) { LAS float* pd = PB + ((k + 1) & 1) * 4096 + tid * 8; *(LAS f32x4*)pd = na; *(LAS f32x4*)(pd + 4) = nc; }
            __syncthreads();
        }
    }
}

__device__ __forceinline__ void ph_post(const Params& P, int l) {
    const bf16_t* Yo = (const bf16_t*)(P.ws + OFF_Y); const bf16_t* Po = (const bf16_t*)(P.ws + OFF_P); const bf16_t* Go = (const bf16_t*)(P.ws + OFF_G);
    const bf16_t* VBo = (const bf16_t*)(P.ws + OFF_VB); const float* SEGp = (const float*)(P.ws + OFF_SEG); bf16_t* OR = (bf16_t*)(P.ws + OFF_ORWKV);
    const int tid = opaque_tid(), wid = __builtin_amdgcn_readfirstlane(tid >> 6), lane = tid & 63, m = lane & 31, hh = lane >> 5;
    for (int blk = blockIdx.x; blk < NB_ * NSEG; blk += gridDim.x) {
        const int b = blk / NSEG, seg = blk % NSEG, tbeg = seg * SEGL;
        bf16x8 SIf[2][4];
        if (seg > 0) {
            const float* sg = SEGp + ((size_t)((b * 8 + wid) * NSEG + seg - 1)) * 8192 + 4096;
#pragma unroll
            for (int ib = 0; ib < 2; ++ib)
#pragma unroll
                for (int ks = 0; ks < 4; ++ks) { const float* sp = sg + (32 * ib + m) * 64 + 16 * ks + 8 * hh; const f32x4 a = *(const f32x4*)sp, c = *(const f32x4*)(sp + 4);
                    u32x4 w; w.x = cvt_pk_bf16(a[0], a[1]); w.y = cvt_pk_bf16(a[2], a[3]); w.z = cvt_pk_bf16(c[0], c[1]); w.w = cvt_pk_bf16(c[2], c[3]); SIf[ib][ks] = __builtin_bit_cast(bf16x8, w); }
        }
        float lnw[32], lnb[32];
#pragma unroll
        for (int q = 0; q < 32; ++q) { const int ch = 64 * wid + 32 * (q >> 4) + (q & 3) + 8 * ((q & 15) >> 2) + 4 * hh; lnw[q] = P.ln_w[l * 512 + ch]; lnb[q] = P.ln_b[l * 512 + ch]; }
#pragma unroll 1
        for (int c = 0; c < SEGL / 32; ++c) {
            const size_t row = (size_t)b * S_ + tbeg + 32 * c + m;
            f32x16 D[2];
#pragma unroll
            for (int r = 0; r < 16; ++r) { D[0][r] = 0.f; D[1][r] = 0.f; }
            if (seg > 0) {
                const bf16_t* pp = Po + row * 512 + 64 * wid + 8 * hh;
#pragma unroll
                for (int ks = 0; ks < 4; ++ks) { const bf16x8 Pf = *(const bf16x8*)(pp + 16 * ks);
                    D[0] = __builtin_amdgcn_mfma_f32_32x32x16_bf16(SIf[0][ks], Pf, D[0], 0, 0, 0); D[1] = __builtin_amdgcn_mfma_f32_32x32x16_bf16(SIf[1][ks], Pf, D[1], 0, 0, 0); }
            }
            float y[32]; float s = 0.f;
#pragma unroll
            for (int ib = 0; ib < 2; ++ib)
#pragma unroll
                for (int g = 0; g < 4; ++g) { const u32x2 yw = *(const u32x2*)(Yo + row * 512 + 64 * wid + 32 * ib + 8 * g + 4 * hh);
                    y[16 * ib + 4 * g + 0] = bflo(yw.x) + D[ib][4 * g + 0]; y[16 * ib + 4 * g + 1] = bfhi(yw.x) + D[ib][4 * g + 1];
                    y[16 * ib + 4 * g + 2] = bflo(yw.y) + D[ib][4 * g + 2]; y[16 * ib + 4 * g + 3] = bfhi(yw.y) + D[ib][4 * g + 3]; }
#pragma unroll
            for (int q = 0; q < 32; ++q) s += y[q];
            s += shx(s, 32, lane);
            const float mean = s * (1.0f / 64.0f); float qv = 0.f;
#pragma unroll
            for (int q = 0; q < 32; ++q) { y[q] -= mean; qv += y[q] * y[q]; }
            qv += shx(qv, 32, lane);
            const float rstd = rsqrtf(qv * (1.0f / 64.0f) + 64e-5f);
#pragma unroll
            for (int ib = 0; ib < 2; ++ib)
#pragma unroll
                for (int g = 0; g < 4; ++g) { const size_t off = row * 512 + 64 * wid + 32 * ib + 8 * g + 4 * hh;
                    const u32x2 vw = *(const u32x2*)(VBo + off), gw = *(const u32x2*)(Go + off); const int q = 16 * ib + 4 * g;
                    const float o0 = (y[q] * rstd * lnw[q] + lnb[q] + bflo(vw.x)) * bflo(gw.x), o1 = (y[q + 1] * rstd * lnw[q + 1] + lnb[q + 1] + bfhi(vw.x)) * bfhi(gw.x);
                    const float o2 = (y[q + 2] * rstd * lnw[q + 2] + lnb[q + 2] + bflo(vw.y)) * bflo(gw.y), o3 = (y[q + 3] * rstd * lnw[q + 3] + lnb[q + 3] + bfhi(vw.y)) * bfhi(gw.y);
                    u32x2 w; w.x = cvt_pk_bf16(o0, o1); w.y = cvt_pk_bf16(o2, o3); *(u32x2*)(OR + off) = w; }
        }
    }
}

enum { PH_PRO = 0, PH_NORM1, PH_ZQ, PH_IDX, PH_ATT, PH_ZR, PH_SCAN, PH_COMB, PH_POST, PH_ZC, PH_CONV, PH_MERGE, PH_WO, PH_NORM2, PH_UP, PH_U, PH_DOWN, PH_FINAL, PH_COUNT };

template <int PH>
__device__ __forceinline__ void run_phase(const Params& P0, int l, LAS unsigned char* lds) {
    Params P = P0; P.ws = opaque_ptr(P0.ws);
    if constexpr (PH == PH_PRO) { if (l == 0) ph_mod(P, lds); ph_wconv(P, l, lds); }
    if constexpr (PH == PH_NORM1) ph_norm(P, l, 0);
    if constexpr (PH == PH_ZQ) ph_gemm_zq(P, lds);
    if constexpr (PH == PH_IDX) ph_idx(P, lds);
    if constexpr (PH == PH_ATT) ph_att(P, lds);
    if constexpr (PH == PH_ZR) ph_gemm_zr(P, lds);
    if constexpr (PH == PH_SCAN) ph_scan(P, l, lds);
    if constexpr (PH == PH_COMB) ph_comb(P, lds);
    if constexpr (PH == PH_POST) ph_post(P, l);
    if constexpr (PH == PH_ZC) ph_gemm_zc(P, lds);
    if constexpr (PH == PH_CONV) ph_conv(P, l, lds);
    if constexpr (PH == PH_MERGE) ph_gemm_merge(P, lds);
    if constexpr (PH == PH_WO) ph_gemm_wo(P, l, lds);
    if constexpr (PH == PH_NORM2) ph_norm(P, l, 1);
    if constexpr (PH == PH_UP) ph_gemm_up(P, l, lds);
    if constexpr (PH == PH_U) ph_ufix(P, l, lds);
    if constexpr (PH == PH_DOWN) ph_gemm_down(P, l, lds);
    if constexpr (PH == PH_FINAL) ph_final(P);
}

#if MK_SINGLE
__global__ void __launch_bounds__(NTHR, 2) k_mega(Params P) {
    extern __shared__ __attribute__((aligned(16))) unsigned char shm[];
    LAS unsigned char* lds = (LAS unsigned char*)shm;
    LAS unsigned* xbw = (LAS unsigned*)(lds + LDS_BYTES - 16);
    if (threadIdx.x == 0) { xbw[0] = 0u; xbw[1] = 0u; xbw[2] = 0u; xbw[3] = 0u; }
    __syncthreads();
    XcdBarrier bar = xcd_barrier_post((unsigned*)(P.ws + OFF_BAR), (volatile LAS unsigned*)xbw);
#ifndef PROBE_PH
#define PROBE_PH (-1)
#endif
#ifndef PROBE_N
#define PROBE_N 4
#endif
#define PHASE(PH, l) do { unsigned long long t0_ = 0; if (PROBE_PH == PH && blockIdx.x == 0) t0_ = wall_clock64(); \
        run_phase<PH>(P, l, lds); xcd_barrier(bar); \
        if (PROBE_PH == PH && blockIdx.x == 0) { const unsigned long long t1_ = wall_clock64(), d_ = (t1_ - t0_) * PROBE_N; while (wall_clock64() - t1_ < d_) __builtin_amdgcn_s_sleep(8); } } while (0)
#pragma unroll 1
    for (int l = 0; l < 2; ++l) {
        PHASE(PH_PRO, l); PHASE(PH_NORM1, l); PHASE(PH_ZQ, l); PHASE(PH_IDX, l); PHASE(PH_ATT, l); PHASE(PH_ZR, l); PHASE(PH_SCAN, l); PHASE(PH_COMB, l); PHASE(PH_POST, l);
        PHASE(PH_ZC, l); PHASE(PH_CONV, l); PHASE(PH_MERGE, l); PHASE(PH_WO, l); PHASE(PH_NORM2, l); PHASE(PH_UP, l); PHASE(PH_U, l); PHASE(PH_DOWN, l);
    }
    run_phase<PH_FINAL>(P, 0, lds);
#undef PHASE
}
#else
template <int PH>
__global__ void __launch_bounds__(NTHR, 2) k_phase(Params P, int l) {
    extern __shared__ __attribute__((aligned(16))) unsigned char shm[];
    run_phase<PH>(P, l, (LAS unsigned char*)shm);
}
template <int PH> static void launch_phase(const Params& P, int l, hipStream_t stream) {
    static bool attr = false;
    if (!attr) { hipFuncSetAttribute((const void*)k_phase<PH>, hipFuncAttributeMaxDynamicSharedMemorySize, LDS_BYTES); attr = true; }
    hipLaunchKernelGGL(k_phase<PH>, dim3(NBLK), dim3(NTHR), LDS_BYTES, stream, P, l);
}
#endif

extern "C" void kernel_launch(void* const* d_in, const int* in_sizes, int n_in, void* d_out, int out_size, void* d_ws, size_t ws_size, hipStream_t stream) {
    (void)in_sizes; (void)n_in; (void)out_size; (void)ws_size;
    Params P{};
    P.x_in = (const float*)d_in[0]; P.c = (const float*)d_in[1]; P.pos = (const int*)d_in[2]; P.rel_bias = (const float*)d_in[3]; P.final_norm = (const float*)d_in[4];
    P.ada_w = (const float*)d_in[5]; P.ada_b = (const float*)d_in[6]; P.norm_mix = (const float*)d_in[7]; P.w_in = (const float*)d_in[8];
    P.mu = (const float*)d_in[9]; P.w0 = (const float*)d_in[10]; P.w_up = (const float*)d_in[11]; P.a0 = (const float*)d_in[12]; P.a_up = (const float*)d_in[13]; P.g_up = (const float*)d_in[14];
    P.k_k = (const float*)d_in[15]; P.k_a = (const float*)d_in[16]; P.r_k = (const float*)d_in[17]; P.ln_w = (const float*)d_in[18]; P.ln_b = (const float*)d_in[19];
    P.sc_conv_w = (const float*)d_in[20]; P.w_branch = (const float*)d_in[21]; P.w_o = (const float*)d_in[22]; P.norm_ffn = (const float*)d_in[23];
    P.ffn_w_up = (const float*)d_in[24]; P.ffn_conv_w = (const float*)d_in[25]; P.ffn_w_down = (const float*)d_in[26];
    P.out = (float*)d_out; P.ws = (unsigned char*)d_ws;
#if MK_SINGLE
    static bool attr = false;
    if (!attr) { hipFuncSetAttribute((const void*)k_mega, hipFuncAttributeMaxDynamicSharedMemorySize, LDS_BYTES); attr = true; }
    hipMemsetAsync((unsigned char*)d_ws + OFF_BAR, 0, XCD_BAR_WORDS * sizeof(unsigned), stream);
    hipLaunchKernelGGL(k_mega, dim3(NBLK), dim3(NTHR), LDS_BYTES, stream, P);
#else
    for (int l = 0; l < 2; ++l) {
        launch_phase<PH_PRO>(P, l, stream); launch_phase<PH_NORM1>(P, l, stream); launch_phase<PH_ZQ>(P, l, stream); launch_phase<PH_IDX>(P, l, stream);
        launch_phase<PH_ATT>(P, l, stream); launch_phase<PH_ZR>(P, l, stream); launch_phase<PH_SCAN>(P, l, stream); launch_phase<PH_COMB>(P, l, stream);
        launch_phase<PH_POST>(P, l, stream); launch_phase<PH_ZC>(P, l, stream); launch_phase<PH_CONV>(P, l, stream); launch_phase<PH_MERGE>(P, l, stream);
        launch_phase<PH_WO>(P, l, stream); launch_phase<PH_NORM2>(P, l, stream); launch_phase<PH_UP>(P, l, stream); launch_phase<PH_U>(P, l, stream);
        launch_phase<PH_DOWN>(P, l, stream);
    }
    launch_phase<PH_FINAL>(P, 0, stream);
#endif
}
```

```cpp
#include <hip/hip_runtime.h>
#include <stdint.h>

#ifndef MK_SINGLE
#define MK_SINGLE 1
#endif

#define LAS __attribute__((address_space(3)))
typedef unsigned short bf16_t;
typedef short bf16x8 __attribute__((ext_vector_type(8)));
typedef short bf16x4 __attribute__((ext_vector_type(4)));
typedef float f32x4 __attribute__((ext_vector_type(4)));
typedef float f32x16 __attribute__((ext_vector_type(16)));
typedef float f32x2 __attribute__((ext_vector_type(2)));
typedef unsigned u32x4 __attribute__((ext_vector_type(4)));
typedef unsigned u32x2 __attribute__((ext_vector_type(2)));
typedef int i32x4 __attribute__((ext_vector_type(4)));
typedef unsigned long long u64;

constexpr int T_ = 32768, D_ = 1024, NB_ = 8, S_ = 4096;
constexpr int NSEG = 32, SEGL = 128, TB = 8;
constexpr int NBLK = 256, NTHR = 512;
constexpr int IN_COLS = 8520, DFF = 2816;
constexpr int LDS_BYTES = 150 * 1024;

constexpr size_t MiB = 1ull << 20;
constexpr size_t OFF_BAR = 0;
constexpr size_t OFF_MOD = 64 * 1024;
constexpr size_t OFF_TAB = 512 * 1024;
constexpr size_t OFF_KPM = 520 * 1024;
constexpr size_t OFF_WB = 2 * MiB;
constexpr size_t WB_WIN = 0;
constexpr size_t WB_WBR = WB_WIN + (size_t)8704 * 1024 * 2;
constexpr size_t WB_WO = WB_WBR + (size_t)3 * 1024 * 512 * 2;
constexpr size_t WB_WUP = WB_WO + (size_t)1024 * 1024 * 2;
constexpr size_t WB_WDN = WB_WUP + (size_t)5632 * 1024 * 2;
constexpr size_t WB_LW = WB_WDN + (size_t)1024 * 2816 * 2;
constexpr size_t WB_LA = WB_LW + (size_t)512 * 64 * 2;
constexpr size_t WB_LG = WB_LA + (size_t)512 * 64 * 2;
constexpr size_t OFF_H = 42 * MiB;
constexpr size_t OFF_ZQ = 106 * MiB;
constexpr size_t OFF_MASK = 250 * MiB;
constexpr size_t OFF_VT = 266 * MiB;
constexpr size_t OFF_ZR = 106 * MiB;
constexpr size_t OFF_Y = 218 * MiB;
constexpr size_t OFF_P = 250 * MiB;
constexpr size_t OFF_G = 282 * MiB;
constexpr size_t OFF_SEG = 314 * MiB;
constexpr size_t OFF_ZCV = 106 * MiB;
constexpr size_t OFF_ZG = 202 * MiB;
constexpr size_t OFF_MRG = 106 * MiB;
constexpr size_t OFF_UP = 106 * MiB;
constexpr size_t OFF_HA = 300 * MiB;
constexpr size_t OFF_HB = 320 * MiB;
constexpr size_t OFF_OCONV = 416 * MiB;
constexpr size_t OFF_ORWKV = 448 * MiB;
constexpr size_t OFF_OATT = 480 * MiB;
constexpr size_t OFF_VB = OFF_ORWKV;
constexpr size_t OFF_SCR = 378 * MiB;

struct Params {
    const float* x_in; const float* c; const int* pos; const float* rel_bias; const float* final_norm;
    const float* ada_w; const float* ada_b; const float* norm_mix; const float* w_in;
    const float* mu; const float* w0; const float* w_up; const float* a0; const float* a_up; const float* g_up;
    const float* k_k; const float* k_a; const float* r_k; const float* ln_w; const float* ln_b;
    const float* sc_conv_w; const float* w_branch; const float* w_o; const float* norm_ffn;
    const float* ffn_w_up; const float* ffn_conv_w; const float* ffn_w_down;
    float* out; unsigned char* ws;
};

__device__ __forceinline__ float bf2f(bf16_t b) { return __uint_as_float(((unsigned)b) << 16); }
__device__ __forceinline__ bf16_t f2bf(float f) { unsigned u = __float_as_uint(f); u += 0x7FFFu + ((u >> 16) & 1u); return (bf16_t)(u >> 16); }
typedef __bf16 bf16x2_t __attribute__((ext_vector_type(2)));
__device__ __forceinline__ unsigned cvt_pk_bf16(float lo, float hi) { const f32x2 v = {lo, hi}; return __builtin_bit_cast(unsigned, __builtin_convertvector(v, bf16x2_t)); }
__device__ __forceinline__ float bflo(unsigned w) { return __uint_as_float(w << 16); }
__device__ __forceinline__ float bfhi(unsigned w) { return __uint_as_float(w & 0xffff0000u); }
__device__ __forceinline__ float shx(float v, int mask, int lane) { return __int_as_float(__builtin_amdgcn_ds_bpermute((lane ^ mask) << 2, __float_as_int(v))); }
__device__ __forceinline__ int shxi(int v, int mask, int lane) { return __builtin_amdgcn_ds_bpermute((lane ^ mask) << 2, v); }
__device__ __forceinline__ float wave_sum(float v, int lane) {
#pragma unroll
    for (int o = 32; o >= 1; o >>= 1) v += shx(v, o, lane);
    return v;
}
__device__ __forceinline__ void writelane_c2(int& vlo, int& vhi, int lo, int hi, int ln  ) {
    asm("s_nop 3\n\tv_writelane_b32 %0, %2, %4\n\tv_writelane_b32 %1, %3, %4" : "+v"(vlo), "+v"(vhi) : "s"(lo), "s"(hi), "n"(ln)); }
__device__ __forceinline__ int writelane_v(int vec, int val, int ln  ) { asm("s_mov_b32 m0, %2\n\ts_nop 3\n\tv_writelane_b32 %0, %1, m0" : "+v"(vec) : "s"(val), "s"(ln) : "m0"); return vec; }
__device__ __forceinline__ float sigmoidf_(float x) { return __builtin_amdgcn_rcpf(1.0f + __expf(-x)); }
__device__ __forceinline__ unsigned f2ord(float x) { unsigned u = __float_as_uint(x); return (u & 0x80000000u) ? ~u : (u | 0x80000000u); }
__device__ __forceinline__ float ord2f(unsigned k) { return __uint_as_float((k & 0x80000000u) ? (k & 0x7fffffffu) : ~k); }

__device__ __forceinline__ int opaque_tid() { int t = threadIdx.x; asm volatile("" : "+v"(t)); return t; }
__device__ __forceinline__ unsigned char* opaque_ptr(unsigned char* p) {
    typedef __attribute__((address_space(1))) unsigned char* gptr_t;
    gptr_t g = (gptr_t)p; asm volatile("" : "+s"(g)); return (unsigned char*)g; }

#define XB_TMO      128
#define XB_XCNT(j)  (256  + 64 * (j))
#define XB_XSUB(j)  (1280 + 64 * (j))
#define XB_XGEN(j)  (2304 + 64 * (j))
#define XB_TOP      3328
#define XB_TOPGEN   3392
#define XCD_BAR_WORDS 3456
#define XB_SPIN_CAP (1u << 22)

__device__ __forceinline__ unsigned xb_ld(unsigned* p)              { return __hip_atomic_load(p, __ATOMIC_RELAXED, __HIP_MEMORY_SCOPE_AGENT); }
__device__ __forceinline__ unsigned xb_add(unsigned* p, unsigned v) { return __hip_atomic_fetch_add(p, v, __ATOMIC_RELAXED, __HIP_MEMORY_SCOPE_AGENT); }
__device__ __forceinline__ unsigned xb_xcc_id() { return (unsigned)__builtin_amdgcn_s_getreg((3 << 11) | 20) & 0xFu; }
#define XB_SPIN(cond, bar) do { unsigned _sp = 0; while (cond) { __builtin_amdgcn_s_sleep(1); \
    if ((++_sp & 255u) == 0u) { if (xb_ld(&(bar)[XB_TMO])) break; if (_sp > XB_SPIN_CAP) { atomicAdd(&(bar)[XB_TMO], 1u); break; } } } } while (0)

struct XcdBarrier { unsigned* bar; unsigned x; volatile LAS unsigned* st; };

__device__ __forceinline__ XcdBarrier xcd_barrier_post(unsigned* bar, volatile LAS unsigned* st) {
    XcdBarrier b; b.bar = bar; b.x = xb_xcc_id(); b.st = st;
    if (threadIdx.x == 0) (void)xb_add(&bar[XB_XCNT(b.x)], 1u);
    return b;
}
__device__ __forceinline__ void xcd_barrier_complete(unsigned* bar, unsigned x, unsigned& nloc, unsigned& nx) {
    const unsigned G = gridDim.x * gridDim.y * gridDim.z;
    unsigned sum, cnt, mine, sp = 0u;
    for (;;) {
        sum = 0u; cnt = 0u; mine = 0u;
#pragma unroll
        for (unsigned j = 0; j < 16; ++j) { const unsigned c = xb_ld(&bar[XB_XCNT(j)]); sum += c; cnt += (c > 0u) ? 1u : 0u; mine = (j == x) ? c : mine; }
        if (sum == G) break;
        __builtin_amdgcn_s_sleep(1);
        if ((++sp & 255u) == 0u) { if (xb_ld(&bar[XB_TMO])) break; if (sp > XB_SPIN_CAP) { atomicAdd(&bar[XB_TMO], 1u); break; } }
    }
    nloc = mine > 0u ? mine : 1u; nx = cnt > 0u ? cnt : 1u;
}
__device__ __forceinline__ void xcd_barrier(const XcdBarrier& b) {
    asm volatile("s_waitcnt vmcnt(0)" ::: "memory");
    __syncthreads();
    if (threadIdx.x == 0) {
        unsigned* bar = b.bar;
        __builtin_amdgcn_s_waitcnt(0);
        unsigned nloc = b.st[0], nx = b.st[1];
        if (nloc == 0u) { xcd_barrier_complete(bar, b.x, nloc, nx); b.st[0] = nloc; b.st[1] = nx; }
        const unsigned old = xb_add(&bar[XB_XSUB(b.x)], 1u);
        const unsigned gen = old / nloc;
        if (old + 1u == (gen + 1u) * nloc) {
            __builtin_amdgcn_fence(__ATOMIC_RELEASE, "agent");
            asm volatile("s_waitcnt vmcnt(0)" ::: "memory");
            const unsigned og = xb_add(&bar[XB_TOP], 1u);
            const unsigned tg = og / nx;
            if (og + 1u == (tg + 1u) * nx) xb_add(&bar[XB_TOPGEN], 1u);
            else XB_SPIN(xb_ld(&bar[XB_TOPGEN]) == tg, bar);
            __builtin_amdgcn_fence(__ATOMIC_ACQUIRE, "agent");
            xb_add(&bar[XB_XGEN(b.x)], 1u);
            asm volatile("s_waitcnt vmcnt(0)" ::: "memory");
        } else {
            XB_SPIN(xb_ld(&bar[XB_XGEN(b.x)]) == gen, bar);
            __builtin_amdgcn_fence(__ATOMIC_ACQUIRE, "agent");
            asm volatile("s_waitcnt vmcnt(0)" ::: "memory");
        }
    }
    __syncthreads();
}

namespace g8 {
constexpr int BM = 256, BK = 64, HALF = 128, HTB = HALF * BK * 2, STAGE_BYTES = 8 * HTB, NXCD = 8, WGM = 8;
__device__ __forceinline__ int lds_byte(int r, int c) { const int st = (r >> 4) * 2 + (c >> 5), rr = r & 15, cc = c & 31, ob = rr * 64 + cc * 2; return st * 1024 + (ob ^ (((ob >> 9) & 1) << 5)); }
__device__ __forceinline__ void stage_rc(int b, int& R, int& C) { const int st = b / 1024, sb = b % 1024, swz = sb ^ (((sb >> 9) & 1) << 5); R = (st >> 1) * 16 + swz / 64; C = (st & 1) * 32 + (swz % 64) / 2; }
__device__ __forceinline__ int perm32(int rho) { const int n = rho >> 4, i = rho & 15; return 8 * (i >> 2) + 4 * n + (i & 3); }

struct Unit { const char* A; const char* B; int pm, pn, tag; };

struct SOrder {
    int nM, nN, nwg, G, c; const char* A; const char* Bt; size_t a_t, b_t;
    __device__ void init(int M, int N, int lda, int ldb, const void* A_, const void* Bt_) {
        nM = M / BM; nN = N / BM; nwg = nM * nN; G = (int)gridDim.x; c = (int)blockIdx.x; A = (const char*)A_; Bt = (const char*)Bt_;
        a_t = (size_t)BM * lda * 2; b_t = (size_t)BM * ldb * 2; }
    __device__ bool next(int i, Unit& u) const {
        const long L = (long)i * G + c; if (L >= nwg) return false;
        int wgid = (int)L; { const int q = nwg / NXCD, r = nwg % NXCD, xcd = wgid % NXCD, off = wgid / NXCD; wgid = (xcd < r ? xcd * (q + 1) : r * (q + 1) + (xcd - r) * q) + off; }
        const int nig = WGM * nN, gid = wgid / nig, fm = gid * WGM, gsz = (nM - fm) < WGM ? (nM - fm) : WGM;
        u.pm = fm + ((wgid % nig) % gsz); u.pn = (wgid % nig) / gsz; u.tag = 0;
        u.A = A + (size_t)u.pm * a_t; u.B = Bt + (size_t)u.pn * b_t; return true;
    }
};

template <class Epi, class Sched>
__device__ __forceinline__ void gemm_phase(LAS unsigned char* lds, const int K, const int lda, const int ldb, const Sched& S, const Epi& E) {
    const int tid = opaque_tid(), wid = __builtin_amdgcn_readfirstlane(tid >> 6), lane = tid & 63, wr = wid >> 2, wc = wid & 3, fr = lane & 15, fq = lane >> 4;
    const int nt = K / BK;
    unsigned voffA[2], voffB[2];
#pragma unroll
    for (int i = 0; i < 2; ++i) { int R, C; stage_rc(tid * 16 + i * 8192, R, C); const int Rb = Epi::PERM ? ((R & ~31) + perm32(R & 31)) : R;
        voffA[i] = (unsigned)(R * lda + C) * 2u; voffB[i] = (unsigned)(Rb * ldb + C) * 2u; }
    const size_t kstep = (size_t)(BK * 2);
    const size_t hstepA = (size_t)HALF * lda * 2, hstepB = (size_t)HALF * ldb * 2;
    const unsigned ldsw = (unsigned)wid * 1024u;
    const int aoff = lds_byte(wr * 64 + fr, fq * 8), boff = lds_byte(wc * 32 + fr, fq * 8);
#define PG8_SA(b, h) (((b) * 2 + (h)) * HTB)
#define PG8_SB(b, h) ((4 + (b) * 2 + (h)) * HTB)
#define PG8_STAGE(bufoff, gbase, voff) do { _Pragma("unroll") for (int _i = 0; _i < 2; ++_i) \
        __builtin_amdgcn_global_load_lds((const unsigned*)((const char*)(gbase) + (voff)[_i]), (LAS unsigned*)(lds + (bufoff) + ldsw + _i * 8192), 16, 0, 0); } while (0)
#define PG8_LDA(dst, b, h) do { _Pragma("unroll") for (int m = 0; m < 4; ++m) _Pragma("unroll") for (int k = 0; k < 2; ++k) dst[m][k] = *(const LAS bf16x8*)(lds + PG8_SA(b, h) + aoff + m * 2048 + k * 1024); } while (0)
#define PG8_LDB(dst, b, h) do { _Pragma("unroll") for (int n = 0; n < 2; ++n) _Pragma("unroll") for (int k = 0; k < 2; ++k) dst[n][k] = *(const LAS bf16x8*)(lds + PG8_SB(b, h) + boff + n * 2048 + k * 1024); } while (0)
#define PG8_MMA(ai, bj, At, Bt) do { __builtin_amdgcn_s_setprio(1); _Pragma("unroll") for (int m = 0; m < 4; ++m) _Pragma("unroll") for (int n = 0; n < 2; ++n) _Pragma("unroll") for (int k = 0; k < 2; ++k) \
        acc[ai][bj][m][n] = __builtin_amdgcn_mfma_f32_16x16x32_bf16(Bt[n][k], At[m][k], acc[ai][bj][m][n], 0, 0, 0); __builtin_amdgcn_s_setprio(0); } while (0)
#define PG8_WAIT_V(n) asm volatile("s_waitcnt vmcnt(" #n ")" ::: "memory")
#define PG8_WAIT_L(n) asm volatile("s_waitcnt lgkmcnt(" #n ")" ::: "memory")
#define PG8_BAR __builtin_amdgcn_s_barrier()
#define PG8_SCHED __builtin_amdgcn_sched_barrier(0)
    Unit cur, nxt; int ui = 0;
    if (!S.next(0, cur)) return;
    f32x4 acc[2][2][4][2];
#pragma unroll
    for (int a = 0; a < 2; ++a)
#pragma unroll
        for (int b = 0; b < 2; ++b)
#pragma unroll
            for (int m = 0; m < 4; ++m)
#pragma unroll
                for (int n = 0; n < 2; ++n) acc[a][b][m][n] = (f32x4){0.f, 0.f, 0.f, 0.f};
    bf16x8 At[4][2], B0[2][2], B1[2][2];
    const char* cA = cur.A; const char* cB = cur.B;
    PG8_STAGE(PG8_SB(0, 0), cB, voffB); PG8_STAGE(PG8_SA(0, 0), cA, voffA); PG8_STAGE(PG8_SB(0, 1), cB + hstepB, voffB); PG8_STAGE(PG8_SA(0, 1), cA + hstepA, voffA);
    if (wr == 1) PG8_BAR;
    PG8_WAIT_V(4); PG8_BAR;
    PG8_STAGE(PG8_SB(1, 0), cB + kstep, voffB); PG8_STAGE(PG8_SA(1, 0), cA + kstep, voffA); PG8_STAGE(PG8_SB(1, 1), cB + hstepB + kstep, voffB);
    PG8_WAIT_V(6); PG8_BAR;
    for (;;) {
        const bool has_next = S.next(ui + 1, nxt);
        const char* nA = has_next ? nxt.A : cA; const char* nB = has_next ? nxt.B : cB;
        for (int t = 0; t < nt; t += 2) {
            const bool last = (t == nt - 2);
            const char* a1 = cA + (size_t)(t + 1) * kstep;
            const char* a2 = last ? nA : cA + (size_t)(t + 2) * kstep; const char* b2 = last ? nB : cB + (size_t)(t + 2) * kstep;
            const char* a3 = a2 + kstep; const char* b3 = b2 + kstep;
            PG8_LDB(B0, 0, 0); PG8_SCHED; PG8_LDA(At, 0, 0); PG8_STAGE(PG8_SA(1, 1), a1 + hstepA, voffA);
            PG8_WAIT_L(8); PG8_BAR; PG8_WAIT_L(0); PG8_MMA(0, 0, At, B0); PG8_BAR; PG8_SCHED;
            PG8_LDB(B1, 0, 1); PG8_STAGE(PG8_SB(0, 0), b2, voffB);
            PG8_BAR; PG8_WAIT_L(0); PG8_MMA(0, 1, At, B1); PG8_BAR;
            PG8_LDA(At, 0, 1); PG8_STAGE(PG8_SA(0, 0), a2, voffA);
            PG8_BAR; PG8_WAIT_L(0); PG8_MMA(1, 0, At, B0); PG8_BAR; PG8_SCHED;
            PG8_STAGE(PG8_SB(0, 1), b2 + hstepB, voffB);
            PG8_WAIT_V(6); PG8_BAR; PG8_MMA(1, 1, At, B1); PG8_BAR;
            PG8_LDB(B0, 1, 0); PG8_SCHED; PG8_LDA(At, 1, 0); PG8_STAGE(PG8_SA(0, 1), a2 + hstepA, voffA);
            PG8_WAIT_L(8); PG8_BAR; PG8_WAIT_L(0); PG8_MMA(0, 0, At, B0); PG8_BAR; PG8_SCHED;
            PG8_LDB(B1, 1, 1); PG8_STAGE(PG8_SB(1, 0), b3, voffB);
            PG8_BAR; PG8_WAIT_L(0); PG8_MMA(0, 1, At, B1); PG8_BAR;
            PG8_LDA(At, 1, 1); PG8_STAGE(PG8_SA(1, 0), a3, voffA);
            PG8_BAR; PG8_WAIT_L(0); PG8_MMA(1, 0, At, B0); PG8_BAR; PG8_SCHED;
            PG8_STAGE(PG8_SB(1, 1), b3 + hstepB, voffB);
            PG8_WAIT_V(6); PG8_BAR; PG8_MMA(1, 1, At, B1); PG8_BAR;
        }
        bool keep = false;
        if constexpr (Epi::CHAIN) keep = E.chain(acc, cur, wr, wc, fr, fq); else E(acc, cur, wr, wc, fr, fq);
        if (!has_next) break;
        if (!keep) {
#pragma unroll
            for (int a = 0; a < 2; ++a)
#pragma unroll
                for (int b = 0; b < 2; ++b)
#pragma unroll
                    for (int m = 0; m < 4; ++m)
#pragma unroll
                        for (int n = 0; n < 2; ++n) acc[a][b][m][n] = (f32x4){0.f, 0.f, 0.f, 0.f};
        }
        cur = nxt; cA = nA; cB = nB; ++ui;
    }
    PG8_WAIT_V(0);
    if (wr == 0) PG8_BAR;
    PG8_BAR;
#undef PG8_SA
#undef PG8_SB
#undef PG8_STAGE
#undef PG8_LDA
#undef PG8_LDB
#undef PG8_MMA
#undef PG8_WAIT_V
#undef PG8_WAIT_L
#undef PG8_BAR
#undef PG8_SCHED
}

struct EpiBf {
    static constexpr bool PERM = true, CHAIN = false;
    bf16_t* O0; int ld0; int split; bf16_t* O1; int ld1; int act1;
    __device__ __forceinline__ void operator()(const f32x4 (&acc)[2][2][4][2], const Unit& u, int wr, int wc, int fr, int fq) const {
        const bool second = u.pn >= split;
        bf16_t* base = second ? O1 : O0; const int ld = second ? ld1 : ld0; const int colt = (second ? (u.pn - split) : u.pn) * BM;
        const bool act = second && act1;
        const int row0 = u.pm * BM + wr * 64 + fr, col0 = colt + wc * 32 + 8 * fq;
#pragma unroll
        for (int ai = 0; ai < 2; ++ai)
#pragma unroll
            for (int m = 0; m < 4; ++m) { bf16_t* rowp = base + (size_t)(row0 + ai * HALF + m * 16) * ld + col0;
#pragma unroll
                for (int bj = 0; bj < 2; ++bj) { f32x4 v0 = acc[ai][bj][m][0], v1 = acc[ai][bj][m][1];
                    if (act) {
#pragma unroll
                        for (int j = 0; j < 4; ++j) { v0[j] = sigmoidf_(v0[j]); v1[j] = sigmoidf_(v1[j]); } }
                    u32x4 w; w.x = cvt_pk_bf16(v0[0], v0[1]); w.y = cvt_pk_bf16(v0[2], v0[3]); w.z = cvt_pk_bf16(v1[0], v1[1]); w.w = cvt_pk_bf16(v1[2], v1[3]);
                    *(u32x4*)(rowp + bj * HALF) = w; } }
    }
};
struct EpiMerge {
    static constexpr bool PERM = true, CHAIN = true;
    bf16_t* M; const bf16_t* ZG;
    __device__ __forceinline__ bool chain(f32x4 (&acc)[2][2][4][2], const Unit& u, int wr, int wc, int fr, int fq) const {
        const int row0 = u.pm * BM + wr * 64 + fr, col0 = u.pn * BM + wc * 32 + 8 * fq;
#pragma unroll
        for (int ai = 0; ai < 2; ++ai)
#pragma unroll
            for (int m = 0; m < 4; ++m) { const size_t r = (size_t)(row0 + ai * HALF + m * 16);
#pragma unroll
                for (int bj = 0; bj < 2; ++bj) {
                    const bf16_t* gp = ZG + r * 3072 + col0 + bj * HALF;
                    float f[8];
                    if (u.tag == 2) { const u32x4 g = *(const u32x4*)(gp + 2048);
                        f[0] = bflo(g.x); f[1] = bfhi(g.x); f[2] = bflo(g.y); f[3] = bfhi(g.y); f[4] = bflo(g.z); f[5] = bfhi(g.z); f[6] = bflo(g.w); f[7] = bfhi(g.w);
#pragma unroll
                        for (int e = 0; e < 8; ++e) f[e] = fmaxf(f[e], 1e-12f);
                    } else { const u32x4 gn = *(const u32x4*)(gp + u.tag * 1024), gd = *(const u32x4*)(gp + (u.tag + 1) * 1024);
                        const float nn[8] = {bflo(gn.x), bfhi(gn.x), bflo(gn.y), bfhi(gn.y), bflo(gn.z), bfhi(gn.z), bflo(gn.w), bfhi(gn.w)};
                        const float dd[8] = {bflo(gd.x), bfhi(gd.x), bflo(gd.y), bfhi(gd.y), bflo(gd.z), bfhi(gd.z), bflo(gd.w), bfhi(gd.w)};
#pragma unroll
                        for (int e = 0; e < 8; ++e) f[e] = (u.tag == 0 ? nn[e] : fmaxf(nn[e], 1e-12f)) * __builtin_amdgcn_rcpf(fmaxf(dd[e], 1e-12f)); }
                    f32x4& v0 = acc[ai][bj][m][0]; f32x4& v1 = acc[ai][bj][m][1];
                    v0[0] *= f[0]; v0[1] *= f[1]; v0[2] *= f[2]; v0[3] *= f[3]; v1[0] *= f[4]; v1[1] *= f[5]; v1[2] *= f[6]; v1[3] *= f[7];
                    if (u.tag == 2) { u32x4 w; w.x = cvt_pk_bf16(v0[0], v0[1]); w.y = cvt_pk_bf16(v0[2], v0[3]); w.z = cvt_pk_bf16(v1[0], v1[1]); w.w = cvt_pk_bf16(v1[2], v1[3]);
                        *(u32x4*)(M + r * 1024 + col0 + bj * HALF) = w; }
                } }
        return u.tag != 2;
    }
};
struct EpiRes {
    static constexpr bool PERM = true, CHAIN = false;
    const float* xin32; const bf16_t* xin16; bf16_t* xout; const float* gate;
    __device__ __forceinline__ void operator()(const f32x4 (&acc)[2][2][4][2], const Unit& u, int wr, int wc, int fr, int fq) const {
        const int row0 = u.pm * BM + wr * 64 + fr, col0 = u.pn * BM + wc * 32 + 8 * fq;
        const float* gp = gate + (size_t)(u.pm >> 4) * 6144 + col0;
        f32x4 gv[2][2];
#pragma unroll
        for (int bj = 0; bj < 2; ++bj) { gv[bj][0] = *(const f32x4*)(gp + bj * HALF); gv[bj][1] = *(const f32x4*)(gp + bj * HALF + 4); }
#pragma unroll
        for (int ai = 0; ai < 2; ++ai)
#pragma unroll
            for (int m = 0; m < 4; ++m) { const size_t off = (size_t)(row0 + ai * HALF + m * 16) * 1024 + col0;
#pragma unroll
                for (int bj = 0; bj < 2; ++bj) {
                    f32x4 x0, x1;
                    if (xin32) { x0 = *(const f32x4*)(xin32 + off + bj * HALF); x1 = *(const f32x4*)(xin32 + off + bj * HALF + 4); }
                    else { const u32x4 xw = *(const u32x4*)(xin16 + off + bj * HALF);
                        x0 = (f32x4){bflo(xw.x), bfhi(xw.x), bflo(xw.y), bfhi(xw.y)}; x1 = (f32x4){bflo(xw.z), bfhi(xw.z), bflo(xw.w), bfhi(xw.w)}; }
                    const f32x4 o0 = x0 + gv[bj][0] * acc[ai][bj][m][0], o1 = x1 + gv[bj][1] * acc[ai][bj][m][1];
                    u32x4 w; w.x = cvt_pk_bf16(o0[0], o0[1]); w.y = cvt_pk_bf16(o0[2], o0[3]); w.z = cvt_pk_bf16(o1[0], o1[1]); w.w = cvt_pk_bf16(o1[2], o1[3]);
                    *(u32x4*)(xout + off + bj * HALF) = w; } }
    }
};
__device__ __forceinline__ float dpp_prev(float x, float y, int n) {
    if (n == 1) { const int yr = __builtin_amdgcn_update_dpp(0, __float_as_int(y), 0x121, 0xf, 0xf, false);
                  return __int_as_float(__builtin_amdgcn_update_dpp(yr, __float_as_int(x), 0x111, 0xf, 0xf, false)); }
    const int yr = __builtin_amdgcn_update_dpp(0, __float_as_int(y), 0x122, 0xf, 0xf, false);
    return __int_as_float(__builtin_amdgcn_update_dpp(yr, __float_as_int(x), 0x112, 0xf, 0xf, false));
}
struct EpiUp {
    static constexpr bool PERM = true, CHAIN = false;
    bf16_t* U; float* HA; float* HB; const float* cw;
    __device__ __forceinline__ void operator()(const f32x4 (&acc)[2][2][4][2], const Unit& u, int wr, int wc, int fr, int fq) const {
        const int c0 = 128 * u.pn + 32 * wc + 8 * fq;
        float w0[8], w1[8], w2[8];
        { float f[24];
#pragma unroll
          for (int q = 0; q < 6; ++q) { const f32x4 v = *(const f32x4*)(cw + (size_t)c0 * 3 + 4 * q); f[4 * q] = v[0]; f[4 * q + 1] = v[1]; f[4 * q + 2] = v[2]; f[4 * q + 3] = v[3]; }
#pragma unroll
          for (int e = 0; e < 8; ++e) { w0[e] = f[3 * e]; w1[e] = f[3 * e + 1]; w2[e] = f[3 * e + 2]; } }
#pragma unroll
        for (int ai = 0; ai < 2; ++ai) {
            const int grp = 4 * u.pm + 2 * ai + wr;
            float Y[8];
#pragma unroll
            for (int e = 0; e < 8; ++e) Y[e] = 0.f;
#pragma unroll
            for (int m = 0; m < 4; ++m) {
                const size_t row = (size_t)u.pm * BM + ai * HALF + wr * 64 + m * 16 + fr;
                float X[8], G[8], o[8];
#pragma unroll
                for (int e = 0; e < 8; ++e) { X[e] = acc[ai][0][m][e >> 2][e & 3]; G[e] = acc[ai][1][m][e >> 2][e & 3]; }
#pragma unroll
                for (int e = 0; e < 8; ++e) { const float a1 = dpp_prev(X[e], Y[e], 1), a2 = dpp_prev(X[e], Y[e], 2);
                    const float s = w0[e] * a2 + w1[e] * a1 + w2[e] * X[e]; o[e] = s * sigmoidf_(s) * G[e]; }
                if (m > 0 || fr >= 2) { u32x4 w; w.x = cvt_pk_bf16(o[0], o[1]); w.y = cvt_pk_bf16(o[2], o[3]); w.z = cvt_pk_bf16(o[4], o[5]); w.w = cvt_pk_bf16(o[6], o[7]);
                    *(u32x4*)(U + row * DFF + c0) = w; }
                if (m == 0 && fr < 2) { float* hb = HB + ((size_t)(grp * 2 + fr) * 2) * DFF + c0;
                    *(f32x4*)hb = (f32x4){X[0], X[1], X[2], X[3]}; *(f32x4*)(hb + 4) = (f32x4){X[4], X[5], X[6], X[7]};
                    *(f32x4*)(hb + DFF) = (f32x4){G[0], G[1], G[2], G[3]}; *(f32x4*)(hb + DFF + 4) = (f32x4){G[4], G[5], G[6], G[7]}; }
                if (m == 3 && fr >= 14) { float* ha = HA + (size_t)(grp * 2 + fr - 14) * DFF + c0;
                    *(f32x4*)ha = (f32x4){X[0], X[1], X[2], X[3]}; *(f32x4*)(ha + 4) = (f32x4){X[4], X[5], X[6], X[7]}; }
#pragma unroll
                for (int e = 0; e < 8; ++e) Y[e] = X[e];
            }
        }
    }
};
struct MergeOrder {
    int G, c; const char* o_att; const char* wbr;
    __device__ bool next(int i, Unit& u) const {
        const int tile = (i / 3) * G + c; if (tile >= (T_ / BM) * 4) return false;
        const int br = i % 3; u.pm = tile >> 2; u.pn = tile & 3; u.tag = br;
        u.A = o_att - (size_t)br * (32 * MiB) + (size_t)u.pm * BM * 512 * 2;
        u.B = wbr + (size_t)br * 1024 * 512 * 2 + (size_t)u.pn * BM * 512 * 2; return true;
    }
};
}

#define GSTRIDE_BLOCKS(var, n) for (int var = blockIdx.x; var < (n); var += gridDim.x)

__device__ __forceinline__ void ph_mod(const Params& P, LAS unsigned char* lds) {
    LAS float* red = (LAS float*)lds;
    float* mod = (float*)(P.ws + OFF_MOD); float* tab = (float*)(P.ws + OFF_TAB);
    const int tid = opaque_tid(), wid = tid >> 6, lane = tid & 63;
    GSTRIDE_BLOCKS(blk, 192) {
        const int l = blk / 96, jb = blk % 96, j = jb * 64 + lane;
        float acc[8];
#pragma unroll
        for (int b = 0; b < 8; ++b) acc[b] = 0.f;
        const float* aw = P.ada_w + (size_t)l * 1024 * 6144 + j;
        for (int k = wid * 128; k < wid * 128 + 128; ++k) {
            const float w = aw[(size_t)k * 6144];
#pragma unroll
            for (int b = 0; b < 8; ++b) acc[b] += P.c[b * 1024 + k] * w;
        }
#pragma unroll
        for (int b = 0; b < 8; ++b) red[(wid * 8 + b) * 64 + lane] = acc[b];
        __syncthreads();
        { const int b = wid; float s = P.ada_b[l * 6144 + j];
#pragma unroll
          for (int w = 0; w < 8; ++w) s += red[(w * 8 + b) * 64 + lane];
          mod[((size_t)l * 8 + b) * 6144 + j] = s; }
        __syncthreads();
    }
    if (blockIdx.x == gridDim.x - 1) {
        for (int i = tid; i < 1024; i += NTHR) { const int n = i >> 3, h = i & 7; int bk;
            if (n < 16) bk = n; else { const float nf = (float)n; bk = 16 + (int)(logf(nf / 16.0f) / 2.0794415416798357f * 16.0f); bk = bk < 31 ? bk : 31; }
            tab[i] = P.rel_bias[bk * 8 + h]; }
    }
}

struct WJob { const float* src; int ldsrc; int K; int N; bf16_t* dst; int win; };
template <int KT  >
__device__ __forceinline__ void conv_tiles(const WJob& J, LAS float* tile  ) {
    const int tid = opaque_tid(); const int nkt = J.K / KT, nnt = J.N / 64, ntiles = nkt * nnt;
    GSTRIDE_BLOCKS(ti, ntiles) {
        const int kt = ti % nkt, ntb = ti / nkt, k0 = kt * KT, n0 = ntb * 64;
        { const int n = tid & 63, kk0 = tid >> 6; const int nn = n0 + n; int col = nn;
          if (J.win == 1) col = nn < 2120 ? nn : (nn < 2304 ? -1 : nn - 184);
          if (J.win == 2) col = ((nn & 255) < 128) ? 128 * (nn >> 8) + (nn & 127) : DFF + 128 * (nn >> 8) + (nn & 127);
          float v[KT / 8];
#pragma unroll
          for (int p = 0; p < KT / 8; ++p) { const int k = kk0 + 8 * p; v[p] = col >= 0 ? J.src[(size_t)(k0 + k) * J.ldsrc + col] : 0.f; }
#pragma unroll
          for (int p = 0; p < KT / 8; ++p) tile[(kk0 + 8 * p) * 65 + n] = v[p]; }
        __syncthreads();
#pragma unroll
        for (int q = 0; q < KT / 64; ++q) { const int n = tid >> 3, kg = (tid & 7) + 8 * q; float v[8];
#pragma unroll
          for (int e = 0; e < 8; ++e) v[e] = tile[(kg * 8 + e) * 65 + n];
          u32x4 w; w.x = cvt_pk_bf16(v[0], v[1]); w.y = cvt_pk_bf16(v[2], v[3]); w.z = cvt_pk_bf16(v[4], v[5]); w.w = cvt_pk_bf16(v[6], v[7]);
          *(u32x4*)(J.dst + (size_t)(n0 + n) * J.K + k0 + kg * 8) = w; }
        __syncthreads();
    }
}
__device__ __forceinline__ void ph_wconv(const Params& P, int l, LAS unsigned char* lds) {
    LAS float* tile = (LAS float*)lds; unsigned char* wb = P.ws + OFF_WB;
    { WJob J{P.w_in + (size_t)l * 1024 * IN_COLS, IN_COLS, 1024, 8704, (bf16_t*)(wb + WB_WIN), 1}; conv_tiles<256>(J, tile); }
    for (int i = 0; i < 3; ++i) { WJob J{P.w_branch + ((size_t)l * 3 + i) * 512 * 1024, 1024, 512, 1024, (bf16_t*)(wb + WB_WBR) + (size_t)i * 1024 * 512, 0}; conv_tiles<256>(J, tile); }
    { WJob J{P.w_o + (size_t)l * 1024 * 1024, 1024, 1024, 1024, (bf16_t*)(wb + WB_WO), 0}; conv_tiles<256>(J, tile); }
    { WJob J{P.ffn_w_up + (size_t)l * 1024 * 5632, 5632, 1024, 5632, (bf16_t*)(wb + WB_WUP), 2}; conv_tiles<256>(J, tile); }
    { WJob J{P.ffn_w_down + (size_t)l * 2816 * 1024, 1024, 2816, 1024, (bf16_t*)(wb + WB_WDN), 0}; conv_tiles<256>(J, tile); }
    { WJob J{P.w_up + (size_t)l * 64 * 512, 512, 64, 512, (bf16_t*)(wb + WB_LW), 0}; conv_tiles<64>(J, tile); }
    { WJob J{P.a_up + (size_t)l * 64 * 512, 512, 64, 512, (bf16_t*)(wb + WB_LA), 0}; conv_tiles<64>(J, tile); }
    { WJob J{P.g_up + (size_t)l * 128 * 512, 512, 128, 512, (bf16_t*)(wb + WB_LG), 0}; conv_tiles<64>(J, tile); }
}

__device__ __forceinline__ void ph_norm(const Params& P, int l, int which) {
    const bool first = (l == 0 && which == 0);
    const float* nw = (which == 0 ? P.norm_mix : P.norm_ffn) + l * 1024;
    const float* mod = (const float*)(P.ws + OFF_MOD) + (size_t)l * 8 * 6144 + which * 3072;
    const bf16_t* XB = (const bf16_t*)P.out;
    bf16_t* H = (bf16_t*)(P.ws + OFF_H);
    const int tid = opaque_tid(), wid = tid >> 6, lane = tid & 63;
    for (int row = blockIdx.x * 8 + wid; row < T_; row += gridDim.x * 8) {
        const int b = row >> 12; const float* mb = mod + (size_t)b * 6144;
        f32x4 v[4]; float ss = 0.f;
#pragma unroll
        for (int i = 0; i < 4; ++i) {
            if (first) v[i] = *(const f32x4*)(P.x_in + (size_t)row * 1024 + i * 256 + lane * 4);
            else { const u32x2 w = *(const u32x2*)(XB + (size_t)row * 1024 + i * 256 + lane * 4); v[i] = (f32x4){bflo(w.x), bfhi(w.x), bflo(w.y), bfhi(w.y)}; }
            ss += v[i][0] * v[i][0] + v[i][1] * v[i][1] + v[i][2] * v[i][2] + v[i][3] * v[i][3]; }
        ss = wave_sum(ss, lane);
        const float rstd = rsqrtf(ss * (1.0f / 1024.0f) + 1e-6f);
#pragma unroll
        for (int i = 0; i < 4; ++i) { const int c = i * 256 + lane * 4;
            const f32x4 g = *(const f32x4*)(nw + c), sh = *(const f32x4*)(mb + c), sc = *(const f32x4*)(mb + 1024 + c);
            const f32x4 y = v[i] * rstd * g * (sc + 1.0f) + sh;
            u32x2 w; w.x = cvt_pk_bf16(y[0], y[1]); w.y = cvt_pk_bf16(y[2], y[3]);
            *(u32x2*)(H + (size_t)row * 1024 + c) = w; }
    }
}

__device__ __forceinline__ void ph_final(const Params& P) {
    const bf16_t* XF = (const bf16_t*)(P.ws + OFF_H);
    const int tid = opaque_tid(), wid = tid >> 6, lane = tid & 63;
    for (int row = blockIdx.x * 8 + wid; row < T_; row += gridDim.x * 8) {
        float* xr = P.out + (size_t)row * 1024;
        f32x4 v[4]; float ss = 0.f;
#pragma unroll
        for (int i = 0; i < 4; ++i) { const u32x2 w = *(const u32x2*)(XF + (size_t)row * 1024 + i * 256 + lane * 4); v[i] = (f32x4){bflo(w.x), bfhi(w.x), bflo(w.y), bfhi(w.y)};
            ss += v[i][0] * v[i][0] + v[i][1] * v[i][1] + v[i][2] * v[i][2] + v[i][3] * v[i][3]; }
        ss = wave_sum(ss, lane);
        const float rstd = rsqrtf(ss * (1.0f / 1024.0f) + 1e-6f);
#pragma unroll
        for (int i = 0; i < 4; ++i) { const int c = i * 256 + lane * 4; const f32x4 g = *(const f32x4*)(P.final_norm + c);
            *(f32x4*)(xr + c) = v[i] * rstd * g; }
    }
}

__device__ __forceinline__ void ph_gemm_zq(const Params& P, LAS unsigned char* lds) {
    g8::SOrder S; S.init(T_, 2304, 1024, 1024, P.ws + OFF_H, P.ws + OFF_WB + WB_WIN);
    g8::EpiBf E{(bf16_t*)(P.ws + OFF_ZQ), 2304, 9, nullptr, 0, 0};
    g8::gemm_phase(lds, 1024, 1024, 1024, S, E);
}
__device__ __forceinline__ void ph_gemm_zr(const Params& P, LAS unsigned char* lds) {
    g8::SOrder S; S.init(T_, 1792, 1024, 1024, P.ws + OFF_H, P.ws + OFF_WB + WB_WIN + (size_t)2304 * 1024 * 2);
    g8::EpiBf E{(bf16_t*)(P.ws + OFF_ZR), 1792, 7, nullptr, 0, 0};
    g8::gemm_phase(lds, 1024, 1024, 1024, S, E);
}
__device__ __forceinline__ void ph_gemm_zc(const Params& P, LAS unsigned char* lds) {
    g8::SOrder S; S.init(T_, 4608, 1024, 1024, P.ws + OFF_H, P.ws + OFF_WB + WB_WIN + (size_t)4096 * 1024 * 2);
    g8::EpiBf E{(bf16_t*)(P.ws + OFF_ZCV), 1536, 6, (bf16_t*)(P.ws + OFF_ZG), 3072, 1};
    g8::gemm_phase(lds, 1024, 1024, 1024, S, E);
}
__device__ __forceinline__ void ph_gemm_merge(const Params& P, LAS unsigned char* lds) {
    g8::MergeOrder S{(int)gridDim.x, (int)blockIdx.x, (const char*)(P.ws + OFF_OATT), (const char*)(P.ws + OFF_WB + WB_WBR)};
    g8::EpiMerge E{(bf16_t*)(P.ws + OFF_MRG), (const bf16_t*)(P.ws + OFF_ZG)};
    g8::gemm_phase(lds, 512, 512, 512, S, E);
}
__device__ __forceinline__ void ph_gemm_wo(const Params& P, int l, LAS unsigned char* lds) {
    g8::SOrder S; S.init(T_, 1024, 1024, 1024, P.ws + OFF_MRG, P.ws + OFF_WB + WB_WO);
    g8::EpiRes E{l == 0 ? P.x_in : nullptr, (const bf16_t*)P.out, (bf16_t*)P.out, (const float*)(P.ws + OFF_MOD) + (size_t)l * 8 * 6144 + 2048};
    g8::gemm_phase(lds, 1024, 1024, 1024, S, E);
}
__device__ __forceinline__ void ph_gemm_up(const Params& P, int l, LAS unsigned char* lds) {
    g8::SOrder S; S.init(T_, 5632, 1024, 1024, P.ws + OFF_H, P.ws + OFF_WB + WB_WUP);
    g8::EpiUp E{(bf16_t*)(P.ws + OFF_UP), (float*)(P.ws + OFF_HA), (float*)(P.ws + OFF_HB), P.ffn_conv_w + (size_t)l * DFF * 3};
    g8::gemm_phase(lds, 1024, 1024, 1024, S, E);
}
__device__ __forceinline__ void ph_gemm_down(const Params& P, int l, LAS unsigned char* lds) {
    g8::SOrder S; S.init(T_, 1024, 2816, 2816, P.ws + OFF_UP, P.ws + OFF_WB + WB_WDN);
    g8::EpiRes E{nullptr, (const bf16_t*)P.out, l == 1 ? (bf16_t*)(P.ws + OFF_H) : (bf16_t*)P.out, (const float*)(P.ws + OFF_MOD) + (size_t)l * 8 * 6144 + 5120};
    g8::gemm_phase(lds, 2816, 2816, 2816, S, E);
}

__device__ __forceinline__ void ph_conv(const Params& P, int l, LAS unsigned char* lds) {
    const bf16_t* Z = (const bf16_t*)(P.ws + OFF_ZCV); bf16_t* O = (bf16_t*)(P.ws + OFF_OCONV);
    LAS float* cwT = (LAS float*)lds;
    const int tid = opaque_tid();
    for (int i = tid; i < 1536; i += NTHR) cwT[(i % 3) * 512 + i / 3] = P.sc_conv_w[(size_t)l * 1536 + i];
    __syncthreads();
    constexpr int RB = 16; const int nitem = (T_ / RB) * 64;
    for (int it = blockIdx.x * NTHR + tid; it < nitem; it += gridDim.x * NTHR) {
        const int rb = it >> 6, c0 = (it & 63) * 8, row0 = rb * RB, t0 = row0 & 4095;
        float w0[8], w1[8], w2[8];
#pragma unroll
        for (int e = 0; e < 8; ++e) { w0[e] = cwT[c0 + e]; w1[e] = cwT[512 + c0 + e]; w2[e] = cwT[1024 + c0 + e]; }
        float pm2[8], pm1[8];
#pragma unroll
        for (int e = 0; e < 8; ++e) { pm2[e] = 0.f; pm1[e] = 0.f; }
        if (t0 >= 2) {
#pragma unroll
            for (int j = 0; j < 2; ++j) { const bf16_t* zr = Z + (size_t)(row0 - 2 + j) * 1536;
                const u32x4 cc = *(const u32x4*)(zr + 512 + c0), cx = *(const u32x4*)(zr + 1024 + c0);
                const unsigned ccw[4] = {cc.x, cc.y, cc.z, cc.w}, cxw[4] = {cx.x, cx.y, cx.z, cx.w};
#pragma unroll
                for (int q = 0; q < 4; ++q) { const float a = bflo(ccw[q]) * bflo(cxw[q]), b2 = bfhi(ccw[q]) * bfhi(cxw[q]);
                    if (j == 0) { pm2[2 * q] = a; pm2[2 * q + 1] = b2; } else { pm1[2 * q] = a; pm1[2 * q + 1] = b2; } } }
        }
#pragma unroll 4
        for (int r = 0; r < RB; ++r) {
            const bf16_t* zr = Z + (size_t)(row0 + r) * 1536;
            const u32x4 cb = *(const u32x4*)(zr + c0), cc = *(const u32x4*)(zr + 512 + c0), cx = *(const u32x4*)(zr + 1024 + c0);
            const unsigned cbw[4] = {cb.x, cb.y, cb.z, cb.w}, ccw[4] = {cc.x, cc.y, cc.z, cc.w}, cxw[4] = {cx.x, cx.y, cx.z, cx.w};
            float cur[8], o[8];
#pragma unroll
            for (int q = 0; q < 4; ++q) { cur[2 * q] = bflo(ccw[q]) * bflo(cxw[q]); cur[2 * q + 1] = bfhi(ccw[q]) * bfhi(cxw[q]); }
#pragma unroll
            for (int e = 0; e < 8; ++e) { o[e] = w0[e] * pm2[e] + w1[e] * pm1[e] + w2[e] * cur[e]; pm2[e] = pm1[e]; pm1[e] = cur[e]; }
            u32x4 w; w.x = cvt_pk_bf16(o[0] * bflo(cbw[0]), o[1] * bfhi(cbw[0])); w.y = cvt_pk_bf16(o[2] * bflo(cbw[1]), o[3] * bfhi(cbw[1]));
            w.z = cvt_pk_bf16(o[4] * bflo(cbw[2]), o[5] * bfhi(cbw[2])); w.w = cvt_pk_bf16(o[6] * bflo(cbw[3]), o[7] * bfhi(cbw[3]));
            *(u32x4*)(O + (size_t)(row0 + r) * 512 + c0) = w;
        }
    }
}

__device__ __forceinline__ void ph_ufix(const Params& P, int l, LAS unsigned char* lds) {
    bf16_t* U = (bf16_t*)(P.ws + OFF_UP); const float* HA = (const float*)(P.ws + OFF_HA); const float* HB = (const float*)(P.ws + OFF_HB);
    LAS float* cwT = (LAS float*)lds;
    const int tid = opaque_tid();
    for (int i = tid; i < DFF * 3; i += NTHR) cwT[(i % 3) * DFF + i / 3] = P.ffn_conv_w[(size_t)l * DFF * 3 + i];
    __syncthreads();
    const int nitem = (T_ / 64) * 2 * 352;
    for (int it = blockIdx.x * NTHR + tid; it < nitem; it += gridDim.x * NTHR) {
        const int c0 = (it % 352) * 8, gr = it / 352, grp = gr >> 1, rr = gr & 1; const bool first = (grp & 63) == 0;
        const float* hb = HB + ((size_t)(grp * 2 + rr) * 2) * DFF + c0;
        float a0[8], a1[8], a2[8], g[8];
#pragma unroll
        for (int q = 0; q < 2; ++q) { const f32x4 va = *(const f32x4*)(hb + 4 * q), vg = *(const f32x4*)(hb + DFF + 4 * q);
#pragma unroll
            for (int e = 0; e < 4; ++e) { a0[4 * q + e] = va[e]; g[4 * q + e] = vg[e]; a1[4 * q + e] = 0.f; a2[4 * q + e] = 0.f; } }
        if (rr == 1) { const float* p1 = HB + ((size_t)(grp * 2) * 2) * DFF + c0;
#pragma unroll
            for (int q = 0; q < 2; ++q) { const f32x4 v = *(const f32x4*)(p1 + 4 * q);
#pragma unroll
                for (int e = 0; e < 4; ++e) a1[4 * q + e] = v[e]; } }
        if (!first) {
            const float* pl = HA + (size_t)((grp - 1) * 2 + 1) * DFF + c0;
            const float* pk = HA + (size_t)((grp - 1) * 2) * DFF + c0;
#pragma unroll
            for (int q = 0; q < 2; ++q) { const f32x4 v63 = *(const f32x4*)(pl + 4 * q), v62 = *(const f32x4*)(pk + 4 * q);
#pragma unroll
                for (int e = 0; e < 4; ++e) { if (rr == 1) a2[4 * q + e] = v63[e]; else { a1[4 * q + e] = v63[e]; a2[4 * q + e] = v62[e]; } } }
        }
        float o[8];
#pragma unroll
        for (int e = 0; e < 8; ++e) { const float s = cwT[c0 + e] * a2[e] + cwT[DFF + c0 + e] * a1[e] + cwT[2 * DFF + c0 + e] * a0[e]; o[e] = s * sigmoidf_(s) * g[e]; }
        u32x4 w; w.x = cvt_pk_bf16(o[0], o[1]); w.y = cvt_pk_bf16(o[2], o[3]); w.z = cvt_pk_bf16(o[4], o[5]); w.w = cvt_pk_bf16(o[6], o[7]);
        *(u32x4*)(U + (size_t)(grp * 64 + rr) * DFF + c0) = w;
    }
}

template <int NR>
__device__ __forceinline__ u64 select_row(LAS float* row, const int t, const int lz) {
    const int imax = t >> 6;
    float x[NR]; float Tx = 0.f; bool have = false, exact = false;
    {
        int bin[NR]; float lo = __builtin_inff(), hi = -__builtin_inff();
        LAS unsigned* hist = (LAS unsigned*)row;
#pragma unroll
        for (int i = 0; i < NR; ++i) { const float v = row[64 * i + lz]; x[i] = (i <= imax) ? v : -__builtin_inff(); hi = fmaxf(hi, x[i]); lo = fminf(lo, (i < imax || x[i] > -__builtin_inff()) ? x[i] : __builtin_inff()); }
#pragma unroll
        for (int o = 32; o >= 1; o >>= 1) { lo = fminf(lo, shx(lo, o, lz)); hi = fmaxf(hi, shx(hi, o, lz)); }
        if (hi > lo) {
            const float scale = 4095.0f / (hi - lo);
#pragma unroll
            for (int q = 0; q < 16; ++q) *(LAS u32x4*)(hist + 256 * q + 4 * lz) = (u32x4){0u, 0u, 0u, 0u};
#pragma unroll
            for (int i = 0; i < NR; ++i) {
                const int bq = (int)fminf(fmaxf((x[i] - lo) * scale, -1.0f), 4095.0f); bin[i] = bq;
                if (bq >= 0) __hip_atomic_fetch_add(hist + bq, 1u, __ATOMIC_RELAXED, __HIP_MEMORY_SCOPE_WORKGROUP); }
            unsigned c1 = 0u;
#pragma unroll
            for (int q = 0; q < 16; ++q) { const u32x4 h4 = *(const LAS u32x4*)(hist + 64 * lz + 4 * ((q + lz) & 15)); c1 += (h4.x + h4.y) + (h4.z + h4.w); }
            unsigned inc = c1;
#pragma unroll
            for (int o = 1; o <= 32; o <<= 1) { const unsigned v = (unsigned)__builtin_amdgcn_ds_bpermute(((lz + o) & 63) << 2, (int)inc); inc += (lz + o < 64) ? v : 0u; }
            const unsigned ab1 = inc - c1;
            const u64 cr1 = __ballot(ab1 < 256u && ab1 + c1 >= 256u);
            const int L1 = __builtin_ctzll(cr1);
            const unsigned abL = (unsigned)__builtin_amdgcn_readlane((int)ab1, L1);
            const unsigned c2 = hist[64 * L1 + lz];
            unsigned inc2 = c2;
#pragma unroll
            for (int o = 1; o <= 32; o <<= 1) { const unsigned v = (unsigned)__builtin_amdgcn_ds_bpermute(((lz + o) & 63) << 2, (int)inc2); inc2 += (lz + o < 64) ? v : 0u; }
            const unsigned ab2 = inc2 - c2 + abL;
            const u64 cr2 = __ballot(ab2 < 256u && ab2 + c2 >= 256u);
            const int L2 = __builtin_ctzll(cr2);
            const int bstar = 64 * L1 + L2;
            const int cb = __builtin_amdgcn_readlane((int)c2, L2), need2 = 256 - __builtin_amdgcn_readlane((int)ab2, L2);
            if (cb <= 64) {
                int cand = 0; int pos = 0;
#pragma unroll
                for (int i = 0; i < NR; ++i) { u64 mm = __ballot(bin[i] == bstar);
                    while (mm) { const int s = __builtin_ctzll(mm); mm &= mm - 1ull; cand = writelane_v(cand, __builtin_amdgcn_readlane(__float_as_int(x[i]), s), pos); ++pos; } }
                const unsigned cu = (lz < cb) ? f2ord(__int_as_float(cand)) : 0u;
                unsigned Tc = 0u;
#pragma unroll 1
                for (int bit = 31; bit >= 0; --bit) { const unsigned cd = Tc | (1u << bit); if ((int)__popcll(__ballot(cu >= cd)) >= need2) Tc = cd; }
                Tx = ord2f(Tc); have = true; exact = (256 - need2) + (int)__popcll(__ballot(cu >= Tc)) == 256;
            }
        }
    }
    if (!have) {
        unsigned Tt = 0u;
#pragma unroll 1
        for (int bit = 31; bit >= 0; --bit) {
            const unsigned cand = Tt | (1u << bit); int cnt = 0;
#pragma unroll
            for (int i = 0; i < NR; ++i) cnt += __popcll(__ballot(f2ord(x[i]) >= cand));
            if (cnt >= 256) Tt = cand;
        }
        Tx = ord2f(Tt);
    }
    int wlo = 0, whi = 0;
#pragma unroll
    for (int i = 0; i < NR; ++i) { const u64 g = __ballot(x[i] >= Tx); writelane_c2(wlo, whi, (int)(unsigned)g, (int)(unsigned)(g >> 32), i); }
    u64 myw = ((u64)(unsigned)whi << 32) | (unsigned)wlo;
    if (!exact) {
        int cgt = 0;
#pragma unroll
        for (int i = 0; i < NR; ++i) cgt += __popcll(__ballot(x[i] > Tx));
        int need = 256 - cgt; myw = 0ull;
#pragma unroll
        for (int i = 0; i < NR; ++i) {
            const u64 g = __ballot(x[i] > Tx); u64 e = __ballot(x[i] == Tx);
            int ne = __popcll(e);
            while (ne > need) { e &= ~(1ull << (63 - __clzll(e))); --ne; }
            need -= ne;
            if (lz == i) myw = g | e;
        }
    }
    return myw;
}

__device__ __forceinline__ void ph_idx(const Params& P, LAS unsigned char* lds) {
    LAS float* SC = (LAS float*)lds;
    const bf16_t* ZQ = (const bf16_t*)(P.ws + OFF_ZQ); u64* MASK = (u64*)(P.ws + OFF_MASK);
    const int tid = opaque_tid(), wid = __builtin_amdgcn_readfirstlane(tid >> 6), lane = tid & 63, m = lane & 31, hh = lane >> 5;
    { int* KPM = (int*)(P.ws + OFF_KPM);
      for (int i = blockIdx.x * NTHR + tid; i < NB_ * 64; i += gridDim.x * NTHR) { const int* pp = P.pos + (i >> 6) * S_ + (i & 63) * 64; int mxp = pp[0];
          for (int k = 1; k < 64; ++k) mxp = pp[k] > mxp ? pp[k] : mxp;
          KPM[i] = mxp; } }
    int itc = 0;
    for (int idx = blockIdx.x; idx < NB_ * 512; idx += gridDim.x, ++itc) {
        const int b = idx & 7, j = idx >> 3; const int qb = (itc & 1) ? (j ^ 31) : j; const int t0 = qb * 8;
        const bf16_t* zb = ZQ + (size_t)b * S_ * 2304;
        bf16x8 Af[2][4]; float wv[2][16];
#pragma unroll
        for (int blk = 0; blk < 2; ++blk) {
            const bf16_t* qp = zb + (size_t)(t0 + 4 * blk + 2 * ((m >> 2) & 1) + (m >> 4)) * 2304 + 1536 + (4 * ((m >> 3) & 1) + (m & 3)) * 64 + 8 * hh;
#pragma unroll
            for (int ks = 0; ks < 4; ++ks) Af[blk][ks] = *(const bf16x8*)(qp + 16 * ks);
#pragma unroll
            for (int q = 0; q < 2; ++q) { const u32x4 ww = *(const u32x4*)(zb + (size_t)(t0 + 4 * blk + 2 * hh + q) * 2304 + 2112);
                wv[blk][8 * q + 0] = bflo(ww.x); wv[blk][8 * q + 1] = bfhi(ww.x); wv[blk][8 * q + 2] = bflo(ww.y); wv[blk][8 * q + 3] = bfhi(ww.y);
                wv[blk][8 * q + 4] = bflo(ww.z); wv[blk][8 * q + 5] = bfhi(ww.z); wv[blk][8 * q + 6] = bflo(ww.w); wv[blk][8 * q + 7] = bfhi(ww.w); }
        }
        const int ntile = 2 * ((t0 + 7) / 64 + 1);
        for (int kt = wid; kt < ntile; kt += 8) {
            const bf16_t* kp = zb + (size_t)(32 * kt + m) * 2304 + 2048 + 8 * hh;
            bf16x8 Bf[4];
#pragma unroll
            for (int ks = 0; ks < 4; ++ks) Bf[ks] = *(const bf16x8*)(kp + 16 * ks);
#pragma unroll
            for (int blk = 0; blk < 2; ++blk) {
                f32x16 Dv;
#pragma unroll
                for (int r = 0; r < 16; ++r) Dv[r] = 0.f;
#pragma unroll
                for (int ks = 0; ks < 4; ++ks) Dv = __builtin_amdgcn_mfma_f32_32x32x16_bf16(Af[blk][ks], Bf[ks], Dv, 0, 0, 0);
#pragma unroll
                for (int q = 0; q < 2; ++q) {
                    float part = 0.f;
#pragma unroll
                    for (int e = 0; e < 8; ++e) { const float d = Dv[8 * q + e], w = wv[blk][8 * q + e]; part = __builtin_fmaf(w, d, part); part = __builtin_fmaf(w, __builtin_fabsf(d), part); }
                    SC[(4 * blk + 2 * hh + q) * 4096 + 32 * kt + m] = (32 * kt + m <= t0 + 4 * blk + 2 * hh + q) ? part : -__builtin_inff();
                }
            }
        }
        __syncthreads();
        {
            const int t = t0 + wid; u64* mrow = MASK + (size_t)(b * S_ + t) * 64;
            if (t < 256) {
                const int lo = 64 * lane; u64 w;
                if (t >= lo + 63) w = ~0ull; else if (t < lo) w = 0ull; else w = (2ull << (t - lo)) - 1ull;
                mrow[lane] = w;
            } else {
                int lz = threadIdx.x; asm volatile("" : "+v"(lz)); lz &= 63;
                LAS float* rowp = SC + wid * 4096; u64 myw;
                if (t < 512) myw = select_row<8>(rowp, t, lz); else if (t < 1024) myw = select_row<16>(rowp, t, lz); else if (t < 2048) myw = select_row<32>(rowp, t, lz); else myw = select_row<64>(rowp, t, lz);
                mrow[lz] = myw;
            }
        }
        __syncthreads();
    }
    {
        LAS bf16_t* tl = (LAS bf16_t*)lds;
        bf16_t* VT = (bf16_t*)(P.ws + OFF_VT);
        for (int it = blockIdx.x; it < NB_ * 8 * 64; it += gridDim.x) {
            const int b = it >> 9, h = (it >> 6) & 7, k0 = (it & 63) * 64;
            { const int row = tid >> 3, ch = tid & 7;
              const u32x4 v = *(const u32x4*)(ZQ + (size_t)(b * S_ + k0 + row) * 2304 + 1024 + h * 64 + ch * 8);
              *(LAS u32x4*)(tl + row * 72 + ch * 8) = v; }
            __syncthreads();
            { const int d = tid >> 3, kc = tid & 7; unsigned short e[8];
#pragma unroll
              for (int q = 0; q < 8; ++q) e[q] = tl[(kc * 8 + q) * 72 + d];
              u32x4 w; w.x = e[0] | ((unsigned)e[1] << 16); w.y = e[2] | ((unsigned)e[3] << 16); w.z = e[4] | ((unsigned)e[5] << 16); w.w = e[6] | ((unsigned)e[7] << 16);
              *(u32x4*)(VT + ((size_t)((b * 8 + h) * 64 + d)) * S_ + k0 + kc * 8) = w; }
            __syncthreads();
        }
    }
}

__device__ __forceinline__ int bitmask(int w, int pos  ) { int m; asm("v_bfe_i32 %0, %1, %2, 1" : "=v"(m) : "v"(w), "n"(pos)); return m; }
__device__ __forceinline__ void ph_att(const Params& P, LAS unsigned char* lds) {
    LAS float* TABL = (LAS float*)lds;
    LAS unsigned char* KB = lds + 4096;
    constexpr int KT_B = 64 * 144, VT_B = 64 * 136, BUF_B = KT_B + VT_B;
    constexpr float LOG2E = 1.4426950408889634f;
    const float* tabg = (const float*)(P.ws + OFF_TAB);
    const int tid = opaque_tid(), wid = __builtin_amdgcn_readfirstlane(tid >> 6), lane = tid & 63, m = lane & 31, hh = lane >> 5;
    for (int i = tid; i < 1024; i += NTHR) TABL[i] = tabg[i] * LOG2E;
    __syncthreads();
    const bf16_t* ZQ = (const bf16_t*)(P.ws + OFF_ZQ); const u64* MASK = (const u64*)(P.ws + OFF_MASK);
    const bf16_t* VT = (const bf16_t*)(P.ws + OFF_VT); bf16_t* OA = (bf16_t*)(P.ws + OFF_OATT); const int* KPM = (const int*)(P.ws + OFF_KPM);
    int itc = 0;
    for (int idx = blockIdx.x; idx < NB_ * 8 * 16; idx += gridDim.x, ++itc) {
        const int b = idx & 7, head = (idx >> 3) & 7, j = idx >> 6; const int qb = (itc & 1) ? (j ^ 3) : j;
        const int q0 = qb * 256, tq0 = q0 + 32 * wid, t = tq0 + m;
        const bf16_t* zb = ZQ + (size_t)b * S_ * 2304;
        bf16x8 Qf[4];
        { const bf16_t* qp = zb + (size_t)t * 2304 + head * 64 + 8 * hh;
#pragma unroll
          for (int ks = 0; ks < 4; ++ks) Qf[ks] = *(const bf16x8*)(qp + 16 * ks); }
        const int posq = P.pos[b * S_ + t];
        int minq = posq;
#pragma unroll
        for (int o = 32; o >= 1; o >>= 1) { const int v = shxi(minq, o, lane); minq = v < minq ? v : minq; }
        minq = __builtin_amdgcn_readfirstlane(minq);
        const u64* mrow = MASK + (size_t)(b * S_ + t) * 64;
        const bf16_t* vtb = VT + (size_t)(b * 8 + head) * 64 * S_;
        const float c1 = 0.125f * LOG2E, c2 = TABL[127 * 8 + head];
        f32x16 O0, O1, OL;
#pragma unroll
        for (int r = 0; r < 16; ++r) { O0[r] = 0.f; O1[r] = 0.f; OL[r] = 0.f; }
        const bf16x8 ones8 = {0x3F80, 0x3F80, 0x3F80, 0x3F80, 0x3F80, 0x3F80, 0x3F80, 0x3F80};
        float m_run = -1e30f;
        const int nt = 4 * qb + 4, my_nt = ((tq0 + 31) >> 6) + 1;
        const int skey = tid >> 3, sch = tid & 7;
        const bf16_t* kg = zb + (size_t)skey * 2304 + 512 + head * 64 + 8 * sch;
        const bf16_t* vg = vtb + (size_t)skey * S_ + 8 * sch;
        LAS unsigned char* kdst = KB + skey * 144 + sch * 16; LAS unsigned char* vdst = KB + KT_B + skey * 136 + sch * 16;
        u64 mw_nxt = mrow[0]; const int kpm_l = KPM[b * 64 + lane];
        auto tile = [&](const int kt, const int boff) {
                const LAS unsigned char* Kt = KB + boff; const LAS unsigned char* Vt = Kt + KT_B;
                f32x16 D0, D1;
#pragma unroll
                for (int r = 0; r < 16; ++r) { D0[r] = 0.f; D1[r] = 0.f; }
#pragma unroll
                for (int ks = 0; ks < 4; ++ks) {
                    const bf16x8 K0 = *(const LAS bf16x8*)(Kt + m * 144 + 32 * ks + 16 * hh), K1 = *(const LAS bf16x8*)(Kt + (32 + m) * 144 + 32 * ks + 16 * hh);
                    D0 = __builtin_amdgcn_mfma_f32_32x32x16_bf16(K0, Qf[ks], D0, 0, 0, 0); D1 = __builtin_amdgcn_mfma_f32_32x32x16_bf16(K1, Qf[ks], D1, 0, 0, 0); }
                const u64 mw = mw_nxt; mw_nxt = mrow[kt + 1 < 64 ? kt + 1 : kt];
                const int w0 = (int)((unsigned)mw >> (4 * hh)), w1 = (int)((unsigned)(mw >> 32) >> (4 * hh));
                float xe[32]; float esc, eoff0;
                if (minq - __builtin_amdgcn_readlane(kpm_l, kt) >= 127) {
#pragma unroll
                    for (int r = 0; r < 16; ++r) { xe[r] = D0[r]; xe[16 + r] = D1[r]; }
                    esc = c1; eoff0 = c2;
                } else {
#pragma unroll
                    for (int mb = 0; mb < 2; ++mb)
#pragma unroll
                        for (int g = 0; g < 4; ++g) {
                            const i32x4 pk = *(const i32x4*)(P.pos + b * S_ + 64 * kt + 32 * mb + 8 * g + 4 * hh);
#pragma unroll
                            for (int e = 0; e < 4; ++e) { const int r = 4 * g + e; int n = posq - pk[e]; n = n < 0 ? 0 : (n > 127 ? 127 : n);
                                xe[16 * mb + r] = (mb ? D1[r] : D0[r]) * c1 + TABL[n * 8 + head]; }
                        }
                    esc = 1.0f; eoff0 = 0.f;
                }
                float mx = __builtin_fmaxf(__builtin_fmaxf(xe[0], xe[1]), xe[2]);
#pragma unroll
                for (int r = 3; r < 31; r += 2) mx = __builtin_fmaxf(__builtin_fmaxf(mx, xe[r]), xe[r + 1]);
                mx = fmaxf(mx, xe[31]);
                mx = fmaxf(mx, shx(mx, 32, lane));
                const float m_new = fmaxf(m_run, mx * esc + eoff0); const float alpha = __builtin_amdgcn_exp2f(m_run - m_new); m_run = m_new;
                const float eoff = eoff0 - m_new;
#pragma unroll
                for (int r = 0; r < 16; ++r) {
                    const int bp = (r & 3) + 8 * (r >> 2);
                    xe[r] = __int_as_float(__float_as_int(__builtin_amdgcn_exp2f(xe[r] * esc + eoff)) & bitmask(w0, bp));
                    xe[16 + r] = __int_as_float(__float_as_int(__builtin_amdgcn_exp2f(xe[16 + r] * esc + eoff)) & bitmask(w1, bp)); }
                if (!__all(alpha == 1.0f)) {
#pragma unroll
                    for (int r = 0; r < 16; ++r) { O0[r] *= alpha; O1[r] *= alpha; OL[r] *= alpha; } }
#pragma unroll
                for (int s = 0; s < 4; ++s) {
                    u32x4 pw; pw.x = cvt_pk_bf16(xe[8 * s + 0], xe[8 * s + 1]); pw.y = cvt_pk_bf16(xe[8 * s + 2], xe[8 * s + 3]); pw.z = cvt_pk_bf16(xe[8 * s + 4], xe[8 * s + 5]); pw.w = cvt_pk_bf16(xe[8 * s + 6], xe[8 * s + 7]);
                    const bf16x8 Pf = __builtin_bit_cast(bf16x8, pw);
                    const LAS unsigned char* vp = Vt + m * 136 + (16 * s + 4 * hh) * 2;
                    { const u32x2 va = *(const LAS u32x2*)vp, vb = *(const LAS u32x2*)(vp + 16); u32x4 vw; vw.x = va.x; vw.y = va.y; vw.z = vb.x; vw.w = vb.y;
                      O0 = __builtin_amdgcn_mfma_f32_32x32x16_bf16(__builtin_bit_cast(bf16x8, vw), Pf, O0, 0, 0, 0); }
                    { const u32x2 va = *(const LAS u32x2*)(vp + 32 * 136), vb = *(const LAS u32x2*)(vp + 32 * 136 + 16); u32x4 vw; vw.x = va.x; vw.y = va.y; vw.z = vb.x; vw.w = vb.y;
                      O1 = __builtin_amdgcn_mfma_f32_32x32x16_bf16(__builtin_bit_cast(bf16x8, vw), Pf, O1, 0, 0, 0); }
                    OL = __builtin_amdgcn_mfma_f32_32x32x16_bf16(ones8, Pf, OL, 0, 0, 0);
                }
        };
        __syncthreads();
        constexpr int SUB_B = KT_B + VT_B, SUP_B = 2 * SUB_B;
        const int nst = nt >> 1;
        u32x4 ka0, kb0, va0, vb0, ka1, kb1, va1, vb1;
#define ATT_LOAD(KA, KB_, VA, VB, ST) do { KA = *(const u32x4*)(kg + (size_t)(2 * (ST)) * 64 * 2304); KB_ = *(const u32x4*)(kg + (size_t)(2 * (ST) + 1) * 64 * 2304); \
            VA = *(const u32x4*)(vg + (2 * (ST)) * 64); VB = *(const u32x4*)(vg + (2 * (ST) + 1) * 64); } while (0)
#define ATT_STORE(KA, KB_, VA, VB, BUF) do { LAS unsigned char* kd_ = kdst + (BUF) * SUP_B; LAS unsigned char* vd_ = vdst + (BUF) * SUP_B; \
            *(LAS u32x4*)kd_ = KA; *(LAS u32x2*)vd_ = (u32x2){VA.x, VA.y}; *(LAS u32x2*)(vd_ + 8) = (u32x2){VA.z, VA.w}; \
            *(LAS u32x4*)(kd_ + SUB_B) = KB_; *(LAS u32x2*)(vd_ + SUB_B) = (u32x2){VB.x, VB.y}; *(LAS u32x2*)(vd_ + SUB_B + 8) = (u32x2){VB.z, VB.w}; } while (0)
        ATT_LOAD(ka0, kb0, va0, vb0, 0); ATT_STORE(ka0, kb0, va0, vb0, 0);
        if (nst > 1) ATT_LOAD(ka1, kb1, va1, vb1, 1);
        __syncthreads();
        for (int st = 0; st < nst; st += 2) {
            if (st + 2 < nst) ATT_LOAD(ka0, kb0, va0, vb0, st + 2);
            if (2 * st < my_nt) tile(2 * st, 0);
            if (2 * st + 1 < my_nt) tile(2 * st + 1, SUB_B);
            if (st + 1 < nst) ATT_STORE(ka1, kb1, va1, vb1, 1);
            __syncthreads();
            if (st + 1 >= nst) break;
            if (st + 3 < nst) ATT_LOAD(ka1, kb1, va1, vb1, st + 3);
            if (2 * st + 2 < my_nt) tile(2 * st + 2, SUP_B);
            if (2 * st + 3 < my_nt) tile(2 * st + 3, SUP_B + SUB_B);
            if (st + 2 < nst) ATT_STORE(ka0, kb0, va0, vb0, 0);
            __syncthreads();
        }
#undef ATT_LOAD
#undef ATT_STORE
        const float inv = __builtin_amdgcn_rcpf(OL[0]);
        bf16_t* op = OA + (size_t)(b * S_ + t) * 512 + head * 64 + 4 * hh;
#pragma unroll
        for (int g = 0; g < 4; ++g) {
            u32x2 wa; wa.x = cvt_pk_bf16(O0[4 * g] * inv, O0[4 * g + 1] * inv); wa.y = cvt_pk_bf16(O0[4 * g + 2] * inv, O0[4 * g + 3] * inv);
            *(u32x2*)(op + 8 * g) = wa;
            u32x2 wb; wb.x = cvt_pk_bf16(O1[4 * g] * inv, O1[4 * g + 1] * inv); wb.y = cvt_pk_bf16(O1[4 * g + 2] * inv, O1[4 * g + 3] * inv);
            *(u32x2*)(op + 32 + 8 * g) = wb;
        }
    }
}

#define DSR4(A, addr, o0, o1, o2, o3) asm volatile("ds_read_b128 %0, %4 offset:%5\n\tds_read_b128 %1, %4 offset:%6\n\tds_read_b128 %2, %4 offset:%7\n\tds_read_b128 %3, %4 offset:%8" \
    : "=&v"(A[0]), "=&v"(A[1]), "=&v"(A[2]), "=&v"(A[3]) : "v"(addr), "i"(o0), "i"(o1), "i"(o2), "i"(o3))
#define DSW(A, N) asm volatile("s_waitcnt lgkmcnt(" #N ")" : "+v"(A[0]), "+v"(A[1]), "+v"(A[2]), "+v"(A[3]))
#define SCAN_A(X, G) _Pragma("unroll") for (int i_ = 0; i_ < 4; ++i_) { const f32x2 k01 = {X[i_][0], X[i_][1]}, k23 = {X[i_][2], X[i_][3]}; \
    sa0 += S2[8 * G + 2 * i_] * k01; sa1 += S2[8 * G + 2 * i_ + 1] * k23; sp0 += Pm2[8 * G + 2 * i_] * k01; sp1 += Pm2[8 * G + 2 * i_ + 1] * k23; }
#define SCAN_B(X, C) { const int j = 2 * C; \
    { const f32x2 w = {X[0][0], X[0][1]}, kb = {X[1][0], X[1][1]}, kk = {X[2][0], X[2][1]}, rr = {X[3][0], X[3][1]}; \
      S2[j] = S2[j] * w + sav * kb + vv2 * kk; Pm2[j] = Pm2[j] * w + spv * kb; y0 += S2[j] * rr; p0 += Pm2[j] * rr; } \
    { const f32x2 w = {X[0][2], X[0][3]}, kb = {X[1][2], X[1][3]}, kk = {X[2][2], X[2][3]}, rr = {X[3][2], X[3][3]}; \
      S2[j + 1] = S2[j + 1] * w + sav * kb + vv2 * kk; Pm2[j + 1] = Pm2[j + 1] * w + spv * kb; y1 += S2[j + 1] * rr; p1 += Pm2[j + 1] * rr; } }
__device__ __forceinline__ float wave_sum_dpp(float v) {
    v += __int_as_float(__builtin_amdgcn_update_dpp(0, __float_as_int(v), 0x111, 0xf, 0xf, true));
    v += __int_as_float(__builtin_amdgcn_update_dpp(0, __float_as_int(v), 0x112, 0xf, 0xf, true));
    v += __int_as_float(__builtin_amdgcn_update_dpp(0, __float_as_int(v), 0x114, 0xf, 0xf, true));
    v += __int_as_float(__builtin_amdgcn_update_dpp(0, __float_as_int(v), 0x118, 0xf, 0xf, true));
    v += __int_as_float(__builtin_amdgcn_update_dpp(0, __float_as_int(v), 0x142, 0xa, 0xf, false));
    v += __int_as_float(__builtin_amdgcn_update_dpp(0, __float_as_int(v), 0x143, 0xc, 0xf, false));
    return __int_as_float(__builtin_amdgcn_readlane(__float_as_int(v), 63));
}
__device__ __forceinline__ void ph_scan(const Params& P, int l, LAS unsigned char* lds) {
    LAS bf16_t* LI = (LAS bf16_t*)lds;
    LAS float* SIN = (LAS float*)(lds + 32768);
    const bf16_t* ZR = (const bf16_t*)(P.ws + OFF_ZR);
    const float* mu = P.mu + (size_t)l * 1792;
    const bf16_t* LW = (const bf16_t*)(P.ws + OFF_WB + WB_LW); const bf16_t* LA = (const bf16_t*)(P.ws + OFF_WB + WB_LA); const bf16_t* LG = (const bf16_t*)(P.ws + OFF_WB + WB_LG);
    bf16_t* Yo = (bf16_t*)(P.ws + OFF_Y); bf16_t* Po = (bf16_t*)(P.ws + OFF_P); bf16_t* Go = (bf16_t*)(P.ws + OFF_G); bf16_t* VBo = (bf16_t*)(P.ws + OFF_VB);
    float* SEGp = (float*)(P.ws + OFF_SEG);
    const int tid = opaque_tid(), wid = __builtin_amdgcn_readfirstlane(tid >> 6), lane = tid & 63;
    for (int blk = blockIdx.x; blk < NB_ * NSEG; blk += gridDim.x) {
        const int b = blk / NSEG, seg = blk % NSEG, tbeg = seg * SEGL;
        f32x2 S2[32], Pm2[32];
        { int lq = threadIdx.x; asm volatile("" : "+v"(lq)); lq &= 63;
#pragma unroll
          for (int j = 0; j < 32; ++j) { S2[j] = (f32x2){0.f, 0.f}; Pm2[j] = (f32x2){(2 * j == lq) ? 1.f : 0.f, (2 * j + 1 == lq) ? 1.f : 0.f}; } }
        for (int half = 0; half < 2; ++half) {
            __syncthreads();
            {
                int tq = threadIdx.x; asm volatile("" : "+v"(tq));
#pragma unroll 1
                for (int rnd = 0; rnd < 4; ++rnd) {
                    const int q = tq + NTHR * rnd, tok = q >> 5, c8 = (q & 31) * 8, t = tbeg + 64 * half + tok; const size_t row = (size_t)b * S_ + t;
                    const u32x4 zc = *(const u32x4*)(ZR + row * 1792 + 1536 + c8);
                    u32x4 zp; zp.x = 0u; zp.y = 0u; zp.z = 0u; zp.w = 0u; if (t > 0) zp = *(const u32x4*)(ZR + (row - 1) * 1792 + 1536 + c8);
                    const f32x4 ma = *(const f32x4*)(mu + 1536 + c8), mb = *(const f32x4*)(mu + 1536 + c8 + 4);
                    const unsigned cw[4] = {zc.x, zc.y, zc.z, zc.w}, pw[4] = {zp.x, zp.y, zp.z, zp.w};
                    float x[8];
#pragma unroll
                    for (int q2 = 0; q2 < 4; ++q2) { const float c0 = bflo(cw[q2]), c1 = bfhi(cw[q2]), p0 = bflo(pw[q2]), p1 = bfhi(pw[q2]);
                        const float m0 = q2 < 2 ? ma[2 * q2] : mb[2 * q2 - 4], m1 = q2 < 2 ? ma[2 * q2 + 1] : mb[2 * q2 - 3];
                        x[2 * q2] = c0 + (p0 - c0) * m0; x[2 * q2 + 1] = c1 + (p1 - c1) * m1; }
#pragma unroll
                    for (int e = 0; e < 8; ++e) { if (c8 < 64) x[e] = 1.0f - 2.0f * __builtin_amdgcn_rcpf(1.0f + __expf(2.0f * x[e])); else if (c8 >= 128) x[e] = sigmoidf_(x[e]); }
                    u32x4 w; w.x = cvt_pk_bf16(x[0], x[1]); w.y = cvt_pk_bf16(x[2], x[3]); w.z = cvt_pk_bf16(x[4], x[5]); w.w = cvt_pk_bf16(x[6], x[7]);
                    *(LAS u32x4*)(LI + tok * 256 + c8) = w;
                }
            }
            __syncthreads();
            float* los = (float*)(P.ws + OFF_SCR) + (size_t)(blk * 8 + wid) * (64 * 2 * 64);
            {
                int tq = threadIdx.x; asm volatile("" : "+v"(tq));
                const int lq = tq & 63, fr = lq & 15, kq = lq >> 4;
#pragma unroll 1
                for (int pass = 0; pass < 8; ++pass) {
                    const int kind = pass < 2 ? 0 : (pass < 4 ? 1 : 2), Kk = kind == 2 ? 128 : 64, aoff = kind * 64, nb0 = kind == 2 ? pass - 4 : 2 * (pass & 1);
                    const bf16_t* Wt = kind == 0 ? LW : (kind == 1 ? LA : LG);
                    bf16x8 Bf[4];
#pragma unroll
                    for (int q = 0; q < 4; ++q) { const int nb = kind == 2 ? nb0 : nb0 + (q >> 1), ks = kind == 2 ? q : (q & 1);
                        Bf[q] = *(const bf16x8*)(Wt + (size_t)(64 * wid + 16 * nb + fr) * Kk + 32 * ks + 8 * kq); }
#pragma unroll 1
                    for (int tt = 0; tt < 4; ++tt) {
                        f32x4 acc[2];
                        acc[0] = (f32x4){0.f, 0.f, 0.f, 0.f}; acc[1] = acc[0];
#pragma unroll
                        for (int q = 0; q < 4; ++q) { const int ai = kind == 2 ? 0 : (q >> 1), ks = kind == 2 ? q : (q & 1);
                            const bf16x8 Afr = *(const LAS bf16x8*)(LI + (16 * tt + fr) * 256 + aoff + 32 * ks + 8 * kq);
                            acc[ai] = __builtin_amdgcn_mfma_f32_16x16x32_bf16(Afr, Bf[q], acc[ai], 0, 0, 0); }
                        if (kind == 2) {
#pragma unroll
                            for (int r = 0; r < 4; ++r) Go[((size_t)b * S_ + tbeg + 64 * half + 16 * tt + 4 * kq + r) * 512 + 64 * wid + 16 * nb0 + fr] = f2bf(acc[0][r]);
                        } else {
#pragma unroll
                            for (int ai = 0; ai < 2; ++ai)
#pragma unroll
                                for (int r = 0; r < 4; ++r) los[((16 * tt + 4 * kq + r) * 2 + kind) * 64 + 16 * (nb0 + ai) + fr] = acc[ai][r];
                        }
                    }
                }
            }
            asm volatile("s_waitcnt vmcnt(0)" ::: "memory");
            for (int sb = 0; sb < 64 / TB; ++sb) {
                const int ts = tbeg + 64 * half + sb * TB;
                int tz = threadIdx.x; asm volatile("" : "+v"(tz));
                const int lz = tz & 63;
                LAS float* sw = SIN + (size_t)wid * (TB * 6 * 64);
                {
                    const int c = 64 * wid + lz; const size_t row0 = (size_t)b * S_ + ts;
                    const float mur = mu[c], muk = mu[512 + c], muv = mu[1024 + c];
                    const float pw0 = P.w0[l * 512 + c], pa0 = P.a0[l * 512 + c], pkk = P.k_k[l * 512 + c], pka = P.k_a[l * 512 + c], prk = P.r_k[l * 512 + c];
                    const float* lo = los + (size_t)(sb * TB) * 128 + lz;
                    float pr = 0.f, pk = 0.f, pv = 0.f;
                    if (ts > 0) { pr = bf2f(ZR[(row0 - 1) * 1792 + c]); pk = bf2f(ZR[(row0 - 1) * 1792 + 512 + c]); pv = bf2f(ZR[(row0 - 1) * 1792 + 1024 + c]); }
                    float nr = bf2f(ZR[row0 * 1792 + c]), nk = bf2f(ZR[row0 * 1792 + 512 + c]), nv = bf2f(ZR[row0 * 1792 + 1024 + c]);
                    float nwl = lo[0], nal = lo[64];
#pragma unroll 1
                    for (int tk = 0; tk < TB; ++tk) {
                        const size_t row = row0 + tk; LAS float* st = sw + tk * 6 * 64;
                        const float cr = nr, ck = nk, cv = nv, wl = nwl, al = nal;
                        if (tk + 1 < TB) { nr = bf2f(ZR[(row + 1) * 1792 + c]); nk = bf2f(ZR[(row + 1) * 1792 + 512 + c]); nv = bf2f(ZR[(row + 1) * 1792 + 1024 + c]);
                            nwl = lo[(tk + 1) * 128]; nal = lo[(tk + 1) * 128 + 64]; }
                        const float rr = cr + (pr - cr) * mur, kv = ck + (pk - ck) * muk, vv = cv + (pv - cv) * muv;
                        pr = cr; pk = ck; pv = cv;
                        const float x = -(pw0 + wl);
                        const float sp = fmaxf(x, 0.f) + __logf(1.0f + __expf(-fabsf(x)));
                        const float dc = __expf(-__expf(-sp - 0.5f));
                        const float av = sigmoidf_(pa0 + al);
                        const float kkv = kv * pkk;
                        const float km = kv * (1.0f + (av - 1.0f) * pka);
                        const float ss = wave_sum_dpp(kkv * kkv), bon = wave_sum_dpp(rr * km * prk);
                        const float kkn = kkv * __builtin_amdgcn_rsqf(fmaxf(ss, 1e-24f));
                        st[lz] = rr; st[64 + lz] = dc; st[2 * 64 + lz] = km; st[3 * 64 + lz] = -kkn; st[4 * 64 + lz] = kkn * av; st[5 * 64 + lz] = vv;
                        VBo[row * 512 + c] = f2bf(bon * vv);
                    }
                }
#pragma unroll 1
                for (int tk = 0; tk < TB; ++tk) {
                    const LAS float* sq = sw + tk * 6 * 64;
                    const float vi = sq[5 * 64 + lz];
                    f32x2 sa0 = {0.f, 0.f}, sa1 = {0.f, 0.f}, sp0 = {0.f, 0.f}, sp1 = {0.f, 0.f};
                    f32x2 y0 = {0.f, 0.f}, y1 = {0.f, 0.f}, p0 = {0.f, 0.f}, p1 = {0.f, 0.f};
                    f32x2 sav, spv; const f32x2 vv2 = {vi, vi};
                    const unsigned sqa = (unsigned)(uintptr_t)sq;
                    f32x4 X0[4], X1[4], X2[4];
                    DSR4(X0, sqa, 768, 784, 800, 816);
                    DSR4(X1, sqa, 832, 848, 864, 880);
                    DSR4(X2, sqa, 896, 912, 928, 944);
                    DSW(X0, 8);
                    SCAN_A(X0, 0);
                    DSR4(X0, sqa, 960, 976, 992, 1008);
                    DSW(X1, 8);
                    SCAN_A(X1, 1);
                    DSR4(X1, sqa, 256, 1024, 512, 0);
                    DSW(X2, 8);
                    SCAN_A(X2, 2);
                    DSR4(X2, sqa, 272, 1040, 528, 16);
                    DSW(X0, 8);
                    SCAN_A(X0, 3);
                    { const float sa = (sa0.x + sa0.y) + (sa1.x + sa1.y), sp = (sp0.x + sp0.y) + (sp1.x + sp1.y); sav = (f32x2){sa, sa}; spv = (f32x2){sp, sp}; }
                    DSR4(X0, sqa, 288, 1056, 544, 32);
                    DSW(X1, 8);
                    SCAN_B(X1, 0);
                    DSR4(X1, sqa, 304, 1072, 560, 48);
                    DSW(X2, 8);
                    SCAN_B(X2, 1);
                    DSR4(X2, sqa, 320, 1088, 576, 64);
                    DSW(X0, 8);
                    SCAN_B(X0, 2);
                    DSR4(X0, sqa, 336, 1104, 592, 80);
                    DSW(X1, 8);
                    SCAN_B(X1, 3);
                    DSR4(X1, sqa, 352, 1120, 608, 96);
                    DSW(X2, 8);
                    SCAN_B(X2, 4);
                    DSR4(X2, sqa, 368, 1136, 624, 112);
                    DSW(X0, 8);
                    SCAN_B(X0, 5);
                    DSR4(X0, sqa, 384, 1152, 640, 128);
                    DSW(X1, 8);
                    SCAN_B(X1, 6);
                    DSR4(X1, sqa, 400, 1168, 656, 144);
                    DSW(X2, 8);
                    SCAN_B(X2, 7);
                    DSR4(X2, sqa, 416, 1184, 672, 160);
                    DSW(X0, 8);
                    SCAN_B(X0, 8);
                    DSR4(X0, sqa, 432, 1200, 688, 176);
                    DSW(X1, 8);
                    SCAN_B(X1, 9);
                    DSR4(X1, sqa, 448, 1216, 704, 192);
                    DSW(X2, 8);
                    SCAN_B(X2, 10);
                    DSR4(X2, sqa, 464, 1232, 720, 208);
                    DSW(X0, 8);
                    SCAN_B(X0, 11);
                    DSR4(X0, sqa, 480, 1248, 736, 224);
                    DSW(X1, 8);
                    SCAN_B(X1, 12);
                    DSR4(X1, sqa, 496, 1264, 752, 240);
                    DSW(X2, 8);
                    SCAN_B(X2, 13);
                    DSW(X0, 4);
                    SCAN_B(X0, 14);
                    DSW(X1, 0);
                    SCAN_B(X1, 15);
                    const size_t row = (size_t)b * S_ + ts + tk;
                    Yo[row * 512 + 64 * wid + lz] = f2bf((y0.x + y0.y) + (y1.x + y1.y));
                    Po[row * 512 + 64 * wid + lz] = f2bf((p0.x + p0.y) + (p1.x + p1.y));
                }
            }
        }
        {
            int lq = threadIdx.x; asm volatile("" : "+v"(lq)); lq &= 63;
            float* sg = SEGp + ((size_t)((b * 8 + wid) * NSEG + seg)) * 8192 + lq * 64;
#pragma unroll
            for (int j = 0; j < 32; j += 2) { *(f32x4*)(sg + 2 * j) = (f32x4){Pm2[j].x, Pm2[j].y, Pm2[j + 1].x, Pm2[j + 1].y};
                *(f32x4*)(sg + 4096 + 2 * j) = (f32x4){S2[j].x, S2[j].y, S2[j + 1].x, S2[j + 1].y}; }
        }
    }
}

__device__ __forceinline__ void ph_comb(const Params& P, LAS unsigned char* lds) {
    LAS float* SI = (LAS float*)lds;
    LAS float* PB = (LAS float*)(lds + 20480);
    float* SEGp = (float*)(P.ws + OFF_SEG);
    const int tid = opaque_tid(), wid = __builtin_amdgcn_readfirstlane(tid >> 6), lane = tid & 63, m = lane & 31, hh = lane >> 5;
    for (int chain = blockIdx.x; chain < 64; chain += gridDim.x) {
        float* base = SEGp + (size_t)chain * NSEG * 8192;
        __syncthreads();
        for (int i = tid; i < 4096; i += NTHR) SI[(i >> 6) * 65 + (i & 63)] = base[4096 + i];
        { const f32x4 a = *(const f32x4*)(base + 8192 + tid * 8), c = *(const f32x4*)(base + 8192 + tid * 8 + 4);
          *(LAS f32x4*)(PB + 4096 + tid * 8) = a; *(LAS f32x4*)(PB + 4096 + tid * 8 + 4) = c; }
        __syncthreads();
        const int ti = (wid >> 1) & 1, tj = wid & 1;
        for (int k = 1; k <= NSEG - 2; ++k) {
            float* Q = base + (size_t)k * 8192 + 4096;
            const LAS float* Pb = PB + (k & 1) * 4096;
            f32x4 na = {0.f, 0.f, 0.f, 0.f}, nc = na;
            if (k + 1 <= NSEG - 2) { const float* pn = base + (size_t)(k + 1) * 8192 + tid * 8; na = *(const f32x4*)pn; nc = *(const f32x4*)(pn + 4); }
            f32x16 Dv;
            if (wid < 4) {
                float qv[16];
#pragma unroll
                for (int r = 0; r < 16; ++r) { const int row = 32 * ti + (r & 3) + 8 * (r >> 2) + 4 * hh; qv[r] = Q[row * 64 + 32 * tj + m]; Dv[r] = 0.f; }
#pragma unroll
                for (int kk = 0; kk < 32; ++kk) { const float a = SI[(32 * ti + m) * 65 + 2 * kk + hh], bq = Pb[(2 * kk + hh) * 64 + 32 * tj + m];
                    Dv = __builtin_amdgcn_mfma_f32_32x32x2f32(a, bq, Dv, 0, 0, 0); }
#pragma unroll
                for (int r = 0; r < 16; ++r) Dv[r] += qv[r];
            }
            __syncthreads();
            if (wid < 4) {
#pragma unroll
                for (int r = 0; r < 16; ++r) { const int row = 32 * ti + (r & 3) + 8 * (r >> 2) + 4 * hh; SI[row * 65 + 32 * tj + m] = Dv[r]; Q[row * 64 + 32 * tj + m] = Dv[r]; }
            }
            if (k + 1 <= NSEG - 2) { LAS float* pd = PB + ((k + 1) & 1) * 4096 + tid * 8; *(LAS f32x4*)pd = na; *(LAS f32x4*)(pd + 4) = nc; }
            __syncthreads();
        }
    }
}

__device__ __forceinline__ void ph_post(const Params& P, int l) {
    const bf16_t* Yo = (const bf16_t*)(P.ws + OFF_Y); const bf16_t* Po = (const bf16_t*)(P.ws + OFF_P); const bf16_t* Go = (const bf16_t*)(P.ws + OFF_G);
    const bf16_t* VBo = (const bf16_t*)(P.ws + OFF_VB); const float* SEGp = (const float*)(P.ws + OFF_SEG); bf16_t* OR = (bf16_t*)(P.ws + OFF_ORWKV);
    const int tid = opaque_tid(), wid = __builtin_amdgcn_readfirstlane(tid >> 6), lane = tid & 63, m = lane & 31, hh = lane >> 5;
    for (int blk = blockIdx.x; blk < NB_ * NSEG; blk += gridDim.x) {
        const int b = blk / NSEG, seg = blk % NSEG, tbeg = seg * SEGL;
        bf16x8 SIf[2][4];
        if (seg > 0) {
            const float* sg = SEGp + ((size_t)((b * 8 + wid) * NSEG + seg - 1)) * 8192 + 4096;
#pragma unroll
            for (int ib = 0; ib < 2; ++ib)
#pragma unroll
                for (int ks = 0; ks < 4; ++ks) { const float* sp = sg + (32 * ib + m) * 64 + 16 * ks + 8 * hh; const f32x4 a = *(const f32x4*)sp, c = *(const f32x4*)(sp + 4);
                    u32x4 w; w.x = cvt_pk_bf16(a[0], a[1]); w.y = cvt_pk_bf16(a[2], a[3]); w.z = cvt_pk_bf16(c[0], c[1]); w.w = cvt_pk_bf16(c[2], c[3]); SIf[ib][ks] = __builtin_bit_cast(bf16x8, w); }
        }
        float lnw[32], lnb[32];
#pragma unroll
        for (int q = 0; q < 32; ++q) { const int ch = 64 * wid + 32 * (q >> 4) + (q & 3) + 8 * ((q & 15) >> 2) + 4 * hh; lnw[q] = P.ln_w[l * 512 + ch]; lnb[q] = P.ln_b[l * 512 + ch]; }
#pragma unroll 1
        for (int c = 0; c < SEGL / 32; ++c) {
            const size_t row = (size_t)b * S_ + tbeg + 32 * c + m;
            f32x16 D[2];
#pragma unroll
            for (int r = 0; r < 16; ++r) { D[0][r] = 0.f; D[1][r] = 0.f; }
            if (seg > 0) {
                const bf16_t* pp = Po + row * 512 + 64 * wid + 8 * hh;
#pragma unroll
                for (int ks = 0; ks < 4; ++ks) { const bf16x8 Pf = *(const bf16x8*)(pp + 16 * ks);
                    D[0] = __builtin_amdgcn_mfma_f32_32x32x16_bf16(SIf[0][ks], Pf, D[0], 0, 0, 0); D[1] = __builtin_amdgcn_mfma_f32_32x32x16_bf16(SIf[1][ks], Pf, D[1], 0, 0, 0); }
            }
            float y[32]; float s = 0.f;
#pragma unroll
            for (int ib = 0; ib < 2; ++ib)
#pragma unroll
                for (int g = 0; g < 4; ++g) { const u32x2 yw = *(const u32x2*)(Yo + row * 512 + 64 * wid + 32 * ib + 8 * g + 4 * hh);
                    y[16 * ib + 4 * g + 0] = bflo(yw.x) + D[ib][4 * g + 0]; y[16 * ib + 4 * g + 1] = bfhi(yw.x) + D[ib][4 * g + 1];
                    y[16 * ib + 4 * g + 2] = bflo(yw.y) + D[ib][4 * g + 2]; y[16 * ib + 4 * g + 3] = bfhi(yw.y) + D[ib][4 * g + 3]; }
#pragma unroll
            for (int q = 0; q < 32; ++q) s += y[q];
            s += shx(s, 32, lane);
            const float mean = s * (1.0f / 64.0f); float qv = 0.f;
#pragma unroll
            for (int q = 0; q < 32; ++q) { y[q] -= mean; qv += y[q] * y[q]; }
            qv += shx(qv, 32, lane);
            const float rstd = rsqrtf(qv * (1.0f / 64.0f) + 64e-5f);
#pragma unroll
            for (int ib = 0; ib < 2; ++ib)
#pragma unroll
                for (int g = 0; g < 4; ++g) { const size_t off = row * 512 + 64 * wid + 32 * ib + 8 * g + 4 * hh;
                    const u32x2 vw = *(const u32x2*)(VBo + off), gw = *(const u32x2*)(Go + off); const int q = 16 * ib + 4 * g;
                    const float o0 = (y[q] * rstd * lnw[q] + lnb[q] + bflo(vw.x)) * bflo(gw.x), o1 = (y[q + 1] * rstd * lnw[q + 1] + lnb[q + 1] + bfhi(vw.x)) * bfhi(gw.x);
                    const float o2 = (y[q + 2] * rstd * lnw[q + 2] + lnb[q + 2] + bflo(vw.y)) * bflo(gw.y), o3 = (y[q + 3] * rstd * lnw[q + 3] + lnb[q + 3] + bfhi(vw.y)) * bfhi(gw.y);
                    u32x2 w; w.x = cvt_pk_bf16(o0, o1); w.y = cvt_pk_bf16(o2, o3); *(u32x2*)(OR + off) = w; }
        }
    }
}

enum { PH_PRO = 0, PH_NORM1, PH_ZQ, PH_IDX, PH_ATT, PH_ZR, PH_SCAN, PH_COMB, PH_POST, PH_ZC, PH_CONV, PH_MERGE, PH_WO, PH_NORM2, PH_UP, PH_U, PH_DOWN, PH_FINAL, PH_COUNT };

template <int PH>
__device__ __forceinline__ void run_phase(const Params& P0, int l, LAS unsigned char* lds) {
    Params P = P0; P.ws = opaque_ptr(P0.ws);
    if constexpr (PH == PH_PRO) { if (l == 0) ph_mod(P, lds); ph_wconv(P, l, lds); }
    if constexpr (PH == PH_NORM1) ph_norm(P, l, 0);
    if constexpr (PH == PH_ZQ) ph_gemm_zq(P, lds);
    if constexpr (PH == PH_IDX) ph_idx(P, lds);
    if constexpr (PH == PH_ATT) ph_att(P, lds);
    if constexpr (PH == PH_ZR) ph_gemm_zr(P, lds);
    if constexpr (PH == PH_SCAN) ph_scan(P, l, lds);
    if constexpr (PH == PH_COMB) ph_comb(P, lds);
    if constexpr (PH == PH_POST) ph_post(P, l);
    if constexpr (PH == PH_ZC) ph_gemm_zc(P, lds);
    if constexpr (PH == PH_CONV) ph_conv(P, l, lds);
    if constexpr (PH == PH_MERGE) ph_gemm_merge(P, lds);
    if constexpr (PH == PH_WO) ph_gemm_wo(P, l, lds);
    if constexpr (PH == PH_NORM2) ph_norm(P, l, 1);
    if constexpr (PH == PH_UP) ph_gemm_up(P, l, lds);
    if constexpr (PH == PH_U) ph_ufix(P, l, lds);
    if constexpr (PH == PH_DOWN) ph_gemm_down(P, l, lds);
    if constexpr (PH == PH_FINAL) ph_final(P);
}

#if MK_SINGLE
__global__ void __launch_bounds__(NTHR, 2) k_mega(Params P) {
    extern __shared__ __attribute__((aligned(16))) unsigned char shm[];
    LAS unsigned char* lds = (LAS unsigned char*)shm;
    LAS unsigned* xbw = (LAS unsigned*)(lds + LDS_BYTES - 16);
    if (threadIdx.x == 0) { xbw[0] = 0u; xbw[1] = 0u; xbw[2] = 0u; xbw[3] = 0u; }
    __syncthreads();
    XcdBarrier bar = xcd_barrier_post((unsigned*)(P.ws + OFF_BAR), (volatile LAS unsigned*)xbw);
#ifndef PROBE_PH
#define PROBE_PH (-1)
#endif
#ifndef PROBE_N
#define PROBE_N 4
#endif
#define PHASE(PH, l) do { unsigned long long t0_ = 0; if (PROBE_PH == PH && blockIdx.x == 0) t0_ = wall_clock64(); \
        run_phase<PH>(P, l, lds); xcd_barrier(bar); \
        if (PROBE_PH == PH && blockIdx.x == 0) { const unsigned long long t1_ = wall_clock64(), d_ = (t1_ - t0_) * PROBE_N; while (wall_clock64() - t1_ < d_) __builtin_amdgcn_s_sleep(8); } } while (0)
#pragma unroll 1
    for (int l = 0; l < 2; ++l) {
        PHASE(PH_PRO, l); PHASE(PH_NORM1, l); PHASE(PH_ZQ, l); PHASE(PH_IDX, l); PHASE(PH_ATT, l); PHASE(PH_ZR, l); PHASE(PH_SCAN, l); PHASE(PH_COMB, l); PHASE(PH_POST, l);
        PHASE(PH_ZC, l); PHASE(PH_CONV, l); PHASE(PH_MERGE, l); PHASE(PH_WO, l); PHASE(PH_NORM2, l); PHASE(PH_UP, l); PHASE(PH_U, l); PHASE(PH_DOWN, l);
    }
    run_phase<PH_FINAL>(P, 0, lds);
#undef PHASE
}
#else
template <int PH>
__global__ void __launch_bounds__(NTHR, 2) k_phase(Params P, int l) {
    extern __shared__ __attribute__((aligned(16))) unsigned char shm[];
    run_phase<PH>(P, l, (LAS unsigned char*)shm);
}
template <int PH> static void launch_phase(const Params& P, int l, hipStream_t stream) {
    static bool attr = false;
    if (!attr) { hipFuncSetAttribute((const void*)k_phase<PH>, hipFuncAttributeMaxDynamicSharedMemorySize, LDS_BYTES); attr = true; }
    hipLaunchKernelGGL(k_phase<PH>, dim3(NBLK), dim3(NTHR), LDS_BYTES, stream, P, l);
}
#endif

extern "C" void kernel_launch(void* const* d_in, const int* in_sizes, int n_in, void* d_out, int out_size, void* d_ws, size_t ws_size, hipStream_t stream) {
    (void)in_sizes; (void)n_in; (void)out_size; (void)ws_size;
    Params P{};
    P.x_in = (const float*)d_in[0]; P.c = (const float*)d_in[1]; P.pos = (const int*)d_in[2]; P.rel_bias = (const float*)d_in[3]; P.final_norm = (const float*)d_in[4];
    P.ada_w = (const float*)d_in[5]; P.ada_b = (const float*)d_in[6]; P.norm_mix = (const float*)d_in[7]; P.w_in = (const float*)d_in[8];
    P.mu = (const float*)d_in[9]; P.w0 = (const float*)d_in[10]; P.w_up = (const float*)d_in[11]; P.a0 = (const float*)d_in[12]; P.a_up = (const float*)d_in[13]; P.g_up = (const float*)d_in[14];
    P.k_k = (const float*)d_in[15]; P.k_a = (const float*)d_in[16]; P.r_k = (const float*)d_in[17]; P.ln_w = (const float*)d_in[18]; P.ln_b = (const float*)d_in[19];
    P.sc_conv_w = (const float*)d_in[20]; P.w_branch = (const float*)d_in[21]; P.w_o = (const float*)d_in[22]; P.norm_ffn = (const float*)d_in[23];
    P.ffn_w_up = (const float*)d_in[24]; P.ffn_conv_w = (const float*)d_in[25]; P.ffn_w_down = (const float*)d_in[26];
    P.out = (float*)d_out; P.ws = (unsigned char*)d_ws;
#if MK_SINGLE
    static bool attr = false;
    if (!attr) { hipFuncSetAttribute((const void*)k_mega, hipFuncAttributeMaxDynamicSharedMemorySize, LDS_BYTES); attr = true; }
    hipMemsetAsync((unsigned char*)d_ws + OFF_BAR, 0, XCD_BAR_WORDS * sizeof(unsigned), stream);
    hipLaunchKernelGGL(k_mega, dim3(NBLK), dim3(NTHR), LDS_BYTES, stream, P);
#else
    for (int l = 0; l < 2; ++l) {
        launch_phase<PH_PRO>(P, l, stream); launch_phase<PH_NORM1>(P, l, stream); launch_phase<PH_ZQ>(P, l, stream); launch_phase<PH_IDX>(P, l, stream);
        launch_phase<PH_ATT>(P, l, stream); launch_phase<PH_ZR>(P, l, stream); launch_phase<PH_SCAN>(P, l, stream); launch_phase<PH_COMB>(P, l, stream);
        launch_phase<PH_POST>(P, l, stream); launch_phase<PH_ZC>(P, l, stream); launch_phase<PH_CONV>(P, l, stream); launch_phase<PH_MERGE>(P, l, stream);
        launch_phase<PH_WO>(P, l, stream); launch_phase<PH_NORM2>(P, l, stream); launch_phase<PH_UP>(P, l, stream); launch_phase<PH_U>(P, l, stream);
        launch_phase<PH_DOWN>(P, l, stream);
    }
    launch_phase<PH_FINAL>(P, 0, stream);
#endif
}
```

```cpp
#include <hip/hip_runtime.h>
#include <stdint.h>

#ifndef MK_SINGLE
#define MK_SINGLE 1
#endif

#define LAS __attribute__((address_space(3)))
typedef unsigned short bf16_t;
typedef short bf16x8 __attribute__((ext_vector_type(8)));
typedef short bf16x4 __attribute__((ext_vector_type(4)));
typedef float f32x4 __attribute__((ext_vector_type(4)));
typedef float f32x16 __attribute__((ext_vector_type(16)));
typedef float f32x2 __attribute__((ext_vector_type(2)));
typedef unsigned u32x4 __attribute__((ext_vector_type(4)));
typedef unsigned u32x2 __attribute__((ext_vector_type(2)));
typedef int i32x4 __attribute__((ext_vector_type(4)));
typedef unsigned long long u64;

constexpr int T_ = 32768, D_ = 1024, NB_ = 8, S_ = 4096;
constexpr int NSEG = 32, SEGL = 128, TB = 8;
constexpr int NBLK = 256, NTHR = 512;
constexpr int IN_COLS = 8520, DFF = 2816;
constexpr int LDS_BYTES = 150 * 1024;

constexpr size_t MiB = 1ull << 20;
constexpr size_t OFF_BAR = 0;
constexpr size_t OFF_MOD = 64 * 1024;
constexpr size_t OFF_TAB = 512 * 1024;
constexpr size_t OFF_KPM = 520 * 1024;
constexpr size_t OFF_WB = 2 * MiB;
constexpr size_t WB_WIN = 0;
constexpr size_t WB_WBR = WB_WIN + (size_t)8704 * 1024 * 2;
constexpr size_t WB_WO = WB_WBR + (size_t)3 * 1024 * 512 * 2;
constexpr size_t WB_WUP = WB_WO + (size_t)1024 * 1024 * 2;
constexpr size_t WB_WDN = WB_WUP + (size_t)5632 * 1024 * 2;
constexpr size_t WB_LW = WB_WDN + (size_t)1024 * 2816 * 2;
constexpr size_t WB_LA = WB_LW + (size_t)512 * 64 * 2;
constexpr size_t WB_LG = WB_LA + (size_t)512 * 64 * 2;
constexpr size_t OFF_H = 42 * MiB;
constexpr size_t OFF_ZQ = 106 * MiB;
constexpr size_t OFF_MASK = 250 * MiB;
constexpr size_t OFF_VT = 266 * MiB;
constexpr size_t OFF_ZR = 106 * MiB;
constexpr size_t OFF_Y = 218 * MiB;
constexpr size_t OFF_P = 250 * MiB;
constexpr size_t OFF_G = 282 * MiB;
constexpr size_t OFF_SEG = 314 * MiB;
constexpr size_t OFF_ZCV = 106 * MiB;
constexpr size_t OFF_ZG = 202 * MiB;
constexpr size_t OFF_MRG = 106 * MiB;
constexpr size_t OFF_UP = 106 * MiB;
constexpr size_t OFF_HA = 300 * MiB;
constexpr size_t OFF_HB = 320 * MiB;
constexpr size_t OFF_OCONV = 416 * MiB;
constexpr size_t OFF_ORWKV = 448 * MiB;
constexpr size_t OFF_OATT = 480 * MiB;
constexpr size_t OFF_VB = OFF_ORWKV;
constexpr size_t OFF_SCR = 378 * MiB;

struct Params {
    const float* x_in; const float* c; const int* pos; const float* rel_bias; const float* final_norm;
    const float* ada_w; const float* ada_b; const float* norm_mix; const float* w_in;
    const float* mu; const float* w0; const float* w_up; const float* a0; const float* a_up; const float* g_up;
    const float* k_k; const float* k_a; const float* r_k; const float* ln_w; const float* ln_b;
    const float* sc_conv_w; const float* w_branch; const float* w_o; const float* norm_ffn;
    const float* ffn_w_up; const float* ffn_conv_w; const float* ffn_w_down;
    float* out; unsigned char* ws;
};

__device__ __forceinline__ float bf2f(bf16_t b) { return __uint_as_float(((unsigned)b) << 16); }
__device__ __forceinline__ bf16_t f2bf(float f) { unsigned u = __float_as_uint(f); u += 0x7FFFu + ((u >> 16) & 1u); return (bf16_t)(u >> 16); }
typedef __bf16 bf16x2_t __attribute__((ext_vector_type(2)));
__device__ __forceinline__ unsigned cvt_pk_bf16(float lo, float hi) { const f32x2 v = {lo, hi}; return __builtin_bit_cast(unsigned, __builtin_convertvector(v, bf16x2_t)); }
__device__ __forceinline__ float bflo(unsigned w) { return __uint_as_float(w << 16); }
__device__ __forceinline__ float bfhi(unsigned w) { return __uint_as_float(w & 0xffff0000u); }
__device__ __forceinline__ float shx(float v, int mask, int lane) { return __int_as_float(__builtin_amdgcn_ds_bpermute((lane ^ mask) << 2, __float_as_int(v))); }
__device__ __forceinline__ int shxi(int v, int mask, int lane) { return __builtin_amdgcn_ds_bpermute((lane ^ mask) << 2, v); }
__device__ __forceinline__ float wave_sum(float v, int lane) {
#pragma unroll
    for (int o = 32; o >= 1; o >>= 1) v += shx(v, o, lane);
    return v;
}
__device__ __forceinline__ void writelane_c2(int& vlo, int& vhi, int lo, int hi, int ln  ) {
    asm("s_nop 3\n\tv_writelane_b32 %0, %2, %4\n\tv_writelane_b32 %1, %3, %4" : "+v"(vlo), "+v"(vhi) : "s"(lo), "s"(hi), "n"(ln)); }
__device__ __forceinline__ int writelane_v(int vec, int val, int ln  ) { asm("s_mov_b32 m0, %2\n\ts_nop 3\n\tv_writelane_b32 %0, %1, m0" : "+v"(vec) : "s"(val), "s"(ln) : "m0"); return vec; }
__device__ __forceinline__ float sigmoidf_(float x) { return __builtin_amdgcn_rcpf(1.0f + __expf(-x)); }
__device__ __forceinline__ unsigned f2ord(float x) { unsigned u = __float_as_uint(x); return (u & 0x80000000u) ? ~u : (u | 0x80000000u); }
__device__ __forceinline__ float ord2f(unsigned k) { return __uint_as_float((k & 0x80000000u) ? (k & 0x7fffffffu) : ~k); }

__device__ __forceinline__ int opaque_tid() { int t = threadIdx.x; asm volatile("" : "+v"(t)); return t; }
__device__ __forceinline__ unsigned char* opaque_ptr(unsigned char* p) {
    typedef __attribute__((address_space(1))) unsigned char* gptr_t;
    gptr_t g = (gptr_t)p; asm volatile("" : "+s"(g)); return (unsigned char*)g; }

#define XB_TMO      128
#define XB_XCNT(j)  (256  + 64 * (j))
#define XB_XSUB(j)  (1280 + 64 * (j))
#define XB_XGEN(j)  (2304 + 64 * (j))
#define XB_TOP      3328
#define XB_TOPGEN   3392
#define XCD_BAR_WORDS 3456
#define XB_SPIN_CAP (1u << 22)

__device__ __forceinline__ unsigned xb_ld(unsigned* p)              { return __hip_atomic_load(p, __ATOMIC_RELAXED, __HIP_MEMORY_SCOPE_AGENT); }
__device__ __forceinline__ unsigned xb_add(unsigned* p, unsigned v) { return __hip_atomic_fetch_add(p, v, __ATOMIC_RELAXED, __HIP_MEMORY_SCOPE_AGENT); }
__device__ __forceinline__ unsigned xb_xcc_id() { return (unsigned)__builtin_amdgcn_s_getreg((3 << 11) | 20) & 0xFu; }
#define XB_SPIN(cond, bar) do { unsigned _sp = 0; while (cond) { __builtin_amdgcn_s_sleep(1); \
    if ((++_sp & 255u) == 0u) { if (xb_ld(&(bar)[XB_TMO])) break; if (_sp > XB_SPIN_CAP) { atomicAdd(&(bar)[XB_TMO], 1u); break; } } } } while (0)

struct XcdBarrier { unsigned* bar; unsigned x; volatile LAS unsigned* st; };

__device__ __forceinline__ XcdBarrier xcd_barrier_post(unsigned* bar, volatile LAS unsigned* st) {
    XcdBarrier b; b.bar = bar; b.x = xb_xcc_id(); b.st = st;
    if (threadIdx.x == 0) (void)xb_add(&bar[XB_XCNT(b.x)], 1u);
    return b;
}
__device__ __forceinline__ void xcd_barrier_complete(unsigned* bar, unsigned x, unsigned& nloc, unsigned& nx) {
    const unsigned G = gridDim.x * gridDim.y * gridDim.z;
    unsigned sum, cnt, mine, sp = 0u;
    for (;;) {
        sum = 0u; cnt = 0u; mine = 0u;
#pragma unroll
        for (unsigned j = 0; j < 16; ++j) { const unsigned c = xb_ld(&bar[XB_XCNT(j)]); sum += c; cnt += (c > 0u) ? 1u : 0u; mine = (j == x) ? c : mine; }
        if (sum == G) break;
        __builtin_amdgcn_s_sleep(1);
        if ((++sp & 255u) == 0u) { if (xb_ld(&bar[XB_TMO])) break; if (sp > XB_SPIN_CAP) { atomicAdd(&bar[XB_TMO], 1u); break; } }
    }
    nloc = mine > 0u ? mine : 1u; nx = cnt > 0u ? cnt : 1u;
}
__device__ __forceinline__ void xcd_barrier(const XcdBarrier& b) {
    asm volatile("s_waitcnt vmcnt(0)" ::: "memory");
    __syncthreads();
    if (threadIdx.x == 0) {
        unsigned* bar = b.bar;
        __builtin_amdgcn_s_waitcnt(0);
        unsigned nloc = b.st[0], nx = b.st[1];
        if (nloc == 0u) { xcd_barrier_complete(bar, b.x, nloc, nx); b.st[0] = nloc; b.st[1] = nx; }
        const unsigned old = xb_add(&bar[XB_XSUB(b.x)], 1u);
        const unsigned gen = old / nloc;
        if (old + 1u == (gen + 1u) * nloc) {
            __builtin_amdgcn_fence(__ATOMIC_RELEASE, "agent");
            asm volatile("s_waitcnt vmcnt(0)" ::: "memory");
            const unsigned og = xb_add(&bar[XB_TOP], 1u);
            const unsigned tg = og / nx;
            if (og + 1u == (tg + 1u) * nx) xb_add(&bar[XB_TOPGEN], 1u);
            else XB_SPIN(xb_ld(&bar[XB_TOPGEN]) == tg, bar);
            __builtin_amdgcn_fence(__ATOMIC_ACQUIRE, "agent");
            xb_add(&bar[XB_XGEN(b.x)], 1u);
            asm volatile("s_waitcnt vmcnt(0)" ::: "memory");
        } else {
            XB_SPIN(xb_ld(&bar[XB_XGEN(b.x)]) == gen, bar);
            __builtin_amdgcn_fence(__ATOMIC_ACQUIRE, "agent");
            asm volatile("s_waitcnt vmcnt(0)" ::: "memory");
        }
    }
    __syncthreads();
}

namespace g8 {
constexpr int BM = 256, BK = 64, HALF = 128, HTB = HALF * BK * 2, STAGE_BYTES = 8 * HTB, NXCD = 8, WGM = 8;
__device__ __forceinline__ int lds_byte(int r, int c) { const int st = (r >> 4) * 2 + (c >> 5), rr = r & 15, cc = c & 31, ob = rr * 64 + cc * 2; return st * 1024 + (ob ^ (((ob >> 9) & 1) << 5)); }
__device__ __forceinline__ void stage_rc(int b, int& R, int& C) { const int st = b / 1024, sb = b % 1024, swz = sb ^ (((sb >> 9) & 1) << 5); R = (st >> 1) * 16 + swz / 64; C = (st & 1) * 32 + (swz % 64) / 2; }
__device__ __forceinline__ int perm32(int rho) { const int n = rho >> 4, i = rho & 15; return 8 * (i >> 2) + 4 * n + (i & 3); }

struct Unit { const char* A; const char* B; int pm, pn, tag; };

struct SOrder {
    int nM, nN, nwg, G, c; const char* A; const char* Bt; size_t a_t, b_t;
    __device__ void init(int M, int N, int lda, int ldb, const void* A_, const void* Bt_) {
        nM = M / BM; nN = N / BM; nwg = nM * nN; G = (int)gridDim.x; c = (int)blockIdx.x; A = (const char*)A_; Bt = (const char*)Bt_;
        a_t = (size_t)BM * lda * 2; b_t = (size_t)BM * ldb * 2; }
    __device__ bool next(int i, Unit& u) const {
        const long L = (long)i * G + c; if (L >= nwg) return false;
        int wgid = (int)L; { const int q = nwg / NXCD, r = nwg % NXCD, xcd = wgid % NXCD, off = wgid / NXCD; wgid = (xcd < r ? xcd * (q + 1) : r * (q + 1) + (xcd - r) * q) + off; }
        const int nig = WGM * nN, gid = wgid / nig, fm = gid * WGM, gsz = (nM - fm) < WGM ? (nM - fm) : WGM;
        u.pm = fm + ((wgid % nig) % gsz); u.pn = (wgid % nig) / gsz; u.tag = 0;
        u.A = A + (size_t)u.pm * a_t; u.B = Bt + (size_t)u.pn * b_t; return true;
    }
};

template <class Epi, class Sched>
__device__ __forceinline__ void gemm_phase(LAS unsigned char* lds, const int K, const int lda, const int ldb, const Sched& S, const Epi& E) {
    const int tid = opaque_tid(), wid = __builtin_amdgcn_readfirstlane(tid >> 6), lane = tid & 63, wr = wid >> 2, wc = wid & 3, fr = lane & 15, fq = lane >> 4;
    const int nt = K / BK;
    unsigned voffA[2], voffB[2];
#pragma unroll
    for (int i = 0; i < 2; ++i) { int R, C; stage_rc(tid * 16 + i * 8192, R, C); const int Rb = Epi::PERM ? ((R & ~31) + perm32(R & 31)) : R;
        voffA[i] = (unsigned)(R * lda + C) * 2u; voffB[i] = (unsigned)(Rb * ldb + C) * 2u; }
    const size_t kstep = (size_t)(BK * 2);
    const size_t hstepA = (size_t)HALF * lda * 2, hstepB = (size_t)HALF * ldb * 2;
    const unsigned ldsw = (unsigned)wid * 1024u;
    const int aoff = lds_byte(wr * 64 + fr, fq * 8), boff = lds_byte(wc * 32 + fr, fq * 8);
#define PG8_SA(b, h) (((b) * 2 + (h)) * HTB)
#define PG8_SB(b, h) ((4 + (b) * 2 + (h)) * HTB)
#define PG8_STAGE(bufoff, gbase, voff) do { _Pragma("unroll") for (int _i = 0; _i < 2; ++_i) \
        __builtin_amdgcn_global_load_lds((const unsigned*)((const char*)(gbase) + (voff)[_i]), (LAS unsigned*)(lds + (bufoff) + ldsw + _i * 8192), 16, 0, 0); } while (0)
#define PG8_LDA(dst, b, h) do { _Pragma("unroll") for (int m = 0; m < 4; ++m) _Pragma("unroll") for (int k = 0; k < 2; ++k) dst[m][k] = *(const LAS bf16x8*)(lds + PG8_SA(b, h) + aoff + m * 2048 + k * 1024); } while (0)
#define PG8_LDB(dst, b, h) do { _Pragma("unroll") for (int n = 0; n < 2; ++n) _Pragma("unroll") for (int k = 0; k < 2; ++k) dst[n][k] = *(const LAS bf16x8*)(lds + PG8_SB(b, h) + boff + n * 2048 + k * 1024); } while (0)
#define PG8_MMA(ai, bj, At, Bt) do { __builtin_amdgcn_s_setprio(1); _Pragma("unroll") for (int m = 0; m < 4; ++m) _Pragma("unroll") for (int n = 0; n < 2; ++n) _Pragma("unroll") for (int k = 0; k < 2; ++k) \
        acc[ai][bj][m][n] = __builtin_amdgcn_mfma_f32_16x16x32_bf16(Bt[n][k], At[m][k], acc[ai][bj][m][n], 0, 0, 0); __builtin_amdgcn_s_setprio(0); } while (0)
#define PG8_WAIT_V(n) asm volatile("s_waitcnt vmcnt(" #n ")" ::: "memory")
#define PG8_WAIT_L(n) asm volatile("s_waitcnt lgkmcnt(" #n ")" ::: "memory")
#define PG8_BAR __builtin_amdgcn_s_barrier()
#define PG8_SCHED __builtin_amdgcn_sched_barrier(0)
    Unit cur, nxt; int ui = 0;
    if (!S.next(0, cur)) return;
    f32x4 acc[2][2][4][2];
#pragma unroll
    for (int a = 0; a < 2; ++a)
#pragma unroll
        for (int b = 0; b < 2; ++b)
#pragma unroll
            for (int m = 0; m < 4; ++m)
#pragma unroll
                for (int n = 0; n < 2; ++n) acc[a][b][m][n] = (f32x4){0.f, 0.f, 0.f, 0.f};
    bf16x8 At[4][2], B0[2][2], B1[2][2];
    const char* cA = cur.A; const char* cB = cur.B;
    PG8_STAGE(PG8_SB(0, 0), cB, voffB); PG8_STAGE(PG8_SA(0, 0), cA, voffA); PG8_STAGE(PG8_SB(0, 1), cB + hstepB, voffB); PG8_STAGE(PG8_SA(0, 1), cA + hstepA, voffA);
    if (wr == 1) PG8_BAR;
    PG8_WAIT_V(4); PG8_BAR;
    PG8_STAGE(PG8_SB(1, 0), cB + kstep, voffB); PG8_STAGE(PG8_SA(1, 0), cA + kstep, voffA); PG8_STAGE(PG8_SB(1, 1), cB + hstepB + kstep, voffB);
    PG8_WAIT_V(6); PG8_BAR;
    for (;;) {
        const bool has_next = S.next(ui + 1, nxt);
        const char* nA = has_next ? nxt.A : cA; const char* nB = has_next ? nxt.B : cB;
        for (int t = 0; t < nt; t += 2) {
            const bool last = (t == nt - 2);
            const char* a1 = cA + (size_t)(t + 1) * kstep;
            const char* a2 = last ? nA : cA + (size_t)(t + 2) * kstep; const char* b2 = last ? nB : cB + (size_t)(t + 2) * kstep;
            const char* a3 = a2 + kstep; const char* b3 = b2 + kstep;
            PG8_LDB(B0, 0, 0); PG8_SCHED; PG8_LDA(At, 0, 0); PG8_STAGE(PG8_SA(1, 1), a1 + hstepA, voffA);
            PG8_WAIT_L(8); PG8_BAR; PG8_WAIT_L(0); PG8_MMA(0, 0, At, B0); PG8_BAR; PG8_SCHED;
            PG8_LDB(B1, 0, 1); PG8_STAGE(PG8_SB(0, 0), b2, voffB);
            PG8_BAR; PG8_WAIT_L(0); PG8_MMA(0, 1, At, B1); PG8_BAR;
            PG8_LDA(At, 0, 1); PG8_STAGE(PG8_SA(0, 0), a2, voffA);
            PG8_BAR; PG8_WAIT_L(0); PG8_MMA(1, 0, At, B0); PG8_BAR; PG8_SCHED;
            PG8_STAGE(PG8_SB(0, 1), b2 + hstepB, voffB);
            PG8_WAIT_V(6); PG8_BAR; PG8_MMA(1, 1, At, B1); PG8_BAR;
            PG8_LDB(B0, 1, 0); PG8_SCHED; PG8_LDA(At, 1, 0); PG8_STAGE(PG8_SA(0, 1), a2 + hstepA, voffA);
            PG8_WAIT_L(8); PG8_BAR; PG8_WAIT_L(0); PG8_MMA(0, 0, At, B0); PG8_BAR; PG8_SCHED;
            PG8_LDB(B1, 1, 1); PG8_STAGE(PG8_SB(1, 0), b3, voffB);
            PG8_BAR; PG8_WAIT_L(0); PG8_MMA(0, 1, At, B1); PG8_BAR;
            PG8_LDA(At, 1, 1); PG8_STAGE(PG8_SA(1, 0), a3, voffA);
            PG8_BAR; PG8_WAIT_L(0); PG8_MMA(1, 0, At, B0); PG8_BAR; PG8_SCHED;
            PG8_STAGE(PG8_SB(1, 1), b3 + hstepB, voffB);
            PG8_WAIT_V(6); PG8_BAR; PG8_MMA(1, 1, At, B1); PG8_BAR;
        }
        bool keep = false;
        if constexpr (Epi::CHAIN) keep = E.chain(acc, cur, wr, wc, fr, fq); else E(acc, cur, wr, wc, fr, fq);
        if (!has_next) break;
        if (!keep) {
#pragma unroll
            for (int a = 0; a < 2; ++a)
#pragma unroll
                for (int b = 0; b < 2; ++b)
#pragma unroll
                    for (int m = 0; m < 4; ++m)
#pragma unroll
                        for (int n = 0; n < 2; ++n) acc[a][b][m][n] = (f32x4){0.f, 0.f, 0.f, 0.f};
        }
        cur = nxt; cA = nA; cB = nB; ++ui;
    }
    PG8_WAIT_V(0);
    if (wr == 0) PG8_BAR;
    PG8_BAR;
#undef PG8_SA
#undef PG8_SB
#undef PG8_STAGE
#undef PG8_LDA
#undef PG8_LDB
#undef PG8_MMA
#undef PG8_WAIT_V
#undef PG8_WAIT_L
#undef PG8_BAR
#undef PG8_SCHED
}

struct EpiBf {
    static constexpr bool PERM = true, CHAIN = false;
    bf16_t* O0; int ld0; int split; bf16_t* O1; int ld1; int act1;
    __device__ __forceinline__ void operator()(const f32x4 (&acc)[2][2][4][2], const Unit& u, int wr, int wc, int fr, int fq) const {
        const bool second = u.pn >= split;
        bf16_t* base = second ? O1 : O0; const int ld = second ? ld1 : ld0; const int colt = (second ? (u.pn - split) : u.pn) * BM;
        const bool act = second && act1;
        const int row0 = u.pm * BM + wr * 64 + fr, col0 = colt + wc * 32 + 8 * fq;
#pragma unroll
        for (int ai = 0; ai < 2; ++ai)
#pragma unroll
            for (int m = 0; m < 4; ++m) { bf16_t* rowp = base + (size_t)(row0 + ai * HALF + m * 16) * ld + col0;
#pragma unroll
                for (int bj = 0; bj < 2; ++bj) { f32x4 v0 = acc[ai][bj][m][0], v1 = acc[ai][bj][m][1];
                    if (act) {
#pragma unroll
                        for (int j = 0; j < 4; ++j) { v0[j] = sigmoidf_(v0[j]); v1[j] = sigmoidf_(v1[j]); } }
                    u32x4 w; w.x = cvt_pk_bf16(v0[0], v0[1]); w.y = cvt_pk_bf16(v0[2], v0[3]); w.z = cvt_pk_bf16(v1[0], v1[1]); w.w = cvt_pk_bf16(v1[2], v1[3]);
                    *(u32x4*)(rowp + bj * HALF) = w; } }
    }
};
struct EpiMerge {
    static constexpr bool PERM = true, CHAIN = true;
    bf16_t* M; const bf16_t* ZG;
    __device__ __forceinline__ bool chain(f32x4 (&acc)[2][2][4][2], const Unit& u, int wr, int wc, int fr, int fq) const {
        const int row0 = u.pm * BM + wr * 64 + fr, col0 = u.pn * BM + wc * 32 + 8 * fq;
#pragma unroll
        for (int ai = 0; ai < 2; ++ai)
#pragma unroll
            for (int m = 0; m < 4; ++m) { const size_t r = (size_t)(row0 + ai * HALF + m * 16);
#pragma unroll
                for (int bj = 0; bj < 2; ++bj) {
                    const bf16_t* gp = ZG + r * 3072 + col0 + bj * HALF;
                    float f[8];
                    if (u.tag == 2) { const u32x4 g = *(const u32x4*)(gp + 2048);
                        f[0] = bflo(g.x); f[1] = bfhi(g.x); f[2] = bflo(g.y); f[3] = bfhi(g.y); f[4] = bflo(g.z); f[5] = bfhi(g.z); f[6] = bflo(g.w); f[7] = bfhi(g.w);
#pragma unroll
                        for (int e = 0; e < 8; ++e) f[e] = fmaxf(f[e], 1e-12f);
                    } else { const u32x4 gn = *(const u32x4*)(gp + u.tag * 1024), gd = *(const u32x4*)(gp + (u.tag + 1) * 1024);
                        const float nn[8] = {bflo(gn.x), bfhi(gn.x), bflo(gn.y), bfhi(gn.y), bflo(gn.z), bfhi(gn.z), bflo(gn.w), bfhi(gn.w)};
                        const float dd[8] = {bflo(gd.x), bfhi(gd.x), bflo(gd.y), bfhi(gd.y), bflo(gd.z), bfhi(gd.z), bflo(gd.w), bfhi(gd.w)};
#pragma unroll
                        for (int e = 0; e < 8; ++e) f[e] = (u.tag == 0 ? nn[e] : fmaxf(nn[e], 1e-12f)) * __builtin_amdgcn_rcpf(fmaxf(dd[e], 1e-12f)); }
                    f32x4& v0 = acc[ai][bj][m][0]; f32x4& v1 = acc[ai][bj][m][1];
                    v0[0] *= f[0]; v0[1] *= f[1]; v0[2] *= f[2]; v0[3] *= f[3]; v1[0] *= f[4]; v1[1] *= f[5]; v1[2] *= f[6]; v1[3] *= f[7];
                    if (u.tag == 2) { u32x4 w; w.x = cvt_pk_bf16(v0[0], v0[1]); w.y = cvt_pk_bf16(v0[2], v0[3]); w.z = cvt_pk_bf16(v1[0], v1[1]); w.w = cvt_pk_bf16(v1[2], v1[3]);
                        *(u32x4*)(M + r * 1024 + col0 + bj * HALF) = w; }
                } }
        return u.tag != 2;
    }
};
struct EpiRes {
    static constexpr bool PERM = true, CHAIN = false;
    const float* xin32; const bf16_t* xin16; bf16_t* xout; const float* gate;
    __device__ __forceinline__ void operator()(const f32x4 (&acc)[2][2][4][2], const Unit& u, int wr, int wc, int fr, int fq) const {
        const int row0 = u.pm * BM + wr * 64 + fr, col0 = u.pn * BM + wc * 32 + 8 * fq;
        const float* gp = gate + (size_t)(u.pm >> 4) * 6144 + col0;
        f32x4 gv[2][2];
#pragma unroll
        for (int bj = 0; bj < 2; ++bj) { gv[bj][0] = *(const f32x4*)(gp + bj * HALF); gv[bj][1] = *(const f32x4*)(gp + bj * HALF + 4); }
#pragma unroll
        for (int ai = 0; ai < 2; ++ai)
#pragma unroll
            for (int m = 0; m < 4; ++m) { const size_t off = (size_t)(row0 + ai * HALF + m * 16) * 1024 + col0;
#pragma unroll
                for (int bj = 0; bj < 2; ++bj) {
                    f32x4 x0, x1;
                    if (xin32) { x0 = *(const f32x4*)(xin32 + off + bj * HALF); x1 = *(const f32x4*)(xin32 + off + bj * HALF + 4); }
                    else { const u32x4 xw = *(const u32x4*)(xin16 + off + bj * HALF);
                        x0 = (f32x4){bflo(xw.x), bfhi(xw.x), bflo(xw.y), bfhi(xw.y)}; x1 = (f32x4){bflo(xw.z), bfhi(xw.z), bflo(xw.w), bfhi(xw.w)}; }
                    const f32x4 o0 = x0 + gv[bj][0] * acc[ai][bj][m][0], o1 = x1 + gv[bj][1] * acc[ai][bj][m][1];
                    u32x4 w; w.x = cvt_pk_bf16(o0[0], o0[1]); w.y = cvt_pk_bf16(o0[2], o0[3]); w.z = cvt_pk_bf16(o1[0], o1[1]); w.w = cvt_pk_bf16(o1[2], o1[3]);
                    *(u32x4*)(xout + off + bj * HALF) = w; } }
    }
};
__device__ __forceinline__ float dpp_prev(float x, float y, int n) {
    if (n == 1) { const int yr = __builtin_amdgcn_update_dpp(0, __float_as_int(y), 0x121, 0xf, 0xf, false);
                  return __int_as_float(__builtin_amdgcn_update_dpp(yr, __float_as_int(x), 0x111, 0xf, 0xf, false)); }
    const int yr = __builtin_amdgcn_update_dpp(0, __float_as_int(y), 0x122, 0xf, 0xf, false);
    return __int_as_float(__builtin_amdgcn_update_dpp(yr, __float_as_int(x), 0x112, 0xf, 0xf, false));
}
struct EpiUp {
    static constexpr bool PERM = true, CHAIN = false;
    bf16_t* U; float* HA; float* HB; const float* cw;
    __device__ __forceinline__ void operator()(const f32x4 (&acc)[2][2][4][2], const Unit& u, int wr, int wc, int fr, int fq) const {
        const int c0 = 128 * u.pn + 32 * wc + 8 * fq;
        float w0[8], w1[8], w2[8];
        { float f[24];
#pragma unroll
          for (int q = 0; q < 6; ++q) { const f32x4 v = *(const f32x4*)(cw + (size_t)c0 * 3 + 4 * q); f[4 * q] = v[0]; f[4 * q + 1] = v[1]; f[4 * q + 2] = v[2]; f[4 * q + 3] = v[3]; }
#pragma unroll
          for (int e = 0; e < 8; ++e) { w0[e] = f[3 * e]; w1[e] = f[3 * e + 1]; w2[e] = f[3 * e + 2]; } }
#pragma unroll
        for (int ai = 0; ai < 2; ++ai) {
            const int grp = 4 * u.pm + 2 * ai + wr;
            float Y[8];
#pragma unroll
            for (int e = 0; e < 8; ++e) Y[e] = 0.f;
#pragma unroll
            for (int m = 0; m < 4; ++m) {
                const size_t row = (size_t)u.pm * BM + ai * HALF + wr * 64 + m * 16 + fr;
                float X[8], G[8], o[8];
#pragma unroll
                for (int e = 0; e < 8; ++e) { X[e] = acc[ai][0][m][e >> 2][e & 3]; G[e] = acc[ai][1][m][e >> 2][e & 3]; }
#pragma unroll
                for (int e = 0; e < 8; ++e) { const float a1 = dpp_prev(X[e], Y[e], 1), a2 = dpp_prev(X[e], Y[e], 2);
                    const float s = w0[e] * a2 + w1[e] * a1 + w2[e] * X[e]; o[e] = s * sigmoidf_(s) * G[e]; }
                if (m > 0 || fr >= 2) { u32x4 w; w.x = cvt_pk_bf16(o[0], o[1]); w.y = cvt_pk_bf16(o[2], o[3]); w.z = cvt_pk_bf16(o[4], o[5]); w.w = cvt_pk_bf16(o[6], o[7]);
                    *(u32x4*)(U + row * DFF + c0) = w; }
                if (m == 0 && fr < 2) { float* hb = HB + ((size_t)(grp * 2 + fr) * 2) * DFF + c0;
                    *(f32x4*)hb = (f32x4){X[0], X[1], X[2], X[3]}; *(f32x4*)(hb + 4) = (f32x4){X[4], X[5], X[6], X[7]};
                    *(f32x4*)(hb + DFF) = (f32x4){G[0], G[1], G[2], G[3]}; *(f32x4*)(hb + DFF + 4) = (f32x4){G[4], G[5], G[6], G[7]}; }
                if (m == 3 && fr >= 14) { float* ha = HA + (size_t)(grp * 2 + fr - 14) * DFF + c0;
                    *(f32x4*)ha = (f32x4){X[0], X[1], X[2], X[3]}; *(f32x4*)(ha + 4) = (f32x4){X[4], X[5], X[6], X[7]}; }
#pragma unroll
                for (int e = 0; e < 8; ++e) Y[e] = X[e];
            }
        }
    }
};
struct MergeOrder {
    int G, c; const char* o_att; const char* wbr;
    __device__ bool next(int i, Unit& u) const {
        const int tile = (i / 3) * G + c; if (tile >= (T_ / BM) * 4) return false;
        const int br = i % 3; u.pm = tile >> 2; u.pn = tile & 3; u.tag = br;
        u.A = o_att - (size_t)br * (32 * MiB) + (size_t)u.pm * BM * 512 * 2;
        u.B = wbr + (size_t)br * 1024 * 512 * 2 + (size_t)u.pn * BM * 512 * 2; return true;
    }
};
}

#define GSTRIDE_BLOCKS(var, n) for (int var = blockIdx.x; var < (n); var += gridDim.x)

__device__ __forceinline__ void ph_mod(const Params& P, LAS unsigned char* lds) {
    LAS float* red = (LAS float*)lds;
    float* mod = (float*)(P.ws + OFF_MOD); float* tab = (float*)(P.ws + OFF_TAB);
    const int tid = opaque_tid(), wid = tid >> 6, lane = tid & 63;
    GSTRIDE_BLOCKS(blk, 192) {
        const int l = blk / 96, jb = blk % 96, j = jb * 64 + lane;
        float acc[8];
#pragma unroll
        for (int b = 0; b < 8; ++b) acc[b] = 0.f;
        const float* aw = P.ada_w + (size_t)l * 1024 * 6144 + j;
        for (int k = wid * 128; k < wid * 128 + 128; ++k) {
            const float w = aw[(size_t)k * 6144];
#pragma unroll
            for (int b = 0; b < 8; ++b) acc[b] += P.c[b * 1024 + k] * w;
        }
#pragma unroll
        for (int b = 0; b < 8; ++b) red[(wid * 8 + b) * 64 + lane] = acc[b];
        __syncthreads();
        { const int b = wid; float s = P.ada_b[l * 6144 + j];
#pragma unroll
          for (int w = 0; w < 8; ++w) s += red[(w * 8 + b) * 64 + lane];
          mod[((size_t)l * 8 + b) * 6144 + j] = s; }
        __syncthreads();
    }
    if (blockIdx.x == gridDim.x - 1) {
        for (int i = tid; i < 1024; i += NTHR) { const int n = i >> 3, h = i & 7; int bk;
            if (n < 16) bk = n; else { const float nf = (float)n; bk = 16 + (int)(logf(nf / 16.0f) / 2.0794415416798357f * 16.0f); bk = bk < 31 ? bk : 31; }
            tab[i] = P.rel_bias[bk * 8 + h]; }
    }
}

struct WJob { const float* src; int ldsrc; int K; int N; bf16_t* dst; int win; };
template <int KT  >
__device__ __forceinline__ void conv_tiles(const WJob& J, LAS float* tile  ) {
    const int tid = opaque_tid(); const int nkt = J.K / KT, nnt = J.N / 64, ntiles = nkt * nnt;
    GSTRIDE_BLOCKS(ti, ntiles) {
        const int kt = ti % nkt, ntb = ti / nkt, k0 = kt * KT, n0 = ntb * 64;
        { const int n = tid & 63, kk0 = tid >> 6; const int nn = n0 + n; int col = nn;
          if (J.win == 1) col = nn < 2120 ? nn : (nn < 2304 ? -1 : nn - 184);
          if (J.win == 2) col = ((nn & 255) < 128) ? 128 * (nn >> 8) + (nn & 127) : DFF + 128 * (nn >> 8) + (nn & 127);
          float v[KT / 8];
#pragma unroll
          for (int p = 0; p < KT / 8; ++p) { const int k = kk0 + 8 * p; v[p] = col >= 0 ? J.src[(size_t)(k0 + k) * J.ldsrc + col] : 0.f; }
#pragma unroll
          for (int p = 0; p < KT / 8; ++p) tile[(kk0 + 8 * p) * 65 + n] = v[p]; }
        __syncthreads();
#pragma unroll
        for (int q = 0; q < KT / 64; ++q) { const int n = tid >> 3, kg = (tid & 7) + 8 * q; float v[8];
#pragma unroll
          for (int e = 0; e < 8; ++e) v[e] = tile[(kg * 8 + e) * 65 + n];
          u32x4 w; w.x = cvt_pk_bf16(v[0], v[1]); w.y = cvt_pk_bf16(v[2], v[3]); w.z = cvt_pk_bf16(v[4], v[5]); w.w = cvt_pk_bf16(v[6], v[7]);
          *(u32x4*)(J.dst + (size_t)(n0 + n) * J.K + k0 + kg * 8) = w; }
        __syncthreads();
    }
}
__device__ __forceinline__ void ph_wconv(const Params& P, int l, LAS unsigned char* lds) {
    LAS float* tile = (LAS float*)lds; unsigned char* wb = P.ws + OFF_WB;
    { WJob J{P.w_in + (size_t)l * 1024 * IN_COLS, IN_COLS, 1024, 8704, (bf16_t*)(wb + WB_WIN), 1}; conv_tiles<256>(J, tile); }
    for (int i = 0; i < 3; ++i) { WJob J{P.w_branch + ((size_t)l * 3 + i) * 512 * 1024, 1024, 512, 1024, (bf16_t*)(wb + WB_WBR) + (size_t)i * 1024 * 512, 0}; conv_tiles<256>(J, tile); }
    { WJob J{P.w_o + (size_t)l * 1024 * 1024, 1024, 1024, 1024, (bf16_t*)(wb + WB_WO), 0}; conv_tiles<256>(J, tile); }
    { WJob J{P.ffn_w_up + (size_t)l * 1024 * 5632, 5632, 1024, 5632, (bf16_t*)(wb + WB_WUP), 2}; conv_tiles<256>(J, tile); }
    { WJob J{P.ffn_w_down + (size_t)l * 2816 * 1024, 1024, 2816, 1024, (bf16_t*)(wb + WB_WDN), 0}; conv_tiles<256>(J, tile); }
    { WJob J{P.w_up + (size_t)l * 64 * 512, 512, 64, 512, (bf16_t*)(wb + WB_LW), 0}; conv_tiles<64>(J, tile); }
    { WJob J{P.a_up + (size_t)l * 64 * 512, 512, 64, 512, (bf16_t*)(wb + WB_LA), 0}; conv_tiles<64>(J, tile); }
    { WJob J{P.g_up + (size_t)l * 128 * 512, 512, 128, 512, (bf16_t*)(wb + WB_LG), 0}; conv_tiles<64>(J, tile); }
}

__device__ __forceinline__ void ph_norm(const Params& P, int l, int which) {
    const bool first = (l == 0 && which == 0);
    const float* nw = (which == 0 ? P.norm_mix : P.norm_ffn) + l * 1024;
    const float* mod = (const float*)(P.ws + OFF_MOD) + (size_t)l * 8 * 6144 + which * 3072;
    const bf16_t* XB = (const bf16_t*)P.out;
    bf16_t* H = (bf16_t*)(P.ws + OFF_H);
    const int tid = opaque_tid(), wid = tid >> 6, lane = tid & 63;
    for (int row = blockIdx.x * 8 + wid; row < T_; row += gridDim.x * 8) {
        const int b = row >> 12; const float* mb = mod + (size_t)b * 6144;
        f32x4 v[4]; float ss = 0.f;
#pragma unroll
        for (int i = 0; i < 4; ++i) {
            if (first) v[i] = *(const f32x4*)(P.x_in + (size_t)row * 1024 + i * 256 + lane * 4);
            else { const u32x2 w = *(const u32x2*)(XB + (size_t)row * 1024 + i * 256 + lane * 4); v[i] = (f32x4){bflo(w.x), bfhi(w.x), bflo(w.y), bfhi(w.y)}; }
            ss += v[i][0] * v[i][0] + v[i][1] * v[i][1] + v[i][2] * v[i][2] + v[i][3] * v[i][3]; }
        ss = wave_sum(ss, lane);
        const float rstd = rsqrtf(ss * (1.0f / 1024.0f) + 1e-6f);
#pragma unroll
        for (int i = 0; i < 4; ++i) { const int c = i * 256 + lane * 4;
            const f32x4 g = *(const f32x4*)(nw + c), sh = *(const f32x4*)(mb + c), sc = *(const f32x4*)(mb + 1024 + c);
            const f32x4 y = v[i] * rstd * g * (sc + 1.0f) + sh;
            u32x2 w; w.x = cvt_pk_bf16(y[0], y[1]); w.y = cvt_pk_bf16(y[2], y[3]);
            *(u32x2*)(H + (size_t)row * 1024 + c) = w; }
    }
}

__device__ __forceinline__ void ph_final(const Params& P) {
    const bf16_t* XF = (const bf16_t*)(P.ws + OFF_H);
    const int tid = opaque_tid(), wid = tid >> 6, lane = tid & 63;
    for (int row = blockIdx.x * 8 + wid; row < T_; row += gridDim.x * 8) {
        float* xr = P.out + (size_t)row * 1024;
        f32x4 v[4]; float ss = 0.f;
#pragma unroll
        for (int i = 0; i < 4; ++i) { const u32x2 w = *(const u32x2*)(XF + (size_t)row * 1024 + i * 256 + lane * 4); v[i] = (f32x4){bflo(w.x), bfhi(w.x), bflo(w.y), bfhi(w.y)};
            ss += v[i][0] * v[i][0] + v[i][1] * v[i][1] + v[i][2] * v[i][2] + v[i][3] * v[i][3]; }
        ss = wave_sum(ss, lane);
        const float rstd = rsqrtf(ss * (1.0f / 1024.0f) + 1e-6f);
#pragma unroll
        for (int i = 0; i < 4; ++i) { const int c = i * 256 + lane * 4; const f32x4 g = *(const f32x4*)(P.final_norm + c);
            *(f32x4*)(xr + c) = v[i] * rstd * g; }
    }
}

__device__ __forceinline__ void ph_gemm_zq(const Params& P, LAS unsigned char* lds) {
    g8::SOrder S; S.init(T_, 2304, 1024, 1024, P.ws + OFF_H, P.ws + OFF_WB + WB_WIN);
    g8::EpiBf E{(bf16_t*)(P.ws + OFF_ZQ), 2304, 9, nullptr, 0, 0};
    g8::gemm_phase(lds, 1024, 1024, 1024, S, E);
}
__device__ __forceinline__ void ph_gemm_zr(const Params& P, LAS unsigned char* lds) {
    g8::SOrder S; S.init(T_, 1792, 1024, 1024, P.ws + OFF_H, P.ws + OFF_WB + WB_WIN + (size_t)2304 * 1024 * 2);
    g8::EpiBf E{(bf16_t*)(P.ws + OFF_ZR), 1792, 7, nullptr, 0, 0};
    g8::gemm_phase(lds, 1024, 1024, 1024, S, E);
}
__device__ __forceinline__ void ph_gemm_zc(const Params& P, LAS unsigned char* lds) {
    g8::SOrder S; S.init(T_, 4608, 1024, 1024, P.ws + OFF_H, P.ws + OFF_WB + WB_WIN + (size_t)4096 * 1024 * 2);
    g8::EpiBf E{(bf16_t*)(P.ws + OFF_ZCV), 1536, 6, (bf16_t*)(P.ws + OFF_ZG), 3072, 1};
    g8::gemm_phase(lds, 1024, 1024, 1024, S, E);
}
__device__ __forceinline__ void ph_gemm_merge(const Params& P, LAS unsigned char* lds) {
    g8::MergeOrder S{(int)gridDim.x, (int)blockIdx.x, (const char*)(P.ws + OFF_OATT), (const char*)(P.ws + OFF_WB + WB_WBR)};
    g8::EpiMerge E{(bf16_t*)(P.ws + OFF_MRG), (const bf16_t*)(P.ws + OFF_ZG)};
    g8::gemm_phase(lds, 512, 512, 512, S, E);
}
__device__ __forceinline__ void ph_gemm_wo(const Params& P, int l, LAS unsigned char* lds) {
    g8::SOrder S; S.init(T_, 1024, 1024, 1024, P.ws + OFF_MRG, P.ws + OFF_WB + WB_WO);
    g8::EpiRes E{l == 0 ? P.x_in : nullptr, (const bf16_t*)P.out, (bf16_t*)P.out, (const float*)(P.ws + OFF_MOD) + (size_t)l * 8 * 6144 + 2048};
    g8::gemm_phase(lds, 1024, 1024, 1024, S, E);
}
__device__ __forceinline__ void ph_gemm_up(const Params& P, int l, LAS unsigned char* lds) {
    g8::SOrder S; S.init(T_, 5632, 1024, 1024, P.ws + OFF_H, P.ws + OFF_WB + WB_WUP);
    g8::EpiUp E{(bf16_t*)(P.ws + OFF_UP), (float*)(P.ws + OFF_HA), (float*)(P.ws + OFF_HB), P.ffn_conv_w + (size_t)l * DFF * 3};
    g8::gemm_phase(lds, 1024, 1024, 1024, S, E);
}
__device__ __forceinline__ void ph_gemm_down(const Params& P, int l, LAS unsigned char* lds) {
    g8::SOrder S; S.init(T_, 1024, 2816, 2816, P.ws + OFF_UP, P.ws + OFF_WB + WB_WDN);
    g8::EpiRes E{nullptr, (const bf16_t*)P.out, l == 1 ? (bf16_t*)(P.ws + OFF_H) : (bf16_t*)P.out, (const float*)(P.ws + OFF_MOD) + (size_t)l * 8 * 6144 + 5120};
    g8::gemm_phase(lds, 2816, 2816, 2816, S, E);
}

__device__ __forceinline__ void ph_conv(const Params& P, int l, LAS unsigned char* lds) {
    const bf16_t* Z = (const bf16_t*)(P.ws + OFF_ZCV); bf16_t* O = (bf16_t*)(P.ws + OFF_OCONV);
    LAS float* cwT = (LAS float*)lds;
    const int tid = opaque_tid();
    for (int i = tid; i < 1536; i += NTHR) cwT[(i % 3) * 512 + i / 3] = P.sc_conv_w[(size_t)l * 1536 + i];
    __syncthreads();
    constexpr int RB = 16; const int nitem = (T_ / RB) * 64;
    for (int it = blockIdx.x * NTHR + tid; it < nitem; it += gridDim.x * NTHR) {
        const int rb = it >> 6, c0 = (it & 63) * 8, row0 = rb * RB, t0 = row0 & 4095;
        float w0[8], w1[8], w2[8];
#pragma unroll
        for (int e = 0; e < 8; ++e) { w0[e] = cwT[c0 + e]; w1[e] = cwT[512 + c0 + e]; w2[e] = cwT[1024 + c0 + e]; }
        float pm2[8], pm1[8];
#pragma unroll
        for (int e = 0; e < 8; ++e) { pm2[e] = 0.f; pm1[e] = 0.f; }
        if (t0 >= 2) {
#pragma unroll
            for (int j = 0; j < 2; ++j) { const bf16_t* zr = Z + (size_t)(row0 - 2 + j) * 1536;
                const u32x4 cc = *(const u32x4*)(zr + 512 + c0), cx = *(const u32x4*)(zr + 1024 + c0);
                const unsigned ccw[4] = {cc.x, cc.y, cc.z, cc.w}, cxw[4] = {cx.x, cx.y, cx.z, cx.w};
#pragma unroll
                for (int q = 0; q < 4; ++q) { const float a = bflo(ccw[q]) * bflo(cxw[q]), b2 = bfhi(ccw[q]) * bfhi(cxw[q]);
                    if (j == 0) { pm2[2 * q] = a; pm2[2 * q + 1] = b2; } else { pm1[2 * q] = a; pm1[2 * q + 1] = b2; } } }
        }
#pragma unroll 4
        for (int r = 0; r < RB; ++r) {
            const bf16_t* zr = Z + (size_t)(row0 + r) * 1536;
            const u32x4 cb = *(const u32x4*)(zr + c0), cc = *(const u32x4*)(zr + 512 + c0), cx = *(const u32x4*)(zr + 1024 + c0);
            const unsigned cbw[4] = {cb.x, cb.y, cb.z, cb.w}, ccw[4] = {cc.x, cc.y, cc.z, cc.w}, cxw[4] = {cx.x, cx.y, cx.z, cx.w};
            float cur[8], o[8];
#pragma unroll
            for (int q = 0; q < 4; ++q) { cur[2 * q] = bflo(ccw[q]) * bflo(cxw[q]); cur[2 * q + 1] = bfhi(ccw[q]) * bfhi(cxw[q]); }
#pragma unroll
            for (int e = 0; e < 8; ++e) { o[e] = w0[e] * pm2[e] + w1[e] * pm1[e] + w2[e] * cur[e]; pm2[e] = pm1[e]; pm1[e] = cur[e]; }
            u32x4 w; w.x = cvt_pk_bf16(o[0] * bflo(cbw[0]), o[1] * bfhi(cbw[0])); w.y = cvt_pk_bf16(o[2] * bflo(cbw[1]), o[3] * bfhi(cbw[1]));
            w.z = cvt_pk_bf16(o[4] * bflo(cbw[2]), o[5] * bfhi(cbw[2])); w.w = cvt_pk_bf16(o[6] * bflo(cbw[3]), o[7] * bfhi(cbw[3]));
            *(u32x4*)(O + (size_t)(row0 + r) * 512 + c0) = w;
        }
    }
}

__device__ __forceinline__ void ph_ufix(const Params& P, int l, LAS unsigned char* lds) {
    bf16_t* U = (bf16_t*)(P.ws + OFF_UP); const float* HA = (const float*)(P.ws + OFF_HA); const float* HB = (const float*)(P.ws + OFF_HB);
    LAS float* cwT = (LAS float*)lds;
    const int tid = opaque_tid();
    for (int i = tid; i < DFF * 3; i += NTHR) cwT[(i % 3) * DFF + i / 3] = P.ffn_conv_w[(size_t)l * DFF * 3 + i];
    __syncthreads();
    const int nitem = (T_ / 64) * 2 * 352;
    for (int it = blockIdx.x * NTHR + tid; it < nitem; it += gridDim.x * NTHR) {
        const int c0 = (it % 352) * 8, gr = it / 352, grp = gr >> 1, rr = gr & 1; const bool first = (grp & 63) == 0;
        const float* hb = HB + ((size_t)(grp * 2 + rr) * 2) * DFF + c0;
        float a0[8], a1[8], a2[8], g[8];
#pragma unroll
        for (int q = 0; q < 2; ++q) { const f32x4 va = *(const f32x4*)(hb + 4 * q), vg = *(const f32x4*)(hb + DFF + 4 * q);
#pragma unroll
            for (int e = 0; e < 4; ++e) { a0[4 * q + e] = va[e]; g[4 * q + e] = vg[e]; a1[4 * q + e] = 0.f; a2[4 * q + e] = 0.f; } }
        if (rr == 1) { const float* p1 = HB + ((size_t)(grp * 2) * 2) * DFF + c0;
#pragma unroll
            for (int q = 0; q < 2; ++q) { const f32x4 v = *(const f32x4*)(p1 + 4 * q);
#pragma unroll
                for (int e = 0; e < 4; ++e) a1[4 * q + e] = v[e]; } }
        if (!first) {
            const float* pl = HA + (size_t)((grp - 1) * 2 + 1) * DFF + c0;
            const float* pk = HA + (size_t)((grp - 1) * 2) * DFF + c0;
#pragma unroll
            for (int q = 0; q < 2; ++q) { const f32x4 v63 = *(const f32x4*)(pl + 4 * q), v62 = *(const f32x4*)(pk + 4 * q);
#pragma unroll
                for (int e = 0; e < 4; ++e) { if (rr == 1) a2[4 * q + e] = v63[e]; else { a1[4 * q + e] = v63[e]; a2[4 * q + e] = v62[e]; } } }
        }
        float o[8];
#pragma unroll
        for (int e = 0; e < 8; ++e) { const float s = cwT[c0 + e] * a2[e] + cwT[DFF + c0 + e] * a1[e] + cwT[2 * DFF + c0 + e] * a0[e]; o[e] = s * sigmoidf_(s) * g[e]; }
        u32x4 w; w.x = cvt_pk_bf16(o[0], o[1]); w.y = cvt_pk_bf16(o[2], o[3]); w.z = cvt_pk_bf16(o[4], o[5]); w.w = cvt_pk_bf16(o[6], o[7]);
        *(u32x4*)(U + (size_t)(grp * 64 + rr) * DFF + c0) = w;
    }
}

template <int NR>
__device__ __forceinline__ u64 select_row(LAS float* row, const int t, const int lz) {
    const int imax = t >> 6;
    float x[NR]; float Tx = 0.f; bool have = false, exact = false;
    {
        int bin[NR]; float lo = __builtin_inff(), hi = -__builtin_inff();
        LAS unsigned* hist = (LAS unsigned*)row;
#pragma unroll
        for (int i = 0; i < NR; ++i) { const float v = row[64 * i + lz]; x[i] = (i <= imax) ? v : -__builtin_inff(); hi = fmaxf(hi, x[i]); lo = fminf(lo, (i < imax || x[i] > -__builtin_inff()) ? x[i] : __builtin_inff()); }
#pragma unroll
        for (int o = 32; o >= 1; o >>= 1) { lo = fminf(lo, shx(lo, o, lz)); hi = fmaxf(hi, shx(hi, o, lz)); }
        if (hi > lo) {
            const float scale = 4095.0f / (hi - lo);
#pragma unroll
            for (int q = 0; q < 16; ++q) *(LAS u32x4*)(hist + 256 * q + 4 * lz) = (u32x4){0u, 0u, 0u, 0u};
#pragma unroll
            for (int i = 0; i < NR; ++i) {
                const int bq = (int)fminf(fmaxf((x[i] - lo) * scale, -1.0f), 4095.0f); bin[i] = bq;
                if (bq >= 0) __hip_atomic_fetch_add(hist + bq, 1u, __ATOMIC_RELAXED, __HIP_MEMORY_SCOPE_WORKGROUP); }
            unsigned c1 = 0u;
#pragma unroll
            for (int q = 0; q < 16; ++q) { const u32x4 h4 = *(const LAS u32x4*)(hist + 64 * lz + 4 * ((q + lz) & 15)); c1 += (h4.x + h4.y) + (h4.z + h4.w); }
            unsigned inc = c1;
#pragma unroll
            for (int o = 1; o <= 32; o <<= 1) { const unsigned v = (unsigned)__builtin_amdgcn_ds_bpermute(((lz + o) & 63) << 2, (int)inc); inc += (lz + o < 64) ? v : 0u; }
            const unsigned ab1 = inc - c1;
            const u64 cr1 = __ballot(ab1 < 256u && ab1 + c1 >= 256u);
            const int L1 = __builtin_ctzll(cr1);
            const unsigned abL = (unsigned)__builtin_amdgcn_readlane((int)ab1, L1);
            const unsigned c2 = hist[64 * L1 + lz];
            unsigned inc2 = c2;
#pragma unroll
            for (int o = 1; o <= 32; o <<= 1) { const unsigned v = (unsigned)__builtin_amdgcn_ds_bpermute(((lz + o) & 63) << 2, (int)inc2); inc2 += (lz + o < 64) ? v : 0u; }
            const unsigned ab2 = inc2 - c2 + abL;
            const u64 cr2 = __ballot(ab2 < 256u && ab2 + c2 >= 256u);
            const int L2 = __builtin_ctzll(cr2);
            const int bstar = 64 * L1 + L2;
            const int cb = __builtin_amdgcn_readlane((int)c2, L2), need2 = 256 - __builtin_amdgcn_readlane((int)ab2, L2);
            if (cb <= 64) {
                int cand = 0; int pos = 0;
#pragma unroll
                for (int i = 0; i < NR; ++i) { u64 mm = __ballot(bin[i] == bstar);
                    while (mm) { const int s = __builtin_ctzll(mm); mm &= mm - 1ull; cand = writelane_v(cand, __builtin_amdgcn_readlane(__float_as_int(x[i]), s), pos); ++pos; } }
                const unsigned cu = (lz < cb) ? f2ord(__int_as_float(cand)) : 0u;
                unsigned Tc = 0u;
#pragma unroll 1
                for (int bit = 31; bit >= 0; --bit) { const unsigned cd = Tc | (1u << bit); if ((int)__popcll(__ballot(cu >= cd)) >= need2) Tc = cd; }
                Tx = ord2f(Tc); have = true; exact = (256 - need2) + (int)__popcll(__ballot(cu >= Tc)) == 256;
            }
        }
    }
    if (!have) {
        unsigned Tt = 0u;
#pragma unroll 1
        for (int bit = 31; bit >= 0; --bit) {
            const unsigned cand = Tt | (1u << bit); int cnt = 0;
#pragma unroll
            for (int i = 0; i < NR; ++i) cnt += __popcll(__ballot(f2ord(x[i]) >= cand));
            if (cnt >= 256) Tt = cand;
        }
        Tx = ord2f(Tt);
    }
    int wlo = 0, whi = 0;
#pragma unroll
    for (int i = 0; i < NR; ++i) { const u64 g = __ballot(x[i] >= Tx); writelane_c2(wlo, whi, (int)(unsigned)g, (int)(unsigned)(g >> 32), i); }
    u64 myw = ((u64)(unsigned)whi << 32) | (unsigned)wlo;
    if (!exact) {
        int cgt = 0;
#pragma unroll
        for (int i = 0; i < NR; ++i) cgt += __popcll(__ballot(x[i] > Tx));
        int need = 256 - cgt; myw = 0ull;
#pragma unroll
        for (int i = 0; i < NR; ++i) {
            const u64 g = __ballot(x[i] > Tx); u64 e = __ballot(x[i] == Tx);
            int ne = __popcll(e);
            while (ne > need) { e &= ~(1ull << (63 - __clzll(e))); --ne; }
            need -= ne;
            if (lz == i) myw = g | e;
        }
    }
    return myw;
}

__device__ __forceinline__ void ph_idx(const Params& P, LAS unsigned char* lds) {
    LAS float* SC = (LAS float*)lds;
    const bf16_t* ZQ = (const bf16_t*)(P.ws + OFF_ZQ); u64* MASK = (u64*)(P.ws + OFF_MASK);
    const int tid = opaque_tid(), wid = __builtin_amdgcn_readfirstlane(tid >> 6), lane = tid & 63, m = lane & 31, hh = lane >> 5;
    { int* KPM = (int*)(P.ws + OFF_KPM);
      for (int i = blockIdx.x * NTHR + tid; i < NB_ * 64; i += gridDim.x * NTHR) { const int* pp = P.pos + (i >> 6) * S_ + (i & 63) * 64; int mxp = pp[0];
          for (int k = 1; k < 64; ++k) mxp = pp[k] > mxp ? pp[k] : mxp;
          KPM[i] = mxp; } }
    int itc = 0;
    for (int idx = blockIdx.x; idx < NB_ * 512; idx += gridDim.x, ++itc) {
        const int b = idx & 7, j = idx >> 3; const int qb = (itc & 1) ? (j ^ 31) : j; const int t0 = qb * 8;
        const bf16_t* zb = ZQ + (size_t)b * S_ * 2304;
        bf16x8 Af[2][4]; float wv[2][16];
#pragma unroll
        for (int blk = 0; blk < 2; ++blk) {
            const bf16_t* qp = zb + (size_t)(t0 + 4 * blk + 2 * ((m >> 2) & 1) + (m >> 4)) * 2304 + 1536 + (4 * ((m >> 3) & 1) + (m & 3)) * 64 + 8 * hh;
#pragma unroll
            for (int ks = 0; ks < 4; ++ks) Af[blk][ks] = *(const bf16x8*)(qp + 16 * ks);
#pragma unroll
            for (int q = 0; q < 2; ++q) { const u32x4 ww = *(const u32x4*)(zb + (size_t)(t0 + 4 * blk + 2 * hh + q) * 2304 + 2112);
                wv[blk][8 * q + 0] = bflo(ww.x); wv[blk][8 * q + 1] = bfhi(ww.x); wv[blk][8 * q + 2] = bflo(ww.y); wv[blk][8 * q + 3] = bfhi(ww.y);
                wv[blk][8 * q + 4] = bflo(ww.z); wv[blk][8 * q + 5] = bfhi(ww.z); wv[blk][8 * q + 6] = bflo(ww.w); wv[blk][8 * q + 7] = bfhi(ww.w); }
        }
        const int ntile = 2 * ((t0 + 7) / 64 + 1);
        for (int kt = wid; kt < ntile; kt += 8) {
            const bf16_t* kp = zb + (size_t)(32 * kt + m) * 2304 + 2048 + 8 * hh;
            bf16x8 Bf[4];
#pragma unroll
            for (int ks = 0; ks < 4; ++ks) Bf[ks] = *(const bf16x8*)(kp + 16 * ks);
#pragma unroll
            for (int blk = 0; blk < 2; ++blk) {
                f32x16 Dv;
#pragma unroll
                for (int r = 0; r < 16; ++r) Dv[r] = 0.f;
#pragma unroll
                for (int ks = 0; ks < 4; ++ks) Dv = __builtin_amdgcn_mfma_f32_32x32x16_bf16(Af[blk][ks], Bf[ks], Dv, 0, 0, 0);
#pragma unroll
                for (int q = 0; q < 2; ++q) {
                    float part = 0.f;
#pragma unroll
                    for (int e = 0; e < 8; ++e) { const float d = Dv[8 * q + e], w = wv[blk][8 * q + e]; part = __builtin_fmaf(w, d, part); part = __builtin_fmaf(w, __builtin_fabsf(d), part); }
                    SC[(4 * blk + 2 * hh + q) * 4096 + 32 * kt + m] = (32 * kt + m <= t0 + 4 * blk + 2 * hh + q) ? part : -__builtin_inff();
                }
            }
        }
        __syncthreads();
        {
            const int t = t0 + wid; u64* mrow = MASK + (size_t)(b * S_ + t) * 64;
            if (t < 256) {
                const int lo = 64 * lane; u64 w;
                if (t >= lo + 63) w = ~0ull; else if (t < lo) w = 0ull; else w = (2ull << (t - lo)) - 1ull;
                mrow[lane] = w;
            } else {
                int lz = threadIdx.x; asm volatile("" : "+v"(lz)); lz &= 63;
                LAS float* rowp = SC + wid * 4096; u64 myw;
                if (t < 512) myw = select_row<8>(rowp, t, lz); else if (t < 1024) myw = select_row<16>(rowp, t, lz); else if (t < 2048) myw = select_row<32>(rowp, t, lz); else myw = select_row<64>(rowp, t, lz);
                mrow[lz] = myw;
            }
        }
        __syncthreads();
    }
    {
        LAS bf16_t* tl = (LAS bf16_t*)lds;
        bf16_t* VT = (bf16_t*)(P.ws + OFF_VT);
        for (int it = blockIdx.x; it < NB_ * 8 * 64; it += gridDim.x) {
            const int b = it >> 9, h = (it >> 6) & 7, k0 = (it & 63) * 64;
            { const int row = tid >> 3, ch = tid & 7;
              const u32x4 v = *(const u32x4*)(ZQ + (size_t)(b * S_ + k0 + row) * 2304 + 1024 + h * 64 + ch * 8);
              *(LAS u32x4*)(tl + row * 72 + ch * 8) = v; }
            __syncthreads();
            { const int d = tid >> 3, kc = tid & 7; unsigned short e[8];
#pragma unroll
              for (int q = 0; q < 8; ++q) e[q] = tl[(kc * 8 + q) * 72 + d];
              u32x4 w; w.x = e[0] | ((unsigned)e[1] << 16); w.y = e[2] | ((unsigned)e[3] << 16); w.z = e[4] | ((unsigned)e[5] << 16); w.w = e[6] | ((unsigned)e[7] << 16);
              *(u32x4*)(VT + ((size_t)((b * 8 + h) * 64 + d)) * S_ + k0 + kc * 8) = w; }
            __syncthreads();
        }
    }
}

__device__ __forceinline__ int bitmask(int w, int pos  ) { int m; asm("v_bfe_i32 %0, %1, %2, 1" : "=v"(m) : "v"(w), "n"(pos)); return m; }
__device__ __forceinline__ void ph_att(const Params& P, LAS unsigned char* lds) {
    LAS float* TABL = (LAS float*)lds;
    LAS unsigned char* KB = lds + 4096;
    constexpr int KT_B = 64 * 144, VT_B = 64 * 136, BUF_B = KT_B + VT_B;
    constexpr float LOG2E = 1.4426950408889634f;
    const float* tabg = (const float*)(P.ws + OFF_TAB);
    const int tid = opaque_tid(), wid = __builtin_amdgcn_readfirstlane(tid >> 6), lane = tid & 63, m = lane & 31, hh = lane >> 5;
    for (int i = tid; i < 1024; i += NTHR) TABL[i] = tabg[i] * LOG2E;
    __syncthreads();
    const bf16_t* ZQ = (const bf16_t*)(P.ws + OFF_ZQ); const u64* MASK = (const u64*)(P.ws + OFF_MASK);
    const bf16_t* VT = (const bf16_t*)(P.ws + OFF_VT); bf16_t* OA = (bf16_t*)(P.ws + OFF_OATT); const int* KPM = (const int*)(P.ws + OFF_KPM);
    int itc = 0;
    for (int idx = blockIdx.x; idx < NB_ * 8 * 16; idx += gridDim.x, ++itc) {
        const int b = idx & 7, head = (idx >> 3) & 7, j = idx >> 6; const int qb = (itc & 1) ? (j ^ 3) : j;
        const int q0 = qb * 256, tq0 = q0 + 32 * wid, t = tq0 + m;
        const bf16_t* zb = ZQ + (size_t)b * S_ * 2304;
        bf16x8 Qf[4];
        { const bf16_t* qp = zb + (size_t)t * 2304 + head * 64 + 8 * hh;
#pragma unroll
          for (int ks = 0; ks < 4; ++ks) Qf[ks] = *(const bf16x8*)(qp + 16 * ks); }
        const int posq = P.pos[b * S_ + t];
        int minq = posq;
#pragma unroll
        for (int o = 32; o >= 1; o >>= 1) { const int v = shxi(minq, o, lane); minq = v < minq ? v : minq; }
        minq = __builtin_amdgcn_readfirstlane(minq);
        const u64* mrow = MASK + (size_t)(b * S_ + t) * 64;
        const bf16_t* vtb = VT + (size_t)(b * 8 + head) * 64 * S_;
        const float c1 = 0.125f * LOG2E, c2 = TABL[127 * 8 + head];
        f32x16 O0, O1, OL;
#pragma unroll
        for (int r = 0; r < 16; ++r) { O0[r] = 0.f; O1[r] = 0.f; OL[r] = 0.f; }
        const bf16x8 ones8 = {0x3F80, 0x3F80, 0x3F80, 0x3F80, 0x3F80, 0x3F80, 0x3F80, 0x3F80};
        float m_run = -1e30f;
        const int nt = 4 * qb + 4, my_nt = ((tq0 + 31) >> 6) + 1;
        const int skey = tid >> 3, sch = tid & 7;
        const bf16_t* kg = zb + (size_t)skey * 2304 + 512 + head * 64 + 8 * sch;
        const bf16_t* vg = vtb + (size_t)skey * S_ + 8 * sch;
        LAS unsigned char* kdst = KB + skey * 144 + sch * 16; LAS unsigned char* vdst = KB + KT_B + skey * 136 + sch * 16;
        u64 mw_nxt = mrow[0]; const int kpm_l = KPM[b * 64 + lane];
        auto tile = [&](const int kt, const int boff) {
                const LAS unsigned char* Kt = KB + boff; const LAS unsigned char* Vt = Kt + KT_B;
                f32x16 D0, D1;
#pragma unroll
                for (int r = 0; r < 16; ++r) { D0[r] = 0.f; D1[r] = 0.f; }
#pragma unroll
                for (int ks = 0; ks < 4; ++ks) {
                    const bf16x8 K0 = *(const LAS bf16x8*)(Kt + m * 144 + 32 * ks + 16 * hh), K1 = *(const LAS bf16x8*)(Kt + (32 + m) * 144 + 32 * ks + 16 * hh);
                    D0 = __builtin_amdgcn_mfma_f32_32x32x16_bf16(K0, Qf[ks], D0, 0, 0, 0); D1 = __builtin_amdgcn_mfma_f32_32x32x16_bf16(K1, Qf[ks], D1, 0, 0, 0); }
                const u64 mw = mw_nxt; mw_nxt = mrow[kt + 1 < 64 ? kt + 1 : kt];
                const int w0 = (int)((unsigned)mw >> (4 * hh)), w1 = (int)((unsigned)(mw >> 32) >> (4 * hh));
                float esc = c1, eoff0 = c2;
                if (minq - __builtin_amdgcn_readlane(kpm_l, kt) < 127) {
#pragma unroll
                    for (int mb = 0; mb < 2; ++mb)
#pragma unroll
                        for (int g = 0; g < 4; ++g) {
                            const i32x4 pk = *(const i32x4*)(P.pos + b * S_ + 64 * kt + 32 * mb + 8 * g + 4 * hh);
#pragma unroll
                            for (int e = 0; e < 4; ++e) { const int r = 4 * g + e; int n = posq - pk[e]; n = n < 0 ? 0 : (n > 127 ? 127 : n);
                                if (mb) D1[r] = D1[r] * c1 + TABL[n * 8 + head]; else D0[r] = D0[r] * c1 + TABL[n * 8 + head]; }
                        }
                    esc = 1.0f; eoff0 = 0.f;
                }
                float mx = __builtin_fmaxf(__builtin_fmaxf(D0[0], D0[1]), D0[2]);
#pragma unroll
                for (int r = 3; r < 15; r += 2) mx = __builtin_fmaxf(__builtin_fmaxf(mx, D0[r]), D0[r + 1]);
#pragma unroll
                for (int r = 0; r < 16; r += 2) mx = __builtin_fmaxf(__builtin_fmaxf(mx, D1[r]), D1[r + 1]);
                mx = fmaxf(mx, D0[15]);
                mx = fmaxf(mx, shx(mx, 32, lane));
                const float m_new = fmaxf(m_run, mx * esc + eoff0); const float alpha = __builtin_amdgcn_exp2f(m_run - m_new); m_run = m_new;
                const float eoff = eoff0 - m_new;
                float pv[32];
#pragma unroll
                for (int r = 0; r < 16; ++r) {
                    const int bp = (r & 3) + 8 * (r >> 2);
                    pv[r] = __int_as_float(__float_as_int(__builtin_amdgcn_exp2f(D0[r] * esc + eoff)) & bitmask(w0, bp));
                    pv[16 + r] = __int_as_float(__float_as_int(__builtin_amdgcn_exp2f(D1[r] * esc + eoff)) & bitmask(w1, bp)); }
                if (!__all(alpha == 1.0f)) {
#pragma unroll
                    for (int r = 0; r < 16; ++r) { O0[r] *= alpha; O1[r] *= alpha; OL[r] *= alpha; } }
#pragma unroll
                for (int s = 0; s < 4; ++s) {
                    u32x4 pw; pw.x = cvt_pk_bf16(pv[8 * s + 0], pv[8 * s + 1]); pw.y = cvt_pk_bf16(pv[8 * s + 2], pv[8 * s + 3]); pw.z = cvt_pk_bf16(pv[8 * s + 4], pv[8 * s + 5]); pw.w = cvt_pk_bf16(pv[8 * s + 6], pv[8 * s + 7]);
                    const bf16x8 Pf = __builtin_bit_cast(bf16x8, pw);
                    const LAS unsigned char* vp = Vt + m * 136 + (16 * s + 4 * hh) * 2;
                    { const u32x2 va = *(const LAS u32x2*)vp, vb = *(const LAS u32x2*)(vp + 16); u32x4 vw; vw.x = va.x; vw.y = va.y; vw.z = vb.x; vw.w = vb.y;
                      O0 = __builtin_amdgcn_mfma_f32_32x32x16_bf16(__builtin_bit_cast(bf16x8, vw), Pf, O0, 0, 0, 0); }
                    { const u32x2 va = *(const LAS u32x2*)(vp + 32 * 136), vb = *(const LAS u32x2*)(vp + 32 * 136 + 16); u32x4 vw; vw.x = va.x; vw.y = va.y; vw.z = vb.x; vw.w = vb.y;
                      O1 = __builtin_amdgcn_mfma_f32_32x32x16_bf16(__builtin_bit_cast(bf16x8, vw), Pf, O1, 0, 0, 0); }
                    OL = __builtin_amdgcn_mfma_f32_32x32x16_bf16(ones8, Pf, OL, 0, 0, 0);
                }
        };
        __syncthreads();
        constexpr int SUB_B = KT_B + VT_B, SUP_B = 2 * SUB_B;
        const int nst = nt >> 1;
        u32x4 ka0, kb0, va0, vb0, ka1, kb1, va1, vb1;
#define ATT_LOAD(KA, KB_, VA, VB, ST) do { KA = *(const u32x4*)(kg + (size_t)(2 * (ST)) * 64 * 2304); KB_ = *(const u32x4*)(kg + (size_t)(2 * (ST) + 1) * 64 * 2304); \
            VA = *(const u32x4*)(vg + (2 * (ST)) * 64); VB = *(const u32x4*)(vg + (2 * (ST) + 1) * 64); } while (0)
#define ATT_STORE(KA, KB_, VA, VB, BUF) do { LAS unsigned char* kd_ = kdst + (BUF) * SUP_B; LAS unsigned char* vd_ = vdst + (BUF) * SUP_B; \
            *(LAS u32x4*)kd_ = KA; *(LAS u32x2*)vd_ = (u32x2){VA.x, VA.y}; *(LAS u32x2*)(vd_ + 8) = (u32x2){VA.z, VA.w}; \
            *(LAS u32x4*)(kd_ + SUB_B) = KB_; *(LAS u32x2*)(vd_ + SUB_B) = (u32x2){VB.x, VB.y}; *(LAS u32x2*)(vd_ + SUB_B + 8) = (u32x2){VB.z, VB.w}; } while (0)
        ATT_LOAD(ka0, kb0, va0, vb0, 0); ATT_STORE(ka0, kb0, va0, vb0, 0);
        if (nst > 1) ATT_LOAD(ka1, kb1, va1, vb1, 1);
        __syncthreads();
        for (int st = 0; st < nst; st += 2) {
            if (st + 2 < nst) ATT_LOAD(ka0, kb0, va0, vb0, st + 2);
            if (2 * st < my_nt) tile(2 * st, 0);
            if (2 * st + 1 < my_nt) tile(2 * st + 1, SUB_B);
            if (st + 1 < nst) ATT_STORE(ka1, kb1, va1, vb1, 1);
            __syncthreads();
            if (st + 1 >= nst) break;
            if (st + 3 < nst) ATT_LOAD(ka1, kb1, va1, vb1, st + 3);
            if (2 * st + 2 < my_nt) tile(2 * st + 2, SUP_B);
            if (2 * st + 3 < my_nt) tile(2 * st + 3, SUP_B + SUB_B);
            if (st + 2 < nst) ATT_STORE(ka0, kb0, va0, vb0, 0);
            __syncthreads();
        }
#undef ATT_LOAD
#undef ATT_STORE
        const float inv = __builtin_amdgcn_rcpf(OL[0]);
        bf16_t* op = OA + (size_t)(b * S_ + t) * 512 + head * 64 + 4 * hh;
#pragma unroll
        for (int g = 0; g < 4; ++g) {
            u32x2 wa; wa.x = cvt_pk_bf16(O0[4 * g] * inv, O0[4 * g + 1] * inv); wa.y = cvt_pk_bf16(O0[4 * g + 2] * inv, O0[4 * g + 3] * inv);
            *(u32x2*)(op + 8 * g) = wa;
            u32x2 wb; wb.x = cvt_pk_bf16(O1[4 * g] * inv, O1[4 * g + 1] * inv); wb.y = cvt_pk_bf16(O1[4 * g + 2] * inv, O1[4 * g + 3] * inv);
            *(u32x2*)(op + 32 + 8 * g) = wb;
        }
    }
}

#define DSR4(A, addr, o0, o1, o2, o3) asm volatile("ds_read_b128 %0, %4 offset:%5\n\tds_read_b128 %1, %4 offset:%6\n\tds_read_b128 %2, %4 offset:%7\n\tds_read_b128 %3, %4 offset:%8" \
    : "=&v"(A[0]), "=&v"(A[1]), "=&v"(A[2]), "=&v"(A[3]) : "v"(addr), "i"(o0), "i"(o1), "i"(o2), "i"(o3))
#define DSW(A, N) asm volatile("s_waitcnt lgkmcnt(" #N ")" : "+v"(A[0]), "+v"(A[1]), "+v"(A[2]), "+v"(A[3]))
#define SCAN_A(X, G) _Pragma("unroll") for (int i_ = 0; i_ < 4; ++i_) { const f32x2 k01 = {X[i_][0], X[i_][1]}, k23 = {X[i_][2], X[i_][3]}; \
    sa0 += S2[8 * G + 2 * i_] * k01; sa1 += S2[8 * G + 2 * i_ + 1] * k23; sp0 += Pm2[8 * G + 2 * i_] * k01; sp1 += Pm2[8 * G + 2 * i_ + 1] * k23; }
#define SCAN_B(X, C) { const int j = 2 * C; \
    { const f32x2 w = {X[0][0], X[0][1]}, kb = {X[1][0], X[1][1]}, kk = {X[2][0], X[2][1]}, rr = {X[3][0], X[3][1]}; \
      S2[j] = S2[j] * w + sav * kb + vv2 * kk; Pm2[j] = Pm2[j] * w + spv * kb; y0 += S2[j] * rr; p0 += Pm2[j] * rr; } \
    { const f32x2 w = {X[0][2], X[0][3]}, kb = {X[1][2], X[1][3]}, kk = {X[2][2], X[2][3]}, rr = {X[3][2], X[3][3]}; \
      S2[j + 1] = S2[j + 1] * w + sav * kb + vv2 * kk; Pm2[j + 1] = Pm2[j + 1] * w + spv * kb; y1 += S2[j + 1] * rr; p1 += Pm2[j + 1] * rr; } }
__device__ __forceinline__ float wave_sum_dpp(float v) {
    v += __int_as_float(__builtin_amdgcn_update_dpp(0, __float_as_int(v), 0x111, 0xf, 0xf, true));
    v += __int_as_float(__builtin_amdgcn_update_dpp(0, __float_as_int(v), 0x112, 0xf, 0xf, true));
    v += __int_as_float(__builtin_amdgcn_update_dpp(0, __float_as_int(v), 0x114, 0xf, 0xf, true));
    v += __int_as_float(__builtin_amdgcn_update_dpp(0, __float_as_int(v), 0x118, 0xf, 0xf, true));
    v += __int_as_float(__builtin_amdgcn_update_dpp(0, __float_as_int(v), 0x142, 0xa, 0xf, false));
    v += __int_as_float(__builtin_amdgcn_update_dpp(0, __float_as_int(v), 0x143, 0xc, 0xf, false));
    return __int_as_float(__builtin_amdgcn_readlane(__float_as_int(v), 63));
}
__device__ __forceinline__ void ph_scan(const Params& P, int l, LAS unsigned char* lds) {
    LAS bf16_t* LI = (LAS bf16_t*)lds;
    LAS float* SIN = (LAS float*)(lds + 32768);
    const bf16_t* ZR = (const bf16_t*)(P.ws + OFF_ZR);
    const float* mu = P.mu + (size_t)l * 1792;
    const bf16_t* LW = (const bf16_t*)(P.ws + OFF_WB + WB_LW); const bf16_t* LA = (const bf16_t*)(P.ws + OFF_WB + WB_LA); const bf16_t* LG = (const bf16_t*)(P.ws + OFF_WB + WB_LG);
    bf16_t* Yo = (bf16_t*)(P.ws + OFF_Y); bf16_t* Po = (bf16_t*)(P.ws + OFF_P); bf16_t* Go = (bf16_t*)(P.ws + OFF_G); bf16_t* VBo = (bf16_t*)(P.ws + OFF_VB);
    float* SEGp = (float*)(P.ws + OFF_SEG);
    const int tid = opaque_tid(), wid = __builtin_amdgcn_readfirstlane(tid >> 6), lane = tid & 63;
    for (int blk = blockIdx.x; blk < NB_ * NSEG; blk += gridDim.x) {
        const int b = blk / NSEG, seg = blk % NSEG, tbeg = seg * SEGL;
        f32x2 S2[32], Pm2[32];
        { int lq = threadIdx.x; asm volatile("" : "+v"(lq)); lq &= 63;
#pragma unroll
          for (int j = 0; j < 32; ++j) { S2[j] = (f32x2){0.f, 0.f}; Pm2[j] = (f32x2){(2 * j == lq) ? 1.f : 0.f, (2 * j + 1 == lq) ? 1.f : 0.f}; } }
        for (int half = 0; half < 2; ++half) {
            __syncthreads();
            {
                int tq = threadIdx.x; asm volatile("" : "+v"(tq));
#pragma unroll 1
                for (int rnd = 0; rnd < 4; ++rnd) {
                    const int q = tq + NTHR * rnd, tok = q >> 5, c8 = (q & 31) * 8, t = tbeg + 64 * half + tok; const size_t row = (size_t)b * S_ + t;
                    const u32x4 zc = *(const u32x4*)(ZR + row * 1792 + 1536 + c8);
                    u32x4 zp; zp.x = 0u; zp.y = 0u; zp.z = 0u; zp.w = 0u; if (t > 0) zp = *(const u32x4*)(ZR + (row - 1) * 1792 + 1536 + c8);
                    const f32x4 ma = *(const f32x4*)(mu + 1536 + c8), mb = *(const f32x4*)(mu + 1536 + c8 + 4);
                    const unsigned cw[4] = {zc.x, zc.y, zc.z, zc.w}, pw[4] = {zp.x, zp.y, zp.z, zp.w};
                    float x[8];
#pragma unroll
                    for (int q2 = 0; q2 < 4; ++q2) { const float c0 = bflo(cw[q2]), c1 = bfhi(cw[q2]), p0 = bflo(pw[q2]), p1 = bfhi(pw[q2]);
                        const float m0 = q2 < 2 ? ma[2 * q2] : mb[2 * q2 - 4], m1 = q2 < 2 ? ma[2 * q2 + 1] : mb[2 * q2 - 3];
                        x[2 * q2] = c0 + (p0 - c0) * m0; x[2 * q2 + 1] = c1 + (p1 - c1) * m1; }
#pragma unroll
                    for (int e = 0; e < 8; ++e) { if (c8 < 64) x[e] = 1.0f - 2.0f * __builtin_amdgcn_rcpf(1.0f + __expf(2.0f * x[e])); else if (c8 >= 128) x[e] = sigmoidf_(x[e]); }
                    u32x4 w; w.x = cvt_pk_bf16(x[0], x[1]); w.y = cvt_pk_bf16(x[2], x[3]); w.z = cvt_pk_bf16(x[4], x[5]); w.w = cvt_pk_bf16(x[6], x[7]);
                    *(LAS u32x4*)(LI + tok * 256 + c8) = w;
                }
            }
            __syncthreads();
            float* los = (float*)(P.ws + OFF_SCR) + (size_t)(blk * 8 + wid) * (64 * 2 * 64);
            {
                int tq = threadIdx.x; asm volatile("" : "+v"(tq));
                const int lq = tq & 63, fr = lq & 15, kq = lq >> 4;
#pragma unroll 1
                for (int pass = 0; pass < 8; ++pass) {
                    const int kind = pass < 2 ? 0 : (pass < 4 ? 1 : 2), Kk = kind == 2 ? 128 : 64, aoff = kind * 64, nb0 = kind == 2 ? pass - 4 : 2 * (pass & 1);
                    const bf16_t* Wt = kind == 0 ? LW : (kind == 1 ? LA : LG);
                    bf16x8 Bf[4];
#pragma unroll
                    for (int q = 0; q < 4; ++q) { const int nb = kind == 2 ? nb0 : nb0 + (q >> 1), ks = kind == 2 ? q : (q & 1);
                        Bf[q] = *(const bf16x8*)(Wt + (size_t)(64 * wid + 16 * nb + fr) * Kk + 32 * ks + 8 * kq); }
#pragma unroll 1
                    for (int tt = 0; tt < 4; ++tt) {
                        f32x4 acc[2];
                        acc[0] = (f32x4){0.f, 0.f, 0.f, 0.f}; acc[1] = acc[0];
#pragma unroll
                        for (int q = 0; q < 4; ++q) { const int ai = kind == 2 ? 0 : (q >> 1), ks = kind == 2 ? q : (q & 1);
                            const bf16x8 Afr = *(const LAS bf16x8*)(LI + (16 * tt + fr) * 256 + aoff + 32 * ks + 8 * kq);
                            acc[ai] = __builtin_amdgcn_mfma_f32_16x16x32_bf16(Afr, Bf[q], acc[ai], 0, 0, 0); }
                        if (kind == 2) {
#pragma unroll
                            for (int r = 0; r < 4; ++r) Go[((size_t)b * S_ + tbeg + 64 * half + 16 * tt + 4 * kq + r) * 512 + 64 * wid + 16 * nb0 + fr] = f2bf(acc[0][r]);
                        } else {
#pragma unroll
                            for (int ai = 0; ai < 2; ++ai)
#pragma unroll
                                for (int r = 0; r < 4; ++r) los[((16 * tt + 4 * kq + r) * 2 + kind) * 64 + 16 * (nb0 + ai) + fr] = acc[ai][r];
                        }
                    }
                }
            }
            asm volatile("s_waitcnt vmcnt(0)" ::: "memory");
            for (int sb = 0; sb < 64 / TB; ++sb) {
                const int ts = tbeg + 64 * half + sb * TB;
                int tz = threadIdx.x; asm volatile("" : "+v"(tz));
                const int lz = tz & 63;
                LAS float* sw = SIN + (size_t)wid * (TB * 6 * 64);
                {
                    const int c = 64 * wid + lz; const size_t row0 = (size_t)b * S_ + ts;
                    const float mur = mu[c], muk = mu[512 + c], muv = mu[1024 + c];
                    const float pw0 = P.w0[l * 512 + c], pa0 = P.a0[l * 512 + c], pkk = P.k_k[l * 512 + c], pka = P.k_a[l * 512 + c], prk = P.r_k[l * 512 + c];
                    const float* lo = los + (size_t)(sb * TB) * 128 + lz;
                    float pr = 0.f, pk = 0.f, pv = 0.f;
                    if (ts > 0) { pr = bf2f(ZR[(row0 - 1) * 1792 + c]); pk = bf2f(ZR[(row0 - 1) * 1792 + 512 + c]); pv = bf2f(ZR[(row0 - 1) * 1792 + 1024 + c]); }
                    float nr = bf2f(ZR[row0 * 1792 + c]), nk = bf2f(ZR[row0 * 1792 + 512 + c]), nv = bf2f(ZR[row0 * 1792 + 1024 + c]);
                    float nwl = lo[0], nal = lo[64];
#pragma unroll 1
                    for (int tk = 0; tk < TB; ++tk) {
                        const size_t row = row0 + tk; LAS float* st = sw + tk * 6 * 64;
                        const float cr = nr, ck = nk, cv = nv, wl = nwl, al = nal;
                        if (tk + 1 < TB) { nr = bf2f(ZR[(row + 1) * 1792 + c]); nk = bf2f(ZR[(row + 1) * 1792 + 512 + c]); nv = bf2f(ZR[(row + 1) * 1792 + 1024 + c]);
                            nwl = lo[(tk + 1) * 128]; nal = lo[(tk + 1) * 128 + 64]; }
                        const float rr = cr + (pr - cr) * mur, kv = ck + (pk - ck) * muk, vv = cv + (pv - cv) * muv;
                        pr = cr; pk = ck; pv = cv;
                        const float x = -(pw0 + wl);
                        const float sp = fmaxf(x, 0.f) + __logf(1.0f + __expf(-fabsf(x)));
                        const float dc = __expf(-__expf(-sp - 0.5f));
                        const float av = sigmoidf_(pa0 + al);
                        const float kkv = kv * pkk;
                        const float km = kv * (1.0f + (av - 1.0f) * pka);
                        const float ss = wave_sum_dpp(kkv * kkv), bon = wave_sum_dpp(rr * km * prk);
                        const float kkn = kkv * __builtin_amdgcn_rsqf(fmaxf(ss, 1e-24f));
                        st[lz] = rr; st[64 + lz] = dc; st[2 * 64 + lz] = km; st[3 * 64 + lz] = -kkn; st[4 * 64 + lz] = kkn * av; st[5 * 64 + lz] = vv;
                        VBo[row * 512 + c] = f2bf(bon * vv);
                    }
                }
#pragma unroll 1
                for (int tk = 0; tk < TB; ++tk) {
                    const LAS float* sq = sw + tk * 6 * 64;
                    const float vi = sq[5 * 64 + lz];
                    f32x2 sa0 = {0.f, 0.f}, sa1 = {0.f, 0.f}, sp0 = {0.f, 0.f}, sp1 = {0.f, 0.f};
                    f32x2 y0 = {0.f, 0.f}, y1 = {0.f, 0.f}, p0 = {0.f, 0.f}, p1 = {0.f, 0.f};
                    f32x2 sav, spv; const f32x2 vv2 = {vi, vi};
                    const unsigned sqa = (unsigned)(uintptr_t)sq;
                    f32x4 X0[4], X1[4], X2[4];
                    DSR4(X0, sqa, 768, 784, 800, 816);
                    DSR4(X1, sqa, 832, 848, 864, 880);
                    DSR4(X2, sqa, 896, 912, 928, 944);
                    DSW(X0, 8);
                    SCAN_A(X0, 0);
                    DSR4(X0, sqa, 960, 976, 992, 1008);
                    DSW(X1, 8);
                    SCAN_A(X1, 1);
                    DSR4(X1, sqa, 256, 1024, 512, 0);
                    DSW(X2, 8);
                    SCAN_A(X2, 2);
                    DSR4(X2, sqa, 272, 1040, 528, 16);
                    DSW(X0, 8);
                    SCAN_A(X0, 3);
                    { const float sa = (sa0.x + sa0.y) + (sa1.x + sa1.y), sp = (sp0.x + sp0.y) + (sp1.x + sp1.y); sav = (f32x2){sa, sa}; spv = (f32x2){sp, sp}; }
                    DSR4(X0, sqa, 288, 1056, 544, 32);
                    DSW(X1, 8);
                    SCAN_B(X1, 0);
                    DSR4(X1, sqa, 304, 1072, 560, 48);
                    DSW(X2, 8);
                    SCAN_B(X2, 1);
                    DSR4(X2, sqa, 320, 1088, 576, 64);
                    DSW(X0, 8);
                    SCAN_B(X0, 2);
                    DSR4(X0, sqa, 336, 1104, 592, 80);
                    DSW(X1, 8);
                    SCAN_B(X1, 3);
                    DSR4(X1, sqa, 352, 1120, 608, 96);
                    DSW(X2, 8);
                    SCAN_B(X2, 4);
                    DSR4(X2, sqa, 368, 1136, 624, 112);
                    DSW(X0, 8);
                    SCAN_B(X0, 5);
                    DSR4(X0, sqa, 384, 1152, 640, 128);
                    DSW(X1, 8);
                    SCAN_B(X1, 6);
                    DSR4(X1, sqa, 400, 1168, 656, 144);
                    DSW(X2, 8);
                    SCAN_B(X2, 7);
                    DSR4(X2, sqa, 416, 1184, 672, 160);
                    DSW(X0, 8);
                    SCAN_B(X0, 8);
                    DSR4(X0, sqa, 432, 1200, 688, 176);
                    DSW(X1, 8);
                    SCAN_B(X1, 9);
                    DSR4(X1, sqa, 448, 1216, 704, 192);
                    DSW(X2, 8);
                    SCAN_B(X2, 10);
                    DSR4(X2, sqa, 464, 1232, 720, 208);
                    DSW(X0, 8);
                    SCAN_B(X0, 11);
                    DSR4(X0, sqa, 480, 1248, 736, 224);
                    DSW(X1, 8);
                    SCAN_B(X1, 12);
                    DSR4(X1, sqa, 496, 1264, 752, 240);
                    DSW(X2, 8);
                    SCAN_B(X2, 13);
                    DSW(X0, 4);
                    SCAN_B(X0, 14);
                    DSW(X1, 0);
                    SCAN_B(X1, 15);
                    const size_t row = (size_t)b * S_ + ts + tk;
                    Yo[row * 512 + 64 * wid + lz] = f2bf((y0.x + y0.y) + (y1.x + y1.y));
                    Po[row * 512 + 64 * wid + lz] = f2bf((p0.x + p0.y) + (p1.x + p1.y));
                }
            }
        }
        {
            int lq = threadIdx.x; asm volatile("" : "+v"(lq)); lq &= 63;
            float* sg = SEGp + ((size_t)((b * 8 + wid) * NSEG + seg)) * 8192 + lq * 64;
#pragma unroll
            for (int j = 0; j < 32; j += 2) { *(f32x4*)(sg + 2 * j) = (f32x4){Pm2[j].x, Pm2[j].y, Pm2[j + 1].x, Pm2[j + 1].y};
                *(f32x4*)(sg + 4096 + 2 * j) = (f32x4){S2[j].x, S2[j].y, S2[j + 1].x, S2[j + 1].y}; }
        }
    }
}

__device__ __forceinline__ void ph_comb(const Params& P, LAS unsigned char* lds) {
    LAS float* SI = (LAS float*)lds;
    LAS float* PB = (LAS float*)(lds + 20480);
    float* SEGp = (float*)(P.ws + OFF_SEG);
    const int tid = opaque_tid(), wid = __builtin_amdgcn_readfirstlane(tid >> 6), lane = tid & 63, m = lane & 31, hh = lane >> 5;
    for (int chain = blockIdx.x; chain < 64; chain += gridDim.x) {
        float* base = SEGp + (size_t)chain * NSEG * 8192;
        __syncthreads();
        for (int i = tid; i < 4096; i += NTHR) SI[(i >> 6) * 65 + (i & 63)] = base[4096 + i];
        { const f32x4 a = *(const f32x4*)(base + 8192 + tid * 8), c = *(const f32x4*)(base + 8192 + tid * 8 + 4);
          *(LAS f32x4*)(PB + 4096 + tid * 8) = a; *(LAS f32x4*)(PB + 4096 + tid * 8 + 4) = c; }
        __syncthreads();
        const int ti = (wid >> 1) & 1, tj = wid & 1;
        for (int k = 1; k <= NSEG - 2; ++k) {
            float* Q = base + (size_t)k * 8192 + 4096;
            const LAS float* Pb = PB + (k & 1) * 4096;
            f32x4 na = {0.f, 0.f, 0.f, 0.f}, nc = na;
            if (k + 1 <= NSEG - 2) { const float* pn = base + (size_t)(k + 1) * 8192 + tid * 8; na = *(const f32x4*)pn; nc = *(const f32x4*)(pn + 4); }
            f32x16 Dv;
            if (wid < 4) {
                float qv[16];
#pragma unroll
                for (int r = 0; r < 16; ++r) { const int row = 32 * ti + (r & 3) + 8 * (r >> 2) + 4 * hh; qv[r] = Q[row * 64 + 32 * tj + m]; Dv[r] = 0.f; }
#pragma unroll
                for (int kk = 0; kk < 32; ++kk) { const float a = SI[(32 * ti + m) * 65 + 2 * kk + hh], bq = Pb[(2 * kk + hh) * 64 + 32 * tj + m];
                    Dv = __builtin_amdgcn_mfma_f32_32x32x2f32(a, bq, Dv, 0, 0, 0); }
#pragma unroll
                for (int r = 0; r < 16; ++r) Dv[r] += qv[r];
            }
            __syncthreads();
            if (wid < 4) {
#pragma unroll
                for (int r = 0; r < 16; ++r) { const int row = 32 * ti + (r & 3) + 8 * (r >> 2) + 4 * hh; SI[row * 65 + 32 * tj + m] = Dv[r]; Q[row * 64 + 32 * tj + m] = Dv[r]; }
            }
            if (k + 1 <= NSEG - 2) { LAS float* pd = PB + ((k + 1) & 1) * 4096 + tid * 8; *(LAS f32x4*)pd = na; *(LAS f32x4*)(pd + 4) = nc; }
            __syncthreads();
        }
    }
}

__device__ __forceinline__ void ph_post(const Params& P, int l) {
    const bf16_t* Yo = (const bf16_t*)(P.ws + OFF_Y); const bf16_t* Po = (const bf16_t*)(P.ws + OFF_P); const bf16_t* Go = (const bf16_t*)(P.ws + OFF_G);
    const bf16_t* VBo = (const bf16_t*)(P.ws + OFF_VB); const float* SEGp = (const float*)(P.ws + OFF_SEG); bf16_t* OR = (bf16_t*)(P.ws + OFF_ORWKV);
    const int tid = opaque_tid(), wid = __builtin_amdgcn_readfirstlane(tid >> 6), lane = tid & 63, m = lane & 31, hh = lane >> 5;
    for (int blk = blockIdx.x; blk < NB_ * NSEG; blk += gridDim.x) {
        const int b = blk / NSEG, seg = blk % NSEG, tbeg = seg * SEGL;
        bf16x8 SIf[2][4];
        if (seg > 0) {
            const float* sg = SEGp + ((size_t)((b * 8 + wid) * NSEG + seg - 1)) * 8192 + 4096;
#pragma unroll
            for (int ib = 0; ib < 2; ++ib)
#pragma unroll
                for (int ks = 0; ks < 4; ++ks) { const float* sp = sg + (32 * ib + m) * 64 + 16 * ks + 8 * hh; const f32x4 a = *(const f32x4*)sp, c = *(const f32x4*)(sp + 4);
                    u32x4 w; w.x = cvt_pk_bf16(a[0], a[1]); w.y = cvt_pk_bf16(a[2], a[3]); w.z = cvt_pk_bf16(c[0], c[1]); w.w = cvt_pk_bf16(c[2], c[3]); SIf[ib][ks] = __builtin_bit_cast(bf16x8, w); }
        }
        float lnw[32], lnb[32];
#pragma unroll
        for (int q = 0; q < 32; ++q) { const int ch = 64 * wid + 32 * (q >> 4) + (q & 3) + 8 * ((q & 15) >> 2) + 4 * hh; lnw[q] = P.ln_w[l * 512 + ch]; lnb[q] = P.ln_b[l * 512 + ch]; }
#pragma unroll 1
        for (int c = 0; c < SEGL / 32; ++c) {
            const size_t row = (size_t)b * S_ + tbeg + 32 * c + m;
            f32x16 D[2];
#pragma unroll
            for (int r = 0; r < 16; ++r) { D[0][r] = 0.f; D[1][r] = 0.f; }
            if (seg > 0) {
                const bf16_t* pp = Po + row * 512 + 64 * wid + 8 * hh;
#pragma unroll
                for (int ks = 0; ks < 4; ++ks) { const bf16x8 Pf = *(const bf16x8*)(pp + 16 * ks);
                    D[0] = __builtin_amdgcn_mfma_f32_32x32x16_bf16(SIf[0][ks], Pf, D[0], 0, 0, 0); D[1] = __builtin_amdgcn_mfma_f32_32x32x16_bf16(SIf[1][ks], Pf, D[1], 0, 0, 0); }
            }
            float y[32]; float s = 0.f;
#pragma unroll
            for (int ib = 0; ib < 2; ++ib)
#pragma unroll
                for (int g = 0; g < 4; ++g) { const u32x2 yw = *(const u32x2*)(Yo + row * 512 + 64 * wid + 32 * ib + 8 * g + 4 * hh);
                    y[16 * ib + 4 * g + 0] = bflo(yw.x) + D[ib][4 * g + 0]; y[16 * ib + 4 * g + 1] = bfhi(yw.x) + D[ib][4 * g + 1];
                    y[16 * ib + 4 * g + 2] = bflo(yw.y) + D[ib][4 * g + 2]; y[16 * ib + 4 * g + 3] = bfhi(yw.y) + D[ib][4 * g + 3]; }
#pragma unroll
            for (int q = 0; q < 32; ++q) s += y[q];
            s += shx(s, 32, lane);
            const float mean = s * (1.0f / 64.0f); float qv = 0.f;
#pragma unroll
            for (int q = 0; q < 32; ++q) { y[q] -= mean; qv += y[q] * y[q]; }
            qv += shx(qv, 32, lane);
            const float rstd = rsqrtf(qv * (1.0f / 64.0f) + 64e-5f);
#pragma unroll
            for (int ib = 0; ib < 2; ++ib)
#pragma unroll
                for (int g = 0; g < 4; ++g) { const size_t off = row * 512 + 64 * wid + 32 * ib + 8 * g + 4 * hh;
                    const u32x2 vw = *(const u32x2*)(VBo + off), gw = *(const u32x2*)(Go + off); const int q = 16 * ib + 4 * g;
                    const float o0 = (y[q] * rstd * lnw[q] + lnb[q] + bflo(vw.x)) * bflo(gw.x), o1 = (y[q + 1] * rstd * lnw[q + 1] + lnb[q + 1] + bfhi(vw.x)) * bfhi(gw.x);
                    const float o2 = (y[q + 2] * rstd * lnw[q + 2] + lnb[q + 2] + bflo(vw.y)) * bflo(gw.y), o3 = (y[q + 3] * rstd * lnw[q + 3] + lnb[q + 3] + bfhi(vw.y)) * bfhi(gw.y);
                    u32x2 w; w.x = cvt_pk_bf16(o0, o1); w.y = cvt_pk_bf16(o2, o3); *(u32x2*)(OR + off) = w; }
        }
    }
}

enum { PH_PRO = 0, PH_NORM1, PH_ZQ, PH_IDX, PH_ATT, PH_ZR, PH_SCAN, PH_COMB, PH_POST, PH_ZC, PH_CONV, PH_MERGE, PH_WO, PH_NORM2, PH_UP, PH_U, PH_DOWN, PH_FINAL, PH_COUNT };

template <int PH>
__device__ __forceinline__ void run_phase(const Params& P0, int l, LAS unsigned char* lds) {
    Params P = P0; P.ws = opaque_ptr(P0.ws);
    if constexpr (PH == PH_PRO) { if (l == 0) ph_mod(P, lds); ph_wconv(P, l, lds); }
    if constexpr (PH == PH_NORM1) ph_norm(P, l, 0);
    if constexpr (PH == PH_ZQ) ph_gemm_zq(P, lds);
    if constexpr (PH == PH_IDX) ph_idx(P, lds);
    if constexpr (PH == PH_ATT) ph_att(P, lds);
    if constexpr (PH == PH_ZR) ph_gemm_zr(P, lds);
    if constexpr (PH == PH_SCAN) ph_scan(P, l, lds);
    if constexpr (PH == PH_COMB) ph_comb(P, lds);
    if constexpr (PH == PH_POST) ph_post(P, l);
    if constexpr (PH == PH_ZC) ph_gemm_zc(P, lds);
    if constexpr (PH == PH_CONV) ph_conv(P, l, lds);
    if constexpr (PH == PH_MERGE) ph_gemm_merge(P, lds);
    if constexpr (PH == PH_WO) ph_gemm_wo(P, l, lds);
    if constexpr (PH == PH_NORM2) ph_norm(P, l, 1);
    if constexpr (PH == PH_UP) ph_gemm_up(P, l, lds);
    if constexpr (PH == PH_U) ph_ufix(P, l, lds);
    if constexpr (PH == PH_DOWN) ph_gemm_down(P, l, lds);
    if constexpr (PH == PH_FINAL) ph_final(P);
}

#if MK_SINGLE
__global__ void __launch_bounds__(NTHR, 2) k_mega(Params P) {
    extern __shared__ __attribute__((aligned(16))) unsigned char shm[];
    LAS unsigned char* lds = (LAS unsigned char*)shm;
    LAS unsigned* xbw = (LAS unsigned*)(lds + LDS_BYTES - 16);
    if (threadIdx.x == 0) { xbw[0] = 0u; xbw[1] = 0u; xbw[2] = 0u; xbw[3] = 0u; }
    __syncthreads();
    XcdBarrier bar = xcd_barrier_post((unsigned*)(P.ws + OFF_BAR), (volatile LAS unsigned*)xbw);
#ifndef PROBE_PH
#define PROBE_PH (-1)
#endif
#ifndef PROBE_N
#define PROBE_N 4
#endif
#define PHASE(PH, l) do { unsigned long long t0_ = 0; if (PROBE_PH == PH && blockIdx.x == 0) t0_ = wall_clock64(); \
        run_phase<PH>(P, l, lds); xcd_barrier(bar); \
        if (PROBE_PH == PH && blockIdx.x == 0) { const unsigned long long t1_ = wall_clock64(), d_ = (t1_ - t0_) * PROBE_N; while (wall_clock64() - t1_ < d_) __builtin_amdgcn_s_sleep(8); } } while (0)
#pragma unroll 1
    for (int l = 0; l < 2; ++l) {
        PHASE(PH_PRO, l); PHASE(PH_NORM1, l); PHASE(PH_ZQ, l); PHASE(PH_IDX, l); PHASE(PH_ATT, l); PHASE(PH_ZR, l); PHASE(PH_SCAN, l); PHASE(PH_COMB, l); PHASE(PH_POST, l);
        PHASE(PH_ZC, l); PHASE(PH_CONV, l); PHASE(PH_MERGE, l); PHASE(PH_WO, l); PHASE(PH_NORM2, l); PHASE(PH_UP, l); PHASE(PH_U, l); PHASE(PH_DOWN, l);
    }
    run_phase<PH_FINAL>(P, 0, lds);
#undef PHASE
}
#else
template <int PH>
__global__ void __launch_bounds__(NTHR, 2) k_phase(Params P, int l) {
    extern __shared__ __attribute__((aligned(16))) unsigned char shm[];
    run_phase<PH>(P, l, (LAS unsigned char*)shm);
}
template <int PH> static void launch_phase(const Params& P, int l, hipStream_t stream) {
    static bool attr = false;
    if (!attr) { hipFuncSetAttribute((const void*)k_phase<PH>, hipFuncAttributeMaxDynamicSharedMemorySize, LDS_BYTES); attr = true; }
    hipLaunchKernelGGL(k_phase<PH>, dim3(NBLK), dim3(NTHR), LDS_BYTES, stream, P, l);
}
#endif

extern "C" void kernel_launch(void* const* d_in, const int* in_sizes, int n_in, void* d_out, int out_size, void* d_ws, size_t ws_size, hipStream_t stream) {
    (void)in_sizes; (void)n_in; (void)out_size; (void)ws_size;
    Params P{};
    P.x_in = (const float*)d_in[0]; P.c = (const float*)d_in[1]; P.pos = (const int*)d_in[2]; P.rel_bias = (const float*)d_in[3]; P.final_norm = (const float*)d_in[4];
    P.ada_w = (const float*)d_in[5]; P.ada_b = (const float*)d_in[6]; P.norm_mix = (const float*)d_in[7]; P.w_in = (const float*)d_in[8];
    P.mu = (const float*)d_in[9]; P.w0 = (const float*)d_in[10]; P.w_up = (const float*)d_in[11]; P.a0 = (const float*)d_in[12]; P.a_up = (const float*)d_in[13]; P.g_up = (const float*)d_in[14];
    P.k_k = (const float*)d_in[15]; P.k_a = (const float*)d_in[16]; P.r_k = (const float*)d_in[17]; P.ln_w = (const float*)d_in[18]; P.ln_b = (const float*)d_in[19];
    P.sc_conv_w = (const float*)d_in[20]; P.w_branch = (const float*)d_in[21]; P.w_o = (const float*)d_in[22]; P.norm_ffn = (const float*)d_in[23];
    P.ffn_w_up = (const float*)d_in[24]; P.ffn_conv_w = (const float*)d_in[25]; P.ffn_w_down = (const float*)d_in[26];
    P.out = (float*)d_out; P.ws = (unsigned char*)d_ws;
#if MK_SINGLE
    static bool attr = false;
    if (!attr) { hipFuncSetAttribute((const void*)k_mega, hipFuncAttributeMaxDynamicSharedMemorySize, LDS_BYTES); attr = true; }
    hipMemsetAsync((unsigned char*)d_ws + OFF_BAR, 0, XCD_BAR_WORDS * sizeof(unsigned), stream);
    hipLaunchKernelGGL(k_mega, dim3(NBLK), dim3(NTHR), LDS_BYTES, stream, P);
#else
    for (int l = 0; l < 2; ++l) {
        launch_phase<PH_PRO>(P, l, stream); launch_phase<PH_NORM1>(P, l, stream); launch_phase<PH_ZQ>(P, l, stream); launch_phase<PH_IDX>(P, l, stream);
        launch_phase<PH_ATT>(P, l, stream); launch_phase<PH_ZR>(P, l, stream); launch_phase<PH_SCAN>(P, l, stream); launch_phase<PH_COMB>(P, l, stream);
        launch_phase<PH_POST>(P, l, stream); launch_phase<PH_ZC>(P, l, stream); launch_phase<PH_CONV>(P, l, stream); launch_phase<PH_MERGE>(P, l, stream);
        launch_phase<PH_WO>(P, l, stream); launch_phase<PH_NORM2>(P, l, stream); launch_phase<PH_UP>(P, l, stream); launch_phase<PH_U>(P, l, stream);
        launch_phase<PH_DOWN>(P, l, stream);
    }
    launch_phase<PH_FINAL>(P, 0, stream);
#endif
}
```

```cpp
#include <hip/hip_runtime.h>
#include <stdint.h>

#ifndef MK_SINGLE
#define MK_SINGLE 1
#endif

#define LAS __attribute__((address_space(3)))
typedef unsigned short bf16_t;
typedef short bf16x8 __attribute__((ext_vector_type(8)));
typedef short bf16x4 __attribute__((ext_vector_type(4)));
typedef float f32x4 __attribute__((ext_vector_type(4)));
typedef float f32x16 __attribute__((ext_vector_type(16)));
typedef float f32x2 __attribute__((ext_vector_type(2)));
typedef unsigned u32x4 __attribute__((ext_vector_type(4)));
typedef unsigned u32x2 __attribute__((ext_vector_type(2)));
typedef int i32x4 __attribute__((ext_vector_type(4)));
typedef unsigned long long u64;

constexpr int T_ = 32768, D_ = 1024, NB_ = 8, S_ = 4096;
constexpr int NSEG = 32, SEGL = 128, TB = 8;
constexpr int NBLK = 256, NTHR = 512;
constexpr int IN_COLS = 8520, DFF = 2816;
constexpr int LDS_BYTES = 150 * 1024;

constexpr size_t MiB = 1ull << 20;
constexpr size_t OFF_BAR = 0;
constexpr size_t OFF_MOD = 64 * 1024;
constexpr size_t OFF_TAB = 512 * 1024;
constexpr size_t OFF_KPM = 520 * 1024;
constexpr size_t OFF_WB = 2 * MiB;
constexpr size_t WB_WIN = 0;
constexpr size_t WB_WBR = WB_WIN + (size_t)8704 * 1024 * 2;
constexpr size_t WB_WO = WB_WBR + (size_t)3 * 1024 * 512 * 2;
constexpr size_t WB_WUP = WB_WO + (size_t)1024 * 1024 * 2;
constexpr size_t WB_WDN = WB_WUP + (size_t)5632 * 1024 * 2;
constexpr size_t WB_LW = WB_WDN + (size_t)1024 * 2816 * 2;
constexpr size_t WB_LA = WB_LW + (size_t)512 * 64 * 2;
constexpr size_t WB_LG = WB_LA + (size_t)512 * 64 * 2;
constexpr size_t OFF_H = 42 * MiB;
constexpr size_t OFF_ZQ = 106 * MiB;
constexpr size_t OFF_MASK = 250 * MiB;
constexpr size_t OFF_VT = 266 * MiB;
constexpr size_t OFF_ZR = 106 * MiB;
constexpr size_t OFF_Y = 218 * MiB;
constexpr size_t OFF_P = 250 * MiB;
constexpr size_t OFF_G = 282 * MiB;
constexpr size_t OFF_SEG = 314 * MiB;
constexpr size_t OFF_ZCV = 106 * MiB;
constexpr size_t OFF_ZG = 202 * MiB;
constexpr size_t OFF_MRG = 106 * MiB;
constexpr size_t OFF_UP = 106 * MiB;
constexpr size_t OFF_HA = 300 * MiB;
constexpr size_t OFF_HB = 320 * MiB;
constexpr size_t OFF_OCONV = 416 * MiB;
constexpr size_t OFF_ORWKV = 448 * MiB;
constexpr size_t OFF_OATT = 480 * MiB;
constexpr size_t OFF_VB = OFF_ORWKV;
constexpr size_t OFF_SCR = 378 * MiB;

struct Params {
    const float* x_in; const float* c; const int* pos; const float* rel_bias; const float* final_norm;
    const float* ada_w; const float* ada_b; const float* norm_mix; const float* w_in;
    const float* mu; const float* w0; const float* w_up; const float* a0; const float* a_up; const float* g_up;
    const float* k_k; const float* k_a; const float* r_k; const float* ln_w; const float* ln_b;
    const float* sc_conv_w; const float* w_branch; const float* w_o; const float* norm_ffn;
    const float* ffn_w_up; const float* ffn_conv_w; const float* ffn_w_down;
    float* out; unsigned char* ws;
};

__device__ __forceinline__ float bf2f(bf16_t b) { return __uint_as_float(((unsigned)b) << 16); }
__device__ __forceinline__ bf16_t f2bf(float f) { unsigned u = __float_as_uint(f); u += 0x7FFFu + ((u >> 16) & 1u); return (bf16_t)(u >> 16); }
typedef __bf16 bf16x2_t __attribute__((ext_vector_type(2)));
__device__ __forceinline__ unsigned cvt_pk_bf16(float lo, float hi) { const f32x2 v = {lo, hi}; return __builtin_bit_cast(unsigned, __builtin_convertvector(v, bf16x2_t)); }
__device__ __forceinline__ float bflo(unsigned w) { return __uint_as_float(w << 16); }
__device__ __forceinline__ float bfhi(unsigned w) { return __uint_as_float(w & 0xffff0000u); }
__device__ __forceinline__ float shx(float v, int mask, int lane) { return __int_as_float(__builtin_amdgcn_ds_bpermute((lane ^ mask) << 2, __float_as_int(v))); }
__device__ __forceinline__ int shxi(int v, int mask, int lane) { return __builtin_amdgcn_ds_bpermute((lane ^ mask) << 2, v); }
__device__ __forceinline__ float wave_sum(float v, int lane) {
#pragma unroll
    for (int o = 32; o >= 1; o >>= 1) v += shx(v, o, lane);
    return v;
}
__device__ __forceinline__ void writelane_c2(int& vlo, int& vhi, int lo, int hi, int ln  ) {
    asm("s_nop 3\n\tv_writelane_b32 %0, %2, %4\n\tv_writelane_b32 %1, %3, %4" : "+v"(vlo), "+v"(vhi) : "s"(lo), "s"(hi), "n"(ln)); }
__device__ __forceinline__ int writelane_v(int vec, int val, int ln  ) { asm("s_mov_b32 m0, %2\n\ts_nop 3\n\tv_writelane_b32 %0, %1, m0" : "+v"(vec) : "s"(val), "s"(ln) : "m0"); return vec; }
__device__ __forceinline__ float sigmoidf_(float x) { return __builtin_amdgcn_rcpf(1.0f + __expf(-x)); }
__device__ __forceinline__ unsigned f2ord(float x) { unsigned u = __float_as_uint(x); return (u & 0x80000000u) ? ~u : (u | 0x80000000u); }
__device__ __forceinline__ float ord2f(unsigned k) { return __uint_as_float((k & 0x80000000u) ? (k & 0x7fffffffu) : ~k); }

__device__ __forceinline__ int opaque_tid() { int t = threadIdx.x; asm volatile("" : "+v"(t)); return t; }
__device__ __forceinline__ unsigned char* opaque_ptr(unsigned char* p) {
    typedef __attribute__((address_space(1))) unsigned char* gptr_t;
    gptr_t g = (gptr_t)p; asm volatile("" : "+s"(g)); return (unsigned char*)g; }

#define XB_TMO      128
#define XB_XCNT(j)  (256  + 64 * (j))
#define XB_XSUB(j)  (1280 + 64 * (j))
#define XB_XGEN(j)  (2304 + 64 * (j))
#define XB_TOP      3328
#define XB_TOPGEN   3392
#define XCD_BAR_WORDS 3456
#define XB_SPIN_CAP (1u << 22)

__device__ __forceinline__ unsigned xb_ld(unsigned* p)              { return __hip_atomic_load(p, __ATOMIC_RELAXED, __HIP_MEMORY_SCOPE_AGENT); }
__device__ __forceinline__ unsigned xb_add(unsigned* p, unsigned v) { return __hip_atomic_fetch_add(p, v, __ATOMIC_RELAXED, __HIP_MEMORY_SCOPE_AGENT); }
__device__ __forceinline__ unsigned xb_xcc_id() { return (unsigned)__builtin_amdgcn_s_getreg((3 << 11) | 20) & 0xFu; }
#define XB_SPIN(cond, bar) do { unsigned _sp = 0; while (cond) { __builtin_amdgcn_s_sleep(1); \
    if ((++_sp & 255u) == 0u) { if (xb_ld(&(bar)[XB_TMO])) break; if (_sp > XB_SPIN_CAP) { atomicAdd(&(bar)[XB_TMO], 1u); break; } } } } while (0)

struct XcdBarrier { unsigned* bar; unsigned x; volatile LAS unsigned* st; };

__device__ __forceinline__ XcdBarrier xcd_barrier_post(unsigned* bar, volatile LAS unsigned* st) {
    XcdBarrier b; b.bar = bar; b.x = xb_xcc_id(); b.st = st;
    if (threadIdx.x == 0) (void)xb_add(&bar[XB_XCNT(b.x)], 1u);
    return b;
}
__device__ __forceinline__ void xcd_barrier_complete(unsigned* bar, unsigned x, unsigned& nloc, unsigned& nx) {
    const unsigned G = gridDim.x * gridDim.y * gridDim.z;
    unsigned sum, cnt, mine, sp = 0u;
    for (;;) {
        sum = 0u; cnt = 0u; mine = 0u;
#pragma unroll
        for (unsigned j = 0; j < 16; ++j) { const unsigned c = xb_ld(&bar[XB_XCNT(j)]); sum += c; cnt += (c > 0u) ? 1u : 0u; mine = (j == x) ? c : mine; }
        if (sum == G) break;
        __builtin_amdgcn_s_sleep(1);
        if ((++sp & 255u) == 0u) { if (xb_ld(&bar[XB_TMO])) break; if (sp > XB_SPIN_CAP) { atomicAdd(&bar[XB_TMO], 1u); break; } }
    }
    nloc = mine > 0u ? mine : 1u; nx = cnt > 0u ? cnt : 1u;
}
__device__ __forceinline__ void xcd_barrier(const XcdBarrier& b) {
    asm volatile("s_waitcnt vmcnt(0)" ::: "memory");
    __syncthreads();
    if (threadIdx.x == 0) {
        unsigned* bar = b.bar;
        __builtin_amdgcn_s_waitcnt(0);
        unsigned nloc = b.st[0], nx = b.st[1];
        if (nloc == 0u) { xcd_barrier_complete(bar, b.x, nloc, nx); b.st[0] = nloc; b.st[1] = nx; }
        const unsigned old = xb_add(&bar[XB_XSUB(b.x)], 1u);
        const unsigned gen = old / nloc;
        if (old + 1u == (gen + 1u) * nloc) {
            __builtin_amdgcn_fence(__ATOMIC_RELEASE, "agent");
            asm volatile("s_waitcnt vmcnt(0)" ::: "memory");
            const unsigned og = xb_add(&bar[XB_TOP], 1u);
            const unsigned tg = og / nx;
            if (og + 1u == (tg + 1u) * nx) xb_add(&bar[XB_TOPGEN], 1u);
            else XB_SPIN(xb_ld(&bar[XB_TOPGEN]) == tg, bar);
            __builtin_amdgcn_fence(__ATOMIC_ACQUIRE, "agent");
            xb_add(&bar[XB_XGEN(b.x)], 1u);
            asm volatile("s_waitcnt vmcnt(0)" ::: "memory");
        } else {
            XB_SPIN(xb_ld(&bar[XB_XGEN(b.x)]) == gen, bar);
            __builtin_amdgcn_fence(__ATOMIC_ACQUIRE, "agent");
            asm volatile("s_waitcnt vmcnt(0)" ::: "memory");
        }
    }
    __syncthreads();
}

namespace g8 {
constexpr int BM = 256, BK = 64, HALF = 128, HTB = HALF * BK * 2, STAGE_BYTES = 8 * HTB, NXCD = 8, WGM = 8;
__device__ __forceinline__ int lds_byte(int r, int c) { const int st = (r >> 4) * 2 + (c >> 5), rr = r & 15, cc = c & 31, ob = rr * 64 + cc * 2; return st * 1024 + (ob ^ (((ob >> 9) & 1) << 5)); }
__device__ __forceinline__ void stage_rc(int b, int& R, int& C) { const int st = b / 1024, sb = b % 1024, swz = sb ^ (((sb >> 9) & 1) << 5); R = (st >> 1) * 16 + swz / 64; C = (st & 1) * 32 + (swz % 64) / 2; }
__device__ __forceinline__ int perm32(int rho) { const int n = rho >> 4, i = rho & 15; return 8 * (i >> 2) + 4 * n + (i & 3); }

struct Unit { const char* A; const char* B; int pm, pn, tag; };

struct SOrder {
    int nM, nN, nwg, G, c; const char* A; const char* Bt; size_t a_t, b_t;
    __device__ void init(int M, int N, int lda, int ldb, const void* A_, const void* Bt_) {
        nM = M / BM; nN = N / BM; nwg = nM * nN; G = (int)gridDim.x; c = (int)blockIdx.x; A = (const char*)A_; Bt = (const char*)Bt_;
        a_t = (size_t)BM * lda * 2; b_t = (size_t)BM * ldb * 2; }
    __device__ bool next(int i, Unit& u) const {
        const long L = (long)i * G + c; if (L >= nwg) return false;
        int wgid = (int)L; { const int q = nwg / NXCD, r = nwg % NXCD, xcd = wgid % NXCD, off = wgid / NXCD; wgid = (xcd < r ? xcd * (q + 1) : r * (q + 1) + (xcd - r) * q) + off; }
        const int nig = WGM * nN, gid = wgid / nig, fm = gid * WGM, gsz = (nM - fm) < WGM ? (nM - fm) : WGM;
        u.pm = fm + ((wgid % nig) % gsz); u.pn = (wgid % nig) / gsz; u.tag = 0;
        u.A = A + (size_t)u.pm * a_t; u.B = Bt + (size_t)u.pn * b_t; return true;
    }
};

template <class Epi, class Sched>
__device__ __forceinline__ void gemm_phase(LAS unsigned char* lds, const int K, const int lda, const int ldb, const Sched& S, const Epi& E) {
    const int tid = opaque_tid(), wid = __builtin_amdgcn_readfirstlane(tid >> 6), lane = tid & 63, wr = wid >> 2, wc = wid & 3, fr = lane & 15, fq = lane >> 4;
    const int nt = K / BK;
    unsigned voffA[2], voffB[2];
#pragma unroll
    for (int i = 0; i < 2; ++i) { int R, C; stage_rc(tid * 16 + i * 8192, R, C); const int Rb = Epi::PERM ? ((R & ~31) + perm32(R & 31)) : R;
        voffA[i] = (unsigned)(R * lda + C) * 2u; voffB[i] = (unsigned)(Rb * ldb + C) * 2u; }
    const size_t kstep = (size_t)(BK * 2);
    const size_t hstepA = (size_t)HALF * lda * 2, hstepB = (size_t)HALF * ldb * 2;
    const unsigned ldsw = (unsigned)wid * 1024u;
    const int aoff = lds_byte(wr * 64 + fr, fq * 8), boff = lds_byte(wc * 32 + fr, fq * 8);
#define PG8_SA(b, h) (((b) * 2 + (h)) * HTB)
#define PG8_SB(b, h) ((4 + (b) * 2 + (h)) * HTB)
#define PG8_STAGE(bufoff, gbase, voff) do { _Pragma("unroll") for (int _i = 0; _i < 2; ++_i) \
        __builtin_amdgcn_global_load_lds((const unsigned*)((const char*)(gbase) + (voff)[_i]), (LAS unsigned*)(lds + (bufoff) + ldsw + _i * 8192), 16, 0, 0); } while (0)
#define PG8_LDA(dst, b, h) do { _Pragma("unroll") for (int m = 0; m < 4; ++m) _Pragma("unroll") for (int k = 0; k < 2; ++k) dst[m][k] = *(const LAS bf16x8*)(lds + PG8_SA(b, h) + aoff + m * 2048 + k * 1024); } while (0)
#define PG8_LDB(dst, b, h) do { _Pragma("unroll") for (int n = 0; n < 2; ++n) _Pragma("unroll") for (int k = 0; k < 2; ++k) dst[n][k] = *(const LAS bf16x8*)(lds + PG8_SB(b, h) + boff + n * 2048 + k * 1024); } while (0)
#define PG8_MMA(ai, bj, At, Bt) do { __builtin_amdgcn_s_setprio(1); _Pragma("unroll") for (int m = 0; m < 4; ++m) _Pragma("unroll") for (int n = 0; n < 2; ++n) _Pragma("unroll") for (int k = 0; k < 2; ++k) \
        acc[ai][bj][m][n] = __builtin_amdgcn_mfma_f32_16x16x32_bf16(Bt[n][k], At[m][k], acc[ai][bj][m][n], 0, 0, 0); __builtin_amdgcn_s_setprio(0); } while (0)
#define PG8_WAIT_V(n) asm volatile("s_waitcnt vmcnt(" #n ")" ::: "memory")
#define PG8_WAIT_L(n) asm volatile("s_waitcnt lgkmcnt(" #n ")" ::: "memory")
#define PG8_BAR __builtin_amdgcn_s_barrier()
#define PG8_SCHED __builtin_amdgcn_sched_barrier(0)
    Unit cur, nxt; int ui = 0;
    if (!S.next(0, cur)) return;
    f32x4 acc[2][2][4][2];
#pragma unroll
    for (int a = 0; a < 2; ++a)
#pragma unroll
        for (int b = 0; b < 2; ++b)
#pragma unroll
            for (int m = 0; m < 4; ++m)
#pragma unroll
                for (int n = 0; n < 2; ++n) acc[a][b][m][n] = (f32x4){0.f, 0.f, 0.f, 0.f};
    bf16x8 At[4][2], B0[2][2], B1[2][2];
    const char* cA = cur.A; const char* cB = cur.B;
    PG8_STAGE(PG8_SB(0, 0), cB, voffB); PG8_STAGE(PG8_SA(0, 0), cA, voffA); PG8_STAGE(PG8_SB(0, 1), cB + hstepB, voffB); PG8_STAGE(PG8_SA(0, 1), cA + hstepA, voffA);
    if (wr == 1) PG8_BAR;
    PG8_WAIT_V(4); PG8_BAR;
    PG8_STAGE(PG8_SB(1, 0), cB + kstep, voffB); PG8_STAGE(PG8_SA(1, 0), cA + kstep, voffA); PG8_STAGE(PG8_SB(1, 1), cB + hstepB + kstep, voffB);
    PG8_WAIT_V(6); PG8_BAR;
    for (;;) {
        const bool has_next = S.next(ui + 1, nxt);
        const char* nA = has_next ? nxt.A : cA; const char* nB = has_next ? nxt.B : cB;
        for (int t = 0; t < nt; t += 2) {
            const bool last = (t == nt - 2);
            const char* a1 = cA + (size_t)(t + 1) * kstep;
            const char* a2 = last ? nA : cA + (size_t)(t + 2) * kstep; const char* b2 = last ? nB : cB + (size_t)(t + 2) * kstep;
            const char* a3 = a2 + kstep; const char* b3 = b2 + kstep;
            PG8_LDB(B0, 0, 0); PG8_SCHED; PG8_LDA(At, 0, 0); PG8_STAGE(PG8_SA(1, 1), a1 + hstepA, voffA);
            PG8_WAIT_L(8); PG8_BAR; PG8_WAIT_L(0); PG8_MMA(0, 0, At, B0); PG8_BAR; PG8_SCHED;
            PG8_LDB(B1, 0, 1); PG8_STAGE(PG8_SB(0, 0), b2, voffB);
            PG8_BAR; PG8_WAIT_L(0); PG8_MMA(0, 1, At, B1); PG8_BAR;
            PG8_LDA(At, 0, 1); PG8_STAGE(PG8_SA(0, 0), a2, voffA);
            PG8_BAR; PG8_WAIT_L(0); PG8_MMA(1, 0, At, B0); PG8_BAR; PG8_SCHED;
            PG8_STAGE(PG8_SB(0, 1), b2 + hstepB, voffB);
            PG8_WAIT_V(6); PG8_BAR; PG8_MMA(1, 1, At, B1); PG8_BAR;
            PG8_LDB(B0, 1, 0); PG8_SCHED; PG8_LDA(At, 1, 0); PG8_STAGE(PG8_SA(0, 1), a2 + hstepA, voffA);
            PG8_WAIT_L(8); PG8_BAR; PG8_WAIT_L(0); PG8_MMA(0, 0, At, B0); PG8_BAR; PG8_SCHED;
            PG8_LDB(B1, 1, 1); PG8_STAGE(PG8_SB(1, 0), b3, voffB);
            PG8_BAR; PG8_WAIT_L(0); PG8_MMA(0, 1, At, B1); PG8_BAR;
            PG8_LDA(At, 1, 1); PG8_STAGE(PG8_SA(1, 0), a3, voffA);
            PG8_BAR; PG8_WAIT_L(0); PG8_MMA(1, 0, At, B0); PG8_BAR; PG8_SCHED;
            PG8_STAGE(PG8_SB(1, 1), b3 + hstepB, voffB);
            PG8_WAIT_V(6); PG8_BAR; PG8_MMA(1, 1, At, B1); PG8_BAR;
        }
        bool keep = false;
        if constexpr (Epi::CHAIN) keep = E.chain(acc, cur, wr, wc, fr, fq); else E(acc, cur, wr, wc, fr, fq);
        if (!has_next) break;
        if (!keep) {
#pragma unroll
            for (int a = 0; a < 2; ++a)
#pragma unroll
                for (int b = 0; b < 2; ++b)
#pragma unroll
                    for (int m = 0; m < 4; ++m)
#pragma unroll
                        for (int n = 0; n < 2; ++n) acc[a][b][m][n] = (f32x4){0.f, 0.f, 0.f, 0.f};
        }
        cur = nxt; cA = nA; cB = nB; ++ui;
    }
    PG8_WAIT_V(0);
    if (wr == 0) PG8_BAR;
    PG8_BAR;
#undef PG8_SA
#undef PG8_SB
#undef PG8_STAGE
#undef PG8_LDA
#undef PG8_LDB
#undef PG8_MMA
#undef PG8_WAIT_V
#undef PG8_WAIT_L
#undef PG8_BAR
#undef PG8_SCHED
}

struct EpiBf {
    static constexpr bool PERM = true, CHAIN = false;
    bf16_t* O0; int ld0; int split; bf16_t* O1; int ld1; int act1;
    __device__ __forceinline__ void operator()(const f32x4 (&acc)[2][2][4][2], const Unit& u, int wr, int wc, int fr, int fq) const {
        const bool second = u.pn >= split;
        bf16_t* base = second ? O1 : O0; const int ld = second ? ld1 : ld0; const int colt = (second ? (u.pn - split) : u.pn) * BM;
        const bool act = second && act1;
        const int row0 = u.pm * BM + wr * 64 + fr, col0 = colt + wc * 32 + 8 * fq;
#pragma unroll
        for (int ai = 0; ai < 2; ++ai)
#pragma unroll
            for (int m = 0; m < 4; ++m) { bf16_t* rowp = base + (size_t)(row0 + ai * HALF + m * 16) * ld + col0;
#pragma unroll
                for (int bj = 0; bj < 2; ++bj) { f32x4 v0 = acc[ai][bj][m][0], v1 = acc[ai][bj][m][1];
                    if (act) {
#pragma unroll
                        for (int j = 0; j < 4; ++j) { v0[j] = sigmoidf_(v0[j]); v1[j] = sigmoidf_(v1[j]); } }
                    u32x4 w; w.x = cvt_pk_bf16(v0[0], v0[1]); w.y = cvt_pk_bf16(v0[2], v0[3]); w.z = cvt_pk_bf16(v1[0], v1[1]); w.w = cvt_pk_bf16(v1[2], v1[3]);
                    *(u32x4*)(rowp + bj * HALF) = w; } }
    }
};
struct EpiMerge {
    static constexpr bool PERM = true, CHAIN = true;
    bf16_t* M; const bf16_t* ZG;
    __device__ __forceinline__ bool chain(f32x4 (&acc)[2][2][4][2], const Unit& u, int wr, int wc, int fr, int fq) const {
        const int row0 = u.pm * BM + wr * 64 + fr, col0 = u.pn * BM + wc * 32 + 8 * fq;
#pragma unroll
        for (int ai = 0; ai < 2; ++ai)
#pragma unroll
            for (int m = 0; m < 4; ++m) { const size_t r = (size_t)(row0 + ai * HALF + m * 16);
#pragma unroll
                for (int bj = 0; bj < 2; ++bj) {
                    const bf16_t* gp = ZG + r * 3072 + col0 + bj * HALF;
                    float f[8];
                    if (u.tag == 2) { const u32x4 g = *(const u32x4*)(gp + 2048);
                        f[0] = bflo(g.x); f[1] = bfhi(g.x); f[2] = bflo(g.y); f[3] = bfhi(g.y); f[4] = bflo(g.z); f[5] = bfhi(g.z); f[6] = bflo(g.w); f[7] = bfhi(g.w);
#pragma unroll
                        for (int e = 0; e < 8; ++e) f[e] = fmaxf(f[e], 1e-12f);
                    } else { const u32x4 gn = *(const u32x4*)(gp + u.tag * 1024), gd = *(const u32x4*)(gp + (u.tag + 1) * 1024);
                        const float nn[8] = {bflo(gn.x), bfhi(gn.x), bflo(gn.y), bfhi(gn.y), bflo(gn.z), bfhi(gn.z), bflo(gn.w), bfhi(gn.w)};
                        const float dd[8] = {bflo(gd.x), bfhi(gd.x), bflo(gd.y), bfhi(gd.y), bflo(gd.z), bfhi(gd.z), bflo(gd.w), bfhi(gd.w)};
#pragma unroll
                        for (int e = 0; e < 8; ++e) f[e] = (u.tag == 0 ? nn[e] : fmaxf(nn[e], 1e-12f)) * __builtin_amdgcn_rcpf(fmaxf(dd[e], 1e-12f)); }
                    f32x4& v0 = acc[ai][bj][m][0]; f32x4& v1 = acc[ai][bj][m][1];
                    v0[0] *= f[0]; v0[1] *= f[1]; v0[2] *= f[2]; v0[3] *= f[3]; v1[0] *= f[4]; v1[1] *= f[5]; v1[2] *= f[6]; v1[3] *= f[7];
                    if (u.tag == 2) { u32x4 w; w.x = cvt_pk_bf16(v0[0], v0[1]); w.y = cvt_pk_bf16(v0[2], v0[3]); w.z = cvt_pk_bf16(v1[0], v1[1]); w.w = cvt_pk_bf16(v1[2], v1[3]);
                        *(u32x4*)(M + r * 1024 + col0 + bj * HALF) = w; }
                } }
        return u.tag != 2;
    }
};
struct EpiRes {
    static constexpr bool PERM = true, CHAIN = false;
    const float* xin32; const bf16_t* xin16; bf16_t* xout; const float* gate;
    __device__ __forceinline__ void operator()(const f32x4 (&acc)[2][2][4][2], const Unit& u, int wr, int wc, int fr, int fq) const {
        const int row0 = u.pm * BM + wr * 64 + fr, col0 = u.pn * BM + wc * 32 + 8 * fq;
        const float* gp = gate + (size_t)(u.pm >> 4) * 6144 + col0;
        f32x4 gv[2][2];
#pragma unroll
        for (int bj = 0; bj < 2; ++bj) { gv[bj][0] = *(const f32x4*)(gp + bj * HALF); gv[bj][1] = *(const f32x4*)(gp + bj * HALF + 4); }
#pragma unroll
        for (int ai = 0; ai < 2; ++ai)
#pragma unroll
            for (int m = 0; m < 4; ++m) { const size_t off = (size_t)(row0 + ai * HALF + m * 16) * 1024 + col0;
#pragma unroll
                for (int bj = 0; bj < 2; ++bj) {
                    f32x4 x0, x1;
                    if (xin32) { x0 = *(const f32x4*)(xin32 + off + bj * HALF); x1 = *(const f32x4*)(xin32 + off + bj * HALF + 4); }
                    else { const u32x4 xw = *(const u32x4*)(xin16 + off + bj * HALF);
                        x0 = (f32x4){bflo(xw.x), bfhi(xw.x), bflo(xw.y), bfhi(xw.y)}; x1 = (f32x4){bflo(xw.z), bfhi(xw.z), bflo(xw.w), bfhi(xw.w)}; }
                    const f32x4 o0 = x0 + gv[bj][0] * acc[ai][bj][m][0], o1 = x1 + gv[bj][1] * acc[ai][bj][m][1];
                    u32x4 w; w.x = cvt_pk_bf16(o0[0], o0[1]); w.y = cvt_pk_bf16(o0[2], o0[3]); w.z = cvt_pk_bf16(o1[0], o1[1]); w.w = cvt_pk_bf16(o1[2], o1[3]);
                    *(u32x4*)(xout + off + bj * HALF) = w; } }
    }
};
__device__ __forceinline__ float dpp_prev(float x, float y, int n) {
    if (n == 1) { const int yr = __builtin_amdgcn_update_dpp(0, __float_as_int(y), 0x121, 0xf, 0xf, false);
                  return __int_as_float(__builtin_amdgcn_update_dpp(yr, __float_as_int(x), 0x111, 0xf, 0xf, false)); }
    const int yr = __builtin_amdgcn_update_dpp(0, __float_as_int(y), 0x122, 0xf, 0xf, false);
    return __int_as_float(__builtin_amdgcn_update_dpp(yr, __float_as_int(x), 0x112, 0xf, 0xf, false));
}
struct EpiUp {
    static constexpr bool PERM = true, CHAIN = false;
    bf16_t* U; float* HA; float* HB; const float* cw;
    __device__ __forceinline__ void operator()(const f32x4 (&acc)[2][2][4][2], const Unit& u, int wr, int wc, int fr, int fq) const {
        const int c0 = 128 * u.pn + 32 * wc + 8 * fq;
        float w0[8], w1[8], w2[8];
        { float f[24];
#pragma unroll
          for (int q = 0; q < 6; ++q) { const f32x4 v = *(const f32x4*)(cw + (size_t)c0 * 3 + 4 * q); f[4 * q] = v[0]; f[4 * q + 1] = v[1]; f[4 * q + 2] = v[2]; f[4 * q + 3] = v[3]; }
#pragma unroll
          for (int e = 0; e < 8; ++e) { w0[e] = f[3 * e]; w1[e] = f[3 * e + 1]; w2[e] = f[3 * e + 2]; } }
#pragma unroll
        for (int ai = 0; ai < 2; ++ai) {
            const int grp = 4 * u.pm + 2 * ai + wr;
            float Y[8];
#pragma unroll
            for (int e = 0; e < 8; ++e) Y[e] = 0.f;
#pragma unroll
            for (int m = 0; m < 4; ++m) {
                const size_t row = (size_t)u.pm * BM + ai * HALF + wr * 64 + m * 16 + fr;
                float X[8], G[8], o[8];
#pragma unroll
                for (int e = 0; e < 8; ++e) { X[e] = acc[ai][0][m][e >> 2][e & 3]; G[e] = acc[ai][1][m][e >> 2][e & 3]; }
#pragma unroll
                for (int e = 0; e < 8; ++e) { const float a1 = dpp_prev(X[e], Y[e], 1), a2 = dpp_prev(X[e], Y[e], 2);
                    const float s = w0[e] * a2 + w1[e] * a1 + w2[e] * X[e]; o[e] = s * sigmoidf_(s) * G[e]; }
                if (m > 0 || fr >= 2) { u32x4 w; w.x = cvt_pk_bf16(o[0], o[1]); w.y = cvt_pk_bf16(o[2], o[3]); w.z = cvt_pk_bf16(o[4], o[5]); w.w = cvt_pk_bf16(o[6], o[7]);
                    *(u32x4*)(U + row * DFF + c0) = w; }
                if (m == 0 && fr < 2) { float* hb = HB + ((size_t)(grp * 2 + fr) * 2) * DFF + c0;
                    *(f32x4*)hb = (f32x4){X[0], X[1], X[2], X[3]}; *(f32x4*)(hb + 4) = (f32x4){X[4], X[5], X[6], X[7]};
                    *(f32x4*)(hb + DFF) = (f32x4){G[0], G[1], G[2], G[3]}; *(f32x4*)(hb + DFF + 4) = (f32x4){G[4], G[5], G[6], G[7]}; }
                if (m == 3 && fr >= 14) { float* ha = HA + (size_t)(grp * 2 + fr - 14) * DFF + c0;
                    *(f32x4*)ha = (f32x4){X[0], X[1], X[2], X[3]}; *(f32x4*)(ha + 4) = (f32x4){X[4], X[5], X[6], X[7]}; }
#pragma unroll
                for (int e = 0; e < 8; ++e) Y[e] = X[e];
            }
        }
    }
};
struct MergeOrder {
    int G, c; const char* o_att; const char* wbr;
    __device__ bool next(int i, Unit& u) const {
        const int tile = (i / 3) * G + c; if (tile >= (T_ / BM) * 4) return false;
        const int br = i % 3; u.pm = tile >> 2; u.pn = tile & 3; u.tag = br;
        u.A = o_att - (size_t)br * (32 * MiB) + (size_t)u.pm * BM * 512 * 2;
        u.B = wbr + (size_t)br * 1024 * 512 * 2 + (size_t)u.pn * BM * 512 * 2; return true;
    }
};
}

#define GSTRIDE_BLOCKS(var, n) for (int var = blockIdx.x; var < (n); var += gridDim.x)

__device__ __forceinline__ void ph_mod(const Params& P, LAS unsigned char* lds) {
    LAS float* red = (LAS float*)lds;
    float* mod = (float*)(P.ws + OFF_MOD); float* tab = (float*)(P.ws + OFF_TAB);
    const int tid = opaque_tid(), wid = tid >> 6, lane = tid & 63;
    GSTRIDE_BLOCKS(blk, 192) {
        const int l = blk / 96, jb = blk % 96, j = jb * 64 + lane;
        float acc[8];
#pragma unroll
        for (int b = 0; b < 8; ++b) acc[b] = 0.f;
        const float* aw = P.ada_w + (size_t)l * 1024 * 6144 + j;
        for (int k = wid * 128; k < wid * 128 + 128; ++k) {
            const float w = aw[(size_t)k * 6144];
#pragma unroll
            for (int b = 0; b < 8; ++b) acc[b] += P.c[b * 1024 + k] * w;
        }
#pragma unroll
        for (int b = 0; b < 8; ++b) red[(wid * 8 + b) * 64 + lane] = acc[b];
        __syncthreads();
        { const int b = wid; float s = P.ada_b[l * 6144 + j];
#pragma unroll
          for (int w = 0; w < 8; ++w) s += red[(w * 8 + b) * 64 + lane];
          mod[((size_t)l * 8 + b) * 6144 + j] = s; }
        __syncthreads();
    }
    if (blockIdx.x == gridDim.x - 1) {
        for (int i = tid; i < 1024; i += NTHR) { const int n = i >> 3, h = i & 7; int bk;
            if (n < 16) bk = n; else { const float nf = (float)n; bk = 16 + (int)(logf(nf / 16.0f) / 2.0794415416798357f * 16.0f); bk = bk < 31 ? bk : 31; }
            tab[i] = P.rel_bias[bk * 8 + h]; }
    }
}

struct WJob { const float* src; int ldsrc; int K; int N; bf16_t* dst; int win; };
template <int KT  >
__device__ __forceinline__ void conv_tiles(const WJob& J, LAS float* tile  ) {
    const int tid = opaque_tid(); const int nkt = J.K / KT, nnt = J.N / 64, ntiles = nkt * nnt;
    GSTRIDE_BLOCKS(ti, ntiles) {
        const int kt = ti % nkt, ntb = ti / nkt, k0 = kt * KT, n0 = ntb * 64;
        { const int n = tid & 63, kk0 = tid >> 6; const int nn = n0 + n; int col = nn;
          if (J.win == 1) col = nn < 2120 ? nn : (nn < 2304 ? -1 : nn - 184);
          if (J.win == 2) col = ((nn & 255) < 128) ? 128 * (nn >> 8) + (nn & 127) : DFF + 128 * (nn >> 8) + (nn & 127);
          float v[KT / 8];
#pragma unroll
          for (int p = 0; p < KT / 8; ++p) { const int k = kk0 + 8 * p; v[p] = col >= 0 ? J.src[(size_t)(k0 + k) * J.ldsrc + col] : 0.f; }
#pragma unroll
          for (int p = 0; p < KT / 8; ++p) tile[(kk0 + 8 * p) * 65 + n] = v[p]; }
        __syncthreads();
#pragma unroll
        for (int q = 0; q < KT / 64; ++q) { const int n = tid >> 3, kg = (tid & 7) + 8 * q; float v[8];
#pragma unroll
          for (int e = 0; e < 8; ++e) v[e] = tile[(kg * 8 + e) * 65 + n];
          u32x4 w; w.x = cvt_pk_bf16(v[0], v[1]); w.y = cvt_pk_bf16(v[2], v[3]); w.z = cvt_pk_bf16(v[4], v[5]); w.w = cvt_pk_bf16(v[6], v[7]);
          *(u32x4*)(J.dst + (size_t)(n0 + n) * J.K + k0 + kg * 8) = w; }
        __syncthreads();
    }
}
__device__ __forceinline__ void ph_wconv(const Params& P, int l, LAS unsigned char* lds) {
    LAS float* tile = (LAS float*)lds; unsigned char* wb = P.ws + OFF_WB;
    { WJob J{P.w_in + (size_t)l * 1024 * IN_COLS, IN_COLS, 1024, 8704, (bf16_t*)(wb + WB_WIN), 1}; conv_tiles<256>(J, tile); }
    for (int i = 0; i < 3; ++i) { WJob J{P.w_branch + ((size_t)l * 3 + i) * 512 * 1024, 1024, 512, 1024, (bf16_t*)(wb + WB_WBR) + (size_t)i * 1024 * 512, 0}; conv_tiles<256>(J, tile); }
    { WJob J{P.w_o + (size_t)l * 1024 * 1024, 1024, 1024, 1024, (bf16_t*)(wb + WB_WO), 0}; conv_tiles<256>(J, tile); }
    { WJob J{P.ffn_w_up + (size_t)l * 1024 * 5632, 5632, 1024, 5632, (bf16_t*)(wb + WB_WUP), 2}; conv_tiles<256>(J, tile); }
    { WJob J{P.ffn_w_down + (size_t)l * 2816 * 1024, 1024, 2816, 1024, (bf16_t*)(wb + WB_WDN), 0}; conv_tiles<256>(J, tile); }
    { WJob J{P.w_up + (size_t)l * 64 * 512, 512, 64, 512, (bf16_t*)(wb + WB_LW), 0}; conv_tiles<64>(J, tile); }
    { WJob J{P.a_up + (size_t)l * 64 * 512, 512, 64, 512, (bf16_t*)(wb + WB_LA), 0}; conv_tiles<64>(J, tile); }
    { WJob J{P.g_up + (size_t)l * 128 * 512, 512, 128, 512, (bf16_t*)(wb + WB_LG), 0}; conv_tiles<64>(J, tile); }
}

__device__ __forceinline__ void ph_norm(const Params& P, int l, int which) {
    const bool first = (l == 0 && which == 0);
    const float* nw = (which == 0 ? P.norm_mix : P.norm_ffn) + l * 1024;
    const float* mod = (const float*)(P.ws + OFF_MOD) + (size_t)l * 8 * 6144 + which * 3072;
    const bf16_t* XB = (const bf16_t*)P.out;
    bf16_t* H = (bf16_t*)(P.ws + OFF_H);
    const int tid = opaque_tid(), wid = tid >> 6, lane = tid & 63;
    for (int row = blockIdx.x * 8 + wid; row < T_; row += gridDim.x * 8) {
        const int b = row >> 12; const float* mb = mod + (size_t)b * 6144;
        f32x4 v[4]; float ss = 0.f;
#pragma unroll
        for (int i = 0; i < 4; ++i) {
            if (first) v[i] = *(const f32x4*)(P.x_in + (size_t)row * 1024 + i * 256 + lane * 4);
            else { const u32x2 w = *(const u32x2*)(XB + (size_t)row * 1024 + i * 256 + lane * 4); v[i] = (f32x4){bflo(w.x), bfhi(w.x), bflo(w.y), bfhi(w.y)}; }
            ss += v[i][0] * v[i][0] + v[i][1] * v[i][1] + v[i][2] * v[i][2] + v[i][3] * v[i][3]; }
        ss = wave_sum(ss, lane);
        const float rstd = rsqrtf(ss * (1.0f / 1024.0f) + 1e-6f);
#pragma unroll
        for (int i = 0; i < 4; ++i) { const int c = i * 256 + lane * 4;
            const f32x4 g = *(const f32x4*)(nw + c), sh = *(const f32x4*)(mb + c), sc = *(const f32x4*)(mb + 1024 + c);
            const f32x4 y = v[i] * rstd * g * (sc + 1.0f) + sh;
            u32x2 w; w.x = cvt_pk_bf16(y[0], y[1]); w.y = cvt_pk_bf16(y[2], y[3]);
            *(u32x2*)(H + (size_t)row * 1024 + c) = w; }
    }
}

__device__ __forceinline__ void ph_final(const Params& P) {
    const bf16_t* XF = (const bf16_t*)(P.ws + OFF_H);
    const int tid = opaque_tid(), wid = tid >> 6, lane = tid & 63;
    for (int row = blockIdx.x * 8 + wid; row < T_; row += gridDim.x * 8) {
        float* xr = P.out + (size_t)row * 1024;
        f32x4 v[4]; float ss = 0.f;
#pragma unroll
        for (int i = 0; i < 4; ++i) { const u32x2 w = *(const u32x2*)(XF + (size_t)row * 1024 + i * 256 + lane * 4); v[i] = (f32x4){bflo(w.x), bfhi(w.x), bflo(w.y), bfhi(w.y)};
            ss += v[i][0] * v[i][0] + v[i][1] * v[i][1] + v[i][2] * v[i][2] + v[i][3] * v[i][3]; }
        ss = wave_sum(ss, lane);
        const float rstd = rsqrtf(ss * (1.0f / 1024.0f) + 1e-6f);
#pragma unroll
        for (int i = 0; i < 4; ++i) { const int c = i * 256 + lane * 4; const f32x4 g = *(const f32x4*)(P.final_norm + c);
            *(f32x4*)(xr + c) = v[i] * rstd * g; }
    }
}

__device__ __forceinline__ void ph_gemm_zq(const Params& P, LAS unsigned char* lds) {
    g8::SOrder S; S.init(T_, 2304, 1024, 1024, P.ws + OFF_H, P.ws + OFF_WB + WB_WIN);
    g8::EpiBf E{(bf16_t*)(P.ws + OFF_ZQ), 2304, 9, nullptr, 0, 0};
    g8::gemm_phase(lds, 1024, 1024, 1024, S, E);
}
__device__ __forceinline__ void ph_gemm_zr(const Params& P, LAS unsigned char* lds) {
    g8::SOrder S; S.init(T_, 1792, 1024, 1024, P.ws + OFF_H, P.ws + OFF_WB + WB_WIN + (size_t)2304 * 1024 * 2);
    g8::EpiBf E{(bf16_t*)(P.ws + OFF_ZR), 1792, 7, nullptr, 0, 0};
    g8::gemm_phase(lds, 1024, 1024, 1024, S, E);
}
__device__ __forceinline__ void ph_gemm_zc(const Params& P, LAS unsigned char* lds) {
    g8::SOrder S; S.init(T_, 4608, 1024, 1024, P.ws + OFF_H, P.ws + OFF_WB + WB_WIN + (size_t)4096 * 1024 * 2);
    g8::EpiBf E{(bf16_t*)(P.ws + OFF_ZCV), 1536, 6, (bf16_t*)(P.ws + OFF_ZG), 3072, 1};
    g8::gemm_phase(lds, 1024, 1024, 1024, S, E);
}
__device__ __forceinline__ void ph_gemm_merge(const Params& P, LAS unsigned char* lds) {
    g8::MergeOrder S{(int)gridDim.x, (int)blockIdx.x, (const char*)(P.ws + OFF_OATT), (const char*)(P.ws + OFF_WB + WB_WBR)};
    g8::EpiMerge E{(bf16_t*)(P.ws + OFF_MRG), (const bf16_t*)(P.ws + OFF_ZG)};
    g8::gemm_phase(lds, 512, 512, 512, S, E);
}
__device__ __forceinline__ void ph_gemm_wo(const Params& P, int l, LAS unsigned char* lds) {
    g8::SOrder S; S.init(T_, 1024, 1024, 1024, P.ws + OFF_MRG, P.ws + OFF_WB + WB_WO);
    g8::EpiRes E{l == 0 ? P.x_in : nullptr, (const bf16_t*)P.out, (bf16_t*)P.out, (const float*)(P.ws + OFF_MOD) + (size_t)l * 8 * 6144 + 2048};
    g8::gemm_phase(lds, 1024, 1024, 1024, S, E);
}
__device__ __forceinline__ void ph_gemm_up(const Params& P, int l, LAS unsigned char* lds) {
    g8::SOrder S; S.init(T_, 5632, 1024, 1024, P.ws + OFF_H, P.ws + OFF_WB + WB_WUP);
    g8::EpiUp E{(bf16_t*)(P.ws + OFF_UP), (float*)(P.ws + OFF_HA), (float*)(P.ws + OFF_HB), P.ffn_conv_w + (size_t)l * DFF * 3};
    g8::gemm_phase(lds, 1024, 1024, 1024, S, E);
}
__device__ __forceinline__ void ph_gemm_down(const Params& P, int l, LAS unsigned char* lds) {
    g8::SOrder S; S.init(T_, 1024, 2816, 2816, P.ws + OFF_UP, P.ws + OFF_WB + WB_WDN);
    g8::EpiRes E{nullptr, (const bf16_t*)P.out, l == 1 ? (bf16_t*)(P.ws + OFF_H) : (bf16_t*)P.out, (const float*)(P.ws + OFF_MOD) + (size_t)l * 8 * 6144 + 5120};
    g8::gemm_phase(lds, 2816, 2816, 2816, S, E);
}

__device__ __forceinline__ void ph_conv(const Params& P, int l, LAS unsigned char* lds) {
    const bf16_t* Z = (const bf16_t*)(P.ws + OFF_ZCV); bf16_t* O = (bf16_t*)(P.ws + OFF_OCONV);
    LAS float* cwT = (LAS float*)lds;
    const int tid = opaque_tid();
    for (int i = tid; i < 1536; i += NTHR) cwT[(i % 3) * 512 + i / 3] = P.sc_conv_w[(size_t)l * 1536 + i];
    __syncthreads();
    constexpr int RB = 16; const int nitem = (T_ / RB) * 64;
    for (int it = blockIdx.x * NTHR + tid; it < nitem; it += gridDim.x * NTHR) {
        const int rb = it >> 6, c0 = (it & 63) * 8, row0 = rb * RB, t0 = row0 & 4095;
        float w0[8], w1[8], w2[8];
#pragma unroll
        for (int e = 0; e < 8; ++e) { w0[e] = cwT[c0 + e]; w1[e] = cwT[512 + c0 + e]; w2[e] = cwT[1024 + c0 + e]; }
        float pm2[8], pm1[8];
#pragma unroll
        for (int e = 0; e < 8; ++e) { pm2[e] = 0.f; pm1[e] = 0.f; }
        if (t0 >= 2) {
#pragma unroll
            for (int j = 0; j < 2; ++j) { const bf16_t* zr = Z + (size_t)(row0 - 2 + j) * 1536;
                const u32x4 cc = *(const u32x4*)(zr + 512 + c0), cx = *(const u32x4*)(zr + 1024 + c0);
                const unsigned ccw[4] = {cc.x, cc.y, cc.z, cc.w}, cxw[4] = {cx.x, cx.y, cx.z, cx.w};
#pragma unroll
                for (int q = 0; q < 4; ++q) { const float a = bflo(ccw[q]) * bflo(cxw[q]), b2 = bfhi(ccw[q]) * bfhi(cxw[q]);
                    if (j == 0) { pm2[2 * q] = a; pm2[2 * q + 1] = b2; } else { pm1[2 * q] = a; pm1[2 * q + 1] = b2; } } }
        }
#pragma unroll 4
        for (int r = 0; r < RB; ++r) {
            const bf16_t* zr = Z + (size_t)(row0 + r) * 1536;
            const u32x4 cb = *(const u32x4*)(zr + c0), cc = *(const u32x4*)(zr + 512 + c0), cx = *(const u32x4*)(zr + 1024 + c0);
            const unsigned cbw[4] = {cb.x, cb.y, cb.z, cb.w}, ccw[4] = {cc.x, cc.y, cc.z, cc.w}, cxw[4] = {cx.x, cx.y, cx.z, cx.w};
            float cur[8], o[8];
#pragma unroll
            for (int q = 0; q < 4; ++q) { cur[2 * q] = bflo(ccw[q]) * bflo(cxw[q]); cur[2 * q + 1] = bfhi(ccw[q]) * bfhi(cxw[q]); }
#pragma unroll
            for (int e = 0; e < 8; ++e) { o[e] = w0[e] * pm2[e] + w1[e] * pm1[e] + w2[e] * cur[e]; pm2[e] = pm1[e]; pm1[e] = cur[e]; }
            u32x4 w; w.x = cvt_pk_bf16(o[0] * bflo(cbw[0]), o[1] * bfhi(cbw[0])); w.y = cvt_pk_bf16(o[2] * bflo(cbw[1]), o[3] * bfhi(cbw[1]));
            w.z = cvt_pk_bf16(o[4] * bflo(cbw[2]), o[5] * bfhi(cbw[2])); w.w = cvt_pk_bf16(o[6] * bflo(cbw[3]), o[7] * bfhi(cbw[3]));
            *(u32x4*)(O + (size_t)(row0 + r) * 512 + c0) = w;
        }
    }
}

__device__ __forceinline__ void ph_ufix(const Params& P, int l, LAS unsigned char* lds) {
    bf16_t* U = (bf16_t*)(P.ws + OFF_UP); const float* HA = (const float*)(P.ws + OFF_HA); const float* HB = (const float*)(P.ws + OFF_HB);
    LAS float* cwT = (LAS float*)lds;
    const int tid = opaque_tid();
    for (int i = tid; i < DFF * 3; i += NTHR) cwT[(i % 3) * DFF + i / 3] = P.ffn_conv_w[(size_t)l * DFF * 3 + i];
    __syncthreads();
    const int nitem = (T_ / 64) * 2 * 352;
    for (int it = blockIdx.x * NTHR + tid; it < nitem; it += gridDim.x * NTHR) {
        const int c0 = (it % 352) * 8, gr = it / 352, grp = gr >> 1, rr = gr & 1; const bool first = (grp & 63) == 0;
        const float* hb = HB + ((size_t)(grp * 2 + rr) * 2) * DFF + c0;
        float a0[8], a1[8], a2[8], g[8];
#pragma unroll
        for (int q = 0; q < 2; ++q) { const f32x4 va = *(const f32x4*)(hb + 4 * q), vg = *(const f32x4*)(hb + DFF + 4 * q);
#pragma unroll
            for (int e = 0; e < 4; ++e) { a0[4 * q + e] = va[e]; g[4 * q + e] = vg[e]; a1[4 * q + e] = 0.f; a2[4 * q + e] = 0.f; } }
        if (rr == 1) { const float* p1 = HB + ((size_t)(grp * 2) * 2) * DFF + c0;
#pragma unroll
            for (int q = 0; q < 2; ++q) { const f32x4 v = *(const f32x4*)(p1 + 4 * q);
#pragma unroll
                for (int e = 0; e < 4; ++e) a1[4 * q + e] = v[e]; } }
        if (!first) {
            const float* pl = HA + (size_t)((grp - 1) * 2 + 1) * DFF + c0;
            const float* pk = HA + (size_t)((grp - 1) * 2) * DFF + c0;
#pragma unroll
            for (int q = 0; q < 2; ++q) { const f32x4 v63 = *(const f32x4*)(pl + 4 * q), v62 = *(const f32x4*)(pk + 4 * q);
#pragma unroll
                for (int e = 0; e < 4; ++e) { if (rr == 1) a2[4 * q + e] = v63[e]; else { a1[4 * q + e] = v63[e]; a2[4 * q + e] = v62[e]; } } }
        }
        float o[8];
#pragma unroll
        for (int e = 0; e < 8; ++e) { const float s = cwT[c0 + e] * a2[e] + cwT[DFF + c0 + e] * a1[e] + cwT[2 * DFF + c0 + e] * a0[e]; o[e] = s * sigmoidf_(s) * g[e]; }
        u32x4 w; w.x = cvt_pk_bf16(o[0], o[1]); w.y = cvt_pk_bf16(o[2], o[3]); w.z = cvt_pk_bf16(o[4], o[5]); w.w = cvt_pk_bf16(o[6], o[7]);
        *(u32x4*)(U + (size_t)(grp * 64 + rr) * DFF + c0) = w;
    }
}

template <int NR>
__device__ __forceinline__ u64 select_row(LAS float* row, const int t, const int lz) {
    const int imax = t >> 6;
    float x[NR]; float Tx = 0.f; bool have = false, exact = false;
    {
        int bin[NR]; float lo = __builtin_inff(), hi = -__builtin_inff();
        LAS unsigned* hist = (LAS unsigned*)row;
#pragma unroll
        for (int i = 0; i < NR; ++i) { const float v = row[64 * i + lz]; x[i] = (i <= imax) ? v : -__builtin_inff(); hi = fmaxf(hi, x[i]); lo = fminf(lo, (i < imax || x[i] > -__builtin_inff()) ? x[i] : __builtin_inff()); }
#pragma unroll
        for (int o = 32; o >= 1; o >>= 1) { lo = fminf(lo, shx(lo, o, lz)); hi = fmaxf(hi, shx(hi, o, lz)); }
        if (hi > lo) {
            const float scale = 4095.0f / (hi - lo);
#pragma unroll
            for (int q = 0; q < 16; ++q) *(LAS u32x4*)(hist + 256 * q + 4 * lz) = (u32x4){0u, 0u, 0u, 0u};
#pragma unroll
            for (int i = 0; i < NR; ++i) {
                const int bq = (int)fminf(fmaxf((x[i] - lo) * scale, -1.0f), 4095.0f); bin[i] = bq;
                if (bq >= 0) __hip_atomic_fetch_add(hist + bq, 1u, __ATOMIC_RELAXED, __HIP_MEMORY_SCOPE_WORKGROUP); }
            unsigned c1 = 0u;
#pragma unroll
            for (int q = 0; q < 16; ++q) { const u32x4 h4 = *(const LAS u32x4*)(hist + 64 * lz + 4 * ((q + lz) & 15)); c1 += (h4.x + h4.y) + (h4.z + h4.w); }
            unsigned inc = c1;
#pragma unroll
            for (int o = 1; o <= 32; o <<= 1) { const unsigned v = (unsigned)__builtin_amdgcn_ds_bpermute(((lz + o) & 63) << 2, (int)inc); inc += (lz + o < 64) ? v : 0u; }
            const unsigned ab1 = inc - c1;
            const u64 cr1 = __ballot(ab1 < 256u && ab1 + c1 >= 256u);
            const int L1 = __builtin_ctzll(cr1);
            const unsigned abL = (unsigned)__builtin_amdgcn_readlane((int)ab1, L1);
            const unsigned c2 = hist[64 * L1 + lz];
            unsigned inc2 = c2;
#pragma unroll
            for (int o = 1; o <= 32; o <<= 1) { const unsigned v = (unsigned)__builtin_amdgcn_ds_bpermute(((lz + o) & 63) << 2, (int)inc2); inc2 += (lz + o < 64) ? v : 0u; }
            const unsigned ab2 = inc2 - c2 + abL;
            const u64 cr2 = __ballot(ab2 < 256u && ab2 + c2 >= 256u);
            const int L2 = __builtin_ctzll(cr2);
            const int bstar = 64 * L1 + L2;
            const int cb = __builtin_amdgcn_readlane((int)c2, L2), need2 = 256 - __builtin_amdgcn_readlane((int)ab2, L2);
            if (cb <= 64) {
                int cand = 0; int pos = 0;
#pragma unroll
                for (int i = 0; i < NR; ++i) { u64 mm = __ballot(bin[i] == bstar);
                    while (mm) { const int s = __builtin_ctzll(mm); mm &= mm - 1ull; cand = writelane_v(cand, __builtin_amdgcn_readlane(__float_as_int(x[i]), s), pos); ++pos; } }
                const unsigned cu = (lz < cb) ? f2ord(__int_as_float(cand)) : 0u;
                unsigned Tc = 0u;
#pragma unroll 1
                for (int bit = 31; bit >= 0; --bit) { const unsigned cd = Tc | (1u << bit); if ((int)__popcll(__ballot(cu >= cd)) >= need2) Tc = cd; }
                Tx = ord2f(Tc); have = true; exact = (256 - need2) + (int)__popcll(__ballot(cu >= Tc)) == 256;
            }
        }
    }
    if (!have) {
        unsigned Tt = 0u;
#pragma unroll 1
        for (int bit = 31; bit >= 0; --bit) {
            const unsigned cand = Tt | (1u << bit); int cnt = 0;
#pragma unroll
            for (int i = 0; i < NR; ++i) cnt += __popcll(__ballot(f2ord(x[i]) >= cand));
            if (cnt >= 256) Tt = cand;
        }
        Tx = ord2f(Tt);
    }
    int wlo = 0, whi = 0;
#pragma unroll
    for (int i = 0; i < NR; ++i) { const u64 g = __ballot(x[i] >= Tx); writelane_c2(wlo, whi, (int)(unsigned)g, (int)(unsigned)(g >> 32), i); }
    u64 myw = ((u64)(unsigned)whi << 32) | (unsigned)wlo;
    if (!exact) {
        int cgt = 0;
#pragma unroll
        for (int i = 0; i < NR; ++i) cgt += __popcll(__ballot(x[i] > Tx));
        int need = 256 - cgt; myw = 0ull;
#pragma unroll
        for (int i = 0; i < NR; ++i) {
            const u64 g = __ballot(x[i] > Tx); u64 e = __ballot(x[i] == Tx);
            int ne = __popcll(e);
            while (ne > need) { e &= ~(1ull << (63 - __clzll(e))); --ne; }
            need -= ne;
            if (lz == i) myw = g | e;
        }
    }
    return myw;
}

__device__ __forceinline__ void ph_idx(const Params& P, LAS unsigned char* lds) {
    LAS float* SC = (LAS float*)lds;
    const bf16_t* ZQ = (const bf16_t*)(P.ws + OFF_ZQ); u64* MASK = (u64*)(P.ws + OFF_MASK);
    const int tid = opaque_tid(), wid = __builtin_amdgcn_readfirstlane(tid >> 6), lane = tid & 63, m = lane & 31, hh = lane >> 5;
    { int* KPM = (int*)(P.ws + OFF_KPM);
      for (int i = blockIdx.x * NTHR + tid; i < NB_ * 64; i += gridDim.x * NTHR) { const int* pp = P.pos + (i >> 6) * S_ + (i & 63) * 64; int mxp = pp[0];
          for (int k = 1; k < 64; ++k) mxp = pp[k] > mxp ? pp[k] : mxp;
          KPM[i] = mxp; } }
    int itc = 0;
    for (int idx = blockIdx.x; idx < NB_ * 512; idx += gridDim.x, ++itc) {
        const int b = idx & 7, j = idx >> 3; const int qb = (itc & 1) ? (j ^ 31) : j; const int t0 = qb * 8;
        const bf16_t* zb = ZQ + (size_t)b * S_ * 2304;
        bf16x8 Af[2][4]; float wv[2][16];
#pragma unroll
        for (int blk = 0; blk < 2; ++blk) {
            const bf16_t* qp = zb + (size_t)(t0 + 4 * blk + 2 * ((m >> 2) & 1) + (m >> 4)) * 2304 + 1536 + (4 * ((m >> 3) & 1) + (m & 3)) * 64 + 8 * hh;
#pragma unroll
            for (int ks = 0; ks < 4; ++ks) Af[blk][ks] = *(const bf16x8*)(qp + 16 * ks);
#pragma unroll
            for (int q = 0; q < 2; ++q) { const u32x4 ww = *(const u32x4*)(zb + (size_t)(t0 + 4 * blk + 2 * hh + q) * 2304 + 2112);
                wv[blk][8 * q + 0] = bflo(ww.x); wv[blk][8 * q + 1] = bfhi(ww.x); wv[blk][8 * q + 2] = bflo(ww.y); wv[blk][8 * q + 3] = bfhi(ww.y);
                wv[blk][8 * q + 4] = bflo(ww.z); wv[blk][8 * q + 5] = bfhi(ww.z); wv[blk][8 * q + 6] = bflo(ww.w); wv[blk][8 * q + 7] = bfhi(ww.w); }
        }
        const int ntile = 2 * ((t0 + 7) / 64 + 1);
        for (int kt = wid; kt < ntile; kt += 8) {
            const bf16_t* kp = zb + (size_t)(32 * kt + m) * 2304 + 2048 + 8 * hh;
            bf16x8 Bf[4];
#pragma unroll
            for (int ks = 0; ks < 4; ++ks) Bf[ks] = *(const bf16x8*)(kp + 16 * ks);
#pragma unroll
            for (int blk = 0; blk < 2; ++blk) {
                f32x16 Dv;
#pragma unroll
                for (int r = 0; r < 16; ++r) Dv[r] = 0.f;
#pragma unroll
                for (int ks = 0; ks < 4; ++ks) Dv = __builtin_amdgcn_mfma_f32_32x32x16_bf16(Af[blk][ks], Bf[ks], Dv, 0, 0, 0);
#pragma unroll
                for (int q = 0; q < 2; ++q) {
                    float part = 0.f;
#pragma unroll
                    for (int e = 0; e < 8; ++e) { const float d = Dv[8 * q + e], w = wv[blk][8 * q + e]; part = __builtin_fmaf(w, d, part); part = __builtin_fmaf(w, __builtin_fabsf(d), part); }
                    SC[(4 * blk + 2 * hh + q) * 4096 + 32 * kt + m] = (32 * kt + m <= t0 + 4 * blk + 2 * hh + q) ? part : -__builtin_inff();
                }
            }
        }
        __syncthreads();
        {
            const int t = t0 + wid; u64* mrow = MASK + (size_t)(b * S_ + t) * 64;
            if (t < 256) {
                const int lo = 64 * lane; u64 w;
                if (t >= lo + 63) w = ~0ull; else if (t < lo) w = 0ull; else w = (2ull << (t - lo)) - 1ull;
                mrow[lane] = w;
            } else {
                int lz = threadIdx.x; asm volatile("" : "+v"(lz)); lz &= 63;
                LAS float* rowp = SC + wid * 4096; u64 myw;
                if (t < 512) myw = select_row<8>(rowp, t, lz); else if (t < 1024) myw = select_row<16>(rowp, t, lz); else if (t < 2048) myw = select_row<32>(rowp, t, lz); else myw = select_row<64>(rowp, t, lz);
                mrow[lz] = myw;
            }
        }
        __syncthreads();
    }
    {
        LAS bf16_t* tl = (LAS bf16_t*)lds;
        bf16_t* VT = (bf16_t*)(P.ws + OFF_VT);
        for (int it = blockIdx.x; it < NB_ * 8 * 64; it += gridDim.x) {
            const int b = it >> 9, h = (it >> 6) & 7, k0 = (it & 63) * 64;
            { const int row = tid >> 3, ch = tid & 7;
              const u32x4 v = *(const u32x4*)(ZQ + (size_t)(b * S_ + k0 + row) * 2304 + 1024 + h * 64 + ch * 8);
              *(LAS u32x4*)(tl + row * 72 + ch * 8) = v; }
            __syncthreads();
            { const int d = tid >> 3, kc = tid & 7; unsigned short e[8];
#pragma unroll
              for (int q = 0; q < 8; ++q) e[q] = tl[(kc * 8 + q) * 72 + d];
              u32x4 w; w.x = e[0] | ((unsigned)e[1] << 16); w.y = e[2] | ((unsigned)e[3] << 16); w.z = e[4] | ((unsigned)e[5] << 16); w.w = e[6] | ((unsigned)e[7] << 16);
              *(u32x4*)(VT + ((size_t)((b * 8 + h) * 64 + d)) * S_ + k0 + kc * 8) = w; }
            __syncthreads();
        }
    }
}

__device__ __forceinline__ int bitmask(int w, int pos  ) { int m; asm("v_bfe_i32 %0, %1, %2, 1" : "=v"(m) : "v"(w), "n"(pos)); return m; }
__device__ __forceinline__ void ph_att(const Params& P, LAS unsigned char* lds) {
    LAS float* TABL = (LAS float*)lds;
    LAS unsigned char* KB = lds + 4096;
    constexpr int KT_B = 64 * 144, VT_B = 64 * 136, BUF_B = KT_B + VT_B;
    constexpr float LOG2E = 1.4426950408889634f;
    const float* tabg = (const float*)(P.ws + OFF_TAB);
    const int tid = opaque_tid(), wid = __builtin_amdgcn_readfirstlane(tid >> 6), lane = tid & 63, m = lane & 31, hh = lane >> 5;
    for (int i = tid; i < 1024; i += NTHR) TABL[i] = tabg[i] * LOG2E;
    __syncthreads();
    const bf16_t* ZQ = (const bf16_t*)(P.ws + OFF_ZQ); const u64* MASK = (const u64*)(P.ws + OFF_MASK);
    const bf16_t* VT = (const bf16_t*)(P.ws + OFF_VT); bf16_t* OA = (bf16_t*)(P.ws + OFF_OATT); const int* KPM = (const int*)(P.ws + OFF_KPM);
    int itc = 0;
    for (int idx = blockIdx.x; idx < NB_ * 8 * 16; idx += gridDim.x, ++itc) {
        const int b = idx & 7, head = (idx >> 3) & 7, j = idx >> 6; const int qb = (itc & 1) ? (j ^ 3) : j;
        const int q0 = qb * 256, tq0 = q0 + 32 * wid, t = tq0 + m;
        const bf16_t* zb = ZQ + (size_t)b * S_ * 2304;
        bf16x8 Qf[4];
        { const bf16_t* qp = zb + (size_t)t * 2304 + head * 64 + 8 * hh;
#pragma unroll
          for (int ks = 0; ks < 4; ++ks) Qf[ks] = *(const bf16x8*)(qp + 16 * ks); }
        const int posq = P.pos[b * S_ + t];
        int minq = posq;
#pragma unroll
        for (int o = 32; o >= 1; o >>= 1) { const int v = shxi(minq, o, lane); minq = v < minq ? v : minq; }
        minq = __builtin_amdgcn_readfirstlane(minq);
        const u64* mrow = MASK + (size_t)(b * S_ + t) * 64;
        const bf16_t* vtb = VT + (size_t)(b * 8 + head) * 64 * S_;
        const float c1 = 0.125f * LOG2E, c2 = TABL[127 * 8 + head];
        f32x16 O0, O1, OL;
#pragma unroll
        for (int r = 0; r < 16; ++r) { O0[r] = 0.f; O1[r] = 0.f; OL[r] = 0.f; }
        const bf16x8 ones8 = {0x3F80, 0x3F80, 0x3F80, 0x3F80, 0x3F80, 0x3F80, 0x3F80, 0x3F80};
        float m_run = -1e30f;
        const int nt = 4 * qb + 4, my_nt = ((tq0 + 31) >> 6) + 1;
        const int skey = tid >> 3, sch = tid & 7;
        const bf16_t* kg = zb + (size_t)skey * 2304 + 512 + head * 64 + 8 * sch;
        const bf16_t* vg = vtb + (size_t)skey * S_ + 8 * sch;
        LAS unsigned char* kdst = KB + skey * 144 + sch * 16; LAS unsigned char* vdst = KB + KT_B + skey * 136 + sch * 16;
        u64 mw_nxt = mrow[0]; const int kpm_l = KPM[b * 64 + lane];
        auto tile = [&](const int kt, const int boff) {
                const LAS unsigned char* Kt = KB + boff; const LAS unsigned char* Vt = Kt + KT_B;
                f32x16 D0, D1;
#pragma unroll
                for (int r = 0; r < 16; ++r) { D0[r] = 0.f; D1[r] = 0.f; }
#pragma unroll
                for (int ks = 0; ks < 4; ++ks) {
                    const bf16x8 K0 = *(const LAS bf16x8*)(Kt + m * 144 + 32 * ks + 16 * hh), K1 = *(const LAS bf16x8*)(Kt + (32 + m) * 144 + 32 * ks + 16 * hh);
                    D0 = __builtin_amdgcn_mfma_f32_32x32x16_bf16(K0, Qf[ks], D0, 0, 0, 0); D1 = __builtin_amdgcn_mfma_f32_32x32x16_bf16(K1, Qf[ks], D1, 0, 0, 0); }
                const u64 mw = mw_nxt; mw_nxt = mrow[kt + 1 < 64 ? kt + 1 : kt];
                const int w0 = (int)((unsigned)mw >> (4 * hh)), w1 = (int)((unsigned)(mw >> 32) >> (4 * hh));
                float esc = c1, eoff0 = c2;
                if (minq - __builtin_amdgcn_readlane(kpm_l, kt) < 127) {
#pragma unroll
                    for (int mb = 0; mb < 2; ++mb)
#pragma unroll
                        for (int g = 0; g < 4; ++g) {
                            const i32x4 pk = *(const i32x4*)(P.pos + b * S_ + 64 * kt + 32 * mb + 8 * g + 4 * hh);
#pragma unroll
                            for (int e = 0; e < 4; ++e) { const int r = 4 * g + e; int n = posq - pk[e]; n = n < 0 ? 0 : (n > 127 ? 127 : n);
                                if (mb) D1[r] = D1[r] * c1 + TABL[n * 8 + head]; else D0[r] = D0[r] * c1 + TABL[n * 8 + head]; }
                        }
                    esc = 1.0f; eoff0 = 0.f;
                }
                float mx = __builtin_fmaxf(__builtin_fmaxf(D0[0], D0[1]), D0[2]);
#pragma unroll
                for (int r = 3; r < 15; r += 2) mx = __builtin_fmaxf(__builtin_fmaxf(mx, D0[r]), D0[r + 1]);
#pragma unroll
                for (int r = 0; r < 16; r += 2) mx = __builtin_fmaxf(__builtin_fmaxf(mx, D1[r]), D1[r + 1]);
                mx = fmaxf(mx, D0[15]);
                mx = fmaxf(mx, shx(mx, 32, lane));
                const float m_new = fmaxf(m_run, mx * esc + eoff0); const float alpha = __builtin_amdgcn_exp2f(m_run - m_new); m_run = m_new;
                const float eoff = eoff0 - m_new;
                float pv[32];
#pragma unroll
                for (int r = 0; r < 16; ++r) {
                    const int bp = (r & 3) + 8 * (r >> 2);
                    pv[r] = __int_as_float(__float_as_int(__builtin_amdgcn_exp2f(D0[r] * esc + eoff)) & bitmask(w0, bp));
                    pv[16 + r] = __int_as_float(__float_as_int(__builtin_amdgcn_exp2f(D1[r] * esc + eoff)) & bitmask(w1, bp)); }
                if (!__all(alpha == 1.0f)) {
#pragma unroll
                    for (int r = 0; r < 16; ++r) { O0[r] *= alpha; O1[r] *= alpha; OL[r] *= alpha; } }
#pragma unroll
                for (int s = 0; s < 4; ++s) {
                    u32x4 pw; pw.x = cvt_pk_bf16(pv[8 * s + 0], pv[8 * s + 1]); pw.y = cvt_pk_bf16(pv[8 * s + 2], pv[8 * s + 3]); pw.z = cvt_pk_bf16(pv[8 * s + 4], pv[8 * s + 5]); pw.w = cvt_pk_bf16(pv[8 * s + 6], pv[8 * s + 7]);
                    const bf16x8 Pf = __builtin_bit_cast(bf16x8, pw);
                    const LAS unsigned char* vp = Vt + m * 136 + (16 * s + 4 * hh) * 2;
                    { const u32x2 va = *(const LAS u32x2*)vp, vb = *(const LAS u32x2*)(vp + 16); u32x4 vw; vw.x = va.x; vw.y = va.y; vw.z = vb.x; vw.w = vb.y;
                      O0 = __builtin_amdgcn_mfma_f32_32x32x16_bf16(__builtin_bit_cast(bf16x8, vw), Pf, O0, 0, 0, 0); }
                    { const u32x2 va = *(const LAS u32x2*)(vp + 32 * 136), vb = *(const LAS u32x2*)(vp + 32 * 136 + 16); u32x4 vw; vw.x = va.x; vw.y = va.y; vw.z = vb.x; vw.w = vb.y;
                      O1 = __builtin_amdgcn_mfma_f32_32x32x16_bf16(__builtin_bit_cast(bf16x8, vw), Pf, O1, 0, 0, 0); }
                    OL = __builtin_amdgcn_mfma_f32_32x32x16_bf16(ones8, Pf, OL, 0, 0, 0);
                }
        };
        __syncthreads();
        constexpr int SUB_B = KT_B + VT_B, SUP_B = 2 * SUB_B;
        const int nst = nt >> 1;
        u32x4 ka0, kb0, va0, vb0, ka1, kb1, va1, vb1;
#define ATT_LOAD(KA, KB_, VA, VB, ST) do { KA = *(const u32x4*)(kg + (size_t)(2 * (ST)) * 64 * 2304); KB_ = *(const u32x4*)(kg + (size_t)(2 * (ST) + 1) * 64 * 2304); \
            VA = *(const u32x4*)(vg + (2 * (ST)) * 64); VB = *(const u32x4*)(vg + (2 * (ST) + 1) * 64); } while (0)
#define ATT_STORE(KA, KB_, VA, VB, BUF) do { LAS unsigned char* kd_ = kdst + (BUF) * SUP_B; LAS unsigned char* vd_ = vdst + (BUF) * SUP_B; \
            *(LAS u32x4*)kd_ = KA; *(LAS u32x2*)vd_ = (u32x2){VA.x, VA.y}; *(LAS u32x2*)(vd_ + 8) = (u32x2){VA.z, VA.w}; \
            *(LAS u32x4*)(kd_ + SUB_B) = KB_; *(LAS u32x2*)(vd_ + SUB_B) = (u32x2){VB.x, VB.y}; *(LAS u32x2*)(vd_ + SUB_B + 8) = (u32x2){VB.z, VB.w}; } while (0)
        ATT_LOAD(ka0, kb0, va0, vb0, 0); ATT_STORE(ka0, kb0, va0, vb0, 0);
        if (nst > 1) ATT_LOAD(ka1, kb1, va1, vb1, 1);
        __syncthreads();
        for (int st = 0; st < nst; st += 2) {
            if (st + 2 < nst) ATT_LOAD(ka0, kb0, va0, vb0, st + 2);
            if (2 * st < my_nt) tile(2 * st, 0);
            if (2 * st + 1 < my_nt) tile(2 * st + 1, SUB_B);
            if (st + 1 < nst) ATT_STORE(ka1, kb1, va1, vb1, 1);
            __syncthreads();
            if (st + 1 >= nst) break;
            if (st + 3 < nst) ATT_LOAD(ka1, kb1, va1, vb1, st + 3);
            if (2 * st + 2 < my_nt) tile(2 * st + 2, SUP_B);
            if (2 * st + 3 < my_nt) tile(2 * st + 3, SUP_B + SUB_B);
            if (st + 2 < nst) ATT_STORE(ka0, kb0, va0, vb0, 0);
            __syncthreads();
        }
#undef ATT_LOAD
#undef ATT_STORE
        const float inv = __builtin_amdgcn_rcpf(OL[0]);
        bf16_t* op = OA + (size_t)(b * S_ + t) * 512 + head * 64 + 4 * hh;
#pragma unroll
        for (int g = 0; g < 4; ++g) {
            u32x2 wa; wa.x = cvt_pk_bf16(O0[4 * g] * inv, O0[4 * g + 1] * inv); wa.y = cvt_pk_bf16(O0[4 * g + 2] * inv, O0[4 * g + 3] * inv);
            *(u32x2*)(op + 8 * g) = wa;
            u32x2 wb; wb.x = cvt_pk_bf16(O1[4 * g] * inv, O1[4 * g + 1] * inv); wb.y = cvt_pk_bf16(O1[4 * g + 2] * inv, O1[4 * g + 3] * inv);
            *(u32x2*)(op + 32 + 8 * g) = wb;
        }
    }
}

#define DSR4(A, addr, o0, o1, o2, o3) asm volatile("ds_read_b128 %0, %4 offset:%5\n\tds_read_b128 %1, %4 offset:%6\n\tds_read_b128 %2, %4 offset:%7\n\tds_read_b128 %3, %4 offset:%8" \
    : "=&v"(A[0]), "=&v"(A[1]), "=&v"(A[2]), "=&v"(A[3]) : "v"(addr), "i"(o0), "i"(o1), "i"(o2), "i"(o3))
#define DSW(A, N) asm volatile("s_waitcnt lgkmcnt(" #N ")" : "+v"(A[0]), "+v"(A[1]), "+v"(A[2]), "+v"(A[3]))
#define DSRV(V, addr, off) asm volatile("ds_read_b32 %0, %1 offset:%2" : "=&v"(V) : "v"(addr), "i"(off))
#define DSWV(A, V, N) asm volatile("s_waitcnt lgkmcnt(" #N ")" : "+v"(A[0]), "+v"(A[1]), "+v"(A[2]), "+v"(A[3]), "+v"(V))
#define SCAN_A(X, G) _Pragma("unroll") for (int i_ = 0; i_ < 4; ++i_) { const f32x2 k01 = {X[i_][0], X[i_][1]}, k23 = {X[i_][2], X[i_][3]}; \
    sa0 += S2[8 * G + 2 * i_] * k01; sa1 += S2[8 * G + 2 * i_ + 1] * k23; sp0 += Pm2[8 * G + 2 * i_] * k01; sp1 += Pm2[8 * G + 2 * i_ + 1] * k23; }
#define SCAN_B(X, C) { const int j = 2 * C; \
    { const f32x2 w = {X[0][0], X[0][1]}, kb = {X[1][0], X[1][1]}, kk = {X[2][0], X[2][1]}, rr = {X[3][0], X[3][1]}; \
      S2[j] = S2[j] * w + sav * kb + vv2 * kk; Pm2[j] = Pm2[j] * w + spv * kb; y0 += S2[j] * rr; p0 += Pm2[j] * rr; } \
    { const f32x2 w = {X[0][2], X[0][3]}, kb = {X[1][2], X[1][3]}, kk = {X[2][2], X[2][3]}, rr = {X[3][2], X[3][3]}; \
      S2[j + 1] = S2[j + 1] * w + sav * kb + vv2 * kk; Pm2[j + 1] = Pm2[j + 1] * w + spv * kb; y1 += S2[j + 1] * rr; p1 += Pm2[j + 1] * rr; } }
__device__ __forceinline__ float wave_sum_dpp(float v) {
    v += __int_as_float(__builtin_amdgcn_update_dpp(0, __float_as_int(v), 0x111, 0xf, 0xf, true));
    v += __int_as_float(__builtin_amdgcn_update_dpp(0, __float_as_int(v), 0x112, 0xf, 0xf, true));
    v += __int_as_float(__builtin_amdgcn_update_dpp(0, __float_as_int(v), 0x114, 0xf, 0xf, true));
    v += __int_as_float(__builtin_amdgcn_update_dpp(0, __float_as_int(v), 0x118, 0xf, 0xf, true));
    v += __int_as_float(__builtin_amdgcn_update_dpp(0, __float_as_int(v), 0x142, 0xa, 0xf, false));
    v += __int_as_float(__builtin_amdgcn_update_dpp(0, __float_as_int(v), 0x143, 0xc, 0xf, false));
    return __int_as_float(__builtin_amdgcn_readlane(__float_as_int(v), 63));
}
__device__ __forceinline__ void wave_sum2_dpp(float a, float b, float& ra, float& rb) {
    const auto sw = __builtin_amdgcn_permlane32_swap(__float_as_uint(a), __float_as_uint(b), false, false);
    float v = __uint_as_float(sw[0]) + __uint_as_float(sw[1]);
    v += __int_as_float(__builtin_amdgcn_update_dpp(0, __float_as_int(v), 0x111, 0xf, 0xf, true));
    v += __int_as_float(__builtin_amdgcn_update_dpp(0, __float_as_int(v), 0x112, 0xf, 0xf, true));
    v += __int_as_float(__builtin_amdgcn_update_dpp(0, __float_as_int(v), 0x114, 0xf, 0xf, true));
    v += __int_as_float(__builtin_amdgcn_update_dpp(0, __float_as_int(v), 0x118, 0xf, 0xf, true));
    v += __int_as_float(__builtin_amdgcn_update_dpp(0, __float_as_int(v), 0x142, 0xa, 0xf, false));
    ra = __int_as_float(__builtin_amdgcn_readlane(__float_as_int(v), 31)); rb = __int_as_float(__builtin_amdgcn_readlane(__float_as_int(v), 63));
}
__device__ __forceinline__ void ph_scan(const Params& P, int l, LAS unsigned char* lds) {
    LAS bf16_t* LI = (LAS bf16_t*)lds;
    LAS float* SIN = (LAS float*)(lds + 32768);
    const bf16_t* ZR = (const bf16_t*)(P.ws + OFF_ZR);
    const float* mu = P.mu + (size_t)l * 1792;
    const bf16_t* LW = (const bf16_t*)(P.ws + OFF_WB + WB_LW); const bf16_t* LA = (const bf16_t*)(P.ws + OFF_WB + WB_LA); const bf16_t* LG = (const bf16_t*)(P.ws + OFF_WB + WB_LG);
    bf16_t* Yo = (bf16_t*)(P.ws + OFF_Y); bf16_t* Po = (bf16_t*)(P.ws + OFF_P); bf16_t* Go = (bf16_t*)(P.ws + OFF_G); bf16_t* VBo = (bf16_t*)(P.ws + OFF_VB);
    float* SEGp = (float*)(P.ws + OFF_SEG);
    const int tid = opaque_tid(), wid = __builtin_amdgcn_readfirstlane(tid >> 6), lane = tid & 63;
    for (int blk = blockIdx.x; blk < NB_ * NSEG; blk += gridDim.x) {
        const int b = blk / NSEG, seg = blk % NSEG, tbeg = seg * SEGL;
        f32x2 S2[32], Pm2[32];
        { int lq = threadIdx.x; asm volatile("" : "+v"(lq)); lq &= 63;
#pragma unroll
          for (int j = 0; j < 32; ++j) { S2[j] = (f32x2){0.f, 0.f}; Pm2[j] = (f32x2){(2 * j == lq) ? 1.f : 0.f, (2 * j + 1 == lq) ? 1.f : 0.f}; } }
        for (int half = 0; half < 2; ++half) {
            __syncthreads();
            {
                int tq = threadIdx.x; asm volatile("" : "+v"(tq));
#pragma unroll 1
                for (int rnd = 0; rnd < 4; ++rnd) {
                    const int q = tq + NTHR * rnd, tok = q >> 5, c8 = (q & 31) * 8, t = tbeg + 64 * half + tok; const size_t row = (size_t)b * S_ + t;
                    const u32x4 zc = *(const u32x4*)(ZR + row * 1792 + 1536 + c8);
                    u32x4 zp; zp.x = 0u; zp.y = 0u; zp.z = 0u; zp.w = 0u; if (t > 0) zp = *(const u32x4*)(ZR + (row - 1) * 1792 + 1536 + c8);
                    const f32x4 ma = *(const f32x4*)(mu + 1536 + c8), mb = *(const f32x4*)(mu + 1536 + c8 + 4);
                    const unsigned cw[4] = {zc.x, zc.y, zc.z, zc.w}, pw[4] = {zp.x, zp.y, zp.z, zp.w};
                    float x[8];
#pragma unroll
                    for (int q2 = 0; q2 < 4; ++q2) { const float c0 = bflo(cw[q2]), c1 = bfhi(cw[q2]), p0 = bflo(pw[q2]), p1 = bfhi(pw[q2]);
                        const float m0 = q2 < 2 ? ma[2 * q2] : mb[2 * q2 - 4], m1 = q2 < 2 ? ma[2 * q2 + 1] : mb[2 * q2 - 3];
                        x[2 * q2] = c0 + (p0 - c0) * m0; x[2 * q2 + 1] = c1 + (p1 - c1) * m1; }
#pragma unroll
                    for (int e = 0; e < 8; ++e) { if (c8 < 64) x[e] = 1.0f - 2.0f * __builtin_amdgcn_rcpf(1.0f + __expf(2.0f * x[e])); else if (c8 >= 128) x[e] = sigmoidf_(x[e]); }
                    u32x4 w; w.x = cvt_pk_bf16(x[0], x[1]); w.y = cvt_pk_bf16(x[2], x[3]); w.z = cvt_pk_bf16(x[4], x[5]); w.w = cvt_pk_bf16(x[6], x[7]);
                    *(LAS u32x4*)(LI + tok * 256 + c8) = w;
                }
            }
            __syncthreads();
            float* los = (float*)(P.ws + OFF_SCR) + (size_t)(blk * 8 + wid) * (64 * 2 * 64);
            {
                int tq = threadIdx.x; asm volatile("" : "+v"(tq));
                const int lq = tq & 63, fr = lq & 15, kq = lq >> 4;
#pragma unroll 1
                for (int pass = 0; pass < 8; ++pass) {
                    const int kind = pass < 2 ? 0 : (pass < 4 ? 1 : 2), Kk = kind == 2 ? 128 : 64, aoff = kind * 64, nb0 = kind == 2 ? pass - 4 : 2 * (pass & 1);
                    const bf16_t* Wt = kind == 0 ? LW : (kind == 1 ? LA : LG);
                    bf16x8 Bf[4];
#pragma unroll
                    for (int q = 0; q < 4; ++q) { const int nb = kind == 2 ? nb0 : nb0 + (q >> 1), ks = kind == 2 ? q : (q & 1);
                        Bf[q] = *(const bf16x8*)(Wt + (size_t)(64 * wid + 16 * nb + fr) * Kk + 32 * ks + 8 * kq); }
#pragma unroll 1
                    for (int tt = 0; tt < 4; ++tt) {
                        f32x4 acc[2];
                        acc[0] = (f32x4){0.f, 0.f, 0.f, 0.f}; acc[1] = acc[0];
#pragma unroll
                        for (int q = 0; q < 4; ++q) { const int ai = kind == 2 ? 0 : (q >> 1), ks = kind == 2 ? q : (q & 1);
                            const bf16x8 Afr = *(const LAS bf16x8*)(LI + (16 * tt + fr) * 256 + aoff + 32 * ks + 8 * kq);
                            acc[ai] = __builtin_amdgcn_mfma_f32_16x16x32_bf16(Afr, Bf[q], acc[ai], 0, 0, 0); }
                        if (kind == 2) {
#pragma unroll
                            for (int r = 0; r < 4; ++r) Go[((size_t)b * S_ + tbeg + 64 * half + 16 * tt + 4 * kq + r) * 512 + 64 * wid + 16 * nb0 + fr] = f2bf(acc[0][r]);
                        } else {
#pragma unroll
                            for (int ai = 0; ai < 2; ++ai)
#pragma unroll
                                for (int r = 0; r < 4; ++r) los[((16 * tt + 4 * kq + r) * 2 + kind) * 64 + 16 * (nb0 + ai) + fr] = acc[ai][r];
                        }
                    }
                }
            }
            asm volatile("s_waitcnt vmcnt(0)" ::: "memory");
            for (int sb = 0; sb < 64 / TB; ++sb) {
                const int ts = tbeg + 64 * half + sb * TB;
                int tz = threadIdx.x; asm volatile("" : "+v"(tz));
                const int lz = tz & 63;
                LAS float* sw = SIN + (size_t)wid * (TB * 6 * 64);
                {
                    const int c = 64 * wid + lz; const size_t row0 = (size_t)b * S_ + ts;
                    const float mur = mu[c], muk = mu[512 + c], muv = mu[1024 + c];
                    const float pw0 = P.w0[l * 512 + c], pa0 = P.a0[l * 512 + c], pkk = P.k_k[l * 512 + c], pka = P.k_a[l * 512 + c], prk = P.r_k[l * 512 + c];
                    const float* lo = los + (size_t)(sb * TB) * 128 + lz;
                    float zr_[TB + 1], zk_[TB + 1], zv_[TB + 1], wl_[TB], al_[TB];
                    zr_[0] = 0.f; zk_[0] = 0.f; zv_[0] = 0.f;
                    if (ts > 0) { zr_[0] = bf2f(ZR[(row0 - 1) * 1792 + c]); zk_[0] = bf2f(ZR[(row0 - 1) * 1792 + 512 + c]); zv_[0] = bf2f(ZR[(row0 - 1) * 1792 + 1024 + c]); }
#pragma unroll
                    for (int tk = 0; tk < TB; ++tk) {
                        zr_[tk + 1] = bf2f(ZR[(row0 + tk) * 1792 + c]); zk_[tk + 1] = bf2f(ZR[(row0 + tk) * 1792 + 512 + c]); zv_[tk + 1] = bf2f(ZR[(row0 + tk) * 1792 + 1024 + c]);
                        wl_[tk] = lo[tk * 128]; al_[tk] = lo[tk * 128 + 64]; }
#pragma unroll
                    for (int tk = 0; tk < TB; ++tk) {
                        const size_t row = row0 + tk; LAS float* st = sw + tk * 6 * 64;
                        const float cr = zr_[tk + 1], ck = zk_[tk + 1], cv = zv_[tk + 1], wl = wl_[tk], al = al_[tk];
                        const float rr = cr + (zr_[tk] - cr) * mur, kv = ck + (zk_[tk] - ck) * muk, vv = cv + (zv_[tk] - cv) * muv;
                        const float dc = __builtin_amdgcn_exp2f(-0.87503877f * __builtin_amdgcn_rcpf(1.0f + __builtin_amdgcn_exp2f(-1.44269504f * (pw0 + wl))));
                        const float av = sigmoidf_(pa0 + al);
                        const float kkv = kv * pkk;
                        const float km = kv * (1.0f + (av - 1.0f) * pka);
                        float ss, bon; wave_sum2_dpp(kkv * kkv, rr * km * prk, ss, bon);
                        const float kkn = kkv * __builtin_amdgcn_rsqf(fmaxf(ss, 1e-24f));
                        st[lz] = rr; st[64 + lz] = dc; st[2 * 64 + lz] = km; st[3 * 64 + lz] = -kkn; st[4 * 64 + lz] = kkn * av; st[5 * 64 + lz] = vv;
                        VBo[row * 512 + c] = f2bf(bon * vv);
                    }
                }
                {
                const unsigned sq0 = (unsigned)(uintptr_t)sw, va0 = sq0 + 4u * (unsigned)lz;
                f32x4 X0[4], X1[4], X2[4]; float vin;
                DSRV(vin, va0, 1280);
                DSR4(X2, sq0, 896, 912, 928, 944);
                DSR4(X0, sq0, 768, 784, 800, 816);
                DSR4(X1, sq0, 832, 848, 864, 880);
#pragma unroll 1
                for (int tk = 0; tk < TB; ++tk) {
                    f32x2 sa0 = {0.f, 0.f}, sa1 = {0.f, 0.f}, sp0 = {0.f, 0.f}, sp1 = {0.f, 0.f};
                    f32x2 y0 = {0.f, 0.f}, y1 = {0.f, 0.f}, p0 = {0.f, 0.f}, p1 = {0.f, 0.f};
                    f32x2 sav, spv;
                    const unsigned sqa = sq0 + 1536u * (unsigned)tk, vna = va0 + 1536u * (unsigned)tk;
                    DSWV(X0, vin, 4);
                    const f32x2 vv2 = {vin, vin};
                    SCAN_A(X0, 0);
                    DSR4(X0, sqa, 960, 976, 992, 1008);
                    DSW(X1, 4);
                    SCAN_A(X1, 1);
                    DSR4(X1, sqa, 256, 1024, 512, 0);
                    DSW(X2, 8);
                    SCAN_A(X2, 2);
                    DSR4(X2, sqa, 272, 1040, 528, 16);
                    DSW(X0, 8);
                    SCAN_A(X0, 3);
                    { const float sa = (sa0.x + sa0.y) + (sa1.x + sa1.y), sp = (sp0.x + sp0.y) + (sp1.x + sp1.y); sav = (f32x2){sa, sa}; spv = (f32x2){sp, sp}; }
                    DSR4(X0, sqa, 288, 1056, 544, 32);
                    DSW(X1, 8);
                    SCAN_B(X1, 0);
                    DSR4(X1, sqa, 304, 1072, 560, 48);
                    DSW(X2, 8);
                    SCAN_B(X2, 1);
                    DSR4(X2, sqa, 320, 1088, 576, 64);
                    DSW(X0, 8);
                    SCAN_B(X0, 2);
                    DSR4(X0, sqa, 336, 1104, 592, 80);
                    DSW(X1, 8);
                    SCAN_B(X1, 3);
                    DSR4(X1, sqa, 352, 1120, 608, 96);
                    DSW(X2, 8);
                    SCAN_B(X2, 4);
                    DSR4(X2, sqa, 368, 1136, 624, 112);
                    DSW(X0, 8);
                    SCAN_B(X0, 5);
                    DSR4(X0, sqa, 384, 1152, 640, 128);
                    DSW(X1, 8);
                    SCAN_B(X1, 6);
                    DSR4(X1, sqa, 400, 1168, 656, 144);
                    DSW(X2, 8);
                    SCAN_B(X2, 7);
                    DSR4(X2, sqa, 416, 1184, 672, 160);
                    DSW(X0, 8);
                    SCAN_B(X0, 8);
                    DSR4(X0, sqa, 432, 1200, 688, 176);
                    DSW(X1, 8);
                    SCAN_B(X1, 9);
                    DSR4(X1, sqa, 448, 1216, 704, 192);
                    DSW(X2, 8);
                    SCAN_B(X2, 10);
                    DSR4(X2, sqa, 464, 1232, 720, 208);
                    DSW(X0, 8);
                    SCAN_B(X0, 11);
                    DSR4(X0, sqa, 480, 1248, 736, 224);
                    DSW(X1, 8);
                    SCAN_B(X1, 12);
                    DSR4(X1, sqa, 496, 1264, 752, 240);
                    DSW(X2, 8);
                    SCAN_B(X2, 13);
                    {
                        const unsigned nx = (tk + 1 < TB) ? 1536u : 0u, sqn = sqa + nx, vnn = vna + nx;
                        DSRV(vin, vnn, 1280);
                        DSR4(X2, sqn, 896, 912, 928, 944);
                        DSW(X0, 9);
                        SCAN_B(X0, 14);
                        DSR4(X0, sqn, 768, 784, 800, 816);
                        DSW(X1, 9);
                        SCAN_B(X1, 15);
                        DSR4(X1, sqn, 832, 848, 864, 880);
                    }
                    const size_t row = (size_t)b * S_ + ts + tk;
                    Yo[row * 512 + 64 * wid + lz] = f2bf((y0.x + y0.y) + (y1.x + y1.y));
                    Po[row * 512 + 64 * wid + lz] = f2bf((p0.x + p0.y) + (p1.x + p1.y));
                }
                asm volatile("s_waitcnt lgkmcnt(0)" : "+v"(X0[0]), "+v"(X0[1]), "+v"(X0[2]), "+v"(X0[3]), "+v"(X1[0]), "+v"(X1[1]), "+v"(X1[2]), "+v"(X1[3]),
                             "+v"(X2[0]), "+v"(X2[1]), "+v"(X2[2]), "+v"(X2[3]), "+v"(vin));
                }
            }
        }
        {
            int lq = threadIdx.x; asm volatile("" : "+v"(lq)); lq &= 63;
            float* sg = SEGp + ((size_t)((b * 8 + wid) * NSEG + seg)) * 8192 + lq * 64;
#pragma unroll
            for (int j = 0; j < 32; j += 2) { *(f32x4*)(sg + 2 * j) = (f32x4){Pm2[j].x, Pm2[j].y, Pm2[j + 1].x, Pm2[j + 1].y};
                *(f32x4*)(sg + 4096 + 2 * j) = (f32x4){S2[j].x, S2[j].y, S2[j + 1].x, S2[j + 1].y}; }
        }
    }
}

__device__ __forceinline__ void ph_comb(const Params& P, LAS unsigned char* lds) {
    LAS float* SI = (LAS float*)lds;
    LAS float* PB = (LAS float*)(lds + 20480);
    float* SEGp = (float*)(P.ws + OFF_SEG);
    const int tid = opaque_tid(), wid = __builtin_amdgcn_readfirstlane(tid >> 6), lane = tid & 63, m = lane & 31, hh = lane >> 5;
    for (int chain = blockIdx.x; chain < 64; chain += gridDim.x) {
        float* base = SEGp + (size_t)chain * NSEG * 8192;
        __syncthreads();
        for (int i = tid; i < 4096; i += NTHR) SI[(i >> 6) * 65 + (i & 63)] = base[4096 + i];
        { const f32x4 a = *(const f32x4*)(base + 8192 + tid * 8), c = *(const f32x4*)(base + 8192 + tid * 8 + 4);
          *(LAS f32x4*)(PB + 4096 + tid * 8) = a; *(LAS f32x4*)(PB + 4096 + tid * 8 + 4) = c; }
        __syncthreads();
        const int ti = (wid >> 1) & 1, tj = wid & 1;
        for (int k = 1; k <= NSEG - 2; ++k) {
            float* Q = base + (size_t)k * 8192 + 4096;
            const LAS float* Pb = PB + (k & 1) * 4096;
            f32x4 na = {0.f, 0.f, 0.f, 0.f}, nc = na;
            if (k + 1 <= NSEG - 2) { const float* pn = base + (size_t)(k + 1) * 8192 + tid * 8; na = *(const f32x4*)pn; nc = *(const f32x4*)(pn + 4); }
            f32x16 Dv;
            if (wid < 4) {
                float qv[16];
#pragma unroll
                for (int r = 0; r < 16; ++r) { const int row = 32 * ti + (r & 3) + 8 * (r >> 2) + 4 * hh; qv[r] = Q[row * 64 + 32 * tj + m]; Dv[r] = 0.f; }
#pragma unroll
                for (int kk = 0; kk < 32; ++kk) { const float a = SI[(32 * ti + m) * 65 + 2 * kk + hh], bq = Pb[(2 * kk + hh) * 64 + 32 * tj + m];
                    Dv = __builtin_amdgcn_mfma_f32_32x32x2f32(a, bq, Dv, 0, 0, 0); }
#pragma unroll
                for (int r = 0; r < 16; ++r) Dv[r] += qv[r];
            }
            __syncthreads();
            if (wid < 4) {
#pragma unroll
                for (int r = 0; r < 16; ++r) { const int row = 32 * ti + (r & 3) + 8 * (r >> 2) + 4 * hh; SI[row * 65 + 32 * tj + m] = Dv[r]; Q[row * 64 + 32 * tj + m] = Dv[r]; }
            }
            if (k + 1 <= NSEG - 2) { LAS float* pd = PB + ((k + 1) & 1) * 4096 + tid * 8; *(LAS f32x4*)pd = na; *(LAS f32x4*)(pd + 4) = nc; }
            __syncthreads();
        }
    }
}

__device__ __forceinline__ void ph_post(const Params& P, int l) {
    const bf16_t* Yo = (const bf16_t*)(P.ws + OFF_Y); const bf16_t* Po = (const bf16_t*)(P.ws + OFF_P); const bf16_t* Go = (const bf16_t*)(P.ws + OFF_G);
    const bf16_t* VBo = (const bf16_t*)(P.ws + OFF_VB); const float* SEGp = (const float*)(P.ws + OFF_SEG); bf16_t* OR = (bf16_t*)(P.ws + OFF_ORWKV);
    const int tid = opaque_tid(), wid = __builtin_amdgcn_readfirstlane(tid >> 6), lane = tid & 63, m = lane & 31, hh = lane >> 5;
    for (int blk = blockIdx.x; blk < NB_ * NSEG; blk += gridDim.x) {
        const int b = blk / NSEG, seg = blk % NSEG, tbeg = seg * SEGL;
        bf16x8 SIf[2][4];
        if (seg > 0) {
            const float* sg = SEGp + ((size_t)((b * 8 + wid) * NSEG + seg - 1)) * 8192 + 4096;
#pragma unroll
            for (int ib = 0; ib < 2; ++ib)
#pragma unroll
                for (int ks = 0; ks < 4; ++ks) { const float* sp = sg + (32 * ib + m) * 64 + 16 * ks + 8 * hh; const f32x4 a = *(const f32x4*)sp, c = *(const f32x4*)(sp + 4);
                    u32x4 w; w.x = cvt_pk_bf16(a[0], a[1]); w.y = cvt_pk_bf16(a[2], a[3]); w.z = cvt_pk_bf16(c[0], c[1]); w.w = cvt_pk_bf16(c[2], c[3]); SIf[ib][ks] = __builtin_bit_cast(bf16x8, w); }
        }
        float lnw[32], lnb[32];
#pragma unroll
        for (int q = 0; q < 32; ++q) { const int ch = 64 * wid + 32 * (q >> 4) + (q & 3) + 8 * ((q & 15) >> 2) + 4 * hh; lnw[q] = P.ln_w[l * 512 + ch]; lnb[q] = P.ln_b[l * 512 + ch]; }
#pragma unroll 1
        for (int c = 0; c < SEGL / 32; ++c) {
            const size_t row = (size_t)b * S_ + tbeg + 32 * c + m;
            f32x16 D[2];
#pragma unroll
            for (int r = 0; r < 16; ++r) { D[0][r] = 0.f; D[1][r] = 0.f; }
            if (seg > 0) {
                const bf16_t* pp = Po + row * 512 + 64 * wid + 8 * hh;
#pragma unroll
                for (int ks = 0; ks < 4; ++ks) { const bf16x8 Pf = *(const bf16x8*)(pp + 16 * ks);
                    D[0] = __builtin_amdgcn_mfma_f32_32x32x16_bf16(SIf[0][ks], Pf, D[0], 0, 0, 0); D[1] = __builtin_amdgcn_mfma_f32_32x32x16_bf16(SIf[1][ks], Pf, D[1], 0, 0, 0); }
            }
            float y[32]; float s = 0.f;
#pragma unroll
            for (int ib = 0; ib < 2; ++ib)
#pragma unroll
                for (int g = 0; g < 4; ++g) { const u32x2 yw = *(const u32x2*)(Yo + row * 512 + 64 * wid + 32 * ib + 8 * g + 4 * hh);
                    y[16 * ib + 4 * g + 0] = bflo(yw.x) + D[ib][4 * g + 0]; y[16 * ib + 4 * g + 1] = bfhi(yw.x) + D[ib][4 * g + 1];
                    y[16 * ib + 4 * g + 2] = bflo(yw.y) + D[ib][4 * g + 2]; y[16 * ib + 4 * g + 3] = bfhi(yw.y) + D[ib][4 * g + 3]; }
#pragma unroll
            for (int q = 0; q < 32; ++q) s += y[q];
            s += shx(s, 32, lane);
            const float mean = s * (1.0f / 64.0f); float qv = 0.f;
#pragma unroll
            for (int q = 0; q < 32; ++q) { y[q] -= mean; qv += y[q] * y[q]; }
            qv += shx(qv, 32, lane);
            const float rstd = rsqrtf(qv * (1.0f / 64.0f) + 64e-5f);
#pragma unroll
            for (int ib = 0; ib < 2; ++ib)
#pragma unroll
                for (int g = 0; g < 4; ++g) { const size_t off = row * 512 + 64 * wid + 32 * ib + 8 * g + 4 * hh;
                    const u32x2 vw = *(const u32x2*)(VBo + off), gw = *(const u32x2*)(Go + off); const int q = 16 * ib + 4 * g;
                    const float o0 = (y[q] * rstd * lnw[q] + lnb[q] + bflo(vw.x)) * bflo(gw.x), o1 = (y[q + 1] * rstd * lnw[q + 1] + lnb[q + 1] + bfhi(vw.x)) * bfhi(gw.x);
                    const float o2 = (y[q + 2] * rstd * lnw[q + 2] + lnb[q + 2] + bflo(vw.y)) * bflo(gw.y), o3 = (y[q + 3] * rstd * lnw[q + 3] + lnb[q + 3] + bfhi(vw.y)) * bfhi(gw.y);
                    u32x2 w; w.x = cvt_pk_bf16(o0, o1); w.y = cvt_pk_bf16(o2, o3); *(u32x2*)(OR + off) = w; }
        }
    }
}

enum { PH_PRO = 0, PH_NORM1, PH_ZQ, PH_IDX, PH_ATT, PH_ZR, PH_SCAN, PH_COMB, PH_POST, PH_ZC, PH_CONV, PH_MERGE, PH_WO, PH_NORM2, PH_UP, PH_U, PH_DOWN, PH_FINAL, PH_COUNT };

template <int PH>
__device__ __forceinline__ void run_phase(const Params& P0, int l, LAS unsigned char* lds) {
    Params P = P0; P.ws = opaque_ptr(P0.ws);
    if constexpr (PH == PH_PRO) { if (l == 0) ph_mod(P, lds); ph_wconv(P, l, lds); }
    if constexpr (PH == PH_NORM1) ph_norm(P, l, 0);
    if constexpr (PH == PH_ZQ) ph_gemm_zq(P, lds);
    if constexpr (PH == PH_IDX) ph_idx(P, lds);
    if constexpr (PH == PH_ATT) ph_att(P, lds);
    if constexpr (PH == PH_ZR) ph_gemm_zr(P, lds);
    if constexpr (PH == PH_SCAN) ph_scan(P, l, lds);
    if constexpr (PH == PH_COMB) ph_comb(P, lds);
    if constexpr (PH == PH_POST) ph_post(P, l);
    if constexpr (PH == PH_ZC) ph_gemm_zc(P, lds);
    if constexpr (PH == PH_CONV) ph_conv(P, l, lds);
    if constexpr (PH == PH_MERGE) ph_gemm_merge(P, lds);
    if constexpr (PH == PH_WO) ph_gemm_wo(P, l, lds);
    if constexpr (PH == PH_NORM2) ph_norm(P, l, 1);
    if constexpr (PH == PH_UP) ph_gemm_up(P, l, lds);
    if constexpr (PH == PH_U) ph_ufix(P, l, lds);
    if constexpr (PH == PH_DOWN) ph_gemm_down(P, l, lds);
    if constexpr (PH == PH_FINAL) ph_final(P);
}

#if MK_SINGLE
__global__ void __launch_bounds__(NTHR, 2) k_mega(Params P) {
    extern __shared__ __attribute__((aligned(16))) unsigned char shm[];
    LAS unsigned char* lds = (LAS unsigned char*)shm;
    LAS unsigned* xbw = (LAS unsigned*)(lds + LDS_BYTES - 16);
    if (threadIdx.x == 0) { xbw[0] = 0u; xbw[1] = 0u; xbw[2] = 0u; xbw[3] = 0u; }
    __syncthreads();
    XcdBarrier bar = xcd_barrier_post((unsigned*)(P.ws + OFF_BAR), (volatile LAS unsigned*)xbw);
#ifndef PROBE_PH
#define PROBE_PH (-1)
#endif
#ifndef PROBE_N
#define PROBE_N 4
#endif
#define PHASE(PH, l) do { unsigned long long t0_ = 0; if (PROBE_PH == PH && blockIdx.x == 0) t0_ = wall_clock64(); \
        run_phase<PH>(P, l, lds); xcd_barrier(bar); \
        if (PROBE_PH == PH && blockIdx.x == 0) { const unsigned long long t1_ = wall_clock64(), d_ = (t1_ - t0_) * PROBE_N; while (wall_clock64() - t1_ < d_) __builtin_amdgcn_s_sleep(8); } } while (0)
#pragma unroll 1
    for (int l = 0; l < 2; ++l) {
        PHASE(PH_PRO, l); PHASE(PH_NORM1, l); PHASE(PH_ZQ, l); PHASE(PH_IDX, l); PHASE(PH_ATT, l); PHASE(PH_ZR, l); PHASE(PH_SCAN, l); PHASE(PH_COMB, l); PHASE(PH_POST, l);
        PHASE(PH_ZC, l); PHASE(PH_CONV, l); PHASE(PH_MERGE, l); PHASE(PH_WO, l); PHASE(PH_NORM2, l); PHASE(PH_UP, l); PHASE(PH_U, l); PHASE(PH_DOWN, l);
    }
    run_phase<PH_FINAL>(P, 0, lds);
#undef PHASE
}
#else
template <int PH>
__global__ void __launch_bounds__(NTHR, 2) k_phase(Params P, int l) {
    extern __shared__ __attribute__((aligned(16))) unsigned char shm[];
    run_phase<PH>(P, l, (LAS unsigned char*)shm);
}
template <int PH> static void launch_phase(const Params& P, int l, hipStream_t stream) {
    static bool attr = false;
    if (!attr) { hipFuncSetAttribute((const void*)k_phase<PH>, hipFuncAttributeMaxDynamicSharedMemorySize, LDS_BYTES); attr = true; }
    hipLaunchKernelGGL(k_phase<PH>, dim3(NBLK), dim3(NTHR), LDS_BYTES, stream, P, l);
}
#endif

extern "C" void kernel_launch(void* const* d_in, const int* in_sizes, int n_in, void* d_out, int out_size, void* d_ws, size_t ws_size, hipStream_t stream) {
    (void)in_sizes; (void)n_in; (void)out_size; (void)ws_size;
    Params P{};
    P.x_in = (const float*)d_in[0]; P.c = (const float*)d_in[1]; P.pos = (const int*)d_in[2]; P.rel_bias = (const float*)d_in[3]; P.final_norm = (const float*)d_in[4];
    P.ada_w = (const float*)d_in[5]; P.ada_b = (const float*)d_in[6]; P.norm_mix = (const float*)d_in[7]; P.w_in = (const float*)d_in[8];
    P.mu = (const float*)d_in[9]; P.w0 = (const float*)d_in[10]; P.w_up = (const float*)d_in[11]; P.a0 = (const float*)d_in[12]; P.a_up = (const float*)d_in[13]; P.g_up = (const float*)d_in[14];
    P.k_k = (const float*)d_in[15]; P.k_a = (const float*)d_in[16]; P.r_k = (const float*)d_in[17]; P.ln_w = (const float*)d_in[18]; P.ln_b = (const float*)d_in[19];
    P.sc_conv_w = (const float*)d_in[20]; P.w_branch = (const float*)d_in[21]; P.w_o = (const float*)d_in[22]; P.norm_ffn = (const float*)d_in[23];
    P.ffn_w_up = (const float*)d_in[24]; P.ffn_conv_w = (const float*)d_in[25]; P.ffn_w_down = (const float*)d_in[26];
    P.out = (float*)d_out; P.ws = (unsigned char*)d_ws;
#if MK_SINGLE
    static bool attr = false;
    if (!attr) { hipFuncSetAttribute((const void*)k_mega, hipFuncAttributeMaxDynamicSharedMemorySize, LDS_BYTES); attr = true; }
    hipMemsetAsync((unsigned char*)d_ws + OFF_BAR, 0, XCD_BAR_WORDS * sizeof(unsigned), stream);
    hipLaunchKernelGGL(k_mega, dim3(NBLK), dim3(NTHR), LDS_BYTES, stream, P);
#else
    for (int l = 0; l < 2; ++l) {
        launch_phase<PH_PRO>(P, l, stream); launch_phase<PH_NORM1>(P, l, stream); launch_phase<PH_ZQ>(P, l, stream); launch_phase<PH_IDX>(P, l, stream);
        launch_phase<PH_ATT>(P, l, stream); launch_phase<PH_ZR>(P, l, stream); launch_phase<PH_SCAN>(P, l, stream); launch_phase<PH_COMB>(P, l, stream);
        launch_phase<PH_POST>(P, l, stream); launch_phase<PH_ZC>(P, l, stream); launch_phase<PH_CONV>(P, l, stream); launch_phase<PH_MERGE>(P, l, stream);
        launch_phase<PH_WO>(P, l, stream); launch_phase<PH_NORM2>(P, l, stream); launch_phase<PH_UP>(P, l, stream); launch_phase<PH_U>(P, l, stream);
        launch_phase<PH_DOWN>(P, l, stream);
    }
    launch_phase<PH_FINAL>(P, 0, stream);
#endif
}
```

```cpp
#include <hip/hip_runtime.h>
#include <stdint.h>

#ifndef MK_SINGLE
#define MK_SINGLE 1
#endif

#define LAS __attribute__((address_space(3)))
typedef unsigned short bf16_t;
typedef short bf16x8 __attribute__((ext_vector_type(8)));
typedef short bf16x4 __attribute__((ext_vector_type(4)));
typedef float f32x4 __attribute__((ext_vector_type(4)));
typedef float f32x16 __attribute__((ext_vector_type(16)));
typedef float f32x2 __attribute__((ext_vector_type(2)));
typedef unsigned u32x4 __attribute__((ext_vector_type(4)));
typedef unsigned u32x2 __attribute__((ext_vector_type(2)));
typedef int i32x4 __attribute__((ext_vector_type(4)));
typedef unsigned long long u64;
typedef unsigned long long u64x2 __attribute__((ext_vector_type(2)));

constexpr int T_ = 32768, D_ = 1024, NB_ = 8, S_ = 4096;
constexpr int NSEG = 32, SEGL = 128, TB = 8;
constexpr int NBLK = 256, NTHR = 512;
constexpr int IN_COLS = 8520, DFF = 2816;
constexpr int LDS_BYTES = 150 * 1024;

constexpr size_t MiB = 1ull << 20;
constexpr size_t OFF_BAR = 0;
constexpr size_t OFF_MOD = 64 * 1024;
constexpr size_t OFF_TAB = 512 * 1024;
constexpr size_t OFF_KPM = 520 * 1024;
constexpr size_t OFF_WB = 2 * MiB;
constexpr size_t WB_WIN = 0;
constexpr size_t WB_WBR = WB_WIN + (size_t)8704 * 1024 * 2;
constexpr size_t WB_WO = WB_WBR + (size_t)3 * 1024 * 512 * 2;
constexpr size_t WB_WUP = WB_WO + (size_t)1024 * 1024 * 2;
constexpr size_t WB_WDN = WB_WUP + (size_t)5632 * 1024 * 2;
constexpr size_t WB_LW = WB_WDN + (size_t)1024 * 2816 * 2;
constexpr size_t WB_LA = WB_LW + (size_t)512 * 64 * 2;
constexpr size_t WB_LG = WB_LA + (size_t)512 * 64 * 2;
constexpr size_t OFF_H = 42 * MiB;
constexpr size_t OFF_ZQ = 106 * MiB;
constexpr size_t OFF_MASK = 250 * MiB;
constexpr size_t OFF_VT = 266 * MiB;
constexpr size_t OFF_ZR = 106 * MiB;
constexpr size_t OFF_Y = 218 * MiB;
constexpr size_t OFF_P = 250 * MiB;
constexpr size_t OFF_G = 282 * MiB;
constexpr size_t OFF_SEG = 314 * MiB;
constexpr size_t OFF_ZCV = 106 * MiB;
constexpr size_t OFF_ZG = 202 * MiB;
constexpr size_t OFF_MRG = 106 * MiB;
constexpr size_t OFF_UP = 106 * MiB;
constexpr size_t OFF_HA = 300 * MiB;
constexpr size_t OFF_HB = 320 * MiB;
constexpr size_t OFF_OCONV = 416 * MiB;
constexpr size_t OFF_ORWKV = 448 * MiB;
constexpr size_t OFF_OATT = 480 * MiB;
constexpr size_t OFF_VB = OFF_ORWKV;
constexpr size_t OFF_SCR = 378 * MiB;

struct Params {
    const float* x_in; const float* c; const int* pos; const float* rel_bias; const float* final_norm;
    const float* ada_w; const float* ada_b; const float* norm_mix; const float* w_in;
    const float* mu; const float* w0; const float* w_up; const float* a0; const float* a_up; const float* g_up;
    const float* k_k; const float* k_a; const float* r_k; const float* ln_w; const float* ln_b;
    const float* sc_conv_w; const float* w_branch; const float* w_o; const float* norm_ffn;
    const float* ffn_w_up; const float* ffn_conv_w; const float* ffn_w_down;
    float* out; unsigned char* ws;
};

__device__ __forceinline__ float bf2f(bf16_t b) { return __uint_as_float(((unsigned)b) << 16); }
__device__ __forceinline__ bf16_t f2bf(float f) { unsigned u = __float_as_uint(f); u += 0x7FFFu + ((u >> 16) & 1u); return (bf16_t)(u >> 16); }
typedef __bf16 bf16x2_t __attribute__((ext_vector_type(2)));
__device__ __forceinline__ unsigned cvt_pk_bf16(float lo, float hi) { const f32x2 v = {lo, hi}; return __builtin_bit_cast(unsigned, __builtin_convertvector(v, bf16x2_t)); }
__device__ __forceinline__ float bflo(unsigned w) { return __uint_as_float(w << 16); }
__device__ __forceinline__ float bfhi(unsigned w) { return __uint_as_float(w & 0xffff0000u); }
__device__ __forceinline__ float shx(float v, int mask, int lane) { return __int_as_float(__builtin_amdgcn_ds_bpermute((lane ^ mask) << 2, __float_as_int(v))); }
__device__ __forceinline__ int shxi(int v, int mask, int lane) { return __builtin_amdgcn_ds_bpermute((lane ^ mask) << 2, v); }
__device__ __forceinline__ float wave_sum(float v, int lane) {
#pragma unroll
    for (int o = 32; o >= 1; o >>= 1) v += shx(v, o, lane);
    return v;
}
__device__ __forceinline__ void writelane_c2(int& vlo, int& vhi, int lo, int hi, int ln  ) {
    asm("s_nop 3\n\tv_writelane_b32 %0, %2, %4\n\tv_writelane_b32 %1, %3, %4" : "+v"(vlo), "+v"(vhi) : "s"(lo), "s"(hi), "n"(ln)); }
__device__ __forceinline__ int writelane_v(int vec, int val, int ln  ) { asm("s_mov_b32 m0, %2\n\ts_nop 3\n\tv_writelane_b32 %0, %1, m0" : "+v"(vec) : "s"(val), "s"(ln) : "m0"); return vec; }
__device__ __forceinline__ float sigmoidf_(float x) { return __builtin_amdgcn_rcpf(1.0f + __expf(-x)); }
__device__ __forceinline__ unsigned f2ord(float x) { unsigned u = __float_as_uint(x); return (u & 0x80000000u) ? ~u : (u | 0x80000000u); }
__device__ __forceinline__ float ord2f(unsigned k) { return __uint_as_float((k & 0x80000000u) ? (k & 0x7fffffffu) : ~k); }

__device__ __forceinline__ int opaque_tid() { int t = threadIdx.x; asm volatile("" : "+v"(t)); return t; }
__device__ __forceinline__ unsigned char* opaque_ptr(unsigned char* p) {
    typedef __attribute__((address_space(1))) unsigned char* gptr_t;
    gptr_t g = (gptr_t)p; asm volatile("" : "+s"(g)); return (unsigned char*)g; }

#define XB_TMO      128
#define XB_XCNT(j)  (256  + 64 * (j))
#define XB_XSUB(j)  (1280 + 64 * (j))
#define XB_XGEN(j)  (2304 + 64 * (j))
#define XB_TOP      3328
#define XB_TOPGEN   3392
#define XCD_BAR_WORDS 3456
#define XB_SPIN_CAP (1u << 22)

__device__ __forceinline__ unsigned xb_ld(unsigned* p)              { return __hip_atomic_load(p, __ATOMIC_RELAXED, __HIP_MEMORY_SCOPE_AGENT); }
__device__ __forceinline__ unsigned xb_add(unsigned* p, unsigned v) { return __hip_atomic_fetch_add(p, v, __ATOMIC_RELAXED, __HIP_MEMORY_SCOPE_AGENT); }
__device__ __forceinline__ unsigned xb_xcc_id() { return (unsigned)__builtin_amdgcn_s_getreg((3 << 11) | 20) & 0xFu; }
#define XB_SPIN(cond, bar) do { unsigned _sp = 0; while (cond) { __builtin_amdgcn_s_sleep(1); \
    if ((++_sp & 255u) == 0u) { if (xb_ld(&(bar)[XB_TMO])) break; if (_sp > XB_SPIN_CAP) { atomicAdd(&(bar)[XB_TMO], 1u); break; } } } } while (0)

struct XcdBarrier { unsigned* bar; unsigned x; volatile LAS unsigned* st; };

__device__ __forceinline__ XcdBarrier xcd_barrier_post(unsigned* bar, volatile LAS unsigned* st) {
    XcdBarrier b; b.bar = bar; b.x = xb_xcc_id(); b.st = st;
    if (threadIdx.x == 0) (void)xb_add(&bar[XB_XCNT(b.x)], 1u);
    return b;
}
__device__ __forceinline__ void xcd_barrier_complete(unsigned* bar, unsigned x, unsigned& nloc, unsigned& nx) {
    const unsigned G = gridDim.x * gridDim.y * gridDim.z;
    unsigned sum, cnt, mine, sp = 0u;
    for (;;) {
        sum = 0u; cnt = 0u; mine = 0u;
#pragma unroll
        for (unsigned j = 0; j < 16; ++j) { const unsigned c = xb_ld(&bar[XB_XCNT(j)]); sum += c; cnt += (c > 0u) ? 1u : 0u; mine = (j == x) ? c : mine; }
        if (sum == G) break;
        __builtin_amdgcn_s_sleep(1);
        if ((++sp & 255u) == 0u) { if (xb_ld(&bar[XB_TMO])) break; if (sp > XB_SPIN_CAP) { atomicAdd(&bar[XB_TMO], 1u); break; } }
    }
    nloc = mine > 0u ? mine : 1u; nx = cnt > 0u ? cnt : 1u;
}
__device__ __forceinline__ void xcd_barrier(const XcdBarrier& b) {
    asm volatile("s_waitcnt vmcnt(0)" ::: "memory");
    __syncthreads();
    if (threadIdx.x == 0) {
        unsigned* bar = b.bar;
        __builtin_amdgcn_s_waitcnt(0);
        unsigned nloc = b.st[0], nx = b.st[1];
        if (nloc == 0u) { xcd_barrier_complete(bar, b.x, nloc, nx); b.st[0] = nloc; b.st[1] = nx; }
        const unsigned old = xb_add(&bar[XB_XSUB(b.x)], 1u);
        const unsigned gen = old / nloc;
        if (old + 1u == (gen + 1u) * nloc) {
            __builtin_amdgcn_fence(__ATOMIC_RELEASE, "agent");
            asm volatile("s_waitcnt vmcnt(0)" ::: "memory");
            const unsigned og = xb_add(&bar[XB_TOP], 1u);
            const unsigned tg = og / nx;
            if (og + 1u == (tg + 1u) * nx) xb_add(&bar[XB_TOPGEN], 1u);
            else XB_SPIN(xb_ld(&bar[XB_TOPGEN]) == tg, bar);
            __builtin_amdgcn_fence(__ATOMIC_ACQUIRE, "agent");
            xb_add(&bar[XB_XGEN(b.x)], 1u);
            asm volatile("s_waitcnt vmcnt(0)" ::: "memory");
        } else {
            XB_SPIN(xb_ld(&bar[XB_XGEN(b.x)]) == gen, bar);
            __builtin_amdgcn_fence(__ATOMIC_ACQUIRE, "agent");
            asm volatile("s_waitcnt vmcnt(0)" ::: "memory");
        }
    }
    __syncthreads();
}

namespace g8 {
constexpr int BM = 256, BK = 64, HALF = 128, HTB = HALF * BK * 2, STAGE_BYTES = 8 * HTB, NXCD = 8, WGM = 8;
__device__ __forceinline__ int lds_byte(int r, int c) { const int st = (r >> 4) * 2 + (c >> 5), rr = r & 15, cc = c & 31, ob = rr * 64 + cc * 2; return st * 1024 + (ob ^ (((ob >> 9) & 1) << 5)); }
__device__ __forceinline__ void stage_rc(int b, int& R, int& C) { const int st = b / 1024, sb = b % 1024, swz = sb ^ (((sb >> 9) & 1) << 5); R = (st >> 1) * 16 + swz / 64; C = (st & 1) * 32 + (swz % 64) / 2; }
__device__ __forceinline__ int perm32(int rho) { const int n = rho >> 4, i = rho & 15; return 8 * (i >> 2) + 4 * n + (i & 3); }

struct Unit { const char* A; const char* B; int pm, pn, tag; };

struct SOrder {
    int nM, nN, nwg, G, c; const char* A; const char* Bt; size_t a_t, b_t;
    __device__ void init(int M, int N, int lda, int ldb, const void* A_, const void* Bt_) {
        nM = M / BM; nN = N / BM; nwg = nM * nN; G = (int)gridDim.x; c = (int)blockIdx.x; A = (const char*)A_; Bt = (const char*)Bt_;
        a_t = (size_t)BM * lda * 2; b_t = (size_t)BM * ldb * 2; }
    __device__ bool next(int i, Unit& u) const {
        const long L = (long)i * G + c; if (L >= nwg) return false;
        int wgid = (int)L; { const int q = nwg / NXCD, r = nwg % NXCD, xcd = wgid % NXCD, off = wgid / NXCD; wgid = (xcd < r ? xcd * (q + 1) : r * (q + 1) + (xcd - r) * q) + off; }
        const int nig = WGM * nN, gid = wgid / nig, fm = gid * WGM, gsz = (nM - fm) < WGM ? (nM - fm) : WGM;
        u.pm = fm + ((wgid % nig) % gsz); u.pn = (wgid % nig) / gsz; u.tag = 0;
        u.A = A + (size_t)u.pm * a_t; u.B = Bt + (size_t)u.pn * b_t; return true;
    }
};

template <class Epi, class Sched>
__device__ __forceinline__ void gemm_phase(LAS unsigned char* lds, const int K, const int lda, const int ldb, const Sched& S, const Epi& E) {
    const int tid = opaque_tid(), wid = __builtin_amdgcn_readfirstlane(tid >> 6), lane = tid & 63, wr = wid >> 2, wc = wid & 3, fr = lane & 15, fq = lane >> 4;
    const int nt = K / BK;
    unsigned voffA[2], voffB[2];
#pragma unroll
    for (int i = 0; i < 2; ++i) { int R, C; stage_rc(tid * 16 + i * 8192, R, C); const int Rb = Epi::PERM ? ((R & ~31) + perm32(R & 31)) : R;
        voffA[i] = (unsigned)(R * lda + C) * 2u; voffB[i] = (unsigned)(Rb * ldb + C) * 2u; }
    const size_t kstep = (size_t)(BK * 2);
    const size_t hstepA = (size_t)HALF * lda * 2, hstepB = (size_t)HALF * ldb * 2;
    const unsigned ldsw = (unsigned)wid * 1024u;
    const int aoff = lds_byte(wr * 64 + fr, fq * 8), boff = lds_byte(wc * 32 + fr, fq * 8);
#define PG8_SA(b, h) (((b) * 2 + (h)) * HTB)
#define PG8_SB(b, h) ((4 + (b) * 2 + (h)) * HTB)
#define PG8_STAGE(bufoff, gbase, voff) do { _Pragma("unroll") for (int _i = 0; _i < 2; ++_i) \
        __builtin_amdgcn_global_load_lds((const unsigned*)((const char*)(gbase) + (voff)[_i]), (LAS unsigned*)(lds + (bufoff) + ldsw + _i * 8192), 16, 0, 0); } while (0)
#define PG8_LDA(dst, b, h) do { _Pragma("unroll") for (int m = 0; m < 4; ++m) _Pragma("unroll") for (int k = 0; k < 2; ++k) dst[m][k] = *(const LAS bf16x8*)(lds + PG8_SA(b, h) + aoff + m * 2048 + k * 1024); } while (0)
#define PG8_LDB(dst, b, h) do { _Pragma("unroll") for (int n = 0; n < 2; ++n) _Pragma("unroll") for (int k = 0; k < 2; ++k) dst[n][k] = *(const LAS bf16x8*)(lds + PG8_SB(b, h) + boff + n * 2048 + k * 1024); } while (0)
#define PG8_MMA(ai, bj, At, Bt) do { __builtin_amdgcn_s_setprio(1); _Pragma("unroll") for (int m = 0; m < 4; ++m) _Pragma("unroll") for (int n = 0; n < 2; ++n) _Pragma("unroll") for (int k = 0; k < 2; ++k) \
        acc[ai][bj][m][n] = __builtin_amdgcn_mfma_f32_16x16x32_bf16(Bt[n][k], At[m][k], acc[ai][bj][m][n], 0, 0, 0); __builtin_amdgcn_s_setprio(0); } while (0)
#define PG8_WAIT_V(n) asm volatile("s_waitcnt vmcnt(" #n ")" ::: "memory")
#define PG8_WAIT_L(n) asm volatile("s_waitcnt lgkmcnt(" #n ")" ::: "memory")
#define PG8_BAR __builtin_amdgcn_s_barrier()
#define PG8_SCHED __builtin_amdgcn_sched_barrier(0)
    Unit cur, nxt; int ui = 0;
    if (!S.next(0, cur)) return;
    f32x4 acc[2][2][4][2];
#pragma unroll
    for (int a = 0; a < 2; ++a)
#pragma unroll
        for (int b = 0; b < 2; ++b)
#pragma unroll
            for (int m = 0; m < 4; ++m)
#pragma unroll
                for (int n = 0; n < 2; ++n) acc[a][b][m][n] = (f32x4){0.f, 0.f, 0.f, 0.f};
    bf16x8 At[4][2], B0[2][2], B1[2][2];
    const char* cA = cur.A; const char* cB = cur.B;
    PG8_STAGE(PG8_SB(0, 0), cB, voffB); PG8_STAGE(PG8_SA(0, 0), cA, voffA); PG8_STAGE(PG8_SB(0, 1), cB + hstepB, voffB); PG8_STAGE(PG8_SA(0, 1), cA + hstepA, voffA);
    if (wr == 1) PG8_BAR;
    PG8_WAIT_V(4); PG8_BAR;
    PG8_STAGE(PG8_SB(1, 0), cB + kstep, voffB); PG8_STAGE(PG8_SA(1, 0), cA + kstep, voffA); PG8_STAGE(PG8_SB(1, 1), cB + hstepB + kstep, voffB);
    PG8_WAIT_V(6); PG8_BAR;
    for (;;) {
        const bool has_next = S.next(ui + 1, nxt);
        const char* nA = has_next ? nxt.A : cA; const char* nB = has_next ? nxt.B : cB;
        for (int t = 0; t < nt; t += 2) {
            const bool last = (t == nt - 2);
            const char* a1 = cA + (size_t)(t + 1) * kstep;
            const char* a2 = last ? nA : cA + (size_t)(t + 2) * kstep; const char* b2 = last ? nB : cB + (size_t)(t + 2) * kstep;
            const char* a3 = a2 + kstep; const char* b3 = b2 + kstep;
            PG8_LDB(B0, 0, 0); PG8_SCHED; PG8_LDA(At, 0, 0); PG8_STAGE(PG8_SA(1, 1), a1 + hstepA, voffA);
            PG8_WAIT_L(8); PG8_BAR; PG8_WAIT_L(0); PG8_MMA(0, 0, At, B0); PG8_BAR; PG8_SCHED;
            PG8_LDB(B1, 0, 1); PG8_STAGE(PG8_SB(0, 0), b2, voffB);
            PG8_BAR; PG8_WAIT_L(0); PG8_MMA(0, 1, At, B1); PG8_BAR;
            PG8_LDA(At, 0, 1); PG8_STAGE(PG8_SA(0, 0), a2, voffA);
            PG8_BAR; PG8_WAIT_L(0); PG8_MMA(1, 0, At, B0); PG8_BAR; PG8_SCHED;
            PG8_STAGE(PG8_SB(0, 1), b2 + hstepB, voffB);
            PG8_WAIT_V(6); PG8_BAR; PG8_MMA(1, 1, At, B1); PG8_BAR;
            PG8_LDB(B0, 1, 0); PG8_SCHED; PG8_LDA(At, 1, 0); PG8_STAGE(PG8_SA(0, 1), a2 + hstepA, voffA);
            PG8_WAIT_L(8); PG8_BAR; PG8_WAIT_L(0); PG8_MMA(0, 0, At, B0); PG8_BAR; PG8_SCHED;
            PG8_LDB(B1, 1, 1); PG8_STAGE(PG8_SB(1, 0), b3, voffB);
            PG8_BAR; PG8_WAIT_L(0); PG8_MMA(0, 1, At, B1); PG8_BAR;
            PG8_LDA(At, 1, 1); PG8_STAGE(PG8_SA(1, 0), a3, voffA);
            PG8_BAR; PG8_WAIT_L(0); PG8_MMA(1, 0, At, B0); PG8_BAR; PG8_SCHED;
            PG8_STAGE(PG8_SB(1, 1), b3 + hstepB, voffB);
            PG8_WAIT_V(6); PG8_BAR; PG8_MMA(1, 1, At, B1); PG8_BAR;
        }
        bool keep = false;
        if constexpr (Epi::CHAIN) keep = E.chain(acc, cur, wr, wc, fr, fq); else E(acc, cur, wr, wc, fr, fq);
        if (!has_next) break;
        if (!keep) {
#pragma unroll
            for (int a = 0; a < 2; ++a)
#pragma unroll
                for (int b = 0; b < 2; ++b)
#pragma unroll
                    for (int m = 0; m < 4; ++m)
#pragma unroll
                        for (int n = 0; n < 2; ++n) acc[a][b][m][n] = (f32x4){0.f, 0.f, 0.f, 0.f};
        }
        cur = nxt; cA = nA; cB = nB; ++ui;
    }
    PG8_WAIT_V(0);
    if (wr == 0) PG8_BAR;
    PG8_BAR;
#undef PG8_SA
#undef PG8_SB
#undef PG8_STAGE
#undef PG8_LDA
#undef PG8_LDB
#undef PG8_MMA
#undef PG8_WAIT_V
#undef PG8_WAIT_L
#undef PG8_BAR
#undef PG8_SCHED
}

struct EpiBf {
    static constexpr bool PERM = true, CHAIN = false;
    bf16_t* O0; int ld0; int split; bf16_t* O1; int ld1; int act1;
    __device__ __forceinline__ void operator()(const f32x4 (&acc)[2][2][4][2], const Unit& u, int wr, int wc, int fr, int fq) const {
        const bool second = u.pn >= split;
        bf16_t* base = second ? O1 : O0; const int ld = second ? ld1 : ld0; const int colt = (second ? (u.pn - split) : u.pn) * BM;
        const bool act = second && act1;
        const int row0 = u.pm * BM + wr * 64 + fr, col0 = colt + wc * 32 + 8 * fq;
#pragma unroll
        for (int ai = 0; ai < 2; ++ai)
#pragma unroll
            for (int m = 0; m < 4; ++m) { bf16_t* rowp = base + (size_t)(row0 + ai * HALF + m * 16) * ld + col0;
#pragma unroll
                for (int bj = 0; bj < 2; ++bj) { f32x4 v0 = acc[ai][bj][m][0], v1 = acc[ai][bj][m][1];
                    if (act) {
#pragma unroll
                        for (int j = 0; j < 4; ++j) { v0[j] = sigmoidf_(v0[j]); v1[j] = sigmoidf_(v1[j]); } }
                    u32x4 w; w.x = cvt_pk_bf16(v0[0], v0[1]); w.y = cvt_pk_bf16(v0[2], v0[3]); w.z = cvt_pk_bf16(v1[0], v1[1]); w.w = cvt_pk_bf16(v1[2], v1[3]);
                    *(u32x4*)(rowp + bj * HALF) = w; } }
    }
};
struct EpiMerge {
    static constexpr bool PERM = true, CHAIN = true;
    bf16_t* M; const bf16_t* ZG;
    __device__ __forceinline__ bool chain(f32x4 (&acc)[2][2][4][2], const Unit& u, int wr, int wc, int fr, int fq) const {
        const int row0 = u.pm * BM + wr * 64 + fr, col0 = u.pn * BM + wc * 32 + 8 * fq;
#pragma unroll
        for (int ai = 0; ai < 2; ++ai)
#pragma unroll
            for (int m = 0; m < 4; ++m) { const size_t r = (size_t)(row0 + ai * HALF + m * 16);
#pragma unroll
                for (int bj = 0; bj < 2; ++bj) {
                    const bf16_t* gp = ZG + r * 3072 + col0 + bj * HALF;
                    float f[8];
                    if (u.tag == 2) { const u32x4 g = *(const u32x4*)(gp + 2048);
                        f[0] = bflo(g.x); f[1] = bfhi(g.x); f[2] = bflo(g.y); f[3] = bfhi(g.y); f[4] = bflo(g.z); f[5] = bfhi(g.z); f[6] = bflo(g.w); f[7] = bfhi(g.w);
#pragma unroll
                        for (int e = 0; e < 8; ++e) f[e] = fmaxf(f[e], 1e-12f);
                    } else { const u32x4 gn = *(const u32x4*)(gp + u.tag * 1024), gd = *(const u32x4*)(gp + (u.tag + 1) * 1024);
                        const float nn[8] = {bflo(gn.x), bfhi(gn.x), bflo(gn.y), bfhi(gn.y), bflo(gn.z), bfhi(gn.z), bflo(gn.w), bfhi(gn.w)};
                        const float dd[8] = {bflo(gd.x), bfhi(gd.x), bflo(gd.y), bfhi(gd.y), bflo(gd.z), bfhi(gd.z), bflo(gd.w), bfhi(gd.w)};
#pragma unroll
                        for (int e = 0; e < 8; ++e) f[e] = (u.tag == 0 ? nn[e] : fmaxf(nn[e], 1e-12f)) * __builtin_amdgcn_rcpf(fmaxf(dd[e], 1e-12f)); }
                    f32x4& v0 = acc[ai][bj][m][0]; f32x4& v1 = acc[ai][bj][m][1];
                    v0[0] *= f[0]; v0[1] *= f[1]; v0[2] *= f[2]; v0[3] *= f[3]; v1[0] *= f[4]; v1[1] *= f[5]; v1[2] *= f[6]; v1[3] *= f[7];
                    if (u.tag == 2) { u32x4 w; w.x = cvt_pk_bf16(v0[0], v0[1]); w.y = cvt_pk_bf16(v0[2], v0[3]); w.z = cvt_pk_bf16(v1[0], v1[1]); w.w = cvt_pk_bf16(v1[2], v1[3]);
                        *(u32x4*)(M + r * 1024 + col0 + bj * HALF) = w; }
                } }
        return u.tag != 2;
    }
};
struct EpiRes {
    static constexpr bool PERM = true, CHAIN = false;
    const float* xin32; const bf16_t* xin16; bf16_t* xout; const float* gate;
    __device__ __forceinline__ void operator()(const f32x4 (&acc)[2][2][4][2], const Unit& u, int wr, int wc, int fr, int fq) const {
        const int row0 = u.pm * BM + wr * 64 + fr, col0 = u.pn * BM + wc * 32 + 8 * fq;
        const float* gp = gate + (size_t)(u.pm >> 4) * 6144 + col0;
        f32x4 gv[2][2];
#pragma unroll
        for (int bj = 0; bj < 2; ++bj) { gv[bj][0] = *(const f32x4*)(gp + bj * HALF); gv[bj][1] = *(const f32x4*)(gp + bj * HALF + 4); }
#pragma unroll
        for (int ai = 0; ai < 2; ++ai)
#pragma unroll
            for (int m = 0; m < 4; ++m) { const size_t off = (size_t)(row0 + ai * HALF + m * 16) * 1024 + col0;
#pragma unroll
                for (int bj = 0; bj < 2; ++bj) {
                    f32x4 x0, x1;
                    if (xin32) { x0 = *(const f32x4*)(xin32 + off + bj * HALF); x1 = *(const f32x4*)(xin32 + off + bj * HALF + 4); }
                    else { const u32x4 xw = *(const u32x4*)(xin16 + off + bj * HALF);
                        x0 = (f32x4){bflo(xw.x), bfhi(xw.x), bflo(xw.y), bfhi(xw.y)}; x1 = (f32x4){bflo(xw.z), bfhi(xw.z), bflo(xw.w), bfhi(xw.w)}; }
                    const f32x4 o0 = x0 + gv[bj][0] * acc[ai][bj][m][0], o1 = x1 + gv[bj][1] * acc[ai][bj][m][1];
                    u32x4 w; w.x = cvt_pk_bf16(o0[0], o0[1]); w.y = cvt_pk_bf16(o0[2], o0[3]); w.z = cvt_pk_bf16(o1[0], o1[1]); w.w = cvt_pk_bf16(o1[2], o1[3]);
                    *(u32x4*)(xout + off + bj * HALF) = w; } }
    }
};
__device__ __forceinline__ float dpp_prev(float x, float y, int n) {
    if (n == 1) { const int yr = __builtin_amdgcn_update_dpp(0, __float_as_int(y), 0x121, 0xf, 0xf, false);
                  return __int_as_float(__builtin_amdgcn_update_dpp(yr, __float_as_int(x), 0x111, 0xf, 0xf, false)); }
    const int yr = __builtin_amdgcn_update_dpp(0, __float_as_int(y), 0x122, 0xf, 0xf, false);
    return __int_as_float(__builtin_amdgcn_update_dpp(yr, __float_as_int(x), 0x112, 0xf, 0xf, false));
}
struct EpiUp {
    static constexpr bool PERM = true, CHAIN = false;
    bf16_t* U; float* HA; float* HB; const float* cw;
    __device__ __forceinline__ void operator()(const f32x4 (&acc)[2][2][4][2], const Unit& u, int wr, int wc, int fr, int fq) const {
        const int c0 = 128 * u.pn + 32 * wc + 8 * fq;
        float w0[8], w1[8], w2[8];
        { float f[24];
#pragma unroll
          for (int q = 0; q < 6; ++q) { const f32x4 v = *(const f32x4*)(cw + (size_t)c0 * 3 + 4 * q); f[4 * q] = v[0]; f[4 * q + 1] = v[1]; f[4 * q + 2] = v[2]; f[4 * q + 3] = v[3]; }
#pragma unroll
          for (int e = 0; e < 8; ++e) { w0[e] = f[3 * e]; w1[e] = f[3 * e + 1]; w2[e] = f[3 * e + 2]; } }
#pragma unroll
        for (int ai = 0; ai < 2; ++ai) {
            const int grp = 4 * u.pm + 2 * ai + wr;
            float Y[8];
#pragma unroll
            for (int e = 0; e < 8; ++e) Y[e] = 0.f;
#pragma unroll
            for (int m = 0; m < 4; ++m) {
                const size_t row = (size_t)u.pm * BM + ai * HALF + wr * 64 + m * 16 + fr;
                float X[8], G[8], o[8];
#pragma unroll
                for (int e = 0; e < 8; ++e) { X[e] = acc[ai][0][m][e >> 2][e & 3]; G[e] = acc[ai][1][m][e >> 2][e & 3]; }
#pragma unroll
                for (int e = 0; e < 8; ++e) { const float a1 = dpp_prev(X[e], Y[e], 1), a2 = dpp_prev(X[e], Y[e], 2);
                    const float s = w0[e] * a2 + w1[e] * a1 + w2[e] * X[e]; o[e] = s * sigmoidf_(s) * G[e]; }
                if (m > 0 || fr >= 2) { u32x4 w; w.x = cvt_pk_bf16(o[0], o[1]); w.y = cvt_pk_bf16(o[2], o[3]); w.z = cvt_pk_bf16(o[4], o[5]); w.w = cvt_pk_bf16(o[6], o[7]);
                    *(u32x4*)(U + row * DFF + c0) = w; }
                if (m == 0 && fr < 2) { float* hb = HB + ((size_t)(grp * 2 + fr) * 2) * DFF + c0;
                    *(f32x4*)hb = (f32x4){X[0], X[1], X[2], X[3]}; *(f32x4*)(hb + 4) = (f32x4){X[4], X[5], X[6], X[7]};
                    *(f32x4*)(hb + DFF) = (f32x4){G[0], G[1], G[2], G[3]}; *(f32x4*)(hb + DFF + 4) = (f32x4){G[4], G[5], G[6], G[7]}; }
                if (m == 3 && fr >= 14) { float* ha = HA + (size_t)(grp * 2 + fr - 14) * DFF + c0;
                    *(f32x4*)ha = (f32x4){X[0], X[1], X[2], X[3]}; *(f32x4*)(ha + 4) = (f32x4){X[4], X[5], X[6], X[7]}; }
#pragma unroll
                for (int e = 0; e < 8; ++e) Y[e] = X[e];
            }
        }
    }
};
struct MergeOrder {
    int G, c; const char* o_att; const char* wbr;
    __device__ bool next(int i, Unit& u) const {
        const int tile = (i / 3) * G + c; if (tile >= (T_ / BM) * 4) return false;
        const int br = i % 3; u.pm = tile >> 2; u.pn = tile & 3; u.tag = br;
        u.A = o_att - (size_t)br * (32 * MiB) + (size_t)u.pm * BM * 512 * 2;
        u.B = wbr + (size_t)br * 1024 * 512 * 2 + (size_t)u.pn * BM * 512 * 2; return true;
    }
};
}

#define GSTRIDE_BLOCKS(var, n) for (int var = blockIdx.x; var < (n); var += gridDim.x)

__device__ __forceinline__ void ph_mod(const Params& P, LAS unsigned char* lds) {
    LAS float* red = (LAS float*)lds;
    float* mod = (float*)(P.ws + OFF_MOD); float* tab = (float*)(P.ws + OFF_TAB);
    const int tid = opaque_tid(), wid = tid >> 6, lane = tid & 63;
    GSTRIDE_BLOCKS(blk, 192) {
        const int l = blk / 96, jb = blk % 96, j = jb * 64 + lane;
        float acc[8];
#pragma unroll
        for (int b = 0; b < 8; ++b) acc[b] = 0.f;
        const float* aw = P.ada_w + (size_t)l * 1024 * 6144 + j;
        for (int k = wid * 128; k < wid * 128 + 128; ++k) {
            const float w = aw[(size_t)k * 6144];
#pragma unroll
            for (int b = 0; b < 8; ++b) acc[b] += P.c[b * 1024 + k] * w;
        }
#pragma unroll
        for (int b = 0; b < 8; ++b) red[(wid * 8 + b) * 64 + lane] = acc[b];
        __syncthreads();
        { const int b = wid; float s = P.ada_b[l * 6144 + j];
#pragma unroll
          for (int w = 0; w < 8; ++w) s += red[(w * 8 + b) * 64 + lane];
          mod[((size_t)l * 8 + b) * 6144 + j] = s; }
        __syncthreads();
    }
    if (blockIdx.x == gridDim.x - 1) {
        for (int i = tid; i < 1024; i += NTHR) { const int n = i >> 3, h = i & 7; int bk;
            if (n < 16) bk = n; else { const float nf = (float)n; bk = 16 + (int)(logf(nf / 16.0f) / 2.0794415416798357f * 16.0f); bk = bk < 31 ? bk : 31; }
            tab[i] = P.rel_bias[bk * 8 + h]; }
    }
}

struct WJob { const float* src; int ldsrc; int K; int N; bf16_t* dst; int win; };
template <int KT  >
__device__ __forceinline__ void conv_tiles(const WJob& J, LAS float* tile  ) {
    const int tid = opaque_tid(); const int nkt = J.K / KT, nnt = J.N / 64, ntiles = nkt * nnt;
    GSTRIDE_BLOCKS(ti, ntiles) {
        const int kt = ti % nkt, ntb = ti / nkt, k0 = kt * KT, n0 = ntb * 64;
        { const int n = tid & 63, kk0 = tid >> 6; const int nn = n0 + n; int col = nn;
          if (J.win == 1) col = nn < 2120 ? nn : (nn < 2304 ? -1 : nn - 184);
          if (J.win == 2) col = ((nn & 255) < 128) ? 128 * (nn >> 8) + (nn & 127) : DFF + 128 * (nn >> 8) + (nn & 127);
          float v[KT / 8];
#pragma unroll
          for (int p = 0; p < KT / 8; ++p) { const int k = kk0 + 8 * p; v[p] = col >= 0 ? J.src[(size_t)(k0 + k) * J.ldsrc + col] : 0.f; }
#pragma unroll
          for (int p = 0; p < KT / 8; ++p) tile[(kk0 + 8 * p) * 65 + n] = v[p]; }
        __syncthreads();
#pragma unroll
        for (int q = 0; q < KT / 64; ++q) { const int n = tid >> 3, kg = (tid & 7) + 8 * q; float v[8];
#pragma unroll
          for (int e = 0; e < 8; ++e) v[e] = tile[(kg * 8 + e) * 65 + n];
          u32x4 w; w.x = cvt_pk_bf16(v[0], v[1]); w.y = cvt_pk_bf16(v[2], v[3]); w.z = cvt_pk_bf16(v[4], v[5]); w.w = cvt_pk_bf16(v[6], v[7]);
          *(u32x4*)(J.dst + (size_t)(n0 + n) * J.K + k0 + kg * 8) = w; }
        __syncthreads();
    }
}
__device__ __forceinline__ void ph_wconv(const Params& P, int l, LAS unsigned char* lds) {
    LAS float* tile = (LAS float*)lds; unsigned char* wb = P.ws + OFF_WB;
    { WJob J{P.w_in + (size_t)l * 1024 * IN_COLS, IN_COLS, 1024, 8704, (bf16_t*)(wb + WB_WIN), 1}; conv_tiles<256>(J, tile); }
    for (int i = 0; i < 3; ++i) { WJob J{P.w_branch + ((size_t)l * 3 + i) * 512 * 1024, 1024, 512, 1024, (bf16_t*)(wb + WB_WBR) + (size_t)i * 1024 * 512, 0}; conv_tiles<256>(J, tile); }
    { WJob J{P.w_o + (size_t)l * 1024 * 1024, 1024, 1024, 1024, (bf16_t*)(wb + WB_WO), 0}; conv_tiles<256>(J, tile); }
    { WJob J{P.ffn_w_up + (size_t)l * 1024 * 5632, 5632, 1024, 5632, (bf16_t*)(wb + WB_WUP), 2}; conv_tiles<256>(J, tile); }
    { WJob J{P.ffn_w_down + (size_t)l * 2816 * 1024, 1024, 2816, 1024, (bf16_t*)(wb + WB_WDN), 0}; conv_tiles<256>(J, tile); }
    { WJob J{P.w_up + (size_t)l * 64 * 512, 512, 64, 512, (bf16_t*)(wb + WB_LW), 0}; conv_tiles<64>(J, tile); }
    { WJob J{P.a_up + (size_t)l * 64 * 512, 512, 64, 512, (bf16_t*)(wb + WB_LA), 0}; conv_tiles<64>(J, tile); }
    { WJob J{P.g_up + (size_t)l * 128 * 512, 512, 128, 512, (bf16_t*)(wb + WB_LG), 0}; conv_tiles<64>(J, tile); }
}

__device__ __forceinline__ void ph_norm(const Params& P, int l, int which) {
    const bool first = (l == 0 && which == 0);
    const float* nw = (which == 0 ? P.norm_mix : P.norm_ffn) + l * 1024;
    const float* mod = (const float*)(P.ws + OFF_MOD) + (size_t)l * 8 * 6144 + which * 3072;
    const bf16_t* XB = (const bf16_t*)P.out;
    bf16_t* H = (bf16_t*)(P.ws + OFF_H);
    const int tid = opaque_tid(), wid = tid >> 6, lane = tid & 63;
    for (int row = blockIdx.x * 8 + wid; row < T_; row += gridDim.x * 8) {
        const int b = row >> 12; const float* mb = mod + (size_t)b * 6144;
        f32x4 v[4]; float ss = 0.f;
#pragma unroll
        for (int i = 0; i < 4; ++i) {
            if (first) v[i] = *(const f32x4*)(P.x_in + (size_t)row * 1024 + i * 256 + lane * 4);
            else { const u32x2 w = *(const u32x2*)(XB + (size_t)row * 1024 + i * 256 + lane * 4); v[i] = (f32x4){bflo(w.x), bfhi(w.x), bflo(w.y), bfhi(w.y)}; }
            ss += v[i][0] * v[i][0] + v[i][1] * v[i][1] + v[i][2] * v[i][2] + v[i][3] * v[i][3]; }
        ss = wave_sum(ss, lane);
        const float rstd = rsqrtf(ss * (1.0f / 1024.0f) + 1e-6f);
#pragma unroll
        for (int i = 0; i < 4; ++i) { const int c = i * 256 + lane * 4;
            const f32x4 g = *(const f32x4*)(nw + c), sh = *(const f32x4*)(mb + c), sc = *(const f32x4*)(mb + 1024 + c);
            const f32x4 y = v[i] * rstd * g * (sc + 1.0f) + sh;
            u32x2 w; w.x = cvt_pk_bf16(y[0], y[1]); w.y = cvt_pk_bf16(y[2], y[3]);
            *(u32x2*)(H + (size_t)row * 1024 + c) = w; }
    }
}

__device__ __forceinline__ void ph_final(const Params& P) {
    const bf16_t* XF = (const bf16_t*)(P.ws + OFF_H);
    const int tid = opaque_tid(), wid = tid >> 6, lane = tid & 63;
    for (int row = blockIdx.x * 8 + wid; row < T_; row += gridDim.x * 8) {
        float* xr = P.out + (size_t)row * 1024;
        f32x4 v[4]; float ss = 0.f;
#pragma unroll
        for (int i = 0; i < 4; ++i) { const u32x2 w = *(const u32x2*)(XF + (size_t)row * 1024 + i * 256 + lane * 4); v[i] = (f32x4){bflo(w.x), bfhi(w.x), bflo(w.y), bfhi(w.y)};
            ss += v[i][0] * v[i][0] + v[i][1] * v[i][1] + v[i][2] * v[i][2] + v[i][3] * v[i][3]; }
        ss = wave_sum(ss, lane);
        const float rstd = rsqrtf(ss * (1.0f / 1024.0f) + 1e-6f);
#pragma unroll
        for (int i = 0; i < 4; ++i) { const int c = i * 256 + lane * 4; const f32x4 g = *(const f32x4*)(P.final_norm + c);
            *(f32x4*)(xr + c) = v[i] * rstd * g; }
    }
}

__device__ __forceinline__ void ph_gemm_zq(const Params& P, LAS unsigned char* lds) {
    g8::SOrder S; S.init(T_, 2304, 1024, 1024, P.ws + OFF_H, P.ws + OFF_WB + WB_WIN);
    g8::EpiBf E{(bf16_t*)(P.ws + OFF_ZQ), 2304, 9, nullptr, 0, 0};
    g8::gemm_phase(lds, 1024, 1024, 1024, S, E);
}
__device__ __forceinline__ void ph_gemm_zr(const Params& P, LAS unsigned char* lds) {
    g8::SOrder S; S.init(T_, 1792, 1024, 1024, P.ws + OFF_H, P.ws + OFF_WB + WB_WIN + (size_t)2304 * 1024 * 2);
    g8::EpiBf E{(bf16_t*)(P.ws + OFF_ZR), 1792, 7, nullptr, 0, 0};
    g8::gemm_phase(lds, 1024, 1024, 1024, S, E);
}
__device__ __forceinline__ void ph_gemm_zc(const Params& P, LAS unsigned char* lds) {
    g8::SOrder S; S.init(T_, 4608, 1024, 1024, P.ws + OFF_H, P.ws + OFF_WB + WB_WIN + (size_t)4096 * 1024 * 2);
    g8::EpiBf E{(bf16_t*)(P.ws + OFF_ZCV), 1536, 6, (bf16_t*)(P.ws + OFF_ZG), 3072, 1};
    g8::gemm_phase(lds, 1024, 1024, 1024, S, E);
}
__device__ __forceinline__ void ph_gemm_merge(const Params& P, LAS unsigned char* lds) {
    g8::MergeOrder S{(int)gridDim.x, (int)blockIdx.x, (const char*)(P.ws + OFF_OATT), (const char*)(P.ws + OFF_WB + WB_WBR)};
    g8::EpiMerge E{(bf16_t*)(P.ws + OFF_MRG), (const bf16_t*)(P.ws + OFF_ZG)};
    g8::gemm_phase(lds, 512, 512, 512, S, E);
}
__device__ __forceinline__ void ph_gemm_wo(const Params& P, int l, LAS unsigned char* lds) {
    g8::SOrder S; S.init(T_, 1024, 1024, 1024, P.ws + OFF_MRG, P.ws + OFF_WB + WB_WO);
    g8::EpiRes E{l == 0 ? P.x_in : nullptr, (const bf16_t*)P.out, (bf16_t*)P.out, (const float*)(P.ws + OFF_MOD) + (size_t)l * 8 * 6144 + 2048};
    g8::gemm_phase(lds, 1024, 1024, 1024, S, E);
}
__device__ __forceinline__ void ph_gemm_up(const Params& P, int l, LAS unsigned char* lds) {
    g8::SOrder S; S.init(T_, 5632, 1024, 1024, P.ws + OFF_H, P.ws + OFF_WB + WB_WUP);
    g8::EpiUp E{(bf16_t*)(P.ws + OFF_UP), (float*)(P.ws + OFF_HA), (float*)(P.ws + OFF_HB), P.ffn_conv_w + (size_t)l * DFF * 3};
    g8::gemm_phase(lds, 1024, 1024, 1024, S, E);
}
__device__ __forceinline__ void ph_gemm_down(const Params& P, int l, LAS unsigned char* lds) {
    g8::SOrder S; S.init(T_, 1024, 2816, 2816, P.ws + OFF_UP, P.ws + OFF_WB + WB_WDN);
    g8::EpiRes E{nullptr, (const bf16_t*)P.out, l == 1 ? (bf16_t*)(P.ws + OFF_H) : (bf16_t*)P.out, (const float*)(P.ws + OFF_MOD) + (size_t)l * 8 * 6144 + 5120};
    g8::gemm_phase(lds, 2816, 2816, 2816, S, E);
}

__device__ __forceinline__ void ph_conv(const Params& P, int l, LAS unsigned char* lds) {
    const bf16_t* Z = (const bf16_t*)(P.ws + OFF_ZCV); bf16_t* O = (bf16_t*)(P.ws + OFF_OCONV);
    LAS float* cwT = (LAS float*)lds;
    const int tid = opaque_tid();
    for (int i = tid; i < 1536; i += NTHR) cwT[(i % 3) * 512 + i / 3] = P.sc_conv_w[(size_t)l * 1536 + i];
    __syncthreads();
    constexpr int RB = 16; const int nitem = (T_ / RB) * 64;
    for (int it = blockIdx.x * NTHR + tid; it < nitem; it += gridDim.x * NTHR) {
        const int rb = it >> 6, c0 = (it & 63) * 8, row0 = rb * RB, t0 = row0 & 4095;
        float w0[8], w1[8], w2[8];
#pragma unroll
        for (int e = 0; e < 8; ++e) { w0[e] = cwT[c0 + e]; w1[e] = cwT[512 + c0 + e]; w2[e] = cwT[1024 + c0 + e]; }
        float pm2[8], pm1[8];
#pragma unroll
        for (int e = 0; e < 8; ++e) { pm2[e] = 0.f; pm1[e] = 0.f; }
        if (t0 >= 2) {
#pragma unroll
            for (int j = 0; j < 2; ++j) { const bf16_t* zr = Z + (size_t)(row0 - 2 + j) * 1536;
                const u32x4 cc = *(const u32x4*)(zr + 512 + c0), cx = *(const u32x4*)(zr + 1024 + c0);
                const unsigned ccw[4] = {cc.x, cc.y, cc.z, cc.w}, cxw[4] = {cx.x, cx.y, cx.z, cx.w};
#pragma unroll
                for (int q = 0; q < 4; ++q) { const float a = bflo(ccw[q]) * bflo(cxw[q]), b2 = bfhi(ccw[q]) * bfhi(cxw[q]);
                    if (j == 0) { pm2[2 * q] = a; pm2[2 * q + 1] = b2; } else { pm1[2 * q] = a; pm1[2 * q + 1] = b2; } } }
        }
#pragma unroll 4
        for (int r = 0; r < RB; ++r) {
            const bf16_t* zr = Z + (size_t)(row0 + r) * 1536;
            const u32x4 cb = *(const u32x4*)(zr + c0), cc = *(const u32x4*)(zr + 512 + c0), cx = *(const u32x4*)(zr + 1024 + c0);
            const unsigned cbw[4] = {cb.x, cb.y, cb.z, cb.w}, ccw[4] = {cc.x, cc.y, cc.z, cc.w}, cxw[4] = {cx.x, cx.y, cx.z, cx.w};
            float cur[8], o[8];
#pragma unroll
            for (int q = 0; q < 4; ++q) { cur[2 * q] = bflo(ccw[q]) * bflo(cxw[q]); cur[2 * q + 1] = bfhi(ccw[q]) * bfhi(cxw[q]); }
#pragma unroll
            for (int e = 0; e < 8; ++e) { o[e] = w0[e] * pm2[e] + w1[e] * pm1[e] + w2[e] * cur[e]; pm2[e] = pm1[e]; pm1[e] = cur[e]; }
            u32x4 w; w.x = cvt_pk_bf16(o[0] * bflo(cbw[0]), o[1] * bfhi(cbw[0])); w.y = cvt_pk_bf16(o[2] * bflo(cbw[1]), o[3] * bfhi(cbw[1]));
            w.z = cvt_pk_bf16(o[4] * bflo(cbw[2]), o[5] * bfhi(cbw[2])); w.w = cvt_pk_bf16(o[6] * bflo(cbw[3]), o[7] * bfhi(cbw[3]));
            *(u32x4*)(O + (size_t)(row0 + r) * 512 + c0) = w;
        }
    }
}

__device__ __forceinline__ void ph_ufix(const Params& P, int l, LAS unsigned char* lds) {
    bf16_t* U = (bf16_t*)(P.ws + OFF_UP); const float* HA = (const float*)(P.ws + OFF_HA); const float* HB = (const float*)(P.ws + OFF_HB);
    LAS float* cwT = (LAS float*)lds;
    const int tid = opaque_tid();
    for (int i = tid; i < DFF * 3; i += NTHR) cwT[(i % 3) * DFF + i / 3] = P.ffn_conv_w[(size_t)l * DFF * 3 + i];
    __syncthreads();
    const int nitem = (T_ / 64) * 2 * 352;
    for (int it = blockIdx.x * NTHR + tid; it < nitem; it += gridDim.x * NTHR) {
        const int c0 = (it % 352) * 8, gr = it / 352, grp = gr >> 1, rr = gr & 1; const bool first = (grp & 63) == 0;
        const float* hb = HB + ((size_t)(grp * 2 + rr) * 2) * DFF + c0;
        float a0[8], a1[8], a2[8], g[8];
#pragma unroll
        for (int q = 0; q < 2; ++q) { const f32x4 va = *(const f32x4*)(hb + 4 * q), vg = *(const f32x4*)(hb + DFF + 4 * q);
#pragma unroll
            for (int e = 0; e < 4; ++e) { a0[4 * q + e] = va[e]; g[4 * q + e] = vg[e]; a1[4 * q + e] = 0.f; a2[4 * q + e] = 0.f; } }
        if (rr == 1) { const float* p1 = HB + ((size_t)(grp * 2) * 2) * DFF + c0;
#pragma unroll
            for (int q = 0; q < 2; ++q) { const f32x4 v = *(const f32x4*)(p1 + 4 * q);
#pragma unroll
                for (int e = 0; e < 4; ++e) a1[4 * q + e] = v[e]; } }
        if (!first) {
            const float* pl = HA + (size_t)((grp - 1) * 2 + 1) * DFF + c0;
            const float* pk = HA + (size_t)((grp - 1) * 2) * DFF + c0;
#pragma unroll
            for (int q = 0; q < 2; ++q) { const f32x4 v63 = *(const f32x4*)(pl + 4 * q), v62 = *(const f32x4*)(pk + 4 * q);
#pragma unroll
                for (int e = 0; e < 4; ++e) { if (rr == 1) a2[4 * q + e] = v63[e]; else { a1[4 * q + e] = v63[e]; a2[4 * q + e] = v62[e]; } } }
        }
        float o[8];
#pragma unroll
        for (int e = 0; e < 8; ++e) { const float s = cwT[c0 + e] * a2[e] + cwT[DFF + c0 + e] * a1[e] + cwT[2 * DFF + c0 + e] * a0[e]; o[e] = s * sigmoidf_(s) * g[e]; }
        u32x4 w; w.x = cvt_pk_bf16(o[0], o[1]); w.y = cvt_pk_bf16(o[2], o[3]); w.z = cvt_pk_bf16(o[4], o[5]); w.w = cvt_pk_bf16(o[6], o[7]);
        *(u32x4*)(U + (size_t)(grp * 64 + rr) * DFF + c0) = w;
    }
}

template <int NR>
__device__ __forceinline__ u64 select_row(LAS float* row, const int t, const int lz) {
    const int imax = t >> 6;
    float x[NR]; float Tx = 0.f; bool have = false, exact = false;
    {
        int bin[NR]; float lo = __builtin_inff(), hi = -__builtin_inff();
        LAS unsigned* hist = (LAS unsigned*)row;
#pragma unroll
        for (int i = 0; i < NR; ++i) { const float v = row[64 * i + lz]; x[i] = (i <= imax) ? v : -__builtin_inff(); hi = fmaxf(hi, x[i]); lo = fminf(lo, (i < imax || x[i] > -__builtin_inff()) ? x[i] : __builtin_inff()); }
#pragma unroll
        for (int o = 32; o >= 1; o >>= 1) { lo = fminf(lo, shx(lo, o, lz)); hi = fmaxf(hi, shx(hi, o, lz)); }
        if (hi > lo) {
            const float scale = 4095.0f / (hi - lo);
#pragma unroll
            for (int q = 0; q < 16; ++q) *(LAS u32x4*)(hist + 256 * q + 4 * lz) = (u32x4){0u, 0u, 0u, 0u};
#pragma unroll
            for (int i = 0; i < NR; ++i) {
                const int bq = (int)fminf(fmaxf((x[i] - lo) * scale, -1.0f), 4095.0f); bin[i] = bq;
                if (bq >= 0) __hip_atomic_fetch_add(hist + bq, 1u, __ATOMIC_RELAXED, __HIP_MEMORY_SCOPE_WORKGROUP); }
            unsigned c1 = 0u;
#pragma unroll
            for (int q = 0; q < 16; ++q) { const u32x4 h4 = *(const LAS u32x4*)(hist + 64 * lz + 4 * ((q + lz) & 15)); c1 += (h4.x + h4.y) + (h4.z + h4.w); }
            unsigned inc = c1;
#pragma unroll
            for (int o = 1; o <= 32; o <<= 1) { const unsigned v = (unsigned)__builtin_amdgcn_ds_bpermute(((lz + o) & 63) << 2, (int)inc); inc += (lz + o < 64) ? v : 0u; }
            const unsigned ab1 = inc - c1;
            const u64 cr1 = __ballot(ab1 < 256u && ab1 + c1 >= 256u);
            const int L1 = __builtin_ctzll(cr1);
            const unsigned abL = (unsigned)__builtin_amdgcn_readlane((int)ab1, L1);
            const unsigned c2 = hist[64 * L1 + lz];
            unsigned inc2 = c2;
#pragma unroll
            for (int o = 1; o <= 32; o <<= 1) { const unsigned v = (unsigned)__builtin_amdgcn_ds_bpermute(((lz + o) & 63) << 2, (int)inc2); inc2 += (lz + o < 64) ? v : 0u; }
            const unsigned ab2 = inc2 - c2 + abL;
            const u64 cr2 = __ballot(ab2 < 256u && ab2 + c2 >= 256u);
            const int L2 = __builtin_ctzll(cr2);
            const int bstar = 64 * L1 + L2;
            const int cb = __builtin_amdgcn_readlane((int)c2, L2), need2 = 256 - __builtin_amdgcn_readlane((int)ab2, L2);
            if (cb <= 64) {
                int cand = 0; int pos = 0;
#pragma unroll
                for (int i = 0; i < NR; ++i) { u64 mm = __ballot(bin[i] == bstar);
                    while (mm) { const int s = __builtin_ctzll(mm); mm &= mm - 1ull; cand = writelane_v(cand, __builtin_amdgcn_readlane(__float_as_int(x[i]), s), pos); ++pos; } }
                const unsigned cu = (lz < cb) ? f2ord(__int_as_float(cand)) : 0u;
                unsigned Tc = 0u;
#pragma unroll 1
                for (int bit = 31; bit >= 0; --bit) { const unsigned cd = Tc | (1u << bit); if ((int)__popcll(__ballot(cu >= cd)) >= need2) Tc = cd; }
                Tx = ord2f(Tc); have = true; exact = (256 - need2) + (int)__popcll(__ballot(cu >= Tc)) == 256;
            }
        }
    }
    if (!have) {
        unsigned Tt = 0u;
#pragma unroll 1
        for (int bit = 31; bit >= 0; --bit) {
            const unsigned cand = Tt | (1u << bit); int cnt = 0;
#pragma unroll
            for (int i = 0; i < NR; ++i) cnt += __popcll(__ballot(f2ord(x[i]) >= cand));
            if (cnt >= 256) Tt = cand;
        }
        Tx = ord2f(Tt);
    }
    int wlo = 0, whi = 0;
#pragma unroll
    for (int i = 0; i < NR; ++i) { const u64 g = __ballot(x[i] >= Tx); writelane_c2(wlo, whi, (int)(unsigned)g, (int)(unsigned)(g >> 32), i); }
    u64 myw = ((u64)(unsigned)whi << 32) | (unsigned)wlo;
    if (!exact) {
        int cgt = 0;
#pragma unroll
        for (int i = 0; i < NR; ++i) cgt += __popcll(__ballot(x[i] > Tx));
        int need = 256 - cgt; myw = 0ull;
#pragma unroll
        for (int i = 0; i < NR; ++i) {
            const u64 g = __ballot(x[i] > Tx); u64 e = __ballot(x[i] == Tx);
            int ne = __popcll(e);
            while (ne > need) { e &= ~(1ull << (63 - __clzll(e))); --ne; }
            need -= ne;
            if (lz == i) myw = g | e;
        }
    }
    return myw;
}

__device__ __forceinline__ void ph_idx(const Params& P, LAS unsigned char* lds) {
    LAS float* SC = (LAS float*)lds;
    const bf16_t* ZQ = (const bf16_t*)(P.ws + OFF_ZQ); u64* MASK = (u64*)(P.ws + OFF_MASK);
    const int tid = opaque_tid(), wid = __builtin_amdgcn_readfirstlane(tid >> 6), lane = tid & 63, m = lane & 31, hh = lane >> 5;
    { int* KPM = (int*)(P.ws + OFF_KPM);
      for (int i = blockIdx.x * NTHR + tid; i < NB_ * 64; i += gridDim.x * NTHR) { const int* pp = P.pos + (i >> 6) * S_ + (i & 63) * 64; int mxp = pp[0];
          for (int k = 1; k < 64; ++k) mxp = pp[k] > mxp ? pp[k] : mxp;
          KPM[i] = mxp; } }
    int itc = 0;
    for (int idx = blockIdx.x; idx < NB_ * 512; idx += gridDim.x, ++itc) {
        const int b = idx & 7, j = idx >> 3; const int qb = (itc & 1) ? (j ^ 31) : j; const int t0 = qb * 8;
        const bf16_t* zb = ZQ + (size_t)b * S_ * 2304;
        bf16x8 Af[2][4]; float wv[2][16];
#pragma unroll
        for (int blk = 0; blk < 2; ++blk) {
            const bf16_t* qp = zb + (size_t)(t0 + 4 * blk + 2 * ((m >> 2) & 1) + (m >> 4)) * 2304 + 1536 + (4 * ((m >> 3) & 1) + (m & 3)) * 64 + 8 * hh;
#pragma unroll
            for (int ks = 0; ks < 4; ++ks) Af[blk][ks] = *(const bf16x8*)(qp + 16 * ks);
#pragma unroll
            for (int q = 0; q < 2; ++q) { const u32x4 ww = *(const u32x4*)(zb + (size_t)(t0 + 4 * blk + 2 * hh + q) * 2304 + 2112);
                wv[blk][8 * q + 0] = bflo(ww.x); wv[blk][8 * q + 1] = bfhi(ww.x); wv[blk][8 * q + 2] = bflo(ww.y); wv[blk][8 * q + 3] = bfhi(ww.y);
                wv[blk][8 * q + 4] = bflo(ww.z); wv[blk][8 * q + 5] = bfhi(ww.z); wv[blk][8 * q + 6] = bflo(ww.w); wv[blk][8 * q + 7] = bfhi(ww.w); }
        }
        const int ntile = 2 * ((t0 + 7) / 64 + 1);
        for (int kt = wid; kt < ntile; kt += 8) {
            const bf16_t* kp = zb + (size_t)(32 * kt + m) * 2304 + 2048 + 8 * hh;
            bf16x8 Bf[4];
#pragma unroll
            for (int ks = 0; ks < 4; ++ks) Bf[ks] = *(const bf16x8*)(kp + 16 * ks);
#pragma unroll
            for (int blk = 0; blk < 2; ++blk) {
                f32x16 Dv;
#pragma unroll
                for (int r = 0; r < 16; ++r) Dv[r] = 0.f;
#pragma unroll
                for (int ks = 0; ks < 4; ++ks) Dv = __builtin_amdgcn_mfma_f32_32x32x16_bf16(Af[blk][ks], Bf[ks], Dv, 0, 0, 0);
#pragma unroll
                for (int q = 0; q < 2; ++q) {
                    float part = 0.f;
#pragma unroll
                    for (int e = 0; e < 8; ++e) { const float d = Dv[8 * q + e], w = wv[blk][8 * q + e]; part = __builtin_fmaf(w, d, part); part = __builtin_fmaf(w, __builtin_fabsf(d), part); }
                    SC[(4 * blk + 2 * hh + q) * 4096 + 32 * kt + m] = (32 * kt + m <= t0 + 4 * blk + 2 * hh + q) ? part : -__builtin_inff();
                }
            }
        }
        __syncthreads();
        {
            const int t = t0 + wid; u64* mrow = MASK + (size_t)(b * S_ + t) * 64;
            if (t < 256) {
                const int lo = 64 * lane; u64 w;
                if (t >= lo + 63) w = ~0ull; else if (t < lo) w = 0ull; else w = (2ull << (t - lo)) - 1ull;
                mrow[lane] = w;
            } else {
                int lz = threadIdx.x; asm volatile("" : "+v"(lz)); lz &= 63;
                LAS float* rowp = SC + wid * 4096; u64 myw;
                if (t < 512) myw = select_row<8>(rowp, t, lz); else if (t < 1024) myw = select_row<16>(rowp, t, lz); else if (t < 2048) myw = select_row<32>(rowp, t, lz); else myw = select_row<64>(rowp, t, lz);
                mrow[lz] = myw;
            }
        }
        __syncthreads();
    }
    {
        LAS bf16_t* tl = (LAS bf16_t*)lds;
        bf16_t* VT = (bf16_t*)(P.ws + OFF_VT);
        for (int it = blockIdx.x; it < NB_ * 8 * 64; it += gridDim.x) {
            const int b = it >> 9, h = (it >> 6) & 7, k0 = (it & 63) * 64;
            { const int row = tid >> 3, ch = tid & 7;
              const u32x4 v = *(const u32x4*)(ZQ + (size_t)(b * S_ + k0 + row) * 2304 + 1024 + h * 64 + ch * 8);
              *(LAS u32x4*)(tl + row * 72 + ch * 8) = v; }
            __syncthreads();
            { const int d = tid >> 3, kc = tid & 7; unsigned short e[8];
#pragma unroll
              for (int q = 0; q < 8; ++q) e[q] = tl[(kc * 8 + q) * 72 + d];
              u32x4 w; w.x = e[0] | ((unsigned)e[1] << 16); w.y = e[2] | ((unsigned)e[3] << 16); w.z = e[4] | ((unsigned)e[5] << 16); w.w = e[6] | ((unsigned)e[7] << 16);
              *(u32x4*)(VT + ((size_t)((b * 8 + h) * 64 + d)) * S_ + k0 + kc * 8) = w; }
            __syncthreads();
        }
    }
}

__device__ __forceinline__ int bitmask(int w, int pos  ) { int m; asm("v_bfe_i32 %0, %1, %2, 1" : "=v"(m) : "v"(w), "n"(pos)); return m; }
__device__ __forceinline__ void ph_att(const Params& P, LAS unsigned char* lds) {
    LAS float* TABL = (LAS float*)lds;
    LAS unsigned char* KB = lds + 4096;
    constexpr int KT_B = 64 * 144, VT_B = 64 * 136, BUF_B = KT_B + VT_B;
    constexpr float LOG2E = 1.4426950408889634f;
    const float* tabg = (const float*)(P.ws + OFF_TAB);
    const int tid = opaque_tid(), wid = __builtin_amdgcn_readfirstlane(tid >> 6), lane = tid & 63, m = lane & 31, hh = lane >> 5;
    for (int i = tid; i < 1024; i += NTHR) TABL[i] = tabg[i] * LOG2E;
    LAS int* POSL = (LAS int*)(KB + 4 * BUF_B);
    int pos_b = -1;
    const bf16_t* ZQ = (const bf16_t*)(P.ws + OFF_ZQ); const u64* MASK = (const u64*)(P.ws + OFF_MASK);
    const bf16_t* VT = (const bf16_t*)(P.ws + OFF_VT); bf16_t* OA = (bf16_t*)(P.ws + OFF_OATT); const int* KPM = (const int*)(P.ws + OFF_KPM);
    int itc = 0;
    for (int idx = blockIdx.x; idx < NB_ * 8 * 16; idx += gridDim.x, ++itc) {
        const int b = idx & 7, head = (idx >> 3) & 7, j = idx >> 6; const int qb = (itc & 1) ? (j ^ 3) : j;
        const int q0 = qb * 256, tq0 = q0 + 32 * wid, t = tq0 + m;
        const bf16_t* zb = ZQ + (size_t)b * S_ * 2304;
        if (b != pos_b) {
            __syncthreads();
            for (int i = tid; i < S_ / 4; i += NTHR) ((LAS i32x4*)POSL)[i] = ((const i32x4*)(P.pos + b * S_))[i];
            pos_b = b;
            __syncthreads();
        }
        bf16x8 Qf[4];
        { const bf16_t* qp = zb + (size_t)t * 2304 + head * 64 + 8 * hh;
#pragma unroll
          for (int ks = 0; ks < 4; ++ks) Qf[ks] = *(const bf16x8*)(qp + 16 * ks); }
        const int posq = POSL[t];
        int minq = posq;
#pragma unroll
        for (int o = 32; o >= 1; o >>= 1) { const int v = shxi(minq, o, lane); minq = v < minq ? v : minq; }
        minq = __builtin_amdgcn_readfirstlane(minq);
        const u64* mrow = MASK + (size_t)(b * S_ + t) * 64;
        const bf16_t* vtb = VT + (size_t)(b * 8 + head) * 64 * S_;
        const float c1 = 0.125f * LOG2E, c2 = TABL[127 * 8 + head];
        f32x16 O0, O1, OL;
#pragma unroll
        for (int r = 0; r < 16; ++r) { O0[r] = 0.f; O1[r] = 0.f; OL[r] = 0.f; }
        const bf16x8 ones8 = {0x3F80, 0x3F80, 0x3F80, 0x3F80, 0x3F80, 0x3F80, 0x3F80, 0x3F80};
        float m_run = -1e30f;
        const int nt = 4 * qb + 4, my_nt = ((tq0 + 31) >> 6) + 1;
        const int skey = tid >> 3, sch = tid & 7;
        const bf16_t* kg = zb + (size_t)skey * 2304 + 512 + head * 64 + 8 * sch;
        const bf16_t* vg = vtb + (size_t)skey * S_ + 8 * sch;
        LAS unsigned char* kdst = KB + skey * 144 + sch * 16; LAS unsigned char* vdst = KB + KT_B + skey * 136 + sch * 16;
        const int kpm_l = KPM[b * 64 + lane];
        auto tile = [&](const int kt, const int boff, const u64 mw) {
                const LAS unsigned char* Kt = KB + boff; const LAS unsigned char* Vt = Kt + KT_B;
                f32x16 D0, D1;
#pragma unroll
                for (int r = 0; r < 16; ++r) { D0[r] = 0.f; D1[r] = 0.f; }
#pragma unroll
                for (int ks = 0; ks < 4; ++ks) {
                    const bf16x8 K0 = *(const LAS bf16x8*)(Kt + m * 144 + 32 * ks + 16 * hh), K1 = *(const LAS bf16x8*)(Kt + (32 + m) * 144 + 32 * ks + 16 * hh);
                    D0 = __builtin_amdgcn_mfma_f32_32x32x16_bf16(K0, Qf[ks], D0, 0, 0, 0); D1 = __builtin_amdgcn_mfma_f32_32x32x16_bf16(K1, Qf[ks], D1, 0, 0, 0); }
                const int w0 = (int)((unsigned)mw >> (4 * hh)), w1 = (int)((unsigned)(mw >> 32) >> (4 * hh));
                float esc = c1, eoff0 = c2;
                if (minq - __builtin_amdgcn_readlane(kpm_l, kt) < 127) {
#pragma unroll
                    for (int mb = 0; mb < 2; ++mb)
#pragma unroll
                        for (int g = 0; g < 4; ++g) {
                            const i32x4 pk = *(const LAS i32x4*)(POSL + 64 * kt + 32 * mb + 8 * g + 4 * hh);
#pragma unroll
                            for (int e = 0; e < 4; ++e) { const int r = 4 * g + e; int n = posq - pk[e]; n = n < 0 ? 0 : (n > 127 ? 127 : n);
                                if (mb) D1[r] = D1[r] * c1 + TABL[n * 8 + head]; else D0[r] = D0[r] * c1 + TABL[n * 8 + head]; }
                        }
                    esc = 1.0f; eoff0 = 0.f;
                }
                float mx = __builtin_fmaxf(__builtin_fmaxf(D0[0], D0[1]), D0[2]);
#pragma unroll
                for (int r = 3; r < 15; r += 2) mx = __builtin_fmaxf(__builtin_fmaxf(mx, D0[r]), D0[r + 1]);
#pragma unroll
                for (int r = 0; r < 16; r += 2) mx = __builtin_fmaxf(__builtin_fmaxf(mx, D1[r]), D1[r + 1]);
                mx = fmaxf(mx, D0[15]);
                mx = fmaxf(mx, shx(mx, 32, lane));
                const float m_new = fmaxf(m_run, mx * esc + eoff0); const float alpha = __builtin_amdgcn_exp2f(m_run - m_new); m_run = m_new;
                const float eoff = eoff0 - m_new;
                float pv[32];
#pragma unroll
                for (int r = 0; r < 16; ++r) {
                    const int bp = (r & 3) + 8 * (r >> 2);
                    pv[r] = __int_as_float(__float_as_int(__builtin_amdgcn_exp2f(D0[r] * esc + eoff)) & bitmask(w0, bp));
                    pv[16 + r] = __int_as_float(__float_as_int(__builtin_amdgcn_exp2f(D1[r] * esc + eoff)) & bitmask(w1, bp)); }
                if (!__all(alpha == 1.0f)) {
#pragma unroll
                    for (int r = 0; r < 16; ++r) { O0[r] *= alpha; O1[r] *= alpha; OL[r] *= alpha; } }
#pragma unroll
                for (int s = 0; s < 4; ++s) {
                    u32x4 pw; pw.x = cvt_pk_bf16(pv[8 * s + 0], pv[8 * s + 1]); pw.y = cvt_pk_bf16(pv[8 * s + 2], pv[8 * s + 3]); pw.z = cvt_pk_bf16(pv[8 * s + 4], pv[8 * s + 5]); pw.w = cvt_pk_bf16(pv[8 * s + 6], pv[8 * s + 7]);
                    const bf16x8 Pf = __builtin_bit_cast(bf16x8, pw);
                    const LAS unsigned char* vp = Vt + m * 136 + (16 * s + 4 * hh) * 2;
                    { const u32x2 va = *(const LAS u32x2*)vp, vb = *(const LAS u32x2*)(vp + 16); u32x4 vw; vw.x = va.x; vw.y = va.y; vw.z = vb.x; vw.w = vb.y;
                      O0 = __builtin_amdgcn_mfma_f32_32x32x16_bf16(__builtin_bit_cast(bf16x8, vw), Pf, O0, 0, 0, 0); }
                    { const u32x2 va = *(const LAS u32x2*)(vp + 32 * 136), vb = *(const LAS u32x2*)(vp + 32 * 136 + 16); u32x4 vw; vw.x = va.x; vw.y = va.y; vw.z = vb.x; vw.w = vb.y;
                      O1 = __builtin_amdgcn_mfma_f32_32x32x16_bf16(__builtin_bit_cast(bf16x8, vw), Pf, O1, 0, 0, 0); }
                    OL = __builtin_amdgcn_mfma_f32_32x32x16_bf16(ones8, Pf, OL, 0, 0, 0);
                }
        };
        __syncthreads();
        constexpr int SUB_B = KT_B + VT_B, SUP_B = 2 * SUB_B;
        const int nst = nt >> 1;
        u32x4 ka0, kb0, va0, vb0, ka1, kb1, va1, vb1;
#define ATT_LOAD(KA, KB_, VA, VB, ST) do { KA = *(const u32x4*)(kg + (size_t)(2 * (ST)) * 64 * 2304); KB_ = *(const u32x4*)(kg + (size_t)(2 * (ST) + 1) * 64 * 2304); \
            VA = *(const u32x4*)(vg + (2 * (ST)) * 64); VB = *(const u32x4*)(vg + (2 * (ST) + 1) * 64); } while (0)
#define ATT_STORE(KA, KB_, VA, VB, BUF) do { LAS unsigned char* kd_ = kdst + (BUF) * SUP_B; LAS unsigned char* vd_ = vdst + (BUF) * SUP_B; \
            *(LAS u32x4*)kd_ = KA; *(LAS u32x2*)vd_ = (u32x2){VA.x, VA.y}; *(LAS u32x2*)(vd_ + 8) = (u32x2){VA.z, VA.w}; \
            *(LAS u32x4*)(kd_ + SUB_B) = KB_; *(LAS u32x2*)(vd_ + SUB_B) = (u32x2){VB.x, VB.y}; *(LAS u32x2*)(vd_ + SUB_B + 8) = (u32x2){VB.z, VB.w}; } while (0)
        u64x2 mwA = *(const u64x2*)mrow, mwB = mwA;
        ATT_LOAD(ka0, kb0, va0, vb0, 0); ATT_STORE(ka0, kb0, va0, vb0, 0);
        if (nst > 1) ATT_LOAD(ka1, kb1, va1, vb1, 1);
        __syncthreads();
        for (int st = 0; st < nst; st += 2) {
            if (st + 1 < nst) mwB = *(const u64x2*)(mrow + 2 * (st + 1));
            if (st + 2 < nst) ATT_LOAD(ka0, kb0, va0, vb0, st + 2);
            if (2 * st < my_nt) tile(2 * st, 0, mwA.x);
            if (2 * st + 1 < my_nt) tile(2 * st + 1, SUB_B, mwA.y);
            if (st + 1 < nst) ATT_STORE(ka1, kb1, va1, vb1, 1);
            __syncthreads();
            if (st + 1 >= nst) break;
            if (st + 2 < nst) mwA = *(const u64x2*)(mrow + 2 * (st + 2));
            if (st + 3 < nst) ATT_LOAD(ka1, kb1, va1, vb1, st + 3);
            if (2 * st + 2 < my_nt) tile(2 * st + 2, SUP_B, mwB.x);
            if (2 * st + 3 < my_nt) tile(2 * st + 3, SUP_B + SUB_B, mwB.y);
            if (st + 2 < nst) ATT_STORE(ka0, kb0, va0, vb0, 0);
            __syncthreads();
        }
#undef ATT_LOAD
#undef ATT_STORE
        const float inv = __builtin_amdgcn_rcpf(OL[0]);
        bf16_t* op = OA + (size_t)(b * S_ + t) * 512 + head * 64 + 4 * hh;
#pragma unroll
        for (int g = 0; g < 4; ++g) {
            u32x2 wa; wa.x = cvt_pk_bf16(O0[4 * g] * inv, O0[4 * g + 1] * inv); wa.y = cvt_pk_bf16(O0[4 * g + 2] * inv, O0[4 * g + 3] * inv);
            *(u32x2*)(op + 8 * g) = wa;
            u32x2 wb; wb.x = cvt_pk_bf16(O1[4 * g] * inv, O1[4 * g + 1] * inv); wb.y = cvt_pk_bf16(O1[4 * g + 2] * inv, O1[4 * g + 3] * inv);
            *(u32x2*)(op + 32 + 8 * g) = wb;
        }
    }
}

#define DSR4(A, addr, o0, o1, o2, o3) asm volatile("ds_read_b128 %0, %4 offset:%5\n\tds_read_b128 %1, %4 offset:%6\n\tds_read_b128 %2, %4 offset:%7\n\tds_read_b128 %3, %4 offset:%8" \
    : "=&v"(A[0]), "=&v"(A[1]), "=&v"(A[2]), "=&v"(A[3]) : "v"(addr), "i"(o0), "i"(o1), "i"(o2), "i"(o3))
#define DSW(A, N) asm volatile("s_waitcnt lgkmcnt(" #N ")" : "+v"(A[0]), "+v"(A[1]), "+v"(A[2]), "+v"(A[3]))
#define DSRV(V, addr, off) asm volatile("ds_read_b32 %0, %1 offset:%2" : "=&v"(V) : "v"(addr), "i"(off))
#define DSWV(A, V, N) asm volatile("s_waitcnt lgkmcnt(" #N ")" : "+v"(A[0]), "+v"(A[1]), "+v"(A[2]), "+v"(A[3]), "+v"(V))
#define SCAN_A(X, G) _Pragma("unroll") for (int i_ = 0; i_ < 4; ++i_) { const f32x2 k01 = {X[i_][0], X[i_][1]}, k23 = {X[i_][2], X[i_][3]}; \
    sa0 += S2[8 * G + 2 * i_] * k01; sa1 += S2[8 * G + 2 * i_ + 1] * k23; sp0 += Pm2[8 * G + 2 * i_] * k01; sp1 += Pm2[8 * G + 2 * i_ + 1] * k23; }
#define SCAN_B(X, C) { const int j = 2 * C; \
    { const f32x2 w = {X[0][0], X[0][1]}, kb = {X[1][0], X[1][1]}, kk = {X[2][0], X[2][1]}, rr = {X[3][0], X[3][1]}; \
      S2[j] = S2[j] * w + sav * kb + vv2 * kk; Pm2[j] = Pm2[j] * w + spv * kb; y0 += S2[j] * rr; p0 += Pm2[j] * rr; } \
    { const f32x2 w = {X[0][2], X[0][3]}, kb = {X[1][2], X[1][3]}, kk = {X[2][2], X[2][3]}, rr = {X[3][2], X[3][3]}; \
      S2[j + 1] = S2[j + 1] * w + sav * kb + vv2 * kk; Pm2[j + 1] = Pm2[j + 1] * w + spv * kb; y1 += S2[j + 1] * rr; p1 += Pm2[j + 1] * rr; } }
__device__ __forceinline__ float wave_sum_dpp(float v) {
    v += __int_as_float(__builtin_amdgcn_update_dpp(0, __float_as_int(v), 0x111, 0xf, 0xf, true));
    v += __int_as_float(__builtin_amdgcn_update_dpp(0, __float_as_int(v), 0x112, 0xf, 0xf, true));
    v += __int_as_float(__builtin_amdgcn_update_dpp(0, __float_as_int(v), 0x114, 0xf, 0xf, true));
    v += __int_as_float(__builtin_amdgcn_update_dpp(0, __float_as_int(v), 0x118, 0xf, 0xf, true));
    v += __int_as_float(__builtin_amdgcn_update_dpp(0, __float_as_int(v), 0x142, 0xa, 0xf, false));
    v += __int_as_float(__builtin_amdgcn_update_dpp(0, __float_as_int(v), 0x143, 0xc, 0xf, false));
    return __int_as_float(__builtin_amdgcn_readlane(__float_as_int(v), 63));
}
__device__ __forceinline__ void wave_sum2_dpp(float a, float b, float& ra, float& rb) {
    const auto sw = __builtin_amdgcn_permlane32_swap(__float_as_uint(a), __float_as_uint(b), false, false);
    float v = __uint_as_float(sw[0]) + __uint_as_float(sw[1]);
    v += __int_as_float(__builtin_amdgcn_update_dpp(0, __float_as_int(v), 0x111, 0xf, 0xf, true));
    v += __int_as_float(__builtin_amdgcn_update_dpp(0, __float_as_int(v), 0x112, 0xf, 0xf, true));
    v += __int_as_float(__builtin_amdgcn_update_dpp(0, __float_as_int(v), 0x114, 0xf, 0xf, true));
    v += __int_as_float(__builtin_amdgcn_update_dpp(0, __float_as_int(v), 0x118, 0xf, 0xf, true));
    v += __int_as_float(__builtin_amdgcn_update_dpp(0, __float_as_int(v), 0x142, 0xa, 0xf, false));
    ra = __int_as_float(__builtin_amdgcn_readlane(__float_as_int(v), 31)); rb = __int_as_float(__builtin_amdgcn_readlane(__float_as_int(v), 63));
}
__device__ __forceinline__ void ph_scan(const Params& P, int l, LAS unsigned char* lds) {
    LAS bf16_t* LI = (LAS bf16_t*)lds;
    LAS float* SIN = (LAS float*)(lds + 32768);
    const bf16_t* ZR = (const bf16_t*)(P.ws + OFF_ZR);
    const float* mu = P.mu + (size_t)l * 1792;
    const bf16_t* LW = (const bf16_t*)(P.ws + OFF_WB + WB_LW); const bf16_t* LA = (const bf16_t*)(P.ws + OFF_WB + WB_LA); const bf16_t* LG = (const bf16_t*)(P.ws + OFF_WB + WB_LG);
    bf16_t* Yo = (bf16_t*)(P.ws + OFF_Y); bf16_t* Po = (bf16_t*)(P.ws + OFF_P); bf16_t* Go = (bf16_t*)(P.ws + OFF_G); bf16_t* VBo = (bf16_t*)(P.ws + OFF_VB);
    float* SEGp = (float*)(P.ws + OFF_SEG);
    const int tid = opaque_tid(), wid = __builtin_amdgcn_readfirstlane(tid >> 6), lane = tid & 63;
    for (int blk = blockIdx.x; blk < NB_ * NSEG; blk += gridDim.x) {
        const int b = blk / NSEG, seg = blk % NSEG, tbeg = seg * SEGL;
        f32x2 S2[32], Pm2[32];
        { int lq = threadIdx.x; asm volatile("" : "+v"(lq)); lq &= 63;
#pragma unroll
          for (int j = 0; j < 32; ++j) { S2[j] = (f32x2){0.f, 0.f}; Pm2[j] = (f32x2){(2 * j == lq) ? 1.f : 0.f, (2 * j + 1 == lq) ? 1.f : 0.f}; } }
        for (int half = 0; half < 2; ++half) {
            __syncthreads();
            {
                int tq = threadIdx.x; asm volatile("" : "+v"(tq));
#pragma unroll 1
                for (int rnd = 0; rnd < 4; ++rnd) {
                    const int q = tq + NTHR * rnd, tok = q >> 5, c8 = (q & 31) * 8, t = tbeg + 64 * half + tok; const size_t row = (size_t)b * S_ + t;
                    const u32x4 zc = *(const u32x4*)(ZR + row * 1792 + 1536 + c8);
                    u32x4 zp; zp.x = 0u; zp.y = 0u; zp.z = 0u; zp.w = 0u; if (t > 0) zp = *(const u32x4*)(ZR + (row - 1) * 1792 + 1536 + c8);
                    const f32x4 ma = *(const f32x4*)(mu + 1536 + c8), mb = *(const f32x4*)(mu + 1536 + c8 + 4);
                    const unsigned cw[4] = {zc.x, zc.y, zc.z, zc.w}, pw[4] = {zp.x, zp.y, zp.z, zp.w};
                    float x[8];
#pragma unroll
                    for (int q2 = 0; q2 < 4; ++q2) { const float c0 = bflo(cw[q2]), c1 = bfhi(cw[q2]), p0 = bflo(pw[q2]), p1 = bfhi(pw[q2]);
                        const float m0 = q2 < 2 ? ma[2 * q2] : mb[2 * q2 - 4], m1 = q2 < 2 ? ma[2 * q2 + 1] : mb[2 * q2 - 3];
                        x[2 * q2] = c0 + (p0 - c0) * m0; x[2 * q2 + 1] = c1 + (p1 - c1) * m1; }
#pragma unroll
                    for (int e = 0; e < 8; ++e) { if (c8 < 64) x[e] = 1.0f - 2.0f * __builtin_amdgcn_rcpf(1.0f + __expf(2.0f * x[e])); else if (c8 >= 128) x[e] = sigmoidf_(x[e]); }
                    u32x4 w; w.x = cvt_pk_bf16(x[0], x[1]); w.y = cvt_pk_bf16(x[2], x[3]); w.z = cvt_pk_bf16(x[4], x[5]); w.w = cvt_pk_bf16(x[6], x[7]);
                    *(LAS u32x4*)(LI + tok * 256 + c8) = w;
                }
            }
            __syncthreads();
            float* los = (float*)(P.ws + OFF_SCR) + (size_t)(blk * 8 + wid) * (64 * 2 * 64);
            {
                int tq = threadIdx.x; asm volatile("" : "+v"(tq));
                const int lq = tq & 63, fr = lq & 15, kq = lq >> 4;
#pragma unroll 1
                for (int pass = 0; pass < 8; ++pass) {
                    const int kind = pass < 2 ? 0 : (pass < 4 ? 1 : 2), Kk = kind == 2 ? 128 : 64, aoff = kind * 64, nb0 = kind == 2 ? pass - 4 : 2 * (pass & 1);
                    const bf16_t* Wt = kind == 0 ? LW : (kind == 1 ? LA : LG);
                    bf16x8 Bf[4];
#pragma unroll
                    for (int q = 0; q < 4; ++q) { const int nb = kind == 2 ? nb0 : nb0 + (q >> 1), ks = kind == 2 ? q : (q & 1);
                        Bf[q] = *(const bf16x8*)(Wt + (size_t)(64 * wid + 16 * nb + fr) * Kk + 32 * ks + 8 * kq); }
#pragma unroll 1
                    for (int tt = 0; tt < 4; ++tt) {
                        f32x4 acc[2];
                        acc[0] = (f32x4){0.f, 0.f, 0.f, 0.f}; acc[1] = acc[0];
#pragma unroll
                        for (int q = 0; q < 4; ++q) { const int ai = kind == 2 ? 0 : (q >> 1), ks = kind == 2 ? q : (q & 1);
                            const bf16x8 Afr = *(const LAS bf16x8*)(LI + (16 * tt + fr) * 256 + aoff + 32 * ks + 8 * kq);
                            acc[ai] = __builtin_amdgcn_mfma_f32_16x16x32_bf16(Afr, Bf[q], acc[ai], 0, 0, 0); }
                        if (kind == 2) {
#pragma unroll
                            for (int r = 0; r < 4; ++r) Go[((size_t)b * S_ + tbeg + 64 * half + 16 * tt + 4 * kq + r) * 512 + 64 * wid + 16 * nb0 + fr] = f2bf(acc[0][r]);
                        } else {
#pragma unroll
                            for (int ai = 0; ai < 2; ++ai)
#pragma unroll
                                for (int r = 0; r < 4; ++r) los[((16 * tt + 4 * kq + r) * 2 + kind) * 64 + 16 * (nb0 + ai) + fr] = acc[ai][r];
                        }
                    }
                }
            }
            asm volatile("s_waitcnt vmcnt(0)" ::: "memory");
            for (int sb = 0; sb < 64 / TB; ++sb) {
                const int ts = tbeg + 64 * half + sb * TB;
                int tz = threadIdx.x; asm volatile("" : "+v"(tz));
                const int lz = tz & 63;
                LAS float* sw = SIN + (size_t)wid * (TB * 6 * 64);
                {
                    const int c = 64 * wid + lz; const size_t row0 = (size_t)b * S_ + ts;
                    const float mur = mu[c], muk = mu[512 + c], muv = mu[1024 + c];
                    const float pw0 = P.w0[l * 512 + c], pa0 = P.a0[l * 512 + c], pkk = P.k_k[l * 512 + c], pka = P.k_a[l * 512 + c], prk = P.r_k[l * 512 + c];
                    const float* lo = los + (size_t)(sb * TB) * 128 + lz;
                    float zr_[TB + 1], zk_[TB + 1], zv_[TB + 1], wl_[TB], al_[TB];
                    zr_[0] = 0.f; zk_[0] = 0.f; zv_[0] = 0.f;
                    if (ts > 0) { zr_[0] = bf2f(ZR[(row0 - 1) * 1792 + c]); zk_[0] = bf2f(ZR[(row0 - 1) * 1792 + 512 + c]); zv_[0] = bf2f(ZR[(row0 - 1) * 1792 + 1024 + c]); }
#pragma unroll
                    for (int tk = 0; tk < TB; ++tk) {
                        zr_[tk + 1] = bf2f(ZR[(row0 + tk) * 1792 + c]); zk_[tk + 1] = bf2f(ZR[(row0 + tk) * 1792 + 512 + c]); zv_[tk + 1] = bf2f(ZR[(row0 + tk) * 1792 + 1024 + c]);
                        wl_[tk] = lo[tk * 128]; al_[tk] = lo[tk * 128 + 64]; }
#pragma unroll
                    for (int tk = 0; tk < TB; ++tk) {
                        const size_t row = row0 + tk; LAS float* st = sw + tk * 6 * 64;
                        const float cr = zr_[tk + 1], ck = zk_[tk + 1], cv = zv_[tk + 1], wl = wl_[tk], al = al_[tk];
                        const float rr = cr + (zr_[tk] - cr) * mur, kv = ck + (zk_[tk] - ck) * muk, vv = cv + (zv_[tk] - cv) * muv;
                        const float dc = __builtin_amdgcn_exp2f(-0.87503877f * __builtin_amdgcn_rcpf(1.0f + __builtin_amdgcn_exp2f(-1.44269504f * (pw0 + wl))));
                        const float av = sigmoidf_(pa0 + al);
                        const float kkv = kv * pkk;
                        const float km = kv * (1.0f + (av - 1.0f) * pka);
                        float ss, bon; wave_sum2_dpp(kkv * kkv, rr * km * prk, ss, bon);
                        const float kkn = kkv * __builtin_amdgcn_rsqf(fmaxf(ss, 1e-24f));
                        st[lz] = rr; st[64 + lz] = dc; st[2 * 64 + lz] = km; st[3 * 64 + lz] = -kkn; st[4 * 64 + lz] = kkn * av; st[5 * 64 + lz] = vv;
                        VBo[row * 512 + c] = f2bf(bon * vv);
                    }
                }
                {
                const unsigned sq0 = (unsigned)(uintptr_t)sw, va0 = sq0 + 4u * (unsigned)lz;
                f32x4 X0[4], X1[4], X2[4]; float vin;
                DSRV(vin, va0, 1280);
                DSR4(X2, sq0, 896, 912, 928, 944);
                DSR4(X0, sq0, 768, 784, 800, 816);
                DSR4(X1, sq0, 832, 848, 864, 880);
#pragma unroll 1
                for (int tk = 0; tk < TB; ++tk) {
                    f32x2 sa0 = {0.f, 0.f}, sa1 = {0.f, 0.f}, sp0 = {0.f, 0.f}, sp1 = {0.f, 0.f};
                    f32x2 y0 = {0.f, 0.f}, y1 = {0.f, 0.f}, p0 = {0.f, 0.f}, p1 = {0.f, 0.f};
                    f32x2 sav, spv;
                    const unsigned sqa = sq0 + 1536u * (unsigned)tk, vna = va0 + 1536u * (unsigned)tk;
                    DSWV(X0, vin, 4);
                    const f32x2 vv2 = {vin, vin};
                    SCAN_A(X0, 0);
                    DSR4(X0, sqa, 960, 976, 992, 1008);
                    DSW(X1, 4);
                    SCAN_A(X1, 1);
                    DSR4(X1, sqa, 256, 1024, 512, 0);
                    DSW(X2, 8);
                    SCAN_A(X2, 2);
                    DSR4(X2, sqa, 272, 1040, 528, 16);
                    DSW(X0, 8);
                    SCAN_A(X0, 3);
                    { const float sa = (sa0.x + sa0.y) + (sa1.x + sa1.y), sp = (sp0.x + sp0.y) + (sp1.x + sp1.y); sav = (f32x2){sa, sa}; spv = (f32x2){sp, sp}; }
                    DSR4(X0, sqa, 288, 1056, 544, 32);
                    DSW(X1, 8);
                    SCAN_B(X1, 0);
                    DSR4(X1, sqa, 304, 1072, 560, 48);
                    DSW(X2, 8);
                    SCAN_B(X2, 1);
                    DSR4(X2, sqa, 320, 1088, 576, 64);
                    DSW(X0, 8);
                    SCAN_B(X0, 2);
                    DSR4(X0, sqa, 336, 1104, 592, 80);
                    DSW(X1, 8);
                    SCAN_B(X1, 3);
                    DSR4(X1, sqa, 352, 1120, 608, 96);
                    DSW(X2, 8);
                    SCAN_B(X2, 4);
                    DSR4(X2, sqa, 368, 1136, 624, 112);
                    DSW(X0, 8);
                    SCAN_B(X0, 5);
                    DSR4(X0, sqa, 384, 1152, 640, 128);
                    DSW(X1, 8);
                    SCAN_B(X1, 6);
                    DSR4(X1, sqa, 400, 1168, 656, 144);
                    DSW(X2, 8);
                    SCAN_B(X2, 7);
                    DSR4(X2, sqa, 416, 1184, 672, 160);
                    DSW(X0, 8);
                    SCAN_B(X0, 8);
                    DSR4(X0, sqa, 432, 1200, 688, 176);
                    DSW(X1, 8);
                    SCAN_B(X1, 9);
                    DSR4(X1, sqa, 448, 1216, 704, 192);
                    DSW(X2, 8);
                    SCAN_B(X2, 10);
                    DSR4(X2, sqa, 464, 1232, 720, 208);
                    DSW(X0, 8);
                    SCAN_B(X0, 11);
                    DSR4(X0, sqa, 480, 1248, 736, 224);
                    DSW(X1, 8);
                    SCAN_B(X1, 12);
                    DSR4(X1, sqa, 496, 1264, 752, 240);
                    DSW(X2, 8);
                    SCAN_B(X2, 13);
                    {
                        const unsigned nx = (tk + 1 < TB) ? 1536u : 0u, sqn = sqa + nx, vnn = vna + nx;
                        DSRV(vin, vnn, 1280);
                        DSR4(X2, sqn, 896, 912, 928, 944);
                        DSW(X0, 9);
                        SCAN_B(X0, 14);
                        DSR4(X0, sqn, 768, 784, 800, 816);
                        DSW(X1, 9);
                        SCAN_B(X1, 15);
                        DSR4(X1, sqn, 832, 848, 864, 880);
                    }
                    const size_t row = (size_t)b * S_ + ts + tk;
                    Yo[row * 512 + 64 * wid + lz] = f2bf((y0.x + y0.y) + (y1.x + y1.y));
                    Po[row * 512 + 64 * wid + lz] = f2bf((p0.x + p0.y) + (p1.x + p1.y));
                }
                asm volatile("s_waitcnt lgkmcnt(0)" : "+v"(X0[0]), "+v"(X0[1]), "+v"(X0[2]), "+v"(X0[3]), "+v"(X1[0]), "+v"(X1[1]), "+v"(X1[2]), "+v"(X1[3]),
                             "+v"(X2[0]), "+v"(X2[1]), "+v"(X2[2]), "+v"(X2[3]), "+v"(vin));
                }
            }
        }
        {
            int lq = threadIdx.x; asm volatile("" : "+v"(lq)); lq &= 63;
            float* sg = SEGp + ((size_t)((b * 8 + wid) * NSEG + seg)) * 8192 + lq * 64;
#pragma unroll
            for (int j = 0; j < 32; j += 2) { *(f32x4*)(sg + 2 * j) = (f32x4){Pm2[j].x, Pm2[j].y, Pm2[j + 1].x, Pm2[j + 1].y};
                *(f32x4*)(sg + 4096 + 2 * j) = (f32x4){S2[j].x, S2[j].y, S2[j + 1].x, S2[j + 1].y}; }
        }
    }
}

__device__ __forceinline__ void ph_comb(const Params& P, LAS unsigned char* lds) {
    LAS float* SI = (LAS float*)lds;
    LAS float* PB = (LAS float*)(lds + 20480);
    float* SEGp = (float*)(P.ws + OFF_SEG);
    const int tid = opaque_tid(), wid = __builtin_amdgcn_readfirstlane(tid >> 6), lane = tid & 63, m = lane & 31, hh = lane >> 5;
    for (int chain = blockIdx.x; chain < 64; chain += gridDim.x) {
        float* base = SEGp + (size_t)chain * NSEG * 8192;
        __syncthreads();
        for (int i = tid; i < 4096; i += NTHR) SI[(i >> 6) * 65 + (i & 63)] = base[4096 + i];
        { const f32x4 a = *(const f32x4*)(base + 8192 + tid * 8), c = *(const f32x4*)(base + 8192 + tid * 8 + 4);
          *(LAS f32x4*)(PB + 4096 + tid * 8) = a; *(LAS f32x4*)(PB + 4096 + tid * 8 + 4) = c; }
        __syncthreads();
        const int ti = (wid >> 1) & 1, tj = wid & 1;
        for (int k = 1; k <= NSEG - 2; ++k) {
            float* Q = base + (size_t)k * 8192 + 4096;
            const LAS float* Pb = PB + (k & 1) * 4096;
            f32x4 na = {0.f, 0.f, 0.f, 0.f}, nc = na;
            if (k + 1 <= NSEG - 2) { const float* pn = base + (size_t)(k + 1) * 8192 + tid * 8; na = *(const f32x4*)pn; nc = *(const f32x4*)(pn + 4); }
            f32x16 Dv;
            if (wid < 4) {
                float qv[16];
#pragma unroll
                for (int r = 0; r < 16; ++r) { const int row = 32 * ti + (r & 3) + 8 * (r >> 2) + 4 * hh; qv[r] = Q[row * 64 + 32 * tj + m]; Dv[r] = 0.f; }
#pragma unroll
                for (int kk = 0; kk < 32; ++kk) { const float a = SI[(32 * ti + m) * 65 + 2 * kk + hh], bq = Pb[(2 * kk + hh) * 64 + 32 * tj + m];
                    Dv = __builtin_amdgcn_mfma_f32_32x32x2f32(a, bq, Dv, 0, 0, 0); }
#pragma unroll
                for (int r = 0; r < 16; ++r) Dv[r] += qv[r];
            }
            __syncthreads();
            if (wid < 4) {
#pragma unroll
                for (int r = 0; r < 16; ++r) { const int row = 32 * ti + (r & 3) + 8 * (r >> 2) + 4 * hh; SI[row * 65 + 32 * tj + m] = Dv[r]; Q[row * 64 + 32 * tj + m] = Dv[r]; }
            }
            if (k + 1 <= NSEG - 2) { LAS float* pd = PB + ((k + 1) & 1) * 4096 + tid * 8; *(LAS f32x4*)pd = na; *(LAS f32x4*)(pd + 4) = nc; }
            __syncthreads();
        }
    }
}

__device__ __forceinline__ void ph_post(const Params& P, int l) {
    const bf16_t* Yo = (const bf16_t*)(P.ws + OFF_Y); const bf16_t* Po = (const bf16_t*)(P.ws + OFF_P); const bf16_t* Go = (const bf16_t*)(P.ws + OFF_G);
    const bf16_t* VBo = (const bf16_t*)(P.ws + OFF_VB); const float* SEGp = (const float*)(P.ws + OFF_SEG); bf16_t* OR = (bf16_t*)(P.ws + OFF_ORWKV);
    const int tid = opaque_tid(), wid = __builtin_amdgcn_readfirstlane(tid >> 6), lane = tid & 63, m = lane & 31, hh = lane >> 5;
    for (int blk = blockIdx.x; blk < NB_ * NSEG; blk += gridDim.x) {
        const int b = blk / NSEG, seg = blk % NSEG, tbeg = seg * SEGL;
        bf16x8 SIf[2][4];
        if (seg > 0) {
            const float* sg = SEGp + ((size_t)((b * 8 + wid) * NSEG + seg - 1)) * 8192 + 4096;
#pragma unroll
            for (int ib = 0; ib < 2; ++ib)
#pragma unroll
                for (int ks = 0; ks < 4; ++ks) { const float* sp = sg + (32 * ib + m) * 64 + 16 * ks + 8 * hh; const f32x4 a = *(const f32x4*)sp, c = *(const f32x4*)(sp + 4);
                    u32x4 w; w.x = cvt_pk_bf16(a[0], a[1]); w.y = cvt_pk_bf16(a[2], a[3]); w.z = cvt_pk_bf16(c[0], c[1]); w.w = cvt_pk_bf16(c[2], c[3]); SIf[ib][ks] = __builtin_bit_cast(bf16x8, w); }
        }
        float lnw[32], lnb[32];
#pragma unroll
        for (int q = 0; q < 32; ++q) { const int ch = 64 * wid + 32 * (q >> 4) + (q & 3) + 8 * ((q & 15) >> 2) + 4 * hh; lnw[q] = P.ln_w[l * 512 + ch]; lnb[q] = P.ln_b[l * 512 + ch]; }
#pragma unroll 1
        for (int c = 0; c < SEGL / 32; ++c) {
            const size_t row = (size_t)b * S_ + tbeg + 32 * c + m;
            f32x16 D[2];
#pragma unroll
            for (int r = 0; r < 16; ++r) { D[0][r] = 0.f; D[1][r] = 0.f; }
            if (seg > 0) {
                const bf16_t* pp = Po + row * 512 + 64 * wid + 8 * hh;
#pragma unroll
                for (int ks = 0; ks < 4; ++ks) { const bf16x8 Pf = *(const bf16x8*)(pp + 16 * ks);
                    D[0] = __builtin_amdgcn_mfma_f32_32x32x16_bf16(SIf[0][ks], Pf, D[0], 0, 0, 0); D[1] = __builtin_amdgcn_mfma_f32_32x32x16_bf16(SIf[1][ks], Pf, D[1], 0, 0, 0); }
            }
            float y[32]; float s = 0.f;
#pragma unroll
            for (int ib = 0; ib < 2; ++ib)
#pragma unroll
                for (int g = 0; g < 4; ++g) { const u32x2 yw = *(const u32x2*)(Yo + row * 512 + 64 * wid + 32 * ib + 8 * g + 4 * hh);
                    y[16 * ib + 4 * g + 0] = bflo(yw.x) + D[ib][4 * g + 0]; y[16 * ib + 4 * g + 1] = bfhi(yw.x) + D[ib][4 * g + 1];
                    y[16 * ib + 4 * g + 2] = bflo(yw.y) + D[ib][4 * g + 2]; y[16 * ib + 4 * g + 3] = bfhi(yw.y) + D[ib][4 * g + 3]; }
#pragma unroll
            for (int q = 0; q < 32; ++q) s += y[q];
            s += shx(s, 32, lane);
            const float mean = s * (1.0f / 64.0f); float qv = 0.f;
#pragma unroll
            for (int q = 0; q < 32; ++q) { y[q] -= mean; qv += y[q] * y[q]; }
            qv += shx(qv, 32, lane);
            const float rstd = rsqrtf(qv * (1.0f / 64.0f) + 64e-5f);
#pragma unroll
            for (int ib = 0; ib < 2; ++ib)
#pragma unroll
                for (int g = 0; g < 4; ++g) { const size_t off = row * 512 + 64 * wid + 32 * ib + 8 * g + 4 * hh;
                    const u32x2 vw = *(const u32x2*)(VBo + off), gw = *(const u32x2*)(Go + off); const int q = 16 * ib + 4 * g;
                    const float o0 = (y[q] * rstd * lnw[q] + lnb[q] + bflo(vw.x)) * bflo(gw.x), o1 = (y[q + 1] * rstd * lnw[q + 1] + lnb[q + 1] + bfhi(vw.x)) * bfhi(gw.x);
                    const float o2 = (y[q + 2] * rstd * lnw[q + 2] + lnb[q + 2] + bflo(vw.y)) * bflo(gw.y), o3 = (y[q + 3] * rstd * lnw[q + 3] + lnb[q + 3] + bfhi(vw.y)) * bfhi(gw.y);
                    u32x2 w; w.x = cvt_pk_bf16(o0, o1); w.y = cvt_pk_bf16(o2, o3); *(u32x2*)(OR + off) = w; }
        }
    }
}

enum { PH_PRO = 0, PH_NORM1, PH_ZQ, PH_IDX, PH_ATT, PH_ZR, PH_SCAN, PH_COMB, PH_POST, PH_ZC, PH_CONV, PH_MERGE, PH_WO, PH_NORM2, PH_UP, PH_U, PH_DOWN, PH_FINAL, PH_COUNT };

template <int PH>
__device__ __forceinline__ void run_phase(const Params& P0, int l, LAS unsigned char* lds) {
    Params P = P0; P.ws = opaque_ptr(P0.ws);
    if constexpr (PH == PH_PRO) { if (l == 0) ph_mod(P, lds); ph_wconv(P, l, lds); }
    if constexpr (PH == PH_NORM1) ph_norm(P, l, 0);
    if constexpr (PH == PH_ZQ) ph_gemm_zq(P, lds);
    if constexpr (PH == PH_IDX) ph_idx(P, lds);
    if constexpr (PH == PH_ATT) ph_att(P, lds);
    if constexpr (PH == PH_ZR) ph_gemm_zr(P, lds);
    if constexpr (PH == PH_SCAN) ph_scan(P, l, lds);
    if constexpr (PH == PH_COMB) ph_comb(P, lds);
    if constexpr (PH == PH_POST) ph_post(P, l);
    if constexpr (PH == PH_ZC) ph_gemm_zc(P, lds);
    if constexpr (PH == PH_CONV) ph_conv(P, l, lds);
    if constexpr (PH == PH_MERGE) ph_gemm_merge(P, lds);
    if constexpr (PH == PH_WO) ph_gemm_wo(P, l, lds);
    if constexpr (PH == PH_NORM2) ph_norm(P, l, 1);
    if constexpr (PH == PH_UP) ph_gemm_up(P, l, lds);
    if constexpr (PH == PH_U) ph_ufix(P, l, lds);
    if constexpr (PH == PH_DOWN) ph_gemm_down(P, l, lds);
    if constexpr (PH == PH_FINAL) ph_final(P);
}

#if MK_SINGLE
__global__ void __launch_bounds__(NTHR, 2) k_mega(Params P) {
    extern __shared__ __attribute__((aligned(16))) unsigned char shm[];
    LAS unsigned char* lds = (LAS unsigned char*)shm;
    LAS unsigned* xbw = (LAS unsigned*)(lds + LDS_BYTES - 16);
    if (threadIdx.x == 0) { xbw[0] = 0u; xbw[1] = 0u; xbw[2] = 0u; xbw[3] = 0u; }
    __syncthreads();
    XcdBarrier bar = xcd_barrier_post((unsigned*)(P.ws + OFF_BAR), (volatile LAS unsigned*)xbw);
#ifndef PROBE_PH
#define PROBE_PH (-1)
#endif
#ifndef PROBE_N
#define PROBE_N 4
#endif
#define PHASE(PH, l) do { unsigned long long t0_ = 0; if (PROBE_PH == PH && blockIdx.x == 0) t0_ = wall_clock64(); \
        run_phase<PH>(P, l, lds); xcd_barrier(bar); \
        if (PROBE_PH == PH && blockIdx.x == 0) { const unsigned long long t1_ = wall_clock64(), d_ = (t1_ - t0_) * PROBE_N; while (wall_clock64() - t1_ < d_) __builtin_amdgcn_s_sleep(8); } } while (0)
#pragma unroll 1
    for (int l = 0; l < 2; ++l) {
        PHASE(PH_PRO, l); PHASE(PH_NORM1, l); PHASE(PH_ZQ, l); PHASE(PH_IDX, l); PHASE(PH_ATT, l); PHASE(PH_ZR, l); PHASE(PH_SCAN, l); PHASE(PH_COMB, l); PHASE(PH_POST, l);
        PHASE(PH_ZC, l); PHASE(PH_CONV, l); PHASE(PH_MERGE, l); PHASE(PH_WO, l); PHASE(PH_NORM2, l); PHASE(PH_UP, l); PHASE(PH_U, l); PHASE(PH_DOWN, l);
    }
    run_phase<PH_FINAL>(P, 0, lds);
#undef PHASE
}
#else
template <int PH>
__global__ void __launch_bounds__(NTHR, 2) k_phase(Params P, int l) {
    extern __shared__ __attribute__((aligned(16))) unsigned char shm[];
    run_phase<PH>(P, l, (LAS unsigned char*)shm);
}
template <int PH> static void launch_phase(const Params& P, int l, hipStream_t stream) {
    static bool attr = false;
    if (!attr) { hipFuncSetAttribute((const void*)k_phase<PH>, hipFuncAttributeMaxDynamicSharedMemorySize, LDS_BYTES); attr = true; }
    hipLaunchKernelGGL(k_phase<PH>, dim3(NBLK), dim3(NTHR), LDS_BYTES, stream, P, l);
}
#endif

extern "C" void kernel_launch(void* const* d_in, const int* in_sizes, int n_in, void* d_out, int out_size, void* d_ws, size_t ws_size, hipStream_t stream) {
    (void)in_sizes; (void)n_in; (void)out_size; (void)ws_size;
    Params P{};
    P.x_in = (const float*)d_in[0]; P.c = (const float*)d_in[1]; P.pos = (const int*)d_in[2]; P.rel_bias = (const float*)d_in[3]; P.final_norm = (const float*)d_in[4];
    P.ada_w = (const float*)d_in[5]; P.ada_b = (const float*)d_in[6]; P.norm_mix = (const float*)d_in[7]; P.w_in = (const float*)d_in[8];
    P.mu = (const float*)d_in[9]; P.w0 = (const float*)d_in[10]; P.w_up = (const float*)d_in[11]; P.a0 = (const float*)d_in[12]; P.a_up = (const float*)d_in[13]; P.g_up = (const float*)d_in[14];
    P.k_k = (const float*)d_in[15]; P.k_a = (const float*)d_in[16]; P.r_k = (const float*)d_in[17]; P.ln_w = (const float*)d_in[18]; P.ln_b = (const float*)d_in[19];
    P.sc_conv_w = (const float*)d_in[20]; P.w_branch = (const float*)d_in[21]; P.w_o = (const float*)d_in[22]; P.norm_ffn = (const float*)d_in[23];
    P.ffn_w_up = (const float*)d_in[24]; P.ffn_conv_w = (const float*)d_in[25]; P.ffn_w_down = (const float*)d_in[26];
    P.out = (float*)d_out; P.ws = (unsigned char*)d_ws;
#if MK_SINGLE
    static bool attr = false;
    if (!attr) { hipFuncSetAttribute((const void*)k_mega, hipFuncAttributeMaxDynamicSharedMemorySize, LDS_BYTES); attr = true; }
    hipMemsetAsync((unsigned char*)d_ws + OFF_BAR, 0, XCD_BAR_WORDS * sizeof(unsigned), stream);
    hipLaunchKernelGGL(k_mega, dim3(NBLK), dim3(NTHR), LDS_BYTES, stream, P);
#else
    for (int l = 0; l < 2; ++l) {
        launch_phase<PH_PRO>(P, l, stream); launch_phase<PH_NORM1>(P, l, stream); launch_phase<PH_ZQ>(P, l, stream); launch_phase<PH_IDX>(P, l, stream);
        launch_phase<PH_ATT>(P, l, stream); launch_phase<PH_ZR>(P, l, stream); launch_phase<PH_SCAN>(P, l, stream); launch_phase<PH_COMB>(P, l, stream);
        launch_phase<PH_POST>(P, l, stream); launch_phase<PH_ZC>(P, l, stream); launch_phase<PH_CONV>(P, l, stream); launch_phase<PH_MERGE>(P, l, stream);
        launch_phase<PH_WO>(P, l, stream); launch_phase<PH_NORM2>(P, l, stream); launch_phase<PH_UP>(P, l, stream); launch_phase<PH_U>(P, l, stream);
        launch_phase<PH_DOWN>(P, l, stream);
    }
    launch_phase<PH_FINAL>(P, 0, stream);
#endif
}
```

```cpp
#include <hip/hip_runtime.h>
#include <stdint.h>

#ifndef MK_SINGLE
#define MK_SINGLE 1
#endif

#define LAS __attribute__((address_space(3)))
typedef unsigned short bf16_t;
typedef short bf16x8 __attribute__((ext_vector_type(8)));
typedef short bf16x4 __attribute__((ext_vector_type(4)));
typedef float f32x4 __attribute__((ext_vector_type(4)));
typedef float f32x16 __attribute__((ext_vector_type(16)));
typedef float f32x2 __attribute__((ext_vector_type(2)));
typedef unsigned u32x4 __attribute__((ext_vector_type(4)));
typedef unsigned u32x2 __attribute__((ext_vector_type(2)));
typedef int i32x4 __attribute__((ext_vector_type(4)));
typedef unsigned long long u64;
typedef unsigned long long u64x2 __attribute__((ext_vector_type(2)));

constexpr int T_ = 32768, D_ = 1024, NB_ = 8, S_ = 4096;
constexpr int NSEG = 32, SEGL = 128, TB = 8;
constexpr int NBLK = 256, NTHR = 512;
constexpr int IN_COLS = 8520, DFF = 2816;
constexpr int LDS_BYTES = 150 * 1024;

constexpr size_t MiB = 1ull << 20;
constexpr size_t OFF_BAR = 0;
constexpr size_t OFF_MOD = 64 * 1024;
constexpr size_t OFF_TAB = 512 * 1024;
constexpr size_t OFF_KPM = 520 * 1024;
constexpr size_t OFF_WB = 2 * MiB;
constexpr size_t WB_WIN = 0;
constexpr size_t WB_WBR = WB_WIN + (size_t)8704 * 1024 * 2;
constexpr size_t WB_WO = WB_WBR + (size_t)3 * 1024 * 512 * 2;
constexpr size_t WB_WUP = WB_WO + (size_t)1024 * 1024 * 2;
constexpr size_t WB_WDN = WB_WUP + (size_t)5632 * 1024 * 2;
constexpr size_t WB_LW = WB_WDN + (size_t)1024 * 2816 * 2;
constexpr size_t WB_LA = WB_LW + (size_t)512 * 64 * 2;
constexpr size_t WB_LG = WB_LA + (size_t)512 * 64 * 2;
constexpr size_t OFF_H = 42 * MiB;
constexpr size_t OFF_ZQ = 106 * MiB;
constexpr size_t OFF_MASK = 250 * MiB;
constexpr size_t OFF_VT = 266 * MiB;
constexpr size_t OFF_ZR = 106 * MiB;
constexpr size_t OFF_Y = 218 * MiB;
constexpr size_t OFF_P = 250 * MiB;
constexpr size_t OFF_G = 282 * MiB;
constexpr size_t OFF_SEG = 314 * MiB;
constexpr size_t OFF_KI = 314 * MiB;
constexpr size_t OFF_ZCV = 106 * MiB;
constexpr size_t OFF_ZG = 202 * MiB;
constexpr size_t OFF_MRG = 106 * MiB;
constexpr size_t OFF_UP = 106 * MiB;
constexpr size_t OFF_HA = 300 * MiB;
constexpr size_t OFF_HB = 320 * MiB;
constexpr size_t OFF_OCONV = 416 * MiB;
constexpr size_t OFF_ORWKV = 448 * MiB;
constexpr size_t OFF_OATT = 480 * MiB;
constexpr size_t OFF_VB = OFF_ORWKV;
constexpr size_t OFF_SCR = 378 * MiB;

struct Params {
    const float* x_in; const float* c; const int* pos; const float* rel_bias; const float* final_norm;
    const float* ada_w; const float* ada_b; const float* norm_mix; const float* w_in;
    const float* mu; const float* w0; const float* w_up; const float* a0; const float* a_up; const float* g_up;
    const float* k_k; const float* k_a; const float* r_k; const float* ln_w; const float* ln_b;
    const float* sc_conv_w; const float* w_branch; const float* w_o; const float* norm_ffn;
    const float* ffn_w_up; const float* ffn_conv_w; const float* ffn_w_down;
    float* out; unsigned char* ws;
};

__device__ __forceinline__ float bf2f(bf16_t b) { return __uint_as_float(((unsigned)b) << 16); }
__device__ __forceinline__ bf16_t f2bf(float f) { unsigned u = __float_as_uint(f); u += 0x7FFFu + ((u >> 16) & 1u); return (bf16_t)(u >> 16); }
typedef __bf16 bf16x2_t __attribute__((ext_vector_type(2)));
__device__ __forceinline__ unsigned cvt_pk_bf16(float lo, float hi) { const f32x2 v = {lo, hi}; return __builtin_bit_cast(unsigned, __builtin_convertvector(v, bf16x2_t)); }
__device__ __forceinline__ float bflo(unsigned w) { return __uint_as_float(w << 16); }
__device__ __forceinline__ float bfhi(unsigned w) { return __uint_as_float(w & 0xffff0000u); }
__device__ __forceinline__ float shx(float v, int mask, int lane) { return __int_as_float(__builtin_amdgcn_ds_bpermute((lane ^ mask) << 2, __float_as_int(v))); }
__device__ __forceinline__ int shxi(int v, int mask, int lane) { return __builtin_amdgcn_ds_bpermute((lane ^ mask) << 2, v); }
__device__ __forceinline__ float wave_sum(float v, int lane) {
#pragma unroll
    for (int o = 32; o >= 1; o >>= 1) v += shx(v, o, lane);
    return v;
}
__device__ __forceinline__ void writelane_c2(int& vlo, int& vhi, int lo, int hi, int ln  ) {
    asm("s_nop 3\n\tv_writelane_b32 %0, %2, %4\n\tv_writelane_b32 %1, %3, %4" : "+v"(vlo), "+v"(vhi) : "s"(lo), "s"(hi), "n"(ln)); }
__device__ __forceinline__ int writelane_v(int vec, int val, int ln  ) { asm("s_mov_b32 m0, %2\n\ts_nop 3\n\tv_writelane_b32 %0, %1, m0" : "+v"(vec) : "s"(val), "s"(ln) : "m0"); return vec; }
__device__ __forceinline__ float sigmoidf_(float x) { return __builtin_amdgcn_rcpf(1.0f + __expf(-x)); }
__device__ __forceinline__ unsigned f2ord(float x) { unsigned u = __float_as_uint(x); return (u & 0x80000000u) ? ~u : (u | 0x80000000u); }
__device__ __forceinline__ float ord2f(unsigned k) { return __uint_as_float((k & 0x80000000u) ? (k & 0x7fffffffu) : ~k); }

__device__ __forceinline__ int opaque_tid() { int t = threadIdx.x; asm volatile("" : "+v"(t)); return t; }
__device__ __forceinline__ unsigned char* opaque_ptr(unsigned char* p) {
    typedef __attribute__((address_space(1))) unsigned char* gptr_t;
    gptr_t g = (gptr_t)p; asm volatile("" : "+s"(g)); return (unsigned char*)g; }

#define XB_TMO      128
#define XB_XCNT(j)  (256  + 64 * (j))
#define XB_XSUB(j)  (1280 + 64 * (j))
#define XB_XGEN(j)  (2304 + 64 * (j))
#define XB_TOP      3328
#define XB_TOPGEN   3392
#define XCD_BAR_WORDS 3456
#define XB_SPIN_CAP (1u << 22)

__device__ __forceinline__ unsigned xb_ld(unsigned* p)              { return __hip_atomic_load(p, __ATOMIC_RELAXED, __HIP_MEMORY_SCOPE_AGENT); }
__device__ __forceinline__ unsigned xb_add(unsigned* p, unsigned v) { return __hip_atomic_fetch_add(p, v, __ATOMIC_RELAXED, __HIP_MEMORY_SCOPE_AGENT); }
__device__ __forceinline__ unsigned xb_xcc_id() { return (unsigned)__builtin_amdgcn_s_getreg((3 << 11) | 20) & 0xFu; }
#define XB_SPIN(cond, bar) do { unsigned _sp = 0; while (cond) { __builtin_amdgcn_s_sleep(1); \
    if ((++_sp & 255u) == 0u) { if (xb_ld(&(bar)[XB_TMO])) break; if (_sp > XB_SPIN_CAP) { atomicAdd(&(bar)[XB_TMO], 1u); break; } } } } while (0)

struct XcdBarrier { unsigned* bar; unsigned x; volatile LAS unsigned* st; };

__device__ __forceinline__ XcdBarrier xcd_barrier_post(unsigned* bar, volatile LAS unsigned* st) {
    XcdBarrier b; b.bar = bar; b.x = xb_xcc_id(); b.st = st;
    if (threadIdx.x == 0) (void)xb_add(&bar[XB_XCNT(b.x)], 1u);
    return b;
}
__device__ __forceinline__ void xcd_barrier_complete(unsigned* bar, unsigned x, unsigned& nloc, unsigned& nx) {
    const unsigned G = gridDim.x * gridDim.y * gridDim.z;
    unsigned sum, cnt, mine, sp = 0u;
    for (;;) {
        sum = 0u; cnt = 0u; mine = 0u;
#pragma unroll
        for (unsigned j = 0; j < 16; ++j) { const unsigned c = xb_ld(&bar[XB_XCNT(j)]); sum += c; cnt += (c > 0u) ? 1u : 0u; mine = (j == x) ? c : mine; }
        if (sum == G) break;
        __builtin_amdgcn_s_sleep(1);
        if ((++sp & 255u) == 0u) { if (xb_ld(&bar[XB_TMO])) break; if (sp > XB_SPIN_CAP) { atomicAdd(&bar[XB_TMO], 1u); break; } }
    }
    nloc = mine > 0u ? mine : 1u; nx = cnt > 0u ? cnt : 1u;
}
__device__ __forceinline__ void xcd_barrier(const XcdBarrier& b) {
    asm volatile("s_waitcnt vmcnt(0)" ::: "memory");
    __syncthreads();
    if (threadIdx.x == 0) {
        unsigned* bar = b.bar;
        __builtin_amdgcn_s_waitcnt(0);
        unsigned nloc = b.st[0], nx = b.st[1];
        if (nloc == 0u) { xcd_barrier_complete(bar, b.x, nloc, nx); b.st[0] = nloc; b.st[1] = nx; }
        const unsigned old = xb_add(&bar[XB_XSUB(b.x)], 1u);
        const unsigned gen = old / nloc;
        if (old + 1u == (gen + 1u) * nloc) {
            __builtin_amdgcn_fence(__ATOMIC_RELEASE, "agent");
            asm volatile("s_waitcnt vmcnt(0)" ::: "memory");
            const unsigned og = xb_add(&bar[XB_TOP], 1u);
            const unsigned tg = og / nx;
            if (og + 1u == (tg + 1u) * nx) xb_add(&bar[XB_TOPGEN], 1u);
            else XB_SPIN(xb_ld(&bar[XB_TOPGEN]) == tg, bar);
            __builtin_amdgcn_fence(__ATOMIC_ACQUIRE, "agent");
            xb_add(&bar[XB_XGEN(b.x)], 1u);
            asm volatile("s_waitcnt vmcnt(0)" ::: "memory");
        } else {
            XB_SPIN(xb_ld(&bar[XB_XGEN(b.x)]) == gen, bar);
            __builtin_amdgcn_fence(__ATOMIC_ACQUIRE, "agent");
            asm volatile("s_waitcnt vmcnt(0)" ::: "memory");
        }
    }
    __syncthreads();
}

namespace g8 {
constexpr int BM = 256, BK = 64, HALF = 128, HTB = HALF * BK * 2, STAGE_BYTES = 8 * HTB, NXCD = 8, WGM = 8;
__device__ __forceinline__ int lds_byte(int r, int c) { const int st = (r >> 4) * 2 + (c >> 5), rr = r & 15, cc = c & 31, ob = rr * 64 + cc * 2; return st * 1024 + (ob ^ (((ob >> 9) & 1) << 5)); }
__device__ __forceinline__ void stage_rc(int b, int& R, int& C) { const int st = b / 1024, sb = b % 1024, swz = sb ^ (((sb >> 9) & 1) << 5); R = (st >> 1) * 16 + swz / 64; C = (st & 1) * 32 + (swz % 64) / 2; }
__device__ __forceinline__ int perm32(int rho) { const int n = rho >> 4, i = rho & 15; return 8 * (i >> 2) + 4 * n + (i & 3); }

struct Unit { const char* A; const char* B; int pm, pn, tag; };

struct SOrder {
    int nM, nN, nwg, G, c; const char* A; const char* Bt; size_t a_t, b_t;
    __device__ void init(int M, int N, int lda, int ldb, const void* A_, const void* Bt_) {
        nM = M / BM; nN = N / BM; nwg = nM * nN; G = (int)gridDim.x; c = (int)blockIdx.x; A = (const char*)A_; Bt = (const char*)Bt_;
        a_t = (size_t)BM * lda * 2; b_t = (size_t)BM * ldb * 2; }
    __device__ bool next(int i, Unit& u) const {
        const long L = (long)i * G + c; if (L >= nwg) return false;
        int wgid = (int)L; { const int q = nwg / NXCD, r = nwg % NXCD, xcd = wgid % NXCD, off = wgid / NXCD; wgid = (xcd < r ? xcd * (q + 1) : r * (q + 1) + (xcd - r) * q) + off; }
        const int nig = WGM * nN, gid = wgid / nig, fm = gid * WGM, gsz = (nM - fm) < WGM ? (nM - fm) : WGM;
        u.pm = fm + ((wgid % nig) % gsz); u.pn = (wgid % nig) / gsz; u.tag = 0;
        u.A = A + (size_t)u.pm * a_t; u.B = Bt + (size_t)u.pn * b_t; return true;
    }
};

template <class Epi, class Sched>
__device__ __forceinline__ void gemm_phase(LAS unsigned char* lds, const int K, const int lda, const int ldb, const Sched& S, const Epi& E) {
    const int tid = opaque_tid(), wid = __builtin_amdgcn_readfirstlane(tid >> 6), lane = tid & 63, wr = wid >> 2, wc = wid & 3, fr = lane & 15, fq = lane >> 4;
    const int nt = K / BK;
    unsigned voffA[2], voffB[2];
#pragma unroll
    for (int i = 0; i < 2; ++i) { int R, C; stage_rc(tid * 16 + i * 8192, R, C); const int Rb = Epi::PERM ? ((R & ~31) + perm32(R & 31)) : R;
        voffA[i] = (unsigned)(R * lda + C) * 2u; voffB[i] = (unsigned)(Rb * ldb + C) * 2u; }
    const size_t kstep = (size_t)(BK * 2);
    const size_t hstepA = (size_t)HALF * lda * 2, hstepB = (size_t)HALF * ldb * 2;
    const unsigned ldsw = (unsigned)wid * 1024u;
    const int aoff = lds_byte(wr * 64 + fr, fq * 8), boff = lds_byte(wc * 32 + fr, fq * 8);
#define PG8_SA(b, h) (((b) * 2 + (h)) * HTB)
#define PG8_SB(b, h) ((4 + (b) * 2 + (h)) * HTB)
#define PG8_STAGE(bufoff, gbase, voff) do { _Pragma("unroll") for (int _i = 0; _i < 2; ++_i) \
        __builtin_amdgcn_global_load_lds((const unsigned*)((const char*)(gbase) + (voff)[_i]), (LAS unsigned*)(lds + (bufoff) + ldsw + _i * 8192), 16, 0, 0); } while (0)
#define PG8_LDA(dst, b, h) do { _Pragma("unroll") for (int m = 0; m < 4; ++m) _Pragma("unroll") for (int k = 0; k < 2; ++k) dst[m][k] = *(const LAS bf16x8*)(lds + PG8_SA(b, h) + aoff + m * 2048 + k * 1024); } while (0)
#define PG8_LDB(dst, b, h) do { _Pragma("unroll") for (int n = 0; n < 2; ++n) _Pragma("unroll") for (int k = 0; k < 2; ++k) dst[n][k] = *(const LAS bf16x8*)(lds + PG8_SB(b, h) + boff + n * 2048 + k * 1024); } while (0)
#define PG8_MMA(ai, bj, At, Bt) do { __builtin_amdgcn_s_setprio(1); _Pragma("unroll") for (int m = 0; m < 4; ++m) _Pragma("unroll") for (int n = 0; n < 2; ++n) _Pragma("unroll") for (int k = 0; k < 2; ++k) \
        acc[ai][bj][m][n] = __builtin_amdgcn_mfma_f32_16x16x32_bf16(Bt[n][k], At[m][k], acc[ai][bj][m][n], 0, 0, 0); __builtin_amdgcn_s_setprio(0); } while (0)
#define PG8_WAIT_V(n) asm volatile("s_waitcnt vmcnt(" #n ")" ::: "memory")
#define PG8_WAIT_L(n) asm volatile("s_waitcnt lgkmcnt(" #n ")" ::: "memory")
#define PG8_BAR __builtin_amdgcn_s_barrier()
#define PG8_SCHED __builtin_amdgcn_sched_barrier(0)
    Unit cur, nxt; int ui = 0;
    if (!S.next(0, cur)) return;
    f32x4 acc[2][2][4][2];
#pragma unroll
    for (int a = 0; a < 2; ++a)
#pragma unroll
        for (int b = 0; b < 2; ++b)
#pragma unroll
            for (int m = 0; m < 4; ++m)
#pragma unroll
                for (int n = 0; n < 2; ++n) acc[a][b][m][n] = (f32x4){0.f, 0.f, 0.f, 0.f};
    bf16x8 At[4][2], B0[2][2], B1[2][2];
    const char* cA = cur.A; const char* cB = cur.B;
    PG8_STAGE(PG8_SB(0, 0), cB, voffB); PG8_STAGE(PG8_SA(0, 0), cA, voffA); PG8_STAGE(PG8_SB(0, 1), cB + hstepB, voffB); PG8_STAGE(PG8_SA(0, 1), cA + hstepA, voffA);
    if (wr == 1) PG8_BAR;
    PG8_WAIT_V(4); PG8_BAR;
    PG8_STAGE(PG8_SB(1, 0), cB + kstep, voffB); PG8_STAGE(PG8_SA(1, 0), cA + kstep, voffA); PG8_STAGE(PG8_SB(1, 1), cB + hstepB + kstep, voffB);
    PG8_WAIT_V(6); PG8_BAR;
    for (;;) {
        const bool has_next = S.next(ui + 1, nxt);
        const char* nA = has_next ? nxt.A : cA; const char* nB = has_next ? nxt.B : cB;
        for (int t = 0; t < nt; t += 2) {
            const bool last = (t == nt - 2);
            const char* a1 = cA + (size_t)(t + 1) * kstep;
            const char* a2 = last ? nA : cA + (size_t)(t + 2) * kstep; const char* b2 = last ? nB : cB + (size_t)(t + 2) * kstep;
            const char* a3 = a2 + kstep; const char* b3 = b2 + kstep;
            PG8_LDB(B0, 0, 0); PG8_SCHED; PG8_LDA(At, 0, 0); PG8_STAGE(PG8_SA(1, 1), a1 + hstepA, voffA);
            PG8_WAIT_L(8); PG8_BAR; PG8_WAIT_L(0); PG8_MMA(0, 0, At, B0); PG8_BAR; PG8_SCHED;
            PG8_LDB(B1, 0, 1); PG8_STAGE(PG8_SB(0, 0), b2, voffB);
            PG8_BAR; PG8_WAIT_L(0); PG8_MMA(0, 1, At, B1); PG8_BAR;
            PG8_LDA(At, 0, 1); PG8_STAGE(PG8_SA(0, 0), a2, voffA);
            PG8_BAR; PG8_WAIT_L(0); PG8_MMA(1, 0, At, B0); PG8_BAR; PG8_SCHED;
            PG8_STAGE(PG8_SB(0, 1), b2 + hstepB, voffB);
            PG8_WAIT_V(6); PG8_BAR; PG8_MMA(1, 1, At, B1); PG8_BAR;
            PG8_LDB(B0, 1, 0); PG8_SCHED; PG8_LDA(At, 1, 0); PG8_STAGE(PG8_SA(0, 1), a2 + hstepA, voffA);
            PG8_WAIT_L(8); PG8_BAR; PG8_WAIT_L(0); PG8_MMA(0, 0, At, B0); PG8_BAR; PG8_SCHED;
            PG8_LDB(B1, 1, 1); PG8_STAGE(PG8_SB(1, 0), b3, voffB);
            PG8_BAR; PG8_WAIT_L(0); PG8_MMA(0, 1, At, B1); PG8_BAR;
            PG8_LDA(At, 1, 1); PG8_STAGE(PG8_SA(1, 0), a3, voffA);
            PG8_BAR; PG8_WAIT_L(0); PG8_MMA(1, 0, At, B0); PG8_BAR; PG8_SCHED;
            PG8_STAGE(PG8_SB(1, 1), b3 + hstepB, voffB);
            PG8_WAIT_V(6); PG8_BAR; PG8_MMA(1, 1, At, B1); PG8_BAR;
        }
        bool keep = false;
        if constexpr (Epi::CHAIN) keep = E.chain(acc, cur, wr, wc, fr, fq); else E(acc, cur, wr, wc, fr, fq);
        if (!has_next) break;
        if (!keep) {
#pragma unroll
            for (int a = 0; a < 2; ++a)
#pragma unroll
                for (int b = 0; b < 2; ++b)
#pragma unroll
                    for (int m = 0; m < 4; ++m)
#pragma unroll
                        for (int n = 0; n < 2; ++n) acc[a][b][m][n] = (f32x4){0.f, 0.f, 0.f, 0.f};
        }
        cur = nxt; cA = nA; cB = nB; ++ui;
    }
    PG8_WAIT_V(0);
    if (wr == 0) PG8_BAR;
    PG8_BAR;
#undef PG8_SA
#undef PG8_SB
#undef PG8_STAGE
#undef PG8_LDA
#undef PG8_LDB
#undef PG8_MMA
#undef PG8_WAIT_V
#undef PG8_WAIT_L
#undef PG8_BAR
#undef PG8_SCHED
}

struct EpiBf {
    static constexpr bool PERM = true, CHAIN = false;
    bf16_t* O0; int ld0; int split; bf16_t* O1; int ld1; int act1;
    __device__ __forceinline__ void operator()(const f32x4 (&acc)[2][2][4][2], const Unit& u, int wr, int wc, int fr, int fq) const {
        const bool second = u.pn >= split;
        bf16_t* base = second ? O1 : O0; const int ld = second ? ld1 : ld0; const int colt = (second ? (u.pn - split) : u.pn) * BM;
        const bool act = second && act1;
        const int row0 = u.pm * BM + wr * 64 + fr, col0 = colt + wc * 32 + 8 * fq;
#pragma unroll
        for (int ai = 0; ai < 2; ++ai)
#pragma unroll
            for (int m = 0; m < 4; ++m) { bf16_t* rowp = base + (size_t)(row0 + ai * HALF + m * 16) * ld + col0;
#pragma unroll
                for (int bj = 0; bj < 2; ++bj) { f32x4 v0 = acc[ai][bj][m][0], v1 = acc[ai][bj][m][1];
                    if (act) {
#pragma unroll
                        for (int j = 0; j < 4; ++j) { v0[j] = sigmoidf_(v0[j]); v1[j] = sigmoidf_(v1[j]); } }
                    u32x4 w; w.x = cvt_pk_bf16(v0[0], v0[1]); w.y = cvt_pk_bf16(v0[2], v0[3]); w.z = cvt_pk_bf16(v1[0], v1[1]); w.w = cvt_pk_bf16(v1[2], v1[3]);
                    *(u32x4*)(rowp + bj * HALF) = w; } }
    }
};
struct EpiMerge {
    static constexpr bool PERM = true, CHAIN = true;
    bf16_t* M; const bf16_t* ZG;
    __device__ __forceinline__ bool chain(f32x4 (&acc)[2][2][4][2], const Unit& u, int wr, int wc, int fr, int fq) const {
        const int row0 = u.pm * BM + wr * 64 + fr, col0 = u.pn * BM + wc * 32 + 8 * fq;
#pragma unroll
        for (int ai = 0; ai < 2; ++ai)
#pragma unroll
            for (int m = 0; m < 4; ++m) { const size_t r = (size_t)(row0 + ai * HALF + m * 16);
#pragma unroll
                for (int bj = 0; bj < 2; ++bj) {
                    const bf16_t* gp = ZG + r * 3072 + col0 + bj * HALF;
                    float f[8];
                    if (u.tag == 2) { const u32x4 g = *(const u32x4*)(gp + 2048);
                        f[0] = bflo(g.x); f[1] = bfhi(g.x); f[2] = bflo(g.y); f[3] = bfhi(g.y); f[4] = bflo(g.z); f[5] = bfhi(g.z); f[6] = bflo(g.w); f[7] = bfhi(g.w);
#pragma unroll
                        for (int e = 0; e < 8; ++e) f[e] = fmaxf(f[e], 1e-12f);
                    } else { const u32x4 gn = *(const u32x4*)(gp + u.tag * 1024), gd = *(const u32x4*)(gp + (u.tag + 1) * 1024);
                        const float nn[8] = {bflo(gn.x), bfhi(gn.x), bflo(gn.y), bfhi(gn.y), bflo(gn.z), bfhi(gn.z), bflo(gn.w), bfhi(gn.w)};
                        const float dd[8] = {bflo(gd.x), bfhi(gd.x), bflo(gd.y), bfhi(gd.y), bflo(gd.z), bfhi(gd.z), bflo(gd.w), bfhi(gd.w)};
#pragma unroll
                        for (int e = 0; e < 8; ++e) f[e] = (u.tag == 0 ? nn[e] : fmaxf(nn[e], 1e-12f)) * __builtin_amdgcn_rcpf(fmaxf(dd[e], 1e-12f)); }
                    f32x4& v0 = acc[ai][bj][m][0]; f32x4& v1 = acc[ai][bj][m][1];
                    v0[0] *= f[0]; v0[1] *= f[1]; v0[2] *= f[2]; v0[3] *= f[3]; v1[0] *= f[4]; v1[1] *= f[5]; v1[2] *= f[6]; v1[3] *= f[7];
                    if (u.tag == 2) { u32x4 w; w.x = cvt_pk_bf16(v0[0], v0[1]); w.y = cvt_pk_bf16(v0[2], v0[3]); w.z = cvt_pk_bf16(v1[0], v1[1]); w.w = cvt_pk_bf16(v1[2], v1[3]);
                        *(u32x4*)(M + r * 1024 + col0 + bj * HALF) = w; }
                } }
        return u.tag != 2;
    }
};
struct EpiRes {
    static constexpr bool PERM = true, CHAIN = false;
    const float* xin32; const bf16_t* xin16; bf16_t* xout; const float* gate;
    __device__ __forceinline__ void operator()(const f32x4 (&acc)[2][2][4][2], const Unit& u, int wr, int wc, int fr, int fq) const {
        const int row0 = u.pm * BM + wr * 64 + fr, col0 = u.pn * BM + wc * 32 + 8 * fq;
        const float* gp = gate + (size_t)(u.pm >> 4) * 6144 + col0;
        f32x4 gv[2][2];
#pragma unroll
        for (int bj = 0; bj < 2; ++bj) { gv[bj][0] = *(const f32x4*)(gp + bj * HALF); gv[bj][1] = *(const f32x4*)(gp + bj * HALF + 4); }
#pragma unroll
        for (int ai = 0; ai < 2; ++ai)
#pragma unroll
            for (int m = 0; m < 4; ++m) { const size_t off = (size_t)(row0 + ai * HALF + m * 16) * 1024 + col0;
#pragma unroll
                for (int bj = 0; bj < 2; ++bj) {
                    f32x4 x0, x1;
                    if (xin32) { x0 = *(const f32x4*)(xin32 + off + bj * HALF); x1 = *(const f32x4*)(xin32 + off + bj * HALF + 4); }
                    else { const u32x4 xw = *(const u32x4*)(xin16 + off + bj * HALF);
                        x0 = (f32x4){bflo(xw.x), bfhi(xw.x), bflo(xw.y), bfhi(xw.y)}; x1 = (f32x4){bflo(xw.z), bfhi(xw.z), bflo(xw.w), bfhi(xw.w)}; }
                    const f32x4 o0 = x0 + gv[bj][0] * acc[ai][bj][m][0], o1 = x1 + gv[bj][1] * acc[ai][bj][m][1];
                    u32x4 w; w.x = cvt_pk_bf16(o0[0], o0[1]); w.y = cvt_pk_bf16(o0[2], o0[3]); w.z = cvt_pk_bf16(o1[0], o1[1]); w.w = cvt_pk_bf16(o1[2], o1[3]);
                    *(u32x4*)(xout + off + bj * HALF) = w; } }
    }
};
__device__ __forceinline__ float dpp_prev(float x, float y, int n) {
    if (n == 1) { const int yr = __builtin_amdgcn_update_dpp(0, __float_as_int(y), 0x121, 0xf, 0xf, false);
                  return __int_as_float(__builtin_amdgcn_update_dpp(yr, __float_as_int(x), 0x111, 0xf, 0xf, false)); }
    const int yr = __builtin_amdgcn_update_dpp(0, __float_as_int(y), 0x122, 0xf, 0xf, false);
    return __int_as_float(__builtin_amdgcn_update_dpp(yr, __float_as_int(x), 0x112, 0xf, 0xf, false));
}
struct EpiUp {
    static constexpr bool PERM = true, CHAIN = false;
    bf16_t* U; float* HA; float* HB; const float* cw;
    __device__ __forceinline__ void operator()(const f32x4 (&acc)[2][2][4][2], const Unit& u, int wr, int wc, int fr, int fq) const {
        const int c0 = 128 * u.pn + 32 * wc + 8 * fq;
        float w0[8], w1[8], w2[8];
        { float f[24];
#pragma unroll
          for (int q = 0; q < 6; ++q) { const f32x4 v = *(const f32x4*)(cw + (size_t)c0 * 3 + 4 * q); f[4 * q] = v[0]; f[4 * q + 1] = v[1]; f[4 * q + 2] = v[2]; f[4 * q + 3] = v[3]; }
#pragma unroll
          for (int e = 0; e < 8; ++e) { w0[e] = f[3 * e]; w1[e] = f[3 * e + 1]; w2[e] = f[3 * e + 2]; } }
#pragma unroll
        for (int ai = 0; ai < 2; ++ai) {
            const int grp = 4 * u.pm + 2 * ai + wr;
            float Y[8];
#pragma unroll
            for (int e = 0; e < 8; ++e) Y[e] = 0.f;
#pragma unroll
            for (int m = 0; m < 4; ++m) {
                const size_t row = (size_t)u.pm * BM + ai * HALF + wr * 64 + m * 16 + fr;
                float X[8], G[8], o[8];
#pragma unroll
                for (int e = 0; e < 8; ++e) { X[e] = acc[ai][0][m][e >> 2][e & 3]; G[e] = acc[ai][1][m][e >> 2][e & 3]; }
#pragma unroll
                for (int e = 0; e < 8; ++e) { const float a1 = dpp_prev(X[e], Y[e], 1), a2 = dpp_prev(X[e], Y[e], 2);
                    const float s = w0[e] * a2 + w1[e] * a1 + w2[e] * X[e]; o[e] = s * sigmoidf_(s) * G[e]; }
                if (m > 0 || fr >= 2) { u32x4 w; w.x = cvt_pk_bf16(o[0], o[1]); w.y = cvt_pk_bf16(o[2], o[3]); w.z = cvt_pk_bf16(o[4], o[5]); w.w = cvt_pk_bf16(o[6], o[7]);
                    *(u32x4*)(U + row * DFF + c0) = w; }
                if (m == 0 && fr < 2) { float* hb = HB + ((size_t)(grp * 2 + fr) * 2) * DFF + c0;
                    *(f32x4*)hb = (f32x4){X[0], X[1], X[2], X[3]}; *(f32x4*)(hb + 4) = (f32x4){X[4], X[5], X[6], X[7]};
                    *(f32x4*)(hb + DFF) = (f32x4){G[0], G[1], G[2], G[3]}; *(f32x4*)(hb + DFF + 4) = (f32x4){G[4], G[5], G[6], G[7]}; }
                if (m == 3 && fr >= 14) { float* ha = HA + (size_t)(grp * 2 + fr - 14) * DFF + c0;
                    *(f32x4*)ha = (f32x4){X[0], X[1], X[2], X[3]}; *(f32x4*)(ha + 4) = (f32x4){X[4], X[5], X[6], X[7]}; }
#pragma unroll
                for (int e = 0; e < 8; ++e) Y[e] = X[e];
            }
        }
    }
};
struct MergeOrder {
    int G, c; const char* o_att; const char* wbr;
    __device__ bool next(int i, Unit& u) const {
        const int tile = (i / 3) * G + c; if (tile >= (T_ / BM) * 4) return false;
        const int br = i % 3; u.pm = tile >> 2; u.pn = tile & 3; u.tag = br;
        u.A = o_att - (size_t)br * (32 * MiB) + (size_t)u.pm * BM * 512 * 2;
        u.B = wbr + (size_t)br * 1024 * 512 * 2 + (size_t)u.pn * BM * 512 * 2; return true;
    }
};
}

#define GSTRIDE_BLOCKS(var, n) for (int var = blockIdx.x; var < (n); var += gridDim.x)

__device__ __forceinline__ void ph_mod(const Params& P, LAS unsigned char* lds) {
    LAS float* red = (LAS float*)lds;
    float* mod = (float*)(P.ws + OFF_MOD); float* tab = (float*)(P.ws + OFF_TAB);
    const int tid = opaque_tid(), wid = tid >> 6, lane = tid & 63;
    GSTRIDE_BLOCKS(blk, 192) {
        const int l = blk / 96, jb = blk % 96, j = jb * 64 + lane;
        float acc[8];
#pragma unroll
        for (int b = 0; b < 8; ++b) acc[b] = 0.f;
        const float* aw = P.ada_w + (size_t)l * 1024 * 6144 + j;
        for (int k = wid * 128; k < wid * 128 + 128; ++k) {
            const float w = aw[(size_t)k * 6144];
#pragma unroll
            for (int b = 0; b < 8; ++b) acc[b] += P.c[b * 1024 + k] * w;
        }
#pragma unroll
        for (int b = 0; b < 8; ++b) red[(wid * 8 + b) * 64 + lane] = acc[b];
        __syncthreads();
        { const int b = wid; float s = P.ada_b[l * 6144 + j];
#pragma unroll
          for (int w = 0; w < 8; ++w) s += red[(w * 8 + b) * 64 + lane];
          mod[((size_t)l * 8 + b) * 6144 + j] = s; }
        __syncthreads();
    }
    if (blockIdx.x == gridDim.x - 1) {
        for (int i = tid; i < 1024; i += NTHR) { const int n = i >> 3, h = i & 7; int bk;
            if (n < 16) bk = n; else { const float nf = (float)n; bk = 16 + (int)(logf(nf / 16.0f) / 2.0794415416798357f * 16.0f); bk = bk < 31 ? bk : 31; }
            tab[i] = P.rel_bias[bk * 8 + h]; }
    }
}

struct WJob { const float* src; int ldsrc; int K; int N; bf16_t* dst; int win; };
template <int KT  >
__device__ __forceinline__ void conv_tiles(const WJob& J, LAS float* tile  ) {
    const int tid = opaque_tid(); const int nkt = J.K / KT, nnt = J.N / 64, ntiles = nkt * nnt;
    GSTRIDE_BLOCKS(ti, ntiles) {
        const int kt = ti % nkt, ntb = ti / nkt, k0 = kt * KT, n0 = ntb * 64;
        { const int n = tid & 63, kk0 = tid >> 6; const int nn = n0 + n; int col = nn;
          if (J.win == 1) col = nn < 2120 ? nn : (nn < 2304 ? -1 : nn - 184);
          if (J.win == 2) col = ((nn & 255) < 128) ? 128 * (nn >> 8) + (nn & 127) : DFF + 128 * (nn >> 8) + (nn & 127);
          float v[KT / 8];
#pragma unroll
          for (int p = 0; p < KT / 8; ++p) { const int k = kk0 + 8 * p; v[p] = col >= 0 ? J.src[(size_t)(k0 + k) * J.ldsrc + col] : 0.f; }
#pragma unroll
          for (int p = 0; p < KT / 8; ++p) tile[(kk0 + 8 * p) * 65 + n] = v[p]; }
        __syncthreads();
#pragma unroll
        for (int q = 0; q < KT / 64; ++q) { const int n = tid >> 3, kg = (tid & 7) + 8 * q; float v[8];
#pragma unroll
          for (int e = 0; e < 8; ++e) v[e] = tile[(kg * 8 + e) * 65 + n];
          u32x4 w; w.x = cvt_pk_bf16(v[0], v[1]); w.y = cvt_pk_bf16(v[2], v[3]); w.z = cvt_pk_bf16(v[4], v[5]); w.w = cvt_pk_bf16(v[6], v[7]);
          *(u32x4*)(J.dst + (size_t)(n0 + n) * J.K + k0 + kg * 8) = w; }
        __syncthreads();
    }
}
__device__ __forceinline__ void ph_wconv(const Params& P, int l, LAS unsigned char* lds) {
    LAS float* tile = (LAS float*)lds; unsigned char* wb = P.ws + OFF_WB;
    { WJob J{P.w_in + (size_t)l * 1024 * IN_COLS, IN_COLS, 1024, 8704, (bf16_t*)(wb + WB_WIN), 1}; conv_tiles<256>(J, tile); }
    for (int i = 0; i < 3; ++i) { WJob J{P.w_branch + ((size_t)l * 3 + i) * 512 * 1024, 1024, 512, 1024, (bf16_t*)(wb + WB_WBR) + (size_t)i * 1024 * 512, 0}; conv_tiles<256>(J, tile); }
    { WJob J{P.w_o + (size_t)l * 1024 * 1024, 1024, 1024, 1024, (bf16_t*)(wb + WB_WO), 0}; conv_tiles<256>(J, tile); }
    { WJob J{P.ffn_w_up + (size_t)l * 1024 * 5632, 5632, 1024, 5632, (bf16_t*)(wb + WB_WUP), 2}; conv_tiles<256>(J, tile); }
    { WJob J{P.ffn_w_down + (size_t)l * 2816 * 1024, 1024, 2816, 1024, (bf16_t*)(wb + WB_WDN), 0}; conv_tiles<256>(J, tile); }
    { WJob J{P.w_up + (size_t)l * 64 * 512, 512, 64, 512, (bf16_t*)(wb + WB_LW), 0}; conv_tiles<64>(J, tile); }
    { WJob J{P.a_up + (size_t)l * 64 * 512, 512, 64, 512, (bf16_t*)(wb + WB_LA), 0}; conv_tiles<64>(J, tile); }
    { WJob J{P.g_up + (size_t)l * 128 * 512, 512, 128, 512, (bf16_t*)(wb + WB_LG), 0}; conv_tiles<64>(J, tile); }
}

__device__ __forceinline__ void ph_norm(const Params& P, int l, int which) {
    const bool first = (l == 0 && which == 0);
    const float* nw = (which == 0 ? P.norm_mix : P.norm_ffn) + l * 1024;
    const float* mod = (const float*)(P.ws + OFF_MOD) + (size_t)l * 8 * 6144 + which * 3072;
    const bf16_t* XB = (const bf16_t*)P.out;
    bf16_t* H = (bf16_t*)(P.ws + OFF_H);
    const int tid = opaque_tid(), wid = tid >> 6, lane = tid & 63;
    for (int row = blockIdx.x * 8 + wid; row < T_; row += gridDim.x * 8) {
        const int b = row >> 12; const float* mb = mod + (size_t)b * 6144;
        f32x4 v[4]; float ss = 0.f;
#pragma unroll
        for (int i = 0; i < 4; ++i) {
            if (first) v[i] = *(const f32x4*)(P.x_in + (size_t)row * 1024 + i * 256 + lane * 4);
            else { const u32x2 w = *(const u32x2*)(XB + (size_t)row * 1024 + i * 256 + lane * 4); v[i] = (f32x4){bflo(w.x), bfhi(w.x), bflo(w.y), bfhi(w.y)}; }
            ss += v[i][0] * v[i][0] + v[i][1] * v[i][1] + v[i][2] * v[i][2] + v[i][3] * v[i][3]; }
        ss = wave_sum(ss, lane);
        const float rstd = rsqrtf(ss * (1.0f / 1024.0f) + 1e-6f);
#pragma unroll
        for (int i = 0; i < 4; ++i) { const int c = i * 256 + lane * 4;
            const f32x4 g = *(const f32x4*)(nw + c), sh = *(const f32x4*)(mb + c), sc = *(const f32x4*)(mb + 1024 + c);
            const f32x4 y = v[i] * rstd * g * (sc + 1.0f) + sh;
            u32x2 w; w.x = cvt_pk_bf16(y[0], y[1]); w.y = cvt_pk_bf16(y[2], y[3]);
            *(u32x2*)(H + (size_t)row * 1024 + c) = w; }
    }
}

__device__ __forceinline__ void ph_final(const Params& P) {
    const bf16_t* XF = (const bf16_t*)(P.ws + OFF_H);
    const int tid = opaque_tid(), wid = tid >> 6, lane = tid & 63;
    for (int row = blockIdx.x * 8 + wid; row < T_; row += gridDim.x * 8) {
        float* xr = P.out + (size_t)row * 1024;
        f32x4 v[4]; float ss = 0.f;
#pragma unroll
        for (int i = 0; i < 4; ++i) { const u32x2 w = *(const u32x2*)(XF + (size_t)row * 1024 + i * 256 + lane * 4); v[i] = (f32x4){bflo(w.x), bfhi(w.x), bflo(w.y), bfhi(w.y)};
            ss += v[i][0] * v[i][0] + v[i][1] * v[i][1] + v[i][2] * v[i][2] + v[i][3] * v[i][3]; }
        ss = wave_sum(ss, lane);
        const float rstd = rsqrtf(ss * (1.0f / 1024.0f) + 1e-6f);
#pragma unroll
        for (int i = 0; i < 4; ++i) { const int c = i * 256 + lane * 4; const f32x4 g = *(const f32x4*)(P.final_norm + c);
            *(f32x4*)(xr + c) = v[i] * rstd * g; }
    }
}

__device__ __forceinline__ void ph_gemm_zq(const Params& P, LAS unsigned char* lds) {
    g8::SOrder S; S.init(T_, 2304, 1024, 1024, P.ws + OFF_H, P.ws + OFF_WB + WB_WIN);
    g8::EpiBf E{(bf16_t*)(P.ws + OFF_ZQ), 2304, 9, nullptr, 0, 0};
    g8::gemm_phase(lds, 1024, 1024, 1024, S, E);
}
__device__ __forceinline__ void ph_gemm_zr(const Params& P, LAS unsigned char* lds) {
    g8::SOrder S; S.init(T_, 1792, 1024, 1024, P.ws + OFF_H, P.ws + OFF_WB + WB_WIN + (size_t)2304 * 1024 * 2);
    g8::EpiBf E{(bf16_t*)(P.ws + OFF_ZR), 1792, 7, nullptr, 0, 0};
    g8::gemm_phase(lds, 1024, 1024, 1024, S, E);
}
__device__ __forceinline__ void ph_gemm_zc(const Params& P, LAS unsigned char* lds) {
    g8::SOrder S; S.init(T_, 4608, 1024, 1024, P.ws + OFF_H, P.ws + OFF_WB + WB_WIN + (size_t)4096 * 1024 * 2);
    g8::EpiBf E{(bf16_t*)(P.ws + OFF_ZCV), 1536, 6, (bf16_t*)(P.ws + OFF_ZG), 3072, 1};
    g8::gemm_phase(lds, 1024, 1024, 1024, S, E);
}
__device__ __forceinline__ void ph_gemm_merge(const Params& P, LAS unsigned char* lds) {
    g8::MergeOrder S{(int)gridDim.x, (int)blockIdx.x, (const char*)(P.ws + OFF_OATT), (const char*)(P.ws + OFF_WB + WB_WBR)};
    g8::EpiMerge E{(bf16_t*)(P.ws + OFF_MRG), (const bf16_t*)(P.ws + OFF_ZG)};
    g8::gemm_phase(lds, 512, 512, 512, S, E);
}
__device__ __forceinline__ void ph_gemm_wo(const Params& P, int l, LAS unsigned char* lds) {
    g8::SOrder S; S.init(T_, 1024, 1024, 1024, P.ws + OFF_MRG, P.ws + OFF_WB + WB_WO);
    g8::EpiRes E{l == 0 ? P.x_in : nullptr, (const bf16_t*)P.out, (bf16_t*)P.out, (const float*)(P.ws + OFF_MOD) + (size_t)l * 8 * 6144 + 2048};
    g8::gemm_phase(lds, 1024, 1024, 1024, S, E);
}
__device__ __forceinline__ void ph_gemm_up(const Params& P, int l, LAS unsigned char* lds) {
    g8::SOrder S; S.init(T_, 5632, 1024, 1024, P.ws + OFF_H, P.ws + OFF_WB + WB_WUP);
    g8::EpiUp E{(bf16_t*)(P.ws + OFF_UP), (float*)(P.ws + OFF_HA), (float*)(P.ws + OFF_HB), P.ffn_conv_w + (size_t)l * DFF * 3};
    g8::gemm_phase(lds, 1024, 1024, 1024, S, E);
}
__device__ __forceinline__ void ph_gemm_down(const Params& P, int l, LAS unsigned char* lds) {
    g8::SOrder S; S.init(T_, 1024, 2816, 2816, P.ws + OFF_UP, P.ws + OFF_WB + WB_WDN);
    g8::EpiRes E{nullptr, (const bf16_t*)P.out, l == 1 ? (bf16_t*)(P.ws + OFF_H) : (bf16_t*)P.out, (const float*)(P.ws + OFF_MOD) + (size_t)l * 8 * 6144 + 5120};
    g8::gemm_phase(lds, 2816, 2816, 2816, S, E);
}

__device__ __forceinline__ void ph_conv(const Params& P, int l, LAS unsigned char* lds) {
    const bf16_t* Z = (const bf16_t*)(P.ws + OFF_ZCV); bf16_t* O = (bf16_t*)(P.ws + OFF_OCONV);
    LAS float* cwT = (LAS float*)lds;
    const int tid = opaque_tid();
    for (int i = tid; i < 1536; i += NTHR) cwT[(i % 3) * 512 + i / 3] = P.sc_conv_w[(size_t)l * 1536 + i];
    __syncthreads();
    constexpr int RB = 16; const int nitem = (T_ / RB) * 64;
    for (int it = blockIdx.x * NTHR + tid; it < nitem; it += gridDim.x * NTHR) {
        const int rb = it >> 6, c0 = (it & 63) * 8, row0 = rb * RB, t0 = row0 & 4095;
        float w0[8], w1[8], w2[8];
#pragma unroll
        for (int e = 0; e < 8; ++e) { w0[e] = cwT[c0 + e]; w1[e] = cwT[512 + c0 + e]; w2[e] = cwT[1024 + c0 + e]; }
        float pm2[8], pm1[8];
#pragma unroll
        for (int e = 0; e < 8; ++e) { pm2[e] = 0.f; pm1[e] = 0.f; }
        if (t0 >= 2) {
#pragma unroll
            for (int j = 0; j < 2; ++j) { const bf16_t* zr = Z + (size_t)(row0 - 2 + j) * 1536;
                const u32x4 cc = *(const u32x4*)(zr + 512 + c0), cx = *(const u32x4*)(zr + 1024 + c0);
                const unsigned ccw[4] = {cc.x, cc.y, cc.z, cc.w}, cxw[4] = {cx.x, cx.y, cx.z, cx.w};
#pragma unroll
                for (int q = 0; q < 4; ++q) { const float a = bflo(ccw[q]) * bflo(cxw[q]), b2 = bfhi(ccw[q]) * bfhi(cxw[q]);
                    if (j == 0) { pm2[2 * q] = a; pm2[2 * q + 1] = b2; } else { pm1[2 * q] = a; pm1[2 * q + 1] = b2; } } }
        }
#pragma unroll 4
        for (int r = 0; r < RB; ++r) {
            const bf16_t* zr = Z + (size_t)(row0 + r) * 1536;
            const u32x4 cb = *(const u32x4*)(zr + c0), cc = *(const u32x4*)(zr + 512 + c0), cx = *(const u32x4*)(zr + 1024 + c0);
            const unsigned cbw[4] = {cb.x, cb.y, cb.z, cb.w}, ccw[4] = {cc.x, cc.y, cc.z, cc.w}, cxw[4] = {cx.x, cx.y, cx.z, cx.w};
            float cur[8], o[8];
#pragma unroll
            for (int q = 0; q < 4; ++q) { cur[2 * q] = bflo(ccw[q]) * bflo(cxw[q]); cur[2 * q + 1] = bfhi(ccw[q]) * bfhi(cxw[q]); }
#pragma unroll
            for (int e = 0; e < 8; ++e) { o[e] = w0[e] * pm2[e] + w1[e] * pm1[e] + w2[e] * cur[e]; pm2[e] = pm1[e]; pm1[e] = cur[e]; }
            u32x4 w; w.x = cvt_pk_bf16(o[0] * bflo(cbw[0]), o[1] * bfhi(cbw[0])); w.y = cvt_pk_bf16(o[2] * bflo(cbw[1]), o[3] * bfhi(cbw[1]));
            w.z = cvt_pk_bf16(o[4] * bflo(cbw[2]), o[5] * bfhi(cbw[2])); w.w = cvt_pk_bf16(o[6] * bflo(cbw[3]), o[7] * bfhi(cbw[3]));
            *(u32x4*)(O + (size_t)(row0 + r) * 512 + c0) = w;
        }
    }
}

__device__ __forceinline__ void ph_ufix(const Params& P, int l, LAS unsigned char* lds) {
    bf16_t* U = (bf16_t*)(P.ws + OFF_UP); const float* HA = (const float*)(P.ws + OFF_HA); const float* HB = (const float*)(P.ws + OFF_HB);
    LAS float* cwT = (LAS float*)lds;
    const int tid = opaque_tid();
    for (int i = tid; i < DFF * 3; i += NTHR) cwT[(i % 3) * DFF + i / 3] = P.ffn_conv_w[(size_t)l * DFF * 3 + i];
    __syncthreads();
    const int nitem = (T_ / 64) * 2 * 352;
    for (int it = blockIdx.x * NTHR + tid; it < nitem; it += gridDim.x * NTHR) {
        const int c0 = (it % 352) * 8, gr = it / 352, grp = gr >> 1, rr = gr & 1; const bool first = (grp & 63) == 0;
        const float* hb = HB + ((size_t)(grp * 2 + rr) * 2) * DFF + c0;
        float a0[8], a1[8], a2[8], g[8];
#pragma unroll
        for (int q = 0; q < 2; ++q) { const f32x4 va = *(const f32x4*)(hb + 4 * q), vg = *(const f32x4*)(hb + DFF + 4 * q);
#pragma unroll
            for (int e = 0; e < 4; ++e) { a0[4 * q + e] = va[e]; g[4 * q + e] = vg[e]; a1[4 * q + e] = 0.f; a2[4 * q + e] = 0.f; } }
        if (rr == 1) { const float* p1 = HB + ((size_t)(grp * 2) * 2) * DFF + c0;
#pragma unroll
            for (int q = 0; q < 2; ++q) { const f32x4 v = *(const f32x4*)(p1 + 4 * q);
#pragma unroll
                for (int e = 0; e < 4; ++e) a1[4 * q + e] = v[e]; } }
        if (!first) {
            const float* pl = HA + (size_t)((grp - 1) * 2 + 1) * DFF + c0;
            const float* pk = HA + (size_t)((grp - 1) * 2) * DFF + c0;
#pragma unroll
            for (int q = 0; q < 2; ++q) { const f32x4 v63 = *(const f32x4*)(pl + 4 * q), v62 = *(const f32x4*)(pk + 4 * q);
#pragma unroll
                for (int e = 0; e < 4; ++e) { if (rr == 1) a2[4 * q + e] = v63[e]; else { a1[4 * q + e] = v63[e]; a2[4 * q + e] = v62[e]; } } }
        }
        float o[8];
#pragma unroll
        for (int e = 0; e < 8; ++e) { const float s = cwT[c0 + e] * a2[e] + cwT[DFF + c0 + e] * a1[e] + cwT[2 * DFF + c0 + e] * a0[e]; o[e] = s * sigmoidf_(s) * g[e]; }
        u32x4 w; w.x = cvt_pk_bf16(o[0], o[1]); w.y = cvt_pk_bf16(o[2], o[3]); w.z = cvt_pk_bf16(o[4], o[5]); w.w = cvt_pk_bf16(o[6], o[7]);
        *(u32x4*)(U + (size_t)(grp * 64 + rr) * DFF + c0) = w;
    }
}

template <int NR>
__device__ __forceinline__ u64 select_row(LAS float* row, const int t, const int lz) {
    const int imax = t >> 6;
    float x[NR]; float Tx = 0.f; bool have = false, exact = false;
    {
        int bin[NR]; float lo = __builtin_inff(), hi = -__builtin_inff();
        LAS unsigned* hist = (LAS unsigned*)row;
#pragma unroll
        for (int i = 0; i < NR; ++i) { const float v = row[64 * i + lz]; x[i] = (i <= imax) ? v : -__builtin_inff(); hi = fmaxf(hi, x[i]); lo = fminf(lo, (i < imax || x[i] > -__builtin_inff()) ? x[i] : __builtin_inff()); }
#pragma unroll
        for (int o = 32; o >= 1; o >>= 1) { lo = fminf(lo, shx(lo, o, lz)); hi = fmaxf(hi, shx(hi, o, lz)); }
        if (hi > lo) {
            const float scale = 4095.0f / (hi - lo);
#pragma unroll
            for (int q = 0; q < 16; ++q) *(LAS u32x4*)(hist + 256 * q + 4 * lz) = (u32x4){0u, 0u, 0u, 0u};
#pragma unroll
            for (int i = 0; i < NR; ++i) {
                const int bq = (int)fminf(fmaxf((x[i] - lo) * scale, -1.0f), 4095.0f); bin[i] = bq;
                if (bq >= 0) __hip_atomic_fetch_add(hist + bq, 1u, __ATOMIC_RELAXED, __HIP_MEMORY_SCOPE_WORKGROUP); }
            unsigned c1 = 0u;
#pragma unroll
            for (int q = 0; q < 16; ++q) { const u32x4 h4 = *(const LAS u32x4*)(hist + 64 * lz + 4 * ((q + lz) & 15)); c1 += (h4.x + h4.y) + (h4.z + h4.w); }
            unsigned inc = c1;
#pragma unroll
            for (int o = 1; o <= 32; o <<= 1) { const unsigned v = (unsigned)__builtin_amdgcn_ds_bpermute(((lz + o) & 63) << 2, (int)inc); inc += (lz + o < 64) ? v : 0u; }
            const unsigned ab1 = inc - c1;
            const u64 cr1 = __ballot(ab1 < 256u && ab1 + c1 >= 256u);
            const int L1 = __builtin_ctzll(cr1);
            const unsigned abL = (unsigned)__builtin_amdgcn_readlane((int)ab1, L1);
            const unsigned c2 = hist[64 * L1 + lz];
            unsigned inc2 = c2;
#pragma unroll
            for (int o = 1; o <= 32; o <<= 1) { const unsigned v = (unsigned)__builtin_amdgcn_ds_bpermute(((lz + o) & 63) << 2, (int)inc2); inc2 += (lz + o < 64) ? v : 0u; }
            const unsigned ab2 = inc2 - c2 + abL;
            const u64 cr2 = __ballot(ab2 < 256u && ab2 + c2 >= 256u);
            const int L2 = __builtin_ctzll(cr2);
            const int bstar = 64 * L1 + L2;
            const int cb = __builtin_amdgcn_readlane((int)c2, L2), need2 = 256 - __builtin_amdgcn_readlane((int)ab2, L2);
            if (cb <= 64) {
                int cand = 0; int pos = 0;
#pragma unroll
                for (int i = 0; i < NR; ++i) { u64 mm = __ballot(bin[i] == bstar);
                    while (mm) { const int s = __builtin_ctzll(mm); mm &= mm - 1ull; cand = writelane_v(cand, __builtin_amdgcn_readlane(__float_as_int(x[i]), s), pos); ++pos; } }
                const unsigned cu = (lz < cb) ? f2ord(__int_as_float(cand)) : 0u;
                unsigned Tc = 0u;
#pragma unroll 1
                for (int bit = 31; bit >= 0; --bit) { const unsigned cd = Tc | (1u << bit); if ((int)__popcll(__ballot(cu >= cd)) >= need2) Tc = cd; }
                Tx = ord2f(Tc); have = true; exact = (256 - need2) + (int)__popcll(__ballot(cu >= Tc)) == 256;
            }
        }
    }
    if (!have) {
        unsigned Tt = 0u;
#pragma unroll 1
        for (int bit = 31; bit >= 0; --bit) {
            const unsigned cand = Tt | (1u << bit); int cnt = 0;
#pragma unroll
            for (int i = 0; i < NR; ++i) cnt += __popcll(__ballot(f2ord(x[i]) >= cand));
            if (cnt >= 256) Tt = cand;
        }
        Tx = ord2f(Tt);
    }
    int wlo = 0, whi = 0;
#pragma unroll
    for (int i = 0; i < NR; ++i) { const u64 g = __ballot(x[i] >= Tx); writelane_c2(wlo, whi, (int)(unsigned)g, (int)(unsigned)(g >> 32), i); }
    u64 myw = ((u64)(unsigned)whi << 32) | (unsigned)wlo;
    if (!exact) {
        int cgt = 0;
#pragma unroll
        for (int i = 0; i < NR; ++i) cgt += __popcll(__ballot(x[i] > Tx));
        int need = 256 - cgt; myw = 0ull;
#pragma unroll
        for (int i = 0; i < NR; ++i) {
            const u64 g = __ballot(x[i] > Tx); u64 e = __ballot(x[i] == Tx);
            int ne = __popcll(e);
            while (ne > need) { e &= ~(1ull << (63 - __clzll(e))); --ne; }
            need -= ne;
            if (lz == i) myw = g | e;
        }
    }
    return myw;
}

__device__ __forceinline__ void ph_ki(const Params& P, LAS unsigned char* lds) {
    const bf16_t* ZQ = (const bf16_t*)(P.ws + OFF_ZQ);
    const int tid = opaque_tid();
    { int* KPM = (int*)(P.ws + OFF_KPM);
      for (int i = blockIdx.x * NTHR + tid; i < NB_ * 64; i += gridDim.x * NTHR) { const int* pp = P.pos + (i >> 6) * S_ + (i & 63) * 64; int mxp = pp[0];
          for (int k = 1; k < 64; ++k) mxp = pp[k] > mxp ? pp[k] : mxp;
          KPM[i] = mxp; } }
    {
        bf16_t* KI = (bf16_t*)(P.ws + OFF_KI);
        for (int i = blockIdx.x * NTHR + tid; i < T_ * 8; i += gridDim.x * NTHR) {
            const int key = i >> 3, c = i & 7;
            const u32x4 v = *(const u32x4*)(ZQ + (size_t)key * 2304 + 2048 + 8 * c);
            *(u32x4*)(KI + ((size_t)((key >> 5) * 4 + (c >> 1)) * 64 + (key & 31) + 32 * (c & 1)) * 8) = v;
        }
    }
    {
        LAS bf16_t* tl = (LAS bf16_t*)lds;
        bf16_t* VT = (bf16_t*)(P.ws + OFF_VT);
        for (int it = blockIdx.x; it < NB_ * 8 * 64; it += gridDim.x) {
            const int b = it >> 9, h = (it >> 6) & 7, k0 = (it & 63) * 64;
            { const int row = tid >> 3, ch = tid & 7;
              const u32x4 v = *(const u32x4*)(ZQ + (size_t)(b * S_ + k0 + row) * 2304 + 1024 + h * 64 + ch * 8);
              *(LAS u32x4*)(tl + row * 72 + ch * 8) = v; }
            __syncthreads();
            { const int d = tid >> 3, kc = tid & 7; unsigned short e[8];
#pragma unroll
              for (int q = 0; q < 8; ++q) e[q] = tl[(kc * 8 + q) * 72 + d];
              u32x4 w; w.x = e[0] | ((unsigned)e[1] << 16); w.y = e[2] | ((unsigned)e[3] << 16); w.z = e[4] | ((unsigned)e[5] << 16); w.w = e[6] | ((unsigned)e[7] << 16);
              *(u32x4*)(VT + ((size_t)((b * 8 + h) * 64 + d)) * S_ + k0 + kc * 8) = w; }
            __syncthreads();
        }
    }
}

__device__ __forceinline__ void ph_idx(const Params& P, LAS unsigned char* lds) {
    LAS float* SC = (LAS float*)lds;
    const bf16_t* ZQ = (const bf16_t*)(P.ws + OFF_ZQ); u64* MASK = (u64*)(P.ws + OFF_MASK); const bf16_t* KI = (const bf16_t*)(P.ws + OFF_KI);
    const int tid = opaque_tid(), wid = __builtin_amdgcn_readfirstlane(tid >> 6), lane = tid & 63, m = lane & 31, hh = lane >> 5;
    int itc = 0;
    for (int idx = blockIdx.x; idx < NB_ * 512; idx += gridDim.x, ++itc) {
        const int b = idx & 7, j = idx >> 3; const int qb = (itc & 1) ? (j ^ 31) : j; const int t0 = qb * 8;
        const bf16_t* zb = ZQ + (size_t)b * S_ * 2304;
        bf16x8 Af[2][4]; float wv[2][16];
#pragma unroll
        for (int blk = 0; blk < 2; ++blk) {
            const bf16_t* qp = zb + (size_t)(t0 + 4 * blk + 2 * ((m >> 2) & 1) + (m >> 4)) * 2304 + 1536 + (4 * ((m >> 3) & 1) + (m & 3)) * 64 + 8 * hh;
#pragma unroll
            for (int ks = 0; ks < 4; ++ks) Af[blk][ks] = *(const bf16x8*)(qp + 16 * ks);
#pragma unroll
            for (int q = 0; q < 2; ++q) { const u32x4 ww = *(const u32x4*)(zb + (size_t)(t0 + 4 * blk + 2 * hh + q) * 2304 + 2112);
                wv[blk][8 * q + 0] = bflo(ww.x); wv[blk][8 * q + 1] = bfhi(ww.x); wv[blk][8 * q + 2] = bflo(ww.y); wv[blk][8 * q + 3] = bfhi(ww.y);
                wv[blk][8 * q + 4] = bflo(ww.z); wv[blk][8 * q + 5] = bfhi(ww.z); wv[blk][8 * q + 6] = bflo(ww.w); wv[blk][8 * q + 7] = bfhi(ww.w); }
        }
        const int ntile = 2 * ((t0 + 7) / 64 + 1);
        {
#define IDX_GLD(B, KT) do { const int kc_ = (KT) < ntile ? (KT) : ntile - 1; const bf16_t* kp_ = KI + ((size_t)((b * 128 + kc_) * 4) * 64 + lane) * 8; \
            asm volatile("global_load_dwordx4 %0, %4, off\n\tglobal_load_dwordx4 %1, %4, off offset:1024\n\tglobal_load_dwordx4 %2, %4, off offset:2048\n\tglobal_load_dwordx4 %3, %4, off offset:3072" \
                : "=&v"(B[0]), "=&v"(B[1]), "=&v"(B[2]), "=&v"(B[3]) : "v"(kp_)); } while (0)
#define IDX_GLW(B, N) asm volatile("s_waitcnt vmcnt(" #N ")" : "+v"(B[0]), "+v"(B[1]), "+v"(B[2]), "+v"(B[3]))
            auto score_tile = [&](const bf16x8 (&Bf)[4], const int kt) {
                f32x16 Dw[2];
#pragma unroll
                for (int r = 0; r < 16; ++r) { Dw[0][r] = 0.f; Dw[1][r] = 0.f; }
#pragma unroll
                for (int ks = 0; ks < 4; ++ks) {
                    Dw[0] = __builtin_amdgcn_mfma_f32_32x32x16_bf16(Af[0][ks], Bf[ks], Dw[0], 0, 0, 0);
                    Dw[1] = __builtin_amdgcn_mfma_f32_32x32x16_bf16(Af[1][ks], Bf[ks], Dw[1], 0, 0, 0); }
#pragma unroll
                for (int blk = 0; blk < 2; ++blk) {
                    const f32x16 Dv = Dw[blk];
#pragma unroll
                    for (int q = 0; q < 2; ++q) {
                        float part = 0.f;
#pragma unroll
                        for (int e = 0; e < 8; ++e) { const float d = Dv[8 * q + e], w = wv[blk][8 * q + e]; part = __builtin_fmaf(w, d, part); part = __builtin_fmaf(w, __builtin_fabsf(d), part); }
                        SC[(4 * blk + 2 * hh + q) * 4096 + 32 * kt + m] = (32 * kt + m <= t0 + 4 * blk + 2 * hh + q) ? part : -__builtin_inff();
                    }
                } };
            bf16x8 B0[4], B1[4], B2[4];
            if (wid < ntile) {
                IDX_GLD(B0, wid); IDX_GLD(B1, wid + 8);
                asm volatile("" :: "v"(Af[0][0]), "v"(Af[0][1]), "v"(Af[0][2]), "v"(Af[0][3]), "v"(Af[1][0]), "v"(Af[1][1]), "v"(Af[1][2]), "v"(Af[1][3]));
#pragma unroll 1
                for (int kt = wid; kt < ntile; kt += 24) {
                    IDX_GLD(B2, kt + 16);
                    IDX_GLW(B0, 8);
                    score_tile(B0, kt);
                    IDX_GLD(B0, kt + 24);
                    IDX_GLW(B1, 8);
                    if (kt + 8 < ntile) score_tile(B1, kt + 8);
                    IDX_GLD(B1, kt + 32);
                    IDX_GLW(B2, 8);
                    if (kt + 16 < ntile) score_tile(B2, kt + 16);
                }
                asm volatile("s_waitcnt vmcnt(0)" : "+v"(B0[0]), "+v"(B0[1]), "+v"(B0[2]), "+v"(B0[3]), "+v"(B1[0]), "+v"(B1[1]), "+v"(B1[2]), "+v"(B1[3]), "+v"(B2[0]), "+v"(B2[1]), "+v"(B2[2]), "+v"(B2[3]));
            }
#undef IDX_GLD
#undef IDX_GLW
        }
        __syncthreads();
        {
            const int t = t0 + wid; u64* mrow = MASK + (size_t)(b * S_ + t) * 64;
            if (t < 256) {
                const int lo = 64 * lane; u64 w;
                if (t >= lo + 63) w = ~0ull; else if (t < lo) w = 0ull; else w = (2ull << (t - lo)) - 1ull;
                mrow[lane] = w;
            } else {
                int lz = threadIdx.x; asm volatile("" : "+v"(lz)); lz &= 63;
                LAS float* rowp = SC + wid * 4096; u64 myw;
                if (t < 512) myw = select_row<8>(rowp, t, lz); else if (t < 1024) myw = select_row<16>(rowp, t, lz); else if (t < 2048) myw = select_row<32>(rowp, t, lz); else myw = select_row<64>(rowp, t, lz);
                mrow[lz] = myw;
            }
        }
        __syncthreads();
    }
}

__device__ __forceinline__ int bitmask(int w, int pos  ) { int m; asm("v_bfe_i32 %0, %1, %2, 1" : "=v"(m) : "v"(w), "n"(pos)); return m; }
__device__ __forceinline__ void ph_att(const Params& P, LAS unsigned char* lds) {
    LAS float* TABL = (LAS float*)lds;
    LAS unsigned char* KB = lds + 4096;
    constexpr int KT_B = 64 * 144, VT_B = 64 * 136, BUF_B = KT_B + VT_B;
    constexpr float LOG2E = 1.4426950408889634f;
    const float* tabg = (const float*)(P.ws + OFF_TAB);
    const int tid = opaque_tid(), wid = __builtin_amdgcn_readfirstlane(tid >> 6), lane = tid & 63, m = lane & 31, hh = lane >> 5;
    for (int i = tid; i < 1024; i += NTHR) TABL[i] = tabg[i] * LOG2E;
    LAS int* POSL = (LAS int*)(KB + 4 * BUF_B);
    int pos_b = -1;
    const bf16_t* ZQ = (const bf16_t*)(P.ws + OFF_ZQ); const u64* MASK = (const u64*)(P.ws + OFF_MASK);
    const bf16_t* VT = (const bf16_t*)(P.ws + OFF_VT); bf16_t* OA = (bf16_t*)(P.ws + OFF_OATT); const int* KPM = (const int*)(P.ws + OFF_KPM);
    int itc = 0;
    for (int idx = blockIdx.x; idx < NB_ * 8 * 16; idx += gridDim.x, ++itc) {
        const int b = idx & 7, head = (idx >> 3) & 7, j = idx >> 6; const int qb = (itc & 1) ? (j ^ 3) : j;
        const int q0 = qb * 256, tq0 = q0 + 32 * wid, t = tq0 + m;
        const bf16_t* zb = ZQ + (size_t)b * S_ * 2304;
        if (b != pos_b) {
            __syncthreads();
            for (int i = tid; i < S_ / 4; i += NTHR) ((LAS i32x4*)POSL)[i] = ((const i32x4*)(P.pos + b * S_))[i];
            pos_b = b;
            __syncthreads();
        }
        bf16x8 Qf[4];
        { const bf16_t* qp = zb + (size_t)t * 2304 + head * 64 + 8 * hh;
#pragma unroll
          for (int ks = 0; ks < 4; ++ks) Qf[ks] = *(const bf16x8*)(qp + 16 * ks); }
        const int posq = POSL[t];
        int minq = posq;
#pragma unroll
        for (int o = 32; o >= 1; o >>= 1) { const int v = shxi(minq, o, lane); minq = v < minq ? v : minq; }
        minq = __builtin_amdgcn_readfirstlane(minq);
        const u64* mrow = MASK + (size_t)(b * S_ + t) * 64;
        const bf16_t* vtb = VT + (size_t)(b * 8 + head) * 64 * S_;
        const float c1 = 0.125f * LOG2E, c2 = TABL[127 * 8 + head];
        f32x16 O0, O1, OL;
#pragma unroll
        for (int r = 0; r < 16; ++r) { O0[r] = 0.f; O1[r] = 0.f; OL[r] = 0.f; }
        const bf16x8 ones8 = {0x3F80, 0x3F80, 0x3F80, 0x3F80, 0x3F80, 0x3F80, 0x3F80, 0x3F80};
        float m_run = -1e30f;
        const int nt = 4 * qb + 4, my_nt = ((tq0 + 31) >> 6) + 1;
        const int skey = tid >> 3, sch = tid & 7;
        const bf16_t* kg = zb + (size_t)skey * 2304 + 512 + head * 64 + 8 * sch;
        const bf16_t* vg = vtb + (size_t)skey * S_ + 8 * sch;
        LAS unsigned char* kdst = KB + skey * 144 + sch * 16; LAS unsigned char* vdst = KB + KT_B + skey * 136 + sch * 16;
        const int kpm_l = KPM[b * 64 + lane];
        auto tile = [&](const int kt, const int boff, const u64 mw) {
                const LAS unsigned char* Kt = KB + boff; const LAS unsigned char* Vt = Kt + KT_B;
                f32x16 D0, D1;
#pragma unroll
                for (int r = 0; r < 16; ++r) { D0[r] = 0.f; D1[r] = 0.f; }
#pragma unroll
                for (int ks = 0; ks < 4; ++ks) {
                    const bf16x8 K0 = *(const LAS bf16x8*)(Kt + m * 144 + 32 * ks + 16 * hh), K1 = *(const LAS bf16x8*)(Kt + (32 + m) * 144 + 32 * ks + 16 * hh);
                    D0 = __builtin_amdgcn_mfma_f32_32x32x16_bf16(K0, Qf[ks], D0, 0, 0, 0); D1 = __builtin_amdgcn_mfma_f32_32x32x16_bf16(K1, Qf[ks], D1, 0, 0, 0); }
                const int w0 = (int)((unsigned)mw >> (4 * hh)), w1 = (int)((unsigned)(mw >> 32) >> (4 * hh));
                float esc = c1, eoff0 = c2;
                if (minq - __builtin_amdgcn_readlane(kpm_l, kt) < 127) {
#pragma unroll
                    for (int mb = 0; mb < 2; ++mb)
#pragma unroll
                        for (int g = 0; g < 4; ++g) {
                            const i32x4 pk = *(const LAS i32x4*)(POSL + 64 * kt + 32 * mb + 8 * g + 4 * hh);
#pragma unroll
                            for (int e = 0; e < 4; ++e) { const int r = 4 * g + e; int n = posq - pk[e]; n = n < 0 ? 0 : (n > 127 ? 127 : n);
                                if (mb) D1[r] = D1[r] * c1 + TABL[n * 8 + head]; else D0[r] = D0[r] * c1 + TABL[n * 8 + head]; }
                        }
                    esc = 1.0f; eoff0 = 0.f;
                }
                float mx = __builtin_fmaxf(__builtin_fmaxf(D0[0], D0[1]), D0[2]);
#pragma unroll
                for (int r = 3; r < 15; r += 2) mx = __builtin_fmaxf(__builtin_fmaxf(mx, D0[r]), D0[r + 1]);
#pragma unroll
                for (int r = 0; r < 16; r += 2) mx = __builtin_fmaxf(__builtin_fmaxf(mx, D1[r]), D1[r + 1]);
                mx = fmaxf(mx, D0[15]);
                mx = fmaxf(mx, shx(mx, 32, lane));
                const float m_new = fmaxf(m_run, mx * esc + eoff0); const float alpha = __builtin_amdgcn_exp2f(m_run - m_new); m_run = m_new;
                const float eoff = eoff0 - m_new;
                float pv[32];
#pragma unroll
                for (int r = 0; r < 16; ++r) {
                    const int bp = (r & 3) + 8 * (r >> 2);
                    pv[r] = __int_as_float(__float_as_int(__builtin_amdgcn_exp2f(D0[r] * esc + eoff)) & bitmask(w0, bp));
                    pv[16 + r] = __int_as_float(__float_as_int(__builtin_amdgcn_exp2f(D1[r] * esc + eoff)) & bitmask(w1, bp)); }
                if (!__all(alpha == 1.0f)) {
#pragma unroll
                    for (int r = 0; r < 16; ++r) { O0[r] *= alpha; O1[r] *= alpha; OL[r] *= alpha; } }
#pragma unroll
                for (int s = 0; s < 4; ++s) {
                    u32x4 pw; pw.x = cvt_pk_bf16(pv[8 * s + 0], pv[8 * s + 1]); pw.y = cvt_pk_bf16(pv[8 * s + 2], pv[8 * s + 3]); pw.z = cvt_pk_bf16(pv[8 * s + 4], pv[8 * s + 5]); pw.w = cvt_pk_bf16(pv[8 * s + 6], pv[8 * s + 7]);
                    const bf16x8 Pf = __builtin_bit_cast(bf16x8, pw);
                    const LAS unsigned char* vp = Vt + m * 136 + (16 * s + 4 * hh) * 2;
                    { const u32x2 va = *(const LAS u32x2*)vp, vb = *(const LAS u32x2*)(vp + 16); u32x4 vw; vw.x = va.x; vw.y = va.y; vw.z = vb.x; vw.w = vb.y;
                      O0 = __builtin_amdgcn_mfma_f32_32x32x16_bf16(__builtin_bit_cast(bf16x8, vw), Pf, O0, 0, 0, 0); }
                    { const u32x2 va = *(const LAS u32x2*)(vp + 32 * 136), vb = *(const LAS u32x2*)(vp + 32 * 136 + 16); u32x4 vw; vw.x = va.x; vw.y = va.y; vw.z = vb.x; vw.w = vb.y;
                      O1 = __builtin_amdgcn_mfma_f32_32x32x16_bf16(__builtin_bit_cast(bf16x8, vw), Pf, O1, 0, 0, 0); }
                    OL = __builtin_amdgcn_mfma_f32_32x32x16_bf16(ones8, Pf, OL, 0, 0, 0);
                }
        };
        __syncthreads();
        constexpr int SUB_B = KT_B + VT_B, SUP_B = 2 * SUB_B;
        const int nst = nt >> 1;
        u32x4 ka0, kb0, va0, vb0, ka1, kb1, va1, vb1;
#define ATT_LOAD(KA, KB_, VA, VB, ST) do { KA = *(const u32x4*)(kg + (size_t)(2 * (ST)) * 64 * 2304); KB_ = *(const u32x4*)(kg + (size_t)(2 * (ST) + 1) * 64 * 2304); \
            VA = *(const u32x4*)(vg + (2 * (ST)) * 64); VB = *(const u32x4*)(vg + (2 * (ST) + 1) * 64); } while (0)
#define ATT_STORE(KA, KB_, VA, VB, BUF) do { LAS unsigned char* kd_ = kdst + (BUF) * SUP_B; LAS unsigned char* vd_ = vdst + (BUF) * SUP_B; \
            *(LAS u32x4*)kd_ = KA; *(LAS u32x2*)vd_ = (u32x2){VA.x, VA.y}; *(LAS u32x2*)(vd_ + 8) = (u32x2){VA.z, VA.w}; \
            *(LAS u32x4*)(kd_ + SUB_B) = KB_; *(LAS u32x2*)(vd_ + SUB_B) = (u32x2){VB.x, VB.y}; *(LAS u32x2*)(vd_ + SUB_B + 8) = (u32x2){VB.z, VB.w}; } while (0)
        u64x2 mwA = *(const u64x2*)mrow, mwB = mwA;
        ATT_LOAD(ka0, kb0, va0, vb0, 0); ATT_STORE(ka0, kb0, va0, vb0, 0);
        if (nst > 1) ATT_LOAD(ka1, kb1, va1, vb1, 1);
        __syncthreads();
        for (int st = 0; st < nst; st += 2) {
            if (st + 1 < nst) mwB = *(const u64x2*)(mrow + 2 * (st + 1));
            if (st + 2 < nst) ATT_LOAD(ka0, kb0, va0, vb0, st + 2);
            if (2 * st < my_nt) tile(2 * st, 0, mwA.x);
            if (2 * st + 1 < my_nt) tile(2 * st + 1, SUB_B, mwA.y);
            if (st + 1 < nst) ATT_STORE(ka1, kb1, va1, vb1, 1);
            __syncthreads();
            if (st + 1 >= nst) break;
            if (st + 2 < nst) mwA = *(const u64x2*)(mrow + 2 * (st + 2));
            if (st + 3 < nst) ATT_LOAD(ka1, kb1, va1, vb1, st + 3);
            if (2 * st + 2 < my_nt) tile(2 * st + 2, SUP_B, mwB.x);
            if (2 * st + 3 < my_nt) tile(2 * st + 3, SUP_B + SUB_B, mwB.y);
            if (st + 2 < nst) ATT_STORE(ka0, kb0, va0, vb0, 0);
            __syncthreads();
        }
#undef ATT_LOAD
#undef ATT_STORE
        const float inv = __builtin_amdgcn_rcpf(OL[0]);
        bf16_t* op = OA + (size_t)(b * S_ + t) * 512 + head * 64 + 4 * hh;
#pragma unroll
        for (int g = 0; g < 4; ++g) {
            u32x2 wa; wa.x = cvt_pk_bf16(O0[4 * g] * inv, O0[4 * g + 1] * inv); wa.y = cvt_pk_bf16(O0[4 * g + 2] * inv, O0[4 * g + 3] * inv);
            *(u32x2*)(op + 8 * g) = wa;
            u32x2 wb; wb.x = cvt_pk_bf16(O1[4 * g] * inv, O1[4 * g + 1] * inv); wb.y = cvt_pk_bf16(O1[4 * g + 2] * inv, O1[4 * g + 3] * inv);
            *(u32x2*)(op + 32 + 8 * g) = wb;
        }
    }
}

#define DSR4(A, addr, o0, o1, o2, o3) asm volatile("ds_read_b128 %0, %4 offset:%5\n\tds_read_b128 %1, %4 offset:%6\n\tds_read_b128 %2, %4 offset:%7\n\tds_read_b128 %3, %4 offset:%8" \
    : "=&v"(A[0]), "=&v"(A[1]), "=&v"(A[2]), "=&v"(A[3]) : "v"(addr), "i"(o0), "i"(o1), "i"(o2), "i"(o3))
#define DSW(A, N) asm volatile("s_waitcnt lgkmcnt(" #N ")" : "+v"(A[0]), "+v"(A[1]), "+v"(A[2]), "+v"(A[3]))
#define DSRV(V, addr, off) asm volatile("ds_read_b32 %0, %1 offset:%2" : "=&v"(V) : "v"(addr), "i"(off))
#define DSWV(A, V, N) asm volatile("s_waitcnt lgkmcnt(" #N ")" : "+v"(A[0]), "+v"(A[1]), "+v"(A[2]), "+v"(A[3]), "+v"(V))
#define SCAN_A(X, G) _Pragma("unroll") for (int i_ = 0; i_ < 4; ++i_) { const f32x2 k01 = {X[i_][0], X[i_][1]}, k23 = {X[i_][2], X[i_][3]}; \
    sa0 += S2[8 * G + 2 * i_] * k01; sa1 += S2[8 * G + 2 * i_ + 1] * k23; sp0 += Pm2[8 * G + 2 * i_] * k01; sp1 += Pm2[8 * G + 2 * i_ + 1] * k23; }
#define SCAN_B(X, C) { const int j = 2 * C; \
    { const f32x2 w = {X[0][0], X[0][1]}, kb = {X[1][0], X[1][1]}, kk = {X[2][0], X[2][1]}, rr = {X[3][0], X[3][1]}; \
      S2[j] = S2[j] * w + sav * kb + vv2 * kk; Pm2[j] = Pm2[j] * w + spv * kb; y0 += S2[j] * rr; p0 += Pm2[j] * rr; } \
    { const f32x2 w = {X[0][2], X[0][3]}, kb = {X[1][2], X[1][3]}, kk = {X[2][2], X[2][3]}, rr = {X[3][2], X[3][3]}; \
      S2[j + 1] = S2[j + 1] * w + sav * kb + vv2 * kk; Pm2[j + 1] = Pm2[j + 1] * w + spv * kb; y1 += S2[j + 1] * rr; p1 += Pm2[j + 1] * rr; } }
__device__ __forceinline__ float wave_sum_dpp(float v) {
    v += __int_as_float(__builtin_amdgcn_update_dpp(0, __float_as_int(v), 0x111, 0xf, 0xf, true));
    v += __int_as_float(__builtin_amdgcn_update_dpp(0, __float_as_int(v), 0x112, 0xf, 0xf, true));
    v += __int_as_float(__builtin_amdgcn_update_dpp(0, __float_as_int(v), 0x114, 0xf, 0xf, true));
    v += __int_as_float(__builtin_amdgcn_update_dpp(0, __float_as_int(v), 0x118, 0xf, 0xf, true));
    v += __int_as_float(__builtin_amdgcn_update_dpp(0, __float_as_int(v), 0x142, 0xa, 0xf, false));
    v += __int_as_float(__builtin_amdgcn_update_dpp(0, __float_as_int(v), 0x143, 0xc, 0xf, false));
    return __int_as_float(__builtin_amdgcn_readlane(__float_as_int(v), 63));
}
__device__ __forceinline__ void wave_sum2_dpp(float a, float b, float& ra, float& rb) {
    const auto sw = __builtin_amdgcn_permlane32_swap(__float_as_uint(a), __float_as_uint(b), false, false);
    float v = __uint_as_float(sw[0]) + __uint_as_float(sw[1]);
    v += __int_as_float(__builtin_amdgcn_update_dpp(0, __float_as_int(v), 0x111, 0xf, 0xf, true));
    v += __int_as_float(__builtin_amdgcn_update_dpp(0, __float_as_int(v), 0x112, 0xf, 0xf, true));
    v += __int_as_float(__builtin_amdgcn_update_dpp(0, __float_as_int(v), 0x114, 0xf, 0xf, true));
    v += __int_as_float(__builtin_amdgcn_update_dpp(0, __float_as_int(v), 0x118, 0xf, 0xf, true));
    v += __int_as_float(__builtin_amdgcn_update_dpp(0, __float_as_int(v), 0x142, 0xa, 0xf, false));
    ra = __int_as_float(__builtin_amdgcn_readlane(__float_as_int(v), 31)); rb = __int_as_float(__builtin_amdgcn_readlane(__float_as_int(v), 63));
}
__device__ __forceinline__ void ph_scan(const Params& P, int l, LAS unsigned char* lds) {
    LAS bf16_t* LI = (LAS bf16_t*)lds;
    LAS float* SIN = (LAS float*)(lds + 32768);
    const bf16_t* ZR = (const bf16_t*)(P.ws + OFF_ZR);
    const float* mu = P.mu + (size_t)l * 1792;
    const bf16_t* LW = (const bf16_t*)(P.ws + OFF_WB + WB_LW); const bf16_t* LA = (const bf16_t*)(P.ws + OFF_WB + WB_LA); const bf16_t* LG = (const bf16_t*)(P.ws + OFF_WB + WB_LG);
    bf16_t* Yo = (bf16_t*)(P.ws + OFF_Y); bf16_t* Po = (bf16_t*)(P.ws + OFF_P); bf16_t* Go = (bf16_t*)(P.ws + OFF_G); bf16_t* VBo = (bf16_t*)(P.ws + OFF_VB);
    float* SEGp = (float*)(P.ws + OFF_SEG);
    const int tid = opaque_tid(), wid = __builtin_amdgcn_readfirstlane(tid >> 6), lane = tid & 63;
    for (int blk = blockIdx.x; blk < NB_ * NSEG; blk += gridDim.x) {
        const int b = blk / NSEG, seg = blk % NSEG, tbeg = seg * SEGL;
        f32x2 S2[32], Pm2[32];
        { int lq = threadIdx.x; asm volatile("" : "+v"(lq)); lq &= 63;
#pragma unroll
          for (int j = 0; j < 32; ++j) { S2[j] = (f32x2){0.f, 0.f}; Pm2[j] = (f32x2){(2 * j == lq) ? 1.f : 0.f, (2 * j + 1 == lq) ? 1.f : 0.f}; } }
        for (int half = 0; half < 2; ++half) {
            __syncthreads();
            {
                int tq = threadIdx.x; asm volatile("" : "+v"(tq));
#pragma unroll 1
                for (int rnd = 0; rnd < 4; ++rnd) {
                    const int q = tq + NTHR * rnd, tok = q >> 5, c8 = (q & 31) * 8, t = tbeg + 64 * half + tok; const size_t row = (size_t)b * S_ + t;
                    const u32x4 zc = *(const u32x4*)(ZR + row * 1792 + 1536 + c8);
                    u32x4 zp; zp.x = 0u; zp.y = 0u; zp.z = 0u; zp.w = 0u; if (t > 0) zp = *(const u32x4*)(ZR + (row - 1) * 1792 + 1536 + c8);
                    const f32x4 ma = *(const f32x4*)(mu + 1536 + c8), mb = *(const f32x4*)(mu + 1536 + c8 + 4);
                    const unsigned cw[4] = {zc.x, zc.y, zc.z, zc.w}, pw[4] = {zp.x, zp.y, zp.z, zp.w};
                    float x[8];
#pragma unroll
                    for (int q2 = 0; q2 < 4; ++q2) { const float c0 = bflo(cw[q2]), c1 = bfhi(cw[q2]), p0 = bflo(pw[q2]), p1 = bfhi(pw[q2]);
                        const float m0 = q2 < 2 ? ma[2 * q2] : mb[2 * q2 - 4], m1 = q2 < 2 ? ma[2 * q2 + 1] : mb[2 * q2 - 3];
                        x[2 * q2] = c0 + (p0 - c0) * m0; x[2 * q2 + 1] = c1 + (p1 - c1) * m1; }
#pragma unroll
                    for (int e = 0; e < 8; ++e) { if (c8 < 64) x[e] = 1.0f - 2.0f * __builtin_amdgcn_rcpf(1.0f + __expf(2.0f * x[e])); else if (c8 >= 128) x[e] = sigmoidf_(x[e]); }
                    u32x4 w; w.x = cvt_pk_bf16(x[0], x[1]); w.y = cvt_pk_bf16(x[2], x[3]); w.z = cvt_pk_bf16(x[4], x[5]); w.w = cvt_pk_bf16(x[6], x[7]);
                    *(LAS u32x4*)(LI + tok * 256 + c8) = w;
                }
            }
            __syncthreads();
            float* los = (float*)(P.ws + OFF_SCR) + (size_t)(blk * 8 + wid) * (64 * 2 * 64);
            {
                int tq = threadIdx.x; asm volatile("" : "+v"(tq));
                const int lq = tq & 63, fr = lq & 15, kq = lq >> 4;
#pragma unroll 1
                for (int pass = 0; pass < 8; ++pass) {
                    const int kind = pass < 2 ? 0 : (pass < 4 ? 1 : 2), Kk = kind == 2 ? 128 : 64, aoff = kind * 64, nb0 = kind == 2 ? pass - 4 : 2 * (pass & 1);
                    const bf16_t* Wt = kind == 0 ? LW : (kind == 1 ? LA : LG);
                    bf16x8 Bf[4];
#pragma unroll
                    for (int q = 0; q < 4; ++q) { const int nb = kind == 2 ? nb0 : nb0 + (q >> 1), ks = kind == 2 ? q : (q & 1);
                        Bf[q] = *(const bf16x8*)(Wt + (size_t)(64 * wid + 16 * nb + fr) * Kk + 32 * ks + 8 * kq); }
#pragma unroll 1
                    for (int tt = 0; tt < 4; ++tt) {
                        f32x4 acc[2];
                        acc[0] = (f32x4){0.f, 0.f, 0.f, 0.f}; acc[1] = acc[0];
#pragma unroll
                        for (int q = 0; q < 4; ++q) { const int ai = kind == 2 ? 0 : (q >> 1), ks = kind == 2 ? q : (q & 1);
                            const bf16x8 Afr = *(const LAS bf16x8*)(LI + (16 * tt + fr) * 256 + aoff + 32 * ks + 8 * kq);
                            acc[ai] = __builtin_amdgcn_mfma_f32_16x16x32_bf16(Afr, Bf[q], acc[ai], 0, 0, 0); }
                        if (kind == 2) {
#pragma unroll
                            for (int r = 0; r < 4; ++r) Go[((size_t)b * S_ + tbeg + 64 * half + 16 * tt + 4 * kq + r) * 512 + 64 * wid + 16 * nb0 + fr] = f2bf(acc[0][r]);
                        } else {
#pragma unroll
                            for (int ai = 0; ai < 2; ++ai)
#pragma unroll
                                for (int r = 0; r < 4; ++r) los[((16 * tt + 4 * kq + r) * 2 + kind) * 64 + 16 * (nb0 + ai) + fr] = acc[ai][r];
                        }
                    }
                }
            }
            asm volatile("s_waitcnt vmcnt(0)" ::: "memory");
            for (int sb = 0; sb < 64 / TB; ++sb) {
                const int ts = tbeg + 64 * half + sb * TB;
                int tz = threadIdx.x; asm volatile("" : "+v"(tz));
                const int lz = tz & 63;
                LAS float* sw = SIN + (size_t)wid * (TB * 6 * 64);
                {
                    const int c = 64 * wid + lz; const size_t row0 = (size_t)b * S_ + ts;
                    const float mur = mu[c], muk = mu[512 + c], muv = mu[1024 + c];
                    const float pw0 = P.w0[l * 512 + c], pa0 = P.a0[l * 512 + c], pkk = P.k_k[l * 512 + c], pka = P.k_a[l * 512 + c], prk = P.r_k[l * 512 + c];
                    const float* lo = los + (size_t)(sb * TB) * 128 + lz;
                    float zr_[TB + 1], zk_[TB + 1], zv_[TB + 1], wl_[TB], al_[TB];
                    zr_[0] = 0.f; zk_[0] = 0.f; zv_[0] = 0.f;
                    if (ts > 0) { zr_[0] = bf2f(ZR[(row0 - 1) * 1792 + c]); zk_[0] = bf2f(ZR[(row0 - 1) * 1792 + 512 + c]); zv_[0] = bf2f(ZR[(row0 - 1) * 1792 + 1024 + c]); }
#pragma unroll
                    for (int tk = 0; tk < TB; ++tk) {
                        zr_[tk + 1] = bf2f(ZR[(row0 + tk) * 1792 + c]); zk_[tk + 1] = bf2f(ZR[(row0 + tk) * 1792 + 512 + c]); zv_[tk + 1] = bf2f(ZR[(row0 + tk) * 1792 + 1024 + c]);
                        wl_[tk] = lo[tk * 128]; al_[tk] = lo[tk * 128 + 64]; }
#pragma unroll
                    for (int tk = 0; tk < TB; ++tk) {
                        const size_t row = row0 + tk; LAS float* st = sw + tk * 6 * 64;
                        const float cr = zr_[tk + 1], ck = zk_[tk + 1], cv = zv_[tk + 1], wl = wl_[tk], al = al_[tk];
                        const float rr = cr + (zr_[tk] - cr) * mur, kv = ck + (zk_[tk] - ck) * muk, vv = cv + (zv_[tk] - cv) * muv;
                        const float dc = __builtin_amdgcn_exp2f(-0.87503877f * __builtin_amdgcn_rcpf(1.0f + __builtin_amdgcn_exp2f(-1.44269504f * (pw0 + wl))));
                        const float av = sigmoidf_(pa0 + al);
                        const float kkv = kv * pkk;
                        const float km = kv * (1.0f + (av - 1.0f) * pka);
                        float ss, bon; wave_sum2_dpp(kkv * kkv, rr * km * prk, ss, bon);
                        const float kkn = kkv * __builtin_amdgcn_rsqf(fmaxf(ss, 1e-24f));
                        st[lz] = rr; st[64 + lz] = dc; st[2 * 64 + lz] = km; st[3 * 64 + lz] = -kkn; st[4 * 64 + lz] = kkn * av; st[5 * 64 + lz] = vv;
                        VBo[row * 512 + c] = f2bf(bon * vv);
                    }
                }
                {
                const unsigned sq0 = (unsigned)(uintptr_t)sw, va0 = sq0 + 4u * (unsigned)lz;
                f32x4 X0[4], X1[4], X2[4]; float vin;
                DSRV(vin, va0, 1280);
                DSR4(X2, sq0, 896, 912, 928, 944);
                DSR4(X0, sq0, 768, 784, 800, 816);
                DSR4(X1, sq0, 832, 848, 864, 880);
#pragma unroll 1
                for (int tk = 0; tk < TB; ++tk) {
                    f32x2 sa0 = {0.f, 0.f}, sa1 = {0.f, 0.f}, sp0 = {0.f, 0.f}, sp1 = {0.f, 0.f};
                    f32x2 y0 = {0.f, 0.f}, y1 = {0.f, 0.f}, p0 = {0.f, 0.f}, p1 = {0.f, 0.f};
                    f32x2 sav, spv;
                    const unsigned sqa = sq0 + 1536u * (unsigned)tk, vna = va0 + 1536u * (unsigned)tk;
                    DSWV(X0, vin, 4);
                    const f32x2 vv2 = {vin, vin};
                    SCAN_A(X0, 0);
                    DSR4(X0, sqa, 960, 976, 992, 1008);
                    DSW(X1, 4);
                    SCAN_A(X1, 1);
                    DSR4(X1, sqa, 256, 1024, 512, 0);
                    DSW(X2, 8);
                    SCAN_A(X2, 2);
                    DSR4(X2, sqa, 272, 1040, 528, 16);
                    DSW(X0, 8);
                    SCAN_A(X0, 3);
                    { const float sa = (sa0.x + sa0.y) + (sa1.x + sa1.y), sp = (sp0.x + sp0.y) + (sp1.x + sp1.y); sav = (f32x2){sa, sa}; spv = (f32x2){sp, sp}; }
                    DSR4(X0, sqa, 288, 1056, 544, 32);
                    DSW(X1, 8);
                    SCAN_B(X1, 0);
                    DSR4(X1, sqa, 304, 1072, 560, 48);
                    DSW(X2, 8);
                    SCAN_B(X2, 1);
                    DSR4(X2, sqa, 320, 1088, 576, 64);
                    DSW(X0, 8);
                    SCAN_B(X0, 2);
                    DSR4(X0, sqa, 336, 1104, 592, 80);
                    DSW(X1, 8);
                    SCAN_B(X1, 3);
                    DSR4(X1, sqa, 352, 1120, 608, 96);
                    DSW(X2, 8);
                    SCAN_B(X2, 4);
                    DSR4(X2, sqa, 368, 1136, 624, 112);
                    DSW(X0, 8);
                    SCAN_B(X0, 5);
                    DSR4(X0, sqa, 384, 1152, 640, 128);
                    DSW(X1, 8);
                    SCAN_B(X1, 6);
                    DSR4(X1, sqa, 400, 1168, 656, 144);
                    DSW(X2, 8);
                    SCAN_B(X2, 7);
                    DSR4(X2, sqa, 416, 1184, 672, 160);
                    DSW(X0, 8);
                    SCAN_B(X0, 8);
                    DSR4(X0, sqa, 432, 1200, 688, 176);
                    DSW(X1, 8);
                    SCAN_B(X1, 9);
                    DSR4(X1, sqa, 448, 1216, 704, 192);
                    DSW(X2, 8);
                    SCAN_B(X2, 10);
                    DSR4(X2, sqa, 464, 1232, 720, 208);
                    DSW(X0, 8);
                    SCAN_B(X0, 11);
                    DSR4(X0, sqa, 480, 1248, 736, 224);
                    DSW(X1, 8);
                    SCAN_B(X1, 12);
                    DSR4(X1, sqa, 496, 1264, 752, 240);
                    DSW(X2, 8);
                    SCAN_B(X2, 13);
                    {
                        const unsigned nx = (tk + 1 < TB) ? 1536u : 0u, sqn = sqa + nx, vnn = vna + nx;
                        DSRV(vin, vnn, 1280);
                        DSR4(X2, sqn, 896, 912, 928, 944);
                        DSW(X0, 9);
                        SCAN_B(X0, 14);
                        DSR4(X0, sqn, 768, 784, 800, 816);
                        DSW(X1, 9);
                        SCAN_B(X1, 15);
                        DSR4(X1, sqn, 832, 848, 864, 880);
                    }
                    const size_t row = (size_t)b * S_ + ts + tk;
                    Yo[row * 512 + 64 * wid + lz] = f2bf((y0.x + y0.y) + (y1.x + y1.y));
                    Po[row * 512 + 64 * wid + lz] = f2bf((p0.x + p0.y) + (p1.x + p1.y));
                }
                asm volatile("s_waitcnt lgkmcnt(0)" : "+v"(X0[0]), "+v"(X0[1]), "+v"(X0[2]), "+v"(X0[3]), "+v"(X1[0]), "+v"(X1[1]), "+v"(X1[2]), "+v"(X1[3]),
                             "+v"(X2[0]), "+v"(X2[1]), "+v"(X2[2]), "+v"(X2[3]), "+v"(vin));
                }
            }
        }
        {
            int lq = threadIdx.x; asm volatile("" : "+v"(lq)); lq &= 63;
            float* sg = SEGp + ((size_t)((b * 8 + wid) * NSEG + seg)) * 8192 + lq * 64;
#pragma unroll
            for (int j = 0; j < 32; j += 2) { *(f32x4*)(sg + 2 * j) = (f32x4){Pm2[j].x, Pm2[j].y, Pm2[j + 1].x, Pm2[j + 1].y};
                *(f32x4*)(sg + 4096 + 2 * j) = (f32x4){S2[j].x, S2[j].y, S2[j + 1].x, S2[j + 1].y}; }
        }
    }
}

__device__ __forceinline__ void ph_comb(const Params& P, LAS unsigned char* lds) {
    LAS float* SI = (LAS float*)lds;
    LAS float* PB = (LAS float*)(lds + 20480);
    float* SEGp = (float*)(P.ws + OFF_SEG);
    const int tid = opaque_tid(), wid = __builtin_amdgcn_readfirstlane(tid >> 6), lane = tid & 63, m = lane & 31, hh = lane >> 5;
    for (int chain = blockIdx.x; chain < 64; chain += gridDim.x) {
        float* base = SEGp + (size_t)chain * NSEG * 8192;
        __syncthreads();
        for (int i = tid; i < 4096; i += NTHR) SI[(i >> 6) * 65 + (i & 63)] = base[4096 + i];
        { const f32x4 a = *(const f32x4*)(base + 8192 + tid * 8), c = *(const f32x4*)(base + 8192 + tid * 8 + 4);
          *(LAS f32x4*)(PB + 4096 + tid * 8) = a; *(LAS f32x4*)(PB + 4096 + tid * 8 + 4) = c; }
        __syncthreads();
        const int ti = (wid >> 1) & 1, tj = wid & 1;
        for (int k = 1; k <= NSEG - 2; ++k) {
            float* Q = base + (size_t)k * 8192 + 4096;
            const LAS float* Pb = PB + (k & 1) * 4096;
            f32x4 na = {0.f, 0.f, 0.f, 0.f}, nc = na;
            if (k + 1 <= NSEG - 2) { const float* pn = base + (size_t)(k + 1) * 8192 + tid * 8; na = *(const f32x4*)pn; nc = *(const f32x4*)(pn + 4); }
            f32x16 Dv;
            if (wid < 4) {
                float qv[16];
#pragma unroll
                for (int r = 0; r < 16; ++r) { const int row = 32 * ti + (r & 3) + 8 * (r >> 2) + 4 * hh; qv[r] = Q[row * 64 + 32 * tj + m]; Dv[r] = 0.f; }
#pragma unroll
                for (int kk = 0; kk < 32; ++kk) { const float a = SI[(32 * ti + m) * 65 + 2 * kk + hh], bq = Pb[(2 * kk + hh) * 64 + 32 * tj + m];
                    Dv = __builtin_amdgcn_mfma_f32_32x32x2f32(a, bq, Dv, 0, 0, 0); }
#pragma unroll
                for (int r = 0; r < 16; ++r) Dv[r] += qv[r];
            }
            __syncthreads();
            if (wid < 4) {
#pragma unroll
                for (int r = 0; r < 16; ++r) { const int row = 32 * ti + (r & 3) + 8 * (r >> 2) + 4 * hh; SI[row * 65 + 32 * tj + m] = Dv[r]; Q[row * 64 + 32 * tj + m] = Dv[r]; }
            }
            if (k + 1 <= NSEG - 2) { LAS float* pd = PB + ((k + 1) & 1) * 4096 + tid * 8; *(LAS f32x4*)pd = na; *(LAS f32x4*)(pd + 4) = nc; }
            __syncthreads();
        }
    }
}

__device__ __forceinline__ void ph_post(const Params& P, int l) {
    const bf16_t* Yo = (const bf16_t*)(P.ws + OFF_Y); const bf16_t* Po = (const bf16_t*)(P.ws + OFF_P); const bf16_t* Go = (const bf16_t*)(P.ws + OFF_G);
    const bf16_t* VBo = (const bf16_t*)(P.ws + OFF_VB); const float* SEGp = (const float*)(P.ws + OFF_SEG); bf16_t* OR = (bf16_t*)(P.ws + OFF_ORWKV);
    const int tid = opaque_tid(), wid = __builtin_amdgcn_readfirstlane(tid >> 6), lane = tid & 63, m = lane & 31, hh = lane >> 5;
    for (int blk = blockIdx.x; blk < NB_ * NSEG; blk += gridDim.x) {
        const int b = blk / NSEG, seg = blk % NSEG, tbeg = seg * SEGL;
        bf16x8 SIf[2][4];
        if (seg > 0) {
            const float* sg = SEGp + ((size_t)((b * 8 + wid) * NSEG + seg - 1)) * 8192 + 4096;
#pragma unroll
            for (int ib = 0; ib < 2; ++ib)
#pragma unroll
                for (int ks = 0; ks < 4; ++ks) { const float* sp = sg + (32 * ib + m) * 64 + 16 * ks + 8 * hh; const f32x4 a = *(const f32x4*)sp, c = *(const f32x4*)(sp + 4);
                    u32x4 w; w.x = cvt_pk_bf16(a[0], a[1]); w.y = cvt_pk_bf16(a[2], a[3]); w.z = cvt_pk_bf16(c[0], c[1]); w.w = cvt_pk_bf16(c[2], c[3]); SIf[ib][ks] = __builtin_bit_cast(bf16x8, w); }
        }
        float lnw[32], lnb[32];
#pragma unroll
        for (int q = 0; q < 32; ++q) { const int ch = 64 * wid + 32 * (q >> 4) + (q & 3) + 8 * ((q & 15) >> 2) + 4 * hh; lnw[q] = P.ln_w[l * 512 + ch]; lnb[q] = P.ln_b[l * 512 + ch]; }
#pragma unroll 1
        for (int c = 0; c < SEGL / 32; ++c) {
            const size_t row = (size_t)b * S_ + tbeg + 32 * c + m;
            f32x16 D[2];
#pragma unroll
            for (int r = 0; r < 16; ++r) { D[0][r] = 0.f; D[1][r] = 0.f; }
            if (seg > 0) {
                const bf16_t* pp = Po + row * 512 + 64 * wid + 8 * hh;
#pragma unroll
                for (int ks = 0; ks < 4; ++ks) { const bf16x8 Pf = *(const bf16x8*)(pp + 16 * ks);
                    D[0] = __builtin_amdgcn_mfma_f32_32x32x16_bf16(SIf[0][ks], Pf, D[0], 0, 0, 0); D[1] = __builtin_amdgcn_mfma_f32_32x32x16_bf16(SIf[1][ks], Pf, D[1], 0, 0, 0); }
            }
            float y[32]; float s = 0.f;
#pragma unroll
            for (int ib = 0; ib < 2; ++ib)
#pragma unroll
                for (int g = 0; g < 4; ++g) { const u32x2 yw = *(const u32x2*)(Yo + row * 512 + 64 * wid + 32 * ib + 8 * g + 4 * hh);
                    y[16 * ib + 4 * g + 0] = bflo(yw.x) + D[ib][4 * g + 0]; y[16 * ib + 4 * g + 1] = bfhi(yw.x) + D[ib][4 * g + 1];
                    y[16 * ib + 4 * g + 2] = bflo(yw.y) + D[ib][4 * g + 2]; y[16 * ib + 4 * g + 3] = bfhi(yw.y) + D[ib][4 * g + 3]; }
#pragma unroll
            for (int q = 0; q < 32; ++q) s += y[q];
            s += shx(s, 32, lane);
            const float mean = s * (1.0f / 64.0f); float qv = 0.f;
#pragma unroll
            for (int q = 0; q < 32; ++q) { y[q] -= mean; qv += y[q] * y[q]; }
            qv += shx(qv, 32, lane);
            const float rstd = rsqrtf(qv * (1.0f / 64.0f) + 64e-5f);
#pragma unroll
            for (int ib = 0; ib < 2; ++ib)
#pragma unroll
                for (int g = 0; g < 4; ++g) { const size_t off = row * 512 + 64 * wid + 32 * ib + 8 * g + 4 * hh;
                    const u32x2 vw = *(const u32x2*)(VBo + off), gw = *(const u32x2*)(Go + off); const int q = 16 * ib + 4 * g;
                    const float o0 = (y[q] * rstd * lnw[q] + lnb[q] + bflo(vw.x)) * bflo(gw.x), o1 = (y[q + 1] * rstd * lnw[q + 1] + lnb[q + 1] + bfhi(vw.x)) * bfhi(gw.x);
                    const float o2 = (y[q + 2] * rstd * lnw[q + 2] + lnb[q + 2] + bflo(vw.y)) * bflo(gw.y), o3 = (y[q + 3] * rstd * lnw[q + 3] + lnb[q + 3] + bfhi(vw.y)) * bfhi(gw.y);
                    u32x2 w; w.x = cvt_pk_bf16(o0, o1); w.y = cvt_pk_bf16(o2, o3); *(u32x2*)(OR + off) = w; }
        }
    }
}

enum { PH_PRO = 0, PH_NORM1, PH_ZQ, PH_KI, PH_IDX, PH_ATT, PH_ZR, PH_SCAN, PH_COMB, PH_POST, PH_ZC, PH_CONV, PH_MERGE, PH_WO, PH_NORM2, PH_UP, PH_U, PH_DOWN, PH_FINAL, PH_COUNT };

template <int PH>
__device__ __forceinline__ void run_phase(const Params& P0, int l, LAS unsigned char* lds) {
    Params P = P0; P.ws = opaque_ptr(P0.ws);
    if constexpr (PH == PH_PRO) { if (l == 0) ph_mod(P, lds); ph_wconv(P, l, lds); }
    if constexpr (PH == PH_NORM1) ph_norm(P, l, 0);
    if constexpr (PH == PH_ZQ) ph_gemm_zq(P, lds);
    if constexpr (PH == PH_KI) ph_ki(P, lds);
    if constexpr (PH == PH_IDX) ph_idx(P, lds);
    if constexpr (PH == PH_ATT) ph_att(P, lds);
    if constexpr (PH == PH_ZR) ph_gemm_zr(P, lds);
    if constexpr (PH == PH_SCAN) ph_scan(P, l, lds);
    if constexpr (PH == PH_COMB) ph_comb(P, lds);
    if constexpr (PH == PH_POST) ph_post(P, l);
    if constexpr (PH == PH_ZC) ph_gemm_zc(P, lds);
    if constexpr (PH == PH_CONV) ph_conv(P, l, lds);
    if constexpr (PH == PH_MERGE) ph_gemm_merge(P, lds);
    if constexpr (PH == PH_WO) ph_gemm_wo(P, l, lds);
    if constexpr (PH == PH_NORM2) ph_norm(P, l, 1);
    if constexpr (PH == PH_UP) ph_gemm_up(P, l, lds);
    if constexpr (PH == PH_U) ph_ufix(P, l, lds);
    if constexpr (PH == PH_DOWN) ph_gemm_down(P, l, lds);
    if constexpr (PH == PH_FINAL) ph_final(P);
}

#if MK_SINGLE
__global__ void __launch_bounds__(NTHR, 2) k_mega(Params P) {
    extern __shared__ __attribute__((aligned(16))) unsigned char shm[];
    LAS unsigned char* lds = (LAS unsigned char*)shm;
    LAS unsigned* xbw = (LAS unsigned*)(lds + LDS_BYTES - 16);
    if (threadIdx.x == 0) { xbw[0] = 0u; xbw[1] = 0u; xbw[2] = 0u; xbw[3] = 0u; }
    __syncthreads();
    XcdBarrier bar = xcd_barrier_post((unsigned*)(P.ws + OFF_BAR), (volatile LAS unsigned*)xbw);
#ifndef PROBE_PH
#define PROBE_PH (-1)
#endif
#ifndef PROBE_N
#define PROBE_N 4
#endif
#define PHASE(PH, l) do { unsigned long long t0_ = 0; if (PROBE_PH == PH && blockIdx.x == 0) t0_ = wall_clock64(); \
        run_phase<PH>(P, l, lds); xcd_barrier(bar); \
        if (PROBE_PH == PH && blockIdx.x == 0) { const unsigned long long t1_ = wall_clock64(), d_ = (t1_ - t0_) * PROBE_N; while (wall_clock64() - t1_ < d_) __builtin_amdgcn_s_sleep(8); } } while (0)
#pragma unroll 1
    for (int l = 0; l < 2; ++l) {
        PHASE(PH_PRO, l); PHASE(PH_NORM1, l); PHASE(PH_ZQ, l); PHASE(PH_KI, l); PHASE(PH_IDX, l); PHASE(PH_ATT, l); PHASE(PH_ZR, l); PHASE(PH_SCAN, l); PHASE(PH_COMB, l); PHASE(PH_POST, l);
        PHASE(PH_ZC, l); PHASE(PH_CONV, l); PHASE(PH_MERGE, l); PHASE(PH_WO, l); PHASE(PH_NORM2, l); PHASE(PH_UP, l); PHASE(PH_U, l); PHASE(PH_DOWN, l);
    }
    run_phase<PH_FINAL>(P, 0, lds);
#undef PHASE
}
#else
template <int PH>
__global__ void __launch_bounds__(NTHR, 2) k_phase(Params P, int l) {
    extern __shared__ __attribute__((aligned(16))) unsigned char shm[];
    run_phase<PH>(P, l, (LAS unsigned char*)shm);
}
template <int PH> static void launch_phase(const Params& P, int l, hipStream_t stream) {
    static bool attr = false;
    if (!attr) { hipFuncSetAttribute((const void*)k_phase<PH>, hipFuncAttributeMaxDynamicSharedMemorySize, LDS_BYTES); attr = true; }
    hipLaunchKernelGGL(k_phase<PH>, dim3(NBLK), dim3(NTHR), LDS_BYTES, stream, P, l);
}
#endif

extern "C" void kernel_launch(void* const* d_in, const int* in_sizes, int n_in, void* d_out, int out_size, void* d_ws, size_t ws_size, hipStream_t stream) {
    (void)in_sizes; (void)n_in; (void)out_size; (void)ws_size;
    Params P{};
    P.x_in = (const float*)d_in[0]; P.c = (const float*)d_in[1]; P.pos = (const int*)d_in[2]; P.rel_bias = (const float*)d_in[3]; P.final_norm = (const float*)d_in[4];
    P.ada_w = (const float*)d_in[5]; P.ada_b = (const float*)d_in[6]; P.norm_mix = (const float*)d_in[7]; P.w_in = (const float*)d_in[8];
    P.mu = (const float*)d_in[9]; P.w0 = (const float*)d_in[10]; P.w_up = (const float*)d_in[11]; P.a0 = (const float*)d_in[12]; P.a_up = (const float*)d_in[13]; P.g_up = (const float*)d_in[14];
    P.k_k = (const float*)d_in[15]; P.k_a = (const float*)d_in[16]; P.r_k = (const float*)d_in[17]; P.ln_w = (const float*)d_in[18]; P.ln_b = (const float*)d_in[19];
    P.sc_conv_w = (const float*)d_in[20]; P.w_branch = (const float*)d_in[21]; P.w_o = (const float*)d_in[22]; P.norm_ffn = (const float*)d_in[23];
    P.ffn_w_up = (const float*)d_in[24]; P.ffn_conv_w = (const float*)d_in[25]; P.ffn_w_down = (const float*)d_in[26];
    P.out = (float*)d_out; P.ws = (unsigned char*)d_ws;
#if MK_SINGLE
    static bool attr = false;
    if (!attr) { hipFuncSetAttribute((const void*)k_mega, hipFuncAttributeMaxDynamicSharedMemorySize, LDS_BYTES); attr = true; }
    hipMemsetAsync((unsigned char*)d_ws + OFF_BAR, 0, XCD_BAR_WORDS * sizeof(unsigned), stream);
    hipLaunchKernelGGL(k_mega, dim3(NBLK), dim3(NTHR), LDS_BYTES, stream, P);
#else
    for (int l = 0; l < 2; ++l) {
        launch_phase<PH_PRO>(P, l, stream); launch_phase<PH_NORM1>(P, l, stream); launch_phase<PH_ZQ>(P, l, stream); launch_phase<PH_KI>(P, l, stream); launch_phase<PH_IDX>(P, l, stream);
        launch_phase<PH_ATT>(P, l, stream); launch_phase<PH_ZR>(P, l, stream); launch_phase<PH_SCAN>(P, l, stream); launch_phase<PH_COMB>(P, l, stream);
        launch_phase<PH_POST>(P, l, stream); launch_phase<PH_ZC>(P, l, stream); launch_phase<PH_CONV>(P, l, stream); launch_phase<PH_MERGE>(P, l, stream);
        launch_phase<PH_WO>(P, l, stream); launch_phase<PH_NORM2>(P, l, stream); launch_phase<PH_UP>(P, l, stream); launch_phase<PH_U>(P, l, stream);
        launch_phase<PH_DOWN>(P, l, stream);
    }
    launch_phase<PH_FINAL>(P, 0, stream);
#endif
}
```

```cpp
#include <hip/hip_runtime.h>
#include <stdint.h>

#ifndef MK_SINGLE
#define MK_SINGLE 1
#endif

#define LAS __attribute__((address_space(3)))
typedef unsigned short bf16_t;
typedef short bf16x8 __attribute__((ext_vector_type(8)));
typedef short bf16x4 __attribute__((ext_vector_type(4)));
typedef float f32x4 __attribute__((ext_vector_type(4)));
typedef float f32x16 __attribute__((ext_vector_type(16)));
typedef float f32x2 __attribute__((ext_vector_type(2)));
typedef unsigned u32x4 __attribute__((ext_vector_type(4)));
typedef unsigned u32x2 __attribute__((ext_vector_type(2)));
typedef int i32x4 __attribute__((ext_vector_type(4)));
typedef unsigned long long u64;
typedef unsigned long long u64x2 __attribute__((ext_vector_type(2)));

constexpr int T_ = 32768, D_ = 1024, NB_ = 8, S_ = 4096;
constexpr int NSEG = 32, SEGL = 128, TB = 8;
constexpr int NBLK = 256, NTHR = 512;
constexpr int IN_COLS = 8520, DFF = 2816;
constexpr int LDS_BYTES = 150 * 1024;

constexpr size_t MiB = 1ull << 20;
constexpr size_t OFF_BAR = 0;
constexpr size_t OFF_MOD = 64 * 1024;
constexpr size_t OFF_TAB = 512 * 1024;
constexpr size_t OFF_KPM = 520 * 1024;
constexpr size_t OFF_WB = 2 * MiB;
constexpr size_t WB_WIN = 0;
constexpr size_t WB_WBR = WB_WIN + (size_t)8704 * 1024 * 2;
constexpr size_t WB_WO = WB_WBR + (size_t)3 * 1024 * 512 * 2;
constexpr size_t WB_WUP = WB_WO + (size_t)1024 * 1024 * 2;
constexpr size_t WB_WDN = WB_WUP + (size_t)5632 * 1024 * 2;
constexpr size_t WB_LW = WB_WDN + (size_t)1024 * 2816 * 2;
constexpr size_t WB_LA = WB_LW + (size_t)512 * 64 * 2;
constexpr size_t WB_LG = WB_LA + (size_t)512 * 64 * 2;
constexpr size_t OFF_H = 42 * MiB;
constexpr size_t OFF_ZQ = 106 * MiB;
constexpr size_t OFF_MASK = 250 * MiB;
constexpr size_t OFF_VT = 266 * MiB;
constexpr size_t OFF_ZR = 106 * MiB;
constexpr size_t OFF_Y = 218 * MiB;
constexpr size_t OFF_P = 250 * MiB;
constexpr size_t OFF_G = 282 * MiB;
constexpr size_t OFF_SEG = 314 * MiB;
constexpr size_t OFF_KI = 314 * MiB;
constexpr size_t OFF_ZCV = 106 * MiB;
constexpr size_t OFF_ZG = 202 * MiB;
constexpr size_t OFF_MRG = 106 * MiB;
constexpr size_t OFF_UP = 106 * MiB;
constexpr size_t OFF_HA = 300 * MiB;
constexpr size_t OFF_HB = 320 * MiB;
constexpr size_t OFF_OCONV = 416 * MiB;
constexpr size_t OFF_ORWKV = 448 * MiB;
constexpr size_t OFF_OATT = 480 * MiB;
constexpr size_t OFF_VB = OFF_ORWKV;
constexpr size_t OFF_SCR = 378 * MiB;

struct Params {
    const float* x_in; const float* c; const int* pos; const float* rel_bias; const float* final_norm;
    const float* ada_w; const float* ada_b; const float* norm_mix; const float* w_in;
    const float* mu; const float* w0; const float* w_up; const float* a0; const float* a_up; const float* g_up;
    const float* k_k; const float* k_a; const float* r_k; const float* ln_w; const float* ln_b;
    const float* sc_conv_w; const float* w_branch; const float* w_o; const float* norm_ffn;
    const float* ffn_w_up; const float* ffn_conv_w; const float* ffn_w_down;
    float* out; unsigned char* ws;
};

__device__ __forceinline__ float bf2f(bf16_t b) { return __uint_as_float(((unsigned)b) << 16); }
__device__ __forceinline__ bf16_t f2bf(float f) { unsigned u = __float_as_uint(f); u += 0x7FFFu + ((u >> 16) & 1u); return (bf16_t)(u >> 16); }
typedef __bf16 bf16x2_t __attribute__((ext_vector_type(2)));
__device__ __forceinline__ unsigned cvt_pk_bf16(float lo, float hi) { const f32x2 v = {lo, hi}; return __builtin_bit_cast(unsigned, __builtin_convertvector(v, bf16x2_t)); }
__device__ __forceinline__ float bflo(unsigned w) { return __uint_as_float(w << 16); }
__device__ __forceinline__ float bfhi(unsigned w) { return __uint_as_float(w & 0xffff0000u); }
__device__ __forceinline__ float shx(float v, int mask, int lane) { return __int_as_float(__builtin_amdgcn_ds_bpermute((lane ^ mask) << 2, __float_as_int(v))); }
__device__ __forceinline__ int shxi(int v, int mask, int lane) { return __builtin_amdgcn_ds_bpermute((lane ^ mask) << 2, v); }
__device__ __forceinline__ float wave_sum(float v, int lane) {
#pragma unroll
    for (int o = 32; o >= 1; o >>= 1) v += shx(v, o, lane);
    return v;
}
__device__ __forceinline__ void writelane_c2(int& vlo, int& vhi, int lo, int hi, int ln  ) {
    asm("s_nop 3\n\tv_writelane_b32 %0, %2, %4\n\tv_writelane_b32 %1, %3, %4" : "+v"(vlo), "+v"(vhi) : "s"(lo), "s"(hi), "n"(ln)); }
__device__ __forceinline__ int writelane_v(int vec, int val, int ln  ) { asm("s_mov_b32 m0, %2\n\ts_nop 3\n\tv_writelane_b32 %0, %1, m0" : "+v"(vec) : "s"(val), "s"(ln) : "m0"); return vec; }
__device__ __forceinline__ float sigmoidf_(float x) { return __builtin_amdgcn_rcpf(1.0f + __expf(-x)); }
__device__ __forceinline__ unsigned f2ord(float x) { unsigned u = __float_as_uint(x); return (u & 0x80000000u) ? ~u : (u | 0x80000000u); }
__device__ __forceinline__ float ord2f(unsigned k) { return __uint_as_float((k & 0x80000000u) ? (k & 0x7fffffffu) : ~k); }

__device__ __forceinline__ int opaque_tid() { int t = threadIdx.x; asm volatile("" : "+v"(t)); return t; }
__device__ __forceinline__ unsigned char* opaque_ptr(unsigned char* p) {
    typedef __attribute__((address_space(1))) unsigned char* gptr_t;
    gptr_t g = (gptr_t)p; asm volatile("" : "+s"(g)); return (unsigned char*)g; }

#define XB_TMO      128
#define XB_XCNT(j)  (256  + 64 * (j))
#define XB_XSUB(j)  (1280 + 64 * (j))
#define XB_XGEN(j)  (2304 + 64 * (j))
#define XB_TOP      3328
#define XB_TOPGEN   3392
#define XCD_BAR_WORDS 3456
#define XB_SPIN_CAP (1u << 22)

__device__ __forceinline__ unsigned xb_ld(unsigned* p)              { return __hip_atomic_load(p, __ATOMIC_RELAXED, __HIP_MEMORY_SCOPE_AGENT); }
__device__ __forceinline__ unsigned xb_add(unsigned* p, unsigned v) { return __hip_atomic_fetch_add(p, v, __ATOMIC_RELAXED, __HIP_MEMORY_SCOPE_AGENT); }
__device__ __forceinline__ unsigned xb_xcc_id() { return (unsigned)__builtin_amdgcn_s_getreg((3 << 11) | 20) & 0xFu; }
#define XB_SPIN(cond, bar) do { unsigned _sp = 0; while (cond) { __builtin_amdgcn_s_sleep(1); \
    if ((++_sp & 255u) == 0u) { if (xb_ld(&(bar)[XB_TMO])) break; if (_sp > XB_SPIN_CAP) { atomicAdd(&(bar)[XB_TMO], 1u); break; } } } } while (0)

struct XcdBarrier { unsigned* bar; unsigned x; volatile LAS unsigned* st; };

__device__ __forceinline__ XcdBarrier xcd_barrier_post(unsigned* bar, volatile LAS unsigned* st) {
    XcdBarrier b; b.bar = bar; b.x = xb_xcc_id(); b.st = st;
    if (threadIdx.x == 0) (void)xb_add(&bar[XB_XCNT(b.x)], 1u);
    return b;
}
__device__ __forceinline__ void xcd_barrier_complete(unsigned* bar, unsigned x, unsigned& nloc, unsigned& nx) {
    const unsigned G = gridDim.x * gridDim.y * gridDim.z;
    unsigned sum, cnt, mine, sp = 0u;
    for (;;) {
        sum = 0u; cnt = 0u; mine = 0u;
#pragma unroll
        for (unsigned j = 0; j < 16; ++j) { const unsigned c = xb_ld(&bar[XB_XCNT(j)]); sum += c; cnt += (c > 0u) ? 1u : 0u; mine = (j == x) ? c : mine; }
        if (sum == G) break;
        __builtin_amdgcn_s_sleep(1);
        if ((++sp & 255u) == 0u) { if (xb_ld(&bar[XB_TMO])) break; if (sp > XB_SPIN_CAP) { atomicAdd(&bar[XB_TMO], 1u); break; } }
    }
    nloc = mine > 0u ? mine : 1u; nx = cnt > 0u ? cnt : 1u;
}
__device__ __forceinline__ void xcd_barrier(const XcdBarrier& b) {
    asm volatile("s_waitcnt vmcnt(0)" ::: "memory");
    __syncthreads();
    if (threadIdx.x == 0) {
        unsigned* bar = b.bar;
        __builtin_amdgcn_s_waitcnt(0);
        unsigned nloc = b.st[0], nx = b.st[1];
        if (nloc == 0u) { xcd_barrier_complete(bar, b.x, nloc, nx); b.st[0] = nloc; b.st[1] = nx; }
        const unsigned old = xb_add(&bar[XB_XSUB(b.x)], 1u);
        const unsigned gen = old / nloc;
        if (old + 1u == (gen + 1u) * nloc) {
            __builtin_amdgcn_fence(__ATOMIC_RELEASE, "agent");
            asm volatile("s_waitcnt vmcnt(0)" ::: "memory");
            const unsigned og = xb_add(&bar[XB_TOP], 1u);
            const unsigned tg = og / nx;
            if (og + 1u == (tg + 1u) * nx) xb_add(&bar[XB_TOPGEN], 1u);
            else XB_SPIN(xb_ld(&bar[XB_TOPGEN]) == tg, bar);
            __builtin_amdgcn_fence(__ATOMIC_ACQUIRE, "agent");
            xb_add(&bar[XB_XGEN(b.x)], 1u);
            asm volatile("s_waitcnt vmcnt(0)" ::: "memory");
        } else {
            XB_SPIN(xb_ld(&bar[XB_XGEN(b.x)]) == gen, bar);
            __builtin_amdgcn_fence(__ATOMIC_ACQUIRE, "agent");
            asm volatile("s_waitcnt vmcnt(0)" ::: "memory");
        }
    }
    __syncthreads();
}

namespace g8 {
constexpr int BM = 256, BK = 64, HALF = 128, HTB = HALF * BK * 2, STAGE_BYTES = 8 * HTB, NXCD = 8, WGM = 8;
__device__ __forceinline__ int lds_byte(int r, int c) { const int st = (r >> 4) * 2 + (c >> 5), rr = r & 15, cc = c & 31, ob = rr * 64 + cc * 2; return st * 1024 + (ob ^ (((ob >> 9) & 1) << 5)); }
__device__ __forceinline__ void stage_rc(int b, int& R, int& C) { const int st = b / 1024, sb = b % 1024, swz = sb ^ (((sb >> 9) & 1) << 5); R = (st >> 1) * 16 + swz / 64; C = (st & 1) * 32 + (swz % 64) / 2; }
__device__ __forceinline__ int perm32(int rho) { const int n = rho >> 4, i = rho & 15; return 8 * (i >> 2) + 4 * n + (i & 3); }

struct Unit { const char* A; const char* B; int pm, pn, tag; };

struct SOrder {
    int nM, nN, nwg, G, c; const char* A; const char* Bt; size_t a_t, b_t;
    __device__ void init(int M, int N, int lda, int ldb, const void* A_, const void* Bt_) {
        nM = M / BM; nN = N / BM; nwg = nM * nN; G = (int)gridDim.x; c = (int)blockIdx.x; A = (const char*)A_; Bt = (const char*)Bt_;
        a_t = (size_t)BM * lda * 2; b_t = (size_t)BM * ldb * 2; }
    __device__ bool next(int i, Unit& u) const {
        const long L = (long)i * G + c; if (L >= nwg) return false;
        int wgid = (int)L; { const int q = nwg / NXCD, r = nwg % NXCD, xcd = wgid % NXCD, off = wgid / NXCD; wgid = (xcd < r ? xcd * (q + 1) : r * (q + 1) + (xcd - r) * q) + off; }
        const int nig = WGM * nN, gid = wgid / nig, fm = gid * WGM, gsz = (nM - fm) < WGM ? (nM - fm) : WGM;
        u.pm = fm + ((wgid % nig) % gsz); u.pn = (wgid % nig) / gsz; u.tag = 0;
        u.A = A + (size_t)u.pm * a_t; u.B = Bt + (size_t)u.pn * b_t; return true;
    }
};

template <class Epi, class Sched>
__device__ __forceinline__ void gemm_phase(LAS unsigned char* lds, const int K, const int lda, const int ldb, const Sched& S, const Epi& E) {
    const int tid = opaque_tid(), wid = __builtin_amdgcn_readfirstlane(tid >> 6), lane = tid & 63, wr = wid >> 2, wc = wid & 3, fr = lane & 15, fq = lane >> 4;
    const int nt = K / BK;
    unsigned voffA[2], voffB[2];
#pragma unroll
    for (int i = 0; i < 2; ++i) { int R, C; stage_rc(tid * 16 + i * 8192, R, C); const int Rb = Epi::PERM ? ((R & ~31) + perm32(R & 31)) : R;
        voffA[i] = (unsigned)(R * lda + C) * 2u; voffB[i] = (unsigned)(Rb * ldb + C) * 2u; }
    const size_t kstep = (size_t)(BK * 2);
    const size_t hstepA = (size_t)HALF * lda * 2, hstepB = (size_t)HALF * ldb * 2;
    const unsigned ldsw = (unsigned)wid * 1024u;
    const int aoff = lds_byte(wr * 64 + fr, fq * 8), boff = lds_byte(wc * 32 + fr, fq * 8);
#define PG8_SA(b, h) (((b) * 2 + (h)) * HTB)
#define PG8_SB(b, h) ((4 + (b) * 2 + (h)) * HTB)
#define PG8_STAGE(bufoff, gbase, voff) do { _Pragma("unroll") for (int _i = 0; _i < 2; ++_i) \
        __builtin_amdgcn_global_load_lds((const unsigned*)((const char*)(gbase) + (voff)[_i]), (LAS unsigned*)(lds + (bufoff) + ldsw + _i * 8192), 16, 0, 0); } while (0)
#define PG8_LDA(dst, b, h) do { _Pragma("unroll") for (int m = 0; m < 4; ++m) _Pragma("unroll") for (int k = 0; k < 2; ++k) dst[m][k] = *(const LAS bf16x8*)(lds + PG8_SA(b, h) + aoff + m * 2048 + k * 1024); } while (0)
#define PG8_LDB(dst, b, h) do { _Pragma("unroll") for (int n = 0; n < 2; ++n) _Pragma("unroll") for (int k = 0; k < 2; ++k) dst[n][k] = *(const LAS bf16x8*)(lds + PG8_SB(b, h) + boff + n * 2048 + k * 1024); } while (0)
#define PG8_MMA(ai, bj, At, Bt) do { __builtin_amdgcn_s_setprio(1); _Pragma("unroll") for (int m = 0; m < 4; ++m) _Pragma("unroll") for (int n = 0; n < 2; ++n) _Pragma("unroll") for (int k = 0; k < 2; ++k) \
        acc[ai][bj][m][n] = __builtin_amdgcn_mfma_f32_16x16x32_bf16(Bt[n][k], At[m][k], acc[ai][bj][m][n], 0, 0, 0); __builtin_amdgcn_s_setprio(0); } while (0)
#define PG8_WAIT_V(n) asm volatile("s_waitcnt vmcnt(" #n ")" ::: "memory")
#define PG8_WAIT_L(n) asm volatile("s_waitcnt lgkmcnt(" #n ")" ::: "memory")
#define PG8_BAR __builtin_amdgcn_s_barrier()
#define PG8_SCHED __builtin_amdgcn_sched_barrier(0)
    Unit cur, nxt; int ui = 0;
    if (!S.next(0, cur)) return;
    f32x4 acc[2][2][4][2];
#pragma unroll
    for (int a = 0; a < 2; ++a)
#pragma unroll
        for (int b = 0; b < 2; ++b)
#pragma unroll
            for (int m = 0; m < 4; ++m)
#pragma unroll
                for (int n = 0; n < 2; ++n) acc[a][b][m][n] = (f32x4){0.f, 0.f, 0.f, 0.f};
    bf16x8 At[4][2], B0[2][2], B1[2][2];
    const char* cA = cur.A; const char* cB = cur.B;
    PG8_STAGE(PG8_SB(0, 0), cB, voffB); PG8_STAGE(PG8_SA(0, 0), cA, voffA); PG8_STAGE(PG8_SB(0, 1), cB + hstepB, voffB); PG8_STAGE(PG8_SA(0, 1), cA + hstepA, voffA);
    if (wr == 1) PG8_BAR;
    PG8_WAIT_V(4); PG8_BAR;
    PG8_STAGE(PG8_SB(1, 0), cB + kstep, voffB); PG8_STAGE(PG8_SA(1, 0), cA + kstep, voffA); PG8_STAGE(PG8_SB(1, 1), cB + hstepB + kstep, voffB);
    PG8_WAIT_V(6); PG8_BAR;
    for (;;) {
        const bool has_next = S.next(ui + 1, nxt);
        const char* nA = has_next ? nxt.A : cA; const char* nB = has_next ? nxt.B : cB;
        for (int t = 0; t < nt; t += 2) {
            const bool last = (t == nt - 2);
            const char* a1 = cA + (size_t)(t + 1) * kstep;
            const char* a2 = last ? nA : cA + (size_t)(t + 2) * kstep; const char* b2 = last ? nB : cB + (size_t)(t + 2) * kstep;
            const char* a3 = a2 + kstep; const char* b3 = b2 + kstep;
            PG8_LDB(B0, 0, 0); PG8_SCHED; PG8_LDA(At, 0, 0); PG8_STAGE(PG8_SA(1, 1), a1 + hstepA, voffA);
            PG8_WAIT_L(8); PG8_BAR; PG8_WAIT_L(0); PG8_MMA(0, 0, At, B0); PG8_BAR; PG8_SCHED;
            PG8_LDB(B1, 0, 1); PG8_STAGE(PG8_SB(0, 0), b2, voffB);
            PG8_BAR; PG8_WAIT_L(0); PG8_MMA(0, 1, At, B1); PG8_BAR;
            PG8_LDA(At, 0, 1); PG8_STAGE(PG8_SA(0, 0), a2, voffA);
            PG8_BAR; PG8_WAIT_L(0); PG8_MMA(1, 0, At, B0); PG8_BAR; PG8_SCHED;
            PG8_STAGE(PG8_SB(0, 1), b2 + hstepB, voffB);
            PG8_WAIT_V(6); PG8_BAR; PG8_MMA(1, 1, At, B1); PG8_BAR;
            PG8_LDB(B0, 1, 0); PG8_SCHED; PG8_LDA(At, 1, 0); PG8_STAGE(PG8_SA(0, 1), a2 + hstepA, voffA);
            PG8_WAIT_L(8); PG8_BAR; PG8_WAIT_L(0); PG8_MMA(0, 0, At, B0); PG8_BAR; PG8_SCHED;
            PG8_LDB(B1, 1, 1); PG8_STAGE(PG8_SB(1, 0), b3, voffB);
            PG8_BAR; PG8_WAIT_L(0); PG8_MMA(0, 1, At, B1); PG8_BAR;
            PG8_LDA(At, 1, 1); PG8_STAGE(PG8_SA(1, 0), a3, voffA);
            PG8_BAR; PG8_WAIT_L(0); PG8_MMA(1, 0, At, B0); PG8_BAR; PG8_SCHED;
            PG8_STAGE(PG8_SB(1, 1), b3 + hstepB, voffB);
            PG8_WAIT_V(6); PG8_BAR; PG8_MMA(1, 1, At, B1); PG8_BAR;
        }
        bool keep = false;
        if constexpr (Epi::CHAIN) keep = E.chain(acc, cur, wr, wc, fr, fq); else E(acc, cur, wr, wc, fr, fq);
        if (!has_next) break;
        if (!keep) {
#pragma unroll
            for (int a = 0; a < 2; ++a)
#pragma unroll
                for (int b = 0; b < 2; ++b)
#pragma unroll
                    for (int m = 0; m < 4; ++m)
#pragma unroll
                        for (int n = 0; n < 2; ++n) acc[a][b][m][n] = (f32x4){0.f, 0.f, 0.f, 0.f};
        }
        cur = nxt; cA = nA; cB = nB; ++ui;
    }
    PG8_WAIT_V(0);
    if (wr == 0) PG8_BAR;
    PG8_BAR;
#undef PG8_SA
#undef PG8_SB
#undef PG8_STAGE
#undef PG8_LDA
#undef PG8_LDB
#undef PG8_MMA
#undef PG8_WAIT_V
#undef PG8_WAIT_L
#undef PG8_BAR
#undef PG8_SCHED
}

struct EpiBf {
    static constexpr bool PERM = true, CHAIN = false;
    bf16_t* O0; int ld0; int split; bf16_t* O1; int ld1; int act1;
    __device__ __forceinline__ void operator()(const f32x4 (&acc)[2][2][4][2], const Unit& u, int wr, int wc, int fr, int fq) const {
        const bool second = u.pn >= split;
        bf16_t* base = second ? O1 : O0; const int ld = second ? ld1 : ld0; const int colt = (second ? (u.pn - split) : u.pn) * BM;
        const bool act = second && act1;
        const int row0 = u.pm * BM + wr * 64 + fr, col0 = colt + wc * 32 + 8 * fq;
#pragma unroll
        for (int ai = 0; ai < 2; ++ai)
#pragma unroll
            for (int m = 0; m < 4; ++m) { bf16_t* rowp = base + (size_t)(row0 + ai * HALF + m * 16) * ld + col0;
#pragma unroll
                for (int bj = 0; bj < 2; ++bj) { f32x4 v0 = acc[ai][bj][m][0], v1 = acc[ai][bj][m][1];
                    if (act) {
#pragma unroll
                        for (int j = 0; j < 4; ++j) { v0[j] = sigmoidf_(v0[j]); v1[j] = sigmoidf_(v1[j]); } }
                    u32x4 w; w.x = cvt_pk_bf16(v0[0], v0[1]); w.y = cvt_pk_bf16(v0[2], v0[3]); w.z = cvt_pk_bf16(v1[0], v1[1]); w.w = cvt_pk_bf16(v1[2], v1[3]);
                    *(u32x4*)(rowp + bj * HALF) = w; } }
    }
};
struct EpiMerge {
    static constexpr bool PERM = true, CHAIN = true;
    bf16_t* M; const bf16_t* ZG;
    __device__ __forceinline__ bool chain(f32x4 (&acc)[2][2][4][2], const Unit& u, int wr, int wc, int fr, int fq) const {
        const int row0 = u.pm * BM + wr * 64 + fr, col0 = u.pn * BM + wc * 32 + 8 * fq;
#pragma unroll
        for (int ai = 0; ai < 2; ++ai)
#pragma unroll
            for (int m = 0; m < 4; ++m) { const size_t r = (size_t)(row0 + ai * HALF + m * 16);
#pragma unroll
                for (int bj = 0; bj < 2; ++bj) {
                    const bf16_t* gp = ZG + r * 3072 + col0 + bj * HALF;
                    float f[8];
                    if (u.tag == 2) { const u32x4 g = *(const u32x4*)(gp + 2048);
                        f[0] = bflo(g.x); f[1] = bfhi(g.x); f[2] = bflo(g.y); f[3] = bfhi(g.y); f[4] = bflo(g.z); f[5] = bfhi(g.z); f[6] = bflo(g.w); f[7] = bfhi(g.w);
#pragma unroll
                        for (int e = 0; e < 8; ++e) f[e] = fmaxf(f[e], 1e-12f);
                    } else { const u32x4 gn = *(const u32x4*)(gp + u.tag * 1024), gd = *(const u32x4*)(gp + (u.tag + 1) * 1024);
                        const float nn[8] = {bflo(gn.x), bfhi(gn.x), bflo(gn.y), bfhi(gn.y), bflo(gn.z), bfhi(gn.z), bflo(gn.w), bfhi(gn.w)};
                        const float dd[8] = {bflo(gd.x), bfhi(gd.x), bflo(gd.y), bfhi(gd.y), bflo(gd.z), bfhi(gd.z), bflo(gd.w), bfhi(gd.w)};
#pragma unroll
                        for (int e = 0; e < 8; ++e) f[e] = (u.tag == 0 ? nn[e] : fmaxf(nn[e], 1e-12f)) * __builtin_amdgcn_rcpf(fmaxf(dd[e], 1e-12f)); }
                    f32x4& v0 = acc[ai][bj][m][0]; f32x4& v1 = acc[ai][bj][m][1];
                    v0[0] *= f[0]; v0[1] *= f[1]; v0[2] *= f[2]; v0[3] *= f[3]; v1[0] *= f[4]; v1[1] *= f[5]; v1[2] *= f[6]; v1[3] *= f[7];
                    if (u.tag == 2) { u32x4 w; w.x = cvt_pk_bf16(v0[0], v0[1]); w.y = cvt_pk_bf16(v0[2], v0[3]); w.z = cvt_pk_bf16(v1[0], v1[1]); w.w = cvt_pk_bf16(v1[2], v1[3]);
                        *(u32x4*)(M + r * 1024 + col0 + bj * HALF) = w; }
                } }
        return u.tag != 2;
    }
};
struct EpiRes {
    static constexpr bool PERM = true, CHAIN = false;
    const float* xin32; const bf16_t* xin16; bf16_t* xout; const float* gate;
    __device__ __forceinline__ void operator()(const f32x4 (&acc)[2][2][4][2], const Unit& u, int wr, int wc, int fr, int fq) const {
        const int row0 = u.pm * BM + wr * 64 + fr, col0 = u.pn * BM + wc * 32 + 8 * fq;
        const float* gp = gate + (size_t)(u.pm >> 4) * 6144 + col0;
        f32x4 gv[2][2];
#pragma unroll
        for (int bj = 0; bj < 2; ++bj) { gv[bj][0] = *(const f32x4*)(gp + bj * HALF); gv[bj][1] = *(const f32x4*)(gp + bj * HALF + 4); }
#pragma unroll
        for (int ai = 0; ai < 2; ++ai)
#pragma unroll
            for (int m = 0; m < 4; ++m) { const size_t off = (size_t)(row0 + ai * HALF + m * 16) * 1024 + col0;
#pragma unroll
                for (int bj = 0; bj < 2; ++bj) {
                    f32x4 x0, x1;
                    if (xin32) { x0 = *(const f32x4*)(xin32 + off + bj * HALF); x1 = *(const f32x4*)(xin32 + off + bj * HALF + 4); }
                    else { const u32x4 xw = *(const u32x4*)(xin16 + off + bj * HALF);
                        x0 = (f32x4){bflo(xw.x), bfhi(xw.x), bflo(xw.y), bfhi(xw.y)}; x1 = (f32x4){bflo(xw.z), bfhi(xw.z), bflo(xw.w), bfhi(xw.w)}; }
                    const f32x4 o0 = x0 + gv[bj][0] * acc[ai][bj][m][0], o1 = x1 + gv[bj][1] * acc[ai][bj][m][1];
                    u32x4 w; w.x = cvt_pk_bf16(o0[0], o0[1]); w.y = cvt_pk_bf16(o0[2], o0[3]); w.z = cvt_pk_bf16(o1[0], o1[1]); w.w = cvt_pk_bf16(o1[2], o1[3]);
                    *(u32x4*)(xout + off + bj * HALF) = w; } }
    }
};
__device__ __forceinline__ float dpp_prev(float x, float y, int n) {
    if (n == 1) { const int yr = __builtin_amdgcn_update_dpp(0, __float_as_int(y), 0x121, 0xf, 0xf, false);
                  return __int_as_float(__builtin_amdgcn_update_dpp(yr, __float_as_int(x), 0x111, 0xf, 0xf, false)); }
    const int yr = __builtin_amdgcn_update_dpp(0, __float_as_int(y), 0x122, 0xf, 0xf, false);
    return __int_as_float(__builtin_amdgcn_update_dpp(yr, __float_as_int(x), 0x112, 0xf, 0xf, false));
}
struct EpiUp {
    static constexpr bool PERM = true, CHAIN = false;
    bf16_t* U; float* HA; float* HB; const float* cw;
    __device__ __forceinline__ void operator()(const f32x4 (&acc)[2][2][4][2], const Unit& u, int wr, int wc, int fr, int fq) const {
        const int c0 = 128 * u.pn + 32 * wc + 8 * fq;
        float w0[8], w1[8], w2[8];
        { float f[24];
#pragma unroll
          for (int q = 0; q < 6; ++q) { const f32x4 v = *(const f32x4*)(cw + (size_t)c0 * 3 + 4 * q); f[4 * q] = v[0]; f[4 * q + 1] = v[1]; f[4 * q + 2] = v[2]; f[4 * q + 3] = v[3]; }
#pragma unroll
          for (int e = 0; e < 8; ++e) { w0[e] = f[3 * e]; w1[e] = f[3 * e + 1]; w2[e] = f[3 * e + 2]; } }
#pragma unroll
        for (int ai = 0; ai < 2; ++ai) {
            const int grp = 4 * u.pm + 2 * ai + wr;
            float Y[8];
#pragma unroll
            for (int e = 0; e < 8; ++e) Y[e] = 0.f;
#pragma unroll
            for (int m = 0; m < 4; ++m) {
                const size_t row = (size_t)u.pm * BM + ai * HALF + wr * 64 + m * 16 + fr;
                float X[8], G[8], o[8];
#pragma unroll
                for (int e = 0; e < 8; ++e) { X[e] = acc[ai][0][m][e >> 2][e & 3]; G[e] = acc[ai][1][m][e >> 2][e & 3]; }
#pragma unroll
                for (int e = 0; e < 8; ++e) { const float a1 = dpp_prev(X[e], Y[e], 1), a2 = dpp_prev(X[e], Y[e], 2);
                    const float s = w0[e] * a2 + w1[e] * a1 + w2[e] * X[e]; o[e] = s * sigmoidf_(s) * G[e]; }
                if (m > 0 || fr >= 2) { u32x4 w; w.x = cvt_pk_bf16(o[0], o[1]); w.y = cvt_pk_bf16(o[2], o[3]); w.z = cvt_pk_bf16(o[4], o[5]); w.w = cvt_pk_bf16(o[6], o[7]);
                    *(u32x4*)(U + row * DFF + c0) = w; }
                if (m == 0 && fr < 2) { float* hb = HB + ((size_t)(grp * 2 + fr) * 2) * DFF + c0;
                    *(f32x4*)hb = (f32x4){X[0], X[1], X[2], X[3]}; *(f32x4*)(hb + 4) = (f32x4){X[4], X[5], X[6], X[7]};
                    *(f32x4*)(hb + DFF) = (f32x4){G[0], G[1], G[2], G[3]}; *(f32x4*)(hb + DFF + 4) = (f32x4){G[4], G[5], G[6], G[7]}; }
                if (m == 3 && fr >= 14) { float* ha = HA + (size_t)(grp * 2 + fr - 14) * DFF + c0;
                    *(f32x4*)ha = (f32x4){X[0], X[1], X[2], X[3]}; *(f32x4*)(ha + 4) = (f32x4){X[4], X[5], X[6], X[7]}; }
#pragma unroll
                for (int e = 0; e < 8; ++e) Y[e] = X[e];
            }
        }
    }
};
struct MergeOrder {
    int G, c; const char* o_att; const char* wbr;
    __device__ bool next(int i, Unit& u) const {
        const int tile = (i / 3) * G + c; if (tile >= (T_ / BM) * 4) return false;
        const int br = i % 3; u.pm = tile >> 2; u.pn = tile & 3; u.tag = br;
        u.A = o_att - (size_t)br * (32 * MiB) + (size_t)u.pm * BM * 512 * 2;
        u.B = wbr + (size_t)br * 1024 * 512 * 2 + (size_t)u.pn * BM * 512 * 2; return true;
    }
};
}

#define GSTRIDE_BLOCKS(var, n) for (int var = blockIdx.x; var < (n); var += gridDim.x)

__device__ __forceinline__ void ph_mod(const Params& P, LAS unsigned char* lds) {
    LAS float* cl = (LAS float*)lds;
    LAS float* red = cl + 8192;
    float* mod = (float*)(P.ws + OFF_MOD); float* tab = (float*)(P.ws + OFF_TAB);
    const int tid = opaque_tid(), wid = tid >> 6, lane = tid & 63;
    for (int i = tid; i < 2048; i += NTHR) ((LAS f32x4*)cl)[i] = ((const f32x4*)P.c)[i];
    __syncthreads();
    GSTRIDE_BLOCKS(blk, 192) {
        const int l = blk / 96, jb = blk % 96, j = jb * 64 + lane;
        float acc[8];
#pragma unroll
        for (int b = 0; b < 8; ++b) acc[b] = 0.f;
        const float* aw = P.ada_w + (size_t)l * 1024 * 6144 + j;
#pragma unroll 1
        for (int k = wid * 128; k < wid * 128 + 128; k += 32) {
            float w[32];
#pragma unroll
            for (int u = 0; u < 32; ++u) w[u] = aw[(size_t)(k + u) * 6144];
#pragma unroll
            for (int u4 = 0; u4 < 8; ++u4)
#pragma unroll
                for (int b = 0; b < 8; ++b) { const f32x4 c4 = *(const LAS f32x4*)(cl + b * 1024 + k + 4 * u4);
                    acc[b] += c4.x * w[4 * u4]; acc[b] += c4.y * w[4 * u4 + 1]; acc[b] += c4.z * w[4 * u4 + 2]; acc[b] += c4.w * w[4 * u4 + 3]; }
        }
#pragma unroll
        for (int b = 0; b < 8; ++b) red[(wid * 8 + b) * 64 + lane] = acc[b];
        __syncthreads();
        { const int b = wid; float s = P.ada_b[l * 6144 + j];
#pragma unroll
          for (int w = 0; w < 8; ++w) s += red[(w * 8 + b) * 64 + lane];
          mod[((size_t)l * 8 + b) * 6144 + j] = s; }
        __syncthreads();
    }
    if (blockIdx.x == gridDim.x - 1) {
        for (int i = tid; i < 1024; i += NTHR) { const int n = i >> 3, h = i & 7; int bk;
            if (n < 16) bk = n; else { const float nf = (float)n; bk = 16 + (int)(logf(nf / 16.0f) / 2.0794415416798357f * 16.0f); bk = bk < 31 ? bk : 31; }
            tab[i] = P.rel_bias[bk * 8 + h]; }
    }
}

struct WJob { const float* src; int ldsrc; int K; int N; bf16_t* dst; int win; };
__device__ __forceinline__ int wjob_col(const WJob& J, const int nn) {
    int col = nn;
    if (J.win == 1) col = nn < 2120 ? nn : (nn < 2304 ? -1 : nn - 184);
    if (J.win == 2) col = ((nn & 255) < 128) ? 128 * (nn >> 8) + (nn & 127) : DFF + 128 * (nn >> 8) + (nn & 127);
    return col;
}
template <int KT  >
__device__ __forceinline__ void wtile_load(const WJob& J, const int lt, const int tid, float (&v)[KT / 8]) {
    const int nkt = J.K / KT, kt = lt % nkt, ntb = lt / nkt, k0 = kt * KT, n0 = ntb * 64;
    const int n = tid & 63, kk0 = tid >> 6; const int col = wjob_col(J, n0 + n);
#pragma unroll
    for (int p = 0; p < KT / 8; ++p) { const int k = kk0 + 8 * p; v[p] = col >= 0 ? J.src[(size_t)(k0 + k) * J.ldsrc + col] : 0.f; }
}
template <int KT>
__device__ __forceinline__ void wtile_put(LAS float* tile  , const int tid, const float (&v)[KT / 8]) {
    const int n = tid & 63, kk0 = tid >> 6;
#pragma unroll
    for (int p = 0; p < KT / 8; ++p) tile[(kk0 + 8 * p) * 65 + n] = v[p];
}
template <int KT>
__device__ __forceinline__ void wtile_out(const WJob& J, const int lt, const int tid, const LAS float* tile) {
    const int nkt = J.K / KT, kt = lt % nkt, ntb = lt / nkt, k0 = kt * KT, n0 = ntb * 64;
#pragma unroll
    for (int q = 0; q < KT / 64; ++q) { const int n = tid >> 3, kg = (tid & 7) + 8 * q; float v[8];
#pragma unroll
      for (int e = 0; e < 8; ++e) v[e] = tile[(kg * 8 + e) * 65 + n];
      u32x4 w; w.x = cvt_pk_bf16(v[0], v[1]); w.y = cvt_pk_bf16(v[2], v[3]); w.z = cvt_pk_bf16(v[4], v[5]); w.w = cvt_pk_bf16(v[6], v[7]);
      *(u32x4*)(J.dst + (size_t)(n0 + n) * J.K + k0 + kg * 8) = w; }
}
__device__ __forceinline__ void ph_wconv(const Params& P, int l, LAS unsigned char* lds) {
    LAS float* tile = (LAS float*)lds; unsigned char* wb = P.ws + OFF_WB;
    const int tid = opaque_tid();
    constexpr int NBIG = 1232;
    auto big_job = [&](const int ti, WJob& J, int& lt) {
        if (ti < 544) { J = WJob{P.w_in + (size_t)l * 1024 * IN_COLS, IN_COLS, 1024, 8704, (bf16_t*)(wb + WB_WIN), 1}; lt = ti; }
        else if (ti < 640) { const int i = (ti - 544) >> 5; J = WJob{P.w_branch + ((size_t)l * 3 + i) * 512 * 1024, 1024, 512, 1024, (bf16_t*)(wb + WB_WBR) + (size_t)i * 1024 * 512, 0}; lt = (ti - 544) & 31; }
        else if (ti < 704) { J = WJob{P.w_o + (size_t)l * 1024 * 1024, 1024, 1024, 1024, (bf16_t*)(wb + WB_WO), 0}; lt = ti - 640; }
        else if (ti < 1056) { J = WJob{P.ffn_w_up + (size_t)l * 1024 * 5632, 5632, 1024, 5632, (bf16_t*)(wb + WB_WUP), 2}; lt = ti - 704; }
        else { J = WJob{P.ffn_w_down + (size_t)l * 2816 * 1024, 1024, 2816, 1024, (bf16_t*)(wb + WB_WDN), 0}; lt = ti - 1056; } };
    {
        int ti = blockIdx.x; WJob J; int lt; float v[32];
        big_job(ti, J, lt); wtile_load<256>(J, lt, tid, v);
        for (;;) {
            wtile_put<256>(tile, tid, v);
            __syncthreads();
            const int tn = ti + gridDim.x; const bool more = tn < NBIG; WJob Jn = J; int ltn = lt;
            if (more) { big_job(tn, Jn, ltn); wtile_load<256>(Jn, ltn, tid, v); }
            wtile_out<256>(J, lt, tid, tile);
            __syncthreads();
            if (!more) break;
            J = Jn; lt = ltn; ti = tn;
        }
    }
    for (int ts = gridDim.x - 1 - blockIdx.x; ts < 32; ts += gridDim.x) {
        WJob J; int lt;
        if (ts < 8) { J = WJob{P.w_up + (size_t)l * 64 * 512, 512, 64, 512, (bf16_t*)(wb + WB_LW), 0}; lt = ts; }
        else if (ts < 16) { J = WJob{P.a_up + (size_t)l * 64 * 512, 512, 64, 512, (bf16_t*)(wb + WB_LA), 0}; lt = ts - 8; }
        else { J = WJob{P.g_up + (size_t)l * 128 * 512, 512, 128, 512, (bf16_t*)(wb + WB_LG), 0}; lt = ts - 16; }
        float v[8];
        wtile_load<64>(J, lt, tid, v); wtile_put<64>(tile, tid, v);
        __syncthreads();
        wtile_out<64>(J, lt, tid, tile);
        __syncthreads();
    }
}

__device__ __forceinline__ void ph_norm(const Params& P, int l, int which) {
    const bool first = (l == 0 && which == 0);
    const float* nw = (which == 0 ? P.norm_mix : P.norm_ffn) + l * 1024;
    const float* mod = (const float*)(P.ws + OFF_MOD) + (size_t)l * 8 * 6144 + which * 3072;
    const bf16_t* XB = (const bf16_t*)P.out;
    bf16_t* H = (bf16_t*)(P.ws + OFF_H);
    const int tid = opaque_tid(), wid = tid >> 6, lane = tid & 63;
    for (int row = blockIdx.x * 8 + wid; row < T_; row += gridDim.x * 8) {
        const int b = row >> 12; const float* mb = mod + (size_t)b * 6144;
        f32x4 v[4]; float ss = 0.f;
#pragma unroll
        for (int i = 0; i < 4; ++i) {
            if (first) v[i] = *(const f32x4*)(P.x_in + (size_t)row * 1024 + i * 256 + lane * 4);
            else { const u32x2 w = *(const u32x2*)(XB + (size_t)row * 1024 + i * 256 + lane * 4); v[i] = (f32x4){bflo(w.x), bfhi(w.x), bflo(w.y), bfhi(w.y)}; }
            ss += v[i][0] * v[i][0] + v[i][1] * v[i][1] + v[i][2] * v[i][2] + v[i][3] * v[i][3]; }
        ss = wave_sum(ss, lane);
        const float rstd = rsqrtf(ss * (1.0f / 1024.0f) + 1e-6f);
#pragma unroll
        for (int i = 0; i < 4; ++i) { const int c = i * 256 + lane * 4;
            const f32x4 g = *(const f32x4*)(nw + c), sh = *(const f32x4*)(mb + c), sc = *(const f32x4*)(mb + 1024 + c);
            const f32x4 y = v[i] * rstd * g * (sc + 1.0f) + sh;
            u32x2 w; w.x = cvt_pk_bf16(y[0], y[1]); w.y = cvt_pk_bf16(y[2], y[3]);
            *(u32x2*)(H + (size_t)row * 1024 + c) = w; }
    }
}

__device__ __forceinline__ void ph_final(const Params& P) {
    const bf16_t* XF = (const bf16_t*)(P.ws + OFF_H);
    const int tid = opaque_tid(), wid = tid >> 6, lane = tid & 63;
    for (int row = blockIdx.x * 8 + wid; row < T_; row += gridDim.x * 8) {
        float* xr = P.out + (size_t)row * 1024;
        f32x4 v[4]; float ss = 0.f;
#pragma unroll
        for (int i = 0; i < 4; ++i) { const u32x2 w = *(const u32x2*)(XF + (size_t)row * 1024 + i * 256 + lane * 4); v[i] = (f32x4){bflo(w.x), bfhi(w.x), bflo(w.y), bfhi(w.y)};
            ss += v[i][0] * v[i][0] + v[i][1] * v[i][1] + v[i][2] * v[i][2] + v[i][3] * v[i][3]; }
        ss = wave_sum(ss, lane);
        const float rstd = rsqrtf(ss * (1.0f / 1024.0f) + 1e-6f);
#pragma unroll
        for (int i = 0; i < 4; ++i) { const int c = i * 256 + lane * 4; const f32x4 g = *(const f32x4*)(P.final_norm + c);
            *(f32x4*)(xr + c) = v[i] * rstd * g; }
    }
}

__device__ __forceinline__ void ph_gemm_zq(const Params& P, LAS unsigned char* lds) {
    g8::SOrder S; S.init(T_, 2304, 1024, 1024, P.ws + OFF_H, P.ws + OFF_WB + WB_WIN);
    g8::EpiBf E{(bf16_t*)(P.ws + OFF_ZQ), 2304, 9, nullptr, 0, 0};
    g8::gemm_phase(lds, 1024, 1024, 1024, S, E);
}
__device__ __forceinline__ void ph_gemm_zr(const Params& P, LAS unsigned char* lds) {
    g8::SOrder S; S.init(T_, 1792, 1024, 1024, P.ws + OFF_H, P.ws + OFF_WB + WB_WIN + (size_t)2304 * 1024 * 2);
    g8::EpiBf E{(bf16_t*)(P.ws + OFF_ZR), 1792, 7, nullptr, 0, 0};
    g8::gemm_phase(lds, 1024, 1024, 1024, S, E);
}
__device__ __forceinline__ void ph_gemm_zc(const Params& P, LAS unsigned char* lds) {
    g8::SOrder S; S.init(T_, 4608, 1024, 1024, P.ws + OFF_H, P.ws + OFF_WB + WB_WIN + (size_t)4096 * 1024 * 2);
    g8::EpiBf E{(bf16_t*)(P.ws + OFF_ZCV), 1536, 6, (bf16_t*)(P.ws + OFF_ZG), 3072, 1};
    g8::gemm_phase(lds, 1024, 1024, 1024, S, E);
}
__device__ __forceinline__ void ph_gemm_merge(const Params& P, LAS unsigned char* lds) {
    g8::MergeOrder S{(int)gridDim.x, (int)blockIdx.x, (const char*)(P.ws + OFF_OATT), (const char*)(P.ws + OFF_WB + WB_WBR)};
    g8::EpiMerge E{(bf16_t*)(P.ws + OFF_MRG), (const bf16_t*)(P.ws + OFF_ZG)};
    g8::gemm_phase(lds, 512, 512, 512, S, E);
}
__device__ __forceinline__ void ph_gemm_wo(const Params& P, int l, LAS unsigned char* lds) {
    g8::SOrder S; S.init(T_, 1024, 1024, 1024, P.ws + OFF_MRG, P.ws + OFF_WB + WB_WO);
    g8::EpiRes E{l == 0 ? P.x_in : nullptr, (const bf16_t*)P.out, (bf16_t*)P.out, (const float*)(P.ws + OFF_MOD) + (size_t)l * 8 * 6144 + 2048};
    g8::gemm_phase(lds, 1024, 1024, 1024, S, E);
}
__device__ __forceinline__ void ph_gemm_up(const Params& P, int l, LAS unsigned char* lds) {
    g8::SOrder S; S.init(T_, 5632, 1024, 1024, P.ws + OFF_H, P.ws + OFF_WB + WB_WUP);
    g8::EpiUp E{(bf16_t*)(P.ws + OFF_UP), (float*)(P.ws + OFF_HA), (float*)(P.ws + OFF_HB), P.ffn_conv_w + (size_t)l * DFF * 3};
    g8::gemm_phase(lds, 1024, 1024, 1024, S, E);
}
__device__ __forceinline__ void ph_gemm_down(const Params& P, int l, LAS unsigned char* lds) {
    g8::SOrder S; S.init(T_, 1024, 2816, 2816, P.ws + OFF_UP, P.ws + OFF_WB + WB_WDN);
    g8::EpiRes E{nullptr, (const bf16_t*)P.out, l == 1 ? (bf16_t*)(P.ws + OFF_H) : (bf16_t*)P.out, (const float*)(P.ws + OFF_MOD) + (size_t)l * 8 * 6144 + 5120};
    g8::gemm_phase(lds, 2816, 2816, 2816, S, E);
}

__device__ __forceinline__ void ph_conv(const Params& P, int l, LAS unsigned char* lds) {
    const bf16_t* Z = (const bf16_t*)(P.ws + OFF_ZCV); bf16_t* O = (bf16_t*)(P.ws + OFF_OCONV);
    LAS float* cwT = (LAS float*)lds;
    const int tid = opaque_tid();
    for (int i = tid; i < 1536; i += NTHR) cwT[(i % 3) * 512 + i / 3] = P.sc_conv_w[(size_t)l * 1536 + i];
    __syncthreads();
    constexpr int RB = 16; const int nitem = (T_ / RB) * 64;
    for (int it = blockIdx.x * NTHR + tid; it < nitem; it += gridDim.x * NTHR) {
        const int rb = it >> 6, c0 = (it & 63) * 8, row0 = rb * RB, t0 = row0 & 4095;
        float w0[8], w1[8], w2[8];
#pragma unroll
        for (int e = 0; e < 8; ++e) { w0[e] = cwT[c0 + e]; w1[e] = cwT[512 + c0 + e]; w2[e] = cwT[1024 + c0 + e]; }
        float pm2[8], pm1[8];
#pragma unroll
        for (int e = 0; e < 8; ++e) { pm2[e] = 0.f; pm1[e] = 0.f; }
        if (t0 >= 2) {
#pragma unroll
            for (int j = 0; j < 2; ++j) { const bf16_t* zr = Z + (size_t)(row0 - 2 + j) * 1536;
                const u32x4 cc = *(const u32x4*)(zr + 512 + c0), cx = *(const u32x4*)(zr + 1024 + c0);
                const unsigned ccw[4] = {cc.x, cc.y, cc.z, cc.w}, cxw[4] = {cx.x, cx.y, cx.z, cx.w};
#pragma unroll
                for (int q = 0; q < 4; ++q) { const float a = bflo(ccw[q]) * bflo(cxw[q]), b2 = bfhi(ccw[q]) * bfhi(cxw[q]);
                    if (j == 0) { pm2[2 * q] = a; pm2[2 * q + 1] = b2; } else { pm1[2 * q] = a; pm1[2 * q + 1] = b2; } } }
        }
#pragma unroll 4
        for (int r = 0; r < RB; ++r) {
            const bf16_t* zr = Z + (size_t)(row0 + r) * 1536;
            const u32x4 cb = *(const u32x4*)(zr + c0), cc = *(const u32x4*)(zr + 512 + c0), cx = *(const u32x4*)(zr + 1024 + c0);
            const unsigned cbw[4] = {cb.x, cb.y, cb.z, cb.w}, ccw[4] = {cc.x, cc.y, cc.z, cc.w}, cxw[4] = {cx.x, cx.y, cx.z, cx.w};
            float cur[8], o[8];
#pragma unroll
            for (int q = 0; q < 4; ++q) { cur[2 * q] = bflo(ccw[q]) * bflo(cxw[q]); cur[2 * q + 1] = bfhi(ccw[q]) * bfhi(cxw[q]); }
#pragma unroll
            for (int e = 0; e < 8; ++e) { o[e] = w0[e] * pm2[e] + w1[e] * pm1[e] + w2[e] * cur[e]; pm2[e] = pm1[e]; pm1[e] = cur[e]; }
            u32x4 w; w.x = cvt_pk_bf16(o[0] * bflo(cbw[0]), o[1] * bfhi(cbw[0])); w.y = cvt_pk_bf16(o[2] * bflo(cbw[1]), o[3] * bfhi(cbw[1]));
            w.z = cvt_pk_bf16(o[4] * bflo(cbw[2]), o[5] * bfhi(cbw[2])); w.w = cvt_pk_bf16(o[6] * bflo(cbw[3]), o[7] * bfhi(cbw[3]));
            *(u32x4*)(O + (size_t)(row0 + r) * 512 + c0) = w;
        }
    }
}

__device__ __forceinline__ void ph_ufix(const Params& P, int l, LAS unsigned char* lds) {
    bf16_t* U = (bf16_t*)(P.ws + OFF_UP); const float* HA = (const float*)(P.ws + OFF_HA); const float* HB = (const float*)(P.ws + OFF_HB);
    LAS float* cwT = (LAS float*)lds;
    const int tid = opaque_tid();
    for (int i = tid; i < DFF * 3; i += NTHR) cwT[(i % 3) * DFF + i / 3] = P.ffn_conv_w[(size_t)l * DFF * 3 + i];
    __syncthreads();
    const int nitem = (T_ / 64) * 2 * 352;
    for (int it = blockIdx.x * NTHR + tid; it < nitem; it += gridDim.x * NTHR) {
        const int c0 = (it % 352) * 8, gr = it / 352, grp = gr >> 1, rr = gr & 1; const bool first = (grp & 63) == 0;
        const float* hb = HB + ((size_t)(grp * 2 + rr) * 2) * DFF + c0;
        float a0[8], a1[8], a2[8], g[8];
#pragma unroll
        for (int q = 0; q < 2; ++q) { const f32x4 va = *(const f32x4*)(hb + 4 * q), vg = *(const f32x4*)(hb + DFF + 4 * q);
#pragma unroll
            for (int e = 0; e < 4; ++e) { a0[4 * q + e] = va[e]; g[4 * q + e] = vg[e]; a1[4 * q + e] = 0.f; a2[4 * q + e] = 0.f; } }
        if (rr == 1) { const float* p1 = HB + ((size_t)(grp * 2) * 2) * DFF + c0;
#pragma unroll
            for (int q = 0; q < 2; ++q) { const f32x4 v = *(const f32x4*)(p1 + 4 * q);
#pragma unroll
                for (int e = 0; e < 4; ++e) a1[4 * q + e] = v[e]; } }
        if (!first) {
            const float* pl = HA + (size_t)((grp - 1) * 2 + 1) * DFF + c0;
            const float* pk = HA + (size_t)((grp - 1) * 2) * DFF + c0;
#pragma unroll
            for (int q = 0; q < 2; ++q) { const f32x4 v63 = *(const f32x4*)(pl + 4 * q), v62 = *(const f32x4*)(pk + 4 * q);
#pragma unroll
                for (int e = 0; e < 4; ++e) { if (rr == 1) a2[4 * q + e] = v63[e]; else { a1[4 * q + e] = v63[e]; a2[4 * q + e] = v62[e]; } } }
        }
        float o[8];
#pragma unroll
        for (int e = 0; e < 8; ++e) { const float s = cwT[c0 + e] * a2[e] + cwT[DFF + c0 + e] * a1[e] + cwT[2 * DFF + c0 + e] * a0[e]; o[e] = s * sigmoidf_(s) * g[e]; }
        u32x4 w; w.x = cvt_pk_bf16(o[0], o[1]); w.y = cvt_pk_bf16(o[2], o[3]); w.z = cvt_pk_bf16(o[4], o[5]); w.w = cvt_pk_bf16(o[6], o[7]);
        *(u32x4*)(U + (size_t)(grp * 64 + rr) * DFF + c0) = w;
    }
}

template <int NR>
__device__ __forceinline__ u64 select_row(LAS float* row, const int t, const int lz) {
    const int imax = t >> 6;
    float x[NR]; float Tx = 0.f; bool have = false, exact = false;
    {
        int bin[NR]; float lo = __builtin_inff(), hi = -__builtin_inff();
        LAS unsigned* hist = (LAS unsigned*)row;
#pragma unroll
        for (int i = 0; i < NR; ++i) { const float v = row[64 * i + lz]; x[i] = (i <= imax) ? v : -__builtin_inff(); hi = fmaxf(hi, x[i]); lo = fminf(lo, (i < imax || x[i] > -__builtin_inff()) ? x[i] : __builtin_inff()); }
#pragma unroll
        for (int o = 32; o >= 1; o >>= 1) { lo = fminf(lo, shx(lo, o, lz)); hi = fmaxf(hi, shx(hi, o, lz)); }
        if (hi > lo) {
            const float scale = 4095.0f / (hi - lo);
#pragma unroll
            for (int q = 0; q < 16; ++q) *(LAS u32x4*)(hist + 256 * q + 4 * lz) = (u32x4){0u, 0u, 0u, 0u};
#pragma unroll
            for (int i = 0; i < NR; ++i) {
                const int bq = (int)fminf(fmaxf((x[i] - lo) * scale, -1.0f), 4095.0f); bin[i] = bq;
                if (bq >= 0) __hip_atomic_fetch_add(hist + bq, 1u, __ATOMIC_RELAXED, __HIP_MEMORY_SCOPE_WORKGROUP); }
            unsigned c1 = 0u;
#pragma unroll
            for (int q = 0; q < 16; ++q) { const u32x4 h4 = *(const LAS u32x4*)(hist + 64 * lz + 4 * ((q + lz) & 15)); c1 += (h4.x + h4.y) + (h4.z + h4.w); }
            unsigned inc = c1;
#pragma unroll
            for (int o = 1; o <= 32; o <<= 1) { const unsigned v = (unsigned)__builtin_amdgcn_ds_bpermute(((lz + o) & 63) << 2, (int)inc); inc += (lz + o < 64) ? v : 0u; }
            const unsigned ab1 = inc - c1;
            const u64 cr1 = __ballot(ab1 < 256u && ab1 + c1 >= 256u);
            const int L1 = __builtin_ctzll(cr1);
            const unsigned abL = (unsigned)__builtin_amdgcn_readlane((int)ab1, L1);
            const unsigned c2 = hist[64 * L1 + lz];
            unsigned inc2 = c2;
#pragma unroll
            for (int o = 1; o <= 32; o <<= 1) { const unsigned v = (unsigned)__builtin_amdgcn_ds_bpermute(((lz + o) & 63) << 2, (int)inc2); inc2 += (lz + o < 64) ? v : 0u; }
            const unsigned ab2 = inc2 - c2 + abL;
            const u64 cr2 = __ballot(ab2 < 256u && ab2 + c2 >= 256u);
            const int L2 = __builtin_ctzll(cr2);
            const int bstar = 64 * L1 + L2;
            const int cb = __builtin_amdgcn_readlane((int)c2, L2), need2 = 256 - __builtin_amdgcn_readlane((int)ab2, L2);
            if (cb <= 64) {
                int cand = 0; int pos = 0;
#pragma unroll
                for (int i = 0; i < NR; ++i) { u64 mm = __ballot(bin[i] == bstar);
                    while (mm) { const int s = __builtin_ctzll(mm); mm &= mm - 1ull; cand = writelane_v(cand, __builtin_amdgcn_readlane(__float_as_int(x[i]), s), pos); ++pos; } }
                const unsigned cu = (lz < cb) ? f2ord(__int_as_float(cand)) : 0u;
                unsigned Tc = 0u;
#pragma unroll 1
                for (int bit = 31; bit >= 0; --bit) { const unsigned cd = Tc | (1u << bit); if ((int)__popcll(__ballot(cu >= cd)) >= need2) Tc = cd; }
                Tx = ord2f(Tc); have = true; exact = (256 - need2) + (int)__popcll(__ballot(cu >= Tc)) == 256;
            }
        }
    }
    if (!have) {
        unsigned Tt = 0u;
#pragma unroll 1
        for (int bit = 31; bit >= 0; --bit) {
            const unsigned cand = Tt | (1u << bit); int cnt = 0;
#pragma unroll
            for (int i = 0; i < NR; ++i) cnt += __popcll(__ballot(f2ord(x[i]) >= cand));
            if (cnt >= 256) Tt = cand;
        }
        Tx = ord2f(Tt);
    }
    int wlo = 0, whi = 0;
#pragma unroll
    for (int i = 0; i < NR; ++i) { const u64 g = __ballot(x[i] >= Tx); writelane_c2(wlo, whi, (int)(unsigned)g, (int)(unsigned)(g >> 32), i); }
    u64 myw = ((u64)(unsigned)whi << 32) | (unsigned)wlo;
    if (!exact) {
        int cgt = 0;
#pragma unroll
        for (int i = 0; i < NR; ++i) cgt += __popcll(__ballot(x[i] > Tx));
        int need = 256 - cgt; myw = 0ull;
#pragma unroll
        for (int i = 0; i < NR; ++i) {
            const u64 g = __ballot(x[i] > Tx); u64 e = __ballot(x[i] == Tx);
            int ne = __popcll(e);
            while (ne > need) { e &= ~(1ull << (63 - __clzll(e))); --ne; }
            need -= ne;
            if (lz == i) myw = g | e;
        }
    }
    return myw;
}

__device__ __forceinline__ void ph_ki(const Params& P, LAS unsigned char* lds) {
    const bf16_t* ZQ = (const bf16_t*)(P.ws + OFF_ZQ);
    const int tid = opaque_tid();
    { int* KPM = (int*)(P.ws + OFF_KPM);
      for (int i = blockIdx.x * NTHR + tid; i < NB_ * 64; i += gridDim.x * NTHR) { const int* pp = P.pos + (i >> 6) * S_ + (i & 63) * 64; int mxp = pp[0];
          for (int k = 1; k < 64; ++k) mxp = pp[k] > mxp ? pp[k] : mxp;
          KPM[i] = mxp; } }
    {
        bf16_t* KI = (bf16_t*)(P.ws + OFF_KI);
        for (int i = blockIdx.x * NTHR + tid; i < T_ * 8; i += gridDim.x * NTHR) {
            const int key = i >> 3, c = i & 7;
            const u32x4 v = *(const u32x4*)(ZQ + (size_t)key * 2304 + 2048 + 8 * c);
            *(u32x4*)(KI + ((size_t)((key >> 5) * 4 + (c >> 1)) * 64 + (key & 31) + 32 * (c & 1)) * 8) = v;
        }
    }
    {
        LAS bf16_t* tl = (LAS bf16_t*)lds;
        bf16_t* VT = (bf16_t*)(P.ws + OFF_VT);
        for (int it = blockIdx.x; it < NB_ * 8 * 64; it += gridDim.x) {
            const int b = it >> 9, h = (it >> 6) & 7, k0 = (it & 63) * 64;
            { const int row = tid >> 3, ch = tid & 7;
              const u32x4 v = *(const u32x4*)(ZQ + (size_t)(b * S_ + k0 + row) * 2304 + 1024 + h * 64 + ch * 8);
              *(LAS u32x4*)(tl + row * 72 + ch * 8) = v; }
            __syncthreads();
            { const int d = tid >> 3, kc = tid & 7; unsigned short e[8];
#pragma unroll
              for (int q = 0; q < 8; ++q) e[q] = tl[(kc * 8 + q) * 72 + d];
              u32x4 w; w.x = e[0] | ((unsigned)e[1] << 16); w.y = e[2] | ((unsigned)e[3] << 16); w.z = e[4] | ((unsigned)e[5] << 16); w.w = e[6] | ((unsigned)e[7] << 16);
              *(u32x4*)(VT + ((size_t)((b * 8 + h) * 64 + d)) * S_ + k0 + kc * 8) = w; }
            __syncthreads();
        }
    }
}

__device__ __forceinline__ void ph_idx(const Params& P, LAS unsigned char* lds) {
    LAS float* SC = (LAS float*)lds;
    const bf16_t* ZQ = (const bf16_t*)(P.ws + OFF_ZQ); u64* MASK = (u64*)(P.ws + OFF_MASK); const bf16_t* KI = (const bf16_t*)(P.ws + OFF_KI);
    const int tid = opaque_tid(), wid = __builtin_amdgcn_readfirstlane(tid >> 6), lane = tid & 63, m = lane & 31, hh = lane >> 5;
    int itc = 0;
    for (int idx = blockIdx.x; idx < NB_ * 512; idx += gridDim.x, ++itc) {
        const int b = idx & 7, j = idx >> 3; const int qb = (itc & 1) ? (j ^ 31) : j; const int t0 = qb * 8;
        const bf16_t* zb = ZQ + (size_t)b * S_ * 2304;
        bf16x8 Af[2][4]; float wv[2][16];
#pragma unroll
        for (int blk = 0; blk < 2; ++blk) {
            const bf16_t* qp = zb + (size_t)(t0 + 4 * blk + 2 * ((m >> 2) & 1) + (m >> 4)) * 2304 + 1536 + (4 * ((m >> 3) & 1) + (m & 3)) * 64 + 8 * hh;
#pragma unroll
            for (int ks = 0; ks < 4; ++ks) Af[blk][ks] = *(const bf16x8*)(qp + 16 * ks);
#pragma unroll
            for (int q = 0; q < 2; ++q) { const u32x4 ww = *(const u32x4*)(zb + (size_t)(t0 + 4 * blk + 2 * hh + q) * 2304 + 2112);
                wv[blk][8 * q + 0] = bflo(ww.x); wv[blk][8 * q + 1] = bfhi(ww.x); wv[blk][8 * q + 2] = bflo(ww.y); wv[blk][8 * q + 3] = bfhi(ww.y);
                wv[blk][8 * q + 4] = bflo(ww.z); wv[blk][8 * q + 5] = bfhi(ww.z); wv[blk][8 * q + 6] = bflo(ww.w); wv[blk][8 * q + 7] = bfhi(ww.w); }
        }
        const int ntile = 2 * ((t0 + 7) / 64 + 1);
        {
#define IDX_GLD(B, KT) do { const int kc_ = (KT) < ntile ? (KT) : ntile - 1; const bf16_t* kp_ = KI + ((size_t)((b * 128 + kc_) * 4) * 64 + lane) * 8; \
            asm volatile("global_load_dwordx4 %0, %4, off\n\tglobal_load_dwordx4 %1, %4, off offset:1024\n\tglobal_load_dwordx4 %2, %4, off offset:2048\n\tglobal_load_dwordx4 %3, %4, off offset:3072" \
                : "=&v"(B[0]), "=&v"(B[1]), "=&v"(B[2]), "=&v"(B[3]) : "v"(kp_)); } while (0)
#define IDX_GLW(B, N) asm volatile("s_waitcnt vmcnt(" #N ")" : "+v"(B[0]), "+v"(B[1]), "+v"(B[2]), "+v"(B[3]))
            auto score_tile = [&](const bf16x8 (&Bf)[4], const int kt) {
                f32x16 Dw[2];
#pragma unroll
                for (int r = 0; r < 16; ++r) { Dw[0][r] = 0.f; Dw[1][r] = 0.f; }
#pragma unroll
                for (int ks = 0; ks < 4; ++ks) {
                    Dw[0] = __builtin_amdgcn_mfma_f32_32x32x16_bf16(Af[0][ks], Bf[ks], Dw[0], 0, 0, 0);
                    Dw[1] = __builtin_amdgcn_mfma_f32_32x32x16_bf16(Af[1][ks], Bf[ks], Dw[1], 0, 0, 0); }
#pragma unroll
                for (int blk = 0; blk < 2; ++blk) {
                    const f32x16 Dv = Dw[blk];
#pragma unroll
                    for (int q = 0; q < 2; ++q) {
                        float part = 0.f;
#pragma unroll
                        for (int e = 0; e < 8; ++e) { const float d = Dv[8 * q + e], w = wv[blk][8 * q + e]; part = __builtin_fmaf(w, d, part); part = __builtin_fmaf(w, __builtin_fabsf(d), part); }
                        SC[(4 * blk + 2 * hh + q) * 4096 + 32 * kt + m] = (32 * kt + m <= t0 + 4 * blk + 2 * hh + q) ? part : -__builtin_inff();
                    }
                } };
            bf16x8 B0[4], B1[4], B2[4];
            if (wid < ntile) {
                IDX_GLD(B0, wid); IDX_GLD(B1, wid + 8);
                asm volatile("" :: "v"(Af[0][0]), "v"(Af[0][1]), "v"(Af[0][2]), "v"(Af[0][3]), "v"(Af[1][0]), "v"(Af[1][1]), "v"(Af[1][2]), "v"(Af[1][3]));
#pragma unroll 1
                for (int kt = wid; kt < ntile; kt += 24) {
                    IDX_GLD(B2, kt + 16);
                    IDX_GLW(B0, 8);
                    score_tile(B0, kt);
                    IDX_GLD(B0, kt + 24);
                    IDX_GLW(B1, 8);
                    if (kt + 8 < ntile) score_tile(B1, kt + 8);
                    IDX_GLD(B1, kt + 32);
                    IDX_GLW(B2, 8);
                    if (kt + 16 < ntile) score_tile(B2, kt + 16);
                }
                asm volatile("s_waitcnt vmcnt(0)" : "+v"(B0[0]), "+v"(B0[1]), "+v"(B0[2]), "+v"(B0[3]), "+v"(B1[0]), "+v"(B1[1]), "+v"(B1[2]), "+v"(B1[3]), "+v"(B2[0]), "+v"(B2[1]), "+v"(B2[2]), "+v"(B2[3]));
            }
#undef IDX_GLD
#undef IDX_GLW
        }
        __syncthreads();
        {
            const int t = t0 + wid; u64* mrow = MASK + (size_t)(b * S_ + t) * 64;
            if (t < 256) {
                const int lo = 64 * lane; u64 w;
                if (t >= lo + 63) w = ~0ull; else if (t < lo) w = 0ull; else w = (2ull << (t - lo)) - 1ull;
                mrow[lane] = w;
            } else {
                int lz = threadIdx.x; asm volatile("" : "+v"(lz)); lz &= 63;
                LAS float* rowp = SC + wid * 4096; u64 myw;
                if (t < 512) myw = select_row<8>(rowp, t, lz); else if (t < 1024) myw = select_row<16>(rowp, t, lz); else if (t < 2048) myw = select_row<32>(rowp, t, lz); else myw = select_row<64>(rowp, t, lz);
                mrow[lz] = myw;
            }
        }
        __syncthreads();
    }
}

__device__ __forceinline__ int bitmask(int w, int pos  ) { int m; asm("v_bfe_i32 %0, %1, %2, 1" : "=v"(m) : "v"(w), "n"(pos)); return m; }
__device__ __forceinline__ void ph_att(const Params& P, LAS unsigned char* lds) {
    LAS float* TABL = (LAS float*)lds;
    LAS unsigned char* KB = lds + 4096;
    constexpr int KT_B = 64 * 144, VT_B = 64 * 136, BUF_B = KT_B + VT_B;
    constexpr float LOG2E = 1.4426950408889634f;
    const float* tabg = (const float*)(P.ws + OFF_TAB);
    const int tid = opaque_tid(), wid = __builtin_amdgcn_readfirstlane(tid >> 6), lane = tid & 63, m = lane & 31, hh = lane >> 5;
    for (int i = tid; i < 1024; i += NTHR) TABL[i] = tabg[i] * LOG2E;
    LAS int* POSL = (LAS int*)(KB + 4 * BUF_B);
    int pos_b = -1;
    const bf16_t* ZQ = (const bf16_t*)(P.ws + OFF_ZQ); const u64* MASK = (const u64*)(P.ws + OFF_MASK);
    const bf16_t* VT = (const bf16_t*)(P.ws + OFF_VT); bf16_t* OA = (bf16_t*)(P.ws + OFF_OATT); const int* KPM = (const int*)(P.ws + OFF_KPM);
    int itc = 0;
    for (int idx = blockIdx.x; idx < NB_ * 8 * 16; idx += gridDim.x, ++itc) {
        const int b = idx & 7, head = (idx >> 3) & 7, j = idx >> 6; const int qb = (itc & 1) ? (j ^ 3) : j;
        const int q0 = qb * 256, tq0 = q0 + 32 * wid, t = tq0 + m;
        const bf16_t* zb = ZQ + (size_t)b * S_ * 2304;
        if (b != pos_b) {
            __syncthreads();
            for (int i = tid; i < S_ / 4; i += NTHR) ((LAS i32x4*)POSL)[i] = ((const i32x4*)(P.pos + b * S_))[i];
            pos_b = b;
            __syncthreads();
        }
        bf16x8 Qf[4];
        { const bf16_t* qp = zb + (size_t)t * 2304 + head * 64 + 8 * hh;
#pragma unroll
          for (int ks = 0; ks < 4; ++ks) Qf[ks] = *(const bf16x8*)(qp + 16 * ks); }
        const int posq = POSL[t];
        int minq = posq;
#pragma unroll
        for (int o = 32; o >= 1; o >>= 1) { const int v = shxi(minq, o, lane); minq = v < minq ? v : minq; }
        minq = __builtin_amdgcn_readfirstlane(minq);
        const u64* mrow = MASK + (size_t)(b * S_ + t) * 64;
        const bf16_t* vtb = VT + (size_t)(b * 8 + head) * 64 * S_;
        const float c1 = 0.125f * LOG2E, c2 = TABL[127 * 8 + head];
        f32x16 O0, O1, OL;
#pragma unroll
        for (int r = 0; r < 16; ++r) { O0[r] = 0.f; O1[r] = 0.f; OL[r] = 0.f; }
        const bf16x8 ones8 = {0x3F80, 0x3F80, 0x3F80, 0x3F80, 0x3F80, 0x3F80, 0x3F80, 0x3F80};
        float m_run = -1e30f;
        const int nt = 4 * qb + 4, my_nt = ((tq0 + 31) >> 6) + 1;
        const int skey = tid >> 3, sch = tid & 7;
        const bf16_t* kg = zb + (size_t)skey * 2304 + 512 + head * 64 + 8 * sch;
        const bf16_t* vg = vtb + (size_t)skey * S_ + 8 * sch;
        LAS unsigned char* kdst = KB + skey * 144 + sch * 16; LAS unsigned char* vdst = KB + KT_B + skey * 136 + sch * 16;
        const int kpm_l = KPM[b * 64 + lane];
        auto tile = [&](const int kt, const int boff, const u64 mw) {
                const LAS unsigned char* Kt = KB + boff; const LAS unsigned char* Vt = Kt + KT_B;
                f32x16 D0, D1;
#pragma unroll
                for (int r = 0; r < 16; ++r) { D0[r] = 0.f; D1[r] = 0.f; }
#pragma unroll
                for (int ks = 0; ks < 4; ++ks) {
                    const bf16x8 K0 = *(const LAS bf16x8*)(Kt + m * 144 + 32 * ks + 16 * hh), K1 = *(const LAS bf16x8*)(Kt + (32 + m) * 144 + 32 * ks + 16 * hh);
                    D0 = __builtin_amdgcn_mfma_f32_32x32x16_bf16(K0, Qf[ks], D0, 0, 0, 0); D1 = __builtin_amdgcn_mfma_f32_32x32x16_bf16(K1, Qf[ks], D1, 0, 0, 0); }
                const int w0 = (int)((unsigned)mw >> (4 * hh)), w1 = (int)((unsigned)(mw >> 32) >> (4 * hh));
                float esc = c1, eoff0 = c2;
                if (minq - __builtin_amdgcn_readlane(kpm_l, kt) < 127) {
#pragma unroll
                    for (int mb = 0; mb < 2; ++mb)
#pragma unroll
                        for (int g = 0; g < 4; ++g) {
                            const i32x4 pk = *(const LAS i32x4*)(POSL + 64 * kt + 32 * mb + 8 * g + 4 * hh);
#pragma unroll
                            for (int e = 0; e < 4; ++e) { const int r = 4 * g + e; int n = posq - pk[e]; n = n < 0 ? 0 : (n > 127 ? 127 : n);
                                if (mb) D1[r] = D1[r] * c1 + TABL[n * 8 + head]; else D0[r] = D0[r] * c1 + TABL[n * 8 + head]; }
                        }
                    esc = 1.0f; eoff0 = 0.f;
                }
                float mx = __builtin_fmaxf(__builtin_fmaxf(D0[0], D0[1]), D0[2]);
#pragma unroll
                for (int r = 3; r < 15; r += 2) mx = __builtin_fmaxf(__builtin_fmaxf(mx, D0[r]), D0[r + 1]);
#pragma unroll
                for (int r = 0; r < 16; r += 2) mx = __builtin_fmaxf(__builtin_fmaxf(mx, D1[r]), D1[r + 1]);
                mx = fmaxf(mx, D0[15]);
                mx = fmaxf(mx, shx(mx, 32, lane));
                const float m_new = fmaxf(m_run, mx * esc + eoff0); const float alpha = __builtin_amdgcn_exp2f(m_run - m_new); m_run = m_new;
                const float eoff = eoff0 - m_new;
                float pv[32];
#pragma unroll
                for (int r = 0; r < 16; ++r) {
                    const int bp = (r & 3) + 8 * (r >> 2);
                    pv[r] = __int_as_float(__float_as_int(__builtin_amdgcn_exp2f(D0[r] * esc + eoff)) & bitmask(w0, bp));
                    pv[16 + r] = __int_as_float(__float_as_int(__builtin_amdgcn_exp2f(D1[r] * esc + eoff)) & bitmask(w1, bp)); }
                if (!__all(alpha == 1.0f)) {
#pragma unroll
                    for (int r = 0; r < 16; ++r) { O0[r] *= alpha; O1[r] *= alpha; OL[r] *= alpha; } }
#pragma unroll
                for (int s = 0; s < 4; ++s) {
                    u32x4 pw; pw.x = cvt_pk_bf16(pv[8 * s + 0], pv[8 * s + 1]); pw.y = cvt_pk_bf16(pv[8 * s + 2], pv[8 * s + 3]); pw.z = cvt_pk_bf16(pv[8 * s + 4], pv[8 * s + 5]); pw.w = cvt_pk_bf16(pv[8 * s + 6], pv[8 * s + 7]);
                    const bf16x8 Pf = __builtin_bit_cast(bf16x8, pw);
                    const LAS unsigned char* vp = Vt + m * 136 + (16 * s + 4 * hh) * 2;
                    { const u32x2 va = *(const LAS u32x2*)vp, vb = *(const LAS u32x2*)(vp + 16); u32x4 vw; vw.x = va.x; vw.y = va.y; vw.z = vb.x; vw.w = vb.y;
                      O0 = __builtin_amdgcn_mfma_f32_32x32x16_bf16(__builtin_bit_cast(bf16x8, vw), Pf, O0, 0, 0, 0); }
                    { const u32x2 va = *(const LAS u32x2*)(vp + 32 * 136), vb = *(const LAS u32x2*)(vp + 32 * 136 + 16); u32x4 vw; vw.x = va.x; vw.y = va.y; vw.z = vb.x; vw.w = vb.y;
                      O1 = __builtin_amdgcn_mfma_f32_32x32x16_bf16(__builtin_bit_cast(bf16x8, vw), Pf, O1, 0, 0, 0); }
                    OL = __builtin_amdgcn_mfma_f32_32x32x16_bf16(ones8, Pf, OL, 0, 0, 0);
                }
        };
        __syncthreads();
        constexpr int SUB_B = KT_B + VT_B, SUP_B = 2 * SUB_B;
        const int nst = nt >> 1;
        u32x4 ka0, kb0, va0, vb0, ka1, kb1, va1, vb1;
#define ATT_LOAD(KA, KB_, VA, VB, ST) do { KA = *(const u32x4*)(kg + (size_t)(2 * (ST)) * 64 * 2304); KB_ = *(const u32x4*)(kg + (size_t)(2 * (ST) + 1) * 64 * 2304); \
            VA = *(const u32x4*)(vg + (2 * (ST)) * 64); VB = *(const u32x4*)(vg + (2 * (ST) + 1) * 64); } while (0)
#define ATT_STORE(KA, KB_, VA, VB, BUF) do { LAS unsigned char* kd_ = kdst + (BUF) * SUP_B; LAS unsigned char* vd_ = vdst + (BUF) * SUP_B; \
            *(LAS u32x4*)kd_ = KA; *(LAS u32x2*)vd_ = (u32x2){VA.x, VA.y}; *(LAS u32x2*)(vd_ + 8) = (u32x2){VA.z, VA.w}; \
            *(LAS u32x4*)(kd_ + SUB_B) = KB_; *(LAS u32x2*)(vd_ + SUB_B) = (u32x2){VB.x, VB.y}; *(LAS u32x2*)(vd_ + SUB_B + 8) = (u32x2){VB.z, VB.w}; } while (0)
        u64x2 mwA = *(const u64x2*)mrow, mwB = mwA;
        ATT_LOAD(ka0, kb0, va0, vb0, 0); ATT_STORE(ka0, kb0, va0, vb0, 0);
        if (nst > 1) ATT_LOAD(ka1, kb1, va1, vb1, 1);
        __syncthreads();
        for (int st = 0; st < nst; st += 2) {
            if (st + 1 < nst) mwB = *(const u64x2*)(mrow + 2 * (st + 1));
            if (st + 2 < nst) ATT_LOAD(ka0, kb0, va0, vb0, st + 2);
            if (2 * st < my_nt) tile(2 * st, 0, mwA.x);
            if (2 * st + 1 < my_nt) tile(2 * st + 1, SUB_B, mwA.y);
            if (st + 1 < nst) ATT_STORE(ka1, kb1, va1, vb1, 1);
            __syncthreads();
            if (st + 1 >= nst) break;
            if (st + 2 < nst) mwA = *(const u64x2*)(mrow + 2 * (st + 2));
            if (st + 3 < nst) ATT_LOAD(ka1, kb1, va1, vb1, st + 3);
            if (2 * st + 2 < my_nt) tile(2 * st + 2, SUP_B, mwB.x);
            if (2 * st + 3 < my_nt) tile(2 * st + 3, SUP_B + SUB_B, mwB.y);
            if (st + 2 < nst) ATT_STORE(ka0, kb0, va0, vb0, 0);
            __syncthreads();
        }
#undef ATT_LOAD
#undef ATT_STORE
        const float inv = __builtin_amdgcn_rcpf(OL[0]);
        bf16_t* op = OA + (size_t)(b * S_ + t) * 512 + head * 64 + 4 * hh;
#pragma unroll
        for (int g = 0; g < 4; ++g) {
            u32x2 wa; wa.x = cvt_pk_bf16(O0[4 * g] * inv, O0[4 * g + 1] * inv); wa.y = cvt_pk_bf16(O0[4 * g + 2] * inv, O0[4 * g + 3] * inv);
            *(u32x2*)(op + 8 * g) = wa;
            u32x2 wb; wb.x = cvt_pk_bf16(O1[4 * g] * inv, O1[4 * g + 1] * inv); wb.y = cvt_pk_bf16(O1[4 * g + 2] * inv, O1[4 * g + 3] * inv);
            *(u32x2*)(op + 32 + 8 * g) = wb;
        }
    }
}

#define DSR4(A, addr, o0, o1, o2, o3) asm volatile("ds_read_b128 %0, %4 offset:%5\n\tds_read_b128 %1, %4 offset:%6\n\tds_read_b128 %2, %4 offset:%7\n\tds_read_b128 %3, %4 offset:%8" \
    : "=&v"(A[0]), "=&v"(A[1]), "=&v"(A[2]), "=&v"(A[3]) : "v"(addr), "i"(o0), "i"(o1), "i"(o2), "i"(o3))
#define DSW(A, N) asm volatile("s_waitcnt lgkmcnt(" #N ")" : "+v"(A[0]), "+v"(A[1]), "+v"(A[2]), "+v"(A[3]))
#define DSRV(V, addr, off) asm volatile("ds_read_b32 %0, %1 offset:%2" : "=&v"(V) : "v"(addr), "i"(off))
#define DSWV(A, V, N) asm volatile("s_waitcnt lgkmcnt(" #N ")" : "+v"(A[0]), "+v"(A[1]), "+v"(A[2]), "+v"(A[3]), "+v"(V))
#define SCAN_A(X, G) _Pragma("unroll") for (int i_ = 0; i_ < 4; ++i_) { const f32x2 k01 = {X[i_][0], X[i_][1]}, k23 = {X[i_][2], X[i_][3]}; \
    sa0 += S2[8 * G + 2 * i_] * k01; sa1 += S2[8 * G + 2 * i_ + 1] * k23; sp0 += Pm2[8 * G + 2 * i_] * k01; sp1 += Pm2[8 * G + 2 * i_ + 1] * k23; }
#define SCAN_B(X, C) { const int j = 2 * C; \
    { const f32x2 w = {X[0][0], X[0][1]}, kb = {X[1][0], X[1][1]}, kk = {X[2][0], X[2][1]}, rr = {X[3][0], X[3][1]}; \
      S2[j] = S2[j] * w + sav * kb + vv2 * kk; Pm2[j] = Pm2[j] * w + spv * kb; y0 += S2[j] * rr; p0 += Pm2[j] * rr; } \
    { const f32x2 w = {X[0][2], X[0][3]}, kb = {X[1][2], X[1][3]}, kk = {X[2][2], X[2][3]}, rr = {X[3][2], X[3][3]}; \
      S2[j + 1] = S2[j + 1] * w + sav * kb + vv2 * kk; Pm2[j + 1] = Pm2[j + 1] * w + spv * kb; y1 += S2[j + 1] * rr; p1 += Pm2[j + 1] * rr; } }
__device__ __forceinline__ float wave_sum_dpp(float v) {
    v += __int_as_float(__builtin_amdgcn_update_dpp(0, __float_as_int(v), 0x111, 0xf, 0xf, true));
    v += __int_as_float(__builtin_amdgcn_update_dpp(0, __float_as_int(v), 0x112, 0xf, 0xf, true));
    v += __int_as_float(__builtin_amdgcn_update_dpp(0, __float_as_int(v), 0x114, 0xf, 0xf, true));
    v += __int_as_float(__builtin_amdgcn_update_dpp(0, __float_as_int(v), 0x118, 0xf, 0xf, true));
    v += __int_as_float(__builtin_amdgcn_update_dpp(0, __float_as_int(v), 0x142, 0xa, 0xf, false));
    v += __int_as_float(__builtin_amdgcn_update_dpp(0, __float_as_int(v), 0x143, 0xc, 0xf, false));
    return __int_as_float(__builtin_amdgcn_readlane(__float_as_int(v), 63));
}
__device__ __forceinline__ void wave_sum2_dpp(float a, float b, float& ra, float& rb) {
    const auto sw = __builtin_amdgcn_permlane32_swap(__float_as_uint(a), __float_as_uint(b), false, false);
    float v = __uint_as_float(sw[0]) + __uint_as_float(sw[1]);
    v += __int_as_float(__builtin_amdgcn_update_dpp(0, __float_as_int(v), 0x111, 0xf, 0xf, true));
    v += __int_as_float(__builtin_amdgcn_update_dpp(0, __float_as_int(v), 0x112, 0xf, 0xf, true));
    v += __int_as_float(__builtin_amdgcn_update_dpp(0, __float_as_int(v), 0x114, 0xf, 0xf, true));
    v += __int_as_float(__builtin_amdgcn_update_dpp(0, __float_as_int(v), 0x118, 0xf, 0xf, true));
    v += __int_as_float(__builtin_amdgcn_update_dpp(0, __float_as_int(v), 0x142, 0xa, 0xf, false));
    ra = __int_as_float(__builtin_amdgcn_readlane(__float_as_int(v), 31)); rb = __int_as_float(__builtin_amdgcn_readlane(__float_as_int(v), 63));
}
__device__ __forceinline__ void ph_scan(const Params& P, int l, LAS unsigned char* lds) {
    LAS bf16_t* LI = (LAS bf16_t*)lds;
    LAS float* SIN = (LAS float*)(lds + 32768);
    const bf16_t* ZR = (const bf16_t*)(P.ws + OFF_ZR);
    const float* mu = P.mu + (size_t)l * 1792;
    const bf16_t* LW = (const bf16_t*)(P.ws + OFF_WB + WB_LW); const bf16_t* LA = (const bf16_t*)(P.ws + OFF_WB + WB_LA); const bf16_t* LG = (const bf16_t*)(P.ws + OFF_WB + WB_LG);
    bf16_t* Yo = (bf16_t*)(P.ws + OFF_Y); bf16_t* Po = (bf16_t*)(P.ws + OFF_P); bf16_t* Go = (bf16_t*)(P.ws + OFF_G); bf16_t* VBo = (bf16_t*)(P.ws + OFF_VB);
    float* SEGp = (float*)(P.ws + OFF_SEG);
    const int tid = opaque_tid(), wid = __builtin_amdgcn_readfirstlane(tid >> 6), lane = tid & 63;
    for (int blk = blockIdx.x; blk < NB_ * NSEG; blk += gridDim.x) {
        const int b = blk / NSEG, seg = blk % NSEG, tbeg = seg * SEGL;
        f32x2 S2[32], Pm2[32];
        { int lq = threadIdx.x; asm volatile("" : "+v"(lq)); lq &= 63;
#pragma unroll
          for (int j = 0; j < 32; ++j) { S2[j] = (f32x2){0.f, 0.f}; Pm2[j] = (f32x2){(2 * j == lq) ? 1.f : 0.f, (2 * j + 1 == lq) ? 1.f : 0.f}; } }
        for (int half = 0; half < 2; ++half) {
            __syncthreads();
            {
                int tq = threadIdx.x; asm volatile("" : "+v"(tq));
#pragma unroll 1
                for (int rnd = 0; rnd < 4; ++rnd) {
                    const int q = tq + NTHR * rnd, tok = q >> 5, c8 = (q & 31) * 8, t = tbeg + 64 * half + tok; const size_t row = (size_t)b * S_ + t;
                    const u32x4 zc = *(const u32x4*)(ZR + row * 1792 + 1536 + c8);
                    u32x4 zp; zp.x = 0u; zp.y = 0u; zp.z = 0u; zp.w = 0u; if (t > 0) zp = *(const u32x4*)(ZR + (row - 1) * 1792 + 1536 + c8);
                    const f32x4 ma = *(const f32x4*)(mu + 1536 + c8), mb = *(const f32x4*)(mu + 1536 + c8 + 4);
                    const unsigned cw[4] = {zc.x, zc.y, zc.z, zc.w}, pw[4] = {zp.x, zp.y, zp.z, zp.w};
                    float x[8];
#pragma unroll
                    for (int q2 = 0; q2 < 4; ++q2) { const float c0 = bflo(cw[q2]), c1 = bfhi(cw[q2]), p0 = bflo(pw[q2]), p1 = bfhi(pw[q2]);
                        const float m0 = q2 < 2 ? ma[2 * q2] : mb[2 * q2 - 4], m1 = q2 < 2 ? ma[2 * q2 + 1] : mb[2 * q2 - 3];
                        x[2 * q2] = c0 + (p0 - c0) * m0; x[2 * q2 + 1] = c1 + (p1 - c1) * m1; }
#pragma unroll
                    for (int e = 0; e < 8; ++e) { if (c8 < 64) x[e] = 1.0f - 2.0f * __builtin_amdgcn_rcpf(1.0f + __expf(2.0f * x[e])); else if (c8 >= 128) x[e] = sigmoidf_(x[e]); }
                    u32x4 w; w.x = cvt_pk_bf16(x[0], x[1]); w.y = cvt_pk_bf16(x[2], x[3]); w.z = cvt_pk_bf16(x[4], x[5]); w.w = cvt_pk_bf16(x[6], x[7]);
                    *(LAS u32x4*)(LI + tok * 256 + c8) = w;
                }
            }
            __syncthreads();
            float* los = (float*)(P.ws + OFF_SCR) + (size_t)(blk * 8 + wid) * (64 * 2 * 64);
            {
                int tq = threadIdx.x; asm volatile("" : "+v"(tq));
                const int lq = tq & 63, fr = lq & 15, kq = lq >> 4;
#pragma unroll 1
                for (int pass = 0; pass < 8; ++pass) {
                    const int kind = pass < 2 ? 0 : (pass < 4 ? 1 : 2), Kk = kind == 2 ? 128 : 64, aoff = kind * 64, nb0 = kind == 2 ? pass - 4 : 2 * (pass & 1);
                    const bf16_t* Wt = kind == 0 ? LW : (kind == 1 ? LA : LG);
                    bf16x8 Bf[4];
#pragma unroll
                    for (int q = 0; q < 4; ++q) { const int nb = kind == 2 ? nb0 : nb0 + (q >> 1), ks = kind == 2 ? q : (q & 1);
                        Bf[q] = *(const bf16x8*)(Wt + (size_t)(64 * wid + 16 * nb + fr) * Kk + 32 * ks + 8 * kq); }
#pragma unroll 1
                    for (int tt = 0; tt < 4; ++tt) {
                        f32x4 acc[2];
                        acc[0] = (f32x4){0.f, 0.f, 0.f, 0.f}; acc[1] = acc[0];
#pragma unroll
                        for (int q = 0; q < 4; ++q) { const int ai = kind == 2 ? 0 : (q >> 1), ks = kind == 2 ? q : (q & 1);
                            const bf16x8 Afr = *(const LAS bf16x8*)(LI + (16 * tt + fr) * 256 + aoff + 32 * ks + 8 * kq);
                            acc[ai] = __builtin_amdgcn_mfma_f32_16x16x32_bf16(Afr, Bf[q], acc[ai], 0, 0, 0); }
                        if (kind == 2) {
#pragma unroll
                            for (int r = 0; r < 4; ++r) Go[((size_t)b * S_ + tbeg + 64 * half + 16 * tt + 4 * kq + r) * 512 + 64 * wid + 16 * nb0 + fr] = f2bf(acc[0][r]);
                        } else {
#pragma unroll
                            for (int ai = 0; ai < 2; ++ai)
#pragma unroll
                                for (int r = 0; r < 4; ++r) los[((16 * tt + 4 * kq + r) * 2 + kind) * 64 + 16 * (nb0 + ai) + fr] = acc[ai][r];
                        }
                    }
                }
            }
            asm volatile("s_waitcnt vmcnt(0)" ::: "memory");
            for (int sb = 0; sb < 64 / TB; ++sb) {
                const int ts = tbeg + 64 * half + sb * TB;
                int tz = threadIdx.x; asm volatile("" : "+v"(tz));
                const int lz = tz & 63;
                LAS float* sw = SIN + (size_t)wid * (TB * 6 * 64);
                {
                    const int c = 64 * wid + lz; const size_t row0 = (size_t)b * S_ + ts;
                    const float mur = mu[c], muk = mu[512 + c], muv = mu[1024 + c];
                    const float pw0 = P.w0[l * 512 + c], pa0 = P.a0[l * 512 + c], pkk = P.k_k[l * 512 + c], pka = P.k_a[l * 512 + c], prk = P.r_k[l * 512 + c];
                    const float* lo = los + (size_t)(sb * TB) * 128 + lz;
                    float zr_[TB + 1], zk_[TB + 1], zv_[TB + 1], wl_[TB], al_[TB];
                    zr_[0] = 0.f; zk_[0] = 0.f; zv_[0] = 0.f;
                    if (ts > 0) { zr_[0] = bf2f(ZR[(row0 - 1) * 1792 + c]); zk_[0] = bf2f(ZR[(row0 - 1) * 1792 + 512 + c]); zv_[0] = bf2f(ZR[(row0 - 1) * 1792 + 1024 + c]); }
#pragma unroll
                    for (int tk = 0; tk < TB; ++tk) {
                        zr_[tk + 1] = bf2f(ZR[(row0 + tk) * 1792 + c]); zk_[tk + 1] = bf2f(ZR[(row0 + tk) * 1792 + 512 + c]); zv_[tk + 1] = bf2f(ZR[(row0 + tk) * 1792 + 1024 + c]);
                        wl_[tk] = lo[tk * 128]; al_[tk] = lo[tk * 128 + 64]; }
#pragma unroll
                    for (int tk = 0; tk < TB; ++tk) {
                        const size_t row = row0 + tk; LAS float* st = sw + tk * 6 * 64;
                        const float cr = zr_[tk + 1], ck = zk_[tk + 1], cv = zv_[tk + 1], wl = wl_[tk], al = al_[tk];
                        const float rr = cr + (zr_[tk] - cr) * mur, kv = ck + (zk_[tk] - ck) * muk, vv = cv + (zv_[tk] - cv) * muv;
                        const float dc = __builtin_amdgcn_exp2f(-0.87503877f * __builtin_amdgcn_rcpf(1.0f + __builtin_amdgcn_exp2f(-1.44269504f * (pw0 + wl))));
                        const float av = sigmoidf_(pa0 + al);
                        const float kkv = kv * pkk;
                        const float km = kv * (1.0f + (av - 1.0f) * pka);
                        float ss, bon; wave_sum2_dpp(kkv * kkv, rr * km * prk, ss, bon);
                        const float kkn = kkv * __builtin_amdgcn_rsqf(fmaxf(ss, 1e-24f));
                        st[lz] = rr; st[64 + lz] = dc; st[2 * 64 + lz] = km; st[3 * 64 + lz] = -kkn; st[4 * 64 + lz] = kkn * av; st[5 * 64 + lz] = vv;
                        VBo[row * 512 + c] = f2bf(bon * vv);
                    }
                }
                {
                const unsigned sq0 = (unsigned)(uintptr_t)sw, va0 = sq0 + 4u * (unsigned)lz;
                f32x4 X0[4], X1[4], X2[4]; float vin;
                DSRV(vin, va0, 1280);
                DSR4(X2, sq0, 896, 912, 928, 944);
                DSR4(X0, sq0, 768, 784, 800, 816);
                DSR4(X1, sq0, 832, 848, 864, 880);
#pragma unroll 1
                for (int tk = 0; tk < TB; ++tk) {
                    f32x2 sa0 = {0.f, 0.f}, sa1 = {0.f, 0.f}, sp0 = {0.f, 0.f}, sp1 = {0.f, 0.f};
                    f32x2 y0 = {0.f, 0.f}, y1 = {0.f, 0.f}, p0 = {0.f, 0.f}, p1 = {0.f, 0.f};
                    f32x2 sav, spv;
                    const unsigned sqa = sq0 + 1536u * (unsigned)tk, vna = va0 + 1536u * (unsigned)tk;
                    DSWV(X0, vin, 4);
                    const f32x2 vv2 = {vin, vin};
                    SCAN_A(X0, 0);
                    DSR4(X0, sqa, 960, 976, 992, 1008);
                    DSW(X1, 4);
                    SCAN_A(X1, 1);
                    DSR4(X1, sqa, 256, 1024, 512, 0);
                    DSW(X2, 8);
                    SCAN_A(X2, 2);
                    DSR4(X2, sqa, 272, 1040, 528, 16);
                    DSW(X0, 8);
                    SCAN_A(X0, 3);
                    { const float sa = (sa0.x + sa0.y) + (sa1.x + sa1.y), sp = (sp0.x + sp0.y) + (sp1.x + sp1.y); sav = (f32x2){sa, sa}; spv = (f32x2){sp, sp}; }
                    DSR4(X0, sqa, 288, 1056, 544, 32);
                    DSW(X1, 8);
                    SCAN_B(X1, 0);
                    DSR4(X1, sqa, 304, 1072, 560, 48);
                    DSW(X2, 8);
                    SCAN_B(X2, 1);
                    DSR4(X2, sqa, 320, 1088, 576, 64);
                    DSW(X0, 8);
                    SCAN_B(X0, 2);
                    DSR4(X0, sqa, 336, 1104, 592, 80);
                    DSW(X1, 8);
                    SCAN_B(X1, 3);
                    DSR4(X1, sqa, 352, 1120, 608, 96);
                    DSW(X2, 8);
                    SCAN_B(X2, 4);
                    DSR4(X2, sqa, 368, 1136, 624, 112);
                    DSW(X0, 8);
                    SCAN_B(X0, 5);
                    DSR4(X0, sqa, 384, 1152, 640, 128);
                    DSW(X1, 8);
                    SCAN_B(X1, 6);
                    DSR4(X1, sqa, 400, 1168, 656, 144);
                    DSW(X2, 8);
                    SCAN_B(X2, 7);
                    DSR4(X2, sqa, 416, 1184, 672, 160);
                    DSW(X0, 8);
                    SCAN_B(X0, 8);
                    DSR4(X0, sqa, 432, 1200, 688, 176);
                    DSW(X1, 8);
                    SCAN_B(X1, 9);
                    DSR4(X1, sqa, 448, 1216, 704, 192);
                    DSW(X2, 8);
                    SCAN_B(X2, 10);
                    DSR4(X2, sqa, 464, 1232, 720, 208);
                    DSW(X0, 8);
                    SCAN_B(X0, 11);
                    DSR4(X0, sqa, 480, 1248, 736, 224);
                    DSW(X1, 8);
                    SCAN_B(X1, 12);
                    DSR4(X1, sqa, 496, 1264, 752, 240);
                    DSW(X2, 8);
                    SCAN_B(X2, 13);
                    {
                        const unsigned nx = (tk + 1 < TB) ? 1536u : 0u, sqn = sqa + nx, vnn = vna + nx;
                        DSRV(vin, vnn, 1280);
                        DSR4(X2, sqn, 896, 912, 928, 944);
                        DSW(X0, 9);
                        SCAN_B(X0, 14);
                        DSR4(X0, sqn, 768, 784, 800, 816);
                        DSW(X1, 9);
                        SCAN_B(X1, 15);
                        DSR4(X1, sqn, 832, 848, 864, 880);
                    }
                    const size_t row = (size_t)b * S_ + ts + tk;
                    Yo[row * 512 + 64 * wid + lz] = f2bf((y0.x + y0.y) + (y1.x + y1.y));
                    Po[row * 512 + 64 * wid + lz] = f2bf((p0.x + p0.y) + (p1.x + p1.y));
                }
                asm volatile("s_waitcnt lgkmcnt(0)" : "+v"(X0[0]), "+v"(X0[1]), "+v"(X0[2]), "+v"(X0[3]), "+v"(X1[0]), "+v"(X1[1]), "+v"(X1[2]), "+v"(X1[3]),
                             "+v"(X2[0]), "+v"(X2[1]), "+v"(X2[2]), "+v"(X2[3]), "+v"(vin));
                }
            }
        }
        {
            int lq = threadIdx.x; asm volatile("" : "+v"(lq)); lq &= 63;
            float* sg = SEGp + ((size_t)((b * 8 + wid) * NSEG + seg)) * 8192 + lq * 64;
#pragma unroll
            for (int j = 0; j < 32; j += 2) { *(f32x4*)(sg + 2 * j) = (f32x4){Pm2[j].x, Pm2[j].y, Pm2[j + 1].x, Pm2[j + 1].y};
                *(f32x4*)(sg + 4096 + 2 * j) = (f32x4){S2[j].x, S2[j].y, S2[j + 1].x, S2[j + 1].y}; }
        }
    }
}

__device__ __forceinline__ void ph_comb(const Params& P, LAS unsigned char* lds) {
    LAS float* SI = (LAS float*)lds;
    LAS float* PB = (LAS float*)(lds + 20480);
    float* SEGp = (float*)(P.ws + OFF_SEG);
    const int tid = opaque_tid(), wid = __builtin_amdgcn_readfirstlane(tid >> 6), lane = tid & 63, m = lane & 31, hh = lane >> 5;
    for (int chain = blockIdx.x; chain < 64; chain += gridDim.x) {
        float* base = SEGp + (size_t)chain * NSEG * 8192;
        __syncthreads();
        for (int i = tid; i < 4096; i += NTHR) SI[(i >> 6) * 65 + (i & 63)] = base[4096 + i];
        { const f32x4 a = *(const f32x4*)(base + 8192 + tid * 8), c = *(const f32x4*)(base + 8192 + tid * 8 + 4);
          *(LAS f32x4*)(PB + 4096 + tid * 8) = a; *(LAS f32x4*)(PB + 4096 + tid * 8 + 4) = c; }
        __syncthreads();
        const int ti = (wid >> 1) & 1, tj = wid & 1;
        for (int k = 1; k <= NSEG - 2; ++k) {
            float* Q = base + (size_t)k * 8192 + 4096;
            const LAS float* Pb = PB + (k & 1) * 4096;
            f32x4 na = {0.f, 0.f, 0.f, 0.f}, nc = na;
            if (k + 1 <= NSEG - 2) { const float* pn = base + (size_t)(k + 1) * 8192 + tid * 8; na = *(const f32x4*)pn; nc = *(const f32x4*)(pn + 4); }
            f32x16 Dv;
            if (wid < 4) {
                float qv[16];
#pragma unroll
                for (int r = 0; r < 16; ++r) { const int row = 32 * ti + (r & 3) + 8 * (r >> 2) + 4 * hh; qv[r] = Q[row * 64 + 32 * tj + m]; Dv[r] = 0.f; }
#pragma unroll
                for (int kk = 0; kk < 32; ++kk) { const float a = SI[(32 * ti + m) * 65 + 2 * kk + hh], bq = Pb[(2 * kk + hh) * 64 + 32 * tj + m];
                    Dv = __builtin_amdgcn_mfma_f32_32x32x2f32(a, bq, Dv, 0, 0, 0); }
#pragma unroll
                for (int r = 0; r < 16; ++r) Dv[r] += qv[r];
            }
            __syncthreads();
            if (wid < 4) {
#pragma unroll
                for (int r = 0; r < 16; ++r) { const int row = 32 * ti + (r & 3) + 8 * (r >> 2) + 4 * hh; SI[row * 65 + 32 * tj + m] = Dv[r]; Q[row * 64 + 32 * tj + m] = Dv[r]; }
            }
            if (k + 1 <= NSEG - 2) { LAS float* pd = PB + ((k + 1) & 1) * 4096 + tid * 8; *(LAS f32x4*)pd = na; *(LAS f32x4*)(pd + 4) = nc; }
            __syncthreads();
        }
    }
}

__device__ __forceinline__ void ph_post(const Params& P, int l) {
    const bf16_t* Yo = (const bf16_t*)(P.ws + OFF_Y); const bf16_t* Po = (const bf16_t*)(P.ws + OFF_P); const bf16_t* Go = (const bf16_t*)(P.ws + OFF_G);
    const bf16_t* VBo = (const bf16_t*)(P.ws + OFF_VB); const float* SEGp = (const float*)(P.ws + OFF_SEG); bf16_t* OR = (bf16_t*)(P.ws + OFF_ORWKV);
    const int tid = opaque_tid(), wid = __builtin_amdgcn_readfirstlane(tid >> 6), lane = tid & 63, m = lane & 31, hh = lane >> 5;
    for (int blk = blockIdx.x; blk < NB_ * NSEG; blk += gridDim.x) {
        const int b = blk / NSEG, seg = blk % NSEG, tbeg = seg * SEGL;
        bf16x8 SIf[2][4];
        if (seg > 0) {
            const float* sg = SEGp + ((size_t)((b * 8 + wid) * NSEG + seg - 1)) * 8192 + 4096;
#pragma unroll
            for (int ib = 0; ib < 2; ++ib)
#pragma unroll
                for (int ks = 0; ks < 4; ++ks) { const float* sp = sg + (32 * ib + m) * 64 + 16 * ks + 8 * hh; const f32x4 a = *(const f32x4*)sp, c = *(const f32x4*)(sp + 4);
                    u32x4 w; w.x = cvt_pk_bf16(a[0], a[1]); w.y = cvt_pk_bf16(a[2], a[3]); w.z = cvt_pk_bf16(c[0], c[1]); w.w = cvt_pk_bf16(c[2], c[3]); SIf[ib][ks] = __builtin_bit_cast(bf16x8, w); }
        }
        float lnw[32], lnb[32];
#pragma unroll
        for (int q = 0; q < 32; ++q) { const int ch = 64 * wid + 32 * (q >> 4) + (q & 3) + 8 * ((q & 15) >> 2) + 4 * hh; lnw[q] = P.ln_w[l * 512 + ch]; lnb[q] = P.ln_b[l * 512 + ch]; }
#pragma unroll 1
        for (int c = 0; c < SEGL / 32; ++c) {
            const size_t row = (size_t)b * S_ + tbeg + 32 * c + m;
            f32x16 D[2];
#pragma unroll
            for (int r = 0; r < 16; ++r) { D[0][r] = 0.f; D[1][r] = 0.f; }
            if (seg > 0) {
                const bf16_t* pp = Po + row * 512 + 64 * wid + 8 * hh;
#pragma unroll
                for (int ks = 0; ks < 4; ++ks) { const bf16x8 Pf = *(const bf16x8*)(pp + 16 * ks);
                    D[0] = __builtin_amdgcn_mfma_f32_32x32x16_bf16(SIf[0][ks], Pf, D[0], 0, 0, 0); D[1] = __builtin_amdgcn_mfma_f32_32x32x16_bf16(SIf[1][ks], Pf, D[1], 0, 0, 0); }
            }
            float y[32]; float s = 0.f;
#pragma unroll
            for (int ib = 0; ib < 2; ++ib)
#pragma unroll
                for (int g = 0; g < 4; ++g) { const u32x2 yw = *(const u32x2*)(Yo + row * 512 + 64 * wid + 32 * ib + 8 * g + 4 * hh);
                    y[16 * ib + 4 * g + 0] = bflo(yw.x) + D[ib][4 * g + 0]; y[16 * ib + 4 * g + 1] = bfhi(yw.x) + D[ib][4 * g + 1];
                    y[16 * ib + 4 * g + 2] = bflo(yw.y) + D[ib][4 * g + 2]; y[16 * ib + 4 * g + 3] = bfhi(yw.y) + D[ib][4 * g + 3]; }
#pragma unroll
            for (int q = 0; q < 32; ++q) s += y[q];
            s += shx(s, 32, lane);
            const float mean = s * (1.0f / 64.0f); float qv = 0.f;
#pragma unroll
            for (int q = 0; q < 32; ++q) { y[q] -= mean; qv += y[q] * y[q]; }
            qv += shx(qv, 32, lane);
            const float rstd = rsqrtf(qv * (1.0f / 64.0f) + 64e-5f);
#pragma unroll
            for (int ib = 0; ib < 2; ++ib)
#pragma unroll
                for (int g = 0; g < 4; ++g) { const size_t off = row * 512 + 64 * wid + 32 * ib + 8 * g + 4 * hh;
                    const u32x2 vw = *(const u32x2*)(VBo + off), gw = *(const u32x2*)(Go + off); const int q = 16 * ib + 4 * g;
                    const float o0 = (y[q] * rstd * lnw[q] + lnb[q] + bflo(vw.x)) * bflo(gw.x), o1 = (y[q + 1] * rstd * lnw[q + 1] + lnb[q + 1] + bfhi(vw.x)) * bfhi(gw.x);
                    const float o2 = (y[q + 2] * rstd * lnw[q + 2] + lnb[q + 2] + bflo(vw.y)) * bflo(gw.y), o3 = (y[q + 3] * rstd * lnw[q + 3] + lnb[q + 3] + bfhi(vw.y)) * bfhi(gw.y);
                    u32x2 w; w.x = cvt_pk_bf16(o0, o1); w.y = cvt_pk_bf16(o2, o3); *(u32x2*)(OR + off) = w; }
        }
    }
}

enum { PH_PRO = 0, PH_NORM1, PH_ZQ, PH_KI, PH_IDX, PH_ATT, PH_ZR, PH_SCAN, PH_COMB, PH_POST, PH_ZC, PH_CONV, PH_MERGE, PH_WO, PH_NORM2, PH_UP, PH_U, PH_DOWN, PH_FINAL, PH_COUNT };

template <int PH>
__device__ __forceinline__ void run_phase(const Params& P0, int l, LAS unsigned char* lds) {
    Params P = P0; P.ws = opaque_ptr(P0.ws);
    if constexpr (PH == PH_PRO) { if (l == 0) ph_mod(P, lds); ph_wconv(P, l, lds); }
    if constexpr (PH == PH_NORM1) ph_norm(P, l, 0);
    if constexpr (PH == PH_ZQ) ph_gemm_zq(P, lds);
    if constexpr (PH == PH_KI) ph_ki(P, lds);
    if constexpr (PH == PH_IDX) ph_idx(P, lds);
    if constexpr (PH == PH_ATT) ph_att(P, lds);
    if constexpr (PH == PH_ZR) ph_gemm_zr(P, lds);
    if constexpr (PH == PH_SCAN) ph_scan(P, l, lds);
    if constexpr (PH == PH_COMB) ph_comb(P, lds);
    if constexpr (PH == PH_POST) ph_post(P, l);
    if constexpr (PH == PH_ZC) ph_gemm_zc(P, lds);
    if constexpr (PH == PH_CONV) ph_conv(P, l, lds);
    if constexpr (PH == PH_MERGE) ph_gemm_merge(P, lds);
    if constexpr (PH == PH_WO) ph_gemm_wo(P, l, lds);
    if constexpr (PH == PH_NORM2) ph_norm(P, l, 1);
    if constexpr (PH == PH_UP) ph_gemm_up(P, l, lds);
    if constexpr (PH == PH_U) ph_ufix(P, l, lds);
    if constexpr (PH == PH_DOWN) ph_gemm_down(P, l, lds);
    if constexpr (PH == PH_FINAL) ph_final(P);
}

#if MK_SINGLE
__global__ void __launch_bounds__(NTHR, 2) k_mega(Params P) {
    extern __shared__ __attribute__((aligned(16))) unsigned char shm[];
    LAS unsigned char* lds = (LAS unsigned char*)shm;
    LAS unsigned* xbw = (LAS unsigned*)(lds + LDS_BYTES - 16);
    if (threadIdx.x == 0) { xbw[0] = 0u; xbw[1] = 0u; xbw[2] = 0u; xbw[3] = 0u; }
    __syncthreads();
    XcdBarrier bar = xcd_barrier_post((unsigned*)(P.ws + OFF_BAR), (volatile LAS unsigned*)xbw);
#ifndef PROBE_PH
#define PROBE_PH (-1)
#endif
#ifndef PROBE_N
#define PROBE_N 4
#endif
#define PHASE(PH, l) do { unsigned long long t0_ = 0; if (PROBE_PH == PH && blockIdx.x == 0) t0_ = wall_clock64(); \
        run_phase<PH>(P, l, lds); xcd_barrier(bar); \
        if (PROBE_PH == PH && blockIdx.x == 0) { const unsigned long long t1_ = wall_clock64(), d_ = (t1_ - t0_) * PROBE_N; while (wall_clock64() - t1_ < d_) __builtin_amdgcn_s_sleep(8); } } while (0)
#pragma unroll 1
    for (int l = 0; l < 2; ++l) {
        PHASE(PH_PRO, l); PHASE(PH_NORM1, l); PHASE(PH_ZQ, l); PHASE(PH_KI, l); PHASE(PH_IDX, l); PHASE(PH_ATT, l); PHASE(PH_ZR, l); PHASE(PH_SCAN, l); PHASE(PH_COMB, l); PHASE(PH_POST, l);
        PHASE(PH_ZC, l); PHASE(PH_CONV, l); PHASE(PH_MERGE, l); PHASE(PH_WO, l); PHASE(PH_NORM2, l); PHASE(PH_UP, l); PHASE(PH_U, l); PHASE(PH_DOWN, l);
    }
    run_phase<PH_FINAL>(P, 0, lds);
#undef PHASE
}
#else
template <int PH>
__global__ void __launch_bounds__(NTHR, 2) k_phase(Params P, int l) {
    extern __shared__ __attribute__((aligned(16))) unsigned char shm[];
    run_phase<PH>(P, l, (LAS unsigned char*)shm);
}
template <int PH> static void launch_phase(const Params& P, int l, hipStream_t stream) {
    static bool attr = false;
    if (!attr) { hipFuncSetAttribute((const void*)k_phase<PH>, hipFuncAttributeMaxDynamicSharedMemorySize, LDS_BYTES); attr = true; }
    hipLaunchKernelGGL(k_phase<PH>, dim3(NBLK), dim3(NTHR), LDS_BYTES, stream, P, l);
}
#endif

extern "C" void kernel_launch(void* const* d_in, const int* in_sizes, int n_in, void* d_out, int out_size, void* d_ws, size_t ws_size, hipStream_t stream) {
    (void)in_sizes; (void)n_in; (void)out_size; (void)ws_size;
    Params P{};
    P.x_in = (const float*)d_in[0]; P.c = (const float*)d_in[1]; P.pos = (const int*)d_in[2]; P.rel_bias = (const float*)d_in[3]; P.final_norm = (const float*)d_in[4];
    P.ada_w = (const float*)d_in[5]; P.ada_b = (const float*)d_in[6]; P.norm_mix = (const float*)d_in[7]; P.w_in = (const float*)d_in[8];
    P.mu = (const float*)d_in[9]; P.w0 = (const float*)d_in[10]; P.w_up = (const float*)d_in[11]; P.a0 = (const float*)d_in[12]; P.a_up = (const float*)d_in[13]; P.g_up = (const float*)d_in[14];
    P.k_k = (const float*)d_in[15]; P.k_a = (const float*)d_in[16]; P.r_k = (const float*)d_in[17]; P.ln_w = (const float*)d_in[18]; P.ln_b = (const float*)d_in[19];
    P.sc_conv_w = (const float*)d_in[20]; P.w_branch = (const float*)d_in[21]; P.w_o = (const float*)d_in[22]; P.norm_ffn = (const float*)d_in[23];
    P.ffn_w_up = (const float*)d_in[24]; P.ffn_conv_w = (const float*)d_in[25]; P.ffn_w_down = (const float*)d_in[26];
    P.out = (float*)d_out; P.ws = (unsigned char*)d_ws;
#if MK_SINGLE
    static bool attr = false;
    if (!attr) { hipFuncSetAttribute((const void*)k_mega, hipFuncAttributeMaxDynamicSharedMemorySize, LDS_BYTES); attr = true; }
    hipMemsetAsync((unsigned char*)d_ws + OFF_BAR, 0, XCD_BAR_WORDS * sizeof(unsigned), stream);
    hipLaunchKernelGGL(k_mega, dim3(NBLK), dim3(NTHR), LDS_BYTES, stream, P);
#else
    for (int l = 0; l < 2; ++l) {
        launch_phase<PH_PRO>(P, l, stream); launch_phase<PH_NORM1>(P, l, stream); launch_phase<PH_ZQ>(P, l, stream); launch_phase<PH_KI>(P, l, stream); launch_phase<PH_IDX>(P, l, stream);
        launch_phase<PH_ATT>(P, l, stream); launch_phase<PH_ZR>(P, l, stream); launch_phase<PH_SCAN>(P, l, stream); launch_phase<PH_COMB>(P, l, stream);
        launch_phase<PH_POST>(P, l, stream); launch_phase<PH_ZC>(P, l, stream); launch_phase<PH_CONV>(P, l, stream); launch_phase<PH_MERGE>(P, l, stream);
        launch_phase<PH_WO>(P, l, stream); launch_phase<PH_NORM2>(P, l, stream); launch_phase<PH_UP>(P, l, stream); launch_phase<PH_U>(P, l, stream);
        launch_phase<PH_DOWN>(P, l, stream);
    }
    launch_phase<PH_FINAL>(P, 0, stream);
#endif
}
```

```cpp
#include <hip/hip_runtime.h>
#include <stdint.h>

#ifndef MK_SINGLE
#define MK_SINGLE 1
#endif

#define LAS __attribute__((address_space(3)))
typedef unsigned short bf16_t;
typedef short bf16x8 __attribute__((ext_vector_type(8)));
typedef short bf16x4 __attribute__((ext_vector_type(4)));
typedef float f32x4 __attribute__((ext_vector_type(4)));
typedef float f32x16 __attribute__((ext_vector_type(16)));
typedef float f32x2 __attribute__((ext_vector_type(2)));
typedef unsigned u32x4 __attribute__((ext_vector_type(4)));
typedef unsigned u32x2 __attribute__((ext_vector_type(2)));
typedef int i32x4 __attribute__((ext_vector_type(4)));
typedef unsigned long long u64;
typedef unsigned long long u64x2 __attribute__((ext_vector_type(2)));

constexpr int T_ = 32768, D_ = 1024, NB_ = 8, S_ = 4096;
constexpr int NSEG = 32, SEGL = 128, TB = 8;
constexpr int NBLK = 256, NTHR = 512;
constexpr int IN_COLS = 8520, DFF = 2816;
constexpr int LDS_BYTES = 150 * 1024;

constexpr size_t MiB = 1ull << 20;
constexpr size_t OFF_BAR = 0;
constexpr size_t OFF_MOD = 64 * 1024;
constexpr size_t OFF_TAB = 512 * 1024;
constexpr size_t OFF_KPM = 520 * 1024;
constexpr size_t OFF_WB = 2 * MiB;
constexpr size_t WB_WIN = 0;
constexpr size_t WB_WBR = WB_WIN + (size_t)8704 * 1024 * 2;
constexpr size_t WB_WO = WB_WBR + (size_t)3 * 1024 * 512 * 2;
constexpr size_t WB_WUP = WB_WO + (size_t)1024 * 1024 * 2;
constexpr size_t WB_WDN = WB_WUP + (size_t)5632 * 1024 * 2;
constexpr size_t WB_LW = WB_WDN + (size_t)1024 * 2816 * 2;
constexpr size_t WB_LA = WB_LW + (size_t)512 * 64 * 2;
constexpr size_t WB_LG = WB_LA + (size_t)512 * 64 * 2;
constexpr size_t OFF_H = 42 * MiB;
constexpr size_t OFF_ZQ = 106 * MiB;
constexpr size_t OFF_MASK = 250 * MiB;
constexpr size_t OFF_VT = 266 * MiB;
constexpr size_t OFF_ZR = 106 * MiB;
constexpr size_t OFF_Y = 218 * MiB;
constexpr size_t OFF_P = 250 * MiB;
constexpr size_t OFF_G = 282 * MiB;
constexpr size_t OFF_SEG = 314 * MiB;
constexpr size_t OFF_KI = 314 * MiB;
constexpr size_t OFF_ZCV = 106 * MiB;
constexpr size_t OFF_ZG = 202 * MiB;
constexpr size_t OFF_MRG = 106 * MiB;
constexpr size_t OFF_UP = 106 * MiB;
constexpr size_t OFF_HA = 300 * MiB;
constexpr size_t OFF_HB = 320 * MiB;
constexpr size_t OFF_OCONV = 416 * MiB;
constexpr size_t OFF_ORWKV = 448 * MiB;
constexpr size_t OFF_OATT = 480 * MiB;
constexpr size_t OFF_VB = OFF_ORWKV;
constexpr size_t OFF_SCR = 378 * MiB;

struct Params {
    const float* x_in; const float* c; const int* pos; const float* rel_bias; const float* final_norm;
    const float* ada_w; const float* ada_b; const float* norm_mix; const float* w_in;
    const float* mu; const float* w0; const float* w_up; const float* a0; const float* a_up; const float* g_up;
    const float* k_k; const float* k_a; const float* r_k; const float* ln_w; const float* ln_b;
    const float* sc_conv_w; const float* w_branch; const float* w_o; const float* norm_ffn;
    const float* ffn_w_up; const float* ffn_conv_w; const float* ffn_w_down;
    float* out; unsigned char* ws;
};

__device__ __forceinline__ float bf2f(bf16_t b) { return __uint_as_float(((unsigned)b) << 16); }
__device__ __forceinline__ bf16_t f2bf(float f) { unsigned u = __float_as_uint(f); u += 0x7FFFu + ((u >> 16) & 1u); return (bf16_t)(u >> 16); }
typedef __bf16 bf16x2_t __attribute__((ext_vector_type(2)));
__device__ __forceinline__ unsigned cvt_pk_bf16(float lo, float hi) { const f32x2 v = {lo, hi}; return __builtin_bit_cast(unsigned, __builtin_convertvector(v, bf16x2_t)); }
__device__ __forceinline__ float bflo(unsigned w) { return __uint_as_float(w << 16); }
__device__ __forceinline__ float bfhi(unsigned w) { return __uint_as_float(w & 0xffff0000u); }
__device__ __forceinline__ float shx(float v, int mask, int lane) { return __int_as_float(__builtin_amdgcn_ds_bpermute((lane ^ mask) << 2, __float_as_int(v))); }
__device__ __forceinline__ int shxi(int v, int mask, int lane) { return __builtin_amdgcn_ds_bpermute((lane ^ mask) << 2, v); }
__device__ __forceinline__ float wave_sum(float v, int lane) {
#pragma unroll
    for (int o = 32; o >= 1; o >>= 1) v += shx(v, o, lane);
    return v;
}
__device__ __forceinline__ void writelane_c2(int& vlo, int& vhi, int lo, int hi, int ln  ) {
    asm("s_nop 3\n\tv_writelane_b32 %0, %2, %4\n\tv_writelane_b32 %1, %3, %4" : "+v"(vlo), "+v"(vhi) : "s"(lo), "s"(hi), "n"(ln)); }
__device__ __forceinline__ int writelane_v(int vec, int val, int ln  ) { asm("s_mov_b32 m0, %2\n\ts_nop 3\n\tv_writelane_b32 %0, %1, m0" : "+v"(vec) : "s"(val), "s"(ln) : "m0"); return vec; }
__device__ __forceinline__ float sigmoidf_(float x) { return __builtin_amdgcn_rcpf(1.0f + __expf(-x)); }
__device__ __forceinline__ unsigned f2ord(float x) { unsigned u = __float_as_uint(x); return (u & 0x80000000u) ? ~u : (u | 0x80000000u); }
__device__ __forceinline__ float ord2f(unsigned k) { return __uint_as_float((k & 0x80000000u) ? (k & 0x7fffffffu) : ~k); }

__device__ __forceinline__ int opaque_tid() { int t = threadIdx.x; asm volatile("" : "+v"(t)); return t; }
__device__ __forceinline__ unsigned char* opaque_ptr(unsigned char* p) {
    typedef __attribute__((address_space(1))) unsigned char* gptr_t;
    gptr_t g = (gptr_t)p; asm volatile("" : "+s"(g)); return (unsigned char*)g; }

#define XB_TMO      128
#define XB_XCNT(j)  (256  + 64 * (j))
#define XB_XSUB(j)  (1280 + 64 * (j))
#define XB_XGEN(j)  (2304 + 64 * (j))
#define XB_TOP      3328
#define XB_TOPGEN   3392
#define XCD_BAR_WORDS 3456
#define XB_SPIN_CAP (1u << 22)

__device__ __forceinline__ unsigned xb_ld(unsigned* p)              { return __hip_atomic_load(p, __ATOMIC_RELAXED, __HIP_MEMORY_SCOPE_AGENT); }
__device__ __forceinline__ unsigned xb_add(unsigned* p, unsigned v) { return __hip_atomic_fetch_add(p, v, __ATOMIC_RELAXED, __HIP_MEMORY_SCOPE_AGENT); }
__device__ __forceinline__ unsigned xb_xcc_id() { return (unsigned)__builtin_amdgcn_s_getreg((3 << 11) | 20) & 0xFu; }
#define XB_SPIN(cond, bar) do { unsigned _sp = 0; while (cond) { __builtin_amdgcn_s_sleep(1); \
    if ((++_sp & 255u) == 0u) { if (xb_ld(&(bar)[XB_TMO])) break; if (_sp > XB_SPIN_CAP) { atomicAdd(&(bar)[XB_TMO], 1u); break; } } } } while (0)

struct XcdBarrier { unsigned* bar; unsigned x; volatile LAS unsigned* st; };

__device__ __forceinline__ XcdBarrier xcd_barrier_post(unsigned* bar, volatile LAS unsigned* st) {
    XcdBarrier b; b.bar = bar; b.x = xb_xcc_id(); b.st = st;
    if (threadIdx.x == 0) (void)xb_add(&bar[XB_XCNT(b.x)], 1u);
    return b;
}
__device__ __forceinline__ void xcd_barrier_complete(unsigned* bar, unsigned x, unsigned& nloc, unsigned& nx) {
    const unsigned G = gridDim.x * gridDim.y * gridDim.z;
    unsigned sum, cnt, mine, sp = 0u;
    for (;;) {
        sum = 0u; cnt = 0u; mine = 0u;
#pragma unroll
        for (unsigned j = 0; j < 16; ++j) { const unsigned c = xb_ld(&bar[XB_XCNT(j)]); sum += c; cnt += (c > 0u) ? 1u : 0u; mine = (j == x) ? c : mine; }
        if (sum == G) break;
        __builtin_amdgcn_s_sleep(1);
        if ((++sp & 255u) == 0u) { if (xb_ld(&bar[XB_TMO])) break; if (sp > XB_SPIN_CAP) { atomicAdd(&bar[XB_TMO], 1u); break; } }
    }
    nloc = mine > 0u ? mine : 1u; nx = cnt > 0u ? cnt : 1u;
}
__device__ __forceinline__ void xcd_barrier(const XcdBarrier& b) {
    asm volatile("s_waitcnt vmcnt(0)" ::: "memory");
    __syncthreads();
    if (threadIdx.x == 0) {
        unsigned* bar = b.bar;
        __builtin_amdgcn_s_waitcnt(0);
        unsigned nloc = b.st[0], nx = b.st[1];
        if (nloc == 0u) { xcd_barrier_complete(bar, b.x, nloc, nx); b.st[0] = nloc; b.st[1] = nx; }
        const unsigned old = xb_add(&bar[XB_XSUB(b.x)], 1u);
        const unsigned gen = old / nloc;
        if (old + 1u == (gen + 1u) * nloc) {
            __builtin_amdgcn_fence(__ATOMIC_RELEASE, "agent");
            asm volatile("s_waitcnt vmcnt(0)" ::: "memory");
            const unsigned og = xb_add(&bar[XB_TOP], 1u);
            const unsigned tg = og / nx;
            if (og + 1u == (tg + 1u) * nx) xb_add(&bar[XB_TOPGEN], 1u);
            else XB_SPIN(xb_ld(&bar[XB_TOPGEN]) == tg, bar);
            __builtin_amdgcn_fence(__ATOMIC_ACQUIRE, "agent");
            xb_add(&bar[XB_XGEN(b.x)], 1u);
            asm volatile("s_waitcnt vmcnt(0)" ::: "memory");
        } else {
            XB_SPIN(xb_ld(&bar[XB_XGEN(b.x)]) == gen, bar);
            __builtin_amdgcn_fence(__ATOMIC_ACQUIRE, "agent");
            asm volatile("s_waitcnt vmcnt(0)" ::: "memory");
        }
    }
    __syncthreads();
}

namespace g8 {
constexpr int BM = 256, BK = 64, HALF = 128, HTB = HALF * BK * 2, STAGE_BYTES = 8 * HTB, NXCD = 8, WGM = 8;
__device__ __forceinline__ int lds_byte(int r, int c) { const int st = (r >> 4) * 2 + (c >> 5), rr = r & 15, cc = c & 31, ob = rr * 64 + cc * 2; return st * 1024 + (ob ^ (((ob >> 9) & 1) << 5)); }
__device__ __forceinline__ void stage_rc(int b, int& R, int& C) { const int st = b / 1024, sb = b % 1024, swz = sb ^ (((sb >> 9) & 1) << 5); R = (st >> 1) * 16 + swz / 64; C = (st & 1) * 32 + (swz % 64) / 2; }
__device__ __forceinline__ int perm32(int rho) { const int n = rho >> 4, i = rho & 15; return 8 * (i >> 2) + 4 * n + (i & 3); }

struct Unit { const char* A; const char* B; int pm, pn, tag; };

struct SOrder {
    int nM, nN, nwg, G, c; const char* A; const char* Bt; size_t a_t, b_t;
    __device__ void init(int M, int N, int lda, int ldb, const void* A_, const void* Bt_) {
        nM = M / BM; nN = N / BM; nwg = nM * nN; G = (int)gridDim.x; c = (int)blockIdx.x; A = (const char*)A_; Bt = (const char*)Bt_;
        a_t = (size_t)BM * lda * 2; b_t = (size_t)BM * ldb * 2; }
    __device__ bool next(int i, Unit& u) const {
        const long L = (long)i * G + c; if (L >= nwg) return false;
        int wgid = (int)L; { const int q = nwg / NXCD, r = nwg % NXCD, xcd = wgid % NXCD, off = wgid / NXCD; wgid = (xcd < r ? xcd * (q + 1) : r * (q + 1) + (xcd - r) * q) + off; }
        const int nig = WGM * nN, gid = wgid / nig, fm = gid * WGM, gsz = (nM - fm) < WGM ? (nM - fm) : WGM;
        u.pm = fm + ((wgid % nig) % gsz); u.pn = (wgid % nig) / gsz; u.tag = 0;
        u.A = A + (size_t)u.pm * a_t; u.B = Bt + (size_t)u.pn * b_t; return true;
    }
};

template <class Epi, class Sched>
__device__ __forceinline__ void gemm_phase(LAS unsigned char* lds, const int K, const int lda, const int ldb, const Sched& S, const Epi& E) {
    const int tid = opaque_tid(), wid = __builtin_amdgcn_readfirstlane(tid >> 6), lane = tid & 63, wr = wid >> 2, wc = wid & 3, fr = lane & 15, fq = lane >> 4;
    const int nt = K / BK;
    unsigned voffA[2], voffB[2];
#pragma unroll
    for (int i = 0; i < 2; ++i) { int R, C; stage_rc(tid * 16 + i * 8192, R, C); const int Rb = Epi::PERM ? ((R & ~31) + perm32(R & 31)) : R;
        voffA[i] = (unsigned)(R * lda + C) * 2u; voffB[i] = (unsigned)(Rb * ldb + C) * 2u; }
    const size_t kstep = (size_t)(BK * 2);
    const size_t hstepA = (size_t)HALF * lda * 2, hstepB = (size_t)HALF * ldb * 2;
    const unsigned ldsw = (unsigned)wid * 1024u;
    const int aoff = lds_byte(wr * 64 + fr, fq * 8), boff = lds_byte(wc * 32 + fr, fq * 8);
#define PG8_SA(b, h) (((b) * 2 + (h)) * HTB)
#define PG8_SB(b, h) ((4 + (b) * 2 + (h)) * HTB)
#define PG8_STAGE(bufoff, gbase, voff) do { _Pragma("unroll") for (int _i = 0; _i < 2; ++_i) \
        __builtin_amdgcn_global_load_lds((const unsigned*)((const char*)(gbase) + (voff)[_i]), (LAS unsigned*)(lds + (bufoff) + ldsw + _i * 8192), 16, 0, 0); } while (0)
#define PG8_LDA(dst, b, h) do { _Pragma("unroll") for (int m = 0; m < 4; ++m) _Pragma("unroll") for (int k = 0; k < 2; ++k) dst[m][k] = *(const LAS bf16x8*)(lds + PG8_SA(b, h) + aoff + m * 2048 + k * 1024); } while (0)
#define PG8_LDB(dst, b, h) do { _Pragma("unroll") for (int n = 0; n < 2; ++n) _Pragma("unroll") for (int k = 0; k < 2; ++k) dst[n][k] = *(const LAS bf16x8*)(lds + PG8_SB(b, h) + boff + n * 2048 + k * 1024); } while (0)
#define PG8_MMA(ai, bj, At, Bt) do { __builtin_amdgcn_s_setprio(1); _Pragma("unroll") for (int m = 0; m < 4; ++m) _Pragma("unroll") for (int n = 0; n < 2; ++n) _Pragma("unroll") for (int k = 0; k < 2; ++k) \
        acc[ai][bj][m][n] = __builtin_amdgcn_mfma_f32_16x16x32_bf16(Bt[n][k], At[m][k], acc[ai][bj][m][n], 0, 0, 0); __builtin_amdgcn_s_setprio(0); } while (0)
#define PG8_WAIT_V(n) asm volatile("s_waitcnt vmcnt(" #n ")" ::: "memory")
#define PG8_WAIT_L(n) asm volatile("s_waitcnt lgkmcnt(" #n ")" ::: "memory")
#define PG8_BAR __builtin_amdgcn_s_barrier()
#define PG8_SCHED __builtin_amdgcn_sched_barrier(0)
    Unit cur, nxt; int ui = 0;
    if (!S.next(0, cur)) return;
    f32x4 acc[2][2][4][2];
#pragma unroll
    for (int a = 0; a < 2; ++a)
#pragma unroll
        for (int b = 0; b < 2; ++b)
#pragma unroll
            for (int m = 0; m < 4; ++m)
#pragma unroll
                for (int n = 0; n < 2; ++n) acc[a][b][m][n] = (f32x4){0.f, 0.f, 0.f, 0.f};
    bf16x8 At[4][2], B0[2][2], B1[2][2];
    const char* cA = cur.A; const char* cB = cur.B;
    PG8_STAGE(PG8_SB(0, 0), cB, voffB); PG8_STAGE(PG8_SA(0, 0), cA, voffA); PG8_STAGE(PG8_SB(0, 1), cB + hstepB, voffB); PG8_STAGE(PG8_SA(0, 1), cA + hstepA, voffA);
    if (wr == 1) PG8_BAR;
    PG8_WAIT_V(4); PG8_BAR;
    PG8_STAGE(PG8_SB(1, 0), cB + kstep, voffB); PG8_STAGE(PG8_SA(1, 0), cA + kstep, voffA); PG8_STAGE(PG8_SB(1, 1), cB + hstepB + kstep, voffB);
    PG8_WAIT_V(6); PG8_BAR;
    for (;;) {
        const bool has_next = S.next(ui + 1, nxt);
        const char* nA = has_next ? nxt.A : cA; const char* nB = has_next ? nxt.B : cB;
        for (int t = 0; t < nt; t += 2) {
            const bool last = (t == nt - 2);
            const char* a1 = cA + (size_t)(t + 1) * kstep;
            const char* a2 = last ? nA : cA + (size_t)(t + 2) * kstep; const char* b2 = last ? nB : cB + (size_t)(t + 2) * kstep;
            const char* a3 = a2 + kstep; const char* b3 = b2 + kstep;
            PG8_LDB(B0, 0, 0); PG8_SCHED; PG8_LDA(At, 0, 0); PG8_STAGE(PG8_SA(1, 1), a1 + hstepA, voffA);
            PG8_WAIT_L(8); PG8_BAR; PG8_WAIT_L(0); PG8_MMA(0, 0, At, B0); PG8_BAR; PG8_SCHED;
            PG8_LDB(B1, 0, 1); PG8_STAGE(PG8_SB(0, 0), b2, voffB);
            PG8_BAR; PG8_WAIT_L(0); PG8_MMA(0, 1, At, B1); PG8_BAR;
            PG8_LDA(At, 0, 1); PG8_STAGE(PG8_SA(0, 0), a2, voffA);
            PG8_BAR; PG8_WAIT_L(0); PG8_MMA(1, 0, At, B0); PG8_BAR; PG8_SCHED;
            PG8_STAGE(PG8_SB(0, 1), b2 + hstepB, voffB);
            PG8_WAIT_V(6); PG8_BAR; PG8_MMA(1, 1, At, B1); PG8_BAR;
            PG8_LDB(B0, 1, 0); PG8_SCHED; PG8_LDA(At, 1, 0); PG8_STAGE(PG8_SA(0, 1), a2 + hstepA, voffA);
            PG8_WAIT_L(8); PG8_BAR; PG8_WAIT_L(0); PG8_MMA(0, 0, At, B0); PG8_BAR; PG8_SCHED;
            PG8_LDB(B1, 1, 1); PG8_STAGE(PG8_SB(1, 0), b3, voffB);
            PG8_BAR; PG8_WAIT_L(0); PG8_MMA(0, 1, At, B1); PG8_BAR;
            PG8_LDA(At, 1, 1); PG8_STAGE(PG8_SA(1, 0), a3, voffA);
            PG8_BAR; PG8_WAIT_L(0); PG8_MMA(1, 0, At, B0); PG8_BAR; PG8_SCHED;
            PG8_STAGE(PG8_SB(1, 1), b3 + hstepB, voffB);
            PG8_WAIT_V(6); PG8_BAR; PG8_MMA(1, 1, At, B1); PG8_BAR;
        }
        bool keep = false;
        if constexpr (Epi::CHAIN) keep = E.chain(acc, cur, wr, wc, fr, fq); else E(acc, cur, wr, wc, fr, fq);
        if (!has_next) break;
        if (!keep) {
#pragma unroll
            for (int a = 0; a < 2; ++a)
#pragma unroll
                for (int b = 0; b < 2; ++b)
#pragma unroll
                    for (int m = 0; m < 4; ++m)
#pragma unroll
                        for (int n = 0; n < 2; ++n) acc[a][b][m][n] = (f32x4){0.f, 0.f, 0.f, 0.f};
        }
        cur = nxt; cA = nA; cB = nB; ++ui;
    }
    PG8_WAIT_V(0);
    if (wr == 0) PG8_BAR;
    PG8_BAR;
#undef PG8_SA
#undef PG8_SB
#undef PG8_STAGE
#undef PG8_LDA
#undef PG8_LDB
#undef PG8_MMA
#undef PG8_WAIT_V
#undef PG8_WAIT_L
#undef PG8_BAR
#undef PG8_SCHED
}

struct EpiBf {
    static constexpr bool PERM = true, CHAIN = false;
    bf16_t* O0; int ld0; int split; bf16_t* O1; int ld1; int act1;
    __device__ __forceinline__ void operator()(const f32x4 (&acc)[2][2][4][2], const Unit& u, int wr, int wc, int fr, int fq) const {
        const bool second = u.pn >= split;
        bf16_t* base = second ? O1 : O0; const int ld = second ? ld1 : ld0; const int colt = (second ? (u.pn - split) : u.pn) * BM;
        const bool act = second && act1;
        const int row0 = u.pm * BM + wr * 64 + fr, col0 = colt + wc * 32 + 8 * fq;
#pragma unroll
        for (int ai = 0; ai < 2; ++ai)
#pragma unroll
            for (int m = 0; m < 4; ++m) { bf16_t* rowp = base + (size_t)(row0 + ai * HALF + m * 16) * ld + col0;
#pragma unroll
                for (int bj = 0; bj < 2; ++bj) { f32x4 v0 = acc[ai][bj][m][0], v1 = acc[ai][bj][m][1];
                    if (act) {
#pragma unroll
                        for (int j = 0; j < 4; ++j) { v0[j] = sigmoidf_(v0[j]); v1[j] = sigmoidf_(v1[j]); } }
                    u32x4 w; w.x = cvt_pk_bf16(v0[0], v0[1]); w.y = cvt_pk_bf16(v0[2], v0[3]); w.z = cvt_pk_bf16(v1[0], v1[1]); w.w = cvt_pk_bf16(v1[2], v1[3]);
                    *(u32x4*)(rowp + bj * HALF) = w; } }
    }
};
struct EpiMerge {
    static constexpr bool PERM = true, CHAIN = true;
    bf16_t* M; const bf16_t* ZG;
    __device__ __forceinline__ bool chain(f32x4 (&acc)[2][2][4][2], const Unit& u, int wr, int wc, int fr, int fq) const {
        const int row0 = u.pm * BM + wr * 64 + fr, col0 = u.pn * BM + wc * 32 + 8 * fq;
        const bool last = u.tag == 2;
        const int tn = u.tag * 1024, td = (last ? 2 : u.tag + 1) * 1024;
        const float nlo = u.tag == 0 ? 0.f : 1e-12f;
#pragma unroll
        for (int am = 0; am < 4; ++am) { const int ai = am >> 1, m0 = 2 * (am & 1);
            u32x4 gn[2][2], gd[2][2];
            int ro = row0; asm volatile("" : "+v"(ro));
#pragma unroll
            for (int mm = 0; mm < 2; ++mm)
#pragma unroll
                for (int bj = 0; bj < 2; ++bj) { const bf16_t* gp = ZG + (size_t)(ro + ai * HALF + (m0 + mm) * 16) * 3072 + col0 + bj * HALF;
                    gn[mm][bj] = *(const u32x4*)(gp + tn); gd[mm][bj] = *(const u32x4*)(gp + td); }
#pragma unroll
            for (int mm = 0; mm < 2; ++mm)
#pragma unroll
                for (int bj = 0; bj < 2; ++bj) {
                    const u32x4 g = gn[mm][bj], h = gd[mm][bj];
                    const float nn[8] = {bflo(g.x), bfhi(g.x), bflo(g.y), bfhi(g.y), bflo(g.z), bfhi(g.z), bflo(g.w), bfhi(g.w)};
                    const float dd[8] = {bflo(h.x), bfhi(h.x), bflo(h.y), bfhi(h.y), bflo(h.z), bfhi(h.z), bflo(h.w), bfhi(h.w)};
                    float f[8];
#pragma unroll
                    for (int e = 0; e < 8; ++e) f[e] = fmaxf(nn[e], nlo) * __builtin_amdgcn_rcpf(last ? 1.0f : fmaxf(dd[e], 1e-12f));
                    f32x4& v0 = acc[ai][bj][m0 + mm][0]; f32x4& v1 = acc[ai][bj][m0 + mm][1];
                    v0[0] *= f[0]; v0[1] *= f[1]; v0[2] *= f[2]; v0[3] *= f[3]; v1[0] *= f[4]; v1[1] *= f[5]; v1[2] *= f[6]; v1[3] *= f[7];
                }
        }
        if (last) {
#pragma unroll
            for (int ai = 0; ai < 2; ++ai)
#pragma unroll
                for (int m = 0; m < 4; ++m) { const size_t r = (size_t)(row0 + ai * HALF + m * 16);
#pragma unroll
                    for (int bj = 0; bj < 2; ++bj) { const f32x4 v0 = acc[ai][bj][m][0], v1 = acc[ai][bj][m][1];
                        u32x4 w; w.x = cvt_pk_bf16(v0[0], v0[1]); w.y = cvt_pk_bf16(v0[2], v0[3]); w.z = cvt_pk_bf16(v1[0], v1[1]); w.w = cvt_pk_bf16(v1[2], v1[3]);
                        *(u32x4*)(M + r * 1024 + col0 + bj * HALF) = w; } }
        }
        return !last;
    }
};
struct EpiRes {
    static constexpr bool PERM = true, CHAIN = false;
    const float* xin32; const bf16_t* xin16; bf16_t* xout; const float* gate;
    template <bool F32>
    __device__ __forceinline__ void body(const f32x4 (&acc)[2][2][4][2], const Unit& u, int wr, int wc, int fr, int fq) const {
        const int row0 = u.pm * BM + wr * 64 + fr, col0 = u.pn * BM + wc * 32 + 8 * fq;
        const float* gp = gate + (size_t)(u.pm >> 4) * 6144 + col0;
        f32x4 gv[2][2];
#pragma unroll
        for (int bj = 0; bj < 2; ++bj) { gv[bj][0] = *(const f32x4*)(gp + bj * HALF); gv[bj][1] = *(const f32x4*)(gp + bj * HALF + 4); }
#pragma unroll
        for (int am = 0; am < 4; ++am) { const int ai = am >> 1, m0 = 2 * (am & 1);
            f32x4 xa[4][2][2]; u32x4 xw[4][2];
            int ro = row0; asm volatile("" : "+v"(ro));
#pragma unroll
            for (int m = m0; m < m0 + 2; ++m) { const size_t off = (size_t)(ro + ai * HALF + m * 16) * 1024 + col0;
#pragma unroll
                for (int bj = 0; bj < 2; ++bj) {
                    if (F32) { xa[m][bj][0] = *(const f32x4*)(xin32 + off + bj * HALF); xa[m][bj][1] = *(const f32x4*)(xin32 + off + bj * HALF + 4); }
                    else xw[m][bj] = *(const u32x4*)(xin16 + off + bj * HALF); } }
#pragma unroll
            for (int m = m0; m < m0 + 2; ++m) { const size_t off = (size_t)(ro + ai * HALF + m * 16) * 1024 + col0;
#pragma unroll
                for (int bj = 0; bj < 2; ++bj) {
                    f32x4 x0, x1;
                    if (F32) { x0 = xa[m][bj][0]; x1 = xa[m][bj][1]; }
                    else { const u32x4 w = xw[m][bj];
                        x0 = (f32x4){bflo(w.x), bfhi(w.x), bflo(w.y), bfhi(w.y)}; x1 = (f32x4){bflo(w.z), bfhi(w.z), bflo(w.w), bfhi(w.w)}; }
                    const f32x4 o0 = x0 + gv[bj][0] * acc[ai][bj][m][0], o1 = x1 + gv[bj][1] * acc[ai][bj][m][1];
                    u32x4 w; w.x = cvt_pk_bf16(o0[0], o0[1]); w.y = cvt_pk_bf16(o0[2], o0[3]); w.z = cvt_pk_bf16(o1[0], o1[1]); w.w = cvt_pk_bf16(o1[2], o1[3]);
                    *(u32x4*)(xout + off + bj * HALF) = w; } }
        }
    }
    __device__ __forceinline__ void operator()(const f32x4 (&acc)[2][2][4][2], const Unit& u, int wr, int wc, int fr, int fq) const {
        if (xin32) body<true>(acc, u, wr, wc, fr, fq); else body<false>(acc, u, wr, wc, fr, fq);
    }
};
__device__ __forceinline__ float dpp_prev(float x, float y, int n) {
    if (n == 1) { const int yr = __builtin_amdgcn_update_dpp(0, __float_as_int(y), 0x121, 0xf, 0xf, false);
                  return __int_as_float(__builtin_amdgcn_update_dpp(yr, __float_as_int(x), 0x111, 0xf, 0xf, false)); }
    const int yr = __builtin_amdgcn_update_dpp(0, __float_as_int(y), 0x122, 0xf, 0xf, false);
    return __int_as_float(__builtin_amdgcn_update_dpp(yr, __float_as_int(x), 0x112, 0xf, 0xf, false));
}
struct EpiUp {
    static constexpr bool PERM = true, CHAIN = false;
    bf16_t* U; float* HA; float* HB; const float* cw;
    __device__ __forceinline__ void operator()(const f32x4 (&acc)[2][2][4][2], const Unit& u, int wr, int wc, int fr, int fq) const {
        const int c0 = 128 * u.pn + 32 * wc + 8 * fq;
        float w0[8], w1[8], w2[8];
        { float f[24];
#pragma unroll
          for (int q = 0; q < 6; ++q) { const f32x4 v = *(const f32x4*)(cw + (size_t)c0 * 3 + 4 * q); f[4 * q] = v[0]; f[4 * q + 1] = v[1]; f[4 * q + 2] = v[2]; f[4 * q + 3] = v[3]; }
#pragma unroll
          for (int e = 0; e < 8; ++e) { w0[e] = f[3 * e]; w1[e] = f[3 * e + 1]; w2[e] = f[3 * e + 2]; } }
#pragma unroll
        for (int ai = 0; ai < 2; ++ai) {
            const int grp = 4 * u.pm + 2 * ai + wr;
            float Y[8];
#pragma unroll
            for (int e = 0; e < 8; ++e) Y[e] = 0.f;
#pragma unroll
            for (int m = 0; m < 4; ++m) {
                const size_t row = (size_t)u.pm * BM + ai * HALF + wr * 64 + m * 16 + fr;
                float X[8], G[8], o[8];
#pragma unroll
                for (int e = 0; e < 8; ++e) { X[e] = acc[ai][0][m][e >> 2][e & 3]; G[e] = acc[ai][1][m][e >> 2][e & 3]; }
#pragma unroll
                for (int e = 0; e < 8; ++e) { const float a1 = dpp_prev(X[e], Y[e], 1), a2 = dpp_prev(X[e], Y[e], 2);
                    const float s = w0[e] * a2 + w1[e] * a1 + w2[e] * X[e]; o[e] = s * sigmoidf_(s) * G[e]; }
                if (m > 0 || fr >= 2) { u32x4 w; w.x = cvt_pk_bf16(o[0], o[1]); w.y = cvt_pk_bf16(o[2], o[3]); w.z = cvt_pk_bf16(o[4], o[5]); w.w = cvt_pk_bf16(o[6], o[7]);
                    *(u32x4*)(U + row * DFF + c0) = w; }
                if (m == 0 && fr < 2) { float* hb = HB + ((size_t)(grp * 2 + fr) * 2) * DFF + c0;
                    *(f32x4*)hb = (f32x4){X[0], X[1], X[2], X[3]}; *(f32x4*)(hb + 4) = (f32x4){X[4], X[5], X[6], X[7]};
                    *(f32x4*)(hb + DFF) = (f32x4){G[0], G[1], G[2], G[3]}; *(f32x4*)(hb + DFF + 4) = (f32x4){G[4], G[5], G[6], G[7]}; }
                if (m == 3 && fr >= 14) { float* ha = HA + (size_t)(grp * 2 + fr - 14) * DFF + c0;
                    *(f32x4*)ha = (f32x4){X[0], X[1], X[2], X[3]}; *(f32x4*)(ha + 4) = (f32x4){X[4], X[5], X[6], X[7]}; }
#pragma unroll
                for (int e = 0; e < 8; ++e) Y[e] = X[e];
            }
        }
    }
};
struct MergeOrder {
    int G, c; const char* o_att; const char* wbr;
    __device__ bool next(int i, Unit& u) const {
        const int tile = (i / 3) * G + c; if (tile >= (T_ / BM) * 4) return false;
        const int br = i % 3; u.pm = tile >> 2; u.pn = tile & 3; u.tag = br;
        u.A = o_att - (size_t)br * (32 * MiB) + (size_t)u.pm * BM * 512 * 2;
        u.B = wbr + (size_t)br * 1024 * 512 * 2 + (size_t)u.pn * BM * 512 * 2; return true;
    }
};
}

#define GSTRIDE_BLOCKS(var, n) for (int var = blockIdx.x; var < (n); var += gridDim.x)

__device__ __forceinline__ void ph_mod(const Params& P, LAS unsigned char* lds) {
    LAS float* cl = (LAS float*)lds;
    LAS float* red = cl + 8192;
    float* mod = (float*)(P.ws + OFF_MOD); float* tab = (float*)(P.ws + OFF_TAB);
    const int tid = opaque_tid(), wid = tid >> 6, lane = tid & 63;
    for (int i = tid; i < 2048; i += NTHR) ((LAS f32x4*)cl)[i] = ((const f32x4*)P.c)[i];
    __syncthreads();
    GSTRIDE_BLOCKS(blk, 192) {
        const int l = blk / 96, jb = blk % 96, j = jb * 64 + lane;
        float acc[8];
#pragma unroll
        for (int b = 0; b < 8; ++b) acc[b] = 0.f;
        const float* aw = P.ada_w + (size_t)l * 1024 * 6144 + j;
#pragma unroll 1
        for (int k = wid * 128; k < wid * 128 + 128; k += 32) {
            float w[32];
#pragma unroll
            for (int u = 0; u < 32; ++u) w[u] = aw[(size_t)(k + u) * 6144];
#pragma unroll
            for (int u4 = 0; u4 < 8; ++u4)
#pragma unroll
                for (int b = 0; b < 8; ++b) { const f32x4 c4 = *(const LAS f32x4*)(cl + b * 1024 + k + 4 * u4);
                    acc[b] += c4.x * w[4 * u4]; acc[b] += c4.y * w[4 * u4 + 1]; acc[b] += c4.z * w[4 * u4 + 2]; acc[b] += c4.w * w[4 * u4 + 3]; }
        }
#pragma unroll
        for (int b = 0; b < 8; ++b) red[(wid * 8 + b) * 64 + lane] = acc[b];
        __syncthreads();
        { const int b = wid; float s = P.ada_b[l * 6144 + j];
#pragma unroll
          for (int w = 0; w < 8; ++w) s += red[(w * 8 + b) * 64 + lane];
          mod[((size_t)l * 8 + b) * 6144 + j] = s; }
        __syncthreads();
    }
    if (blockIdx.x == gridDim.x - 1) {
        for (int i = tid; i < 1024; i += NTHR) { const int n = i >> 3, h = i & 7; int bk;
            if (n < 16) bk = n; else { const float nf = (float)n; bk = 16 + (int)(logf(nf / 16.0f) / 2.0794415416798357f * 16.0f); bk = bk < 31 ? bk : 31; }
            tab[i] = P.rel_bias[bk * 8 + h]; }
    }
}

struct WJob { const float* src; int ldsrc; int K; int N; bf16_t* dst; int win; };
__device__ __forceinline__ int wjob_col(const WJob& J, const int nn) {
    int col = nn;
    if (J.win == 1) col = nn < 2120 ? nn : (nn < 2304 ? -1 : nn - 184);
    if (J.win == 2) col = ((nn & 255) < 128) ? 128 * (nn >> 8) + (nn & 127) : DFF + 128 * (nn >> 8) + (nn & 127);
    return col;
}
template <int KT  >
__device__ __forceinline__ void wtile_load(const WJob& J, const int lt, const int tid, float (&v)[KT / 8]) {
    const int nkt = J.K / KT, kt = lt % nkt, ntb = lt / nkt, k0 = kt * KT, n0 = ntb * 64;
    const int n = tid & 63, kk0 = tid >> 6; const int col = wjob_col(J, n0 + n);
#pragma unroll
    for (int p = 0; p < KT / 8; ++p) { const int k = kk0 + 8 * p; v[p] = col >= 0 ? J.src[(size_t)(k0 + k) * J.ldsrc + col] : 0.f; }
}
template <int KT>
__device__ __forceinline__ void wtile_put(LAS float* tile  , const int tid, const float (&v)[KT / 8]) {
    const int n = tid & 63, kk0 = tid >> 6;
#pragma unroll
    for (int p = 0; p < KT / 8; ++p) tile[(kk0 + 8 * p) * 65 + n] = v[p];
}
template <int KT>
__device__ __forceinline__ void wtile_out(const WJob& J, const int lt, const int tid, const LAS float* tile) {
    const int nkt = J.K / KT, kt = lt % nkt, ntb = lt / nkt, k0 = kt * KT, n0 = ntb * 64;
#pragma unroll
    for (int q = 0; q < KT / 64; ++q) { const int n = tid >> 3, kg = (tid & 7) + 8 * q; float v[8];
#pragma unroll
      for (int e = 0; e < 8; ++e) v[e] = tile[(kg * 8 + e) * 65 + n];
      u32x4 w; w.x = cvt_pk_bf16(v[0], v[1]); w.y = cvt_pk_bf16(v[2], v[3]); w.z = cvt_pk_bf16(v[4], v[5]); w.w = cvt_pk_bf16(v[6], v[7]);
      *(u32x4*)(J.dst + (size_t)(n0 + n) * J.K + k0 + kg * 8) = w; }
}
__device__ __forceinline__ void ph_wconv(const Params& P, int l, LAS unsigned char* lds) {
    LAS float* tile = (LAS float*)lds; unsigned char* wb = P.ws + OFF_WB;
    const int tid = opaque_tid();
    constexpr int NBIG = 1232;
    auto big_job = [&](const int ti, WJob& J, int& lt) {
        if (ti < 544) { J = WJob{P.w_in + (size_t)l * 1024 * IN_COLS, IN_COLS, 1024, 8704, (bf16_t*)(wb + WB_WIN), 1}; lt = ti; }
        else if (ti < 640) { const int i = (ti - 544) >> 5; J = WJob{P.w_branch + ((size_t)l * 3 + i) * 512 * 1024, 1024, 512, 1024, (bf16_t*)(wb + WB_WBR) + (size_t)i * 1024 * 512, 0}; lt = (ti - 544) & 31; }
        else if (ti < 704) { J = WJob{P.w_o + (size_t)l * 1024 * 1024, 1024, 1024, 1024, (bf16_t*)(wb + WB_WO), 0}; lt = ti - 640; }
        else if (ti < 1056) { J = WJob{P.ffn_w_up + (size_t)l * 1024 * 5632, 5632, 1024, 5632, (bf16_t*)(wb + WB_WUP), 2}; lt = ti - 704; }
        else { J = WJob{P.ffn_w_down + (size_t)l * 2816 * 1024, 1024, 2816, 1024, (bf16_t*)(wb + WB_WDN), 0}; lt = ti - 1056; } };
    {
        int ti = blockIdx.x; WJob J; int lt; float v[32];
        big_job(ti, J, lt); wtile_load<256>(J, lt, tid, v);
        for (;;) {
            wtile_put<256>(tile, tid, v);
            __syncthreads();
            const int tn = ti + gridDim.x; const bool more = tn < NBIG; WJob Jn = J; int ltn = lt;
            if (more) { big_job(tn, Jn, ltn); wtile_load<256>(Jn, ltn, tid, v); }
            wtile_out<256>(J, lt, tid, tile);
            __syncthreads();
            if (!more) break;
            J = Jn; lt = ltn; ti = tn;
        }
    }
    for (int ts = gridDim.x - 1 - blockIdx.x; ts < 32; ts += gridDim.x) {
        WJob J; int lt;
        if (ts < 8) { J = WJob{P.w_up + (size_t)l * 64 * 512, 512, 64, 512, (bf16_t*)(wb + WB_LW), 0}; lt = ts; }
        else if (ts < 16) { J = WJob{P.a_up + (size_t)l * 64 * 512, 512, 64, 512, (bf16_t*)(wb + WB_LA), 0}; lt = ts - 8; }
        else { J = WJob{P.g_up + (size_t)l * 128 * 512, 512, 128, 512, (bf16_t*)(wb + WB_LG), 0}; lt = ts - 16; }
        float v[8];
        wtile_load<64>(J, lt, tid, v); wtile_put<64>(tile, tid, v);
        __syncthreads();
        wtile_out<64>(J, lt, tid, tile);
        __syncthreads();
    }
}

__device__ __forceinline__ void ph_norm(const Params& P, int l, int which) {
    const bool first = (l == 0 && which == 0);
    const float* nw = (which == 0 ? P.norm_mix : P.norm_ffn) + l * 1024;
    const float* mod = (const float*)(P.ws + OFF_MOD) + (size_t)l * 8 * 6144 + which * 3072;
    const bf16_t* XB = (const bf16_t*)P.out;
    bf16_t* H = (bf16_t*)(P.ws + OFF_H);
    const int tid = opaque_tid(), wid = tid >> 6, lane = tid & 63;
    for (int row = blockIdx.x * 8 + wid; row < T_; row += gridDim.x * 8) {
        const int b = row >> 12; const float* mb = mod + (size_t)b * 6144;
        f32x4 v[4]; float ss = 0.f;
#pragma unroll
        for (int i = 0; i < 4; ++i) {
            if (first) v[i] = *(const f32x4*)(P.x_in + (size_t)row * 1024 + i * 256 + lane * 4);
            else { const u32x2 w = *(const u32x2*)(XB + (size_t)row * 1024 + i * 256 + lane * 4); v[i] = (f32x4){bflo(w.x), bfhi(w.x), bflo(w.y), bfhi(w.y)}; }
            ss += v[i][0] * v[i][0] + v[i][1] * v[i][1] + v[i][2] * v[i][2] + v[i][3] * v[i][3]; }
        ss = wave_sum(ss, lane);
        const float rstd = rsqrtf(ss * (1.0f / 1024.0f) + 1e-6f);
#pragma unroll
        for (int i = 0; i < 4; ++i) { const int c = i * 256 + lane * 4;
            const f32x4 g = *(const f32x4*)(nw + c), sh = *(const f32x4*)(mb + c), sc = *(const f32x4*)(mb + 1024 + c);
            const f32x4 y = v[i] * rstd * g * (sc + 1.0f) + sh;
            u32x2 w; w.x = cvt_pk_bf16(y[0], y[1]); w.y = cvt_pk_bf16(y[2], y[3]);
            *(u32x2*)(H + (size_t)row * 1024 + c) = w; }
    }
}

__device__ __forceinline__ void ph_final(const Params& P) {
    const bf16_t* XF = (const bf16_t*)(P.ws + OFF_H);
    const int tid = opaque_tid(), wid = tid >> 6, lane = tid & 63;
    for (int row = blockIdx.x * 8 + wid; row < T_; row += gridDim.x * 8) {
        float* xr = P.out + (size_t)row * 1024;
        f32x4 v[4]; float ss = 0.f;
#pragma unroll
        for (int i = 0; i < 4; ++i) { const u32x2 w = *(const u32x2*)(XF + (size_t)row * 1024 + i * 256 + lane * 4); v[i] = (f32x4){bflo(w.x), bfhi(w.x), bflo(w.y), bfhi(w.y)};
            ss += v[i][0] * v[i][0] + v[i][1] * v[i][1] + v[i][2] * v[i][2] + v[i][3] * v[i][3]; }
        ss = wave_sum(ss, lane);
        const float rstd = rsqrtf(ss * (1.0f / 1024.0f) + 1e-6f);
#pragma unroll
        for (int i = 0; i < 4; ++i) { const int c = i * 256 + lane * 4; const f32x4 g = *(const f32x4*)(P.final_norm + c);
            *(f32x4*)(xr + c) = v[i] * rstd * g; }
    }
}

__device__ __forceinline__ void ph_gemm_zq(const Params& P, LAS unsigned char* lds) {
    g8::SOrder S; S.init(T_, 2304, 1024, 1024, P.ws + OFF_H, P.ws + OFF_WB + WB_WIN);
    g8::EpiBf E{(bf16_t*)(P.ws + OFF_ZQ), 2304, 9, nullptr, 0, 0};
    g8::gemm_phase(lds, 1024, 1024, 1024, S, E);
}
__device__ __forceinline__ void ph_gemm_zr(const Params& P, LAS unsigned char* lds) {
    g8::SOrder S; S.init(T_, 1792, 1024, 1024, P.ws + OFF_H, P.ws + OFF_WB + WB_WIN + (size_t)2304 * 1024 * 2);
    g8::EpiBf E{(bf16_t*)(P.ws + OFF_ZR), 1792, 7, nullptr, 0, 0};
    g8::gemm_phase(lds, 1024, 1024, 1024, S, E);
}
__device__ __forceinline__ void ph_gemm_zc(const Params& P, LAS unsigned char* lds) {
    g8::SOrder S; S.init(T_, 4608, 1024, 1024, P.ws + OFF_H, P.ws + OFF_WB + WB_WIN + (size_t)4096 * 1024 * 2);
    g8::EpiBf E{(bf16_t*)(P.ws + OFF_ZCV), 1536, 6, (bf16_t*)(P.ws + OFF_ZG), 3072, 1};
    g8::gemm_phase(lds, 1024, 1024, 1024, S, E);
}
__device__ __forceinline__ void ph_gemm_merge(const Params& P, LAS unsigned char* lds) {
    g8::MergeOrder S{(int)gridDim.x, (int)blockIdx.x, (const char*)(P.ws + OFF_OATT), (const char*)(P.ws + OFF_WB + WB_WBR)};
    g8::EpiMerge E{(bf16_t*)(P.ws + OFF_MRG), (const bf16_t*)(P.ws + OFF_ZG)};
    g8::gemm_phase(lds, 512, 512, 512, S, E);
}
__device__ __forceinline__ void ph_gemm_wo(const Params& P, int l, LAS unsigned char* lds) {
    g8::SOrder S; S.init(T_, 1024, 1024, 1024, P.ws + OFF_MRG, P.ws + OFF_WB + WB_WO);
    g8::EpiRes E{l == 0 ? P.x_in : nullptr, (const bf16_t*)P.out, (bf16_t*)P.out, (const float*)(P.ws + OFF_MOD) + (size_t)l * 8 * 6144 + 2048};
    g8::gemm_phase(lds, 1024, 1024, 1024, S, E);
}
__device__ __forceinline__ void ph_gemm_up(const Params& P, int l, LAS unsigned char* lds) {
    g8::SOrder S; S.init(T_, 5632, 1024, 1024, P.ws + OFF_H, P.ws + OFF_WB + WB_WUP);
    g8::EpiUp E{(bf16_t*)(P.ws + OFF_UP), (float*)(P.ws + OFF_HA), (float*)(P.ws + OFF_HB), P.ffn_conv_w + (size_t)l * DFF * 3};
    g8::gemm_phase(lds, 1024, 1024, 1024, S, E);
}
__device__ __forceinline__ void ph_gemm_down(const Params& P, int l, LAS unsigned char* lds) {
    g8::SOrder S; S.init(T_, 1024, 2816, 2816, P.ws + OFF_UP, P.ws + OFF_WB + WB_WDN);
    g8::EpiRes E{nullptr, (const bf16_t*)P.out, l == 1 ? (bf16_t*)(P.ws + OFF_H) : (bf16_t*)P.out, (const float*)(P.ws + OFF_MOD) + (size_t)l * 8 * 6144 + 5120};
    g8::gemm_phase(lds, 2816, 2816, 2816, S, E);
}

__device__ __forceinline__ void ph_conv(const Params& P, int l, LAS unsigned char* lds) {
    const bf16_t* Z = (const bf16_t*)(P.ws + OFF_ZCV); bf16_t* O = (bf16_t*)(P.ws + OFF_OCONV);
    LAS float* cwT = (LAS float*)lds;
    const int tid = opaque_tid();
    for (int i = tid; i < 1536; i += NTHR) cwT[(i % 3) * 512 + i / 3] = P.sc_conv_w[(size_t)l * 1536 + i];
    __syncthreads();
    constexpr int RB = 16; const int nitem = (T_ / RB) * 64;
    for (int it = blockIdx.x * NTHR + tid; it < nitem; it += gridDim.x * NTHR) {
        const int rb = it >> 6, c0 = (it & 63) * 8, row0 = rb * RB, t0 = row0 & 4095;
        float w0[8], w1[8], w2[8];
#pragma unroll
        for (int e = 0; e < 8; ++e) { w0[e] = cwT[c0 + e]; w1[e] = cwT[512 + c0 + e]; w2[e] = cwT[1024 + c0 + e]; }
        float pm2[8], pm1[8];
#pragma unroll
        for (int e = 0; e < 8; ++e) { pm2[e] = 0.f; pm1[e] = 0.f; }
        if (t0 >= 2) {
#pragma unroll
            for (int j = 0; j < 2; ++j) { const bf16_t* zr = Z + (size_t)(row0 - 2 + j) * 1536;
                const u32x4 cc = *(const u32x4*)(zr + 512 + c0), cx = *(const u32x4*)(zr + 1024 + c0);
                const unsigned ccw[4] = {cc.x, cc.y, cc.z, cc.w}, cxw[4] = {cx.x, cx.y, cx.z, cx.w};
#pragma unroll
                for (int q = 0; q < 4; ++q) { const float a = bflo(ccw[q]) * bflo(cxw[q]), b2 = bfhi(ccw[q]) * bfhi(cxw[q]);
                    if (j == 0) { pm2[2 * q] = a; pm2[2 * q + 1] = b2; } else { pm1[2 * q] = a; pm1[2 * q + 1] = b2; } } }
        }
#pragma unroll 4
        for (int r = 0; r < RB; ++r) {
            const bf16_t* zr = Z + (size_t)(row0 + r) * 1536;
            const u32x4 cb = *(const u32x4*)(zr + c0), cc = *(const u32x4*)(zr + 512 + c0), cx = *(const u32x4*)(zr + 1024 + c0);
            const unsigned cbw[4] = {cb.x, cb.y, cb.z, cb.w}, ccw[4] = {cc.x, cc.y, cc.z, cc.w}, cxw[4] = {cx.x, cx.y, cx.z, cx.w};
            float cur[8], o[8];
#pragma unroll
            for (int q = 0; q < 4; ++q) { cur[2 * q] = bflo(ccw[q]) * bflo(cxw[q]); cur[2 * q + 1] = bfhi(ccw[q]) * bfhi(cxw[q]); }
#pragma unroll
            for (int e = 0; e < 8; ++e) { o[e] = w0[e] * pm2[e] + w1[e] * pm1[e] + w2[e] * cur[e]; pm2[e] = pm1[e]; pm1[e] = cur[e]; }
            u32x4 w; w.x = cvt_pk_bf16(o[0] * bflo(cbw[0]), o[1] * bfhi(cbw[0])); w.y = cvt_pk_bf16(o[2] * bflo(cbw[1]), o[3] * bfhi(cbw[1]));
            w.z = cvt_pk_bf16(o[4] * bflo(cbw[2]), o[5] * bfhi(cbw[2])); w.w = cvt_pk_bf16(o[6] * bflo(cbw[3]), o[7] * bfhi(cbw[3]));
            *(u32x4*)(O + (size_t)(row0 + r) * 512 + c0) = w;
        }
    }
}

__device__ __forceinline__ void ph_ufix(const Params& P, int l, LAS unsigned char* lds) {
    bf16_t* U = (bf16_t*)(P.ws + OFF_UP); const float* HA = (const float*)(P.ws + OFF_HA); const float* HB = (const float*)(P.ws + OFF_HB);
    LAS float* cwT = (LAS float*)lds;
    const int tid = opaque_tid();
    for (int i = tid; i < DFF * 3; i += NTHR) cwT[(i % 3) * DFF + i / 3] = P.ffn_conv_w[(size_t)l * DFF * 3 + i];
    __syncthreads();
    const int nitem = (T_ / 64) * 2 * 352;
    for (int it = blockIdx.x * NTHR + tid; it < nitem; it += gridDim.x * NTHR) {
        const int c0 = (it % 352) * 8, gr = it / 352, grp = gr >> 1, rr = gr & 1; const bool first = (grp & 63) == 0;
        const float* hb = HB + ((size_t)(grp * 2 + rr) * 2) * DFF + c0;
        float a0[8], a1[8], a2[8], g[8];
#pragma unroll
        for (int q = 0; q < 2; ++q) { const f32x4 va = *(const f32x4*)(hb + 4 * q), vg = *(const f32x4*)(hb + DFF + 4 * q);
#pragma unroll
            for (int e = 0; e < 4; ++e) { a0[4 * q + e] = va[e]; g[4 * q + e] = vg[e]; a1[4 * q + e] = 0.f; a2[4 * q + e] = 0.f; } }
        if (rr == 1) { const float* p1 = HB + ((size_t)(grp * 2) * 2) * DFF + c0;
#pragma unroll
            for (int q = 0; q < 2; ++q) { const f32x4 v = *(const f32x4*)(p1 + 4 * q);
#pragma unroll
                for (int e = 0; e < 4; ++e) a1[4 * q + e] = v[e]; } }
        if (!first) {
            const float* pl = HA + (size_t)((grp - 1) * 2 + 1) * DFF + c0;
            const float* pk = HA + (size_t)((grp - 1) * 2) * DFF + c0;
#pragma unroll
            for (int q = 0; q < 2; ++q) { const f32x4 v63 = *(const f32x4*)(pl + 4 * q), v62 = *(const f32x4*)(pk + 4 * q);
#pragma unroll
                for (int e = 0; e < 4; ++e) { if (rr == 1) a2[4 * q + e] = v63[e]; else { a1[4 * q + e] = v63[e]; a2[4 * q + e] = v62[e]; } } }
        }
        float o[8];
#pragma unroll
        for (int e = 0; e < 8; ++e) { const float s = cwT[c0 + e] * a2[e] + cwT[DFF + c0 + e] * a1[e] + cwT[2 * DFF + c0 + e] * a0[e]; o[e] = s * sigmoidf_(s) * g[e]; }
        u32x4 w; w.x = cvt_pk_bf16(o[0], o[1]); w.y = cvt_pk_bf16(o[2], o[3]); w.z = cvt_pk_bf16(o[4], o[5]); w.w = cvt_pk_bf16(o[6], o[7]);
        *(u32x4*)(U + (size_t)(grp * 64 + rr) * DFF + c0) = w;
    }
}

template <int NR>
__device__ __forceinline__ u64 select_row(LAS float* row, const int t, const int lz) {
    const int imax = t >> 6;
    float x[NR]; float Tx = 0.f; bool have = false, exact = false;
    {
        int bin[NR]; float lo = __builtin_inff(), hi = -__builtin_inff();
        LAS unsigned* hist = (LAS unsigned*)row;
#pragma unroll
        for (int i = 0; i < NR; ++i) { const float v = row[64 * i + lz]; x[i] = (i <= imax) ? v : -__builtin_inff(); hi = fmaxf(hi, x[i]); lo = fminf(lo, (i < imax || x[i] > -__builtin_inff()) ? x[i] : __builtin_inff()); }
#pragma unroll
        for (int o = 32; o >= 1; o >>= 1) { lo = fminf(lo, shx(lo, o, lz)); hi = fmaxf(hi, shx(hi, o, lz)); }
        if (hi > lo) {
            const float scale = 4095.0f / (hi - lo);
#pragma unroll
            for (int q = 0; q < 16; ++q) *(LAS u32x4*)(hist + 256 * q + 4 * lz) = (u32x4){0u, 0u, 0u, 0u};
#pragma unroll
            for (int i = 0; i < NR; ++i) {
                const int bq = (int)fminf(fmaxf((x[i] - lo) * scale, -1.0f), 4095.0f); bin[i] = bq;
                if (bq >= 0) __hip_atomic_fetch_add(hist + bq, 1u, __ATOMIC_RELAXED, __HIP_MEMORY_SCOPE_WORKGROUP); }
            unsigned c1 = 0u;
#pragma unroll
            for (int q = 0; q < 16; ++q) { const u32x4 h4 = *(const LAS u32x4*)(hist + 64 * lz + 4 * ((q + lz) & 15)); c1 += (h4.x + h4.y) + (h4.z + h4.w); }
            unsigned inc = c1;
#pragma unroll
            for (int o = 1; o <= 32; o <<= 1) { const unsigned v = (unsigned)__builtin_amdgcn_ds_bpermute(((lz + o) & 63) << 2, (int)inc); inc += (lz + o < 64) ? v : 0u; }
            const unsigned ab1 = inc - c1;
            const u64 cr1 = __ballot(ab1 < 256u && ab1 + c1 >= 256u);
            const int L1 = __builtin_ctzll(cr1);
            const unsigned abL = (unsigned)__builtin_amdgcn_readlane((int)ab1, L1);
            const unsigned c2 = hist[64 * L1 + lz];
            unsigned inc2 = c2;
#pragma unroll
            for (int o = 1; o <= 32; o <<= 1) { const unsigned v = (unsigned)__builtin_amdgcn_ds_bpermute(((lz + o) & 63) << 2, (int)inc2); inc2 += (lz + o < 64) ? v : 0u; }
            const unsigned ab2 = inc2 - c2 + abL;
            const u64 cr2 = __ballot(ab2 < 256u && ab2 + c2 >= 256u);
            const int L2 = __builtin_ctzll(cr2);
            const int bstar = 64 * L1 + L2;
            const int cb = __builtin_amdgcn_readlane((int)c2, L2), need2 = 256 - __builtin_amdgcn_readlane((int)ab2, L2);
            if (cb <= 64) {
                int cand = 0; int pos = 0;
#pragma unroll
                for (int i = 0; i < NR; ++i) { u64 mm = __ballot(bin[i] == bstar);
                    while (mm) { const int s = __builtin_ctzll(mm); mm &= mm - 1ull; cand = writelane_v(cand, __builtin_amdgcn_readlane(__float_as_int(x[i]), s), pos); ++pos; } }
                const unsigned cu = (lz < cb) ? f2ord(__int_as_float(cand)) : 0u;
                unsigned Tc = 0u;
#pragma unroll 1
                for (int bit = 31; bit >= 0; --bit) { const unsigned cd = Tc | (1u << bit); if ((int)__popcll(__ballot(cu >= cd)) >= need2) Tc = cd; }
                Tx = ord2f(Tc); have = true; exact = (256 - need2) + (int)__popcll(__ballot(cu >= Tc)) == 256;
            }
        }
    }
    if (!have) {
        unsigned Tt = 0u;
#pragma unroll 1
        for (int bit = 31; bit >= 0; --bit) {
            const unsigned cand = Tt | (1u << bit); int cnt = 0;
#pragma unroll
            for (int i = 0; i < NR; ++i) cnt += __popcll(__ballot(f2ord(x[i]) >= cand));
            if (cnt >= 256) Tt = cand;
        }
        Tx = ord2f(Tt);
    }
    int wlo = 0, whi = 0;
#pragma unroll
    for (int i = 0; i < NR; ++i) { const u64 g = __ballot(x[i] >= Tx); writelane_c2(wlo, whi, (int)(unsigned)g, (int)(unsigned)(g >> 32), i); }
    u64 myw = ((u64)(unsigned)whi << 32) | (unsigned)wlo;
    if (!exact) {
        int cgt = 0;
#pragma unroll
        for (int i = 0; i < NR; ++i) cgt += __popcll(__ballot(x[i] > Tx));
        int need = 256 - cgt; myw = 0ull;
#pragma unroll
        for (int i = 0; i < NR; ++i) {
            const u64 g = __ballot(x[i] > Tx); u64 e = __ballot(x[i] == Tx);
            int ne = __popcll(e);
            while (ne > need) { e &= ~(1ull << (63 - __clzll(e))); --ne; }
            need -= ne;
            if (lz == i) myw = g | e;
        }
    }
    return myw;
}

__device__ __forceinline__ void ph_ki(const Params& P, LAS unsigned char* lds) {
    const bf16_t* ZQ = (const bf16_t*)(P.ws + OFF_ZQ);
    const int tid = opaque_tid();
    { int* KPM = (int*)(P.ws + OFF_KPM);
      for (int i = blockIdx.x * NTHR + tid; i < NB_ * 64; i += gridDim.x * NTHR) { const int* pp = P.pos + (i >> 6) * S_ + (i & 63) * 64; int mxp = pp[0];
          for (int k = 1; k < 64; ++k) mxp = pp[k] > mxp ? pp[k] : mxp;
          KPM[i] = mxp; } }
    {
        bf16_t* KI = (bf16_t*)(P.ws + OFF_KI);
        for (int i = blockIdx.x * NTHR + tid; i < T_ * 8; i += gridDim.x * NTHR) {
            const int key = i >> 3, c = i & 7;
            const u32x4 v = *(const u32x4*)(ZQ + (size_t)key * 2304 + 2048 + 8 * c);
            *(u32x4*)(KI + ((size_t)((key >> 5) * 4 + (c >> 1)) * 64 + (key & 31) + 32 * (c & 1)) * 8) = v;
        }
    }
    {
        LAS bf16_t* tl = (LAS bf16_t*)lds;
        bf16_t* VT = (bf16_t*)(P.ws + OFF_VT);
        for (int it = blockIdx.x; it < NB_ * 8 * 64; it += gridDim.x) {
            const int b = it >> 9, h = (it >> 6) & 7, k0 = (it & 63) * 64;
            { const int row = tid >> 3, ch = tid & 7;
              const u32x4 v = *(const u32x4*)(ZQ + (size_t)(b * S_ + k0 + row) * 2304 + 1024 + h * 64 + ch * 8);
              *(LAS u32x4*)(tl + row * 72 + ch * 8) = v; }
            __syncthreads();
            { const int d = tid >> 3, kc = tid & 7; unsigned short e[8];
#pragma unroll
              for (int q = 0; q < 8; ++q) e[q] = tl[(kc * 8 + q) * 72 + d];
              u32x4 w; w.x = e[0] | ((unsigned)e[1] << 16); w.y = e[2] | ((unsigned)e[3] << 16); w.z = e[4] | ((unsigned)e[5] << 16); w.w = e[6] | ((unsigned)e[7] << 16);
              *(u32x4*)(VT + ((size_t)((b * 8 + h) * 64 + d)) * S_ + k0 + kc * 8) = w; }
            __syncthreads();
        }
    }
}

__device__ __forceinline__ void ph_idx(const Params& P, LAS unsigned char* lds) {
    LAS float* SC = (LAS float*)lds;
    const bf16_t* ZQ = (const bf16_t*)(P.ws + OFF_ZQ); u64* MASK = (u64*)(P.ws + OFF_MASK); const bf16_t* KI = (const bf16_t*)(P.ws + OFF_KI);
    const int tid = opaque_tid(), wid = __builtin_amdgcn_readfirstlane(tid >> 6), lane = tid & 63, m = lane & 31, hh = lane >> 5;
    int itc = 0;
    for (int idx = blockIdx.x; idx < NB_ * 512; idx += gridDim.x, ++itc) {
        const int b = idx & 7, j = idx >> 3; const int qb = (itc & 1) ? (j ^ 31) : j; const int t0 = qb * 8;
        const bf16_t* zb = ZQ + (size_t)b * S_ * 2304;
        bf16x8 Af[2][4]; float wv[2][16];
#pragma unroll
        for (int blk = 0; blk < 2; ++blk) {
            const bf16_t* qp = zb + (size_t)(t0 + 4 * blk + 2 * ((m >> 2) & 1) + (m >> 4)) * 2304 + 1536 + (4 * ((m >> 3) & 1) + (m & 3)) * 64 + 8 * hh;
#pragma unroll
            for (int ks = 0; ks < 4; ++ks) Af[blk][ks] = *(const bf16x8*)(qp + 16 * ks);
#pragma unroll
            for (int q = 0; q < 2; ++q) { const u32x4 ww = *(const u32x4*)(zb + (size_t)(t0 + 4 * blk + 2 * hh + q) * 2304 + 2112);
                wv[blk][8 * q + 0] = bflo(ww.x); wv[blk][8 * q + 1] = bfhi(ww.x); wv[blk][8 * q + 2] = bflo(ww.y); wv[blk][8 * q + 3] = bfhi(ww.y);
                wv[blk][8 * q + 4] = bflo(ww.z); wv[blk][8 * q + 5] = bfhi(ww.z); wv[blk][8 * q + 6] = bflo(ww.w); wv[blk][8 * q + 7] = bfhi(ww.w); }
        }
        const int ntile = 2 * ((t0 + 7) / 64 + 1);
        {
#define IDX_GLD(B, KT) do { const int kc_ = (KT) < ntile ? (KT) : ntile - 1; const bf16_t* kp_ = KI + ((size_t)((b * 128 + kc_) * 4) * 64 + lane) * 8; \
            asm volatile("global_load_dwordx4 %0, %4, off\n\tglobal_load_dwordx4 %1, %4, off offset:1024\n\tglobal_load_dwordx4 %2, %4, off offset:2048\n\tglobal_load_dwordx4 %3, %4, off offset:3072" \
                : "=&v"(B[0]), "=&v"(B[1]), "=&v"(B[2]), "=&v"(B[3]) : "v"(kp_)); } while (0)
#define IDX_GLW(B, N) asm volatile("s_waitcnt vmcnt(" #N ")" : "+v"(B[0]), "+v"(B[1]), "+v"(B[2]), "+v"(B[3]))
            auto score_tile = [&](const bf16x8 (&Bf)[4], const int kt) {
                f32x16 Dw[2];
#pragma unroll
                for (int r = 0; r < 16; ++r) { Dw[0][r] = 0.f; Dw[1][r] = 0.f; }
#pragma unroll
                for (int ks = 0; ks < 4; ++ks) {
                    Dw[0] = __builtin_amdgcn_mfma_f32_32x32x16_bf16(Af[0][ks], Bf[ks], Dw[0], 0, 0, 0);
                    Dw[1] = __builtin_amdgcn_mfma_f32_32x32x16_bf16(Af[1][ks], Bf[ks], Dw[1], 0, 0, 0); }
#pragma unroll
                for (int blk = 0; blk < 2; ++blk) {
                    const f32x16 Dv = Dw[blk];
#pragma unroll
                    for (int q = 0; q < 2; ++q) {
                        float part = 0.f;
#pragma unroll
                        for (int e = 0; e < 8; ++e) { const float d = Dv[8 * q + e], w = wv[blk][8 * q + e]; part = __builtin_fmaf(w, d, part); part = __builtin_fmaf(w, __builtin_fabsf(d), part); }
                        SC[(4 * blk + 2 * hh + q) * 4096 + 32 * kt + m] = (32 * kt + m <= t0 + 4 * blk + 2 * hh + q) ? part : -__builtin_inff();
                    }
                } };
            bf16x8 B0[4], B1[4], B2[4];
            if (wid < ntile) {
                IDX_GLD(B0, wid); IDX_GLD(B1, wid + 8);
                asm volatile("" :: "v"(Af[0][0]), "v"(Af[0][1]), "v"(Af[0][2]), "v"(Af[0][3]), "v"(Af[1][0]), "v"(Af[1][1]), "v"(Af[1][2]), "v"(Af[1][3]));
#pragma unroll 1
                for (int kt = wid; kt < ntile; kt += 24) {
                    IDX_GLD(B2, kt + 16);
                    IDX_GLW(B0, 8);
                    score_tile(B0, kt);
                    IDX_GLD(B0, kt + 24);
                    IDX_GLW(B1, 8);
                    if (kt + 8 < ntile) score_tile(B1, kt + 8);
                    IDX_GLD(B1, kt + 32);
                    IDX_GLW(B2, 8);
                    if (kt + 16 < ntile) score_tile(B2, kt + 16);
                }
                asm volatile("s_waitcnt vmcnt(0)" : "+v"(B0[0]), "+v"(B0[1]), "+v"(B0[2]), "+v"(B0[3]), "+v"(B1[0]), "+v"(B1[1]), "+v"(B1[2]), "+v"(B1[3]), "+v"(B2[0]), "+v"(B2[1]), "+v"(B2[2]), "+v"(B2[3]));
            }
#undef IDX_GLD
#undef IDX_GLW
        }
        __syncthreads();
        {
            const int t = t0 + wid; u64* mrow = MASK + (size_t)(b * S_ + t) * 64;
            if (t < 256) {
                const int lo = 64 * lane; u64 w;
                if (t >= lo + 63) w = ~0ull; else if (t < lo) w = 0ull; else w = (2ull << (t - lo)) - 1ull;
                mrow[lane] = w;
            } else {
                int lz = threadIdx.x; asm volatile("" : "+v"(lz)); lz &= 63;
                LAS float* rowp = SC + wid * 4096; u64 myw;
                if (t < 512) myw = select_row<8>(rowp, t, lz); else if (t < 1024) myw = select_row<16>(rowp, t, lz); else if (t < 2048) myw = select_row<32>(rowp, t, lz); else myw = select_row<64>(rowp, t, lz);
                mrow[lz] = myw;
            }
        }
        __syncthreads();
    }
}

__device__ __forceinline__ int bitmask(int w, int pos  ) { int m; asm("v_bfe_i32 %0, %1, %2, 1" : "=v"(m) : "v"(w), "n"(pos)); return m; }
__device__ __forceinline__ void ph_att(const Params& P, LAS unsigned char* lds) {
    LAS float* TABL = (LAS float*)lds;
    LAS unsigned char* KB = lds + 4096;
    constexpr int KT_B = 64 * 144, VT_B = 64 * 136, BUF_B = KT_B + VT_B;
    constexpr float LOG2E = 1.4426950408889634f;
    const float* tabg = (const float*)(P.ws + OFF_TAB);
    const int tid = opaque_tid(), wid = __builtin_amdgcn_readfirstlane(tid >> 6), lane = tid & 63, m = lane & 31, hh = lane >> 5;
    for (int i = tid; i < 1024; i += NTHR) TABL[i] = tabg[i] * LOG2E;
    LAS int* POSL = (LAS int*)(KB + 4 * BUF_B);
    int pos_b = -1;
    const bf16_t* ZQ = (const bf16_t*)(P.ws + OFF_ZQ); const u64* MASK = (const u64*)(P.ws + OFF_MASK);
    const bf16_t* VT = (const bf16_t*)(P.ws + OFF_VT); bf16_t* OA = (bf16_t*)(P.ws + OFF_OATT); const int* KPM = (const int*)(P.ws + OFF_KPM);
    int itc = 0;
    for (int idx = blockIdx.x; idx < NB_ * 8 * 16; idx += gridDim.x, ++itc) {
        const int b = idx & 7, head = (idx >> 3) & 7, j = idx >> 6; const int qb = (itc & 1) ? (j ^ 3) : j;
        const int q0 = qb * 256, tq0 = q0 + 32 * wid, t = tq0 + m;
        const bf16_t* zb = ZQ + (size_t)b * S_ * 2304;
        if (b != pos_b) {
            __syncthreads();
            for (int i = tid; i < S_ / 4; i += NTHR) ((LAS i32x4*)POSL)[i] = ((const i32x4*)(P.pos + b * S_))[i];
            pos_b = b;
            __syncthreads();
        }
        bf16x8 Qf[4];
        { const bf16_t* qp = zb + (size_t)t * 2304 + head * 64 + 8 * hh;
#pragma unroll
          for (int ks = 0; ks < 4; ++ks) Qf[ks] = *(const bf16x8*)(qp + 16 * ks); }
        const int posq = POSL[t];
        int minq = posq;
#pragma unroll
        for (int o = 32; o >= 1; o >>= 1) { const int v = shxi(minq, o, lane); minq = v < minq ? v : minq; }
        minq = __builtin_amdgcn_readfirstlane(minq);
        const u64* mrow = MASK + (size_t)(b * S_ + t) * 64;
        const bf16_t* vtb = VT + (size_t)(b * 8 + head) * 64 * S_;
        const float c1 = 0.125f * LOG2E, c2 = TABL[127 * 8 + head];
        f32x16 O0, O1, OL;
#pragma unroll
        for (int r = 0; r < 16; ++r) { O0[r] = 0.f; O1[r] = 0.f; OL[r] = 0.f; }
        const bf16x8 ones8 = {0x3F80, 0x3F80, 0x3F80, 0x3F80, 0x3F80, 0x3F80, 0x3F80, 0x3F80};
        float m_run = -1e30f;
        const int nt = 4 * qb + 4, my_nt = ((tq0 + 31) >> 6) + 1;
        const int skey = tid >> 3, sch = tid & 7;
        const bf16_t* kg = zb + (size_t)skey * 2304 + 512 + head * 64 + 8 * sch;
        const bf16_t* vg = vtb + (size_t)skey * S_ + 8 * sch;
        LAS unsigned char* kdst = KB + skey * 144 + sch * 16; LAS unsigned char* vdst = KB + KT_B + skey * 136 + sch * 16;
        const int kpm_l = KPM[b * 64 + lane];
        auto tile = [&](const int kt, const int boff, const u64 mw) {
                const LAS unsigned char* Kt = KB + boff; const LAS unsigned char* Vt = Kt + KT_B;
                f32x16 D0, D1;
#pragma unroll
                for (int r = 0; r < 16; ++r) { D0[r] = 0.f; D1[r] = 0.f; }
#pragma unroll
                for (int ks = 0; ks < 4; ++ks) {
                    const bf16x8 K0 = *(const LAS bf16x8*)(Kt + m * 144 + 32 * ks + 16 * hh), K1 = *(const LAS bf16x8*)(Kt + (32 + m) * 144 + 32 * ks + 16 * hh);
                    D0 = __builtin_amdgcn_mfma_f32_32x32x16_bf16(K0, Qf[ks], D0, 0, 0, 0); D1 = __builtin_amdgcn_mfma_f32_32x32x16_bf16(K1, Qf[ks], D1, 0, 0, 0); }
                const int w0 = (int)((unsigned)mw >> (4 * hh)), w1 = (int)((unsigned)(mw >> 32) >> (4 * hh));
                float esc = c1, eoff0 = c2;
                if (minq - __builtin_amdgcn_readlane(kpm_l, kt) < 127) {
#pragma unroll
                    for (int mb = 0; mb < 2; ++mb)
#pragma unroll
                        for (int g = 0; g < 4; ++g) {
                            const i32x4 pk = *(const LAS i32x4*)(POSL + 64 * kt + 32 * mb + 8 * g + 4 * hh);
#pragma unroll
                            for (int e = 0; e < 4; ++e) { const int r = 4 * g + e; int n = posq - pk[e]; n = n < 0 ? 0 : (n > 127 ? 127 : n);
                                if (mb) D1[r] = D1[r] * c1 + TABL[n * 8 + head]; else D0[r] = D0[r] * c1 + TABL[n * 8 + head]; }
                        }
                    esc = 1.0f; eoff0 = 0.f;
                }
                float mx = __builtin_fmaxf(__builtin_fmaxf(D0[0], D0[1]), D0[2]);
#pragma unroll
                for (int r = 3; r < 15; r += 2) mx = __builtin_fmaxf(__builtin_fmaxf(mx, D0[r]), D0[r + 1]);
#pragma unroll
                for (int r = 0; r < 16; r += 2) mx = __builtin_fmaxf(__builtin_fmaxf(mx, D1[r]), D1[r + 1]);
                mx = fmaxf(mx, D0[15]);
                mx = fmaxf(mx, shx(mx, 32, lane));
                const float m_new = fmaxf(m_run, mx * esc + eoff0); const float alpha = __builtin_amdgcn_exp2f(m_run - m_new); m_run = m_new;
                const float eoff = eoff0 - m_new;
                float pv[32];
#pragma unroll
                for (int r = 0; r < 16; ++r) {
                    const int bp = (r & 3) + 8 * (r >> 2);
                    pv[r] = __int_as_float(__float_as_int(__builtin_amdgcn_exp2f(D0[r] * esc + eoff)) & bitmask(w0, bp));
                    pv[16 + r] = __int_as_float(__float_as_int(__builtin_amdgcn_exp2f(D1[r] * esc + eoff)) & bitmask(w1, bp)); }
                if (!__all(alpha == 1.0f)) {
#pragma unroll
                    for (int r = 0; r < 16; ++r) { O0[r] *= alpha; O1[r] *= alpha; OL[r] *= alpha; } }
#pragma unroll
                for (int s = 0; s < 4; ++s) {
                    u32x4 pw; pw.x = cvt_pk_bf16(pv[8 * s + 0], pv[8 * s + 1]); pw.y = cvt_pk_bf16(pv[8 * s + 2], pv[8 * s + 3]); pw.z = cvt_pk_bf16(pv[8 * s + 4], pv[8 * s + 5]); pw.w = cvt_pk_bf16(pv[8 * s + 6], pv[8 * s + 7]);
                    const bf16x8 Pf = __builtin_bit_cast(bf16x8, pw);
                    const LAS unsigned char* vp = Vt + m * 136 + (16 * s + 4 * hh) * 2;
                    { const u32x2 va = *(const LAS u32x2*)vp, vb = *(const LAS u32x2*)(vp + 16); u32x4 vw; vw.x = va.x; vw.y = va.y; vw.z = vb.x; vw.w = vb.y;
                      O0 = __builtin_amdgcn_mfma_f32_32x32x16_bf16(__builtin_bit_cast(bf16x8, vw), Pf, O0, 0, 0, 0); }
                    { const u32x2 va = *(const LAS u32x2*)(vp + 32 * 136), vb = *(const LAS u32x2*)(vp + 32 * 136 + 16); u32x4 vw; vw.x = va.x; vw.y = va.y; vw.z = vb.x; vw.w = vb.y;
                      O1 = __builtin_amdgcn_mfma_f32_32x32x16_bf16(__builtin_bit_cast(bf16x8, vw), Pf, O1, 0, 0, 0); }
                    OL = __builtin_amdgcn_mfma_f32_32x32x16_bf16(ones8, Pf, OL, 0, 0, 0);
                }
        };
        __syncthreads();
        constexpr int SUB_B = KT_B + VT_B, SUP_B = 2 * SUB_B;
        const int nst = nt >> 1;
        u32x4 ka0, kb0, va0, vb0, ka1, kb1, va1, vb1;
#define ATT_LOAD(KA, KB_, VA, VB, ST) do { KA = *(const u32x4*)(kg + (size_t)(2 * (ST)) * 64 * 2304); KB_ = *(const u32x4*)(kg + (size_t)(2 * (ST) + 1) * 64 * 2304); \
            VA = *(const u32x4*)(vg + (2 * (ST)) * 64); VB = *(const u32x4*)(vg + (2 * (ST) + 1) * 64); } while (0)
#define ATT_STORE(KA, KB_, VA, VB, BUF) do { LAS unsigned char* kd_ = kdst + (BUF) * SUP_B; LAS unsigned char* vd_ = vdst + (BUF) * SUP_B; \
            *(LAS u32x4*)kd_ = KA; *(LAS u32x2*)vd_ = (u32x2){VA.x, VA.y}; *(LAS u32x2*)(vd_ + 8) = (u32x2){VA.z, VA.w}; \
            *(LAS u32x4*)(kd_ + SUB_B) = KB_; *(LAS u32x2*)(vd_ + SUB_B) = (u32x2){VB.x, VB.y}; *(LAS u32x2*)(vd_ + SUB_B + 8) = (u32x2){VB.z, VB.w}; } while (0)
        u64x2 mwA = *(const u64x2*)mrow, mwB = mwA;
        ATT_LOAD(ka0, kb0, va0, vb0, 0); ATT_STORE(ka0, kb0, va0, vb0, 0);
        if (nst > 1) ATT_LOAD(ka1, kb1, va1, vb1, 1);
        __syncthreads();
        for (int st = 0; st < nst; st += 2) {
            if (st + 1 < nst) mwB = *(const u64x2*)(mrow + 2 * (st + 1));
            if (st + 2 < nst) ATT_LOAD(ka0, kb0, va0, vb0, st + 2);
            if (2 * st < my_nt) tile(2 * st, 0, mwA.x);
            if (2 * st + 1 < my_nt) tile(2 * st + 1, SUB_B, mwA.y);
            if (st + 1 < nst) ATT_STORE(ka1, kb1, va1, vb1, 1);
            __syncthreads();
            if (st + 1 >= nst) break;
            if (st + 2 < nst) mwA = *(const u64x2*)(mrow + 2 * (st + 2));
            if (st + 3 < nst) ATT_LOAD(ka1, kb1, va1, vb1, st + 3);
            if (2 * st + 2 < my_nt) tile(2 * st + 2, SUP_B, mwB.x);
            if (2 * st + 3 < my_nt) tile(2 * st + 3, SUP_B + SUB_B, mwB.y);
            if (st + 2 < nst) ATT_STORE(ka0, kb0, va0, vb0, 0);
            __syncthreads();
        }
#undef ATT_LOAD
#undef ATT_STORE
        const float inv = __builtin_amdgcn_rcpf(OL[0]);
        bf16_t* op = OA + (size_t)(b * S_ + t) * 512 + head * 64 + 4 * hh;
#pragma unroll
        for (int g = 0; g < 4; ++g) {
            u32x2 wa; wa.x = cvt_pk_bf16(O0[4 * g] * inv, O0[4 * g + 1] * inv); wa.y = cvt_pk_bf16(O0[4 * g + 2] * inv, O0[4 * g + 3] * inv);
            *(u32x2*)(op + 8 * g) = wa;
            u32x2 wb; wb.x = cvt_pk_bf16(O1[4 * g] * inv, O1[4 * g + 1] * inv); wb.y = cvt_pk_bf16(O1[4 * g + 2] * inv, O1[4 * g + 3] * inv);
            *(u32x2*)(op + 32 + 8 * g) = wb;
        }
    }
}

#define DSR4(A, addr, o0, o1, o2, o3) asm volatile("ds_read_b128 %0, %4 offset:%5\n\tds_read_b128 %1, %4 offset:%6\n\tds_read_b128 %2, %4 offset:%7\n\tds_read_b128 %3, %4 offset:%8" \
    : "=&v"(A[0]), "=&v"(A[1]), "=&v"(A[2]), "=&v"(A[3]) : "v"(addr), "i"(o0), "i"(o1), "i"(o2), "i"(o3))
#define DSW(A, N) asm volatile("s_waitcnt lgkmcnt(" #N ")" : "+v"(A[0]), "+v"(A[1]), "+v"(A[2]), "+v"(A[3]))
#define DSRV(V, addr, off) asm volatile("ds_read_b32 %0, %1 offset:%2" : "=&v"(V) : "v"(addr), "i"(off))
#define DSWV(A, V, N) asm volatile("s_waitcnt lgkmcnt(" #N ")" : "+v"(A[0]), "+v"(A[1]), "+v"(A[2]), "+v"(A[3]), "+v"(V))
#define SCAN_A(X, G) _Pragma("unroll") for (int i_ = 0; i_ < 4; ++i_) { const f32x2 k01 = {X[i_][0], X[i_][1]}, k23 = {X[i_][2], X[i_][3]}; \
    sa0 += S2[8 * G + 2 * i_] * k01; sa1 += S2[8 * G + 2 * i_ + 1] * k23; sp0 += Pm2[8 * G + 2 * i_] * k01; sp1 += Pm2[8 * G + 2 * i_ + 1] * k23; }
#define SCAN_B(X, C) { const int j = 2 * C; \
    { const f32x2 w = {X[0][0], X[0][1]}, kb = {X[1][0], X[1][1]}, kk = {X[2][0], X[2][1]}, rr = {X[3][0], X[3][1]}; \
      S2[j] = S2[j] * w + sav * kb + vv2 * kk; Pm2[j] = Pm2[j] * w + spv * kb; y0 += S2[j] * rr; p0 += Pm2[j] * rr; } \
    { const f32x2 w = {X[0][2], X[0][3]}, kb = {X[1][2], X[1][3]}, kk = {X[2][2], X[2][3]}, rr = {X[3][2], X[3][3]}; \
      S2[j + 1] = S2[j + 1] * w + sav * kb + vv2 * kk; Pm2[j + 1] = Pm2[j + 1] * w + spv * kb; y1 += S2[j + 1] * rr; p1 += Pm2[j + 1] * rr; } }
__device__ __forceinline__ float wave_sum_dpp(float v) {
    v += __int_as_float(__builtin_amdgcn_update_dpp(0, __float_as_int(v), 0x111, 0xf, 0xf, true));
    v += __int_as_float(__builtin_amdgcn_update_dpp(0, __float_as_int(v), 0x112, 0xf, 0xf, true));
    v += __int_as_float(__builtin_amdgcn_update_dpp(0, __float_as_int(v), 0x114, 0xf, 0xf, true));
    v += __int_as_float(__builtin_amdgcn_update_dpp(0, __float_as_int(v), 0x118, 0xf, 0xf, true));
    v += __int_as_float(__builtin_amdgcn_update_dpp(0, __float_as_int(v), 0x142, 0xa, 0xf, false));
    v += __int_as_float(__builtin_amdgcn_update_dpp(0, __float_as_int(v), 0x143, 0xc, 0xf, false));
    return __int_as_float(__builtin_amdgcn_readlane(__float_as_int(v), 63));
}
__device__ __forceinline__ void wave_sum2_dpp(float a, float b, float& ra, float& rb) {
    const auto sw = __builtin_amdgcn_permlane32_swap(__float_as_uint(a), __float_as_uint(b), false, false);
    float v = __uint_as_float(sw[0]) + __uint_as_float(sw[1]);
    v += __int_as_float(__builtin_amdgcn_update_dpp(0, __float_as_int(v), 0x111, 0xf, 0xf, true));
    v += __int_as_float(__builtin_amdgcn_update_dpp(0, __float_as_int(v), 0x112, 0xf, 0xf, true));
    v += __int_as_float(__builtin_amdgcn_update_dpp(0, __float_as_int(v), 0x114, 0xf, 0xf, true));
    v += __int_as_float(__builtin_amdgcn_update_dpp(0, __float_as_int(v), 0x118, 0xf, 0xf, true));
    v += __int_as_float(__builtin_amdgcn_update_dpp(0, __float_as_int(v), 0x142, 0xa, 0xf, false));
    ra = __int_as_float(__builtin_amdgcn_readlane(__float_as_int(v), 31)); rb = __int_as_float(__builtin_amdgcn_readlane(__float_as_int(v), 63));
}
__device__ __forceinline__ void ph_scan(const Params& P, int l, LAS unsigned char* lds) {
    LAS bf16_t* LI = (LAS bf16_t*)lds;
    LAS float* SIN = (LAS float*)(lds + 32768);
    const bf16_t* ZR = (const bf16_t*)(P.ws + OFF_ZR);
    const float* mu = P.mu + (size_t)l * 1792;
    const bf16_t* LW = (const bf16_t*)(P.ws + OFF_WB + WB_LW); const bf16_t* LA = (const bf16_t*)(P.ws + OFF_WB + WB_LA); const bf16_t* LG = (const bf16_t*)(P.ws + OFF_WB + WB_LG);
    bf16_t* Yo = (bf16_t*)(P.ws + OFF_Y); bf16_t* Po = (bf16_t*)(P.ws + OFF_P); bf16_t* Go = (bf16_t*)(P.ws + OFF_G); bf16_t* VBo = (bf16_t*)(P.ws + OFF_VB);
    float* SEGp = (float*)(P.ws + OFF_SEG);
    const int tid = opaque_tid(), wid = __builtin_amdgcn_readfirstlane(tid >> 6), lane = tid & 63;
    for (int blk = blockIdx.x; blk < NB_ * NSEG; blk += gridDim.x) {
        const int b = blk / NSEG, seg = blk % NSEG, tbeg = seg * SEGL;
        f32x2 S2[32], Pm2[32];
        { int lq = threadIdx.x; asm volatile("" : "+v"(lq)); lq &= 63;
#pragma unroll
          for (int j = 0; j < 32; ++j) { S2[j] = (f32x2){0.f, 0.f}; Pm2[j] = (f32x2){(2 * j == lq) ? 1.f : 0.f, (2 * j + 1 == lq) ? 1.f : 0.f}; } }
        for (int half = 0; half < 2; ++half) {
            __syncthreads();
            {
                int tq = threadIdx.x; asm volatile("" : "+v"(tq));
#pragma unroll 1
                for (int rnd = 0; rnd < 4; ++rnd) {
                    const int q = tq + NTHR * rnd, tok = q >> 5, c8 = (q & 31) * 8, t = tbeg + 64 * half + tok; const size_t row = (size_t)b * S_ + t;
                    const u32x4 zc = *(const u32x4*)(ZR + row * 1792 + 1536 + c8);
                    u32x4 zp; zp.x = 0u; zp.y = 0u; zp.z = 0u; zp.w = 0u; if (t > 0) zp = *(const u32x4*)(ZR + (row - 1) * 1792 + 1536 + c8);
                    const f32x4 ma = *(const f32x4*)(mu + 1536 + c8), mb = *(const f32x4*)(mu + 1536 + c8 + 4);
                    const unsigned cw[4] = {zc.x, zc.y, zc.z, zc.w}, pw[4] = {zp.x, zp.y, zp.z, zp.w};
                    float x[8];
#pragma unroll
                    for (int q2 = 0; q2 < 4; ++q2) { const float c0 = bflo(cw[q2]), c1 = bfhi(cw[q2]), p0 = bflo(pw[q2]), p1 = bfhi(pw[q2]);
                        const float m0 = q2 < 2 ? ma[2 * q2] : mb[2 * q2 - 4], m1 = q2 < 2 ? ma[2 * q2 + 1] : mb[2 * q2 - 3];
                        x[2 * q2] = c0 + (p0 - c0) * m0; x[2 * q2 + 1] = c1 + (p1 - c1) * m1; }
#pragma unroll
                    for (int e = 0; e < 8; ++e) { if (c8 < 64) x[e] = 1.0f - 2.0f * __builtin_amdgcn_rcpf(1.0f + __expf(2.0f * x[e])); else if (c8 >= 128) x[e] = sigmoidf_(x[e]); }
                    u32x4 w; w.x = cvt_pk_bf16(x[0], x[1]); w.y = cvt_pk_bf16(x[2], x[3]); w.z = cvt_pk_bf16(x[4], x[5]); w.w = cvt_pk_bf16(x[6], x[7]);
                    *(LAS u32x4*)(LI + tok * 256 + c8) = w;
                }
            }
            __syncthreads();
            float* los = (float*)(P.ws + OFF_SCR) + (size_t)(blk * 8 + wid) * (64 * 2 * 64);
            {
                int tq = threadIdx.x; asm volatile("" : "+v"(tq));
                const int lq = tq & 63, fr = lq & 15, kq = lq >> 4;
#pragma unroll 1
                for (int pass = 0; pass < 8; ++pass) {
                    const int kind = pass < 2 ? 0 : (pass < 4 ? 1 : 2), Kk = kind == 2 ? 128 : 64, aoff = kind * 64, nb0 = kind == 2 ? pass - 4 : 2 * (pass & 1);
                    const bf16_t* Wt = kind == 0 ? LW : (kind == 1 ? LA : LG);
                    bf16x8 Bf[4];
#pragma unroll
                    for (int q = 0; q < 4; ++q) { const int nb = kind == 2 ? nb0 : nb0 + (q >> 1), ks = kind == 2 ? q : (q & 1);
                        Bf[q] = *(const bf16x8*)(Wt + (size_t)(64 * wid + 16 * nb + fr) * Kk + 32 * ks + 8 * kq); }
#pragma unroll 1
                    for (int tt = 0; tt < 4; ++tt) {
                        f32x4 acc[2];
                        acc[0] = (f32x4){0.f, 0.f, 0.f, 0.f}; acc[1] = acc[0];
#pragma unroll
                        for (int q = 0; q < 4; ++q) { const int ai = kind == 2 ? 0 : (q >> 1), ks = kind == 2 ? q : (q & 1);
                            const bf16x8 Afr = *(const LAS bf16x8*)(LI + (16 * tt + fr) * 256 + aoff + 32 * ks + 8 * kq);
                            acc[ai] = __builtin_amdgcn_mfma_f32_16x16x32_bf16(Afr, Bf[q], acc[ai], 0, 0, 0); }
                        if (kind == 2) {
#pragma unroll
                            for (int r = 0; r < 4; ++r) Go[((size_t)b * S_ + tbeg + 64 * half + 16 * tt + 4 * kq + r) * 512 + 64 * wid + 16 * nb0 + fr] = f2bf(acc[0][r]);
                        } else {
#pragma unroll
                            for (int ai = 0; ai < 2; ++ai)
#pragma unroll
                                for (int r = 0; r < 4; ++r) los[((16 * tt + 4 * kq + r) * 2 + kind) * 64 + 16 * (nb0 + ai) + fr] = acc[ai][r];
                        }
                    }
                }
            }
            asm volatile("s_waitcnt vmcnt(0)" ::: "memory");
            for (int sb = 0; sb < 64 / TB; ++sb) {
                const int ts = tbeg + 64 * half + sb * TB;
                int tz = threadIdx.x; asm volatile("" : "+v"(tz));
                const int lz = tz & 63;
                LAS float* sw = SIN + (size_t)wid * (TB * 6 * 64);
                {
                    const int c = 64 * wid + lz; const size_t row0 = (size_t)b * S_ + ts;
                    const float mur = mu[c], muk = mu[512 + c], muv = mu[1024 + c];
                    const float pw0 = P.w0[l * 512 + c], pa0 = P.a0[l * 512 + c], pkk = P.k_k[l * 512 + c], pka = P.k_a[l * 512 + c], prk = P.r_k[l * 512 + c];
                    const float* lo = los + (size_t)(sb * TB) * 128 + lz;
                    float zr_[TB + 1], zk_[TB + 1], zv_[TB + 1], wl_[TB], al_[TB];
                    zr_[0] = 0.f; zk_[0] = 0.f; zv_[0] = 0.f;
                    if (ts > 0) { zr_[0] = bf2f(ZR[(row0 - 1) * 1792 + c]); zk_[0] = bf2f(ZR[(row0 - 1) * 1792 + 512 + c]); zv_[0] = bf2f(ZR[(row0 - 1) * 1792 + 1024 + c]); }
#pragma unroll
                    for (int tk = 0; tk < TB; ++tk) {
                        zr_[tk + 1] = bf2f(ZR[(row0 + tk) * 1792 + c]); zk_[tk + 1] = bf2f(ZR[(row0 + tk) * 1792 + 512 + c]); zv_[tk + 1] = bf2f(ZR[(row0 + tk) * 1792 + 1024 + c]);
                        wl_[tk] = lo[tk * 128]; al_[tk] = lo[tk * 128 + 64]; }
#pragma unroll
                    for (int tk = 0; tk < TB; ++tk) {
                        const size_t row = row0 + tk; LAS float* st = sw + tk * 6 * 64;
                        const float cr = zr_[tk + 1], ck = zk_[tk + 1], cv = zv_[tk + 1], wl = wl_[tk], al = al_[tk];
                        const float rr = cr + (zr_[tk] - cr) * mur, kv = ck + (zk_[tk] - ck) * muk, vv = cv + (zv_[tk] - cv) * muv;
                        const float dc = __builtin_amdgcn_exp2f(-0.87503877f * __builtin_amdgcn_rcpf(1.0f + __builtin_amdgcn_exp2f(-1.44269504f * (pw0 + wl))));
                        const float av = sigmoidf_(pa0 + al);
                        const float kkv = kv * pkk;
                        const float km = kv * (1.0f + (av - 1.0f) * pka);
                        float ss, bon; wave_sum2_dpp(kkv * kkv, rr * km * prk, ss, bon);
                        const float kkn = kkv * __builtin_amdgcn_rsqf(fmaxf(ss, 1e-24f));
                        st[lz] = rr; st[64 + lz] = dc; st[2 * 64 + lz] = km; st[3 * 64 + lz] = -kkn; st[4 * 64 + lz] = kkn * av; st[5 * 64 + lz] = vv;
                        VBo[row * 512 + c] = f2bf(bon * vv);
                    }
                }
                {
                const unsigned sq0 = (unsigned)(uintptr_t)sw, va0 = sq0 + 4u * (unsigned)lz;
                f32x4 X0[4], X1[4], X2[4]; float vin;
                DSRV(vin, va0, 1280);
                DSR4(X2, sq0, 896, 912, 928, 944);
                DSR4(X0, sq0, 768, 784, 800, 816);
                DSR4(X1, sq0, 832, 848, 864, 880);
#pragma unroll 1
                for (int tk = 0; tk < TB; ++tk) {
                    f32x2 sa0 = {0.f, 0.f}, sa1 = {0.f, 0.f}, sp0 = {0.f, 0.f}, sp1 = {0.f, 0.f};
                    f32x2 y0 = {0.f, 0.f}, y1 = {0.f, 0.f}, p0 = {0.f, 0.f}, p1 = {0.f, 0.f};
                    f32x2 sav, spv;
                    const unsigned sqa = sq0 + 1536u * (unsigned)tk, vna = va0 + 1536u * (unsigned)tk;
                    DSWV(X0, vin, 4);
                    const f32x2 vv2 = {vin, vin};
                    SCAN_A(X0, 0);
                    DSR4(X0, sqa, 960, 976, 992, 1008);
                    DSW(X1, 4);
                    SCAN_A(X1, 1);
                    DSR4(X1, sqa, 256, 1024, 512, 0);
                    DSW(X2, 8);
                    SCAN_A(X2, 2);
                    DSR4(X2, sqa, 272, 1040, 528, 16);
                    DSW(X0, 8);
                    SCAN_A(X0, 3);
                    { const float sa = (sa0.x + sa0.y) + (sa1.x + sa1.y), sp = (sp0.x + sp0.y) + (sp1.x + sp1.y); sav = (f32x2){sa, sa}; spv = (f32x2){sp, sp}; }
                    DSR4(X0, sqa, 288, 1056, 544, 32);
                    DSW(X1, 8);
                    SCAN_B(X1, 0);
                    DSR4(X1, sqa, 304, 1072, 560, 48);
                    DSW(X2, 8);
                    SCAN_B(X2, 1);
                    DSR4(X2, sqa, 320, 1088, 576, 64);
                    DSW(X0, 8);
                    SCAN_B(X0, 2);
                    DSR4(X0, sqa, 336, 1104, 592, 80);
                    DSW(X1, 8);
                    SCAN_B(X1, 3);
                    DSR4(X1, sqa, 352, 1120, 608, 96);
                    DSW(X2, 8);
                    SCAN_B(X2, 4);
                    DSR4(X2, sqa, 368, 1136, 624, 112);
                    DSW(X0, 8);
                    SCAN_B(X0, 5);
                    DSR4(X0, sqa, 384, 1152, 640, 128);
                    DSW(X1, 8);
                    SCAN_B(X1, 6);
                    DSR4(X1, sqa, 400, 1168, 656, 144);
                    DSW(X2, 8);
                    SCAN_B(X2, 7);
                    DSR4(X2, sqa, 416, 1184, 672, 160);
                    DSW(X0, 8);
                    SCAN_B(X0, 8);
                    DSR4(X0, sqa, 432, 1200, 688, 176);
                    DSW(X1, 8);
                    SCAN_B(X1, 9);
                    DSR4(X1, sqa, 448, 1216, 704, 192);
                    DSW(X2, 8);
                    SCAN_B(X2, 10);
                    DSR4(X2, sqa, 464, 1232, 720, 208);
                    DSW(X0, 8);
                    SCAN_B(X0, 11);
                    DSR4(X0, sqa, 480, 1248, 736, 224);
                    DSW(X1, 8);
                    SCAN_B(X1, 12);
                    DSR4(X1, sqa, 496, 1264, 752, 240);
                    DSW(X2, 8);
                    SCAN_B(X2, 13);
                    {
                        const unsigned nx = (tk + 1 < TB) ? 1536u : 0u, sqn = sqa + nx, vnn = vna + nx;
                        DSRV(vin, vnn, 1280);
                        DSR4(X2, sqn, 896, 912, 928, 944);
                        DSW(X0, 9);
                        SCAN_B(X0, 14);
                        DSR4(X0, sqn, 768, 784, 800, 816);
                        DSW(X1, 9);
                        SCAN_B(X1, 15);
                        DSR4(X1, sqn, 832, 848, 864, 880);
                    }
                    const size_t row = (size_t)b * S_ + ts + tk;
                    Yo[row * 512 + 64 * wid + lz] = f2bf((y0.x + y0.y) + (y1.x + y1.y));
                    Po[row * 512 + 64 * wid + lz] = f2bf((p0.x + p0.y) + (p1.x + p1.y));
                }
                asm volatile("s_waitcnt lgkmcnt(0)" : "+v"(X0[0]), "+v"(X0[1]), "+v"(X0[2]), "+v"(X0[3]), "+v"(X1[0]), "+v"(X1[1]), "+v"(X1[2]), "+v"(X1[3]),
                             "+v"(X2[0]), "+v"(X2[1]), "+v"(X2[2]), "+v"(X2[3]), "+v"(vin));
                }
            }
        }
        {
            int lq = threadIdx.x; asm volatile("" : "+v"(lq)); lq &= 63;
            float* sg = SEGp + ((size_t)((b * 8 + wid) * NSEG + seg)) * 8192 + lq * 64;
#pragma unroll
            for (int j = 0; j < 32; j += 2) { *(f32x4*)(sg + 2 * j) = (f32x4){Pm2[j].x, Pm2[j].y, Pm2[j + 1].x, Pm2[j + 1].y};
                *(f32x4*)(sg + 4096 + 2 * j) = (f32x4){S2[j].x, S2[j].y, S2[j + 1].x, S2[j + 1].y}; }
        }
    }
}

__device__ __forceinline__ void ph_comb(const Params& P, LAS unsigned char* lds) {
    LAS float* SI = (LAS float*)lds;
    LAS float* PB = (LAS float*)(lds + 20480);
    float* SEGp = (float*)(P.ws + OFF_SEG);
    const int tid = opaque_tid(), wid = __builtin_amdgcn_readfirstlane(tid >> 6), lane = tid & 63, m = lane & 31, hh = lane >> 5;
    for (int chain = blockIdx.x; chain < 64; chain += gridDim.x) {
        float* base = SEGp + (size_t)chain * NSEG * 8192;
        __syncthreads();
        for (int i = tid; i < 4096; i += NTHR) SI[(i >> 6) * 65 + (i & 63)] = base[4096 + i];
        { const f32x4 a = *(const f32x4*)(base + 8192 + tid * 8), c = *(const f32x4*)(base + 8192 + tid * 8 + 4);
          *(LAS f32x4*)(PB + 4096 + tid * 8) = a; *(LAS f32x4*)(PB + 4096 + tid * 8 + 4) = c; }
        __syncthreads();
        const int ti = (wid >> 1) & 1, tj = wid & 1;
        for (int k = 1; k <= NSEG - 2; ++k) {
            float* Q = base + (size_t)k * 8192 + 4096;
            const LAS float* Pb = PB + (k & 1) * 4096;
            f32x4 na = {0.f, 0.f, 0.f, 0.f}, nc = na;
            if (k + 1 <= NSEG - 2) { const float* pn = base + (size_t)(k + 1) * 8192 + tid * 8; na = *(const f32x4*)pn; nc = *(const f32x4*)(pn + 4); }
            f32x16 Dv;
            if (wid < 4) {
                float qv[16];
#pragma unroll
                for (int r = 0; r < 16; ++r) { const int row = 32 * ti + (r & 3) + 8 * (r >> 2) + 4 * hh; qv[r] = Q[row * 64 + 32 * tj + m]; Dv[r] = 0.f; }
#pragma unroll
                for (int kk = 0; kk < 32; ++kk) { const float a = SI[(32 * ti + m) * 65 + 2 * kk + hh], bq = Pb[(2 * kk + hh) * 64 + 32 * tj + m];
                    Dv = __builtin_amdgcn_mfma_f32_32x32x2f32(a, bq, Dv, 0, 0, 0); }
#pragma unroll
                for (int r = 0; r < 16; ++r) Dv[r] += qv[r];
            }
            __syncthreads();
            if (wid < 4) {
#pragma unroll
                for (int r = 0; r < 16; ++r) { const int row = 32 * ti + (r & 3) + 8 * (r >> 2) + 4 * hh; SI[row * 65 + 32 * tj + m] = Dv[r]; Q[row * 64 + 32 * tj + m] = Dv[r]; }
            }
            if (k + 1 <= NSEG - 2) { LAS float* pd = PB + ((k + 1) & 1) * 4096 + tid * 8; *(LAS f32x4*)pd = na; *(LAS f32x4*)(pd + 4) = nc; }
            __syncthreads();
        }
    }
}

__device__ __forceinline__ void ph_post(const Params& P, int l) {
    const bf16_t* Yo = (const bf16_t*)(P.ws + OFF_Y); const bf16_t* Po = (const bf16_t*)(P.ws + OFF_P); const bf16_t* Go = (const bf16_t*)(P.ws + OFF_G);
    const bf16_t* VBo = (const bf16_t*)(P.ws + OFF_VB); const float* SEGp = (const float*)(P.ws + OFF_SEG); bf16_t* OR = (bf16_t*)(P.ws + OFF_ORWKV);
    const int tid = opaque_tid(), wid = __builtin_amdgcn_readfirstlane(tid >> 6), lane = tid & 63, m = lane & 31, hh = lane >> 5;
    for (int blk = blockIdx.x; blk < NB_ * NSEG; blk += gridDim.x) {
        const int b = blk / NSEG, seg = blk % NSEG, tbeg = seg * SEGL;
        bf16x8 SIf[2][4];
        if (seg > 0) {
            const float* sg = SEGp + ((size_t)((b * 8 + wid) * NSEG + seg - 1)) * 8192 + 4096;
#pragma unroll
            for (int ib = 0; ib < 2; ++ib)
#pragma unroll
                for (int ks = 0; ks < 4; ++ks) { const float* sp = sg + (32 * ib + m) * 64 + 16 * ks + 8 * hh; const f32x4 a = *(const f32x4*)sp, c = *(const f32x4*)(sp + 4);
                    u32x4 w; w.x = cvt_pk_bf16(a[0], a[1]); w.y = cvt_pk_bf16(a[2], a[3]); w.z = cvt_pk_bf16(c[0], c[1]); w.w = cvt_pk_bf16(c[2], c[3]); SIf[ib][ks] = __builtin_bit_cast(bf16x8, w); }
        }
        float lnw[32], lnb[32];
#pragma unroll
        for (int q = 0; q < 32; ++q) { const int ch = 64 * wid + 32 * (q >> 4) + (q & 3) + 8 * ((q & 15) >> 2) + 4 * hh; lnw[q] = P.ln_w[l * 512 + ch]; lnb[q] = P.ln_b[l * 512 + ch]; }
#pragma unroll 1
        for (int c = 0; c < SEGL / 32; ++c) {
            const size_t row = (size_t)b * S_ + tbeg + 32 * c + m;
            f32x16 D[2];
#pragma unroll
            for (int r = 0; r < 16; ++r) { D[0][r] = 0.f; D[1][r] = 0.f; }
            if (seg > 0) {
                const bf16_t* pp = Po + row * 512 + 64 * wid + 8 * hh;
#pragma unroll
                for (int ks = 0; ks < 4; ++ks) { const bf16x8 Pf = *(const bf16x8*)(pp + 16 * ks);
                    D[0] = __builtin_amdgcn_mfma_f32_32x32x16_bf16(SIf[0][ks], Pf, D[0], 0, 0, 0); D[1] = __builtin_amdgcn_mfma_f32_32x32x16_bf16(SIf[1][ks], Pf, D[1], 0, 0, 0); }
            }
            float y[32]; float s = 0.f;
#pragma unroll
            for (int ib = 0; ib < 2; ++ib)
#pragma unroll
                for (int g = 0; g < 4; ++g) { const u32x2 yw = *(const u32x2*)(Yo + row * 512 + 64 * wid + 32 * ib + 8 * g + 4 * hh);
                    y[16 * ib + 4 * g + 0] = bflo(yw.x) + D[ib][4 * g + 0]; y[16 * ib + 4 * g + 1] = bfhi(yw.x) + D[ib][4 * g + 1];
                    y[16 * ib + 4 * g + 2] = bflo(yw.y) + D[ib][4 * g + 2]; y[16 * ib + 4 * g + 3] = bfhi(yw.y) + D[ib][4 * g + 3]; }
#pragma unroll
            for (int q = 0; q < 32; ++q) s += y[q];
            s += shx(s, 32, lane);
            const float mean = s * (1.0f / 64.0f); float qv = 0.f;
#pragma unroll
            for (int q = 0; q < 32; ++q) { y[q] -= mean; qv += y[q] * y[q]; }
            qv += shx(qv, 32, lane);
            const float rstd = rsqrtf(qv * (1.0f / 64.0f) + 64e-5f);
#pragma unroll
            for (int ib = 0; ib < 2; ++ib)
#pragma unroll
                for (int g = 0; g < 4; ++g) { const size_t off = row * 512 + 64 * wid + 32 * ib + 8 * g + 4 * hh;
                    const u32x2 vw = *(const u32x2*)(VBo + off), gw = *(const u32x2*)(Go + off); const int q = 16 * ib + 4 * g;
                    const float o0 = (y[q] * rstd * lnw[q] + lnb[q] + bflo(vw.x)) * bflo(gw.x), o1 = (y[q + 1] * rstd * lnw[q + 1] + lnb[q + 1] + bfhi(vw.x)) * bfhi(gw.x);
                    const float o2 = (y[q + 2] * rstd * lnw[q + 2] + lnb[q + 2] + bflo(vw.y)) * bflo(gw.y), o3 = (y[q + 3] * rstd * lnw[q + 3] + lnb[q + 3] + bfhi(vw.y)) * bfhi(gw.y);
                    u32x2 w; w.x = cvt_pk_bf16(o0, o1); w.y = cvt_pk_bf16(o2, o3); *(u32x2*)(OR + off) = w; }
        }
    }
}

enum { PH_PRO = 0, PH_NORM1, PH_ZQ, PH_KI, PH_IDX, PH_ATT, PH_ZR, PH_SCAN, PH_COMB, PH_POST, PH_ZC, PH_CONV, PH_MERGE, PH_WO, PH_NORM2, PH_UP, PH_U, PH_DOWN, PH_FINAL, PH_COUNT };

template <int PH>
__device__ __forceinline__ void run_phase(const Params& P0, int l, LAS unsigned char* lds) {
    Params P = P0; P.ws = opaque_ptr(P0.ws);
    if constexpr (PH == PH_PRO) { if (l == 0) ph_mod(P, lds); ph_wconv(P, l, lds); }
    if constexpr (PH == PH_NORM1) ph_norm(P, l, 0);
    if constexpr (PH == PH_ZQ) ph_gemm_zq(P, lds);
    if constexpr (PH == PH_KI) ph_ki(P, lds);
    if constexpr (PH == PH_IDX) ph_idx(P, lds);
    if constexpr (PH == PH_ATT) ph_att(P, lds);
    if constexpr (PH == PH_ZR) ph_gemm_zr(P, lds);
    if constexpr (PH == PH_SCAN) ph_scan(P, l, lds);
    if constexpr (PH == PH_COMB) ph_comb(P, lds);
    if constexpr (PH == PH_POST) ph_post(P, l);
    if constexpr (PH == PH_ZC) ph_gemm_zc(P, lds);
    if constexpr (PH == PH_CONV) ph_conv(P, l, lds);
    if constexpr (PH == PH_MERGE) ph_gemm_merge(P, lds);
    if constexpr (PH == PH_WO) ph_gemm_wo(P, l, lds);
    if constexpr (PH == PH_NORM2) ph_norm(P, l, 1);
    if constexpr (PH == PH_UP) ph_gemm_up(P, l, lds);
    if constexpr (PH == PH_U) ph_ufix(P, l, lds);
    if constexpr (PH == PH_DOWN) ph_gemm_down(P, l, lds);
    if constexpr (PH == PH_FINAL) ph_final(P);
}

#if MK_SINGLE
__global__ void __launch_bounds__(NTHR, 2) k_mega(Params P) {
    extern __shared__ __attribute__((aligned(16))) unsigned char shm[];
    LAS unsigned char* lds = (LAS unsigned char*)shm;
    LAS unsigned* xbw = (LAS unsigned*)(lds + LDS_BYTES - 16);
    if (threadIdx.x == 0) { xbw[0] = 0u; xbw[1] = 0u; xbw[2] = 0u; xbw[3] = 0u; }
    __syncthreads();
    XcdBarrier bar = xcd_barrier_post((unsigned*)(P.ws + OFF_BAR), (volatile LAS unsigned*)xbw);
#ifndef PROBE_PH
#define PROBE_PH (-1)
#endif
#ifndef PROBE_N
#define PROBE_N 4
#endif
#define PHASE(PH, l) do { unsigned long long t0_ = 0; if (PROBE_PH == PH && blockIdx.x == 0) t0_ = wall_clock64(); \
        run_phase<PH>(P, l, lds); xcd_barrier(bar); \
        if (PROBE_PH == PH && blockIdx.x == 0) { const unsigned long long t1_ = wall_clock64(), d_ = (t1_ - t0_) * PROBE_N; while (wall_clock64() - t1_ < d_) __builtin_amdgcn_s_sleep(8); } } while (0)
#pragma unroll 1
    for (int l = 0; l < 2; ++l) {
        PHASE(PH_PRO, l); PHASE(PH_NORM1, l); PHASE(PH_ZQ, l); PHASE(PH_KI, l); PHASE(PH_IDX, l); PHASE(PH_ATT, l); PHASE(PH_ZR, l); PHASE(PH_SCAN, l); PHASE(PH_COMB, l); PHASE(PH_POST, l);
        PHASE(PH_ZC, l); PHASE(PH_CONV, l); PHASE(PH_MERGE, l); PHASE(PH_WO, l); PHASE(PH_NORM2, l); PHASE(PH_UP, l); PHASE(PH_U, l); PHASE(PH_DOWN, l);
    }
    run_phase<PH_FINAL>(P, 0, lds);
#undef PHASE
}
#else
template <int PH>
__global__ void __launch_bounds__(NTHR, 2) k_phase(Params P, int l) {
    extern __shared__ __attribute__((aligned(16))) unsigned char shm[];
    run_phase<PH>(P, l, (LAS unsigned char*)shm);
}
template <int PH> static void launch_phase(const Params& P, int l, hipStream_t stream) {
    static bool attr = false;
    if (!attr) { hipFuncSetAttribute((const void*)k_phase<PH>, hipFuncAttributeMaxDynamicSharedMemorySize, LDS_BYTES); attr = true; }
    hipLaunchKernelGGL(k_phase<PH>, dim3(NBLK), dim3(NTHR), LDS_BYTES, stream, P, l);
}
#endif

extern "C" void kernel_launch(void* const* d_in, const int* in_sizes, int n_in, void* d_out, int out_size, void* d_ws, size_t ws_size, hipStream_t stream) {
    (void)in_sizes; (void)n_in; (void)out_size; (void)ws_size;
    Params P{};
    P.x_in = (const float*)d_in[0]; P.c = (const float*)d_in[1]; P.pos = (const int*)d_in[2]; P.rel_bias = (const float*)d_in[3]; P.final_norm = (const float*)d_in[4];
    P.ada_w = (const float*)d_in[5]; P.ada_b = (const float*)d_in[6]; P.norm_mix = (const float*)d_in[7]; P.w_in = (const float*)d_in[8];
    P.mu = (const float*)d_in[9]; P.w0 = (const float*)d_in[10]; P.w_up = (const float*)d_in[11]; P.a0 = (const float*)d_in[12]; P.a_up = (const float*)d_in[13]; P.g_up = (const float*)d_in[14];
    P.k_k = (const float*)d_in[15]; P.k_a = (const float*)d_in[16]; P.r_k = (const float*)d_in[17]; P.ln_w = (const float*)d_in[18]; P.ln_b = (const float*)d_in[19];
    P.sc_conv_w = (const float*)d_in[20]; P.w_branch = (const float*)d_in[21]; P.w_o = (const float*)d_in[22]; P.norm_ffn = (const float*)d_in[23];
    P.ffn_w_up = (const float*)d_in[24]; P.ffn_conv_w = (const float*)d_in[25]; P.ffn_w_down = (const float*)d_in[26];
    P.out = (float*)d_out; P.ws = (unsigned char*)d_ws;
#if MK_SINGLE
    static bool attr = false;
    if (!attr) { hipFuncSetAttribute((const void*)k_mega, hipFuncAttributeMaxDynamicSharedMemorySize, LDS_BYTES); attr = true; }
    hipMemsetAsync((unsigned char*)d_ws + OFF_BAR, 0, XCD_BAR_WORDS * sizeof(unsigned), stream);
    hipLaunchKernelGGL(k_mega, dim3(NBLK), dim3(NTHR), LDS_BYTES, stream, P);
#else
    for (int l = 0; l < 2; ++l) {
        launch_phase<PH_PRO>(P, l, stream); launch_phase<PH_NORM1>(P, l, stream); launch_phase<PH_ZQ>(P, l, stream); launch_phase<PH_KI>(P, l, stream); launch_phase<PH_IDX>(P, l, stream);
        launch_phase<PH_ATT>(P, l, stream); launch_phase<PH_ZR>(P, l, stream); launch_phase<PH_SCAN>(P, l, stream); launch_phase<PH_COMB>(P, l, stream);
        launch_phase<PH_POST>(P, l, stream); launch_phase<PH_ZC>(P, l, stream); launch_phase<PH_CONV>(P, l, stream); launch_phase<PH_MERGE>(P, l, stream);
        launch_phase<PH_WO>(P, l, stream); launch_phase<PH_NORM2>(P, l, stream); launch_phase<PH_UP>(P, l, stream); launch_phase<PH_U>(P, l, stream);
        launch_phase<PH_DOWN>(P, l, stream);
    }
    launch_phase<PH_FINAL>(P, 0, stream);
#endif
}
```

```cpp
#include <hip/hip_runtime.h>
#include <stdint.h>

#ifndef MK_SINGLE
#define MK_SINGLE 1
#endif

#define LAS __attribute__((address_space(3)))
typedef unsigned short bf16_t;
typedef short bf16x8 __attribute__((ext_vector_type(8)));
typedef short bf16x4 __attribute__((ext_vector_type(4)));
typedef float f32x4 __attribute__((ext_vector_type(4)));
typedef float f32x16 __attribute__((ext_vector_type(16)));
typedef float f32x2 __attribute__((ext_vector_type(2)));
typedef unsigned u32x4 __attribute__((ext_vector_type(4)));
typedef unsigned u32x2 __attribute__((ext_vector_type(2)));
typedef int i32x4 __attribute__((ext_vector_type(4)));
typedef unsigned long long u64;
typedef unsigned long long u64x2 __attribute__((ext_vector_type(2)));

constexpr int T_ = 32768, D_ = 1024, NB_ = 8, S_ = 4096;
constexpr int NSEG = 32, SEGL = 128, TB = 8;
constexpr int NBLK = 256, NTHR = 512;
constexpr int IN_COLS = 8520, DFF = 2816;
constexpr int LDS_BYTES = 150 * 1024;

constexpr size_t MiB = 1ull << 20;
constexpr size_t OFF_BAR = 0;
constexpr size_t OFF_MOD = 64 * 1024;
constexpr size_t OFF_TAB = 512 * 1024;
constexpr size_t OFF_KPM = 520 * 1024;
constexpr size_t OFF_WB = 2 * MiB;
constexpr size_t WB_WIN = 0;
constexpr size_t WB_WBR = WB_WIN + (size_t)8704 * 1024 * 2;
constexpr size_t WB_WO = WB_WBR + (size_t)3 * 1024 * 512 * 2;
constexpr size_t WB_WUP = WB_WO + (size_t)1024 * 1024 * 2;
constexpr size_t WB_WDN = WB_WUP + (size_t)5632 * 1024 * 2;
constexpr size_t WB_LW = WB_WDN + (size_t)1024 * 2816 * 2;
constexpr size_t WB_LA = WB_LW + (size_t)512 * 64 * 2;
constexpr size_t WB_LG = WB_LA + (size_t)512 * 64 * 2;
constexpr size_t OFF_H = 42 * MiB;
constexpr size_t OFF_ZQ = 106 * MiB;
constexpr size_t OFF_MASK = 250 * MiB;
constexpr size_t OFF_VT = 266 * MiB;
constexpr size_t OFF_ZR = 106 * MiB;
constexpr size_t OFF_Y = 218 * MiB;
constexpr size_t OFF_P = 250 * MiB;
constexpr size_t OFF_G = 282 * MiB;
constexpr size_t OFF_SEG = 314 * MiB;
constexpr size_t OFF_KI = 314 * MiB;
constexpr size_t OFF_ZCV = 106 * MiB;
constexpr size_t OFF_ZG = 202 * MiB;
constexpr size_t OFF_MRG = 106 * MiB;
constexpr size_t OFF_UP = 106 * MiB;
constexpr size_t OFF_HA = 300 * MiB;
constexpr size_t OFF_HB = 320 * MiB;
constexpr size_t OFF_OCONV = 416 * MiB;
constexpr size_t OFF_ORWKV = 448 * MiB;
constexpr size_t OFF_OATT = 480 * MiB;
constexpr size_t OFF_VB = OFF_ORWKV;
constexpr size_t OFF_SCR = 378 * MiB;

struct Params {
    const float* x_in; const float* c; const int* pos; const float* rel_bias; const float* final_norm;
    const float* ada_w; const float* ada_b; const float* norm_mix; const float* w_in;
    const float* mu; const float* w0; const float* w_up; const float* a0; const float* a_up; const float* g_up;
    const float* k_k; const float* k_a; const float* r_k; const float* ln_w; const float* ln_b;
    const float* sc_conv_w; const float* w_branch; const float* w_o; const float* norm_ffn;
    const float* ffn_w_up; const float* ffn_conv_w; const float* ffn_w_down;
    float* out; unsigned char* ws;
};

__device__ __forceinline__ float bf2f(bf16_t b) { return __uint_as_float(((unsigned)b) << 16); }
__device__ __forceinline__ bf16_t f2bf(float f) { unsigned u = __float_as_uint(f); u += 0x7FFFu + ((u >> 16) & 1u); return (bf16_t)(u >> 16); }
typedef __bf16 bf16x2_t __attribute__((ext_vector_type(2)));
__device__ __forceinline__ unsigned cvt_pk_bf16(float lo, float hi) { const f32x2 v = {lo, hi}; return __builtin_bit_cast(unsigned, __builtin_convertvector(v, bf16x2_t)); }
__device__ __forceinline__ float bflo(unsigned w) { return __uint_as_float(w << 16); }
__device__ __forceinline__ float bfhi(unsigned w) { return __uint_as_float(w & 0xffff0000u); }
__device__ __forceinline__ float shx(float v, int mask, int lane) { return __int_as_float(__builtin_amdgcn_ds_bpermute((lane ^ mask) << 2, __float_as_int(v))); }
__device__ __forceinline__ int shxi(int v, int mask, int lane) { return __builtin_amdgcn_ds_bpermute((lane ^ mask) << 2, v); }
__device__ __forceinline__ float wave_sum(float v, int lane) {
#pragma unroll
    for (int o = 32; o >= 1; o >>= 1) v += shx(v, o, lane);
    return v;
}
__device__ __forceinline__ void writelane_c2(int& vlo, int& vhi, int lo, int hi, int ln  ) {
    asm("s_nop 3\n\tv_writelane_b32 %0, %2, %4\n\tv_writelane_b32 %1, %3, %4" : "+v"(vlo), "+v"(vhi) : "s"(lo), "s"(hi), "n"(ln)); }
__device__ __forceinline__ int writelane_v(int vec, int val, int ln  ) { asm("s_mov_b32 m0, %2\n\ts_nop 3\n\tv_writelane_b32 %0, %1, m0" : "+v"(vec) : "s"(val), "s"(ln) : "m0"); return vec; }
__device__ __forceinline__ float sigmoidf_(float x) { return __builtin_amdgcn_rcpf(1.0f + __expf(-x)); }
__device__ __forceinline__ unsigned f2ord(float x) { unsigned u = __float_as_uint(x); return (u & 0x80000000u) ? ~u : (u | 0x80000000u); }
__device__ __forceinline__ float ord2f(unsigned k) { return __uint_as_float((k & 0x80000000u) ? (k & 0x7fffffffu) : ~k); }

__device__ __forceinline__ int opaque_tid() { int t = threadIdx.x; asm volatile("" : "+v"(t)); return t; }
__device__ __forceinline__ unsigned char* opaque_ptr(unsigned char* p) {
    typedef __attribute__((address_space(1))) unsigned char* gptr_t;
    gptr_t g = (gptr_t)p; asm volatile("" : "+s"(g)); return (unsigned char*)g; }

#define XB_TMO      128
#define XB_XCNT(j)  (256  + 64 * (j))
#define XB_XSUB(j)  (1280 + 64 * (j))
#define XB_XGEN(j)  (2304 + 64 * (j))
#define XB_TOP      3328
#define XB_TOPGEN   3392
#define XCD_BAR_WORDS 3456
#define XB_SPIN_CAP (1u << 22)

__device__ __forceinline__ unsigned xb_ld(unsigned* p)              { return __hip_atomic_load(p, __ATOMIC_RELAXED, __HIP_MEMORY_SCOPE_AGENT); }
__device__ __forceinline__ unsigned xb_add(unsigned* p, unsigned v) { return __hip_atomic_fetch_add(p, v, __ATOMIC_RELAXED, __HIP_MEMORY_SCOPE_AGENT); }
__device__ __forceinline__ unsigned xb_xcc_id() { return (unsigned)__builtin_amdgcn_s_getreg((3 << 11) | 20) & 0xFu; }
#define XB_SPIN(cond, bar) do { unsigned _sp = 0; while (cond) { __builtin_amdgcn_s_sleep(1); \
    if ((++_sp & 255u) == 0u) { if (xb_ld(&(bar)[XB_TMO])) break; if (_sp > XB_SPIN_CAP) { atomicAdd(&(bar)[XB_TMO], 1u); break; } } } } while (0)

struct XcdBarrier { unsigned* bar; unsigned x; volatile LAS unsigned* st; };

__device__ __forceinline__ XcdBarrier xcd_barrier_post(unsigned* bar, volatile LAS unsigned* st) {
    XcdBarrier b; b.bar = bar; b.x = xb_xcc_id(); b.st = st;
    if (threadIdx.x == 0) (void)xb_add(&bar[XB_XCNT(b.x)], 1u);
    return b;
}
__device__ __forceinline__ void xcd_barrier_complete(unsigned* bar, unsigned x, unsigned& nloc, unsigned& nx) {
    const unsigned G = gridDim.x * gridDim.y * gridDim.z;
    unsigned sum, cnt, mine, sp = 0u;
    for (;;) {
        sum = 0u; cnt = 0u; mine = 0u;
#pragma unroll
        for (unsigned j = 0; j < 16; ++j) { const unsigned c = xb_ld(&bar[XB_XCNT(j)]); sum += c; cnt += (c > 0u) ? 1u : 0u; mine = (j == x) ? c : mine; }
        if (sum == G) break;
        __builtin_amdgcn_s_sleep(1);
        if ((++sp & 255u) == 0u) { if (xb_ld(&bar[XB_TMO])) break; if (sp > XB_SPIN_CAP) { atomicAdd(&bar[XB_TMO], 1u); break; } }
    }
    nloc = mine > 0u ? mine : 1u; nx = cnt > 0u ? cnt : 1u;
}
__device__ __forceinline__ void xcd_barrier(const XcdBarrier& b) {
    asm volatile("s_waitcnt vmcnt(0)" ::: "memory");
    __syncthreads();
    if (threadIdx.x == 0) {
        unsigned* bar = b.bar;
        __builtin_amdgcn_s_waitcnt(0);
        unsigned nloc = b.st[0], nx = b.st[1];
        if (nloc == 0u) { xcd_barrier_complete(bar, b.x, nloc, nx); b.st[0] = nloc; b.st[1] = nx; }
        const unsigned old = xb_add(&bar[XB_XSUB(b.x)], 1u);
        const unsigned gen = old / nloc;
        if (old + 1u == (gen + 1u) * nloc) {
            __builtin_amdgcn_fence(__ATOMIC_RELEASE, "agent");
            asm volatile("s_waitcnt vmcnt(0)" ::: "memory");
            const unsigned og = xb_add(&bar[XB_TOP], 1u);
            const unsigned tg = og / nx;
            if (og + 1u == (tg + 1u) * nx) xb_add(&bar[XB_TOPGEN], 1u);
            else XB_SPIN(xb_ld(&bar[XB_TOPGEN]) == tg, bar);
            __builtin_amdgcn_fence(__ATOMIC_ACQUIRE, "agent");
            xb_add(&bar[XB_XGEN(b.x)], 1u);
            asm volatile("s_waitcnt vmcnt(0)" ::: "memory");
        } else {
            XB_SPIN(xb_ld(&bar[XB_XGEN(b.x)]) == gen, bar);
            __builtin_amdgcn_fence(__ATOMIC_ACQUIRE, "agent");
            asm volatile("s_waitcnt vmcnt(0)" ::: "memory");
        }
    }
    __syncthreads();
}

namespace g8 {
constexpr int BM = 256, BK = 64, HALF = 128, HTB = HALF * BK * 2, STAGE_BYTES = 8 * HTB, NXCD = 8, WGM = 8;
__device__ __forceinline__ int lds_byte(int r, int c) { const int st = (r >> 4) * 2 + (c >> 5), rr = r & 15, cc = c & 31, ob = rr * 64 + cc * 2; return st * 1024 + (ob ^ (((ob >> 9) & 1) << 5)); }
__device__ __forceinline__ void stage_rc(int b, int& R, int& C) { const int st = b / 1024, sb = b % 1024, swz = sb ^ (((sb >> 9) & 1) << 5); R = (st >> 1) * 16 + swz / 64; C = (st & 1) * 32 + (swz % 64) / 2; }
__device__ __forceinline__ int perm32(int rho) { const int n = rho >> 4, i = rho & 15; return 8 * (i >> 2) + 4 * n + (i & 3); }

struct Unit { const char* A; const char* B; int pm, pn, tag; };

struct SOrder {
    int nM, nN, nwg, G, c; const char* A; const char* Bt; size_t a_t, b_t;
    __device__ void init(int M, int N, int lda, int ldb, const void* A_, const void* Bt_) {
        nM = M / BM; nN = N / BM; nwg = nM * nN; G = (int)gridDim.x; c = (int)blockIdx.x; A = (const char*)A_; Bt = (const char*)Bt_;
        a_t = (size_t)BM * lda * 2; b_t = (size_t)BM * ldb * 2; }
    __device__ bool next(int i, Unit& u) const {
        const long L = (long)i * G + c; if (L >= nwg) return false;
        int wgid = (int)L; { const int q = nwg / NXCD, r = nwg % NXCD, xcd = wgid % NXCD, off = wgid / NXCD; wgid = (xcd < r ? xcd * (q + 1) : r * (q + 1) + (xcd - r) * q) + off; }
        const int nig = WGM * nN, gid = wgid / nig, fm = gid * WGM, gsz = (nM - fm) < WGM ? (nM - fm) : WGM;
        u.pm = fm + ((wgid % nig) % gsz); u.pn = (wgid % nig) / gsz; u.tag = 0;
        u.A = A + (size_t)u.pm * a_t; u.B = Bt + (size_t)u.pn * b_t; return true;
    }
};

template <class Epi, class Sched>
__device__ __forceinline__ void gemm_phase(LAS unsigned char* lds, const int K, const int lda, const int ldb, const Sched& S, const Epi& E) {
    const int tid = opaque_tid(), wid = __builtin_amdgcn_readfirstlane(tid >> 6), lane = tid & 63, wr = wid >> 2, wc = wid & 3, fr = lane & 15, fq = lane >> 4;
    const int nt = K / BK;
    unsigned voffA[2], voffB[2];
#pragma unroll
    for (int i = 0; i < 2; ++i) { int R, C; stage_rc(tid * 16 + i * 8192, R, C); const int Rb = Epi::PERM ? ((R & ~31) + perm32(R & 31)) : R;
        voffA[i] = (unsigned)(R * lda + C) * 2u; voffB[i] = (unsigned)(Rb * ldb + C) * 2u; }
    const size_t kstep = (size_t)(BK * 2);
    const size_t hstepA = (size_t)HALF * lda * 2, hstepB = (size_t)HALF * ldb * 2;
    const unsigned ldsw = (unsigned)wid * 1024u;
    const int aoff = lds_byte(wr * 64 + fr, fq * 8), boff = lds_byte(wc * 32 + fr, fq * 8);
#define PG8_SA(b, h) (((b) * 2 + (h)) * HTB)
#define PG8_SB(b, h) ((4 + (b) * 2 + (h)) * HTB)
#define PG8_STAGE(bufoff, gbase, voff) do { _Pragma("unroll") for (int _i = 0; _i < 2; ++_i) \
        __builtin_amdgcn_global_load_lds((const unsigned*)((const char*)(gbase) + (voff)[_i]), (LAS unsigned*)(lds + (bufoff) + ldsw + _i * 8192), 16, 0, 0); } while (0)
#define PG8_LDA(dst, b, h) do { _Pragma("unroll") for (int m = 0; m < 4; ++m) _Pragma("unroll") for (int k = 0; k < 2; ++k) dst[m][k] = *(const LAS bf16x8*)(lds + PG8_SA(b, h) + aoff + m * 2048 + k * 1024); } while (0)
#define PG8_LDB(dst, b, h) do { _Pragma("unroll") for (int n = 0; n < 2; ++n) _Pragma("unroll") for (int k = 0; k < 2; ++k) dst[n][k] = *(const LAS bf16x8*)(lds + PG8_SB(b, h) + boff + n * 2048 + k * 1024); } while (0)
#define PG8_MMA(ai, bj, At, Bt) do { __builtin_amdgcn_s_setprio(1); _Pragma("unroll") for (int m = 0; m < 4; ++m) _Pragma("unroll") for (int n = 0; n < 2; ++n) _Pragma("unroll") for (int k = 0; k < 2; ++k) \
        acc[ai][bj][m][n] = __builtin_amdgcn_mfma_f32_16x16x32_bf16(Bt[n][k], At[m][k], acc[ai][bj][m][n], 0, 0, 0); __builtin_amdgcn_s_setprio(0); } while (0)
#define PG8_WAIT_V(n) asm volatile("s_waitcnt vmcnt(" #n ")" ::: "memory")
#define PG8_WAIT_L(n) asm volatile("s_waitcnt lgkmcnt(" #n ")" ::: "memory")
#define PG8_BAR __builtin_amdgcn_s_barrier()
#define PG8_SCHED __builtin_amdgcn_sched_barrier(0)
    Unit cur, nxt; int ui = 0;
    if (!S.next(0, cur)) return;
    f32x4 acc[2][2][4][2];
#pragma unroll
    for (int a = 0; a < 2; ++a)
#pragma unroll
        for (int b = 0; b < 2; ++b)
#pragma unroll
            for (int m = 0; m < 4; ++m)
#pragma unroll
                for (int n = 0; n < 2; ++n) acc[a][b][m][n] = (f32x4){0.f, 0.f, 0.f, 0.f};
    bf16x8 At[4][2], B0[2][2], B1[2][2];
    const char* cA = cur.A; const char* cB = cur.B;
    PG8_STAGE(PG8_SB(0, 0), cB, voffB); PG8_STAGE(PG8_SA(0, 0), cA, voffA); PG8_STAGE(PG8_SB(0, 1), cB + hstepB, voffB); PG8_STAGE(PG8_SA(0, 1), cA + hstepA, voffA);
    if (wr == 1) PG8_BAR;
    PG8_WAIT_V(4); PG8_BAR;
    PG8_STAGE(PG8_SB(1, 0), cB + kstep, voffB); PG8_STAGE(PG8_SA(1, 0), cA + kstep, voffA); PG8_STAGE(PG8_SB(1, 1), cB + hstepB + kstep, voffB);
    PG8_WAIT_V(6); PG8_BAR;
    for (;;) {
        const bool has_next = S.next(ui + 1, nxt);
        const char* nA = has_next ? nxt.A : cA; const char* nB = has_next ? nxt.B : cB;
        for (int t = 0; t < nt; t += 2) {
            const bool last = (t == nt - 2);
            const char* a1 = cA + (size_t)(t + 1) * kstep;
            const char* a2 = last ? nA : cA + (size_t)(t + 2) * kstep; const char* b2 = last ? nB : cB + (size_t)(t + 2) * kstep;
            const char* a3 = a2 + kstep; const char* b3 = b2 + kstep;
            PG8_LDB(B0, 0, 0); PG8_SCHED; PG8_LDA(At, 0, 0); PG8_STAGE(PG8_SA(1, 1), a1 + hstepA, voffA);
            PG8_WAIT_L(8); PG8_BAR; PG8_WAIT_L(0); PG8_MMA(0, 0, At, B0); PG8_BAR; PG8_SCHED;
            PG8_LDB(B1, 0, 1); PG8_STAGE(PG8_SB(0, 0), b2, voffB);
            PG8_BAR; PG8_WAIT_L(0); PG8_MMA(0, 1, At, B1); PG8_BAR;
            PG8_LDA(At, 0, 1); PG8_STAGE(PG8_SA(0, 0), a2, voffA);
            PG8_BAR; PG8_WAIT_L(0); PG8_MMA(1, 0, At, B0); PG8_BAR; PG8_SCHED;
            PG8_STAGE(PG8_SB(0, 1), b2 + hstepB, voffB);
            PG8_WAIT_V(6); PG8_BAR; PG8_MMA(1, 1, At, B1); PG8_BAR;
            PG8_LDB(B0, 1, 0); PG8_SCHED; PG8_LDA(At, 1, 0); PG8_STAGE(PG8_SA(0, 1), a2 + hstepA, voffA);
            PG8_WAIT_L(8); PG8_BAR; PG8_WAIT_L(0); PG8_MMA(0, 0, At, B0); PG8_BAR; PG8_SCHED;
            PG8_LDB(B1, 1, 1); PG8_STAGE(PG8_SB(1, 0), b3, voffB);
            PG8_BAR; PG8_WAIT_L(0); PG8_MMA(0, 1, At, B1); PG8_BAR;
            PG8_LDA(At, 1, 1); PG8_STAGE(PG8_SA(1, 0), a3, voffA);
            PG8_BAR; PG8_WAIT_L(0); PG8_MMA(1, 0, At, B0); PG8_BAR; PG8_SCHED;
            PG8_STAGE(PG8_SB(1, 1), b3 + hstepB, voffB);
            PG8_WAIT_V(6); PG8_BAR; PG8_MMA(1, 1, At, B1); PG8_BAR;
        }
        bool keep = false;
        if constexpr (Epi::CHAIN) keep = E.chain(acc, cur, wr, wc, fr, fq); else E(acc, cur, wr, wc, fr, fq);
        if (!has_next) break;
        if (!keep) {
#pragma unroll
            for (int a = 0; a < 2; ++a)
#pragma unroll
                for (int b = 0; b < 2; ++b)
#pragma unroll
                    for (int m = 0; m < 4; ++m)
#pragma unroll
                        for (int n = 0; n < 2; ++n) acc[a][b][m][n] = (f32x4){0.f, 0.f, 0.f, 0.f};
        }
        cur = nxt; cA = nA; cB = nB; ++ui;
    }
    PG8_WAIT_V(0);
    if (wr == 0) PG8_BAR;
    PG8_BAR;
#undef PG8_SA
#undef PG8_SB
#undef PG8_STAGE
#undef PG8_LDA
#undef PG8_LDB
#undef PG8_MMA
#undef PG8_WAIT_V
#undef PG8_WAIT_L
#undef PG8_BAR
#undef PG8_SCHED
}

struct EpiBf {
    static constexpr bool PERM = true, CHAIN = false;
    bf16_t* O0; int ld0; int split; bf16_t* O1; int ld1; int act1;
    __device__ __forceinline__ void operator()(const f32x4 (&acc)[2][2][4][2], const Unit& u, int wr, int wc, int fr, int fq) const {
        const bool second = u.pn >= split;
        bf16_t* base = second ? O1 : O0; const int ld = second ? ld1 : ld0; const int colt = (second ? (u.pn - split) : u.pn) * BM;
        const bool act = second && act1;
        const int row0 = u.pm * BM + wr * 64 + fr, col0 = colt + wc * 32 + 8 * fq;
#pragma unroll
        for (int ai = 0; ai < 2; ++ai)
#pragma unroll
            for (int m = 0; m < 4; ++m) { bf16_t* rowp = base + (size_t)(row0 + ai * HALF + m * 16) * ld + col0;
#pragma unroll
                for (int bj = 0; bj < 2; ++bj) { f32x4 v0 = acc[ai][bj][m][0], v1 = acc[ai][bj][m][1];
                    if (act) {
#pragma unroll
                        for (int j = 0; j < 4; ++j) { v0[j] = sigmoidf_(v0[j]); v1[j] = sigmoidf_(v1[j]); } }
                    u32x4 w; w.x = cvt_pk_bf16(v0[0], v0[1]); w.y = cvt_pk_bf16(v0[2], v0[3]); w.z = cvt_pk_bf16(v1[0], v1[1]); w.w = cvt_pk_bf16(v1[2], v1[3]);
                    *(u32x4*)(rowp + bj * HALF) = w; } }
    }
};
struct EpiMerge {
    static constexpr bool PERM = true, CHAIN = true;
    bf16_t* M; const bf16_t* ZG;
    __device__ __forceinline__ bool chain(f32x4 (&acc)[2][2][4][2], const Unit& u, int wr, int wc, int fr, int fq) const {
        const int row0 = u.pm * BM + wr * 64 + fr, col0 = u.pn * BM + wc * 32 + 8 * fq;
        const bool last = u.tag == 2;
        const int tn = u.tag * 1024, td = (last ? 2 : u.tag + 1) * 1024;
        const float nlo = u.tag == 0 ? 0.f : 1e-12f;
#pragma unroll
        for (int am = 0; am < 4; ++am) { const int ai = am >> 1, m0 = 2 * (am & 1);
            u32x4 gn[2][2], gd[2][2];
            int ro = row0; asm volatile("" : "+v"(ro));
#pragma unroll
            for (int mm = 0; mm < 2; ++mm)
#pragma unroll
                for (int bj = 0; bj < 2; ++bj) { const bf16_t* gp = ZG + (size_t)(ro + ai * HALF + (m0 + mm) * 16) * 3072 + col0 + bj * HALF;
                    gn[mm][bj] = *(const u32x4*)(gp + tn); gd[mm][bj] = *(const u32x4*)(gp + td); }
#pragma unroll
            for (int mm = 0; mm < 2; ++mm)
#pragma unroll
                for (int bj = 0; bj < 2; ++bj) {
                    const u32x4 g = gn[mm][bj], h = gd[mm][bj];
                    const float nn[8] = {bflo(g.x), bfhi(g.x), bflo(g.y), bfhi(g.y), bflo(g.z), bfhi(g.z), bflo(g.w), bfhi(g.w)};
                    const float dd[8] = {bflo(h.x), bfhi(h.x), bflo(h.y), bfhi(h.y), bflo(h.z), bfhi(h.z), bflo(h.w), bfhi(h.w)};
                    float f[8];
#pragma unroll
                    for (int e = 0; e < 8; ++e) f[e] = fmaxf(nn[e], nlo) * __builtin_amdgcn_rcpf(last ? 1.0f : fmaxf(dd[e], 1e-12f));
                    f32x4& v0 = acc[ai][bj][m0 + mm][0]; f32x4& v1 = acc[ai][bj][m0 + mm][1];
                    v0[0] *= f[0]; v0[1] *= f[1]; v0[2] *= f[2]; v0[3] *= f[3]; v1[0] *= f[4]; v1[1] *= f[5]; v1[2] *= f[6]; v1[3] *= f[7];
                }
        }
        if (last) {
#pragma unroll
            for (int ai = 0; ai < 2; ++ai)
#pragma unroll
                for (int m = 0; m < 4; ++m) { const size_t r = (size_t)(row0 + ai * HALF + m * 16);
#pragma unroll
                    for (int bj = 0; bj < 2; ++bj) { const f32x4 v0 = acc[ai][bj][m][0], v1 = acc[ai][bj][m][1];
                        u32x4 w; w.x = cvt_pk_bf16(v0[0], v0[1]); w.y = cvt_pk_bf16(v0[2], v0[3]); w.z = cvt_pk_bf16(v1[0], v1[1]); w.w = cvt_pk_bf16(v1[2], v1[3]);
                        *(u32x4*)(M + r * 1024 + col0 + bj * HALF) = w; } }
        }
        return !last;
    }
};
struct EpiRes {
    static constexpr bool PERM = true, CHAIN = false;
    const float* xin32; const bf16_t* xin16; bf16_t* xout; const float* gate;
    template <bool F32>
    __device__ __forceinline__ void body(const f32x4 (&acc)[2][2][4][2], const Unit& u, int wr, int wc, int fr, int fq) const {
        const int row0 = u.pm * BM + wr * 64 + fr, col0 = u.pn * BM + wc * 32 + 8 * fq;
        const float* gp = gate + (size_t)(u.pm >> 4) * 6144 + col0;
        f32x4 gv[2][2];
#pragma unroll
        for (int bj = 0; bj < 2; ++bj) { gv[bj][0] = *(const f32x4*)(gp + bj * HALF); gv[bj][1] = *(const f32x4*)(gp + bj * HALF + 4); }
#pragma unroll
        for (int am = 0; am < 4; ++am) { const int ai = am >> 1, m0 = 2 * (am & 1);
            f32x4 xa[4][2][2]; u32x4 xw[4][2];
            int ro = row0; asm volatile("" : "+v"(ro));
#pragma unroll
            for (int m = m0; m < m0 + 2; ++m) { const size_t off = (size_t)(ro + ai * HALF + m * 16) * 1024 + col0;
#pragma unroll
                for (int bj = 0; bj < 2; ++bj) {
                    if (F32) { xa[m][bj][0] = *(const f32x4*)(xin32 + off + bj * HALF); xa[m][bj][1] = *(const f32x4*)(xin32 + off + bj * HALF + 4); }
                    else xw[m][bj] = *(const u32x4*)(xin16 + off + bj * HALF); } }
#pragma unroll
            for (int m = m0; m < m0 + 2; ++m) { const size_t off = (size_t)(ro + ai * HALF + m * 16) * 1024 + col0;
#pragma unroll
                for (int bj = 0; bj < 2; ++bj) {
                    f32x4 x0, x1;
                    if (F32) { x0 = xa[m][bj][0]; x1 = xa[m][bj][1]; }
                    else { const u32x4 w = xw[m][bj];
                        x0 = (f32x4){bflo(w.x), bfhi(w.x), bflo(w.y), bfhi(w.y)}; x1 = (f32x4){bflo(w.z), bfhi(w.z), bflo(w.w), bfhi(w.w)}; }
                    const f32x4 o0 = x0 + gv[bj][0] * acc[ai][bj][m][0], o1 = x1 + gv[bj][1] * acc[ai][bj][m][1];
                    u32x4 w; w.x = cvt_pk_bf16(o0[0], o0[1]); w.y = cvt_pk_bf16(o0[2], o0[3]); w.z = cvt_pk_bf16(o1[0], o1[1]); w.w = cvt_pk_bf16(o1[2], o1[3]);
                    *(u32x4*)(xout + off + bj * HALF) = w; } }
        }
    }
    __device__ __forceinline__ void operator()(const f32x4 (&acc)[2][2][4][2], const Unit& u, int wr, int wc, int fr, int fq) const {
        if (xin32) body<true>(acc, u, wr, wc, fr, fq); else body<false>(acc, u, wr, wc, fr, fq);
    }
};
__device__ __forceinline__ float dpp_prev(float x, float y, int n) {
    if (n == 1) { const int yr = __builtin_amdgcn_update_dpp(0, __float_as_int(y), 0x121, 0xf, 0xf, false);
                  return __int_as_float(__builtin_amdgcn_update_dpp(yr, __float_as_int(x), 0x111, 0xf, 0xf, false)); }
    const int yr = __builtin_amdgcn_update_dpp(0, __float_as_int(y), 0x122, 0xf, 0xf, false);
    return __int_as_float(__builtin_amdgcn_update_dpp(yr, __float_as_int(x), 0x112, 0xf, 0xf, false));
}
struct EpiUp {
    static constexpr bool PERM = true, CHAIN = false;
    bf16_t* U; float* HA; float* HB; const float* cw;
    __device__ __forceinline__ void operator()(const f32x4 (&acc)[2][2][4][2], const Unit& u, int wr, int wc, int fr, int fq) const {
        const int c0 = 128 * u.pn + 32 * wc + 8 * fq;
        float w0[8], w1[8], w2[8];
        { float f[24];
#pragma unroll
          for (int q = 0; q < 6; ++q) { const f32x4 v = *(const f32x4*)(cw + (size_t)c0 * 3 + 4 * q); f[4 * q] = v[0]; f[4 * q + 1] = v[1]; f[4 * q + 2] = v[2]; f[4 * q + 3] = v[3]; }
#pragma unroll
          for (int e = 0; e < 8; ++e) { w0[e] = f[3 * e]; w1[e] = f[3 * e + 1]; w2[e] = f[3 * e + 2]; } }
#pragma unroll
        for (int ai = 0; ai < 2; ++ai) {
            const int grp = 4 * u.pm + 2 * ai + wr;
            float Y[8];
#pragma unroll
            for (int e = 0; e < 8; ++e) Y[e] = 0.f;
#pragma unroll
            for (int m = 0; m < 4; ++m) {
                const size_t row = (size_t)u.pm * BM + ai * HALF + wr * 64 + m * 16 + fr;
                float X[8], G[8], o[8];
#pragma unroll
                for (int e = 0; e < 8; ++e) { X[e] = acc[ai][0][m][e >> 2][e & 3]; G[e] = acc[ai][1][m][e >> 2][e & 3]; }
#pragma unroll
                for (int e = 0; e < 8; ++e) { const float a1 = dpp_prev(X[e], Y[e], 1), a2 = dpp_prev(X[e], Y[e], 2);
                    const float s = w0[e] * a2 + w1[e] * a1 + w2[e] * X[e]; o[e] = s * sigmoidf_(s) * G[e]; }
                if (m > 0 || fr >= 2) { u32x4 w; w.x = cvt_pk_bf16(o[0], o[1]); w.y = cvt_pk_bf16(o[2], o[3]); w.z = cvt_pk_bf16(o[4], o[5]); w.w = cvt_pk_bf16(o[6], o[7]);
                    *(u32x4*)(U + row * DFF + c0) = w; }
                if (m == 0 && fr < 2) { float* hb = HB + ((size_t)(grp * 2 + fr) * 2) * DFF + c0;
                    *(f32x4*)hb = (f32x4){X[0], X[1], X[2], X[3]}; *(f32x4*)(hb + 4) = (f32x4){X[4], X[5], X[6], X[7]};
                    *(f32x4*)(hb + DFF) = (f32x4){G[0], G[1], G[2], G[3]}; *(f32x4*)(hb + DFF + 4) = (f32x4){G[4], G[5], G[6], G[7]}; }
                if (m == 3 && fr >= 14) { float* ha = HA + (size_t)(grp * 2 + fr - 14) * DFF + c0;
                    *(f32x4*)ha = (f32x4){X[0], X[1], X[2], X[3]}; *(f32x4*)(ha + 4) = (f32x4){X[4], X[5], X[6], X[7]}; }
#pragma unroll
                for (int e = 0; e < 8; ++e) Y[e] = X[e];
            }
        }
    }
};
struct MergeOrder {
    int G, c; const char* o_att; const char* wbr;
    __device__ bool next(int i, Unit& u) const {
        const int tile = (i / 3) * G + c; if (tile >= (T_ / BM) * 4) return false;
        const int br = i % 3; u.pm = tile >> 2; u.pn = tile & 3; u.tag = br;
        u.A = o_att - (size_t)br * (32 * MiB) + (size_t)u.pm * BM * 512 * 2;
        u.B = wbr + (size_t)br * 1024 * 512 * 2 + (size_t)u.pn * BM * 512 * 2; return true;
    }
};
}

#define GSTRIDE_BLOCKS(var, n) for (int var = blockIdx.x; var < (n); var += gridDim.x)

__device__ __forceinline__ void ph_mod(const Params& P, LAS unsigned char* lds) {
    LAS float* cl = (LAS float*)lds;
    LAS float* red = cl + 8192;
    float* mod = (float*)(P.ws + OFF_MOD); float* tab = (float*)(P.ws + OFF_TAB);
    const int tid = opaque_tid(), wid = tid >> 6, lane = tid & 63;
    for (int i = tid; i < 2048; i += NTHR) ((LAS f32x4*)cl)[i] = ((const f32x4*)P.c)[i];
    __syncthreads();
    GSTRIDE_BLOCKS(blk, 192) {
        const int l = blk / 96, jb = blk % 96, j = jb * 64 + lane;
        float acc[8];
#pragma unroll
        for (int b = 0; b < 8; ++b) acc[b] = 0.f;
        const float* aw = P.ada_w + (size_t)l * 1024 * 6144 + j;
#pragma unroll 1
        for (int k = wid * 128; k < wid * 128 + 128; k += 32) {
            float w[32];
#pragma unroll
            for (int u = 0; u < 32; ++u) w[u] = aw[(size_t)(k + u) * 6144];
#pragma unroll
            for (int u4 = 0; u4 < 8; ++u4)
#pragma unroll
                for (int b = 0; b < 8; ++b) { const f32x4 c4 = *(const LAS f32x4*)(cl + b * 1024 + k + 4 * u4);
                    acc[b] += c4.x * w[4 * u4]; acc[b] += c4.y * w[4 * u4 + 1]; acc[b] += c4.z * w[4 * u4 + 2]; acc[b] += c4.w * w[4 * u4 + 3]; }
        }
#pragma unroll
        for (int b = 0; b < 8; ++b) red[(wid * 8 + b) * 64 + lane] = acc[b];
        __syncthreads();
        { const int b = wid; float s = P.ada_b[l * 6144 + j];
#pragma unroll
          for (int w = 0; w < 8; ++w) s += red[(w * 8 + b) * 64 + lane];
          mod[((size_t)l * 8 + b) * 6144 + j] = s; }
        __syncthreads();
    }
    if (blockIdx.x == gridDim.x - 1) {
        for (int i = tid; i < 1024; i += NTHR) { const int n = i >> 3, h = i & 7; int bk;
            if (n < 16) bk = n; else { const float nf = (float)n; bk = 16 + (int)(logf(nf / 16.0f) / 2.0794415416798357f * 16.0f); bk = bk < 31 ? bk : 31; }
            tab[i] = P.rel_bias[bk * 8 + h]; }
    }
}

struct WJob { const float* src; int ldsrc; int K; int N; bf16_t* dst; int win; };
__device__ __forceinline__ int wjob_col(const WJob& J, const int nn) {
    int col = nn;
    if (J.win == 1) col = nn < 2120 ? nn : (nn < 2304 ? -1 : nn - 184);
    if (J.win == 2) col = ((nn & 255) < 128) ? 128 * (nn >> 8) + (nn & 127) : DFF + 128 * (nn >> 8) + (nn & 127);
    return col;
}
template <int KT  >
__device__ __forceinline__ void wtile_load(const WJob& J, const int lt, const int tid, float (&v)[KT / 8]) {
    const int nkt = J.K / KT, kt = lt % nkt, ntb = lt / nkt, k0 = kt * KT, n0 = ntb * 64;
    const int n = tid & 63, kk0 = tid >> 6; const int col = wjob_col(J, n0 + n);
#pragma unroll
    for (int p = 0; p < KT / 8; ++p) { const int k = kk0 + 8 * p; v[p] = col >= 0 ? J.src[(size_t)(k0 + k) * J.ldsrc + col] : 0.f; }
}
template <int KT>
__device__ __forceinline__ void wtile_put(LAS float* tile  , const int tid, const float (&v)[KT / 8]) {
    const int n = tid & 63, kk0 = tid >> 6;
#pragma unroll
    for (int p = 0; p < KT / 8; ++p) tile[(kk0 + 8 * p) * 65 + n] = v[p];
}
template <int KT>
__device__ __forceinline__ void wtile_out(const WJob& J, const int lt, const int tid, const LAS float* tile) {
    const int nkt = J.K / KT, kt = lt % nkt, ntb = lt / nkt, k0 = kt * KT, n0 = ntb * 64;
#pragma unroll
    for (int q = 0; q < KT / 64; ++q) { const int n = tid >> 3, kg = (tid & 7) + 8 * q; float v[8];
#pragma unroll
      for (int e = 0; e < 8; ++e) v[e] = tile[(kg * 8 + e) * 65 + n];
      u32x4 w; w.x = cvt_pk_bf16(v[0], v[1]); w.y = cvt_pk_bf16(v[2], v[3]); w.z = cvt_pk_bf16(v[4], v[5]); w.w = cvt_pk_bf16(v[6], v[7]);
      *(u32x4*)(J.dst + (size_t)(n0 + n) * J.K + k0 + kg * 8) = w; }
}
__device__ __forceinline__ void ph_wconv(const Params& P, int l, LAS unsigned char* lds) {
    LAS float* tile = (LAS float*)lds; unsigned char* wb = P.ws + OFF_WB;
    const int tid = opaque_tid();
    constexpr int NBIG = 1232;
    auto big_job = [&](const int ti, WJob& J, int& lt) {
        if (ti < 544) { J = WJob{P.w_in + (size_t)l * 1024 * IN_COLS, IN_COLS, 1024, 8704, (bf16_t*)(wb + WB_WIN), 1}; lt = ti; }
        else if (ti < 640) { const int i = (ti - 544) >> 5; J = WJob{P.w_branch + ((size_t)l * 3 + i) * 512 * 1024, 1024, 512, 1024, (bf16_t*)(wb + WB_WBR) + (size_t)i * 1024 * 512, 0}; lt = (ti - 544) & 31; }
        else if (ti < 704) { J = WJob{P.w_o + (size_t)l * 1024 * 1024, 1024, 1024, 1024, (bf16_t*)(wb + WB_WO), 0}; lt = ti - 640; }
        else if (ti < 1056) { J = WJob{P.ffn_w_up + (size_t)l * 1024 * 5632, 5632, 1024, 5632, (bf16_t*)(wb + WB_WUP), 2}; lt = ti - 704; }
        else { J = WJob{P.ffn_w_down + (size_t)l * 2816 * 1024, 1024, 2816, 1024, (bf16_t*)(wb + WB_WDN), 0}; lt = ti - 1056; } };
    {
        int ti = blockIdx.x; WJob J; int lt; float v[32];
        big_job(ti, J, lt); wtile_load<256>(J, lt, tid, v);
        for (;;) {
            wtile_put<256>(tile, tid, v);
            __syncthreads();
            const int tn = ti + gridDim.x; const bool more = tn < NBIG; WJob Jn = J; int ltn = lt;
            if (more) { big_job(tn, Jn, ltn); wtile_load<256>(Jn, ltn, tid, v); }
            wtile_out<256>(J, lt, tid, tile);
            __syncthreads();
            if (!more) break;
            J = Jn; lt = ltn; ti = tn;
        }
    }
    for (int ts = gridDim.x - 1 - blockIdx.x; ts < 32; ts += gridDim.x) {
        WJob J; int lt;
        if (ts < 8) { J = WJob{P.w_up + (size_t)l * 64 * 512, 512, 64, 512, (bf16_t*)(wb + WB_LW), 0}; lt = ts; }
        else if (ts < 16) { J = WJob{P.a_up + (size_t)l * 64 * 512, 512, 64, 512, (bf16_t*)(wb + WB_LA), 0}; lt = ts - 8; }
        else { J = WJob{P.g_up + (size_t)l * 128 * 512, 512, 128, 512, (bf16_t*)(wb + WB_LG), 0}; lt = ts - 16; }
        float v[8];
        wtile_load<64>(J, lt, tid, v); wtile_put<64>(tile, tid, v);
        __syncthreads();
        wtile_out<64>(J, lt, tid, tile);
        __syncthreads();
    }
}

__device__ __forceinline__ void ph_norm(const Params& P, int l, int which) {
    const bool first = (l == 0 && which == 0);
    const float* nw = (which == 0 ? P.norm_mix : P.norm_ffn) + l * 1024;
    const float* mod = (const float*)(P.ws + OFF_MOD) + (size_t)l * 8 * 6144 + which * 3072;
    const bf16_t* XB = (const bf16_t*)P.out;
    bf16_t* H = (bf16_t*)(P.ws + OFF_H);
    const int tid = opaque_tid(), wid = tid >> 6, lane = tid & 63;
    for (int row = blockIdx.x * 8 + wid; row < T_; row += gridDim.x * 8) {
        const int b = row >> 12; const float* mb = mod + (size_t)b * 6144;
        f32x4 v[4]; float ss = 0.f;
#pragma unroll
        for (int i = 0; i < 4; ++i) {
            if (first) v[i] = *(const f32x4*)(P.x_in + (size_t)row * 1024 + i * 256 + lane * 4);
            else { const u32x2 w = *(const u32x2*)(XB + (size_t)row * 1024 + i * 256 + lane * 4); v[i] = (f32x4){bflo(w.x), bfhi(w.x), bflo(w.y), bfhi(w.y)}; }
            ss += v[i][0] * v[i][0] + v[i][1] * v[i][1] + v[i][2] * v[i][2] + v[i][3] * v[i][3]; }
        ss = wave_sum(ss, lane);
        const float rstd = rsqrtf(ss * (1.0f / 1024.0f) + 1e-6f);
#pragma unroll
        for (int i = 0; i < 4; ++i) { const int c = i * 256 + lane * 4;
            const f32x4 g = *(const f32x4*)(nw + c), sh = *(const f32x4*)(mb + c), sc = *(const f32x4*)(mb + 1024 + c);
            const f32x4 y = v[i] * rstd * g * (sc + 1.0f) + sh;
            u32x2 w; w.x = cvt_pk_bf16(y[0], y[1]); w.y = cvt_pk_bf16(y[2], y[3]);
            *(u32x2*)(H + (size_t)row * 1024 + c) = w; }
    }
}

__device__ __forceinline__ void ph_final(const Params& P) {
    const bf16_t* XF = (const bf16_t*)(P.ws + OFF_H);
    const int tid = opaque_tid(), wid = tid >> 6, lane = tid & 63;
    for (int row = blockIdx.x * 8 + wid; row < T_; row += gridDim.x * 8) {
        float* xr = P.out + (size_t)row * 1024;
        f32x4 v[4]; float ss = 0.f;
#pragma unroll
        for (int i = 0; i < 4; ++i) { const u32x2 w = *(const u32x2*)(XF + (size_t)row * 1024 + i * 256 + lane * 4); v[i] = (f32x4){bflo(w.x), bfhi(w.x), bflo(w.y), bfhi(w.y)};
            ss += v[i][0] * v[i][0] + v[i][1] * v[i][1] + v[i][2] * v[i][2] + v[i][3] * v[i][3]; }
        ss = wave_sum(ss, lane);
        const float rstd = rsqrtf(ss * (1.0f / 1024.0f) + 1e-6f);
#pragma unroll
        for (int i = 0; i < 4; ++i) { const int c = i * 256 + lane * 4; const f32x4 g = *(const f32x4*)(P.final_norm + c);
            *(f32x4*)(xr + c) = v[i] * rstd * g; }
    }
}

__device__ __forceinline__ void ph_gemm_zq(const Params& P, LAS unsigned char* lds) {
    g8::SOrder S; S.init(T_, 2304, 1024, 1024, P.ws + OFF_H, P.ws + OFF_WB + WB_WIN);
    g8::EpiBf E{(bf16_t*)(P.ws + OFF_ZQ), 2304, 9, nullptr, 0, 0};
    g8::gemm_phase(lds, 1024, 1024, 1024, S, E);
}
__device__ __forceinline__ void ph_gemm_zr(const Params& P, LAS unsigned char* lds) {
    g8::SOrder S; S.init(T_, 1792, 1024, 1024, P.ws + OFF_H, P.ws + OFF_WB + WB_WIN + (size_t)2304 * 1024 * 2);
    g8::EpiBf E{(bf16_t*)(P.ws + OFF_ZR), 1792, 7, nullptr, 0, 0};
    g8::gemm_phase(lds, 1024, 1024, 1024, S, E);
}
__device__ __forceinline__ void ph_gemm_zc(const Params& P, LAS unsigned char* lds) {
    g8::SOrder S; S.init(T_, 4608, 1024, 1024, P.ws + OFF_H, P.ws + OFF_WB + WB_WIN + (size_t)4096 * 1024 * 2);
    g8::EpiBf E{(bf16_t*)(P.ws + OFF_ZCV), 1536, 6, (bf16_t*)(P.ws + OFF_ZG), 3072, 1};
    g8::gemm_phase(lds, 1024, 1024, 1024, S, E);
}
__device__ __forceinline__ void ph_gemm_merge(const Params& P, LAS unsigned char* lds) {
    g8::MergeOrder S{(int)gridDim.x, (int)blockIdx.x, (const char*)(P.ws + OFF_OATT), (const char*)(P.ws + OFF_WB + WB_WBR)};
    g8::EpiMerge E{(bf16_t*)(P.ws + OFF_MRG), (const bf16_t*)(P.ws + OFF_ZG)};
    g8::gemm_phase(lds, 512, 512, 512, S, E);
}
__device__ __forceinline__ void ph_gemm_wo(const Params& P, int l, LAS unsigned char* lds) {
    g8::SOrder S; S.init(T_, 1024, 1024, 1024, P.ws + OFF_MRG, P.ws + OFF_WB + WB_WO);
    g8::EpiRes E{l == 0 ? P.x_in : nullptr, (const bf16_t*)P.out, (bf16_t*)P.out, (const float*)(P.ws + OFF_MOD) + (size_t)l * 8 * 6144 + 2048};
    g8::gemm_phase(lds, 1024, 1024, 1024, S, E);
}
__device__ __forceinline__ void ph_gemm_up(const Params& P, int l, LAS unsigned char* lds) {
    g8::SOrder S; S.init(T_, 5632, 1024, 1024, P.ws + OFF_H, P.ws + OFF_WB + WB_WUP);
    g8::EpiUp E{(bf16_t*)(P.ws + OFF_UP), (float*)(P.ws + OFF_HA), (float*)(P.ws + OFF_HB), P.ffn_conv_w + (size_t)l * DFF * 3};
    g8::gemm_phase(lds, 1024, 1024, 1024, S, E);
}
__device__ __forceinline__ void ph_gemm_down(const Params& P, int l, LAS unsigned char* lds) {
    g8::SOrder S; S.init(T_, 1024, 2816, 2816, P.ws + OFF_UP, P.ws + OFF_WB + WB_WDN);
    g8::EpiRes E{nullptr, (const bf16_t*)P.out, l == 1 ? (bf16_t*)(P.ws + OFF_H) : (bf16_t*)P.out, (const float*)(P.ws + OFF_MOD) + (size_t)l * 8 * 6144 + 5120};
    g8::gemm_phase(lds, 2816, 2816, 2816, S, E);
}

__device__ __forceinline__ void ph_conv(const Params& P, int l, LAS unsigned char* lds) {
    const bf16_t* Z = (const bf16_t*)(P.ws + OFF_ZCV); bf16_t* O = (bf16_t*)(P.ws + OFF_OCONV);
    LAS float* cwT = (LAS float*)lds;
    const int tid = opaque_tid();
    for (int i = tid; i < 1536; i += NTHR) cwT[(i % 3) * 512 + i / 3] = P.sc_conv_w[(size_t)l * 1536 + i];
    __syncthreads();
    constexpr int RB = 16; const int nitem = (T_ / RB) * 64;
    for (int it = blockIdx.x * NTHR + tid; it < nitem; it += gridDim.x * NTHR) {
        const int rb = it >> 6, c0 = (it & 63) * 8, row0 = rb * RB, t0 = row0 & 4095;
        float w0[8], w1[8], w2[8];
#pragma unroll
        for (int e = 0; e < 8; ++e) { w0[e] = cwT[c0 + e]; w1[e] = cwT[512 + c0 + e]; w2[e] = cwT[1024 + c0 + e]; }
        float pm2[8], pm1[8];
#pragma unroll
        for (int e = 0; e < 8; ++e) { pm2[e] = 0.f; pm1[e] = 0.f; }
        if (t0 >= 2) {
#pragma unroll
            for (int j = 0; j < 2; ++j) { const bf16_t* zr = Z + (size_t)(row0 - 2 + j) * 1536;
                const u32x4 cc = *(const u32x4*)(zr + 512 + c0), cx = *(const u32x4*)(zr + 1024 + c0);
                const unsigned ccw[4] = {cc.x, cc.y, cc.z, cc.w}, cxw[4] = {cx.x, cx.y, cx.z, cx.w};
#pragma unroll
                for (int q = 0; q < 4; ++q) { const float a = bflo(ccw[q]) * bflo(cxw[q]), b2 = bfhi(ccw[q]) * bfhi(cxw[q]);
                    if (j == 0) { pm2[2 * q] = a; pm2[2 * q + 1] = b2; } else { pm1[2 * q] = a; pm1[2 * q + 1] = b2; } } }
        }
#pragma unroll 4
        for (int r = 0; r < RB; ++r) {
            const bf16_t* zr = Z + (size_t)(row0 + r) * 1536;
            const u32x4 cb = *(const u32x4*)(zr + c0), cc = *(const u32x4*)(zr + 512 + c0), cx = *(const u32x4*)(zr + 1024 + c0);
            const unsigned cbw[4] = {cb.x, cb.y, cb.z, cb.w}, ccw[4] = {cc.x, cc.y, cc.z, cc.w}, cxw[4] = {cx.x, cx.y, cx.z, cx.w};
            float cur[8], o[8];
#pragma unroll
            for (int q = 0; q < 4; ++q) { cur[2 * q] = bflo(ccw[q]) * bflo(cxw[q]); cur[2 * q + 1] = bfhi(ccw[q]) * bfhi(cxw[q]); }
#pragma unroll
            for (int e = 0; e < 8; ++e) { o[e] = w0[e] * pm2[e] + w1[e] * pm1[e] + w2[e] * cur[e]; pm2[e] = pm1[e]; pm1[e] = cur[e]; }
            u32x4 w; w.x = cvt_pk_bf16(o[0] * bflo(cbw[0]), o[1] * bfhi(cbw[0])); w.y = cvt_pk_bf16(o[2] * bflo(cbw[1]), o[3] * bfhi(cbw[1]));
            w.z = cvt_pk_bf16(o[4] * bflo(cbw[2]), o[5] * bfhi(cbw[2])); w.w = cvt_pk_bf16(o[6] * bflo(cbw[3]), o[7] * bfhi(cbw[3]));
            *(u32x4*)(O + (size_t)(row0 + r) * 512 + c0) = w;
        }
    }
}

__device__ __forceinline__ void ph_ufix(const Params& P, int l, LAS unsigned char* lds) {
    bf16_t* U = (bf16_t*)(P.ws + OFF_UP); const float* HA = (const float*)(P.ws + OFF_HA); const float* HB = (const float*)(P.ws + OFF_HB);
    LAS float* cwT = (LAS float*)lds;
    const int tid = opaque_tid();
    for (int i = tid; i < DFF * 3; i += NTHR) cwT[(i % 3) * DFF + i / 3] = P.ffn_conv_w[(size_t)l * DFF * 3 + i];
    __syncthreads();
    const int nitem = (T_ / 64) * 2 * 352;
    for (int it = blockIdx.x * NTHR + tid; it < nitem; it += gridDim.x * NTHR) {
        const int c0 = (it % 352) * 8, gr = it / 352, grp = gr >> 1, rr = gr & 1; const bool first = (grp & 63) == 0;
        const float* hb = HB + ((size_t)(grp * 2 + rr) * 2) * DFF + c0;
        float a0[8], a1[8], a2[8], g[8];
#pragma unroll
        for (int q = 0; q < 2; ++q) { const f32x4 va = *(const f32x4*)(hb + 4 * q), vg = *(const f32x4*)(hb + DFF + 4 * q);
#pragma unroll
            for (int e = 0; e < 4; ++e) { a0[4 * q + e] = va[e]; g[4 * q + e] = vg[e]; a1[4 * q + e] = 0.f; a2[4 * q + e] = 0.f; } }
        if (rr == 1) { const float* p1 = HB + ((size_t)(grp * 2) * 2) * DFF + c0;
#pragma unroll
            for (int q = 0; q < 2; ++q) { const f32x4 v = *(const f32x4*)(p1 + 4 * q);
#pragma unroll
                for (int e = 0; e < 4; ++e) a1[4 * q + e] = v[e]; } }
        if (!first) {
            const float* pl = HA + (size_t)((grp - 1) * 2 + 1) * DFF + c0;
            const float* pk = HA + (size_t)((grp - 1) * 2) * DFF + c0;
#pragma unroll
            for (int q = 0; q < 2; ++q) { const f32x4 v63 = *(const f32x4*)(pl + 4 * q), v62 = *(const f32x4*)(pk + 4 * q);
#pragma unroll
                for (int e = 0; e < 4; ++e) { if (rr == 1) a2[4 * q + e] = v63[e]; else { a1[4 * q + e] = v63[e]; a2[4 * q + e] = v62[e]; } } }
        }
        float o[8];
#pragma unroll
        for (int e = 0; e < 8; ++e) { const float s = cwT[c0 + e] * a2[e] + cwT[DFF + c0 + e] * a1[e] + cwT[2 * DFF + c0 + e] * a0[e]; o[e] = s * sigmoidf_(s) * g[e]; }
        u32x4 w; w.x = cvt_pk_bf16(o[0], o[1]); w.y = cvt_pk_bf16(o[2], o[3]); w.z = cvt_pk_bf16(o[4], o[5]); w.w = cvt_pk_bf16(o[6], o[7]);
        *(u32x4*)(U + (size_t)(grp * 64 + rr) * DFF + c0) = w;
    }
}

template <int NR>
__device__ __forceinline__ u64 select_row(LAS float* row, const int t, const int lz) {
    const int imax = t >> 6;
    float x[NR]; float Tx = 0.f; bool have = false, exact = false;
    {
        int bin[NR]; float lo = __builtin_inff(), hi = -__builtin_inff();
        LAS unsigned* hist = (LAS unsigned*)row;
#pragma unroll
        for (int i = 0; i < NR; ++i) { const float v = row[64 * i + lz]; x[i] = (i <= imax) ? v : -__builtin_inff(); hi = fmaxf(hi, x[i]); lo = fminf(lo, (i < imax || x[i] > -__builtin_inff()) ? x[i] : __builtin_inff()); }
#pragma unroll
        for (int o = 32; o >= 1; o >>= 1) { lo = fminf(lo, shx(lo, o, lz)); hi = fmaxf(hi, shx(hi, o, lz)); }
        if (hi > lo) {
            const float scale = 4095.0f / (hi - lo);
#pragma unroll
            for (int q = 0; q < 16; ++q) *(LAS u32x4*)(hist + 256 * q + 4 * lz) = (u32x4){0u, 0u, 0u, 0u};
#pragma unroll
            for (int i = 0; i < NR; ++i) {
                const int bq = (int)fminf(fmaxf((x[i] - lo) * scale, -1.0f), 4095.0f); bin[i] = bq;
                if (bq >= 0) __hip_atomic_fetch_add(hist + bq, 1u, __ATOMIC_RELAXED, __HIP_MEMORY_SCOPE_WORKGROUP); }
            unsigned c1 = 0u;
#pragma unroll
            for (int q = 0; q < 16; ++q) { const u32x4 h4 = *(const LAS u32x4*)(hist + 64 * lz + 4 * ((q + lz) & 15)); c1 += (h4.x + h4.y) + (h4.z + h4.w); }
            unsigned inc = c1;
#pragma unroll
            for (int o = 1; o <= 32; o <<= 1) { const unsigned v = (unsigned)__builtin_amdgcn_ds_bpermute(((lz + o) & 63) << 2, (int)inc); inc += (lz + o < 64) ? v : 0u; }
            const unsigned ab1 = inc - c1;
            const u64 cr1 = __ballot(ab1 < 256u && ab1 + c1 >= 256u);
            const int L1 = __builtin_ctzll(cr1);
            const unsigned abL = (unsigned)__builtin_amdgcn_readlane((int)ab1, L1);
            const unsigned c2 = hist[64 * L1 + lz];
            unsigned inc2 = c2;
#pragma unroll
            for (int o = 1; o <= 32; o <<= 1) { const unsigned v = (unsigned)__builtin_amdgcn_ds_bpermute(((lz + o) & 63) << 2, (int)inc2); inc2 += (lz + o < 64) ? v : 0u; }
            const unsigned ab2 = inc2 - c2 + abL;
            const u64 cr2 = __ballot(ab2 < 256u && ab2 + c2 >= 256u);
            const int L2 = __builtin_ctzll(cr2);
            const int bstar = 64 * L1 + L2;
            const int cb = __builtin_amdgcn_readlane((int)c2, L2), need2 = 256 - __builtin_amdgcn_readlane((int)ab2, L2);
            if (cb <= 64) {
                int cand = 0; int pos = 0;
#pragma unroll
                for (int i = 0; i < NR; ++i) { u64 mm = __ballot(bin[i] == bstar);
                    while (mm) { const int s = __builtin_ctzll(mm); mm &= mm - 1ull; cand = writelane_v(cand, __builtin_amdgcn_readlane(__float_as_int(x[i]), s), pos); ++pos; } }
                const unsigned cu = (lz < cb) ? f2ord(__int_as_float(cand)) : 0u;
                unsigned Tc = 0u;
#pragma unroll 1
                for (int bit = 31; bit >= 0; --bit) { const unsigned cd = Tc | (1u << bit); if ((int)__popcll(__ballot(cu >= cd)) >= need2) Tc = cd; }
                Tx = ord2f(Tc); have = true; exact = (256 - need2) + (int)__popcll(__ballot(cu >= Tc)) == 256;
            }
        }
    }
    if (!have) {
        unsigned Tt = 0u;
#pragma unroll 1
        for (int bit = 31; bit >= 0; --bit) {
            const unsigned cand = Tt | (1u << bit); int cnt = 0;
#pragma unroll
            for (int i = 0; i < NR; ++i) cnt += __popcll(__ballot(f2ord(x[i]) >= cand));
            if (cnt >= 256) Tt = cand;
        }
        Tx = ord2f(Tt);
    }
    int wlo = 0, whi = 0;
#pragma unroll
    for (int i = 0; i < NR; ++i) { const u64 g = __ballot(x[i] >= Tx); writelane_c2(wlo, whi, (int)(unsigned)g, (int)(unsigned)(g >> 32), i); }
    u64 myw = ((u64)(unsigned)whi << 32) | (unsigned)wlo;
    if (!exact) {
        int cgt = 0;
#pragma unroll
        for (int i = 0; i < NR; ++i) cgt += __popcll(__ballot(x[i] > Tx));
        int need = 256 - cgt; myw = 0ull;
#pragma unroll
        for (int i = 0; i < NR; ++i) {
            const u64 g = __ballot(x[i] > Tx); u64 e = __ballot(x[i] == Tx);
            int ne = __popcll(e);
            while (ne > need) { e &= ~(1ull << (63 - __clzll(e))); --ne; }
            need -= ne;
            if (lz == i) myw = g | e;
        }
    }
    return myw;
}

__device__ __forceinline__ void ph_ki(const Params& P, LAS unsigned char* lds) {
    const bf16_t* ZQ = (const bf16_t*)(P.ws + OFF_ZQ);
    const int tid = opaque_tid();
    { int* KPM = (int*)(P.ws + OFF_KPM);
      for (int i = blockIdx.x * NTHR + tid; i < NB_ * 64; i += gridDim.x * NTHR) { const int* pp = P.pos + (i >> 6) * S_ + (i & 63) * 64; int mxp = pp[0];
          for (int k = 1; k < 64; ++k) mxp = pp[k] > mxp ? pp[k] : mxp;
          KPM[i] = mxp; } }
    {
        bf16_t* KI = (bf16_t*)(P.ws + OFF_KI);
        for (int i = blockIdx.x * NTHR + tid; i < T_ * 8; i += gridDim.x * NTHR) {
            const int key = i >> 3, c = i & 7;
            const u32x4 v = *(const u32x4*)(ZQ + (size_t)key * 2304 + 2048 + 8 * c);
            *(u32x4*)(KI + ((size_t)((key >> 5) * 4 + (c >> 1)) * 64 + (key & 31) + 32 * (c & 1)) * 8) = v;
        }
    }
    {
        LAS bf16_t* tl = (LAS bf16_t*)lds;
        bf16_t* VT = (bf16_t*)(P.ws + OFF_VT);
        for (int it = blockIdx.x; it < NB_ * 8 * 64; it += gridDim.x) {
            const int b = it >> 9, h = (it >> 6) & 7, k0 = (it & 63) * 64;
            { const int row = tid >> 3, ch = tid & 7;
              const u32x4 v = *(const u32x4*)(ZQ + (size_t)(b * S_ + k0 + row) * 2304 + 1024 + h * 64 + ch * 8);
              *(LAS u32x4*)(tl + row * 72 + ch * 8) = v; }
            __syncthreads();
            { const int d = tid >> 3, kc = tid & 7; unsigned short e[8];
#pragma unroll
              for (int q = 0; q < 8; ++q) e[q] = tl[(kc * 8 + q) * 72 + d];
              u32x4 w; w.x = e[0] | ((unsigned)e[1] << 16); w.y = e[2] | ((unsigned)e[3] << 16); w.z = e[4] | ((unsigned)e[5] << 16); w.w = e[6] | ((unsigned)e[7] << 16);
              *(u32x4*)(VT + ((size_t)((b * 8 + h) * 64 + d)) * S_ + k0 + kc * 8) = w; }
            __syncthreads();
        }
    }
}

__device__ __forceinline__ void ph_idx(const Params& P, LAS unsigned char* lds) {
    LAS float* SC = (LAS float*)lds;
    const bf16_t* ZQ = (const bf16_t*)(P.ws + OFF_ZQ); u64* MASK = (u64*)(P.ws + OFF_MASK); const bf16_t* KI = (const bf16_t*)(P.ws + OFF_KI);
    const int tid = opaque_tid(), wid = __builtin_amdgcn_readfirstlane(tid >> 6), lane = tid & 63, m = lane & 31, hh = lane >> 5;
    int itc = 0;
    for (int idx = blockIdx.x; idx < NB_ * 512; idx += gridDim.x, ++itc) {
        const int b = idx & 7, j = idx >> 3; const int qb = (itc & 1) ? (j ^ 31) : j; const int t0 = qb * 8;
        const bf16_t* zb = ZQ + (size_t)b * S_ * 2304;
        bf16x8 Af[2][4]; float wv[2][16];
#pragma unroll
        for (int blk = 0; blk < 2; ++blk) {
            const bf16_t* qp = zb + (size_t)(t0 + 4 * blk + 2 * ((m >> 2) & 1) + (m >> 4)) * 2304 + 1536 + (4 * ((m >> 3) & 1) + (m & 3)) * 64 + 8 * hh;
#pragma unroll
            for (int ks = 0; ks < 4; ++ks) Af[blk][ks] = *(const bf16x8*)(qp + 16 * ks);
#pragma unroll
            for (int q = 0; q < 2; ++q) { const u32x4 ww = *(const u32x4*)(zb + (size_t)(t0 + 4 * blk + 2 * hh + q) * 2304 + 2112);
                wv[blk][8 * q + 0] = bflo(ww.x); wv[blk][8 * q + 1] = bfhi(ww.x); wv[blk][8 * q + 2] = bflo(ww.y); wv[blk][8 * q + 3] = bfhi(ww.y);
                wv[blk][8 * q + 4] = bflo(ww.z); wv[blk][8 * q + 5] = bfhi(ww.z); wv[blk][8 * q + 6] = bflo(ww.w); wv[blk][8 * q + 7] = bfhi(ww.w); }
        }
        const int ntile = 2 * ((t0 + 7) / 64 + 1);
        {
#define IDX_GLD(B, KT) do { const int kc_ = (KT) < ntile ? (KT) : ntile - 1; const bf16_t* kp_ = KI + ((size_t)((b * 128 + kc_) * 4) * 64 + lane) * 8; \
            asm volatile("global_load_dwordx4 %0, %4, off\n\tglobal_load_dwordx4 %1, %4, off offset:1024\n\tglobal_load_dwordx4 %2, %4, off offset:2048\n\tglobal_load_dwordx4 %3, %4, off offset:3072" \
                : "=&v"(B[0]), "=&v"(B[1]), "=&v"(B[2]), "=&v"(B[3]) : "v"(kp_)); } while (0)
#define IDX_GLW(B, N) asm volatile("s_waitcnt vmcnt(" #N ")" : "+v"(B[0]), "+v"(B[1]), "+v"(B[2]), "+v"(B[3]))
            auto score_tile = [&](const bf16x8 (&Bf)[4], const int kt) {
                f32x16 Dw[2];
#pragma unroll
                for (int r = 0; r < 16; ++r) { Dw[0][r] = 0.f; Dw[1][r] = 0.f; }
#pragma unroll
                for (int ks = 0; ks < 4; ++ks) {
                    Dw[0] = __builtin_amdgcn_mfma_f32_32x32x16_bf16(Af[0][ks], Bf[ks], Dw[0], 0, 0, 0);
                    Dw[1] = __builtin_amdgcn_mfma_f32_32x32x16_bf16(Af[1][ks], Bf[ks], Dw[1], 0, 0, 0); }
#pragma unroll
                for (int blk = 0; blk < 2; ++blk) {
                    const f32x16 Dv = Dw[blk];
#pragma unroll
                    for (int q = 0; q < 2; ++q) {
                        float part = 0.f;
#pragma unroll
                        for (int e = 0; e < 8; ++e) { const float d = Dv[8 * q + e], w = wv[blk][8 * q + e]; part = __builtin_fmaf(w, d, part); part = __builtin_fmaf(w, __builtin_fabsf(d), part); }
                        SC[(4 * blk + 2 * hh + q) * 4096 + 32 * kt + m] = (32 * kt + m <= t0 + 4 * blk + 2 * hh + q) ? part : -__builtin_inff();
                    }
                } };
            bf16x8 B0[4], B1[4], B2[4];
            if (wid < ntile) {
                IDX_GLD(B0, wid); IDX_GLD(B1, wid + 8);
                asm volatile("" :: "v"(Af[0][0]), "v"(Af[0][1]), "v"(Af[0][2]), "v"(Af[0][3]), "v"(Af[1][0]), "v"(Af[1][1]), "v"(Af[1][2]), "v"(Af[1][3]));
#pragma unroll 1
                for (int kt = wid; kt < ntile; kt += 24) {
                    IDX_GLD(B2, kt + 16);
                    IDX_GLW(B0, 8);
                    score_tile(B0, kt);
                    IDX_GLD(B0, kt + 24);
                    IDX_GLW(B1, 8);
                    if (kt + 8 < ntile) score_tile(B1, kt + 8);
                    IDX_GLD(B1, kt + 32);
                    IDX_GLW(B2, 8);
                    if (kt + 16 < ntile) score_tile(B2, kt + 16);
                }
                asm volatile("s_waitcnt vmcnt(0)" : "+v"(B0[0]), "+v"(B0[1]), "+v"(B0[2]), "+v"(B0[3]), "+v"(B1[0]), "+v"(B1[1]), "+v"(B1[2]), "+v"(B1[3]), "+v"(B2[0]), "+v"(B2[1]), "+v"(B2[2]), "+v"(B2[3]));
            }
#undef IDX_GLD
#undef IDX_GLW
        }
        __syncthreads();
        {
            const int t = t0 + wid; u64* mrow = MASK + (size_t)(b * S_ + t) * 64;
            if (t < 256) {
                const int lo = 64 * lane; u64 w;
                if (t >= lo + 63) w = ~0ull; else if (t < lo) w = 0ull; else w = (2ull << (t - lo)) - 1ull;
                mrow[lane] = w;
            } else {
                int lz = threadIdx.x; asm volatile("" : "+v"(lz)); lz &= 63;
                LAS float* rowp = SC + wid * 4096; u64 myw;
                if (t < 512) myw = select_row<8>(rowp, t, lz); else if (t < 1024) myw = select_row<16>(rowp, t, lz); else if (t < 2048) myw = select_row<32>(rowp, t, lz); else myw = select_row<64>(rowp, t, lz);
                mrow[lz] = myw;
            }
        }
        __syncthreads();
    }
}

__device__ __forceinline__ int bitmask(int w, int pos  ) { int m; asm("v_bfe_i32 %0, %1, %2, 1" : "=v"(m) : "v"(w), "n"(pos)); return m; }
__device__ __forceinline__ void ph_att(const Params& P, LAS unsigned char* lds) {
    LAS float* TABL = (LAS float*)lds;
    LAS unsigned char* KB = lds + 4096;
    constexpr int KT_B = 64 * 144, VT_B = 64 * 136, BUF_B = KT_B + VT_B;
    constexpr float LOG2E = 1.4426950408889634f;
    const float* tabg = (const float*)(P.ws + OFF_TAB);
    const int tid = opaque_tid(), wid = __builtin_amdgcn_readfirstlane(tid >> 6), lane = tid & 63, m = lane & 31, hh = lane >> 5;
    for (int i = tid; i < 1024; i += NTHR) TABL[i] = (tabg[i] - tabg[127 * 8 + (i & 7)]) * LOG2E;
    LAS int* POSL = (LAS int*)(KB + 4 * BUF_B);
    int pos_b = -1;
    const bf16_t* ZQ = (const bf16_t*)(P.ws + OFF_ZQ); const u64* MASK = (const u64*)(P.ws + OFF_MASK);
    const bf16_t* VT = (const bf16_t*)(P.ws + OFF_VT); bf16_t* OA = (bf16_t*)(P.ws + OFF_OATT); const int* KPM = (const int*)(P.ws + OFF_KPM);
    int itc = 0;
    for (int idx = blockIdx.x; idx < NB_ * 8 * 16; idx += gridDim.x, ++itc) {
        const int b = idx & 7, head = (idx >> 3) & 7, j = idx >> 6; const int qb = (itc & 1) ? (j ^ 3) : j;
        const int q0 = qb * 256, tq0 = q0 + 32 * wid, t = tq0 + m;
        const bf16_t* zb = ZQ + (size_t)b * S_ * 2304;
        if (b != pos_b) {
            __syncthreads();
            for (int i = tid; i < S_ / 4; i += NTHR) ((LAS i32x4*)POSL)[i] = ((const i32x4*)(P.pos + b * S_))[i];
            pos_b = b;
            __syncthreads();
        }
        bf16x8 Qf[4];
        { const bf16_t* qp = zb + (size_t)t * 2304 + head * 64 + 8 * hh;
#pragma unroll
          for (int ks = 0; ks < 4; ++ks) { const u32x4 qw = *(const u32x4*)(qp + 16 * ks);
              const float cq = 0.125f * LOG2E; u32x4 qs;
              qs.x = cvt_pk_bf16(bflo(qw.x) * cq, bfhi(qw.x) * cq); qs.y = cvt_pk_bf16(bflo(qw.y) * cq, bfhi(qw.y) * cq);
              qs.z = cvt_pk_bf16(bflo(qw.z) * cq, bfhi(qw.z) * cq); qs.w = cvt_pk_bf16(bflo(qw.w) * cq, bfhi(qw.w) * cq);
              Qf[ks] = __builtin_bit_cast(bf16x8, qs); } }
        const int posq = POSL[t];
        int minq = posq;
#pragma unroll
        for (int o = 32; o >= 1; o >>= 1) { const int v = shxi(minq, o, lane); minq = v < minq ? v : minq; }
        minq = __builtin_amdgcn_readfirstlane(minq);
        const u64* mrow = MASK + (size_t)(b * S_ + t) * 64;
        const bf16_t* vtb = VT + (size_t)(b * 8 + head) * 64 * S_;
        const float c2 = tabg[127 * 8 + head] * LOG2E;
        f32x16 O0, O1, OL;
#pragma unroll
        for (int r = 0; r < 16; ++r) { O0[r] = 0.f; O1[r] = 0.f; OL[r] = 0.f; }
        const bf16x8 ones8 = {0x3F80, 0x3F80, 0x3F80, 0x3F80, 0x3F80, 0x3F80, 0x3F80, 0x3F80};
        float cm = c2;
        f32x16 CM;
#pragma unroll
        for (int r = 0; r < 16; ++r) CM[r] = cm;
        const int nt = 4 * qb + 4, my_nt = ((tq0 + 31) >> 6) + 1;
        const int skey = tid >> 3, sch = tid & 7;
        const bf16_t* kg = zb + (size_t)skey * 2304 + 512 + head * 64 + 8 * sch;
        const bf16_t* vg = vtb + (size_t)skey * S_ + 8 * sch;
        LAS unsigned char* kdst = KB + skey * 144 + sch * 16; LAS unsigned char* vdst = KB + KT_B + skey * 136 + sch * 16;
        const int kpm_l = KPM[b * 64 + lane];
        auto tile = [&](const int kt, const int boff, const u64 mw) {
                const LAS unsigned char* Kt = KB + boff; const LAS unsigned char* Vt = Kt + KT_B;
                f32x16 D0 = CM, D1 = CM;
#pragma unroll
                for (int ks = 0; ks < 4; ++ks) {
                    const bf16x8 K0 = *(const LAS bf16x8*)(Kt + m * 144 + 32 * ks + 16 * hh), K1 = *(const LAS bf16x8*)(Kt + (32 + m) * 144 + 32 * ks + 16 * hh);
                    D0 = __builtin_amdgcn_mfma_f32_32x32x16_bf16(K0, Qf[ks], D0, 0, 0, 0); D1 = __builtin_amdgcn_mfma_f32_32x32x16_bf16(K1, Qf[ks], D1, 0, 0, 0); }
                const int w0 = (int)((unsigned)mw >> (4 * hh)), w1 = (int)((unsigned)(mw >> 32) >> (4 * hh));
                if (minq - __builtin_amdgcn_readlane(kpm_l, kt) < 127) {
#pragma unroll
                    for (int mb = 0; mb < 2; ++mb)
#pragma unroll
                        for (int g = 0; g < 4; ++g) {
                            const i32x4 pk = *(const LAS i32x4*)(POSL + 64 * kt + 32 * mb + 8 * g + 4 * hh);
#pragma unroll
                            for (int e = 0; e < 4; ++e) { const int r = 4 * g + e; int n = posq - pk[e]; n = n < 0 ? 0 : (n > 127 ? 127 : n);
                                if (mb) D1[r] += TABL[n * 8 + head]; else D0[r] += TABL[n * 8 + head]; }
                        }
                }
                float mx = __builtin_fmaxf(__builtin_fmaxf(D0[0], D0[1]), D0[2]);
#pragma unroll
                for (int r = 3; r < 15; r += 2) mx = __builtin_fmaxf(__builtin_fmaxf(mx, D0[r]), D0[r + 1]);
#pragma unroll
                for (int r = 0; r < 16; r += 2) mx = __builtin_fmaxf(__builtin_fmaxf(mx, D1[r]), D1[r + 1]);
                mx = fmaxf(mx, D0[15]);
                mx = fmaxf(mx, shx(mx, 32, lane));
                if (__any(mx > 8.0f)) {
                    const float sh = fmaxf(mx, 0.f), alpha = __builtin_amdgcn_exp2f(-sh);
                    cm -= sh;
#pragma unroll
                    for (int r = 0; r < 16; ++r) { D0[r] -= sh; D1[r] -= sh; CM[r] = cm; O0[r] *= alpha; O1[r] *= alpha; OL[r] *= alpha; }
                }
                float pv[32];
#pragma unroll
                for (int r = 0; r < 16; ++r) {
                    const int bp = (r & 3) + 8 * (r >> 2);
                    pv[r] = __int_as_float(__float_as_int(__builtin_amdgcn_exp2f(D0[r])) & bitmask(w0, bp));
                    pv[16 + r] = __int_as_float(__float_as_int(__builtin_amdgcn_exp2f(D1[r])) & bitmask(w1, bp)); }
#pragma unroll
                for (int s = 0; s < 4; ++s) {
                    u32x4 pw; pw.x = cvt_pk_bf16(pv[8 * s + 0], pv[8 * s + 1]); pw.y = cvt_pk_bf16(pv[8 * s + 2], pv[8 * s + 3]); pw.z = cvt_pk_bf16(pv[8 * s + 4], pv[8 * s + 5]); pw.w = cvt_pk_bf16(pv[8 * s + 6], pv[8 * s + 7]);
                    const bf16x8 Pf = __builtin_bit_cast(bf16x8, pw);
                    const LAS unsigned char* vp = Vt + m * 136 + (16 * s + 4 * hh) * 2;
                    { const u32x2 va = *(const LAS u32x2*)vp, vb = *(const LAS u32x2*)(vp + 16); u32x4 vw; vw.x = va.x; vw.y = va.y; vw.z = vb.x; vw.w = vb.y;
                      O0 = __builtin_amdgcn_mfma_f32_32x32x16_bf16(__builtin_bit_cast(bf16x8, vw), Pf, O0, 0, 0, 0); }
                    { const u32x2 va = *(const LAS u32x2*)(vp + 32 * 136), vb = *(const LAS u32x2*)(vp + 32 * 136 + 16); u32x4 vw; vw.x = va.x; vw.y = va.y; vw.z = vb.x; vw.w = vb.y;
                      O1 = __builtin_amdgcn_mfma_f32_32x32x16_bf16(__builtin_bit_cast(bf16x8, vw), Pf, O1, 0, 0, 0); }
                    OL = __builtin_amdgcn_mfma_f32_32x32x16_bf16(ones8, Pf, OL, 0, 0, 0);
                }
        };
        __syncthreads();
        constexpr int SUB_B = KT_B + VT_B, SUP_B = 2 * SUB_B;
        const int nst = nt >> 1;
        u32x4 ka0, kb0, va0, vb0, ka1, kb1, va1, vb1;
#define ATT_LOAD(KA, KB_, VA, VB, ST) do { KA = *(const u32x4*)(kg + (size_t)(2 * (ST)) * 64 * 2304); KB_ = *(const u32x4*)(kg + (size_t)(2 * (ST) + 1) * 64 * 2304); \
            VA = *(const u32x4*)(vg + (2 * (ST)) * 64); VB = *(const u32x4*)(vg + (2 * (ST) + 1) * 64); } while (0)
#define ATT_STORE(KA, KB_, VA, VB, BUF) do { LAS unsigned char* kd_ = kdst + (BUF) * SUP_B; LAS unsigned char* vd_ = vdst + (BUF) * SUP_B; \
            *(LAS u32x4*)kd_ = KA; *(LAS u32x2*)vd_ = (u32x2){VA.x, VA.y}; *(LAS u32x2*)(vd_ + 8) = (u32x2){VA.z, VA.w}; \
            *(LAS u32x4*)(kd_ + SUB_B) = KB_; *(LAS u32x2*)(vd_ + SUB_B) = (u32x2){VB.x, VB.y}; *(LAS u32x2*)(vd_ + SUB_B + 8) = (u32x2){VB.z, VB.w}; } while (0)
        u64x2 mwA = *(const u64x2*)mrow, mwB = mwA;
        ATT_LOAD(ka0, kb0, va0, vb0, 0); ATT_STORE(ka0, kb0, va0, vb0, 0);
        if (nst > 1) ATT_LOAD(ka1, kb1, va1, vb1, 1);
        __syncthreads();
        for (int st = 0; st < nst; st += 2) {
            if (st + 1 < nst) mwB = *(const u64x2*)(mrow + 2 * (st + 1));
            if (st + 2 < nst) ATT_LOAD(ka0, kb0, va0, vb0, st + 2);
            if (2 * st < my_nt) tile(2 * st, 0, mwA.x);
            if (2 * st + 1 < my_nt) tile(2 * st + 1, SUB_B, mwA.y);
            if (st + 1 < nst) ATT_STORE(ka1, kb1, va1, vb1, 1);
            __syncthreads();
            if (st + 1 >= nst) break;
            if (st + 2 < nst) mwA = *(const u64x2*)(mrow + 2 * (st + 2));
            if (st + 3 < nst) ATT_LOAD(ka1, kb1, va1, vb1, st + 3);
            if (2 * st + 2 < my_nt) tile(2 * st + 2, SUP_B, mwB.x);
            if (2 * st + 3 < my_nt) tile(2 * st + 3, SUP_B + SUB_B, mwB.y);
            if (st + 2 < nst) ATT_STORE(ka0, kb0, va0, vb0, 0);
            __syncthreads();
        }
#undef ATT_LOAD
#undef ATT_STORE
        const float inv = __builtin_amdgcn_rcpf(OL[0]);
        bf16_t* op = OA + (size_t)(b * S_ + t) * 512 + head * 64 + 4 * hh;
#pragma unroll
        for (int g = 0; g < 4; ++g) {
            u32x2 wa; wa.x = cvt_pk_bf16(O0[4 * g] * inv, O0[4 * g + 1] * inv); wa.y = cvt_pk_bf16(O0[4 * g + 2] * inv, O0[4 * g + 3] * inv);
            *(u32x2*)(op + 8 * g) = wa;
            u32x2 wb; wb.x = cvt_pk_bf16(O1[4 * g] * inv, O1[4 * g + 1] * inv); wb.y = cvt_pk_bf16(O1[4 * g + 2] * inv, O1[4 * g + 3] * inv);
            *(u32x2*)(op + 32 + 8 * g) = wb;
        }
    }
}

#define DSR4(A, addr, o0, o1, o2, o3) asm volatile("ds_read_b128 %0, %4 offset:%5\n\tds_read_b128 %1, %4 offset:%6\n\tds_read_b128 %2, %4 offset:%7\n\tds_read_b128 %3, %4 offset:%8" \
    : "=&v"(A[0]), "=&v"(A[1]), "=&v"(A[2]), "=&v"(A[3]) : "v"(addr), "i"(o0), "i"(o1), "i"(o2), "i"(o3))
#define DSW(A, N) asm volatile("s_waitcnt lgkmcnt(" #N ")" : "+v"(A[0]), "+v"(A[1]), "+v"(A[2]), "+v"(A[3]))
#define DSRV(V, addr, off) asm volatile("ds_read_b32 %0, %1 offset:%2" : "=&v"(V) : "v"(addr), "i"(off))
#define DSWV(A, V, N) asm volatile("s_waitcnt lgkmcnt(" #N ")" : "+v"(A[0]), "+v"(A[1]), "+v"(A[2]), "+v"(A[3]), "+v"(V))
#define SCAN_A(X, G) _Pragma("unroll") for (int i_ = 0; i_ < 4; ++i_) { const f32x2 k01 = {X[i_][0], X[i_][1]}, k23 = {X[i_][2], X[i_][3]}; \
    sa0 += S2[8 * G + 2 * i_] * k01; sa1 += S2[8 * G + 2 * i_ + 1] * k23; sp0 += Pm2[8 * G + 2 * i_] * k01; sp1 += Pm2[8 * G + 2 * i_ + 1] * k23; }
#define SCAN_B(X, C) { const int j = 2 * C; \
    { const f32x2 w = {X[0][0], X[0][1]}, kb = {X[1][0], X[1][1]}, kk = {X[2][0], X[2][1]}, rr = {X[3][0], X[3][1]}; \
      S2[j] = S2[j] * w + sav * kb + vv2 * kk; Pm2[j] = Pm2[j] * w + spv * kb; y0 += S2[j] * rr; p0 += Pm2[j] * rr; } \
    { const f32x2 w = {X[0][2], X[0][3]}, kb = {X[1][2], X[1][3]}, kk = {X[2][2], X[2][3]}, rr = {X[3][2], X[3][3]}; \
      S2[j + 1] = S2[j + 1] * w + sav * kb + vv2 * kk; Pm2[j + 1] = Pm2[j + 1] * w + spv * kb; y1 += S2[j + 1] * rr; p1 += Pm2[j + 1] * rr; } }
__device__ __forceinline__ float wave_sum_dpp(float v) {
    v += __int_as_float(__builtin_amdgcn_update_dpp(0, __float_as_int(v), 0x111, 0xf, 0xf, true));
    v += __int_as_float(__builtin_amdgcn_update_dpp(0, __float_as_int(v), 0x112, 0xf, 0xf, true));
    v += __int_as_float(__builtin_amdgcn_update_dpp(0, __float_as_int(v), 0x114, 0xf, 0xf, true));
    v += __int_as_float(__builtin_amdgcn_update_dpp(0, __float_as_int(v), 0x118, 0xf, 0xf, true));
    v += __int_as_float(__builtin_amdgcn_update_dpp(0, __float_as_int(v), 0x142, 0xa, 0xf, false));
    v += __int_as_float(__builtin_amdgcn_update_dpp(0, __float_as_int(v), 0x143, 0xc, 0xf, false));
    return __int_as_float(__builtin_amdgcn_readlane(__float_as_int(v), 63));
}
__device__ __forceinline__ void wave_sum2_dpp(float a, float b, float& ra, float& rb) {
    const auto sw = __builtin_amdgcn_permlane32_swap(__float_as_uint(a), __float_as_uint(b), false, false);
    float v = __uint_as_float(sw[0]) + __uint_as_float(sw[1]);
    v += __int_as_float(__builtin_amdgcn_update_dpp(0, __float_as_int(v), 0x111, 0xf, 0xf, true));
    v += __int_as_float(__builtin_amdgcn_update_dpp(0, __float_as_int(v), 0x112, 0xf, 0xf, true));
    v += __int_as_float(__builtin_amdgcn_update_dpp(0, __float_as_int(v), 0x114, 0xf, 0xf, true));
    v += __int_as_float(__builtin_amdgcn_update_dpp(0, __float_as_int(v), 0x118, 0xf, 0xf, true));
    v += __int_as_float(__builtin_amdgcn_update_dpp(0, __float_as_int(v), 0x142, 0xa, 0xf, false));
    ra = __int_as_float(__builtin_amdgcn_readlane(__float_as_int(v), 31)); rb = __int_as_float(__builtin_amdgcn_readlane(__float_as_int(v), 63));
}
__device__ __forceinline__ void ph_scan(const Params& P, int l, LAS unsigned char* lds) {
    LAS bf16_t* LI = (LAS bf16_t*)lds;
    LAS float* SIN = (LAS float*)(lds + 32768);
    const bf16_t* ZR = (const bf16_t*)(P.ws + OFF_ZR);
    const float* mu = P.mu + (size_t)l * 1792;
    const bf16_t* LW = (const bf16_t*)(P.ws + OFF_WB + WB_LW); const bf16_t* LA = (const bf16_t*)(P.ws + OFF_WB + WB_LA); const bf16_t* LG = (const bf16_t*)(P.ws + OFF_WB + WB_LG);
    bf16_t* Yo = (bf16_t*)(P.ws + OFF_Y); bf16_t* Po = (bf16_t*)(P.ws + OFF_P); bf16_t* Go = (bf16_t*)(P.ws + OFF_G); bf16_t* VBo = (bf16_t*)(P.ws + OFF_VB);
    float* SEGp = (float*)(P.ws + OFF_SEG);
    const int tid = opaque_tid(), wid = __builtin_amdgcn_readfirstlane(tid >> 6), lane = tid & 63;
    for (int blk = blockIdx.x; blk < NB_ * NSEG; blk += gridDim.x) {
        const int b = blk / NSEG, seg = blk % NSEG, tbeg = seg * SEGL;
        f32x2 S2[32], Pm2[32];
        { int lq = threadIdx.x; asm volatile("" : "+v"(lq)); lq &= 63;
#pragma unroll
          for (int j = 0; j < 32; ++j) { S2[j] = (f32x2){0.f, 0.f}; Pm2[j] = (f32x2){(2 * j == lq) ? 1.f : 0.f, (2 * j + 1 == lq) ? 1.f : 0.f}; } }
        for (int half = 0; half < 2; ++half) {
            __syncthreads();
            {
                int tq = threadIdx.x; asm volatile("" : "+v"(tq));
#pragma unroll 1
                for (int rnd = 0; rnd < 4; ++rnd) {
                    const int q = tq + NTHR * rnd, tok = q >> 5, c8 = (q & 31) * 8, t = tbeg + 64 * half + tok; const size_t row = (size_t)b * S_ + t;
                    const u32x4 zc = *(const u32x4*)(ZR + row * 1792 + 1536 + c8);
                    u32x4 zp; zp.x = 0u; zp.y = 0u; zp.z = 0u; zp.w = 0u; if (t > 0) zp = *(const u32x4*)(ZR + (row - 1) * 1792 + 1536 + c8);
                    const f32x4 ma = *(const f32x4*)(mu + 1536 + c8), mb = *(const f32x4*)(mu + 1536 + c8 + 4);
                    const unsigned cw[4] = {zc.x, zc.y, zc.z, zc.w}, pw[4] = {zp.x, zp.y, zp.z, zp.w};
                    float x[8];
#pragma unroll
                    for (int q2 = 0; q2 < 4; ++q2) { const float c0 = bflo(cw[q2]), c1 = bfhi(cw[q2]), p0 = bflo(pw[q2]), p1 = bfhi(pw[q2]);
                        const float m0 = q2 < 2 ? ma[2 * q2] : mb[2 * q2 - 4], m1 = q2 < 2 ? ma[2 * q2 + 1] : mb[2 * q2 - 3];
                        x[2 * q2] = c0 + (p0 - c0) * m0; x[2 * q2 + 1] = c1 + (p1 - c1) * m1; }
#pragma unroll
                    for (int e = 0; e < 8; ++e) { if (c8 < 64) x[e] = 1.0f - 2.0f * __builtin_amdgcn_rcpf(1.0f + __expf(2.0f * x[e])); else if (c8 >= 128) x[e] = sigmoidf_(x[e]); }
                    u32x4 w; w.x = cvt_pk_bf16(x[0], x[1]); w.y = cvt_pk_bf16(x[2], x[3]); w.z = cvt_pk_bf16(x[4], x[5]); w.w = cvt_pk_bf16(x[6], x[7]);
                    *(LAS u32x4*)(LI + tok * 256 + c8) = w;
                }
            }
            __syncthreads();
            float* los = (float*)(P.ws + OFF_SCR) + (size_t)(blk * 8 + wid) * (64 * 2 * 64);
            {
                int tq = threadIdx.x; asm volatile("" : "+v"(tq));
                const int lq = tq & 63, fr = lq & 15, kq = lq >> 4;
#pragma unroll 1
                for (int pass = 0; pass < 8; ++pass) {
                    const int kind = pass < 2 ? 0 : (pass < 4 ? 1 : 2), Kk = kind == 2 ? 128 : 64, aoff = kind * 64, nb0 = kind == 2 ? pass - 4 : 2 * (pass & 1);
                    const bf16_t* Wt = kind == 0 ? LW : (kind == 1 ? LA : LG);
                    bf16x8 Bf[4];
#pragma unroll
                    for (int q = 0; q < 4; ++q) { const int nb = kind == 2 ? nb0 : nb0 + (q >> 1), ks = kind == 2 ? q : (q & 1);
                        Bf[q] = *(const bf16x8*)(Wt + (size_t)(64 * wid + 16 * nb + fr) * Kk + 32 * ks + 8 * kq); }
#pragma unroll 1
                    for (int tt = 0; tt < 4; ++tt) {
                        f32x4 acc[2];
                        acc[0] = (f32x4){0.f, 0.f, 0.f, 0.f}; acc[1] = acc[0];
#pragma unroll
                        for (int q = 0; q < 4; ++q) { const int ai = kind == 2 ? 0 : (q >> 1), ks = kind == 2 ? q : (q & 1);
                            const bf16x8 Afr = *(const LAS bf16x8*)(LI + (16 * tt + fr) * 256 + aoff + 32 * ks + 8 * kq);
                            acc[ai] = __builtin_amdgcn_mfma_f32_16x16x32_bf16(Afr, Bf[q], acc[ai], 0, 0, 0); }
                        if (kind == 2) {
#pragma unroll
                            for (int r = 0; r < 4; ++r) Go[((size_t)b * S_ + tbeg + 64 * half + 16 * tt + 4 * kq + r) * 512 + 64 * wid + 16 * nb0 + fr] = f2bf(acc[0][r]);
                        } else {
#pragma unroll
                            for (int ai = 0; ai < 2; ++ai)
#pragma unroll
                                for (int r = 0; r < 4; ++r) los[((16 * tt + 4 * kq + r) * 2 + kind) * 64 + 16 * (nb0 + ai) + fr] = acc[ai][r];
                        }
                    }
                }
            }
            asm volatile("s_waitcnt vmcnt(0)" ::: "memory");
            for (int sb = 0; sb < 64 / TB; ++sb) {
                const int ts = tbeg + 64 * half + sb * TB;
                int tz = threadIdx.x; asm volatile("" : "+v"(tz));
                const int lz = tz & 63;
                LAS float* sw = SIN + (size_t)wid * (TB * 6 * 64);
                {
                    const int c = 64 * wid + lz; const size_t row0 = (size_t)b * S_ + ts;
                    const float mur = mu[c], muk = mu[512 + c], muv = mu[1024 + c];
                    const float pw0 = P.w0[l * 512 + c], pa0 = P.a0[l * 512 + c], pkk = P.k_k[l * 512 + c], pka = P.k_a[l * 512 + c], prk = P.r_k[l * 512 + c];
                    const float* lo = los + (size_t)(sb * TB) * 128 + lz;
                    float zr_[TB + 1], zk_[TB + 1], zv_[TB + 1], wl_[TB], al_[TB];
                    zr_[0] = 0.f; zk_[0] = 0.f; zv_[0] = 0.f;
                    if (ts > 0) { zr_[0] = bf2f(ZR[(row0 - 1) * 1792 + c]); zk_[0] = bf2f(ZR[(row0 - 1) * 1792 + 512 + c]); zv_[0] = bf2f(ZR[(row0 - 1) * 1792 + 1024 + c]); }
#pragma unroll
                    for (int tk = 0; tk < TB; ++tk) {
                        zr_[tk + 1] = bf2f(ZR[(row0 + tk) * 1792 + c]); zk_[tk + 1] = bf2f(ZR[(row0 + tk) * 1792 + 512 + c]); zv_[tk + 1] = bf2f(ZR[(row0 + tk) * 1792 + 1024 + c]);
                        wl_[tk] = lo[tk * 128]; al_[tk] = lo[tk * 128 + 64]; }
#pragma unroll
                    for (int tk = 0; tk < TB; ++tk) {
                        const size_t row = row0 + tk; LAS float* st = sw + tk * 6 * 64;
                        const float cr = zr_[tk + 1], ck = zk_[tk + 1], cv = zv_[tk + 1], wl = wl_[tk], al = al_[tk];
                        const float rr = cr + (zr_[tk] - cr) * mur, kv = ck + (zk_[tk] - ck) * muk, vv = cv + (zv_[tk] - cv) * muv;
                        const float dc = __builtin_amdgcn_exp2f(-0.87503877f * __builtin_amdgcn_rcpf(1.0f + __builtin_amdgcn_exp2f(-1.44269504f * (pw0 + wl))));
                        const float av = sigmoidf_(pa0 + al);
                        const float kkv = kv * pkk;
                        const float km = kv * (1.0f + (av - 1.0f) * pka);
                        float ss, bon; wave_sum2_dpp(kkv * kkv, rr * km * prk, ss, bon);
                        const float kkn = kkv * __builtin_amdgcn_rsqf(fmaxf(ss, 1e-24f));
                        st[lz] = rr; st[64 + lz] = dc; st[2 * 64 + lz] = km; st[3 * 64 + lz] = -kkn; st[4 * 64 + lz] = kkn * av; st[5 * 64 + lz] = vv;
                        VBo[row * 512 + c] = f2bf(bon * vv);
                    }
                }
                {
                const unsigned sq0 = (unsigned)(uintptr_t)sw, va0 = sq0 + 4u * (unsigned)lz;
                f32x4 X0[4], X1[4], X2[4]; float vin;
                DSRV(vin, va0, 1280);
                DSR4(X2, sq0, 896, 912, 928, 944);
                DSR4(X0, sq0, 768, 784, 800, 816);
                DSR4(X1, sq0, 832, 848, 864, 880);
#pragma unroll 1
                for (int tk = 0; tk < TB; ++tk) {
                    f32x2 sa0 = {0.f, 0.f}, sa1 = {0.f, 0.f}, sp0 = {0.f, 0.f}, sp1 = {0.f, 0.f};
                    f32x2 y0 = {0.f, 0.f}, y1 = {0.f, 0.f}, p0 = {0.f, 0.f}, p1 = {0.f, 0.f};
                    f32x2 sav, spv;
                    const unsigned sqa = sq0 + 1536u * (unsigned)tk, vna = va0 + 1536u * (unsigned)tk;
                    DSWV(X0, vin, 4);
                    const f32x2 vv2 = {vin, vin};
                    SCAN_A(X0, 0);
                    DSR4(X0, sqa, 960, 976, 992, 1008);
                    DSW(X1, 4);
                    SCAN_A(X1, 1);
                    DSR4(X1, sqa, 256, 1024, 512, 0);
                    DSW(X2, 8);
                    SCAN_A(X2, 2);
                    DSR4(X2, sqa, 272, 1040, 528, 16);
                    DSW(X0, 8);
                    SCAN_A(X0, 3);
                    { const float sa = (sa0.x + sa0.y) + (sa1.x + sa1.y), sp = (sp0.x + sp0.y) + (sp1.x + sp1.y); sav = (f32x2){sa, sa}; spv = (f32x2){sp, sp}; }
                    DSR4(X0, sqa, 288, 1056, 544, 32);
                    DSW(X1, 8);
                    SCAN_B(X1, 0);
                    DSR4(X1, sqa, 304, 1072, 560, 48);
                    DSW(X2, 8);
                    SCAN_B(X2, 1);
                    DSR4(X2, sqa, 320, 1088, 576, 64);
                    DSW(X0, 8);
                    SCAN_B(X0, 2);
                    DSR4(X0, sqa, 336, 1104, 592, 80);
                    DSW(X1, 8);
                    SCAN_B(X1, 3);
                    DSR4(X1, sqa, 352, 1120, 608, 96);
                    DSW(X2, 8);
                    SCAN_B(X2, 4);
                    DSR4(X2, sqa, 368, 1136, 624, 112);
                    DSW(X0, 8);
                    SCAN_B(X0, 5);
                    DSR4(X0, sqa, 384, 1152, 640, 128);
                    DSW(X1, 8);
                    SCAN_B(X1, 6);
                    DSR4(X1, sqa, 400, 1168, 656, 144);
                    DSW(X2, 8);
                    SCAN_B(X2, 7);
                    DSR4(X2, sqa, 416, 1184, 672, 160);
                    DSW(X0, 8);
                    SCAN_B(X0, 8);
                    DSR4(X0, sqa, 432, 1200, 688, 176);
                    DSW(X1, 8);
                    SCAN_B(X1, 9);
                    DSR4(X1, sqa, 448, 1216, 704, 192);
                    DSW(X2, 8);
                    SCAN_B(X2, 10);
                    DSR4(X2, sqa, 464, 1232, 720, 208);
                    DSW(X0, 8);
                    SCAN_B(X0, 11);
                    DSR4(X0, sqa, 480, 1248, 736, 224);
                    DSW(X1, 8);
                    SCAN_B(X1, 12);
                    DSR4(X1, sqa, 496, 1264, 752, 240);
                    DSW(X2, 8);
                    SCAN_B(X2, 13);
                    {
                        const unsigned nx = (tk + 1 < TB) ? 1536u : 0u, sqn = sqa + nx, vnn = vna + nx;
                        DSRV(vin, vnn, 1280);
                        DSR4(X2, sqn, 896, 912, 928, 944);
                        DSW(X0, 9);
                        SCAN_B(X0, 14);
                        DSR4(X0, sqn, 768, 784, 800, 816);
                        DSW(X1, 9);
                        SCAN_B(X1, 15);
                        DSR4(X1, sqn, 832, 848, 864, 880);
                    }
                    const size_t row = (size_t)b * S_ + ts + tk;
                    Yo[row * 512 + 64 * wid + lz] = f2bf((y0.x + y0.y) + (y1.x + y1.y));
                    Po[row * 512 + 64 * wid + lz] = f2bf((p0.x + p0.y) + (p1.x + p1.y));
                }
                asm volatile("s_waitcnt lgkmcnt(0)" : "+v"(X0[0]), "+v"(X0[1]), "+v"(X0[2]), "+v"(X0[3]), "+v"(X1[0]), "+v"(X1[1]), "+v"(X1[2]), "+v"(X1[3]),
                             "+v"(X2[0]), "+v"(X2[1]), "+v"(X2[2]), "+v"(X2[3]), "+v"(vin));
                }
            }
        }
        {
            int lq = threadIdx.x; asm volatile("" : "+v"(lq)); lq &= 63;
            float* sg = SEGp + ((size_t)((b * 8 + wid) * NSEG + seg)) * 8192 + lq * 64;
#pragma unroll
            for (int j = 0; j < 32; j += 2) { *(f32x4*)(sg + 2 * j) = (f32x4){Pm2[j].x, Pm2[j].y, Pm2[j + 1].x, Pm2[j + 1].y};
                *(f32x4*)(sg + 4096 + 2 * j) = (f32x4){S2[j].x, S2[j].y, S2[j + 1].x, S2[j + 1].y}; }
        }
    }
}

__device__ __forceinline__ void ph_comb(const Params& P, LAS unsigned char* lds) {
    LAS float* SI = (LAS float*)lds;
    LAS float* PB = (LAS float*)(lds + 20480);
    float* SEGp = (float*)(P.ws + OFF_SEG);
    const int tid = opaque_tid(), wid = __builtin_amdgcn_readfirstlane(tid >> 6), lane = tid & 63, m = lane & 31, hh = lane >> 5;
    for (int chain = blockIdx.x; chain < 64; chain += gridDim.x) {
        float* base = SEGp + (size_t)chain * NSEG * 8192;
        __syncthreads();
        for (int i = tid; i < 4096; i += NTHR) SI[(i >> 6) * 65 + (i & 63)] = base[4096 + i];
        { const f32x4 a = *(const f32x4*)(base + 8192 + tid * 8), c = *(const f32x4*)(base + 8192 + tid * 8 + 4);
          *(LAS f32x4*)(PB + 4096 + tid * 8) = a; *(LAS f32x4*)(PB + 4096 + tid * 8 + 4) = c; }
        __syncthreads();
        const int ti = (wid >> 1) & 1, tj = wid & 1;
        for (int k = 1; k <= NSEG - 2; ++k) {
            float* Q = base + (size_t)k * 8192 + 4096;
            const LAS float* Pb = PB + (k & 1) * 4096;
            f32x4 na = {0.f, 0.f, 0.f, 0.f}, nc = na;
            if (k + 1 <= NSEG - 2) { const float* pn = base + (size_t)(k + 1) * 8192 + tid * 8; na = *(const f32x4*)pn; nc = *(const f32x4*)(pn + 4); }
            f32x16 Dv;
            if (wid < 4) {
                float qv[16];
#pragma unroll
                for (int r = 0; r < 16; ++r) { const int row = 32 * ti + (r & 3) + 8 * (r >> 2) + 4 * hh; qv[r] = Q[row * 64 + 32 * tj + m]; Dv[r] = 0.f; }
#pragma unroll
                for (int kk = 0; kk < 32; ++kk) { const float a = SI[(32 * ti + m) * 65 + 2 * kk + hh], bq = Pb[(2 * kk + hh) * 64 + 32 * tj + m];
                    Dv = __builtin_amdgcn_mfma_f32_32x32x2f32(a, bq, Dv, 0, 0, 0); }
#pragma unroll
                for (int r = 0; r < 16; ++r) Dv[r] += qv[r];
            }
            __syncthreads();
            if (wid < 4) {
#pragma unroll
                for (int r = 0; r < 16; ++r) { const int row = 32 * ti + (r & 3) + 8 * (r >> 2) + 4 * hh; SI[row * 65 + 32 * tj + m] = Dv[r]; Q[row * 64 + 32 * tj + m] = Dv[r]; }
            }
            if (k + 1 <= NSEG - 2) { LAS float* pd = PB + ((k + 1) & 1) * 4096 + tid * 8; *(LAS f32x4*)pd = na; *(LAS f32x4*)(pd + 4) = nc; }
            __syncthreads();
        }
    }
}

__device__ __forceinline__ void ph_post(const Params& P, int l) {
    const bf16_t* Yo = (const bf16_t*)(P.ws + OFF_Y); const bf16_t* Po = (const bf16_t*)(P.ws + OFF_P); const bf16_t* Go = (const bf16_t*)(P.ws + OFF_G);
    const bf16_t* VBo = (const bf16_t*)(P.ws + OFF_VB); const float* SEGp = (const float*)(P.ws + OFF_SEG); bf16_t* OR = (bf16_t*)(P.ws + OFF_ORWKV);
    const int tid = opaque_tid(), wid = __builtin_amdgcn_readfirstlane(tid >> 6), lane = tid & 63, m = lane & 31, hh = lane >> 5;
    for (int blk = blockIdx.x; blk < NB_ * NSEG; blk += gridDim.x) {
        const int b = blk / NSEG, seg = blk % NSEG, tbeg = seg * SEGL;
        bf16x8 SIf[2][4];
        if (seg > 0) {
            const float* sg = SEGp + ((size_t)((b * 8 + wid) * NSEG + seg - 1)) * 8192 + 4096;
#pragma unroll
            for (int ib = 0; ib < 2; ++ib)
#pragma unroll
                for (int ks = 0; ks < 4; ++ks) { const float* sp = sg + (32 * ib + m) * 64 + 16 * ks + 8 * hh; const f32x4 a = *(const f32x4*)sp, c = *(const f32x4*)(sp + 4);
                    u32x4 w; w.x = cvt_pk_bf16(a[0], a[1]); w.y = cvt_pk_bf16(a[2], a[3]); w.z = cvt_pk_bf16(c[0], c[1]); w.w = cvt_pk_bf16(c[2], c[3]); SIf[ib][ks] = __builtin_bit_cast(bf16x8, w); }
        }
        float lnw[32], lnb[32];
#pragma unroll
        for (int q = 0; q < 32; ++q) { const int ch = 64 * wid + 32 * (q >> 4) + (q & 3) + 8 * ((q & 15) >> 2) + 4 * hh; lnw[q] = P.ln_w[l * 512 + ch]; lnb[q] = P.ln_b[l * 512 + ch]; }
#pragma unroll 1
        for (int c = 0; c < SEGL / 32; ++c) {
            const size_t row = (size_t)b * S_ + tbeg + 32 * c + m;
            f32x16 D[2];
#pragma unroll
            for (int r = 0; r < 16; ++r) { D[0][r] = 0.f; D[1][r] = 0.f; }
            if (seg > 0) {
                const bf16_t* pp = Po + row * 512 + 64 * wid + 8 * hh;
#pragma unroll
                for (int ks = 0; ks < 4; ++ks) { const bf16x8 Pf = *(const bf16x8*)(pp + 16 * ks);
                    D[0] = __builtin_amdgcn_mfma_f32_32x32x16_bf16(SIf[0][ks], Pf, D[0], 0, 0, 0); D[1] = __builtin_amdgcn_mfma_f32_32x32x16_bf16(SIf[1][ks], Pf, D[1], 0, 0, 0); }
            }
            float y[32]; float s = 0.f;
#pragma unroll
            for (int ib = 0; ib < 2; ++ib)
#pragma unroll
                for (int g = 0; g < 4; ++g) { const u32x2 yw = *(const u32x2*)(Yo + row * 512 + 64 * wid + 32 * ib + 8 * g + 4 * hh);
                    y[16 * ib + 4 * g + 0] = bflo(yw.x) + D[ib][4 * g + 0]; y[16 * ib + 4 * g + 1] = bfhi(yw.x) + D[ib][4 * g + 1];
                    y[16 * ib + 4 * g + 2] = bflo(yw.y) + D[ib][4 * g + 2]; y[16 * ib + 4 * g + 3] = bfhi(yw.y) + D[ib][4 * g + 3]; }
#pragma unroll
            for (int q = 0; q < 32; ++q) s += y[q];
            s += shx(s, 32, lane);
            const float mean = s * (1.0f / 64.0f); float qv = 0.f;
#pragma unroll
            for (int q = 0; q < 32; ++q) { y[q] -= mean; qv += y[q] * y[q]; }
            qv += shx(qv, 32, lane);
            const float rstd = rsqrtf(qv * (1.0f / 64.0f) + 64e-5f);
#pragma unroll
            for (int ib = 0; ib < 2; ++ib)
#pragma unroll
                for (int g = 0; g < 4; ++g) { const size_t off = row * 512 + 64 * wid + 32 * ib + 8 * g + 4 * hh;
                    const u32x2 vw = *(const u32x2*)(VBo + off), gw = *(const u32x2*)(Go + off); const int q = 16 * ib + 4 * g;
                    const float o0 = (y[q] * rstd * lnw[q] + lnb[q] + bflo(vw.x)) * bflo(gw.x), o1 = (y[q + 1] * rstd * lnw[q + 1] + lnb[q + 1] + bfhi(vw.x)) * bfhi(gw.x);
                    const float o2 = (y[q + 2] * rstd * lnw[q + 2] + lnb[q + 2] + bflo(vw.y)) * bflo(gw.y), o3 = (y[q + 3] * rstd * lnw[q + 3] + lnb[q + 3] + bfhi(vw.y)) * bfhi(gw.y);
                    u32x2 w; w.x = cvt_pk_bf16(o0, o1); w.y = cvt_pk_bf16(o2, o3); *(u32x2*)(OR + off) = w; }
        }
    }
}

enum { PH_PRO = 0, PH_NORM1, PH_ZQ, PH_KI, PH_IDX, PH_ATT, PH_ZR, PH_SCAN, PH_COMB, PH_POST, PH_ZC, PH_CONV, PH_MERGE, PH_WO, PH_NORM2, PH_UP, PH_U, PH_DOWN, PH_FINAL, PH_COUNT };

template <int PH>
__device__ __forceinline__ void run_phase(const Params& P0, int l, LAS unsigned char* lds) {
    Params P = P0; P.ws = opaque_ptr(P0.ws);
    if constexpr (PH == PH_PRO) { if (l == 0) ph_mod(P, lds); ph_wconv(P, l, lds); }
    if constexpr (PH == PH_NORM1) ph_norm(P, l, 0);
    if constexpr (PH == PH_ZQ) ph_gemm_zq(P, lds);
    if constexpr (PH == PH_KI) ph_ki(P, lds);
    if constexpr (PH == PH_IDX) ph_idx(P, lds);
    if constexpr (PH == PH_ATT) ph_att(P, lds);
    if constexpr (PH == PH_ZR) ph_gemm_zr(P, lds);
    if constexpr (PH == PH_SCAN) ph_scan(P, l, lds);
    if constexpr (PH == PH_COMB) ph_comb(P, lds);
    if constexpr (PH == PH_POST) ph_post(P, l);
    if constexpr (PH == PH_ZC) ph_gemm_zc(P, lds);
    if constexpr (PH == PH_CONV) ph_conv(P, l, lds);
    if constexpr (PH == PH_MERGE) ph_gemm_merge(P, lds);
    if constexpr (PH == PH_WO) ph_gemm_wo(P, l, lds);
    if constexpr (PH == PH_NORM2) ph_norm(P, l, 1);
    if constexpr (PH == PH_UP) ph_gemm_up(P, l, lds);
    if constexpr (PH == PH_U) ph_ufix(P, l, lds);
    if constexpr (PH == PH_DOWN) ph_gemm_down(P, l, lds);
    if constexpr (PH == PH_FINAL) ph_final(P);
}

#if MK_SINGLE
__global__ void __launch_bounds__(NTHR, 2) k_mega(Params P) {
    extern __shared__ __attribute__((aligned(16))) unsigned char shm[];
    LAS unsigned char* lds = (LAS unsigned char*)shm;
    LAS unsigned* xbw = (LAS unsigned*)(lds + LDS_BYTES - 16);
    if (threadIdx.x == 0) { xbw[0] = 0u; xbw[1] = 0u; xbw[2] = 0u; xbw[3] = 0u; }
    __syncthreads();
    XcdBarrier bar = xcd_barrier_post((unsigned*)(P.ws + OFF_BAR), (volatile LAS unsigned*)xbw);
#ifndef PROBE_PH
#define PROBE_PH (-1)
#endif
#ifndef PROBE_N
#define PROBE_N 4
#endif
#define PHASE(PH, l) do { unsigned long long t0_ = 0; if (PROBE_PH == PH && blockIdx.x == 0) t0_ = wall_clock64(); \
        run_phase<PH>(P, l, lds); xcd_barrier(bar); \
        if (PROBE_PH == PH && blockIdx.x == 0) { const unsigned long long t1_ = wall_clock64(), d_ = (t1_ - t0_) * PROBE_N; while (wall_clock64() - t1_ < d_) __builtin_amdgcn_s_sleep(8); } } while (0)
#pragma unroll 1
    for (int l = 0; l < 2; ++l) {
        PHASE(PH_PRO, l); PHASE(PH_NORM1, l); PHASE(PH_ZQ, l); PHASE(PH_KI, l); PHASE(PH_IDX, l); PHASE(PH_ATT, l); PHASE(PH_ZR, l); PHASE(PH_SCAN, l); PHASE(PH_COMB, l); PHASE(PH_POST, l);
        PHASE(PH_ZC, l); PHASE(PH_CONV, l); PHASE(PH_MERGE, l); PHASE(PH_WO, l); PHASE(PH_NORM2, l); PHASE(PH_UP, l); PHASE(PH_U, l); PHASE(PH_DOWN, l);
    }
    run_phase<PH_FINAL>(P, 0, lds);
#undef PHASE
}
#else
template <int PH>
__global__ void __launch_bounds__(NTHR, 2) k_phase(Params P, int l) {
    extern __shared__ __attribute__((aligned(16))) unsigned char shm[];
    run_phase<PH>(P, l, (LAS unsigned char*)shm);
}
template <int PH> static void launch_phase(const Params& P, int l, hipStream_t stream) {
    static bool attr = false;
    if (!attr) { hipFuncSetAttribute((const void*)k_phase<PH>, hipFuncAttributeMaxDynamicSharedMemorySize, LDS_BYTES); attr = true; }
    hipLaunchKernelGGL(k_phase<PH>, dim3(NBLK), dim3(NTHR), LDS_BYTES, stream, P, l);
}
#endif

extern "C" void kernel_launch(void* const* d_in, const int* in_sizes, int n_in, void* d_out, int out_size, void* d_ws, size_t ws_size, hipStream_t stream) {
    (void)in_sizes; (void)n_in; (void)out_size; (void)ws_size;
    Params P{};
    P.x_in = (const float*)d_in[0]; P.c = (const float*)d_in[1]; P.pos = (const int*)d_in[2]; P.rel_bias = (const float*)d_in[3]; P.final_norm = (const float*)d_in[4];
    P.ada_w = (const float*)d_in[5]; P.ada_b = (const float*)d_in[6]; P.norm_mix = (const float*)d_in[7]; P.w_in = (const float*)d_in[8];
    P.mu = (const float*)d_in[9]; P.w0 = (const float*)d_in[10]; P.w_up = (const float*)d_in[11]; P.a0 = (const float*)d_in[12]; P.a_up = (const float*)d_in[13]; P.g_up = (const float*)d_in[14];
    P.k_k = (const float*)d_in[15]; P.k_a = (const float*)d_in[16]; P.r_k = (const float*)d_in[17]; P.ln_w = (const float*)d_in[18]; P.ln_b = (const float*)d_in[19];
    P.sc_conv_w = (const float*)d_in[20]; P.w_branch = (const float*)d_in[21]; P.w_o = (const float*)d_in[22]; P.norm_ffn = (const float*)d_in[23];
    P.ffn_w_up = (const float*)d_in[24]; P.ffn_conv_w = (const float*)d_in[25]; P.ffn_w_down = (const float*)d_in[26];
    P.out = (float*)d_out; P.ws = (unsigned char*)d_ws;
#if MK_SINGLE
    static bool attr = false;
    if (!attr) { hipFuncSetAttribute((const void*)k_mega, hipFuncAttributeMaxDynamicSharedMemorySize, LDS_BYTES); attr = true; }
    hipMemsetAsync((unsigned char*)d_ws + OFF_BAR, 0, XCD_BAR_WORDS * sizeof(unsigned), stream);
    hipLaunchKernelGGL(k_mega, dim3(NBLK), dim3(NTHR), LDS_BYTES, stream, P);
#else
    for (int l = 0; l < 2; ++l) {
        launch_phase<PH_PRO>(P, l, stream); launch_phase<PH_NORM1>(P, l, stream); launch_phase<PH_ZQ>(P, l, stream); launch_phase<PH_KI>(P, l, stream); launch_phase<PH_IDX>(P, l, stream);
        launch_phase<PH_ATT>(P, l, stream); launch_phase<PH_ZR>(P, l, stream); launch_phase<PH_SCAN>(P, l, stream); launch_phase<PH_COMB>(P, l, stream);
        launch_phase<PH_POST>(P, l, stream); launch_phase<PH_ZC>(P, l, stream); launch_phase<PH_CONV>(P, l, stream); launch_phase<PH_MERGE>(P, l, stream);
        launch_phase<PH_WO>(P, l, stream); launch_phase<PH_NORM2>(P, l, stream); launch_phase<PH_UP>(P, l, stream); launch_phase<PH_U>(P, l, stream);
        launch_phase<PH_DOWN>(P, l, stream);
    }
    launch_phase<PH_FINAL>(P, 0, stream);
#endif
}
```

```cpp
#include <hip/hip_runtime.h>
#include <stdint.h>

#ifndef MK_SINGLE
#define MK_SINGLE 1
#endif

#define LAS __attribute__((address_space(3)))
typedef unsigned short bf16_t;
typedef short bf16x8 __attribute__((ext_vector_type(8)));
typedef short bf16x4 __attribute__((ext_vector_type(4)));
typedef float f32x4 __attribute__((ext_vector_type(4)));
typedef float f32x16 __attribute__((ext_vector_type(16)));
typedef float f32x2 __attribute__((ext_vector_type(2)));
typedef unsigned u32x4 __attribute__((ext_vector_type(4)));
typedef unsigned u32x2 __attribute__((ext_vector_type(2)));
typedef int i32x4 __attribute__((ext_vector_type(4)));
typedef unsigned long long u64;
typedef unsigned long long u64x2 __attribute__((ext_vector_type(2)));

constexpr int T_ = 32768, D_ = 1024, NB_ = 8, S_ = 4096;
constexpr int NSEG = 32, SEGL = 128, TB = 8;
constexpr int NBLK = 256, NTHR = 512;
constexpr int IN_COLS = 8520, DFF = 2816;
constexpr int LDS_BYTES = 150 * 1024;

constexpr size_t MiB = 1ull << 20;
constexpr size_t OFF_BAR = 0;
constexpr size_t OFF_MOD = 64 * 1024;
constexpr size_t OFF_TAB = 512 * 1024;
constexpr size_t OFF_KPM = 520 * 1024;
constexpr size_t OFF_WB = 2 * MiB;
constexpr size_t WB_WIN = 0;
constexpr size_t WB_WBR = WB_WIN + (size_t)8704 * 1024 * 2;
constexpr size_t WB_WO = WB_WBR + (size_t)3 * 1024 * 512 * 2;
constexpr size_t WB_WUP = WB_WO + (size_t)1024 * 1024 * 2;
constexpr size_t WB_WDN = WB_WUP + (size_t)5632 * 1024 * 2;
constexpr size_t WB_LW = WB_WDN + (size_t)1024 * 2816 * 2;
constexpr size_t WB_LA = WB_LW + (size_t)512 * 64 * 2;
constexpr size_t WB_LG = WB_LA + (size_t)512 * 64 * 2;
constexpr size_t OFF_H = 42 * MiB;
constexpr size_t OFF_ZQ = 106 * MiB;
constexpr size_t OFF_MASK = 250 * MiB;
constexpr size_t OFF_VT = 266 * MiB;
constexpr size_t OFF_ZR = 330 * MiB;
constexpr size_t OFF_Y = 234 * MiB;
constexpr size_t OFF_P = 266 * MiB;
constexpr size_t OFF_G = 298 * MiB;
constexpr size_t OFF_SEG = 106 * MiB;
constexpr size_t OFF_KI = 314 * MiB;
constexpr size_t OFF_ZCV = 106 * MiB;
constexpr size_t OFF_ZG = 202 * MiB;
constexpr size_t OFF_MRG = 106 * MiB;
constexpr size_t OFF_UP = 106 * MiB;
constexpr size_t OFF_HA = 300 * MiB;
constexpr size_t OFF_HB = 320 * MiB;
constexpr size_t OFF_OCONV = 416 * MiB;
constexpr size_t OFF_ORWKV = 448 * MiB;
constexpr size_t OFF_OATT = 480 * MiB;
constexpr size_t OFF_VB = OFF_ORWKV;
constexpr size_t OFF_SCR = 170 * MiB;

struct Params {
    const float* x_in; const float* c; const int* pos; const float* rel_bias; const float* final_norm;
    const float* ada_w; const float* ada_b; const float* norm_mix; const float* w_in;
    const float* mu; const float* w0; const float* w_up; const float* a0; const float* a_up; const float* g_up;
    const float* k_k; const float* k_a; const float* r_k; const float* ln_w; const float* ln_b;
    const float* sc_conv_w; const float* w_branch; const float* w_o; const float* norm_ffn;
    const float* ffn_w_up; const float* ffn_conv_w; const float* ffn_w_down;
    float* out; unsigned char* ws;
};

__device__ __forceinline__ float bf2f(bf16_t b) { return __uint_as_float(((unsigned)b) << 16); }
__device__ __forceinline__ bf16_t f2bf(float f) { unsigned u = __float_as_uint(f); u += 0x7FFFu + ((u >> 16) & 1u); return (bf16_t)(u >> 16); }
typedef __bf16 bf16x2_t __attribute__((ext_vector_type(2)));
__device__ __forceinline__ unsigned cvt_pk_bf16(float lo, float hi) { const f32x2 v = {lo, hi}; return __builtin_bit_cast(unsigned, __builtin_convertvector(v, bf16x2_t)); }
__device__ __forceinline__ float bflo(unsigned w) { return __uint_as_float(w << 16); }
__device__ __forceinline__ float bfhi(unsigned w) { return __uint_as_float(w & 0xffff0000u); }
__device__ __forceinline__ float shx(float v, int mask, int lane) { return __int_as_float(__builtin_amdgcn_ds_bpermute((lane ^ mask) << 2, __float_as_int(v))); }
__device__ __forceinline__ int shxi(int v, int mask, int lane) { return __builtin_amdgcn_ds_bpermute((lane ^ mask) << 2, v); }
__device__ __forceinline__ float wave_sum(float v, int lane) {
#pragma unroll
    for (int o = 32; o >= 1; o >>= 1) v += shx(v, o, lane);
    return v;
}
__device__ __forceinline__ void writelane_c2(int& vlo, int& vhi, int lo, int hi, int ln  ) {
    asm("s_nop 3\n\tv_writelane_b32 %0, %2, %4\n\tv_writelane_b32 %1, %3, %4" : "+v"(vlo), "+v"(vhi) : "s"(lo), "s"(hi), "n"(ln)); }
__device__ __forceinline__ int writelane_v(int vec, int val, int ln  ) { asm("s_mov_b32 m0, %2\n\ts_nop 3\n\tv_writelane_b32 %0, %1, m0" : "+v"(vec) : "s"(val), "s"(ln) : "m0"); return vec; }
__device__ __forceinline__ float sigmoidf_(float x) { return __builtin_amdgcn_rcpf(1.0f + __expf(-x)); }
__device__ __forceinline__ unsigned f2ord(float x) { unsigned u = __float_as_uint(x); return (u & 0x80000000u) ? ~u : (u | 0x80000000u); }
__device__ __forceinline__ float ord2f(unsigned k) { return __uint_as_float((k & 0x80000000u) ? (k & 0x7fffffffu) : ~k); }

__device__ __forceinline__ int opaque_tid() { int t = threadIdx.x; asm volatile("" : "+v"(t)); return t; }
__device__ __forceinline__ unsigned char* opaque_ptr(unsigned char* p) {
    typedef __attribute__((address_space(1))) unsigned char* gptr_t;
    gptr_t g = (gptr_t)p; asm volatile("" : "+s"(g)); return (unsigned char*)g; }

#define XB_TMO      128
#define XB_XCNT(j)  (256  + 64 * (j))
#define XB_XSUB(j)  (1280 + 64 * (j))
#define XB_XGEN(j)  (2304 + 64 * (j))
#define XB_TOP      3328
#define XB_TOPGEN   3392
#define XCD_BAR_WORDS 3456
#define XB_SPIN_CAP (1u << 22)

__device__ __forceinline__ unsigned xb_ld(unsigned* p)              { return __hip_atomic_load(p, __ATOMIC_RELAXED, __HIP_MEMORY_SCOPE_AGENT); }
__device__ __forceinline__ unsigned xb_add(unsigned* p, unsigned v) { return __hip_atomic_fetch_add(p, v, __ATOMIC_RELAXED, __HIP_MEMORY_SCOPE_AGENT); }
__device__ __forceinline__ unsigned xb_xcc_id() { return (unsigned)__builtin_amdgcn_s_getreg((3 << 11) | 20) & 0xFu; }
#define XB_SPIN(cond, bar) do { unsigned _sp = 0; while (cond) { __builtin_amdgcn_s_sleep(1); \
    if ((++_sp & 255u) == 0u) { if (xb_ld(&(bar)[XB_TMO])) break; if (_sp > XB_SPIN_CAP) { atomicAdd(&(bar)[XB_TMO], 1u); break; } } } } while (0)

struct XcdBarrier { unsigned* bar; unsigned x; volatile LAS unsigned* st; };

__device__ __forceinline__ XcdBarrier xcd_barrier_post(unsigned* bar, volatile LAS unsigned* st) {
    XcdBarrier b; b.bar = bar; b.x = xb_xcc_id(); b.st = st;
    if (threadIdx.x == 0) (void)xb_add(&bar[XB_XCNT(b.x)], 1u);
    return b;
}
__device__ __forceinline__ void xcd_barrier_complete(unsigned* bar, unsigned x, unsigned& nloc, unsigned& nx) {
    const unsigned G = gridDim.x * gridDim.y * gridDim.z;
    unsigned sum, cnt, mine, sp = 0u;
    for (;;) {
        sum = 0u; cnt = 0u; mine = 0u;
#pragma unroll
        for (unsigned j = 0; j < 16; ++j) { const unsigned c = xb_ld(&bar[XB_XCNT(j)]); sum += c; cnt += (c > 0u) ? 1u : 0u; mine = (j == x) ? c : mine; }
        if (sum == G) break;
        __builtin_amdgcn_s_sleep(1);
        if ((++sp & 255u) == 0u) { if (xb_ld(&bar[XB_TMO])) break; if (sp > XB_SPIN_CAP) { atomicAdd(&bar[XB_TMO], 1u); break; } }
    }
    nloc = mine > 0u ? mine : 1u; nx = cnt > 0u ? cnt : 1u;
}
__device__ __forceinline__ void xcd_barrier(const XcdBarrier& b) {
    asm volatile("s_waitcnt vmcnt(0)" ::: "memory");
    __syncthreads();
    if (threadIdx.x == 0) {
        unsigned* bar = b.bar;
        __builtin_amdgcn_s_waitcnt(0);
        unsigned nloc = b.st[0], nx = b.st[1];
        if (nloc == 0u) { xcd_barrier_complete(bar, b.x, nloc, nx); b.st[0] = nloc; b.st[1] = nx; }
        const unsigned old = xb_add(&bar[XB_XSUB(b.x)], 1u);
        const unsigned gen = old / nloc;
        if (old + 1u == (gen + 1u) * nloc) {
            __builtin_amdgcn_fence(__ATOMIC_RELEASE, "agent");
            asm volatile("s_waitcnt vmcnt(0)" ::: "memory");
            const unsigned og = xb_add(&bar[XB_TOP], 1u);
            const unsigned tg = og / nx;
            if (og + 1u == (tg + 1u) * nx) xb_add(&bar[XB_TOPGEN], 1u);
            else XB_SPIN(xb_ld(&bar[XB_TOPGEN]) == tg, bar);
            __builtin_amdgcn_fence(__ATOMIC_ACQUIRE, "agent");
            xb_add(&bar[XB_XGEN(b.x)], 1u);
            asm volatile("s_waitcnt vmcnt(0)" ::: "memory");
        } else {
            XB_SPIN(xb_ld(&bar[XB_XGEN(b.x)]) == gen, bar);
            __builtin_amdgcn_fence(__ATOMIC_ACQUIRE, "agent");
            asm volatile("s_waitcnt vmcnt(0)" ::: "memory");
        }
    }
    __syncthreads();
}

namespace g8 {
constexpr int BM = 256, BK = 64, HALF = 128, HTB = HALF * BK * 2, STAGE_BYTES = 8 * HTB, NXCD = 8, WGM = 8;
__device__ __forceinline__ int lds_byte(int r, int c) { const int st = (r >> 4) * 2 + (c >> 5), rr = r & 15, cc = c & 31, ob = rr * 64 + cc * 2; return st * 1024 + (ob ^ (((ob >> 9) & 1) << 5)); }
__device__ __forceinline__ void stage_rc(int b, int& R, int& C) { const int st = b / 1024, sb = b % 1024, swz = sb ^ (((sb >> 9) & 1) << 5); R = (st >> 1) * 16 + swz / 64; C = (st & 1) * 32 + (swz % 64) / 2; }
__device__ __forceinline__ int perm32(int rho) { const int n = rho >> 4, i = rho & 15; return 8 * (i >> 2) + 4 * n + (i & 3); }

struct Unit { const char* A; const char* B; int pm, pn, tag; };

struct SOrder {
    int nM, nN, nwg, G, c; const char* A; const char* Bt; size_t a_t, b_t;
    __device__ void init(int M, int N, int lda, int ldb, const void* A_, const void* Bt_) {
        nM = M / BM; nN = N / BM; nwg = nM * nN; G = (int)gridDim.x; c = (int)blockIdx.x; A = (const char*)A_; Bt = (const char*)Bt_;
        a_t = (size_t)BM * lda * 2; b_t = (size_t)BM * ldb * 2; }
    __device__ bool next(int i, Unit& u) const {
        const long L = (long)i * G + c; if (L >= nwg) return false;
        int wgid = (int)L; { const int q = nwg / NXCD, r = nwg % NXCD, xcd = wgid % NXCD, off = wgid / NXCD; wgid = (xcd < r ? xcd * (q + 1) : r * (q + 1) + (xcd - r) * q) + off; }
        const int nig = WGM * nN, gid = wgid / nig, fm = gid * WGM, gsz = (nM - fm) < WGM ? (nM - fm) : WGM;
        u.pm = fm + ((wgid % nig) % gsz); u.pn = (wgid % nig) / gsz; u.tag = 0;
        u.A = A + (size_t)u.pm * a_t; u.B = Bt + (size_t)u.pn * b_t; return true;
    }
};

template <class Epi, class Sched>
__device__ __forceinline__ void gemm_phase(LAS unsigned char* lds, const int K, const int lda, const int ldb, const Sched& S, const Epi& E) {
    const int tid = opaque_tid(), wid = __builtin_amdgcn_readfirstlane(tid >> 6), lane = tid & 63, wr = wid >> 2, wc = wid & 3, fr = lane & 15, fq = lane >> 4;
    const int nt = K / BK;
    unsigned voffA[2], voffB[2];
#pragma unroll
    for (int i = 0; i < 2; ++i) { int R, C; stage_rc(tid * 16 + i * 8192, R, C); const int Rb = Epi::PERM ? ((R & ~31) + perm32(R & 31)) : R;
        voffA[i] = (unsigned)(R * lda + C) * 2u; voffB[i] = (unsigned)(Rb * ldb + C) * 2u; }
    const size_t kstep = (size_t)(BK * 2);
    const size_t hstepA = (size_t)HALF * lda * 2, hstepB = (size_t)HALF * ldb * 2;
    const unsigned ldsw = (unsigned)wid * 1024u;
    const int aoff = lds_byte(wr * 64 + fr, fq * 8), boff = lds_byte(wc * 32 + fr, fq * 8);
#define PG8_SA(b, h) (((b) * 2 + (h)) * HTB)
#define PG8_SB(b, h) ((4 + (b) * 2 + (h)) * HTB)
#define PG8_STAGE(bufoff, gbase, voff) do { _Pragma("unroll") for (int _i = 0; _i < 2; ++_i) \
        __builtin_amdgcn_global_load_lds((const unsigned*)((const char*)(gbase) + (voff)[_i]), (LAS unsigned*)(lds + (bufoff) + ldsw + _i * 8192), 16, 0, 0); } while (0)
#define PG8_LDA(dst, b, h) do { _Pragma("unroll") for (int m = 0; m < 4; ++m) _Pragma("unroll") for (int k = 0; k < 2; ++k) dst[m][k] = *(const LAS bf16x8*)(lds + PG8_SA(b, h) + aoff + m * 2048 + k * 1024); } while (0)
#define PG8_LDB(dst, b, h) do { _Pragma("unroll") for (int n = 0; n < 2; ++n) _Pragma("unroll") for (int k = 0; k < 2; ++k) dst[n][k] = *(const LAS bf16x8*)(lds + PG8_SB(b, h) + boff + n * 2048 + k * 1024); } while (0)
#define PG8_MMA(ai, bj, At, Bt) do { __builtin_amdgcn_s_setprio(1); _Pragma("unroll") for (int m = 0; m < 4; ++m) _Pragma("unroll") for (int n = 0; n < 2; ++n) _Pragma("unroll") for (int k = 0; k < 2; ++k) \
        acc[ai][bj][m][n] = __builtin_amdgcn_mfma_f32_16x16x32_bf16(Bt[n][k], At[m][k], acc[ai][bj][m][n], 0, 0, 0); __builtin_amdgcn_s_setprio(0); } while (0)
#define PG8_WAIT_V(n) asm volatile("s_waitcnt vmcnt(" #n ")" ::: "memory")
#define PG8_WAIT_L(n) asm volatile("s_waitcnt lgkmcnt(" #n ")" ::: "memory")
#define PG8_BAR __builtin_amdgcn_s_barrier()
#define PG8_SCHED __builtin_amdgcn_sched_barrier(0)
    Unit cur, nxt; int ui = 0;
    if (!S.next(0, cur)) return;
    f32x4 acc[2][2][4][2];
#pragma unroll
    for (int a = 0; a < 2; ++a)
#pragma unroll
        for (int b = 0; b < 2; ++b)
#pragma unroll
            for (int m = 0; m < 4; ++m)
#pragma unroll
                for (int n = 0; n < 2; ++n) acc[a][b][m][n] = (f32x4){0.f, 0.f, 0.f, 0.f};
    bf16x8 At[4][2], B0[2][2], B1[2][2];
    const char* cA = cur.A; const char* cB = cur.B;
    PG8_STAGE(PG8_SB(0, 0), cB, voffB); PG8_STAGE(PG8_SA(0, 0), cA, voffA); PG8_STAGE(PG8_SB(0, 1), cB + hstepB, voffB); PG8_STAGE(PG8_SA(0, 1), cA + hstepA, voffA);
    if (wr == 1) PG8_BAR;
    PG8_WAIT_V(4); PG8_BAR;
    PG8_STAGE(PG8_SB(1, 0), cB + kstep, voffB); PG8_STAGE(PG8_SA(1, 0), cA + kstep, voffA); PG8_STAGE(PG8_SB(1, 1), cB + hstepB + kstep, voffB);
    PG8_WAIT_V(6); PG8_BAR;
    for (;;) {
        const bool has_next = S.next(ui + 1, nxt);
        const char* nA = has_next ? nxt.A : cA; const char* nB = has_next ? nxt.B : cB;
        for (int t = 0; t < nt; t += 2) {
            const bool last = (t == nt - 2);
            const char* a1 = cA + (size_t)(t + 1) * kstep;
            const char* a2 = last ? nA : cA + (size_t)(t + 2) * kstep; const char* b2 = last ? nB : cB + (size_t)(t + 2) * kstep;
            const char* a3 = a2 + kstep; const char* b3 = b2 + kstep;
            PG8_LDB(B0, 0, 0); PG8_SCHED; PG8_LDA(At, 0, 0); PG8_STAGE(PG8_SA(1, 1), a1 + hstepA, voffA);
            PG8_WAIT_L(8); PG8_BAR; PG8_WAIT_L(0); PG8_MMA(0, 0, At, B0); PG8_BAR; PG8_SCHED;
            PG8_LDB(B1, 0, 1); PG8_STAGE(PG8_SB(0, 0), b2, voffB);
            PG8_BAR; PG8_WAIT_L(0); PG8_MMA(0, 1, At, B1); PG8_BAR;
            PG8_LDA(At, 0, 1); PG8_STAGE(PG8_SA(0, 0), a2, voffA);
            PG8_BAR; PG8_WAIT_L(0); PG8_MMA(1, 0, At, B0); PG8_BAR; PG8_SCHED;
            PG8_STAGE(PG8_SB(0, 1), b2 + hstepB, voffB);
            PG8_WAIT_V(6); PG8_BAR; PG8_MMA(1, 1, At, B1); PG8_BAR;
            PG8_LDB(B0, 1, 0); PG8_SCHED; PG8_LDA(At, 1, 0); PG8_STAGE(PG8_SA(0, 1), a2 + hstepA, voffA);
            PG8_WAIT_L(8); PG8_BAR; PG8_WAIT_L(0); PG8_MMA(0, 0, At, B0); PG8_BAR; PG8_SCHED;
            PG8_LDB(B1, 1, 1); PG8_STAGE(PG8_SB(1, 0), b3, voffB);
            PG8_BAR; PG8_WAIT_L(0); PG8_MMA(0, 1, At, B1); PG8_BAR;
            PG8_LDA(At, 1, 1); PG8_STAGE(PG8_SA(1, 0), a3, voffA);
            PG8_BAR; PG8_WAIT_L(0); PG8_MMA(1, 0, At, B0); PG8_BAR; PG8_SCHED;
            PG8_STAGE(PG8_SB(1, 1), b3 + hstepB, voffB);
            PG8_WAIT_V(6); PG8_BAR; PG8_MMA(1, 1, At, B1); PG8_BAR;
        }
        bool keep = false;
        if constexpr (Epi::CHAIN) keep = E.chain(acc, cur, wr, wc, fr, fq); else E(acc, cur, wr, wc, fr, fq);
        if (!has_next) break;
        if (!keep) {
#pragma unroll
            for (int a = 0; a < 2; ++a)
#pragma unroll
                for (int b = 0; b < 2; ++b)
#pragma unroll
                    for (int m = 0; m < 4; ++m)
#pragma unroll
                        for (int n = 0; n < 2; ++n) acc[a][b][m][n] = (f32x4){0.f, 0.f, 0.f, 0.f};
        }
        cur = nxt; cA = nA; cB = nB; ++ui;
    }
    PG8_WAIT_V(0);
    if (wr == 0) PG8_BAR;
    PG8_BAR;
#undef PG8_SA
#undef PG8_SB
#undef PG8_STAGE
#undef PG8_LDA
#undef PG8_LDB
#undef PG8_MMA
#undef PG8_WAIT_V
#undef PG8_WAIT_L
#undef PG8_BAR
#undef PG8_SCHED
}

struct EpiBf {
    static constexpr bool PERM = true, CHAIN = false;
    bf16_t* O0; int ld0; int split; bf16_t* O1; int ld1; int act1;
    __device__ __forceinline__ void operator()(const f32x4 (&acc)[2][2][4][2], const Unit& u, int wr, int wc, int fr, int fq) const {
        const bool second = u.pn >= split;
        bf16_t* base = second ? O1 : O0; const int ld = second ? ld1 : ld0; const int colt = (second ? (u.pn - split) : u.pn) * BM;
        const bool act = second && act1;
        const int row0 = u.pm * BM + wr * 64 + fr, col0 = colt + wc * 32 + 8 * fq;
#pragma unroll
        for (int ai = 0; ai < 2; ++ai)
#pragma unroll
            for (int m = 0; m < 4; ++m) { bf16_t* rowp = base + (size_t)(row0 + ai * HALF + m * 16) * ld + col0;
#pragma unroll
                for (int bj = 0; bj < 2; ++bj) { f32x4 v0 = acc[ai][bj][m][0], v1 = acc[ai][bj][m][1];
                    if (act) {
#pragma unroll
                        for (int j = 0; j < 4; ++j) { v0[j] = sigmoidf_(v0[j]); v1[j] = sigmoidf_(v1[j]); } }
                    u32x4 w; w.x = cvt_pk_bf16(v0[0], v0[1]); w.y = cvt_pk_bf16(v0[2], v0[3]); w.z = cvt_pk_bf16(v1[0], v1[1]); w.w = cvt_pk_bf16(v1[2], v1[3]);
                    *(u32x4*)(rowp + bj * HALF) = w; } }
    }
};
struct EpiMerge {
    static constexpr bool PERM = true, CHAIN = true;
    bf16_t* M; const bf16_t* ZG;
    __device__ __forceinline__ bool chain(f32x4 (&acc)[2][2][4][2], const Unit& u, int wr, int wc, int fr, int fq) const {
        const int row0 = u.pm * BM + wr * 64 + fr, col0 = u.pn * BM + wc * 32 + 8 * fq;
        const bool last = u.tag == 2;
        const int tn = u.tag * 1024, td = (last ? 2 : u.tag + 1) * 1024;
        const float nlo = u.tag == 0 ? 0.f : 1e-12f;
#pragma unroll
        for (int am = 0; am < 4; ++am) { const int ai = am >> 1, m0 = 2 * (am & 1);
            u32x4 gn[2][2], gd[2][2];
            int ro = row0; asm volatile("" : "+v"(ro));
#pragma unroll
            for (int mm = 0; mm < 2; ++mm)
#pragma unroll
                for (int bj = 0; bj < 2; ++bj) { const bf16_t* gp = ZG + (size_t)(ro + ai * HALF + (m0 + mm) * 16) * 3072 + col0 + bj * HALF;
                    gn[mm][bj] = *(const u32x4*)(gp + tn); gd[mm][bj] = *(const u32x4*)(gp + td); }
#pragma unroll
            for (int mm = 0; mm < 2; ++mm)
#pragma unroll
                for (int bj = 0; bj < 2; ++bj) {
                    const u32x4 g = gn[mm][bj], h = gd[mm][bj];
                    const float nn[8] = {bflo(g.x), bfhi(g.x), bflo(g.y), bfhi(g.y), bflo(g.z), bfhi(g.z), bflo(g.w), bfhi(g.w)};
                    const float dd[8] = {bflo(h.x), bfhi(h.x), bflo(h.y), bfhi(h.y), bflo(h.z), bfhi(h.z), bflo(h.w), bfhi(h.w)};
                    float f[8];
#pragma unroll
                    for (int e = 0; e < 8; ++e) f[e] = fmaxf(nn[e], nlo) * __builtin_amdgcn_rcpf(last ? 1.0f : fmaxf(dd[e], 1e-12f));
                    f32x4& v0 = acc[ai][bj][m0 + mm][0]; f32x4& v1 = acc[ai][bj][m0 + mm][1];
                    v0[0] *= f[0]; v0[1] *= f[1]; v0[2] *= f[2]; v0[3] *= f[3]; v1[0] *= f[4]; v1[1] *= f[5]; v1[2] *= f[6]; v1[3] *= f[7];
                }
        }
        if (last) {
#pragma unroll
            for (int ai = 0; ai < 2; ++ai)
#pragma unroll
                for (int m = 0; m < 4; ++m) { const size_t r = (size_t)(row0 + ai * HALF + m * 16);
#pragma unroll
                    for (int bj = 0; bj < 2; ++bj) { const f32x4 v0 = acc[ai][bj][m][0], v1 = acc[ai][bj][m][1];
                        u32x4 w; w.x = cvt_pk_bf16(v0[0], v0[1]); w.y = cvt_pk_bf16(v0[2], v0[3]); w.z = cvt_pk_bf16(v1[0], v1[1]); w.w = cvt_pk_bf16(v1[2], v1[3]);
                        *(u32x4*)(M + r * 1024 + col0 + bj * HALF) = w; } }
        }
        return !last;
    }
};
struct EpiRes {
    static constexpr bool PERM = true, CHAIN = false;
    const float* xin32; const bf16_t* xin16; bf16_t* xout; const float* gate;
    template <bool F32>
    __device__ __forceinline__ void body(const f32x4 (&acc)[2][2][4][2], const Unit& u, int wr, int wc, int fr, int fq) const {
        const int row0 = u.pm * BM + wr * 64 + fr, col0 = u.pn * BM + wc * 32 + 8 * fq;
        const float* gp = gate + (size_t)(u.pm >> 4) * 6144 + col0;
        f32x4 gv[2][2];
#pragma unroll
        for (int bj = 0; bj < 2; ++bj) { gv[bj][0] = *(const f32x4*)(gp + bj * HALF); gv[bj][1] = *(const f32x4*)(gp + bj * HALF + 4); }
#pragma unroll
        for (int am = 0; am < 4; ++am) { const int ai = am >> 1, m0 = 2 * (am & 1);
            f32x4 xa[4][2][2]; u32x4 xw[4][2];
            int ro = row0; asm volatile("" : "+v"(ro));
#pragma unroll
            for (int m = m0; m < m0 + 2; ++m) { const size_t off = (size_t)(ro + ai * HALF + m * 16) * 1024 + col0;
#pragma unroll
                for (int bj = 0; bj < 2; ++bj) {
                    if (F32) { xa[m][bj][0] = *(const f32x4*)(xin32 + off + bj * HALF); xa[m][bj][1] = *(const f32x4*)(xin32 + off + bj * HALF + 4); }
                    else xw[m][bj] = *(const u32x4*)(xin16 + off + bj * HALF); } }
#pragma unroll
            for (int m = m0; m < m0 + 2; ++m) { const size_t off = (size_t)(ro + ai * HALF + m * 16) * 1024 + col0;
#pragma unroll
                for (int bj = 0; bj < 2; ++bj) {
                    f32x4 x0, x1;
                    if (F32) { x0 = xa[m][bj][0]; x1 = xa[m][bj][1]; }
                    else { const u32x4 w = xw[m][bj];
                        x0 = (f32x4){bflo(w.x), bfhi(w.x), bflo(w.y), bfhi(w.y)}; x1 = (f32x4){bflo(w.z), bfhi(w.z), bflo(w.w), bfhi(w.w)}; }
                    const f32x4 o0 = x0 + gv[bj][0] * acc[ai][bj][m][0], o1 = x1 + gv[bj][1] * acc[ai][bj][m][1];
                    u32x4 w; w.x = cvt_pk_bf16(o0[0], o0[1]); w.y = cvt_pk_bf16(o0[2], o0[3]); w.z = cvt_pk_bf16(o1[0], o1[1]); w.w = cvt_pk_bf16(o1[2], o1[3]);
                    *(u32x4*)(xout + off + bj * HALF) = w; } }
        }
    }
    __device__ __forceinline__ void operator()(const f32x4 (&acc)[2][2][4][2], const Unit& u, int wr, int wc, int fr, int fq) const {
        if (xin32) body<true>(acc, u, wr, wc, fr, fq); else body<false>(acc, u, wr, wc, fr, fq);
    }
};
__device__ __forceinline__ float dpp_prev(float x, float y, int n) {
    if (n == 1) { const int yr = __builtin_amdgcn_update_dpp(0, __float_as_int(y), 0x121, 0xf, 0xf, false);
                  return __int_as_float(__builtin_amdgcn_update_dpp(yr, __float_as_int(x), 0x111, 0xf, 0xf, false)); }
    const int yr = __builtin_amdgcn_update_dpp(0, __float_as_int(y), 0x122, 0xf, 0xf, false);
    return __int_as_float(__builtin_amdgcn_update_dpp(yr, __float_as_int(x), 0x112, 0xf, 0xf, false));
}
struct EpiUp {
    static constexpr bool PERM = true, CHAIN = false;
    bf16_t* U; float* HA; float* HB; const float* cw;
    __device__ __forceinline__ void operator()(const f32x4 (&acc)[2][2][4][2], const Unit& u, int wr, int wc, int fr, int fq) const {
        const int c0 = 128 * u.pn + 32 * wc + 8 * fq;
        float w0[8], w1[8], w2[8];
        { float f[24];
#pragma unroll
          for (int q = 0; q < 6; ++q) { const f32x4 v = *(const f32x4*)(cw + (size_t)c0 * 3 + 4 * q); f[4 * q] = v[0]; f[4 * q + 1] = v[1]; f[4 * q + 2] = v[2]; f[4 * q + 3] = v[3]; }
#pragma unroll
          for (int e = 0; e < 8; ++e) { w0[e] = f[3 * e]; w1[e] = f[3 * e + 1]; w2[e] = f[3 * e + 2]; } }
#pragma unroll
        for (int ai = 0; ai < 2; ++ai) {
            const int grp = 4 * u.pm + 2 * ai + wr;
            float Y[8];
#pragma unroll
            for (int e = 0; e < 8; ++e) Y[e] = 0.f;
#pragma unroll
            for (int m = 0; m < 4; ++m) {
                const size_t row = (size_t)u.pm * BM + ai * HALF + wr * 64 + m * 16 + fr;
                float X[8], G[8], o[8];
#pragma unroll
                for (int e = 0; e < 8; ++e) { X[e] = acc[ai][0][m][e >> 2][e & 3]; G[e] = acc[ai][1][m][e >> 2][e & 3]; }
#pragma unroll
                for (int e = 0; e < 8; ++e) { const float a1 = dpp_prev(X[e], Y[e], 1), a2 = dpp_prev(X[e], Y[e], 2);
                    const float s = w0[e] * a2 + w1[e] * a1 + w2[e] * X[e]; o[e] = s * sigmoidf_(s) * G[e]; }
                if (m > 0 || fr >= 2) { u32x4 w; w.x = cvt_pk_bf16(o[0], o[1]); w.y = cvt_pk_bf16(o[2], o[3]); w.z = cvt_pk_bf16(o[4], o[5]); w.w = cvt_pk_bf16(o[6], o[7]);
                    *(u32x4*)(U + row * DFF + c0) = w; }
                if (m == 0 && fr < 2) { float* hb = HB + ((size_t)(grp * 2 + fr) * 2) * DFF + c0;
                    *(f32x4*)hb = (f32x4){X[0], X[1], X[2], X[3]}; *(f32x4*)(hb + 4) = (f32x4){X[4], X[5], X[6], X[7]};
                    *(f32x4*)(hb + DFF) = (f32x4){G[0], G[1], G[2], G[3]}; *(f32x4*)(hb + DFF + 4) = (f32x4){G[4], G[5], G[6], G[7]}; }
                if (m == 3 && fr >= 14) { float* ha = HA + (size_t)(grp * 2 + fr - 14) * DFF + c0;
                    *(f32x4*)ha = (f32x4){X[0], X[1], X[2], X[3]}; *(f32x4*)(ha + 4) = (f32x4){X[4], X[5], X[6], X[7]}; }
#pragma unroll
                for (int e = 0; e < 8; ++e) Y[e] = X[e];
            }
        }
    }
};
struct MergeOrder {
    int G, c; const char* o_att; const char* wbr;
    __device__ bool next(int i, Unit& u) const {
        const int tile = (i / 3) * G + c; if (tile >= (T_ / BM) * 4) return false;
        const int br = i % 3; u.pm = tile >> 2; u.pn = tile & 3; u.tag = br;
        u.A = o_att - (size_t)br * (32 * MiB) + (size_t)u.pm * BM * 512 * 2;
        u.B = wbr + (size_t)br * 1024 * 512 * 2 + (size_t)u.pn * BM * 512 * 2; return true;
    }
};
}

#define GSTRIDE_BLOCKS(var, n) for (int var = blockIdx.x; var < (n); var += gridDim.x)

__device__ __forceinline__ void ph_mod(const Params& P, LAS unsigned char* lds) {
    LAS float* cl = (LAS float*)lds;
    LAS float* red = cl + 8192;
    float* mod = (float*)(P.ws + OFF_MOD); float* tab = (float*)(P.ws + OFF_TAB);
    const int tid = opaque_tid(), wid = tid >> 6, lane = tid & 63;
    for (int i = tid; i < 2048; i += NTHR) ((LAS f32x4*)cl)[i] = ((const f32x4*)P.c)[i];
    __syncthreads();
    GSTRIDE_BLOCKS(blk, 192) {
        const int l = blk / 96, jb = blk % 96, j = jb * 64 + lane;
        float acc[8];
#pragma unroll
        for (int b = 0; b < 8; ++b) acc[b] = 0.f;
        const float* aw = P.ada_w + (size_t)l * 1024 * 6144 + j;
#pragma unroll 1
        for (int k = wid * 128; k < wid * 128 + 128; k += 32) {
            float w[32];
#pragma unroll
            for (int u = 0; u < 32; ++u) w[u] = aw[(size_t)(k + u) * 6144];
#pragma unroll
            for (int u4 = 0; u4 < 8; ++u4)
#pragma unroll
                for (int b = 0; b < 8; ++b) { const f32x4 c4 = *(const LAS f32x4*)(cl + b * 1024 + k + 4 * u4);
                    acc[b] += c4.x * w[4 * u4]; acc[b] += c4.y * w[4 * u4 + 1]; acc[b] += c4.z * w[4 * u4 + 2]; acc[b] += c4.w * w[4 * u4 + 3]; }
        }
#pragma unroll
        for (int b = 0; b < 8; ++b) red[(wid * 8 + b) * 64 + lane] = acc[b];
        __syncthreads();
        { const int b = wid; float s = P.ada_b[l * 6144 + j];
#pragma unroll
          for (int w = 0; w < 8; ++w) s += red[(w * 8 + b) * 64 + lane];
          mod[((size_t)l * 8 + b) * 6144 + j] = s; }
        __syncthreads();
    }
    if (blockIdx.x == gridDim.x - 1) {
        for (int i = tid; i < 1024; i += NTHR) { const int n = i >> 3, h = i & 7; int bk;
            if (n < 16) bk = n; else { const float nf = (float)n; bk = 16 + (int)(logf(nf / 16.0f) / 2.0794415416798357f * 16.0f); bk = bk < 31 ? bk : 31; }
            tab[i] = P.rel_bias[bk * 8 + h]; }
    }
}

struct WJob { const float* src; int ldsrc; int K; int N; bf16_t* dst; int win; };
__device__ __forceinline__ int wjob_col(const WJob& J, const int nn) {
    int col = nn;
    if (J.win == 1) col = nn < 2120 ? nn : (nn < 2304 ? -1 : nn - 184);
    if (J.win == 2) col = ((nn & 255) < 128) ? 128 * (nn >> 8) + (nn & 127) : DFF + 128 * (nn >> 8) + (nn & 127);
    return col;
}
template <int KT  >
__device__ __forceinline__ void wtile_load(const WJob& J, const int lt, const int tid, float (&v)[KT / 8]) {
    const int nkt = J.K / KT, kt = lt % nkt, ntb = lt / nkt, k0 = kt * KT, n0 = ntb * 64;
    const int n = tid & 63, kk0 = tid >> 6; const int col = wjob_col(J, n0 + n);
#pragma unroll
    for (int p = 0; p < KT / 8; ++p) { const int k = kk0 + 8 * p; v[p] = col >= 0 ? J.src[(size_t)(k0 + k) * J.ldsrc + col] : 0.f; }
}
template <int KT>
__device__ __forceinline__ void wtile_put(LAS float* tile  , const int tid, const float (&v)[KT / 8]) {
    const int n = tid & 63, kk0 = tid >> 6;
#pragma unroll
    for (int p = 0; p < KT / 8; ++p) tile[(kk0 + 8 * p) * 65 + n] = v[p];
}
template <int KT>
__device__ __forceinline__ void wtile_out(const WJob& J, const int lt, const int tid, const LAS float* tile) {
    const int nkt = J.K / KT, kt = lt % nkt, ntb = lt / nkt, k0 = kt * KT, n0 = ntb * 64;
#pragma unroll
    for (int q = 0; q < KT / 64; ++q) { const int n = tid >> 3, kg = (tid & 7) + 8 * q; float v[8];
#pragma unroll
      for (int e = 0; e < 8; ++e) v[e] = tile[(kg * 8 + e) * 65 + n];
      u32x4 w; w.x = cvt_pk_bf16(v[0], v[1]); w.y = cvt_pk_bf16(v[2], v[3]); w.z = cvt_pk_bf16(v[4], v[5]); w.w = cvt_pk_bf16(v[6], v[7]);
      *(u32x4*)(J.dst + (size_t)(n0 + n) * J.K + k0 + kg * 8) = w; }
}
__device__ __forceinline__ void ph_wconv(const Params& P, int l, LAS unsigned char* lds) {
    LAS float* tile = (LAS float*)lds; unsigned char* wb = P.ws + OFF_WB;
    const int tid = opaque_tid();
    constexpr int NBIG = 1232;
    auto big_job = [&](const int ti, WJob& J, int& lt) {
        if (ti < 544) { J = WJob{P.w_in + (size_t)l * 1024 * IN_COLS, IN_COLS, 1024, 8704, (bf16_t*)(wb + WB_WIN), 1}; lt = ti; }
        else if (ti < 640) { const int i = (ti - 544) >> 5; J = WJob{P.w_branch + ((size_t)l * 3 + i) * 512 * 1024, 1024, 512, 1024, (bf16_t*)(wb + WB_WBR) + (size_t)i * 1024 * 512, 0}; lt = (ti - 544) & 31; }
        else if (ti < 704) { J = WJob{P.w_o + (size_t)l * 1024 * 1024, 1024, 1024, 1024, (bf16_t*)(wb + WB_WO), 0}; lt = ti - 640; }
        else if (ti < 1056) { J = WJob{P.ffn_w_up + (size_t)l * 1024 * 5632, 5632, 1024, 5632, (bf16_t*)(wb + WB_WUP), 2}; lt = ti - 704; }
        else { J = WJob{P.ffn_w_down + (size_t)l * 2816 * 1024, 1024, 2816, 1024, (bf16_t*)(wb + WB_WDN), 0}; lt = ti - 1056; } };
    {
        int ti = blockIdx.x; WJob J; int lt; float v[32];
        big_job(ti, J, lt); wtile_load<256>(J, lt, tid, v);
        for (;;) {
            wtile_put<256>(tile, tid, v);
            __syncthreads();
            const int tn = ti + gridDim.x; const bool more = tn < NBIG; WJob Jn = J; int ltn = lt;
            if (more) { big_job(tn, Jn, ltn); wtile_load<256>(Jn, ltn, tid, v); }
            wtile_out<256>(J, lt, tid, tile);
            __syncthreads();
            if (!more) break;
            J = Jn; lt = ltn; ti = tn;
        }
    }
    for (int ts = gridDim.x - 1 - blockIdx.x; ts < 32; ts += gridDim.x) {
        WJob J; int lt;
        if (ts < 8) { J = WJob{P.w_up + (size_t)l * 64 * 512, 512, 64, 512, (bf16_t*)(wb + WB_LW), 0}; lt = ts; }
        else if (ts < 16) { J = WJob{P.a_up + (size_t)l * 64 * 512, 512, 64, 512, (bf16_t*)(wb + WB_LA), 0}; lt = ts - 8; }
        else { J = WJob{P.g_up + (size_t)l * 128 * 512, 512, 128, 512, (bf16_t*)(wb + WB_LG), 0}; lt = ts - 16; }
        float v[8];
        wtile_load<64>(J, lt, tid, v); wtile_put<64>(tile, tid, v);
        __syncthreads();
        wtile_out<64>(J, lt, tid, tile);
        __syncthreads();
    }
}

__device__ __forceinline__ void ph_norm(const Params& P, int l, int which) {
    const bool first = (l == 0 && which == 0);
    const float* nw = (which == 0 ? P.norm_mix : P.norm_ffn) + l * 1024;
    const float* mod = (const float*)(P.ws + OFF_MOD) + (size_t)l * 8 * 6144 + which * 3072;
    const bf16_t* XB = (const bf16_t*)P.out;
    bf16_t* H = (bf16_t*)(P.ws + OFF_H);
    const int tid = opaque_tid(), wid = tid >> 6, lane = tid & 63;
    for (int row = blockIdx.x * 8 + wid; row < T_; row += gridDim.x * 8) {
        const int b = row >> 12; const float* mb = mod + (size_t)b * 6144;
        f32x4 v[4]; float ss = 0.f;
#pragma unroll
        for (int i = 0; i < 4; ++i) {
            if (first) v[i] = *(const f32x4*)(P.x_in + (size_t)row * 1024 + i * 256 + lane * 4);
            else { const u32x2 w = *(const u32x2*)(XB + (size_t)row * 1024 + i * 256 + lane * 4); v[i] = (f32x4){bflo(w.x), bfhi(w.x), bflo(w.y), bfhi(w.y)}; }
            ss += v[i][0] * v[i][0] + v[i][1] * v[i][1] + v[i][2] * v[i][2] + v[i][3] * v[i][3]; }
        ss = wave_sum(ss, lane);
        const float rstd = rsqrtf(ss * (1.0f / 1024.0f) + 1e-6f);
#pragma unroll
        for (int i = 0; i < 4; ++i) { const int c = i * 256 + lane * 4;
            const f32x4 g = *(const f32x4*)(nw + c), sh = *(const f32x4*)(mb + c), sc = *(const f32x4*)(mb + 1024 + c);
            const f32x4 y = v[i] * rstd * g * (sc + 1.0f) + sh;
            u32x2 w; w.x = cvt_pk_bf16(y[0], y[1]); w.y = cvt_pk_bf16(y[2], y[3]);
            *(u32x2*)(H + (size_t)row * 1024 + c) = w; }
    }
}

__device__ __forceinline__ void ph_final(const Params& P) {
    const bf16_t* XF = (const bf16_t*)(P.ws + OFF_H);
    const int tid = opaque_tid(), wid = tid >> 6, lane = tid & 63;
    for (int row = blockIdx.x * 8 + wid; row < T_; row += gridDim.x * 8) {
        float* xr = P.out + (size_t)row * 1024;
        f32x4 v[4]; float ss = 0.f;
#pragma unroll
        for (int i = 0; i < 4; ++i) { const u32x2 w = *(const u32x2*)(XF + (size_t)row * 1024 + i * 256 + lane * 4); v[i] = (f32x4){bflo(w.x), bfhi(w.x), bflo(w.y), bfhi(w.y)};
            ss += v[i][0] * v[i][0] + v[i][1] * v[i][1] + v[i][2] * v[i][2] + v[i][3] * v[i][3]; }
        ss = wave_sum(ss, lane);
        const float rstd = rsqrtf(ss * (1.0f / 1024.0f) + 1e-6f);
#pragma unroll
        for (int i = 0; i < 4; ++i) { const int c = i * 256 + lane * 4; const f32x4 g = *(const f32x4*)(P.final_norm + c);
            *(f32x4*)(xr + c) = v[i] * rstd * g; }
    }
}

__device__ __forceinline__ void ph_gemm_zq(const Params& P, LAS unsigned char* lds) {
    g8::SOrder S; S.init(T_, 4096, 1024, 1024, P.ws + OFF_H, P.ws + OFF_WB + WB_WIN);
    g8::EpiBf E{(bf16_t*)(P.ws + OFF_ZQ), 2304, 9, (bf16_t*)(P.ws + OFF_ZR), 1792, 0};
    g8::gemm_phase(lds, 1024, 1024, 1024, S, E);
}
__device__ __forceinline__ void ph_gemm_zc(const Params& P, LAS unsigned char* lds) {
    g8::SOrder S; S.init(T_, 4608, 1024, 1024, P.ws + OFF_H, P.ws + OFF_WB + WB_WIN + (size_t)4096 * 1024 * 2);
    g8::EpiBf E{(bf16_t*)(P.ws + OFF_ZCV), 1536, 6, (bf16_t*)(P.ws + OFF_ZG), 3072, 1};
    g8::gemm_phase(lds, 1024, 1024, 1024, S, E);
}
__device__ __forceinline__ void ph_gemm_merge(const Params& P, LAS unsigned char* lds) {
    g8::MergeOrder S{(int)gridDim.x, (int)blockIdx.x, (const char*)(P.ws + OFF_OATT), (const char*)(P.ws + OFF_WB + WB_WBR)};
    g8::EpiMerge E{(bf16_t*)(P.ws + OFF_MRG), (const bf16_t*)(P.ws + OFF_ZG)};
    g8::gemm_phase(lds, 512, 512, 512, S, E);
}
__device__ __forceinline__ void ph_gemm_wo(const Params& P, int l, LAS unsigned char* lds) {
    g8::SOrder S; S.init(T_, 1024, 1024, 1024, P.ws + OFF_MRG, P.ws + OFF_WB + WB_WO);
    g8::EpiRes E{l == 0 ? P.x_in : nullptr, (const bf16_t*)P.out, (bf16_t*)P.out, (const float*)(P.ws + OFF_MOD) + (size_t)l * 8 * 6144 + 2048};
    g8::gemm_phase(lds, 1024, 1024, 1024, S, E);
}
__device__ __forceinline__ void ph_gemm_up(const Params& P, int l, LAS unsigned char* lds) {
    g8::SOrder S; S.init(T_, 5632, 1024, 1024, P.ws + OFF_H, P.ws + OFF_WB + WB_WUP);
    g8::EpiUp E{(bf16_t*)(P.ws + OFF_UP), (float*)(P.ws + OFF_HA), (float*)(P.ws + OFF_HB), P.ffn_conv_w + (size_t)l * DFF * 3};
    g8::gemm_phase(lds, 1024, 1024, 1024, S, E);
}
__device__ __forceinline__ void ph_gemm_down(const Params& P, int l, LAS unsigned char* lds) {
    g8::SOrder S; S.init(T_, 1024, 2816, 2816, P.ws + OFF_UP, P.ws + OFF_WB + WB_WDN);
    g8::EpiRes E{nullptr, (const bf16_t*)P.out, l == 1 ? (bf16_t*)(P.ws + OFF_H) : (bf16_t*)P.out, (const float*)(P.ws + OFF_MOD) + (size_t)l * 8 * 6144 + 5120};
    g8::gemm_phase(lds, 2816, 2816, 2816, S, E);
}

__device__ __forceinline__ void ph_conv(const Params& P, int l, LAS unsigned char* lds) {
    const bf16_t* Z = (const bf16_t*)(P.ws + OFF_ZCV); bf16_t* O = (bf16_t*)(P.ws + OFF_OCONV);
    LAS float* cwT = (LAS float*)lds;
    const int tid = opaque_tid();
    for (int i = tid; i < 1536; i += NTHR) cwT[(i % 3) * 512 + i / 3] = P.sc_conv_w[(size_t)l * 1536 + i];
    __syncthreads();
    constexpr int RB = 16; const int nitem = (T_ / RB) * 64;
    for (int it = blockIdx.x * NTHR + tid; it < nitem; it += gridDim.x * NTHR) {
        const int rb = it >> 6, c0 = (it & 63) * 8, row0 = rb * RB, t0 = row0 & 4095;
        float w0[8], w1[8], w2[8];
#pragma unroll
        for (int e = 0; e < 8; ++e) { w0[e] = cwT[c0 + e]; w1[e] = cwT[512 + c0 + e]; w2[e] = cwT[1024 + c0 + e]; }
        float pm2[8], pm1[8];
#pragma unroll
        for (int e = 0; e < 8; ++e) { pm2[e] = 0.f; pm1[e] = 0.f; }
        if (t0 >= 2) {
#pragma unroll
            for (int j = 0; j < 2; ++j) { const bf16_t* zr = Z + (size_t)(row0 - 2 + j) * 1536;
                const u32x4 cc = *(const u32x4*)(zr + 512 + c0), cx = *(const u32x4*)(zr + 1024 + c0);
                const unsigned ccw[4] = {cc.x, cc.y, cc.z, cc.w}, cxw[4] = {cx.x, cx.y, cx.z, cx.w};
#pragma unroll
                for (int q = 0; q < 4; ++q) { const float a = bflo(ccw[q]) * bflo(cxw[q]), b2 = bfhi(ccw[q]) * bfhi(cxw[q]);
                    if (j == 0) { pm2[2 * q] = a; pm2[2 * q + 1] = b2; } else { pm1[2 * q] = a; pm1[2 * q + 1] = b2; } } }
        }
#pragma unroll 4
        for (int r = 0; r < RB; ++r) {
            const bf16_t* zr = Z + (size_t)(row0 + r) * 1536;
            const u32x4 cb = *(const u32x4*)(zr + c0), cc = *(const u32x4*)(zr + 512 + c0), cx = *(const u32x4*)(zr + 1024 + c0);
            const unsigned cbw[4] = {cb.x, cb.y, cb.z, cb.w}, ccw[4] = {cc.x, cc.y, cc.z, cc.w}, cxw[4] = {cx.x, cx.y, cx.z, cx.w};
            float cur[8], o[8];
#pragma unroll
            for (int q = 0; q < 4; ++q) { cur[2 * q] = bflo(ccw[q]) * bflo(cxw[q]); cur[2 * q + 1] = bfhi(ccw[q]) * bfhi(cxw[q]); }
#pragma unroll
            for (int e = 0; e < 8; ++e) { o[e] = w0[e] * pm2[e] + w1[e] * pm1[e] + w2[e] * cur[e]; pm2[e] = pm1[e]; pm1[e] = cur[e]; }
            u32x4 w; w.x = cvt_pk_bf16(o[0] * bflo(cbw[0]), o[1] * bfhi(cbw[0])); w.y = cvt_pk_bf16(o[2] * bflo(cbw[1]), o[3] * bfhi(cbw[1]));
            w.z = cvt_pk_bf16(o[4] * bflo(cbw[2]), o[5] * bfhi(cbw[2])); w.w = cvt_pk_bf16(o[6] * bflo(cbw[3]), o[7] * bfhi(cbw[3]));
            *(u32x4*)(O + (size_t)(row0 + r) * 512 + c0) = w;
        }
    }
}

__device__ __forceinline__ void ph_ufix(const Params& P, int l, LAS unsigned char* lds) {
    bf16_t* U = (bf16_t*)(P.ws + OFF_UP); const float* HA = (const float*)(P.ws + OFF_HA); const float* HB = (const float*)(P.ws + OFF_HB);
    LAS float* cwT = (LAS float*)lds;
    const int tid = opaque_tid();
    for (int i = tid; i < DFF * 3; i += NTHR) cwT[(i % 3) * DFF + i / 3] = P.ffn_conv_w[(size_t)l * DFF * 3 + i];
    __syncthreads();
    const int nitem = (T_ / 64) * 2 * 352;
    for (int it = blockIdx.x * NTHR + tid; it < nitem; it += gridDim.x * NTHR) {
        const int c0 = (it % 352) * 8, gr = it / 352, grp = gr >> 1, rr = gr & 1; const bool first = (grp & 63) == 0;
        const float* hb = HB + ((size_t)(grp * 2 + rr) * 2) * DFF + c0;
        float a0[8], a1[8], a2[8], g[8];
#pragma unroll
        for (int q = 0; q < 2; ++q) { const f32x4 va = *(const f32x4*)(hb + 4 * q), vg = *(const f32x4*)(hb + DFF + 4 * q);
#pragma unroll
            for (int e = 0; e < 4; ++e) { a0[4 * q + e] = va[e]; g[4 * q + e] = vg[e]; a1[4 * q + e] = 0.f; a2[4 * q + e] = 0.f; } }
        if (rr == 1) { const float* p1 = HB + ((size_t)(grp * 2) * 2) * DFF + c0;
#pragma unroll
            for (int q = 0; q < 2; ++q) { const f32x4 v = *(const f32x4*)(p1 + 4 * q);
#pragma unroll
                for (int e = 0; e < 4; ++e) a1[4 * q + e] = v[e]; } }
        if (!first) {
            const float* pl = HA + (size_t)((grp - 1) * 2 + 1) * DFF + c0;
            const float* pk = HA + (size_t)((grp - 1) * 2) * DFF + c0;
#pragma unroll
            for (int q = 0; q < 2; ++q) { const f32x4 v63 = *(const f32x4*)(pl + 4 * q), v62 = *(const f32x4*)(pk + 4 * q);
#pragma unroll
                for (int e = 0; e < 4; ++e) { if (rr == 1) a2[4 * q + e] = v63[e]; else { a1[4 * q + e] = v63[e]; a2[4 * q + e] = v62[e]; } } }
        }
        float o[8];
#pragma unroll
        for (int e = 0; e < 8; ++e) { const float s = cwT[c0 + e] * a2[e] + cwT[DFF + c0 + e] * a1[e] + cwT[2 * DFF + c0 + e] * a0[e]; o[e] = s * sigmoidf_(s) * g[e]; }
        u32x4 w; w.x = cvt_pk_bf16(o[0], o[1]); w.y = cvt_pk_bf16(o[2], o[3]); w.z = cvt_pk_bf16(o[4], o[5]); w.w = cvt_pk_bf16(o[6], o[7]);
        *(u32x4*)(U + (size_t)(grp * 64 + rr) * DFF + c0) = w;
    }
}

__device__ __forceinline__ unsigned wave_scan_u32(unsigned v) {
    v += (unsigned)__builtin_amdgcn_update_dpp(0, (int)v, 0x111, 0xf, 0xf, true);
    v += (unsigned)__builtin_amdgcn_update_dpp(0, (int)v, 0x112, 0xf, 0xf, true);
    v += (unsigned)__builtin_amdgcn_update_dpp(0, (int)v, 0x114, 0xf, 0xf, true);
    v += (unsigned)__builtin_amdgcn_update_dpp(0, (int)v, 0x118, 0xf, 0xf, true);
    v += (unsigned)__builtin_amdgcn_update_dpp(0, (int)v, 0x142, 0xa, 0xf, false);
    v += (unsigned)__builtin_amdgcn_update_dpp(0, (int)v, 0x143, 0xc, 0xf, false);
    return v;
}
template <bool MAX>
__device__ __forceinline__ float wave_minmax_dpp(float v) {
#define MM_STEP(CTRL, RM) { const float o = __int_as_float(__builtin_amdgcn_update_dpp(__float_as_int(v), __float_as_int(v), CTRL, RM, 0xf, false)); v = MAX ? fmaxf(v, o) : fminf(v, o); }
    MM_STEP(0x111, 0xf) MM_STEP(0x112, 0xf) MM_STEP(0x114, 0xf) MM_STEP(0x118, 0xf) MM_STEP(0x142, 0xa) MM_STEP(0x143, 0xc)
#undef MM_STEP
    return __int_as_float(__builtin_amdgcn_readlane(__float_as_int(v), 63));
}
template <bool MAX>
__device__ __forceinline__ unsigned wave_uminmax_dpp(unsigned v) {
#define MM_STEP(CTRL, RM) { const unsigned o = (unsigned)__builtin_amdgcn_update_dpp((int)v, (int)v, CTRL, RM, 0xf, false); v = MAX ? (v > o ? v : o) : (v < o ? v : o); }
    MM_STEP(0x111, 0xf) MM_STEP(0x112, 0xf) MM_STEP(0x114, 0xf) MM_STEP(0x118, 0xf) MM_STEP(0x142, 0xa) MM_STEP(0x143, 0xc)
#undef MM_STEP
    return (unsigned)__builtin_amdgcn_readlane((int)v, 63);
}
template <int NR>
__device__ __forceinline__ u64 select_row(LAS float* row, const int t, const int lz) {
    const int imax = t >> 6;
    float x[NR]; float Tx = 0.f; bool have = false, exact = false;
    {
        int bin[NR]; float lo = __builtin_inff(), hi = -__builtin_inff();
        LAS unsigned* hist = (LAS unsigned*)row;
#pragma unroll
        for (int i = 0; i < NR; ++i) { const float v = row[64 * i + lz]; x[i] = (i <= imax) ? v : -__builtin_inff(); hi = fmaxf(hi, x[i]); lo = fminf(lo, (i < imax || x[i] > -__builtin_inff()) ? x[i] : __builtin_inff()); }
        lo = wave_minmax_dpp<false>(lo); hi = wave_minmax_dpp<true>(hi);
        if (hi > lo) {
            const float scale = 4095.0f / (hi - lo), nls = -lo * scale;
#pragma unroll
            for (int q = 0; q < 16; ++q) *(LAS u32x4*)(hist + 256 * q + 4 * lz) = (u32x4){0u, 0u, 0u, 0u};
#pragma unroll
            for (int i = 0; i < NR; ++i) {
                int bq; { const float fb = __builtin_fmaf(x[i], scale, nls); asm("v_cvt_i32_f32 %0, %1" : "=v"(bq) : "v"(fb)); }
                bin[i] = bq;
                if (bq >= 0) __hip_atomic_fetch_add(hist + bq, 1u, __ATOMIC_RELAXED, __HIP_MEMORY_SCOPE_WORKGROUP); }
            unsigned c1 = 0u;
#pragma unroll
            for (int q = 0; q < 16; ++q) { const u32x4 h4 = *(const LAS u32x4*)(hist + 64 * lz + 4 * ((q + lz) & 15)); c1 += (h4.x + h4.y) + (h4.z + h4.w); }
            const unsigned pf1 = wave_scan_u32(c1);
            const unsigned ab1 = (unsigned)__builtin_amdgcn_readlane((int)pf1, 63) - pf1;
            const u64 cr1 = __ballot(ab1 < 256u && ab1 + c1 >= 256u);
            const int L1 = __builtin_ctzll(cr1);
            const unsigned abL = (unsigned)__builtin_amdgcn_readlane((int)ab1, L1);
            const unsigned c2 = hist[64 * L1 + lz];
            const unsigned pf2 = wave_scan_u32(c2);
            const unsigned ab2 = (unsigned)__builtin_amdgcn_readlane((int)pf2, 63) - pf2 + abL;
            const u64 cr2 = __ballot(ab2 < 256u && ab2 + c2 >= 256u);
            const int L2 = __builtin_ctzll(cr2);
            const int bstar = 64 * L1 + L2;
            const int cb = __builtin_amdgcn_readlane((int)c2, L2), need2 = 256 - __builtin_amdgcn_readlane((int)ab2, L2);
            if (cb <= 64) {
                int cand = 0; int pos = 0;
#pragma unroll
                for (int i = 0; i < NR; ++i) { u64 mm = __ballot(bin[i] == bstar);
                    while (mm) { const int s = __builtin_ctzll(mm); mm &= mm - 1ull; cand = writelane_v(cand, __builtin_amdgcn_readlane(__float_as_int(x[i]), s), pos); ++pos; } }
                const unsigned cu = (lz < cb) ? f2ord(__int_as_float(cand)) : 0u;
                const unsigned vmax = wave_uminmax_dpp<true>(cu), vmin = wave_uminmax_dpp<false>((lz < cb) ? cu : 0xFFFFFFFFu), dif = vmax ^ vmin;
                unsigned Tc = vmax;
                if (dif != 0u) {
                    const int top = 31 - __builtin_clz(dif); Tc = vmax & ~((2u << top) - 1u);
#pragma unroll 1
                    for (int bit = top; bit >= 0; --bit) { const unsigned cd = Tc | (1u << bit); if ((int)__popcll(__ballot(cu >= cd)) >= need2) Tc = cd; }
                }
                Tx = ord2f(Tc); have = true; exact = (256 - need2) + (int)__popcll(__ballot(cu >= Tc)) == 256;
            }
        }
    }
    if (!have) {
        unsigned Tt = 0u;
#pragma unroll 1
        for (int bit = 31; bit >= 0; --bit) {
            const unsigned cand = Tt | (1u << bit); int cnt = 0;
#pragma unroll
            for (int i = 0; i < NR; ++i) cnt += __popcll(__ballot(f2ord(x[i]) >= cand));
            if (cnt >= 256) Tt = cand;
        }
        Tx = ord2f(Tt);
    }
    int wlo = 0, whi = 0;
#pragma unroll
    for (int i = 0; i < NR; ++i) { const u64 g = __ballot(x[i] >= Tx); writelane_c2(wlo, whi, (int)(unsigned)g, (int)(unsigned)(g >> 32), i); }
    u64 myw = ((u64)(unsigned)whi << 32) | (unsigned)wlo;
    if (!exact) {
        int cgt = 0;
#pragma unroll
        for (int i = 0; i < NR; ++i) cgt += __popcll(__ballot(x[i] > Tx));
        int need = 256 - cgt; myw = 0ull;
#pragma unroll
        for (int i = 0; i < NR; ++i) {
            const u64 g = __ballot(x[i] > Tx); u64 e = __ballot(x[i] == Tx);
            int ne = __popcll(e);
            while (ne > need) { e &= ~(1ull << (63 - __clzll(e))); --ne; }
            need -= ne;
            if (lz == i) myw = g | e;
        }
    }
    return myw;
}

__device__ __forceinline__ void ph_ki(const Params& P, LAS unsigned char* lds) {
    const bf16_t* ZQ = (const bf16_t*)(P.ws + OFF_ZQ);
    const int tid = opaque_tid();
    { int* KPM = (int*)(P.ws + OFF_KPM);
      const int lane = tid & 63;
      for (int i = blockIdx.x * (NTHR / 64) + (tid >> 6); i < NB_ * 64; i += gridDim.x * (NTHR / 64)) {
          int mxp = P.pos[(i >> 6) * S_ + (i & 63) * 64 + lane];
#pragma unroll
          for (int o = 32; o >= 1; o >>= 1) { const int v = shxi(mxp, o, lane); mxp = v > mxp ? v : mxp; }
          if (lane == 0) KPM[i] = mxp; } }
    {
        bf16_t* KI = (bf16_t*)(P.ws + OFF_KI);
        for (int i = blockIdx.x * NTHR + tid; i < T_ * 8; i += gridDim.x * NTHR) {
            const int key = i >> 3, c = i & 7;
            const u32x4 v = *(const u32x4*)(ZQ + (size_t)key * 2304 + 2048 + 8 * c);
            *(u32x4*)(KI + ((size_t)((key >> 5) * 4 + (c >> 1)) * 64 + (key & 31) + 32 * (c & 1)) * 8) = v;
        }
    }
}

__device__ __forceinline__ void ph_idx(const Params& P, LAS unsigned char* lds) {
    LAS float* SC = (LAS float*)lds;
    const bf16_t* ZQ = (const bf16_t*)(P.ws + OFF_ZQ); u64* MASK = (u64*)(P.ws + OFF_MASK); const bf16_t* KI = (const bf16_t*)(P.ws + OFF_KI);
    const int tid = opaque_tid(), wid = __builtin_amdgcn_readfirstlane(tid >> 6), lane = tid & 63, m = lane & 31, hh = lane >> 5;
    int itc = 0;
    bf16x8 An[2][4]; u32x4 Wn[2][2];
    auto load_q = [&](const int idx2, const int itc2) {
        const int b2 = idx2 & 7, j2 = idx2 >> 3, qb2 = (itc2 & 1) ? (j2 ^ 31) : j2, t02 = qb2 * 8;
        const bf16_t* zb2 = ZQ + (size_t)b2 * S_ * 2304;
#pragma unroll
        for (int blk = 0; blk < 2; ++blk) {
            const bf16_t* qp = zb2 + (size_t)(t02 + 4 * blk + 2 * ((m >> 2) & 1) + (m >> 4)) * 2304 + 1536 + (4 * ((m >> 3) & 1) + (m & 3)) * 64 + 8 * hh;
#pragma unroll
            for (int ks = 0; ks < 4; ++ks) An[blk][ks] = *(const bf16x8*)(qp + 16 * ks);
#pragma unroll
            for (int q = 0; q < 2; ++q) Wn[blk][q] = *(const u32x4*)(zb2 + (size_t)(t02 + 4 * blk + 2 * hh + q) * 2304 + 2112);
        } };
    if ((int)blockIdx.x < NB_ * 512) load_q(blockIdx.x, 0);
    for (int idx = blockIdx.x; idx < NB_ * 512; idx += gridDim.x, ++itc) {
        const int b = idx & 7, j = idx >> 3; const int qb = (itc & 1) ? (j ^ 31) : j; const int t0 = qb * 8;
        const bf16_t* zb = ZQ + (size_t)b * S_ * 2304;
        bf16x8 Af[2][4]; float wv[2][16];
#pragma unroll
        for (int blk = 0; blk < 2; ++blk) {
#pragma unroll
            for (int ks = 0; ks < 4; ++ks) Af[blk][ks] = An[blk][ks];
#pragma unroll
            for (int q = 0; q < 2; ++q) { const u32x4 ww = Wn[blk][q];
                wv[blk][8 * q + 0] = bflo(ww.x); wv[blk][8 * q + 1] = bfhi(ww.x); wv[blk][8 * q + 2] = bflo(ww.y); wv[blk][8 * q + 3] = bfhi(ww.y);
                wv[blk][8 * q + 4] = bflo(ww.z); wv[blk][8 * q + 5] = bfhi(ww.z); wv[blk][8 * q + 6] = bflo(ww.w); wv[blk][8 * q + 7] = bfhi(ww.w); }
        }
        const int ntile = 2 * ((t0 + 7) / 64 + 1);
        {
#define IDX_GLD(B, KT) do { const int kc_ = (KT) < ntile ? (KT) : ntile - 1; const bf16_t* kp_ = KI + ((size_t)((b * 128 + kc_) * 4) * 64 + lane) * 8; \
            asm volatile("global_load_dwordx4 %0, %4, off\n\tglobal_load_dwordx4 %1, %4, off offset:1024\n\tglobal_load_dwordx4 %2, %4, off offset:2048\n\tglobal_load_dwordx4 %3, %4, off offset:3072" \
                : "=&v"(B[0]), "=&v"(B[1]), "=&v"(B[2]), "=&v"(B[3]) : "v"(kp_)); } while (0)
#define IDX_GLW(B, N) asm volatile("s_waitcnt vmcnt(" #N ")" : "+v"(B[0]), "+v"(B[1]), "+v"(B[2]), "+v"(B[3]))
            auto score_tile = [&](const bf16x8 (&Bf)[4], const int kt) {
                f32x16 Dw[2];
#pragma unroll
                for (int r = 0; r < 16; ++r) { Dw[0][r] = 0.f; Dw[1][r] = 0.f; }
#pragma unroll
                for (int ks = 0; ks < 4; ++ks) {
                    Dw[0] = __builtin_amdgcn_mfma_f32_32x32x16_bf16(Af[0][ks], Bf[ks], Dw[0], 0, 0, 0);
                    Dw[1] = __builtin_amdgcn_mfma_f32_32x32x16_bf16(Af[1][ks], Bf[ks], Dw[1], 0, 0, 0); }
#pragma unroll
                for (int blk = 0; blk < 2; ++blk) {
                    const f32x16 Dv = Dw[blk];
#pragma unroll
                    for (int q = 0; q < 2; ++q) {
                        float part = 0.f;
#pragma unroll
                        for (int e = 0; e < 8; ++e) { const float d = Dv[8 * q + e], w = wv[blk][8 * q + e]; part = __builtin_fmaf(w, d, part); part = __builtin_fmaf(w, __builtin_fabsf(d), part); }
                        SC[(4 * blk + 2 * hh + q) * 4096 + 32 * kt + m] = (32 * kt + m <= t0 + 4 * blk + 2 * hh + q) ? part : -__builtin_inff();
                    }
                } };
            bf16x8 B0[4], B1[4], B2[4];
            if (wid < ntile) {
                IDX_GLD(B0, wid); IDX_GLD(B1, wid + 8);
                asm volatile("" :: "v"(Af[0][0]), "v"(Af[0][1]), "v"(Af[0][2]), "v"(Af[0][3]), "v"(Af[1][0]), "v"(Af[1][1]), "v"(Af[1][2]), "v"(Af[1][3]));
#pragma unroll 1
                for (int kt = wid; kt < ntile; kt += 24) {
                    IDX_GLD(B2, kt + 16);
                    IDX_GLW(B0, 8);
                    score_tile(B0, kt);
                    IDX_GLD(B0, kt + 24);
                    IDX_GLW(B1, 8);
                    if (kt + 8 < ntile) score_tile(B1, kt + 8);
                    IDX_GLD(B1, kt + 32);
                    IDX_GLW(B2, 8);
                    if (kt + 16 < ntile) score_tile(B2, kt + 16);
                }
                asm volatile("s_waitcnt vmcnt(0)" : "+v"(B0[0]), "+v"(B0[1]), "+v"(B0[2]), "+v"(B0[3]), "+v"(B1[0]), "+v"(B1[1]), "+v"(B1[2]), "+v"(B1[3]), "+v"(B2[0]), "+v"(B2[1]), "+v"(B2[2]), "+v"(B2[3]));
            }
#undef IDX_GLD
#undef IDX_GLW
        }
        __syncthreads();
        if (idx + (int)gridDim.x < NB_ * 512) load_q(idx + (int)gridDim.x, itc + 1);
        {
            const int t = t0 + wid; u64* mrow = MASK + (size_t)(b * S_ + t) * 64;
            if (t < 256) {
                const int lo = 64 * lane; u64 w;
                if (t >= lo + 63) w = ~0ull; else if (t < lo) w = 0ull; else w = (2ull << (t - lo)) - 1ull;
                mrow[lane] = w;
            } else {
                int lz = threadIdx.x; asm volatile("" : "+v"(lz)); lz &= 63;
                LAS float* rowp = SC + wid * 4096; u64 myw;
                if (t < 512) myw = select_row<8>(rowp, t, lz); else if (t < 1024) myw = select_row<16>(rowp, t, lz); else if (t < 1536) myw = select_row<24>(rowp, t, lz); else if (t < 2048) myw = select_row<32>(rowp, t, lz);
                else if (t < 3072) myw = select_row<48>(rowp, t, lz); else myw = select_row<64>(rowp, t, lz);
                mrow[lz] = myw;
            }
        }
        __syncthreads();
    }
}

__device__ __forceinline__ int bitmask(int w, int pos  ) { int m; asm("v_bfe_i32 %0, %1, %2, 1" : "=v"(m) : "v"(w), "n"(pos)); return m; }
__device__ __forceinline__ void ph_att(const Params& P, LAS unsigned char* lds) {
    LAS float* TABL = (LAS float*)lds;
    LAS unsigned char* KB = lds + 4096;
    constexpr int KT_B = 64 * 144, VT_B = 64 * 144, BUF_B = KT_B + VT_B;
    constexpr float LOG2E = 1.4426950408889634f;
    const float* tabg = (const float*)(P.ws + OFF_TAB);
    const int tid = opaque_tid(), wid = __builtin_amdgcn_readfirstlane(tid >> 6), lane = tid & 63, m = lane & 31, hh = lane >> 5;
    for (int i = tid; i < 1024; i += NTHR) TABL[i] = (tabg[i] - tabg[127 * 8 + (i & 7)]) * LOG2E;
    LAS int* POSL = (LAS int*)(KB + 4 * BUF_B);
    int pos_b = -1;
    const bf16_t* ZQ = (const bf16_t*)(P.ws + OFF_ZQ); const u64* MASK = (const u64*)(P.ws + OFF_MASK);
    bf16_t* OA = (bf16_t*)(P.ws + OFF_OATT); const int* KPM = (const int*)(P.ws + OFF_KPM);
    int itc = 0;
    for (int idx = blockIdx.x; idx < NB_ * 8 * 16; idx += gridDim.x, ++itc) {
        int tid_i = tid; asm volatile("" : "+v"(tid_i));
        const int tid = tid_i, lane = tid & 63, m = lane & 31, hh = lane >> 5;
        const int b = idx & 7, head = (idx >> 3) & 7, j = idx >> 6; const int qb = (itc & 1) ? (j ^ 3) : j;
        const int q0 = qb * 256, tq0 = q0 + 32 * wid, t = tq0 + m;
        const bf16_t* zb = ZQ + (size_t)b * S_ * 2304;
        if (b != pos_b) {
            __syncthreads();
            for (int i = tid; i < S_ / 4; i += NTHR) ((LAS i32x4*)POSL)[i] = ((const i32x4*)(P.pos + b * S_))[i];
            pos_b = b;
            __syncthreads();
        }
        bf16x8 Qf[4];
        { const bf16_t* qp = zb + (size_t)t * 2304 + head * 64 + 8 * hh;
#pragma unroll
          for (int ks = 0; ks < 4; ++ks) { const u32x4 qw = *(const u32x4*)(qp + 16 * ks);
              const float cq = 0.125f * LOG2E; u32x4 qs;
              qs.x = cvt_pk_bf16(bflo(qw.x) * cq, bfhi(qw.x) * cq); qs.y = cvt_pk_bf16(bflo(qw.y) * cq, bfhi(qw.y) * cq);
              qs.z = cvt_pk_bf16(bflo(qw.z) * cq, bfhi(qw.z) * cq); qs.w = cvt_pk_bf16(bflo(qw.w) * cq, bfhi(qw.w) * cq);
              Qf[ks] = __builtin_bit_cast(bf16x8, qs); } }
        const int posq = POSL[t];
        int minq = posq;
#pragma unroll
        for (int o = 32; o >= 1; o >>= 1) { const int v = shxi(minq, o, lane); minq = v < minq ? v : minq; }
        minq = __builtin_amdgcn_readfirstlane(minq);
        const u64* mrow = MASK + (size_t)(b * S_ + t) * 64;
        const float c2 = tabg[127 * 8 + head] * LOG2E;
        f32x16 O0, O1; f32x2 L0, L1, L2, L3;
        const bf16x8 ones8 = {0x3F80, 0x3F80, 0x3F80, 0x3F80, 0x3F80, 0x3F80, 0x3F80, 0x3F80};
        f32x16 CM; bool tracked = false; float lsum = 0.f;
        const int nt = 4 * qb + 4, my_nt = ((tq0 + 31) >> 6) + 1;
        const int skey = tid >> 3, sch = tid & 7;
        const bf16_t* kg = zb + (size_t)skey * 2304 + 512 + head * 64 + 8 * sch;
        const bf16_t* vg = zb + (size_t)skey * 2304 + 1024 + head * 64 + 8 * sch;
        LAS unsigned char* kdst = KB + skey * 144 + sch * 16; LAS unsigned char* vdst = KB + KT_B + skey * 144 + sch * 16;
        const int kpm_l = KPM[b * 64 + lane];
        const unsigned trl = (unsigned)((4 * hh + ((lane & 15) >> 2)) * 144 + (2 * ((lane >> 4) & 1) + ((lane & 3) >> 1)) * 16 + 8 * (lane & 1));
        auto tile = [&](const int kt, const int boff, const u64 mw) {
                const LAS unsigned char* Kt = KB + boff; const LAS unsigned char* Vt = Kt + KT_B;
                f32x16 D0 = CM, D1 = CM;
#pragma unroll
                for (int ks = 0; ks < 4; ++ks) {
                    const bf16x8 K0 = *(const LAS bf16x8*)(Kt + m * 144 + 32 * ks + 16 * hh), K1 = *(const LAS bf16x8*)(Kt + (32 + m) * 144 + 32 * ks + 16 * hh);
                    D0 = __builtin_amdgcn_mfma_f32_32x32x16_bf16(K0, Qf[ks], D0, 0, 0, 0); D1 = __builtin_amdgcn_mfma_f32_32x32x16_bf16(K1, Qf[ks], D1, 0, 0, 0); }
                const int w0 = (int)((unsigned)mw >> (4 * hh)), w1 = (int)((unsigned)(mw >> 32) >> (4 * hh));
                if (minq - __builtin_amdgcn_readlane(kpm_l, kt) < 127) {
#pragma unroll
                    for (int mb = 0; mb < 2; ++mb)
#pragma unroll
                        for (int g = 0; g < 4; ++g) {
                            const i32x4 pk = *(const LAS i32x4*)(POSL + 64 * kt + 32 * mb + 8 * g + 4 * hh);
#pragma unroll
                            for (int e = 0; e < 4; ++e) { const int r = 4 * g + e; int n = posq - pk[e]; n = n < 0 ? 0 : (n > 127 ? 127 : n);
                                if (mb) D1[r] += TABL[n * 8 + head]; else D0[r] += TABL[n * 8 + head]; }
                        }
                }
                if (tracked) {
                    float mx = __builtin_fmaxf(__builtin_fmaxf(D0[0], D0[1]), D0[2]);
#pragma unroll
                    for (int r = 3; r < 15; r += 2) mx = __builtin_fmaxf(__builtin_fmaxf(mx, D0[r]), D0[r + 1]);
#pragma unroll
                    for (int r = 0; r < 16; r += 2) mx = __builtin_fmaxf(__builtin_fmaxf(mx, D1[r]), D1[r + 1]);
                    mx = fmaxf(mx, D0[15]);
                    mx = fmaxf(mx, shx(mx, 32, lane));
                    if (__any(mx > 8.0f) || kt == 0) {
                        const float sh = kt == 0 ? mx : fmaxf(mx, 0.f), alpha = __builtin_amdgcn_exp2f(-sh);
                        const float cm = CM[0] - sh;
#pragma unroll
                        for (int r = 0; r < 16; ++r) { D0[r] -= sh; D1[r] -= sh; CM[r] = cm; O0[r] *= alpha; O1[r] *= alpha; }
                        L0 *= alpha; L1 *= alpha; L2 *= alpha; L3 *= alpha;
                    }
                }
                float pv[32];
#pragma unroll
                for (int r = 0; r < 16; ++r) {
                    const int bp = (r & 3) + 8 * (r >> 2);
                    pv[r] = __int_as_float(__float_as_int(__builtin_amdgcn_exp2f(D0[r])) & bitmask(w0, bp));
                    pv[16 + r] = __int_as_float(__float_as_int(__builtin_amdgcn_exp2f(D1[r])) & bitmask(w1, bp)); }
                const unsigned va_ = (unsigned)(uintptr_t)Vt + trl;
#define ATT_TR4(V_, S_) asm volatile("ds_read_b64_tr_b16 %0, %4 offset:%5\n\tds_read_b64_tr_b16 %1, %4 offset:%6\n\tds_read_b64_tr_b16 %2, %4 offset:%7\n\tds_read_b64_tr_b16 %3, %4 offset:%8" \
                    : "=&v"(V_[0][0]), "=&v"(V_[0][1]), "=&v"(V_[1][0]), "=&v"(V_[1][1]) : "v"(va_), "i"(2304 * (S_)), "i"(2304 * (S_) + 1152), "i"(2304 * (S_) + 64), "i"(2304 * (S_) + 1152 + 64))
#define ATT_TRW(VA_, VB_) asm volatile("s_waitcnt lgkmcnt(0)" : "+v"(VA_[0][0]), "+v"(VA_[0][1]), "+v"(VA_[1][0]), "+v"(VA_[1][1]), "+v"(VB_[0][0]), "+v"(VB_[0][1]), "+v"(VB_[1][0]), "+v"(VB_[1][1]))
#define ATT_PV(V_, S_) do { u32x4 pw; pw.x = cvt_pk_bf16(pv[8 * (S_) + 0], pv[8 * (S_) + 1]); pw.y = cvt_pk_bf16(pv[8 * (S_) + 2], pv[8 * (S_) + 3]); pw.z = cvt_pk_bf16(pv[8 * (S_) + 4], pv[8 * (S_) + 5]); pw.w = cvt_pk_bf16(pv[8 * (S_) + 6], pv[8 * (S_) + 7]); \
                    const bf16x8 Pf = __builtin_bit_cast(bf16x8, pw); \
                    { u32x4 vw; vw.x = V_[0][0].x; vw.y = V_[0][0].y; vw.z = V_[0][1].x; vw.w = V_[0][1].y; O0 = __builtin_amdgcn_mfma_f32_32x32x16_bf16(__builtin_bit_cast(bf16x8, vw), Pf, O0, 0, 0, 0); } \
                    { u32x4 vw; vw.x = V_[1][0].x; vw.y = V_[1][0].y; vw.z = V_[1][1].x; vw.w = V_[1][1].y; O1 = __builtin_amdgcn_mfma_f32_32x32x16_bf16(__builtin_bit_cast(bf16x8, vw), Pf, O1, 0, 0, 0); } \
                    L0 += (f32x2){pv[8 * (S_) + 0], pv[8 * (S_) + 1]}; L1 += (f32x2){pv[8 * (S_) + 2], pv[8 * (S_) + 3]}; L2 += (f32x2){pv[8 * (S_) + 4], pv[8 * (S_) + 5]}; L3 += (f32x2){pv[8 * (S_) + 6], pv[8 * (S_) + 7]};   } while (0)
                {
                    u32x2 V0[2][2], V1[2][2];
                    ATT_TR4(V0, 0); ATT_TR4(V1, 1); ATT_TRW(V0, V1);
                    ATT_PV(V0, 0); ATT_PV(V1, 1);
                    u32x2 V2[2][2], V3[2][2];
                    ATT_TR4(V2, 2); ATT_TR4(V3, 3); ATT_TRW(V2, V3);
                    ATT_PV(V2, 2); ATT_PV(V3, 3);
                }
#undef ATT_TR4
#undef ATT_TRW
#undef ATT_PV
        };
        for (;;) {
#pragma unroll
        for (int r = 0; r < 16; ++r) { O0[r] = 0.f; O1[r] = 0.f; CM[r] = c2; }
        L0 = (f32x2){0.f, 0.f}; L1 = L0; L2 = L0; L3 = L0;
        __syncthreads();
        constexpr int SUB_B = KT_B + VT_B, SUP_B = 2 * SUB_B;
        const int nst = nt >> 1;
        u32x4 ka0, kb0, va0, vb0, ka1, kb1, va1, vb1;
#define ATT_LOAD(KA, KB_, VA, VB, ST) do { KA = *(const u32x4*)(kg + (size_t)(2 * (ST)) * 64 * 2304); KB_ = *(const u32x4*)(kg + (size_t)(2 * (ST) + 1) * 64 * 2304); \
            VA = *(const u32x4*)(vg + (size_t)(2 * (ST)) * 64 * 2304); VB = *(const u32x4*)(vg + (size_t)(2 * (ST) + 1) * 64 * 2304); } while (0)
#define ATT_STORE(KA, KB_, VA, VB, BUF) do { LAS unsigned char* kd_ = kdst + (BUF) * SUP_B; LAS unsigned char* vd_ = vdst + (BUF) * SUP_B; \
            *(LAS u32x4*)kd_ = KA; *(LAS u32x4*)vd_ = VA; *(LAS u32x4*)(kd_ + SUB_B) = KB_; *(LAS u32x4*)(vd_ + SUB_B) = VB; } while (0)
        u64x2 mwA = *(const u64x2*)mrow, mwB = mwA;
        ATT_LOAD(ka0, kb0, va0, vb0, 0); ATT_STORE(ka0, kb0, va0, vb0, 0);
        if (nst > 1) ATT_LOAD(ka1, kb1, va1, vb1, 1);
        __syncthreads();
        for (int st = 0; st < nst; st += 2) {
            if (st + 1 < nst) mwB = *(const u64x2*)(mrow + 2 * (st + 1));
            if (st + 2 < nst) ATT_LOAD(ka0, kb0, va0, vb0, st + 2);
            if (2 * st < my_nt) tile(2 * st, 0, mwA.x);
            if (2 * st + 1 < my_nt) tile(2 * st + 1, SUB_B, mwA.y);
            if (st + 1 < nst) ATT_STORE(ka1, kb1, va1, vb1, 1);
            __syncthreads();
            if (st + 1 >= nst) break;
            if (st + 2 < nst) mwA = *(const u64x2*)(mrow + 2 * (st + 2));
            if (st + 3 < nst) ATT_LOAD(ka1, kb1, va1, vb1, st + 3);
            if (2 * st + 2 < my_nt) tile(2 * st + 2, SUP_B, mwB.x);
            if (2 * st + 3 < my_nt) tile(2 * st + 3, SUP_B + SUB_B, mwB.y);
            if (st + 2 < nst) ATT_STORE(ka0, kb0, va0, vb0, 0);
            __syncthreads();
        }
        { const f32x2 ls = (L0 + L1) + (L2 + L3); float l = ls.x + ls.y; l += shx(l, 32, lane); lsum = l; const bool bad = !(l > 1e-30f && l < 1e30f);
          if (tracked || !__syncthreads_or(bad ? 1 : 0)) break;
          tracked = true; }
        }
#undef ATT_LOAD
#undef ATT_STORE
        const float inv = __builtin_amdgcn_rcpf(lsum);
        bf16_t* op = OA + (size_t)(b * S_ + t) * 512 + head * 64 + 4 * hh;
#pragma unroll
        for (int g = 0; g < 4; ++g) {
            u32x2 wa; wa.x = cvt_pk_bf16(O0[4 * g] * inv, O0[4 * g + 1] * inv); wa.y = cvt_pk_bf16(O0[4 * g + 2] * inv, O0[4 * g + 3] * inv);
            *(u32x2*)(op + 8 * g) = wa;
            u32x2 wb; wb.x = cvt_pk_bf16(O1[4 * g] * inv, O1[4 * g + 1] * inv); wb.y = cvt_pk_bf16(O1[4 * g + 2] * inv, O1[4 * g + 3] * inv);
            *(u32x2*)(op + 32 + 8 * g) = wb;
        }
    }
}

#define DSR4(A, addr, o0, o1, o2, o3) asm volatile("ds_read_b128 %0, %4 offset:%5\n\tds_read_b128 %1, %4 offset:%6\n\tds_read_b128 %2, %4 offset:%7\n\tds_read_b128 %3, %4 offset:%8" \
    : "=&v"(A[0]), "=&v"(A[1]), "=&v"(A[2]), "=&v"(A[3]) : "v"(addr), "i"(o0), "i"(o1), "i"(o2), "i"(o3))
#define DSW(A, N) asm volatile("s_waitcnt lgkmcnt(" #N ")" : "+v"(A[0]), "+v"(A[1]), "+v"(A[2]), "+v"(A[3]))
#define DSRV(V, addr, off) asm volatile("ds_read_b32 %0, %1 offset:%2" : "=&v"(V) : "v"(addr), "i"(off))
#define DSWV(A, V, N) asm volatile("s_waitcnt lgkmcnt(" #N ")" : "+v"(A[0]), "+v"(A[1]), "+v"(A[2]), "+v"(A[3]), "+v"(V))
#define SCAN_A(X, G) _Pragma("unroll") for (int i_ = 0; i_ < 4; ++i_) { const f32x2 k01 = {X[i_][0], X[i_][1]}, k23 = {X[i_][2], X[i_][3]}; \
    if (i_ & 1) { sa2 += S2[8 * G + 2 * i_] * k01; sa3 += S2[8 * G + 2 * i_ + 1] * k23; sp2 += Pm2[8 * G + 2 * i_] * k01; sp3 += Pm2[8 * G + 2 * i_ + 1] * k23; } \
    else { sa0 += S2[8 * G + 2 * i_] * k01; sa1 += S2[8 * G + 2 * i_ + 1] * k23; sp0 += Pm2[8 * G + 2 * i_] * k01; sp1 += Pm2[8 * G + 2 * i_ + 1] * k23; } }
#define SCAN_B(X, C) { const int j = 2 * C; \
    const f32x2 w0_ = {X[0][0], X[0][1]}, kb0_ = {X[1][0], X[1][1]}, kk0_ = {X[2][0], X[2][1]}, rr0_ = {X[3][0], X[3][1]}; \
    const f32x2 w1_ = {X[0][2], X[0][3]}, kb1_ = {X[1][2], X[1][3]}, kk1_ = {X[2][2], X[2][3]}, rr1_ = {X[3][2], X[3][3]}; \
      \
    f32x2 tS0_ = sav * kb0_, tS1_ = sav * kb1_, tP0_ = spv * kb0_, tP1_ = spv * kb1_; \
    tS0_ = vv2 * kk0_ + tS0_; tS1_ = vv2 * kk1_ + tS1_; \
    Pm2[j] = Pm2[j] * w0_ + tP0_; Pm2[j + 1] = Pm2[j + 1] * w1_ + tP1_; \
    S2[j] = S2[j] * w0_ + tS0_; S2[j + 1] = S2[j + 1] * w1_ + tS1_; \
    p0 += Pm2[j] * rr0_; p1 += Pm2[j + 1] * rr1_; \
    y0 += S2[j] * rr0_; y1 += S2[j + 1] * rr1_; }
__device__ __forceinline__ float wave_sum_dpp(float v) {
    v += __int_as_float(__builtin_amdgcn_update_dpp(0, __float_as_int(v), 0x111, 0xf, 0xf, true));
    v += __int_as_float(__builtin_amdgcn_update_dpp(0, __float_as_int(v), 0x112, 0xf, 0xf, true));
    v += __int_as_float(__builtin_amdgcn_update_dpp(0, __float_as_int(v), 0x114, 0xf, 0xf, true));
    v += __int_as_float(__builtin_amdgcn_update_dpp(0, __float_as_int(v), 0x118, 0xf, 0xf, true));
    v += __int_as_float(__builtin_amdgcn_update_dpp(0, __float_as_int(v), 0x142, 0xa, 0xf, false));
    v += __int_as_float(__builtin_amdgcn_update_dpp(0, __float_as_int(v), 0x143, 0xc, 0xf, false));
    return __int_as_float(__builtin_amdgcn_readlane(__float_as_int(v), 63));
}
__device__ __forceinline__ void wave_sum2_dpp(float a, float b, float& ra, float& rb) {
    const auto sw = __builtin_amdgcn_permlane32_swap(__float_as_uint(a), __float_as_uint(b), false, false);
    float v = __uint_as_float(sw[0]) + __uint_as_float(sw[1]);
    v += __int_as_float(__builtin_amdgcn_update_dpp(0, __float_as_int(v), 0x111, 0xf, 0xf, true));
    v += __int_as_float(__builtin_amdgcn_update_dpp(0, __float_as_int(v), 0x112, 0xf, 0xf, true));
    v += __int_as_float(__builtin_amdgcn_update_dpp(0, __float_as_int(v), 0x114, 0xf, 0xf, true));
    v += __int_as_float(__builtin_amdgcn_update_dpp(0, __float_as_int(v), 0x118, 0xf, 0xf, true));
    v += __int_as_float(__builtin_amdgcn_update_dpp(0, __float_as_int(v), 0x142, 0xa, 0xf, false));
    ra = __int_as_float(__builtin_amdgcn_readlane(__float_as_int(v), 31)); rb = __int_as_float(__builtin_amdgcn_readlane(__float_as_int(v), 63));
}
__device__ __forceinline__ void ph_scan(const Params& P, int l, LAS unsigned char* lds) {
    LAS bf16_t* LI = (LAS bf16_t*)lds;
    LAS float* SIN = (LAS float*)(lds + 32768);
    const bf16_t* ZR = (const bf16_t*)(P.ws + OFF_ZR);
    const float* mu = P.mu + (size_t)l * 1792;
    const bf16_t* LW = (const bf16_t*)(P.ws + OFF_WB + WB_LW); const bf16_t* LA = (const bf16_t*)(P.ws + OFF_WB + WB_LA); const bf16_t* LG = (const bf16_t*)(P.ws + OFF_WB + WB_LG);
    bf16_t* Yo = (bf16_t*)(P.ws + OFF_Y); bf16_t* Po = (bf16_t*)(P.ws + OFF_P); bf16_t* Go = (bf16_t*)(P.ws + OFF_G); bf16_t* VBo = (bf16_t*)(P.ws + OFF_VB);
    float* SEGp = (float*)(P.ws + OFF_SEG);
    const int tid = opaque_tid(), wid = __builtin_amdgcn_readfirstlane(tid >> 6), lane = tid & 63;
    for (int blk = blockIdx.x; blk < NB_ * NSEG; blk += gridDim.x) {
        const int b = blk / NSEG, seg = blk % NSEG, tbeg = seg * SEGL;
        f32x2 S2[32], Pm2[32];
        { int lq = threadIdx.x; asm volatile("" : "+v"(lq)); lq &= 63;
#pragma unroll
          for (int j = 0; j < 32; ++j) { S2[j] = (f32x2){0.f, 0.f}; Pm2[j] = (f32x2){(2 * j == lq) ? 1.f : 0.f, (2 * j + 1 == lq) ? 1.f : 0.f}; } }
        for (int half = 0; half < 2; ++half) {
            __syncthreads();
            {
                int tq = threadIdx.x; asm volatile("" : "+v"(tq));
                u32x4 zc4[4], zp4[4];
#pragma unroll
                for (int rnd = 0; rnd < 4; ++rnd) {
                    const int q = tq + NTHR * rnd, tok = q >> 5, c8 = (q & 31) * 8, t = tbeg + 64 * half + tok; const size_t row = (size_t)b * S_ + t;
                    zc4[rnd] = *(const u32x4*)(ZR + row * 1792 + 1536 + c8);
                    zp4[rnd] = (u32x4){0u, 0u, 0u, 0u}; if (t > 0) zp4[rnd] = *(const u32x4*)(ZR + (row - 1) * 1792 + 1536 + c8);
                }
                const int c8 = (tq & 31) * 8;
                const f32x4 ma = *(const f32x4*)(mu + 1536 + c8), mb = *(const f32x4*)(mu + 1536 + c8 + 4);
#pragma unroll
                for (int rnd = 0; rnd < 4; ++rnd) {
                    const int q = tq + NTHR * rnd, tok = q >> 5;
                    const u32x4 zc = zc4[rnd], zp = zp4[rnd];
                    const unsigned cw[4] = {zc.x, zc.y, zc.z, zc.w}, pw[4] = {zp.x, zp.y, zp.z, zp.w};
                    float x[8];
#pragma unroll
                    for (int q2 = 0; q2 < 4; ++q2) { const float c0 = bflo(cw[q2]), c1 = bfhi(cw[q2]), p0 = bflo(pw[q2]), p1 = bfhi(pw[q2]);
                        const float m0 = q2 < 2 ? ma[2 * q2] : mb[2 * q2 - 4], m1 = q2 < 2 ? ma[2 * q2 + 1] : mb[2 * q2 - 3];
                        x[2 * q2] = c0 + (p0 - c0) * m0; x[2 * q2 + 1] = c1 + (p1 - c1) * m1; }
#pragma unroll
                    for (int e = 0; e < 8; ++e) { if (c8 < 64) x[e] = 1.0f - 2.0f * __builtin_amdgcn_rcpf(1.0f + __expf(2.0f * x[e])); else if (c8 >= 128) x[e] = sigmoidf_(x[e]); }
                    u32x4 w; w.x = cvt_pk_bf16(x[0], x[1]); w.y = cvt_pk_bf16(x[2], x[3]); w.z = cvt_pk_bf16(x[4], x[5]); w.w = cvt_pk_bf16(x[6], x[7]);
                    *(LAS u32x4*)(LI + tok * 256 + c8) = w;
                }
            }
            __syncthreads();
            float* los = (float*)(P.ws + OFF_SCR) + (size_t)(blk * 8 + wid) * (64 * 2 * 64);
            {
                int tq = threadIdx.x; asm volatile("" : "+v"(tq));
                const int lq = tq & 63, fr = lq & 15, kq = lq >> 4;
#pragma unroll 1
                for (int pass = 0; pass < 8; ++pass) {
                    const int kind = pass < 2 ? 0 : (pass < 4 ? 1 : 2), Kk = kind == 2 ? 128 : 64, aoff = kind * 64, nb0 = kind == 2 ? pass - 4 : 2 * (pass & 1);
                    const bf16_t* Wt = kind == 0 ? LW : (kind == 1 ? LA : LG);
                    bf16x8 Bf[4];
#pragma unroll
                    for (int q = 0; q < 4; ++q) { const int nb = kind == 2 ? nb0 : nb0 + (q >> 1), ks = kind == 2 ? q : (q & 1);
                        Bf[q] = *(const bf16x8*)(Wt + (size_t)(64 * wid + 16 * nb + fr) * Kk + 32 * ks + 8 * kq); }
#pragma unroll 2
                    for (int tt = 0; tt < 4; ++tt) {
                        f32x4 acc[2];
                        acc[0] = (f32x4){0.f, 0.f, 0.f, 0.f}; acc[1] = acc[0];
#pragma unroll
                        for (int q = 0; q < 4; ++q) { const int ai = kind == 2 ? 0 : (q >> 1), ks = kind == 2 ? q : (q & 1);
                            const bf16x8 Afr = *(const LAS bf16x8*)(LI + (16 * tt + fr) * 256 + aoff + 32 * ks + 8 * kq);
                            acc[ai] = __builtin_amdgcn_mfma_f32_16x16x32_bf16(Afr, Bf[q], acc[ai], 0, 0, 0); }
                        if (kind == 2) {
#pragma unroll
                            for (int r = 0; r < 4; ++r) Go[((size_t)b * S_ + tbeg + 64 * half + 16 * tt + 4 * kq + r) * 512 + 64 * wid + 16 * nb0 + fr] = f2bf(acc[0][r]);
                        } else {
#pragma unroll
                            for (int ai = 0; ai < 2; ++ai)
#pragma unroll
                                for (int r = 0; r < 4; ++r) los[((16 * tt + 4 * kq + r) * 2 + kind) * 64 + 16 * (nb0 + ai) + fr] = acc[ai][r];
                        }
                    }
                }
            }
            asm volatile("s_waitcnt vmcnt(0)" ::: "memory");
            for (int sb = 0; sb < 64 / TB; ++sb) {
                const int ts = tbeg + 64 * half + sb * TB;
                int tz = threadIdx.x; asm volatile("" : "+v"(tz));
                const int lz = tz & 63;
                LAS float* sw = SIN + (size_t)wid * (TB * 6 * 64);
                {
                    const int c = 64 * wid + lz; const size_t row0 = (size_t)b * S_ + ts;
                    const float mur = mu[c], muk = mu[512 + c], muv = mu[1024 + c];
                    const float pw0 = P.w0[l * 512 + c], pa0 = P.a0[l * 512 + c], pkk = P.k_k[l * 512 + c], pka = P.k_a[l * 512 + c], prk = P.r_k[l * 512 + c];
                    const float* lo = los + (size_t)(sb * TB) * 128 + lz;
                    float zr_[TB + 1], zk_[TB + 1], zv_[TB + 1], wl_[TB], al_[TB];
                    zr_[0] = 0.f; zk_[0] = 0.f; zv_[0] = 0.f;
                    if (ts > 0) { zr_[0] = bf2f(ZR[(row0 - 1) * 1792 + c]); zk_[0] = bf2f(ZR[(row0 - 1) * 1792 + 512 + c]); zv_[0] = bf2f(ZR[(row0 - 1) * 1792 + 1024 + c]); }
#pragma unroll
                    for (int tk = 0; tk < TB; ++tk) {
                        zr_[tk + 1] = bf2f(ZR[(row0 + tk) * 1792 + c]); zk_[tk + 1] = bf2f(ZR[(row0 + tk) * 1792 + 512 + c]); zv_[tk + 1] = bf2f(ZR[(row0 + tk) * 1792 + 1024 + c]);
                        wl_[tk] = lo[tk * 128]; al_[tk] = lo[tk * 128 + 64]; }
#pragma unroll
                    for (int tk = 0; tk < TB; ++tk) {
                        const size_t row = row0 + tk; LAS float* st = sw + tk * 6 * 64;
                        const float cr = zr_[tk + 1], ck = zk_[tk + 1], cv = zv_[tk + 1], wl = wl_[tk], al = al_[tk];
                        const float rr = cr + (zr_[tk] - cr) * mur, kv = ck + (zk_[tk] - ck) * muk, vv = cv + (zv_[tk] - cv) * muv;
                        const float dc = __builtin_amdgcn_exp2f(-0.87503877f * __builtin_amdgcn_rcpf(1.0f + __builtin_amdgcn_exp2f(-1.44269504f * (pw0 + wl))));
                        const float av = sigmoidf_(pa0 + al);
                        const float kkv = kv * pkk;
                        const float km = kv * (1.0f + (av - 1.0f) * pka);
                        float ss, bon; wave_sum2_dpp(kkv * kkv, rr * km * prk, ss, bon);
                        const float kkn = kkv * __builtin_amdgcn_rsqf(fmaxf(ss, 1e-24f));
                        st[lz] = rr; st[64 + lz] = dc; st[2 * 64 + lz] = km; st[3 * 64 + lz] = -kkn; st[4 * 64 + lz] = kkn * av; st[5 * 64 + lz] = vv;
                        VBo[row * 512 + c] = f2bf(bon * vv);
                    }
                }
                {
                const unsigned sq0 = (unsigned)(uintptr_t)sw, va0 = sq0 + 4u * (unsigned)lz;
                f32x4 X0[4], X1[4], X2[4]; float vin;
                DSRV(vin, va0, 1280);
                DSR4(X2, sq0, 896, 912, 928, 944);
                DSR4(X0, sq0, 768, 784, 800, 816);
                DSR4(X1, sq0, 832, 848, 864, 880);
#pragma unroll 1
                for (int tk = 0; tk < TB; ++tk) {
                    f32x2 sa0 = {0.f, 0.f}, sa1 = {0.f, 0.f}, sp0 = {0.f, 0.f}, sp1 = {0.f, 0.f}, sa2 = sa0, sa3 = sa0, sp2 = sa0, sp3 = sa0;
                    f32x2 y0 = {0.f, 0.f}, y1 = {0.f, 0.f}, p0 = {0.f, 0.f}, p1 = {0.f, 0.f};
                    f32x2 sav, spv;
                    const unsigned sqa = sq0 + 1536u * (unsigned)tk, vna = va0 + 1536u * (unsigned)tk;
                    DSWV(X0, vin, 4);
                    const f32x2 vv2 = {vin, vin};
                    SCAN_A(X0, 0);
                    DSR4(X0, sqa, 960, 976, 992, 1008);
                    DSW(X1, 4);
                    SCAN_A(X1, 1);
                    DSR4(X1, sqa, 256, 1024, 512, 0);
                    DSW(X2, 8);
                    SCAN_A(X2, 2);
                    DSR4(X2, sqa, 272, 1040, 528, 16);
                    DSW(X0, 8);
                    SCAN_A(X0, 3);
                    { const f32x2 ta = (sa0 + sa1) + (sa2 + sa3), tp = (sp0 + sp1) + (sp2 + sp3); const float sa = ta.x + ta.y, sp = tp.x + tp.y; sav = (f32x2){sa, sa}; spv = (f32x2){sp, sp}; }
                    DSR4(X0, sqa, 288, 1056, 544, 32);
                    DSW(X1, 8);
                    SCAN_B(X1, 0);
                    DSR4(X1, sqa, 304, 1072, 560, 48);
                    DSW(X2, 8);
                    SCAN_B(X2, 1);
                    DSR4(X2, sqa, 320, 1088, 576, 64);
                    DSW(X0, 8);
                    SCAN_B(X0, 2);
                    DSR4(X0, sqa, 336, 1104, 592, 80);
                    DSW(X1, 8);
                    SCAN_B(X1, 3);
                    DSR4(X1, sqa, 352, 1120, 608, 96);
                    DSW(X2, 8);
                    SCAN_B(X2, 4);
                    DSR4(X2, sqa, 368, 1136, 624, 112);
                    DSW(X0, 8);
                    SCAN_B(X0, 5);
                    DSR4(X0, sqa, 384, 1152, 640, 128);
                    DSW(X1, 8);
                    SCAN_B(X1, 6);
                    DSR4(X1, sqa, 400, 1168, 656, 144);
                    DSW(X2, 8);
                    SCAN_B(X2, 7);
                    DSR4(X2, sqa, 416, 1184, 672, 160);
                    DSW(X0, 8);
                    SCAN_B(X0, 8);
                    DSR4(X0, sqa, 432, 1200, 688, 176);
                    DSW(X1, 8);
                    SCAN_B(X1, 9);
                    DSR4(X1, sqa, 448, 1216, 704, 192);
                    DSW(X2, 8);
                    SCAN_B(X2, 10);
                    DSR4(X2, sqa, 464, 1232, 720, 208);
                    DSW(X0, 8);
                    SCAN_B(X0, 11);
                    DSR4(X0, sqa, 480, 1248, 736, 224);
                    DSW(X1, 8);
                    SCAN_B(X1, 12);
                    DSR4(X1, sqa, 496, 1264, 752, 240);
                    DSW(X2, 8);
                    SCAN_B(X2, 13);
                    {
                        const unsigned nx = (tk + 1 < TB) ? 1536u : 0u, sqn = sqa + nx, vnn = vna + nx;
                        DSRV(vin, vnn, 1280);
                        DSR4(X2, sqn, 896, 912, 928, 944);
                        DSW(X0, 9);
                        SCAN_B(X0, 14);
                        DSR4(X0, sqn, 768, 784, 800, 816);
                        DSW(X1, 9);
                        SCAN_B(X1, 15);
                        DSR4(X1, sqn, 832, 848, 864, 880);
                    }
                    const size_t row = (size_t)b * S_ + ts + tk;
                    Yo[row * 512 + 64 * wid + lz] = f2bf((y0.x + y0.y) + (y1.x + y1.y));
                    Po[row * 512 + 64 * wid + lz] = f2bf((p0.x + p0.y) + (p1.x + p1.y));
                }
                asm volatile("s_waitcnt lgkmcnt(0)" : "+v"(X0[0]), "+v"(X0[1]), "+v"(X0[2]), "+v"(X0[3]), "+v"(X1[0]), "+v"(X1[1]), "+v"(X1[2]), "+v"(X1[3]),
                             "+v"(X2[0]), "+v"(X2[1]), "+v"(X2[2]), "+v"(X2[3]), "+v"(vin));
                }
            }
        }
        {
            int lq = threadIdx.x; asm volatile("" : "+v"(lq)); lq &= 63;
            float* sg = SEGp + ((size_t)((b * 8 + wid) * NSEG + seg)) * 8192 + lq * 64;
#pragma unroll
            for (int j = 0; j < 32; j += 2) { *(f32x4*)(sg + 2 * j) = (f32x4){Pm2[j].x, Pm2[j].y, Pm2[j + 1].x, Pm2[j + 1].y};
                *(f32x4*)(sg + 4096 + 2 * j) = (f32x4){S2[j].x, S2[j].y, S2[j + 1].x, S2[j + 1].y}; }
        }
    }
}

__device__ __forceinline__ void ph_comb(const Params& P, LAS unsigned char* lds) {
    LAS float* SI = (LAS float*)lds;
    LAS float* PB = (LAS float*)(lds + 8192);
    constexpr int SIS = 66, PBS = 80, PBB = 64 * PBS;
    float* SEGp = (float*)(P.ws + OFF_SEG);
    const int tid = opaque_tid(), wid = __builtin_amdgcn_readfirstlane(tid >> 6), lane = tid & 63, fr = lane & 15, kq = lane >> 4;
    const int prow = (tid * 8) >> 6, pcol = (tid * 8) & 63;
    for (int item = blockIdx.x; item < 64 * 4; item += gridDim.x) {
        const int chain = item >> 2, rq = item & 3;
        float* base = SEGp + (size_t)chain * NSEG * 8192;
        const float* pmp = base + tid * 8;
        float* qp = base + 4096 + (16 * rq + 4 * kq) * 64 + 16 * (wid & 3) + fr;
        __syncthreads();
        for (int i = tid; i < 1024; i += NTHR) SI[(i >> 6) * SIS + (i & 63)] = base[4096 + (16 * rq + (i >> 6)) * 64 + (i & 63)];
        f32x4 pa[3], pc[3]; float qv[3][4];
#define COMB_LDP(S_, K_) do { pa[S_] = *(const f32x4*)(pmp + (size_t)(K_) * 8192); pc[S_] = *(const f32x4*)(pmp + (size_t)(K_) * 8192 + 4); } while (0)
#define COMB_LDQ(S_, K_) do { _Pragma("unroll") for (int r = 0; r < 4; ++r) qv[S_][r] = qp[(size_t)(K_) * 8192 + r * 64]; } while (0)
#define COMB_STP(S_, K_) do { LAS float* pd = PB + ((K_) & 1) * PBB + prow * PBS + pcol; *(LAS f32x4*)pd = pa[S_]; *(LAS f32x4*)(pd + 4) = pc[S_]; } while (0)
        COMB_LDP(1, 1); COMB_LDP(2, 2); COMB_LDP(0, 3);
        COMB_LDQ(1, 1); COMB_LDQ(2, 2); COMB_LDQ(0, 3);
        COMB_STP(1, 1);
        __syncthreads();
#pragma unroll 1
        for (int k0 = 1; k0 <= NSEG - 2; k0 += 3) {
#pragma unroll
            for (int u = 0; u < 3; ++u) {
                const int k = k0 + u;
                const int s0 = (1 + u) % 3, s1 = (2 + u) % 3;
                if (k + 3 <= NSEG - 2) COMB_LDP(s0, k + 3);
                const LAS float* Pb = PB + (k & 1) * PBB;
                f32x4 Dv = {0.f, 0.f, 0.f, 0.f};
                if (wid < 4) {
#pragma unroll
                    for (int kk = 0; kk < 16; ++kk) { const float a = SI[fr * SIS + 4 * kk + kq], bq = Pb[(4 * kk + kq) * PBS + 16 * wid + fr];
                        Dv = __builtin_amdgcn_mfma_f32_16x16x4f32(a, bq, Dv, 0, 0, 0); }
#pragma unroll
                    for (int r = 0; r < 4; ++r) Dv[r] += qv[s0][r];
                    if (k + 3 <= NSEG - 2) COMB_LDQ(s0, k + 3);
                }
                __syncthreads();
                if (wid < 4) {
#pragma unroll
                    for (int r = 0; r < 4; ++r) { SI[(4 * kq + r) * SIS + 16 * wid + fr] = Dv[r]; qp[(size_t)k * 8192 + r * 64] = Dv[r]; }
                }
                if (k + 1 <= NSEG - 2) COMB_STP(s1, k + 1);
                __syncthreads();
            }
        }
#undef COMB_LDP
#undef COMB_LDQ
#undef COMB_STP
    }
}

__device__ __forceinline__ void ph_post(const Params& P, int l) {
    const bf16_t* Yo = (const bf16_t*)(P.ws + OFF_Y); const bf16_t* Po = (const bf16_t*)(P.ws + OFF_P); const bf16_t* Go = (const bf16_t*)(P.ws + OFF_G);
    const bf16_t* VBo = (const bf16_t*)(P.ws + OFF_VB); const float* SEGp = (const float*)(P.ws + OFF_SEG); bf16_t* OR = (bf16_t*)(P.ws + OFF_ORWKV);
    const int tid = opaque_tid(), wid = __builtin_amdgcn_readfirstlane(tid >> 6), lane = tid & 63, m = lane & 31, hh = lane >> 5;
    for (int blk = blockIdx.x; blk < NB_ * NSEG; blk += gridDim.x) {
        const int b = blk / NSEG, seg = blk % NSEG, tbeg = seg * SEGL;
        bf16x8 SIf[2][4];
        if (seg > 0) {
            const float* sg = SEGp + ((size_t)((b * 8 + wid) * NSEG + seg - 1)) * 8192 + 4096;
#pragma unroll
            for (int ib = 0; ib < 2; ++ib)
#pragma unroll
                for (int ks = 0; ks < 4; ++ks) { const float* sp = sg + (32 * ib + m) * 64 + 16 * ks + 8 * hh; const f32x4 a = *(const f32x4*)sp, c = *(const f32x4*)(sp + 4);
                    u32x4 w; w.x = cvt_pk_bf16(a[0], a[1]); w.y = cvt_pk_bf16(a[2], a[3]); w.z = cvt_pk_bf16(c[0], c[1]); w.w = cvt_pk_bf16(c[2], c[3]); SIf[ib][ks] = __builtin_bit_cast(bf16x8, w); }
        }
        float lnw[32], lnb[32];
#pragma unroll
        for (int q = 0; q < 32; ++q) { const int ch = 64 * wid + 32 * (q >> 4) + (q & 3) + 8 * ((q & 15) >> 2) + 4 * hh; lnw[q] = P.ln_w[l * 512 + ch]; lnb[q] = P.ln_b[l * 512 + ch]; }
#pragma unroll 1
        for (int c = 0; c < SEGL / 32; ++c) {
            const size_t row = (size_t)b * S_ + tbeg + 32 * c + m;
            f32x16 D[2];
#pragma unroll
            for (int r = 0; r < 16; ++r) { D[0][r] = 0.f; D[1][r] = 0.f; }
            if (seg > 0) {
                const bf16_t* pp = Po + row * 512 + 64 * wid + 8 * hh;
#pragma unroll
                for (int ks = 0; ks < 4; ++ks) { const bf16x8 Pf = *(const bf16x8*)(pp + 16 * ks);
                    D[0] = __builtin_amdgcn_mfma_f32_32x32x16_bf16(SIf[0][ks], Pf, D[0], 0, 0, 0); D[1] = __builtin_amdgcn_mfma_f32_32x32x16_bf16(SIf[1][ks], Pf, D[1], 0, 0, 0); }
            }
            float y[32]; float s = 0.f;
#pragma unroll
            for (int ib = 0; ib < 2; ++ib)
#pragma unroll
                for (int g = 0; g < 4; ++g) { const u32x2 yw = *(const u32x2*)(Yo + row * 512 + 64 * wid + 32 * ib + 8 * g + 4 * hh);
                    y[16 * ib + 4 * g + 0] = bflo(yw.x) + D[ib][4 * g + 0]; y[16 * ib + 4 * g + 1] = bfhi(yw.x) + D[ib][4 * g + 1];
                    y[16 * ib + 4 * g + 2] = bflo(yw.y) + D[ib][4 * g + 2]; y[16 * ib + 4 * g + 3] = bfhi(yw.y) + D[ib][4 * g + 3]; }
#pragma unroll
            for (int q = 0; q < 32; ++q) s += y[q];
            s += shx(s, 32, lane);
            const float mean = s * (1.0f / 64.0f); float qv = 0.f;
#pragma unroll
            for (int q = 0; q < 32; ++q) { y[q] -= mean; qv += y[q] * y[q]; }
            qv += shx(qv, 32, lane);
            const float rstd = rsqrtf(qv * (1.0f / 64.0f) + 64e-5f);
#pragma unroll
            for (int ib = 0; ib < 2; ++ib)
#pragma unroll
                for (int g = 0; g < 4; ++g) { const size_t off = row * 512 + 64 * wid + 32 * ib + 8 * g + 4 * hh;
                    const u32x2 vw = *(const u32x2*)(VBo + off), gw = *(const u32x2*)(Go + off); const int q = 16 * ib + 4 * g;
                    const float o0 = (y[q] * rstd * lnw[q] + lnb[q] + bflo(vw.x)) * bflo(gw.x), o1 = (y[q + 1] * rstd * lnw[q + 1] + lnb[q + 1] + bfhi(vw.x)) * bfhi(gw.x);
                    const float o2 = (y[q + 2] * rstd * lnw[q + 2] + lnb[q + 2] + bflo(vw.y)) * bflo(gw.y), o3 = (y[q + 3] * rstd * lnw[q + 3] + lnb[q + 3] + bfhi(vw.y)) * bfhi(gw.y);
                    u32x2 w; w.x = cvt_pk_bf16(o0, o1); w.y = cvt_pk_bf16(o2, o3); *(u32x2*)(OR + off) = w; }
        }
    }
}

enum { PH_PRO = 0, PH_NORM1, PH_ZQ, PH_KI, PH_IDX, PH_ATT, PH_SCAN, PH_COMB, PH_POST, PH_ZC, PH_CONV, PH_MERGE, PH_WO, PH_NORM2, PH_UP, PH_U, PH_DOWN, PH_FINAL, PH_COUNT };

template <int PH>
__device__ __forceinline__ void run_phase(const Params& P0, int l, LAS unsigned char* lds) {
    Params P = P0; P.ws = opaque_ptr(P0.ws);
    if constexpr (PH == PH_PRO) { if (l == 0) ph_mod(P, lds); ph_wconv(P, l, lds); }
    if constexpr (PH == PH_NORM1) ph_norm(P, l, 0);
    if constexpr (PH == PH_ZQ) ph_gemm_zq(P, lds);
    if constexpr (PH == PH_KI) ph_ki(P, lds);
    if constexpr (PH == PH_IDX) ph_idx(P, lds);
    if constexpr (PH == PH_ATT) ph_att(P, lds);
    if constexpr (PH == PH_SCAN) ph_scan(P, l, lds);
    if constexpr (PH == PH_COMB) ph_comb(P, lds);
    if constexpr (PH == PH_POST) ph_post(P, l);
    if constexpr (PH == PH_ZC) ph_gemm_zc(P, lds);
    if constexpr (PH == PH_CONV) ph_conv(P, l, lds);
    if constexpr (PH == PH_MERGE) ph_gemm_merge(P, lds);
    if constexpr (PH == PH_WO) ph_gemm_wo(P, l, lds);
    if constexpr (PH == PH_NORM2) ph_norm(P, l, 1);
    if constexpr (PH == PH_UP) ph_gemm_up(P, l, lds);
    if constexpr (PH == PH_U) ph_ufix(P, l, lds);
    if constexpr (PH == PH_DOWN) ph_gemm_down(P, l, lds);
    if constexpr (PH == PH_FINAL) ph_final(P);
}

#if MK_SINGLE
__global__ void __launch_bounds__(NTHR, 2) k_mega(Params P) {
    extern __shared__ __attribute__((aligned(16))) unsigned char shm[];
    LAS unsigned char* lds = (LAS unsigned char*)shm;
    LAS unsigned* xbw = (LAS unsigned*)(lds + LDS_BYTES - 16);
    if (threadIdx.x == 0) { xbw[0] = 0u; xbw[1] = 0u; xbw[2] = 0u; xbw[3] = 0u; }
    __syncthreads();
    XcdBarrier bar = xcd_barrier_post((unsigned*)(P.ws + OFF_BAR), (volatile LAS unsigned*)xbw);
#ifndef PROBE_PH
#define PROBE_PH (-1)
#endif
#ifndef PROBE_N
#define PROBE_N 4
#endif
#define PHASE(PH, l) do { unsigned long long t0_ = 0; if (PROBE_PH == PH && blockIdx.x == 0) t0_ = wall_clock64(); \
        run_phase<PH>(P, l, lds); xcd_barrier(bar); \
        if (PROBE_PH == PH && blockIdx.x == 0) { const unsigned long long t1_ = wall_clock64(), d_ = (t1_ - t0_) * PROBE_N; while (wall_clock64() - t1_ < d_) __builtin_amdgcn_s_sleep(8); } } while (0)
#pragma unroll 1
    for (int l = 0; l < 2; ++l) {
        PHASE(PH_PRO, l); PHASE(PH_NORM1, l); PHASE(PH_ZQ, l); PHASE(PH_KI, l); PHASE(PH_IDX, l); PHASE(PH_ATT, l); PHASE(PH_SCAN, l); PHASE(PH_COMB, l); PHASE(PH_POST, l);
        PHASE(PH_ZC, l); PHASE(PH_CONV, l); PHASE(PH_MERGE, l); PHASE(PH_WO, l); PHASE(PH_NORM2, l); PHASE(PH_UP, l); PHASE(PH_U, l); PHASE(PH_DOWN, l);
    }
    run_phase<PH_FINAL>(P, 0, lds);
#undef PHASE
}
#else
template <int PH>
__global__ void __launch_bounds__(NTHR, 2) k_phase(Params P, int l) {
    extern __shared__ __attribute__((aligned(16))) unsigned char shm[];
    run_phase<PH>(P, l, (LAS unsigned char*)shm);
}
template <int PH> static void launch_phase(const Params& P, int l, hipStream_t stream) {
    static bool attr = false;
    if (!attr) { hipFuncSetAttribute((const void*)k_phase<PH>, hipFuncAttributeMaxDynamicSharedMemorySize, LDS_BYTES); attr = true; }
    hipLaunchKernelGGL(k_phase<PH>, dim3(NBLK), dim3(NTHR), LDS_BYTES, stream, P, l);
}
#endif

extern "C" void kernel_launch(void* const* d_in, const int* in_sizes, int n_in, void* d_out, int out_size, void* d_ws, size_t ws_size, hipStream_t stream) {
    (void)in_sizes; (void)n_in; (void)out_size; (void)ws_size;
    Params P{};
    P.x_in = (const float*)d_in[0]; P.c = (const float*)d_in[1]; P.pos = (const int*)d_in[2]; P.rel_bias = (const float*)d_in[3]; P.final_norm = (const float*)d_in[4];
    P.ada_w = (const float*)d_in[5]; P.ada_b = (const float*)d_in[6]; P.norm_mix = (const float*)d_in[7]; P.w_in = (const float*)d_in[8];
    P.mu = (const float*)d_in[9]; P.w0 = (const float*)d_in[10]; P.w_up = (const float*)d_in[11]; P.a0 = (const float*)d_in[12]; P.a_up = (const float*)d_in[13]; P.g_up = (const float*)d_in[14];
    P.k_k = (const float*)d_in[15]; P.k_a = (const float*)d_in[16]; P.r_k = (const float*)d_in[17]; P.ln_w = (const float*)d_in[18]; P.ln_b = (const float*)d_in[19];
    P.sc_conv_w = (const float*)d_in[20]; P.w_branch = (const float*)d_in[21]; P.w_o = (const float*)d_in[22]; P.norm_ffn = (const float*)d_in[23];
    P.ffn_w_up = (const float*)d_in[24]; P.ffn_conv_w = (const float*)d_in[25]; P.ffn_w_down = (const float*)d_in[26];
    P.out = (float*)d_out; P.ws = (unsigned char*)d_ws;
#if MK_SINGLE
    static bool attr = false;
    if (!attr) { hipFuncSetAttribute((const void*)k_mega, hipFuncAttributeMaxDynamicSharedMemorySize, LDS_BYTES); attr = true; }
    hipMemsetAsync((unsigned char*)d_ws + OFF_BAR, 0, XCD_BAR_WORDS * sizeof(unsigned), stream);
    hipLaunchKernelGGL(k_mega, dim3(NBLK), dim3(NTHR), LDS_BYTES, stream, P);
#else
    for (int l = 0; l < 2; ++l) {
        launch_phase<PH_PRO>(P, l, stream); launch_phase<PH_NORM1>(P, l, stream); launch_phase<PH_ZQ>(P, l, stream); launch_phase<PH_KI>(P, l, stream); launch_phase<PH_IDX>(P, l, stream);
        launch_phase<PH_ATT>(P, l, stream); launch_phase<PH_SCAN>(P, l, stream); launch_phase<PH_COMB>(P, l, stream);
        launch_phase<PH_POST>(P, l, stream); launch_phase<PH_ZC>(P, l, stream); launch_phase<PH_CONV>(P, l, stream); launch_phase<PH_MERGE>(P, l, stream);
        launch_phase<PH_WO>(P, l, stream); launch_phase<PH_NORM2>(P, l, stream); launch_phase<PH_UP>(P, l, stream); launch_phase<PH_U>(P, l, stream);
        launch_phase<PH_DOWN>(P, l, stream);
    }
    launch_phase<PH_FINAL>(P, 0, stream);
#endif
}
```
